# Optimizing an MI355X kernel written in HIP

```python
import math
import jax, jax.numpy as jnp
from jax import lax
import numpy as np

D_MODEL = 1024
BATCH = 8
SEQ = 8192
DEPTH = 1

MIX_WIDTH = D_MODEL
SGU_GROUPS = 4
SGU_CH = D_MODEL // 8
SGU_WIDTH = SGU_GROUPS * SGU_CH
CHUNK = 128
DIFF_HEADS = 4
DIFF_QK_DIM = D_MODEL // 16
DIFF_V_DIM = 2 * DIFF_QK_DIM
DIFF_QK_WIDTH = DIFF_HEADS * 2 * DIFF_QK_DIM
DIFF_WIDTH = DIFF_HEADS * DIFF_V_DIM
Q_BLOCK = 128
IN_WIDTH = 2 * SGU_WIDTH + 2 * DIFF_QK_WIDTH + DIFF_WIDTH
MEM_LEN = 256
MEM_HEADS = 4
MEM_HEAD_DIM = D_MODEL // MEM_HEADS
MEM_WIDTH = MEM_HEADS * MEM_HEAD_DIM
N_GROUPS = 4
EXPERTS_PER_GROUP = 8
N_EXPERTS = N_GROUPS * EXPERTS_PER_GROUP
TOP_K = 2
D_EXPERT = D_MODEL // 2
EXPERT_BLOCK = 128
RMS_EPS = 1e-6
LN_EPS = 1e-5

kernel_name = "hymba_sgu_diffattn_alibi_memxattn_hmoe"


def rms_norm(x, g, eps=RMS_EPS):
    xf = x.astype(jnp.float32)
    y = xf * lax.rsqrt(jnp.mean(xf * xf, axis=-1, keepdims=True) + eps)
    return (y * g.astype(jnp.float32)).astype(x.dtype)


def layer_norm(x, g, b, eps=LN_EPS):
    xf = x.astype(jnp.float32)
    mu = jnp.mean(xf, axis=-1, keepdims=True)
    var = jnp.mean(jnp.square(xf - mu), axis=-1, keepdims=True)
    y = (xf - mu) * lax.rsqrt(var + eps)
    return (y * g.astype(jnp.float32) + b.astype(jnp.float32)).astype(x.dtype)


def chunked_sgu(u, v, ln_g, ln_b, w_s, b_s):
    Bn, Sn, G, C = v.shape
    vn = layer_norm(v, ln_g, ln_b)
    vc = vn.reshape(Bn, Sn // CHUNK, CHUNK, G, C)
    ws = jnp.tril(w_s).astype(vc.dtype)
    sp = jnp.einsum('gts,bnsgc->bntgc', ws, vc) + b_s.T.astype(vc.dtype)[:, :, None]
    return u * sp.reshape(Bn, Sn, G, C)


def diff_attention(q, k, v, lam):
    Bn, H, _, Sn, Dq = q.shape
    n_qb = Sn // Q_BLOCK
    slopes = 2.0 ** (-8.0 * jnp.arange(1, H + 1, dtype=jnp.float32) / H)
    q_blocks = jnp.moveaxis(q.reshape(Bn, H, 2, n_qb, Q_BLOCK, Dq), 3, 0)
    kpos = jnp.arange(Sn, dtype=jnp.int32)

    def attend(args):
        qb, i = args
        s = jnp.einsum('bhiqd,bhikd->bhiqk', qb, k).astype(jnp.float32)
        qpos = i * Q_BLOCK + jnp.arange(Q_BLOCK, dtype=jnp.int32)
        dist = (qpos[:, None] - kpos[None, :]).astype(jnp.float32)
        s = s - (slopes[:, None, None] * dist)[None, :, None]
        s = jnp.where(dist >= 0, s, -jnp.inf)
        p = jax.nn.softmax(s, axis=-1)
        a = p[:, :, 0] - lam * p[:, :, 1]
        return jnp.einsum('bhqk,bhkd->bqhd', a.astype(v.dtype), v)

    o = lax.map(attend, (q_blocks, jnp.arange(n_qb, dtype=jnp.int32)))
    return jnp.moveaxis(o, 0, 1).reshape(Bn, Sn, H, v.shape[-1])


def memory_attention(hq, mem_n, w_q, w_kv, w_o):
    Bn, Sn, _ = hq.shape
    Mn = mem_n.shape[1]
    q = (hq @ w_q).reshape(Bn, Sn, MEM_HEADS, MEM_HEAD_DIM) * (MEM_HEAD_DIM ** -0.5)
    kv = (mem_n @ w_kv).reshape(Bn, Mn, 2, MEM_HEADS, MEM_HEAD_DIM)
    k, v = kv[:, :, 0], kv[:, :, 1]
    s = jnp.einsum('bqhd,bkhd->bhqk', q, k).astype(jnp.float32)
    p = jax.nn.softmax(s, axis=-1)
    o = jnp.einsum('bhqk,bkhd->bqhd', p.astype(v.dtype), v).reshape(Bn, Sn, MEM_WIDTH)
    return o @ w_o


def hierarchical_moe(h, w_rg, b_rg, w_re, b_re, w_gate, w_up, w_down):
    Bn, Sn, D = h.shape
    t = h.reshape(-1, D)
    N = t.shape[0]
    pg = jax.nn.softmax((t @ w_rg + b_rg).astype(jnp.float32), axis=-1)
    gate_g, gidx = lax.top_k(pg, 1)
    el = (t @ w_re + b_re).astype(jnp.float32).reshape(N, N_GROUPS, EXPERTS_PER_GROUP)
    el = el[jnp.arange(N), gidx[:, 0]]
    pe = jax.nn.softmax(el, axis=-1)
    pe_top, eloc = lax.top_k(pe, TOP_K)
    wts = gate_g * pe_top / jnp.sum(pe_top, axis=-1, keepdims=True)
    eid = (gidx * EXPERTS_PER_GROUP + eloc).reshape(-1)
    A = N * TOP_K
    tok = jnp.repeat(jnp.arange(N, dtype=jnp.int32), TOP_K)
    order = jnp.argsort(eid)
    e_sorted = eid[order]
    counts = jnp.bincount(eid, length=N_EXPERTS)
    starts = jnp.cumsum(counts) - counts
    padded = (counts + EXPERT_BLOCK - 1) // EXPERT_BLOCK * EXPERT_BLOCK
    pend = jnp.cumsum(padded)
    pstarts = pend - padded
    pos_sorted = (pstarts[e_sorted] + jnp.arange(A, dtype=jnp.int32) - starts[e_sorted]).astype(jnp.int32)
    P = -(-A // EXPERT_BLOCK) * EXPERT_BLOCK + N_EXPERTS * EXPERT_BLOCK
    n_blocks = P // EXPERT_BLOCK
    row_tok = jnp.zeros((P,), jnp.int32).at[pos_sorted].set(tok[order])
    block_expert = jnp.clip(jnp.searchsorted(pend, jnp.arange(n_blocks, dtype=jnp.int32) * EXPERT_BLOCK,
                                             side='right'), 0, N_EXPERTS - 1).astype(jnp.int32)
    x_rows = t[row_tok].reshape(n_blocks, EXPERT_BLOCK, D)

    def expert_rows(args):
        xb, e = args
        g = xb @ w_gate[e]
        u = xb @ w_up[e]
        return (jax.nn.silu(g) * u) @ w_down[e]

    y_rows = lax.map(expert_rows, (x_rows, block_expert)).reshape(P, D)
    pos = jnp.zeros((A,), jnp.int32).at[order].set(pos_sorted)
    y = y_rows[pos].reshape(N, TOP_K, D)
    out = jnp.einsum('nk,nkd->nd', wts.astype(y.dtype), y)
    return out.reshape(Bn, Sn, D)


def setup_inputs(seed: int = 0) -> dict:
    key = jax.random.key(seed)
    ks = jax.random.split(key, 32)
    L, D = DEPTH, D_MODEL
    f32 = jnp.float32

    def nrm(k, shape, scale):
        return jax.random.normal(k, shape, f32) * scale

    def gain(k, shape):
        return 1.0 + 0.05 * jax.random.normal(k, shape, f32)

    return {
        "x": jax.random.normal(ks[0], (BATCH, SEQ, D), f32),
        "mem": jax.random.normal(ks[1], (BATCH, MEM_LEN, D), f32),
        "norm_mix": gain(ks[2], (L, D)),
        "w_in": nrm(ks[3], (L, D, IN_WIDTH), D ** -0.5),
        "sgu_ln_g": gain(ks[4], (L, SGU_GROUPS, SGU_CH)),
        "sgu_ln_b": nrm(ks[5], (L, SGU_GROUPS, SGU_CH), 0.02),
        "sgu_w": nrm(ks[6], (L, SGU_GROUPS, CHUNK, CHUNK), CHUNK ** -0.5),
        "sgu_b": gain(ks[7], (L, SGU_GROUPS, CHUNK)),
        "lambda_q1": nrm(ks[8], (L, DIFF_QK_DIM), 0.1),
        "lambda_k1": nrm(ks[9], (L, DIFF_QK_DIM), 0.1),
        "lambda_q2": nrm(ks[10], (L, DIFF_QK_DIM), 0.1),
        "lambda_k2": nrm(ks[11], (L, DIFF_QK_DIM), 0.1),
        "diff_subln": gain(ks[12], (L, DIFF_V_DIM)),
        "w_out": nrm(ks[13], (L, MIX_WIDTH, D), MIX_WIDTH ** -0.5),
        "norm_xq": gain(ks[14], (L, D)),
        "norm_mem": gain(ks[15], (L, D)),
        "w_q_mem": nrm(ks[16], (L, D, MEM_WIDTH), D ** -0.5),
        "w_kv_mem": nrm(ks[17], (L, D, 2 * MEM_WIDTH), D ** -0.5),
        "w_o_mem": nrm(ks[18], (L, MEM_WIDTH, D), MEM_WIDTH ** -0.5),
        "norm_ffn": gain(ks[19], (L, D)),
        "w_router_group": nrm(ks[20], (L, D, N_GROUPS), D ** -0.5),
        "b_router_group": nrm(ks[21], (L, N_GROUPS), 0.01),
        "w_router_expert": nrm(ks[22], (L, D, N_EXPERTS), D ** -0.5),
        "b_router_expert": nrm(ks[23], (L, N_EXPERTS), 0.01),
        "w_gate": nrm(ks[24], (L, N_EXPERTS, D, D_EXPERT), D ** -0.5),
        "w_up": nrm(ks[25], (L, N_EXPERTS, D, D_EXPERT), D ** -0.5),
        "w_down": nrm(ks[26], (L, N_EXPERTS, D_EXPERT, D), D_EXPERT ** -0.5),
        "norm_final": gain(ks[27], (D,)),
    }


def reference(x, mem, norm_mix, w_in, sgu_ln_g, sgu_ln_b, sgu_w, sgu_b, lambda_q1, lambda_k1, lambda_q2,
              lambda_k2, diff_subln, w_out, norm_xq, norm_mem, w_q_mem, w_kv_mem, w_o_mem, norm_ffn,
              w_router_group, b_router_group, w_router_expert, b_router_expert, w_gate, w_up, w_down,
              norm_final):
    Bn, Sn, _ = x.shape
    cuts = [SGU_WIDTH, 2 * SGU_WIDTH, 2 * SGU_WIDTH + DIFF_QK_WIDTH, 2 * SGU_WIDTH + 2 * DIFF_QK_WIDTH]
    for l in range(DEPTH):
        lambda_init = 0.8 - 0.6 * math.exp(-0.3 * l)
        h = rms_norm(x, norm_mix[l])
        z = h @ w_in[l]
        zu, zv, zq, zk, zval = jnp.split(z, cuts, axis=-1)
        u = jax.nn.gelu(zu, approximate=False).reshape(Bn, Sn, SGU_GROUPS, SGU_CH)
        v = jax.nn.gelu(zv, approximate=False).reshape(Bn, Sn, SGU_GROUPS, SGU_CH)
        a_out = chunked_sgu(u, v, sgu_ln_g[l], sgu_ln_b[l], sgu_w[l], sgu_b[l]).reshape(Bn, Sn, SGU_WIDTH)
        q = zq.reshape(Bn, Sn, DIFF_HEADS, 2, DIFF_QK_DIM).transpose(0, 2, 3, 1, 4) * (DIFF_QK_DIM ** -0.5)
        k = zk.reshape(Bn, Sn, DIFF_HEADS, 2, DIFF_QK_DIM).transpose(0, 2, 3, 1, 4)
        vv = zval.reshape(Bn, Sn, DIFF_HEADS, DIFF_V_DIM).transpose(0, 2, 1, 3)
        lam = (jnp.exp(jnp.sum(lambda_q1[l].astype(jnp.float32) * lambda_k1[l].astype(jnp.float32)))
               - jnp.exp(jnp.sum(lambda_q2[l].astype(jnp.float32) * lambda_k2[l].astype(jnp.float32)))
               + lambda_init)
        o = diff_attention(q, k, vv, lam)
        o = rms_norm(o, diff_subln[l]) * (1.0 - lambda_init)
        mixed = jnp.concatenate([a_out, o.reshape(Bn, Sn, DIFF_WIDTH)], axis=-1) @ w_out[l]
        x = x + mixed
        x = x + memory_attention(rms_norm(x, norm_xq[l]), rms_norm(mem, norm_mem[l]),
                                 w_q_mem[l], w_kv_mem[l], w_o_mem[l])
        x = x + hierarchical_moe(rms_norm(x, norm_ffn[l]), w_router_group[l], b_router_group[l],
                                 w_router_expert[l], b_router_expert[l], w_gate[l], w_up[l], w_down[l])
    return rms_norm(x, norm_final)
```

```cpp
#include <hip/hip_runtime.h>
#include <hip/hip_cooperative_groups.h>
#include <cstdio>
#include <cstdint>
namespace cg = cooperative_groups;

#ifndef MK_ONE_LAUNCH
#define MK_ONE_LAUNCH 0
#endif

#define LAS __attribute__((address_space(3)))
#define GAS __attribute__((address_space(1)))
typedef unsigned short bf16_t;
typedef short bf16x8 __attribute__((ext_vector_type(8)));
typedef short s16x4 __attribute__((ext_vector_type(4)));
typedef float f32x2 __attribute__((ext_vector_type(2)));
typedef float f32x4 __attribute__((ext_vector_type(4)));
typedef float f32x16 __attribute__((ext_vector_type(16)));
typedef unsigned u32x2 __attribute__((ext_vector_type(2)));
typedef unsigned u32x4 __attribute__((ext_vector_type(4)));

constexpr int NB = 8, SEQ = 8192, DM = 1024, M = NB * SEQ;
constexpr int ZP = 2560;
constexpr int ZU = 0, ZV = 512, ZQ = 1024, ZK = 1536, ZVAL = 2048;
constexpr int MEML = 256, MROWS = NB * MEML;
constexpr int NEXP = 32, DEXP = 512;
constexpr int PROWS = 2 * M + NEXP * 256;
constexpr int MAXBLK = PROWS / 256;
constexpr float RMS_EPS = 1e-6f, LN_EPS = 1e-5f;
constexpr float LOG2E = 1.4426950408889634f;
constexpr float C2_DIFF = 0.125f * LOG2E;
constexpr float C2_MEM = 0.0625f * LOG2E;

constexpr size_t MiB = 1u << 20;
constexpr size_t WS_CTL = 0, CTL_BYTES = 1 * MiB;
constexpr size_t WS_WIN = 1 * MiB;
constexpr size_t WS_WOUT = 6 * MiB;
constexpr size_t WS_WQ = 8 * MiB;
constexpr size_t WS_WKV = 10 * MiB;
constexpr size_t WS_WO = 14 * MiB;
constexpr size_t WS_WR = 16 * MiB;
constexpr size_t WS_WSGU = 17 * MiB;
constexpr size_t WS_MEMN = 18 * MiB;
constexpr size_t WS_KM = 22 * MiB;
constexpr size_t WS_VT = 26 * MiB;
constexpr size_t WS_WGU = 30 * MiB;
constexpr size_t WS_WD = 94 * MiB;
constexpr size_t WS_RA = 128 * MiB;
constexpr size_t WS_RB = 448 * MiB;
constexpr size_t WS_RC = 592 * MiB;
constexpr size_t WS_SSQ1 = 720 * MiB;
constexpr size_t WS_SSQ2 = 724 * MiB;
constexpr size_t WS_LOGIT = 728 * MiB;
constexpr size_t WS_TOKE = 744 * MiB;
constexpr size_t WS_TOKW = 745 * MiB;
constexpr size_t WS_TOKS = 746 * MiB;
constexpr size_t WS_ROWTOK = 747 * MiB;
constexpr size_t WS_END = 752 * MiB;
constexpr int CW_CNT = 64;
constexpr int CW_NBLK = 128;
constexpr int CW_PSTART = 192;
constexpr int CW_BLKE = 256;

__device__ __forceinline__ unsigned cvt_pk_bf16(float lo, float hi) { unsigned r; asm volatile("v_cvt_pk_bf16_f32 %0, %1, %2" : "=v"(r) : "v"(lo), "v"(hi)); return r; }
__device__ __forceinline__ float bf_lo(unsigned w) { return __uint_as_float(w << 16); }
__device__ __forceinline__ float bf_hi(unsigned w) { return __uint_as_float(w & 0xffff0000u); }
__device__ __forceinline__ float wave_sum(float v) {
#pragma unroll
    for (int o = 1; o < 64; o <<= 1) v += __shfl_xor(v, o);
    return v;
}
__device__ __forceinline__ float wave_max(float v) {
#pragma unroll
    for (int o = 1; o < 64; o <<= 1) v = fmaxf(v, __shfl_xor(v, o));
    return v;
}
__device__ __forceinline__ int lane_id() { int l; asm volatile("v_mbcnt_lo_u32_b32 %0, -1, 0\n\tv_mbcnt_hi_u32_b32 %0, -1, %0" : "=v"(l)); return l; }
__device__ __forceinline__ unsigned ld_u32_agent(const unsigned* p) { return __hip_atomic_load(p, __ATOMIC_RELAXED, __HIP_MEMORY_SCOPE_AGENT); }

namespace pg8 {
constexpr int BM = 256, BK = 64, HALF = 128, HTB = HALF * BK * 2, STAGE_BYTES = 8 * HTB, NXCD = 8, WGM = 8;
__host__ __device__ __forceinline__ int lds_byte(int r, int c) { const int st = (r >> 4) * 2 + (c >> 5), rr = r & 15, cc = c & 31, ob = rr * 64 + cc * 2; return st * 1024 + (ob ^ (((ob >> 9) & 1) << 5)); }
__host__ __device__ __forceinline__ void stage_rc(int b, int& R, int& C) { const int st = b / 1024, sb = b % 1024, swz = sb ^ (((sb >> 9) & 1) << 5); R = (st >> 1) * 16 + swz / 64; C = (st & 1) * 32 + (swz % 64) / 2; }
__host__ __device__ __forceinline__ int perm32(int rho) { const int n = rho >> 4, i = rho & 15; return 8 * (i >> 2) + 4 * n + (i & 3); }

struct Unit { const char* A; const char* B; int pm, pn, aux; };
struct Gemm { int lda, ldb, K; };

struct TileOrder {
    int nM, nN, nwg, G, c;
    __device__ void init(int nM_, int nN_, int G_, int c_) { nM = nM_; nN = nN_; nwg = nM * nN; G = G_; c = c_; }
    __device__ bool get(int i, int& pm, int& pn) const {
        const long L = (long)i * G + c; if (L >= nwg) return false;
        int wgid = (int)L; { const int q = nwg / NXCD, r = nwg % NXCD, xcd = wgid % NXCD, off = wgid / NXCD; wgid = (xcd < r ? xcd * (q + 1) : r * (q + 1) + (xcd - r) * q) + off; }
        const int nig = WGM * nN, gid = wgid / nig, fm = gid * WGM, gsz = (nM - fm) < WGM ? (nM - fm) : WGM;
        pm = fm + ((wgid % nig) % gsz); pn = (wgid % nig) / gsz; return true;
    }
};

typedef float f32x2g __attribute__((ext_vector_type(2)));
__device__ __forceinline__ f32x2g gelu_pk(f32x2g v) {
    const f32x2g av = __builtin_elementwise_abs(v), d = av * 0.2316418882f + 1.0f;
    f32x2g t; t.x = __builtin_amdgcn_rcpf(d.x); t.y = __builtin_amdgcn_rcpf(d.y);
    f32x2g q = t * 0.5307027145f + (-0.7265760135f); q = q * t + 0.7107068705f; q = q * t + (-0.142248368f); q = q * t + 0.127414796f; q = q * t;
    const f32x2g s = (v * v) * (-0.72134752044f);
    f32x2g e; e.x = __builtin_amdgcn_exp2f(s.x); e.y = __builtin_amdgcn_exp2f(s.y);
    const f32x2g m = v * (q * e), r = v - m;
    f32x2g o; o.x = v.x < 0.f ? m.x : r.x; o.y = v.y < 0.f ? m.y : r.y; return o;
}

template <class Epi, class Sched>
__device__ __forceinline__ void gemm_phase(LAS unsigned char* lds, int wid, const Gemm g, const Sched& S, const Epi& E) {
    const int lane = lane_id(), tid = wid * 64 + lane, wr = wid >> 2, wc = wid & 3, fr = lane & 15, fq = lane >> 4;
    const int nt = g.K / BK;
    unsigned voffA[2], voffB[2];
#pragma unroll
    for (int i = 0; i < 2; ++i) { int R, C; stage_rc(tid * 16 + i * 8192, R, C); const int Rb = Epi::PERM ? ((R & ~31) + perm32(R & 31)) : R;
        voffA[i] = (unsigned)(R * g.lda + C) * 2u; voffB[i] = (unsigned)(Rb * g.ldb + C) * 2u; }
    const size_t kstep = (size_t)(BK * 2);
    const size_t hstepA = (size_t)HALF * g.lda * 2, hstepB = (size_t)HALF * g.ldb * 2;
    const unsigned ldsw = (unsigned)wid * 1024u;
    const int aoff = lds_byte(wr * 64 + fr, fq * 8), boff = lds_byte(wc * 32 + fr, fq * 8);
#define PG8_SA(b, h) (((b) * 2 + (h)) * HTB)
#define PG8_SB(b, h) ((4 + (b) * 2 + (h)) * HTB)
#define PG8_STAGE(bufoff, gbase, voff) do { _Pragma("unroll") for (int _i = 0; _i < 2; ++_i) \
        __builtin_amdgcn_global_load_lds((const unsigned*)((const char*)(gbase) + (voff)[_i]), (LAS unsigned*)(lds + (bufoff) + ldsw + _i * 8192), 16, 0, 0); } while (0)
#define PG8_LDA(dst, b, h) do { _Pragma("unroll") for (int m = 0; m < 4; ++m) _Pragma("unroll") for (int k = 0; k < 2; ++k) dst[m][k] = *(const LAS bf16x8*)(lds + PG8_SA(b, h) + aoff + m * 2048 + k * 1024); } while (0)
#define PG8_LDB(dst, b, h) do { _Pragma("unroll") for (int n = 0; n < 2; ++n) _Pragma("unroll") for (int k = 0; k < 2; ++k) dst[n][k] = *(const LAS bf16x8*)(lds + PG8_SB(b, h) + boff + n * 2048 + k * 1024); } while (0)
#define PG8_MMA(ai, bj, At, Bt) do { __builtin_amdgcn_s_setprio(1); _Pragma("unroll") for (int m = 0; m < 4; ++m) _Pragma("unroll") for (int n = 0; n < 2; ++n) _Pragma("unroll") for (int k = 0; k < 2; ++k) \
        acc[ai][bj][m][n] = __builtin_amdgcn_mfma_f32_16x16x32_bf16(Bt[n][k], At[m][k], acc[ai][bj][m][n], 0, 0, 0); __builtin_amdgcn_s_setprio(0); } while (0)
#define PG8_WAIT_V(n) asm volatile("s_waitcnt vmcnt(" #n ")" ::: "memory")
#define PG8_WAIT_L(n) asm volatile("s_waitcnt lgkmcnt(" #n ")" ::: "memory")
#define PG8_BAR __builtin_amdgcn_s_barrier()
#define PG8_SCHED __builtin_amdgcn_sched_barrier(0)
    Unit cur, nxt; int ui = 0;
    if (!S.next(0, cur)) return;
    f32x4 acc[2][2][4][2];
#pragma unroll
    for (int a = 0; a < 2; ++a)
#pragma unroll
        for (int b = 0; b < 2; ++b)
#pragma unroll
            for (int m = 0; m < 4; ++m)
#pragma unroll
                for (int n = 0; n < 2; ++n) acc[a][b][m][n] = (f32x4){0.f, 0.f, 0.f, 0.f};
    bf16x8 At[4][2], B0[2][2], B1[2][2];
    const char* cA = cur.A; const char* cB = cur.B;
    PG8_STAGE(PG8_SB(0, 0), cB, voffB); PG8_STAGE(PG8_SB(0, 1), cB + hstepB, voffB); PG8_STAGE(PG8_SA(0, 0), cA, voffA); PG8_STAGE(PG8_SA(0, 1), cA + hstepA, voffA);
    if (wr == 1) PG8_BAR;
    PG8_WAIT_V(2); PG8_BAR;
    PG8_STAGE(PG8_SB(1, 0), cB + kstep, voffB); PG8_STAGE(PG8_SA(1, 0), cA + kstep, voffA); PG8_STAGE(PG8_SB(1, 1), cB + hstepB + kstep, voffB);
    PG8_WAIT_V(6); PG8_BAR;
    for (;;) {
        const bool has_next = S.next(ui + 1, nxt);
        const char* nA = has_next ? nxt.A : cA; const char* nB = has_next ? nxt.B : cB;
        for (int t = 0; t < nt; t += 2) {
            const bool last = (t == nt - 2);
            const char* a1 = cA + (size_t)(t + 1) * kstep;
            const char* a2 = last ? nA : cA + (size_t)(t + 2) * kstep; const char* b2 = last ? nB : cB + (size_t)(t + 2) * kstep;
            const char* a3 = a2 + kstep; const char* b3 = b2 + kstep;
            PG8_LDB(B0, 0, 0); PG8_LDB(B1, 0, 1); PG8_SCHED; PG8_LDA(At, 0, 0); PG8_STAGE(PG8_SA(1, 1), a1 + hstepA, voffA);
            PG8_WAIT_V(8); PG8_WAIT_L(0); PG8_BAR; PG8_MMA(0, 0, At, B0); PG8_MMA(0, 1, At, B1); PG8_BAR; PG8_SCHED;
            PG8_LDA(At, 0, 1); PG8_STAGE(PG8_SB(0, 0), b2, voffB); PG8_STAGE(PG8_SB(0, 1), b2 + hstepB, voffB); PG8_STAGE(PG8_SA(0, 0), a2, voffA);
            PG8_WAIT_V(8); PG8_WAIT_L(0); PG8_BAR; PG8_MMA(1, 0, At, B0); PG8_MMA(1, 1, At, B1); PG8_BAR; PG8_SCHED;
            PG8_LDB(B0, 1, 0); PG8_LDB(B1, 1, 1); PG8_SCHED; PG8_LDA(At, 1, 0); PG8_STAGE(PG8_SA(0, 1), a2 + hstepA, voffA);
            PG8_WAIT_V(8); PG8_WAIT_L(0); PG8_BAR; PG8_MMA(0, 0, At, B0); PG8_MMA(0, 1, At, B1); PG8_BAR; PG8_SCHED;
            PG8_LDA(At, 1, 1); PG8_STAGE(PG8_SB(1, 0), b3, voffB); PG8_STAGE(PG8_SB(1, 1), b3 + hstepB, voffB); PG8_STAGE(PG8_SA(1, 0), a3, voffA);
            PG8_WAIT_V(8); PG8_WAIT_L(0); PG8_BAR; PG8_MMA(1, 0, At, B0); PG8_MMA(1, 1, At, B1); PG8_BAR; PG8_SCHED;
        }
        if (wr == 0) PG8_BAR;
        E(acc, cur, wr, wc, fr, fq);
        if (!has_next) break;
#pragma unroll
        for (int a = 0; a < 2; ++a)
#pragma unroll
            for (int b = 0; b < 2; ++b)
#pragma unroll
                for (int m = 0; m < 4; ++m)
#pragma unroll
                    for (int n = 0; n < 2; ++n) acc[a][b][m][n] = (f32x4){0.f, 0.f, 0.f, 0.f};
        cur = nxt; cA = nA; cB = nB; ++ui;
        if (wr == 1) PG8_BAR;
    }
    PG8_WAIT_V(0);
    PG8_BAR;
#undef PG8_SA
#undef PG8_SB
#undef PG8_STAGE
#undef PG8_LDA
#undef PG8_LDB
#undef PG8_MMA
#undef PG8_WAIT_V
#undef PG8_WAIT_L
#undef PG8_BAR
#undef PG8_SCHED
}

struct PlainSched {
    TileOrder to; const char* A; const char* B; size_t tA, tB;
    __device__ __forceinline__ bool next(int i, Unit& u) const { int pm, pn; if (!to.get(i, pm, pn)) return false; u.pm = pm; u.pn = pn; u.aux = 0; u.A = A + (size_t)pm * tA; u.B = B + (size_t)pn * tB; return true; }
};
struct MemAttnSched {
    TileOrder to; const char* A; const char* B; size_t bB, hB;
    __device__ __forceinline__ bool next(int i, Unit& u) const { int pm, pn; if (!to.get(i, pm, pn)) return false; u.pm = pm; u.pn = pn; u.aux = 0;
        u.A = A + (size_t)pm * (256 * DM * 2) + (size_t)pn * 512; const int b = pm >> 5; u.B = B + (size_t)b * bB + (size_t)pn * hB; return true; }
};
struct MoeSched {
    int G, c, nblk; const unsigned* blk_e; const char* A; const char* B; size_t tA, eB, tB;
    __device__ __forceinline__ bool next(int i, Unit& u) const { const int L = i * G + c; if (L >= nblk * 4) return false; const int rb = L >> 2, pn = L & 3;
        const int e = (int)__builtin_amdgcn_readfirstlane(ld_u32_agent(blk_e + rb)); u.pm = rb; u.pn = pn; u.aux = e;
        u.A = A + (size_t)rb * tA; u.B = B + (size_t)e * eB + (size_t)pn * tB; return true; }
};

#define EPI_ARGS const f32x4 (&acc)[2][2][4][2], const Unit& u, int wr, int wc, int fr, int fq
struct EpiZ {
    static constexpr bool PERM = true;
    bf16_t* O;
    __device__ __forceinline__ void operator()(EPI_ARGS) const {
        const int row0 = u.pm * BM + wr * 64 + fr, col0 = u.pn * BM + wc * 32 + 8 * fq;
        const int mode = u.pn < 4 ? 1 : (u.pn < 6 ? 2 : 0);
#pragma unroll
        for (int ai = 0; ai < 2; ++ai)
#pragma unroll
            for (int m = 0; m < 4; ++m) { bf16_t* rowp = O + (size_t)(row0 + ai * HALF + m * 16) * ZP + col0;
#pragma unroll
                for (int bj = 0; bj < 2; ++bj) { f32x4 v0 = acc[ai][bj][m][0], v1 = acc[ai][bj][m][1];
                    if (mode == 1) { f32x2g a = gelu_pk((f32x2g){v0[0], v0[1]}), b = gelu_pk((f32x2g){v0[2], v0[3]}), c = gelu_pk((f32x2g){v1[0], v1[1]}), d = gelu_pk((f32x2g){v1[2], v1[3]});
                        v0 = (f32x4){a.x, a.y, b.x, b.y}; v1 = (f32x4){c.x, c.y, d.x, d.y}; }
                    else if (mode == 2) { v0 = v0 * C2_DIFF; v1 = v1 * C2_DIFF; }
                    u32x4 w; w.x = cvt_pk_bf16(v0[0], v0[1]); w.y = cvt_pk_bf16(v0[2], v0[3]); w.z = cvt_pk_bf16(v1[0], v1[1]); w.w = cvt_pk_bf16(v1[2], v1[3]);
                    *(u32x4*)(rowp + bj * HALF) = w; } }
    }
};
struct EpiBf16 {
    static constexpr bool PERM = true;
    bf16_t* O; int ldc; const float* ssq; float cscale;
    __device__ __forceinline__ void operator()(EPI_ARGS) const {
        const int row0 = u.pm * BM + wr * 64 + fr, col0 = u.pn * BM + wc * 32 + 8 * fq;
#pragma unroll
        for (int ai = 0; ai < 2; ++ai)
#pragma unroll
            for (int m = 0; m < 4; ++m) { const int row = row0 + ai * HALF + m * 16; float sc = cscale;
                if (ssq) { float s = 0.f;
#pragma unroll
                    for (int j = 0; j < 16; ++j) s += ssq[(size_t)j * M + row];
                    sc *= __builtin_amdgcn_rsqf(s * (1.0f / DM) + RMS_EPS); }
                bf16_t* rowp = O + (size_t)row * ldc + col0;
#pragma unroll
                for (int bj = 0; bj < 2; ++bj) { const f32x4 v0 = acc[ai][bj][m][0] * sc, v1 = acc[ai][bj][m][1] * sc;
                    u32x4 w; w.x = cvt_pk_bf16(v0[0], v0[1]); w.y = cvt_pk_bf16(v0[2], v0[3]); w.z = cvt_pk_bf16(v1[0], v1[1]); w.w = cvt_pk_bf16(v1[2], v1[3]);
                    *(u32x4*)(rowp + bj * HALF) = w; } }
    }
};
struct EpiResid {
    static constexpr bool PERM = false;
    const float* base; float* out; bf16_t* ob; float* ssq;
    __device__ __forceinline__ void operator()(EPI_ARGS) const {
        const int row0 = u.pm * BM + wr * 64 + fr, col0 = u.pn * BM + wc * 32 + 4 * fq;
#pragma unroll
        for (int ai = 0; ai < 2; ++ai)
#pragma unroll
            for (int m = 0; m < 4; ++m) { const int row = row0 + ai * HALF + m * 16; const size_t off = (size_t)row * DM + col0; float s = 0.f;
#pragma unroll
                for (int bj = 0; bj < 2; ++bj)
#pragma unroll
                    for (int n = 0; n < 2; ++n) { const f32x4 bs = *(const f32x4*)(base + off + bj * HALF + n * 16); const f32x4 o = bs + acc[ai][bj][m][n];
                        *(f32x4*)(out + off + bj * HALF + n * 16) = o; s += (o[0] * o[0] + o[1] * o[1]) + (o[2] * o[2] + o[3] * o[3]);
                        u32x2 w; w.x = cvt_pk_bf16(o[0], o[1]); w.y = cvt_pk_bf16(o[2], o[3]); *(u32x2*)(ob + off + bj * HALF + n * 16) = w; }
                s += __shfl_xor(s, 16); s += __shfl_xor(s, 32);
                if (fq == 0) ssq[(size_t)(u.pn * 4 + wc) * M + row] = s; }
    }
};
struct EpiRouter {
    static constexpr bool PERM = false;
    float* L; const float* ssq; const float* bg; const float* be;
    __device__ __forceinline__ void operator()(EPI_ARGS) const {
        if (wc >= 2) return;
        const int row0 = u.pm * BM + wr * 64 + fr;
#pragma unroll
        for (int ai = 0; ai < 2; ++ai)
#pragma unroll
            for (int m = 0; m < 4; ++m) { const int row = row0 + ai * HALF + m * 16; float s = 0.f;
#pragma unroll
                for (int j = 0; j < 16; ++j) s += ssq[(size_t)j * M + row];
                const float rs = __builtin_amdgcn_rsqf(s * (1.0f / DM) + RMS_EPS);
#pragma unroll
                for (int n = 0; n < 2; ++n) { const int c0 = wc * 32 + n * 16 + 4 * fq; f32x4 o = acc[ai][0][m][n] * rs;
#pragma unroll
                    for (int j = 0; j < 4; ++j) { const int c = c0 + j; const float b = c < 4 ? bg[c] : (c < 36 ? be[c - 4] : 0.f); o[j] += b; }
                    *(f32x4*)(L + (size_t)row * 64 + c0) = o; } }
    }
};
struct EpiGateUp {
    static constexpr bool PERM = true;
    bf16_t* act; const float* ssq; const int* row_tok;
    __device__ __forceinline__ void operator()(EPI_ARGS) const {
        const int row0 = u.pm * BM + wr * 64 + fr, col0 = u.pn * 128 + wc * 32 + 8 * fq;
#pragma unroll
        for (int ai = 0; ai < 2; ++ai)
#pragma unroll
            for (int m = 0; m < 4; ++m) { const int row = row0 + ai * HALF + m * 16; const int tok = row_tok[row]; float s = 0.f;
#pragma unroll
                for (int j = 0; j < 16; ++j) s += ssq[(size_t)j * M + tok];
                const float rs = __builtin_amdgcn_rsqf(s * (1.0f / DM) + RMS_EPS);
                float r[8];
#pragma unroll
                for (int n = 0; n < 2; ++n)
#pragma unroll
                    for (int j = 0; j < 4; ++j) { const float gg = acc[ai][0][m][n][j] * rs, uu = acc[ai][1][m][n][j] * rs;
                        r[n * 4 + j] = gg * __builtin_amdgcn_rcpf(1.0f + __builtin_amdgcn_exp2f(-gg * LOG2E)) * uu; }
                u32x4 w; w.x = cvt_pk_bf16(r[0], r[1]); w.y = cvt_pk_bf16(r[2], r[3]); w.z = cvt_pk_bf16(r[4], r[5]); w.w = cvt_pk_bf16(r[6], r[7]);
                *(u32x4*)(act + (size_t)row * DEXP + col0) = w; }
    }
};
}

namespace da {
constexpr int NW = 8, QBLK = 32, KVBLK = 64, QB = NW * QBLK, DV = 128;
constexpr int SHM_V = KVBLK * DV * 2, SHM_K = KVBLK * 64 * 2;
constexpr int LDS_V = 0, LDS_K = 2 * SHM_V, LDS_WS = LDS_K + 2 * SHM_K, LDS_STASH = LDS_WS + NW * 64 * 4, LDS_BYTES = LDS_STASH + NW * 8192;
constexpr float THR = 8.f;
#define SBAR() __builtin_amdgcn_sched_barrier(0)
__device__ __forceinline__ int kswz(int row, int chunk) { return row * 128 + ((chunk ^ ((row >> 1) & 7)) << 4); }
__device__ __forceinline__ int v_st(int k, int c) { const int kk = (k & ~0xC) | ((k & 4) << 1) | ((k & 8) >> 1); return ((kk >> 3) * 4 + (c >> 5)) * 512 + ((kk & 7) * 32 + (c & 31)) * 2; }
__device__ __forceinline__ int v_rd_base(int lane) { return ((lane & 3) << 3) | (((lane >> 2) & 3) << 6) | (((lane >> 4) & 1) << 5) | (((lane >> 5) & 1) << 8); }
constexpr int v_rd_off(int d0, int ks, int half) { return d0 * 512 + ks * 4096 + half * 2048; }
__device__ __forceinline__ int crow(int r, int hi) { return (r & 3) + 8 * (r >> 2) + 4 * hi; }
__device__ __forceinline__ bf16x8 load8(const bf16_t* p) { return *reinterpret_cast<const bf16x8*>(p); }

__device__ __forceinline__ void mask_tile(f32x16& p0, f32x16& p1, int dq) {
    const float NEG = -__builtin_inff();
#pragma unroll
    for (int r = 0; r < 16; ++r) { const int c = (r & 3) + 8 * (r >> 2); if (dq - c < 0) p0[r] = NEG; if (dq - c - 32 < 0) p1[r] = NEG; }
}
__device__ __forceinline__ void partialSM(f32x16& p0, f32x16& p1, float& m_reg, float& alpha) {
    float pmax = p0[0];
#pragma unroll
    for (int r = 1; r < 16; ++r) pmax = fmaxf(pmax, p0[r]);
#pragma unroll
    for (int r = 0; r < 16; ++r) pmax = fmaxf(pmax, p1[r]);
    { auto rr = __builtin_amdgcn_permlane32_swap(__float_as_uint(pmax), __float_as_uint(pmax), false, false); pmax = fmaxf(__uint_as_float(rr[0]), __uint_as_float(rr[1])); }
    float mn;
    if (__builtin_expect(__all((pmax - m_reg) <= THR), 1)) { mn = m_reg; alpha = 1.f; }
    else { mn = fmaxf(m_reg, pmax); alpha = __builtin_amdgcn_exp2f(m_reg - mn); m_reg = mn; }
#pragma unroll
    for (int r = 0; r < 16; ++r) p0[r] = p0[r] - mn;
#pragma unroll
    for (int r = 0; r < 16; ++r) p1[r] = p1[r] - mn;
#pragma unroll
    for (int r = 0; r < 16; ++r) p0[r] = __builtin_amdgcn_exp2f(p0[r]);
}
__device__ __forceinline__ void finishSM(f32x16& p0, f32x16& p1, float alpha, float& l_reg, bf16x8& pa0, bf16x8& pa1, bf16x8& pa2, bf16x8& pa3) {
#pragma unroll
    for (int r = 0; r < 16; ++r) p1[r] = __builtin_amdgcn_exp2f(p1[r]);
    float ps = 0;
#pragma unroll
    for (int r = 0; r < 16; ++r) ps += p0[r];
#pragma unroll
    for (int r = 0; r < 16; ++r) ps += p1[r];
    { auto rr = __builtin_amdgcn_permlane32_swap(__float_as_uint(ps), __float_as_uint(ps), false, false); ps = __uint_as_float(rr[0]) + __uint_as_float(rr[1]); }
    l_reg = l_reg * alpha + ps;
#define PK4(P, B_, OUT) do { unsigned a0 = cvt_pk_bf16(P[B_+0], P[B_+1]), a1 = cvt_pk_bf16(P[B_+2], P[B_+3]);                          \
        unsigned b0 = cvt_pk_bf16(P[B_+4], P[B_+5]), b1 = cvt_pk_bf16(P[B_+6], P[B_+7]);                                             \
        auto r0 = __builtin_amdgcn_permlane32_swap(a0, b0, false, false); auto r1 = __builtin_amdgcn_permlane32_swap(a1, b1, false, false); \
        u32x4 w = {r0[0], r1[0], r0[1], r1[1]}; OUT = *reinterpret_cast<bf16x8*>(&w); } while (0)
    PK4(p0, 0, pa0); PK4(p0, 8, pa1); PK4(p1, 0, pa2); PK4(p1, 8, pa3);
#undef PK4
}
template <int KB>
__device__ __forceinline__ void qkt(f32x16& p0, f32x16& p1, const char* K_lds, int r32, int hi, const bf16x8* qr, float ab, float slope2) {
    const float s32 = 32.f * slope2;
#pragma unroll
    for (int r = 0; r < 16; ++r) { p0[r] = fmaf(slope2, (float)((r & 3) + 8 * (r >> 2)), ab); p1[r] = p0[r] + s32; }
#pragma unroll
    for (int d0 = 0; d0 < 4; ++d0) { const char* a = K_lds + KB * SHM_K + kswz(r32, d0 * 2 + hi);
        bf16x8 b0 = *reinterpret_cast<const bf16x8*>(a);
        bf16x8 b1 = *reinterpret_cast<const bf16x8*>(a + 32 * 128);
        p0 = __builtin_amdgcn_mfma_f32_32x32x16_bf16(b0, qr[d0], p0, 0, 0, 0);
        p1 = __builtin_amdgcn_mfma_f32_32x32x16_bf16(b1, qr[d0], p1, 0, 0, 0); }
}
template <int VB>
__device__ __forceinline__ void pv_tile(f32x16* o, int vb0, bf16x8 pa0, bf16x8 pa1, bf16x8 pa2, bf16x8 pa3) {
#define TRRD(dst, off) asm volatile("ds_read_b64_tr_b16 %0, %1 offset:%2" : "=&v"(dst) : "v"(vb0), "i"(off) : "memory")
#define PV_D0(d0) do { s16x4 l0, l1, l2, l3, h0, h1, h2, h3; constexpr int b_ = VB * SHM_V + v_rd_off(d0, 0, 0); \
        TRRD(l0, b_); TRRD(h0, b_ + 2048); TRRD(l1, b_ + 4096); TRRD(h1, b_ + 6144); TRRD(l2, b_ + 8192); TRRD(h2, b_ + 10240); TRRD(l3, b_ + 12288); TRRD(h3, b_ + 14336); \
        asm volatile("s_waitcnt lgkmcnt(0)" ::: "memory"); SBAR();   \
        o[d0] = __builtin_amdgcn_mfma_f32_32x32x16_bf16(pa0, (bf16x8){l0[0], l0[1], l0[2], l0[3], h0[0], h0[1], h0[2], h0[3]}, o[d0], 0, 0, 0);   \
        o[d0] = __builtin_amdgcn_mfma_f32_32x32x16_bf16(pa1, (bf16x8){l1[0], l1[1], l1[2], l1[3], h1[0], h1[1], h1[2], h1[3]}, o[d0], 0, 0, 0);   \
        o[d0] = __builtin_amdgcn_mfma_f32_32x32x16_bf16(pa2, (bf16x8){l2[0], l2[1], l2[2], l2[3], h2[0], h2[1], h2[2], h2[3]}, o[d0], 0, 0, 0);   \
        o[d0] = __builtin_amdgcn_mfma_f32_32x32x16_bf16(pa3, (bf16x8){l3[0], l3[1], l3[2], l3[3], h3[0], h3[1], h3[2], h3[3]}, o[d0], 0, 0, 0); } while (0)
    PV_D0(0); PV_D0(1); PV_D0(2); PV_D0(3);
#undef PV_D0
#undef TRRD
}

struct BlockRef { const bf16_t* Q; const bf16_t* K; const bf16_t* V; bf16_t* O; int P0; int mode; float slope2; int h; };
struct Seam { bf16x8 qr[4]; bf16x8 st_v0, st_v1, st_k0; };
__device__ __forceinline__ BlockRef mkref(const bf16_t* Z, bf16_t* AO, int item, int pass) { BlockRef r; const int bh = item >> 4, y = item & 15, b = bh >> 2, h = bh & 3; const int qb = (pass < 2) ? y : 31 - y, mp = pass & 1;
    const bf16_t* zb = Z + (size_t)b * SEQ * ZP; r.Q = zb + (size_t)(qb * 256) * ZP + ZQ + h * 128 + mp * 64; r.K = zb + ZK + h * 128 + mp * 64; r.V = zb + ZVAL + h * 128;
    r.O = AO + ((size_t)b * SEQ + qb * 256) * DM + 512 + h * 128; r.P0 = qb * 256; r.mode = mp; r.slope2 = exp2f(-2.0f * (float)(h + 1)) * LOG2E; r.h = h; return r; }
#define ROWV(p, k0, rr) ((p) + (size_t)((k0) + (rr)) * ZP + sc)
#define ROWK(p, k0) ((p) + (size_t)((k0) + skr) * ZP + skc * 8)
#define VMW() asm volatile("s_waitcnt vmcnt(0)" ::: "memory")
#define VMWN(n) asm volatile("s_waitcnt vmcnt(%0)" :: "i"(n) : "memory")
#define SLOAD_H(Kp, Vp, k0) do { S.st_v0 = load8(ROWV(Vp, k0, sr)); S.st_v1 = load8(ROWV(Vp, k0, 32 + sr)); S.st_k0 = load8(ROWK(Kp, k0)); } while (0)
#define SWRITE_HK(bf) do { *(bf16x8*)(K_lds + (bf) * SHM_K + kws) = S.st_k0; } while (0)
#define SWRITE_HV(bf) do { *(bf16x8*)(V_lds + (bf) * SHM_V + vst0) = S.st_v0; *(bf16x8*)(V_lds + (bf) * SHM_V + vst1) = S.st_v1; } while (0)
#define SWRITE_H(bf) do { SWRITE_HV(bf); SWRITE_HK(bf); } while (0)
__device__ __forceinline__ void prime(const BlockRef& cur, char* lds, Seam& S, int wid) {
    const int lane = lane_id(), tid = wid * 64 + lane, r32 = lane & 31, hi = lane >> 5;
    const int sr = tid >> 4, sc = (tid & 15) * 8, skr = tid >> 3, skc = tid & 7, kws = kswz(skr, skc); char* K_lds = lds + LDS_K;
#pragma unroll
    for (int d0 = 0; d0 < 4; ++d0) S.qr[d0] = load8(cur.Q + (size_t)(wid * QBLK + r32) * ZP + d0 * 16 + hi * 8);
    SLOAD_H(cur.K, cur.V, 0); VMW(); SWRITE_HK(0);
    __syncthreads();
}
__device__ __forceinline__ void block(const BlockRef& cur, const BlockRef& nxt, char* lds, Seam& S, float lam, const float* __restrict__ subln, int wid) {
    const int lane = lane_id(), tid = wid * 64 + lane, r32 = lane & 31, hi = lane >> 5;
    const int NT = (cur.P0 + QB) / KVBLK;
    const int qlo = cur.P0 + wid * QBLK, qm = qlo + r32 - 4 * hi;
    const float slope2 = cur.slope2;
    char* V_lds = lds + LDS_V; char* K_lds = lds + LDS_K;
    float* ws = (float*)(lds + LDS_WS) + wid * 64; float* li_l = ws, * al_l = ws + 32;
    float m_reg = -1e30f, l_reg = 0; f32x16 o[4] = {};
    const int sr = tid >> 4, sc = (tid & 15) * 8, vst0 = v_st(sr, sc), vst1 = v_st(32 + sr, sc), skr = tid >> 3, skc = tid & 7, kws = kswz(skr, skc);
    const int vb0 = (int)(uintptr_t)V_lds + v_rd_base(lane);
    const bf16_t* Kh = cur.K; const bf16_t* Vh = cur.V;
#define RESC(a) do { if (__any((a) < 1.f)) { if (hi == 0) al_l[r32] = (a); asm volatile("s_waitcnt lgkmcnt(0)" ::: "memory");              \
                     for (int d_ = 0; d_ < 4; ++d_) for (int r = 0; r < 16; ++r) o[d_][r] *= al_l[crow(r, hi)]; } } while (0)
#define KBASE(t) ((t) * KVBLK)
#define AB(t) (slope2 * (float)(KBASE(t) - qm))
#define MASKT(P0_, P1_, t) do { const int kb_ = KBASE(t); if (kb_ + KVBLK - 1 > qlo) mask_tile(P0_, P1_, qm - kb_); } while (0)
    constexpr int NQL = 4;
#define SEAM_K0() do { VMWN(NQL); SWRITE_HK(0); SBAR(); } while (0)
    f32x16 pA0, pA1, pB0, pB1; float alA, alB; bf16x8 pa0, pa1, pa2, pa3;
    SWRITE_HV(0); SBAR();
    if (NT > 1) { SLOAD_H(Kh, Vh, KBASE(1)); }
    SBAR(); qkt<0>(pA0, pA1, K_lds, r32, hi, S.qr, AB(0), slope2);
    MASKT(pA0, pA1, 0); partialSM(pA0, pA1, m_reg, alA);
    if (NT > 1) { VMW(); SWRITE_H(1); }
    __syncthreads();
#define HALF_STEP(PX0, PX1, alX, PY0, PY1, alY, t, KB, VB, SB) do {                                                      \
        SBAR(); qkt<KB>(PX0, PX1, K_lds, r32, hi, S.qr, AB(t), slope2);                                                   \
        finishSM(PY0, PY1, alY, l_reg, pa0, pa1, pa2, pa3); SBAR();                                                       \
        if ((t) + 1 < NT) { SLOAD_H(Kh, Vh, KBASE((t) + 1)); SBAR(); }                                                    \
        pv_tile<VB>(o, vb0, pa0, pa1, pa2, pa3); MASKT(PX0, PX1, (t)); partialSM(PX0, PX1, m_reg, alX);                   \
        __syncthreads();                                                                                                  \
        if ((t) + 1 < NT) { VMW(); SWRITE_H(SB); }                                                                        \
        RESC(alX); __syncthreads(); } while (0)
    for (int t = 1; t + 1 < NT; t += 2) {
        HALF_STEP(pB0, pB1, alB, pA0, pA1, alA, t, 1, 0, 0);
        HALF_STEP(pA0, pA1, alA, pB0, pB1, alB, t + 1, 0, 1, 1);
    }
    SBAR(); qkt<1>(pB0, pB1, K_lds, r32, hi, S.qr, AB(NT - 1), slope2); SBAR();
    SLOAD_H(nxt.K, nxt.V, 0); SBAR();
#pragma unroll
    for (int d0 = 0; d0 < 4; ++d0) S.qr[d0] = load8(nxt.Q + (size_t)(wid * QBLK + r32) * ZP + d0 * 16 + hi * 8);
    SBAR();
    finishSM(pA0, pA1, alA, l_reg, pa0, pa1, pa2, pa3); SBAR();
    pv_tile<0>(o, vb0, pa0, pa1, pa2, pa3);
    MASKT(pB0, pB1, NT - 1); partialSM(pB0, pB1, m_reg, alB); __syncthreads(); RESC(alB);
    finishSM(pB0, pB1, alB, l_reg, pa0, pa1, pa2, pa3); SBAR(); pv_tile<1>(o, vb0, pa0, pa1, pa2, pa3);
    SBAR(); SEAM_K0();
    if (hi == 0) li_l[r32] = l_reg; asm volatile("s_waitcnt lgkmcnt(0)" ::: "memory");
    float rli[16];
#pragma unroll
    for (int r = 0; r < 16; ++r) rli[r] = __builtin_amdgcn_rcpf(li_l[crow(r, hi)]);
    unsigned* stash = (unsigned*)(lds + LDS_STASH) + wid * 2048 + lane;
    if (cur.mode == 0) {
#pragma unroll
        for (int r = 0; r < 16; ++r) { stash[(r * 2 + 0) * 64] = cvt_pk_bf16(o[0][r] * rli[r], o[1][r] * rli[r]); stash[(r * 2 + 1) * 64] = cvt_pk_bf16(o[2][r] * rli[r], o[3][r] * rli[r]); }
    } else {
        float ssq[16];
#pragma unroll
        for (int r = 0; r < 16; ++r) { const unsigned w0 = stash[(r * 2 + 0) * 64], w1 = stash[(r * 2 + 1) * 64];
            o[0][r] = bf_lo(w0) - lam * (o[0][r] * rli[r]); o[1][r] = bf_hi(w0) - lam * (o[1][r] * rli[r]);
            o[2][r] = bf_lo(w1) - lam * (o[2][r] * rli[r]); o[3][r] = bf_hi(w1) - lam * (o[3][r] * rli[r]);
            ssq[r] = (o[0][r] * o[0][r] + o[1][r] * o[1][r]) + (o[2][r] * o[2][r] + o[3][r] * o[3][r]); }
#pragma unroll
        for (int r = 0; r < 16; ++r) {
#pragma unroll
            for (int off = 1; off < 32; off <<= 1) ssq[r] += __shfl_xor(ssq[r], off);
            ssq[r] = __builtin_amdgcn_rsqf(ssq[r] * (1.0f / DV) + RMS_EPS); }
        float g4[4];
#pragma unroll
        for (int d0 = 0; d0 < 4; ++d0) g4[d0] = subln[d0 * 32 + r32] * 0.8f;
        bf16_t* Ow = cur.O + (size_t)(wid * QBLK) * DM;
#pragma unroll
        for (int r = 0; r < 16; ++r) { const int orow = crow(r, hi);
#pragma unroll
            for (int d0 = 0; d0 < 4; ++d0) { const float v = o[d0][r] * ssq[r] * g4[d0]; const float vn = __shfl_xor(v, 1);
                if ((r32 & 1) == 0) *(unsigned*)(Ow + (size_t)orow * DM + d0 * 32 + r32) = cvt_pk_bf16(v, vn); } }
    }
    __syncthreads();
#undef RESC
#undef KBASE
#undef AB
#undef MASKT
#undef SEAM_K0
#undef HALF_STEP
}
#undef ROWV
#undef ROWK
#undef VMW
#undef VMWN
#undef SLOAD_H
#undef SWRITE_HK
#undef SWRITE_HV
#undef SWRITE_H
#undef SBAR
}

constexpr int NWAVES = 8, NTHR = 512;
constexpr int LDS_BYTES = 147456;
struct Args {
    const float* in[28]; float* out; unsigned char* ws; int ph_lo, ph_hi;
};
constexpr int N_PHASES = 15;

struct Frame {
    LAS unsigned char* lds; int wave, vcu, G;
};

__device__ __forceinline__ void transpose_item(const float* W, int ldw, int k0, int n0, bf16_t* dst, int ldt, const float* kscale, LAS float* scr, int lane) {
#pragma unroll 8
    for (int i = 0; i < 32; ++i) { const int kk = 2 * i + (lane >> 5); float v = W[(size_t)(k0 + kk) * ldw + n0 + (lane & 31)]; if (kscale) v *= kscale[k0 + kk]; scr[kk * 33 + (lane & 31)] = v; }
    asm volatile("s_waitcnt lgkmcnt(0)" ::: "memory");
    const int c = lane & 7;
#pragma unroll
    for (int j = 0; j < 4; ++j) { const int n = (lane >> 3) + 8 * j; const LAS float* s = scr + (8 * c) * 33 + n;
        u32x4 o; o.x = cvt_pk_bf16(s[0 * 33], s[1 * 33]); o.y = cvt_pk_bf16(s[2 * 33], s[3 * 33]); o.z = cvt_pk_bf16(s[4 * 33], s[5 * 33]); o.w = cvt_pk_bf16(s[6 * 33], s[7 * 33]);
        *(u32x4*)(dst + (size_t)n * ldt + k0 + 8 * c) = o; }
    asm volatile("s_waitcnt lgkmcnt(0)" ::: "memory");
}
__device__ __forceinline__ void rms_row_to_bf16(const float* xrow, const float* g, bf16_t* orow, int lane) {
    const f32x4* xr = (const f32x4*)xrow + lane; const f32x4* gr = (const f32x4*)g + lane;
    f32x4 v[4]; float s = 0.f;
#pragma unroll
    for (int j = 0; j < 4; ++j) { v[j] = xr[64 * j]; s += (v[j].x * v[j].x + v[j].y * v[j].y) + (v[j].z * v[j].z + v[j].w * v[j].w); }
    const float rstd = __builtin_amdgcn_rsqf(wave_sum(s) * (1.f / DM) + RMS_EPS);
    u32x2* o8 = (u32x2*)orow + lane;
#pragma unroll
    for (int j = 0; j < 4; ++j) { const f32x4 gg = gr[64 * j]; u32x2 w; w.x = cvt_pk_bf16(v[j].x * rstd * gg.x, v[j].y * rstd * gg.y); w.y = cvt_pk_bf16(v[j].z * rstd * gg.z, v[j].w * rstd * gg.w); o8[64 * j] = w; }
}

__global__ void __launch_bounds__(NTHR, 2) mega(Args args) {
    extern __shared__ __attribute__((aligned(16))) unsigned char lds_raw[];
    Frame F; F.lds = (LAS unsigned char*)lds_raw; F.wave = __builtin_amdgcn_readfirstlane(threadIdx.x >> 6);
    F.G = gridDim.x; { const int bx = blockIdx.x; F.vcu = (F.G % 8 == 0) ? (bx % 8) * (F.G / 8) + bx / 8 : bx; }
    unsigned char* ws = args.ws;
    unsigned* ctl = (unsigned*)(ws + WS_CTL);
    const float* x = args.in[0]; float* out = args.out;
    bf16_t* Win_t = (bf16_t*)(ws + WS_WIN); bf16_t* Wout_t = (bf16_t*)(ws + WS_WOUT); bf16_t* Wq_t = (bf16_t*)(ws + WS_WQ); bf16_t* Wkv_t = (bf16_t*)(ws + WS_WKV);
    bf16_t* Wo_t = (bf16_t*)(ws + WS_WO); bf16_t* Wr_t = (bf16_t*)(ws + WS_WR); bf16_t* Wsgu = (bf16_t*)(ws + WS_WSGU); bf16_t* memn = (bf16_t*)(ws + WS_MEMN);
    bf16_t* Km = (bf16_t*)(ws + WS_KM); bf16_t* Vt = (bf16_t*)(ws + WS_VT); bf16_t* Wgu_t = (bf16_t*)(ws + WS_WGU); bf16_t* Wd_t = (bf16_t*)(ws + WS_WD);
    bf16_t* Z = (bf16_t*)(ws + WS_RA); bf16_t* Qm = (bf16_t*)(ws + WS_RA); bf16_t* Sc = (bf16_t*)(ws + WS_RA + 128 * MiB); bf16_t* xg = (bf16_t*)(ws + WS_RA); bf16_t* yb = (bf16_t*)(ws + WS_RA);
    bf16_t* XN = (bf16_t*)(ws + WS_RB); bf16_t* AO = (bf16_t*)(ws + WS_RB); bf16_t* Om = (bf16_t*)(ws + WS_RB); bf16_t* act = (bf16_t*)(ws + WS_RB);
    bf16_t* x1b = (bf16_t*)(ws + WS_RC); bf16_t* x2b = (bf16_t*)(ws + WS_RC);
    float* ssq1 = (float*)(ws + WS_SSQ1); float* ssq2 = (float*)(ws + WS_SSQ2); float* logit = (float*)(ws + WS_LOGIT);
    int* tok_e = (int*)(ws + WS_TOKE); float* tok_w = (float*)(ws + WS_TOKW); int* tok_s = (int*)(ws + WS_TOKS); int* row_tok = (int*)(ws + WS_ROWTOK);
    const int gw = F.vcu * NWAVES + F.wave, NGW = F.G * NWAVES;
    const int lo = args.ph_lo, hi = args.ph_hi;
#define IN(k) (lo <= (k) && (k) < hi)
#if MK_ONE_LAUNCH
    cg::grid_group grid = cg::this_grid();
#define GRID_BAR(k) do { if (IN(k) && IN((k) + 1)) grid.sync(); } while (0)
#else
#define GRID_BAR(k) do { } while (0)
#endif

    if (IN(0)) {
        const int lane_ = lane_id(), tid_ = F.wave * 64 + lane_; (void)tid_;
        LAS float* scr = (LAS float*)(F.lds + F.wave * 16384);
        constexpr int I_IN = 16 * 80, I_SQ = 16 * 32, I_KV = 16 * 64, I_G = 16 * 16, I_D = 8 * 32;
        constexpr int NITEMS = I_IN + 3 * I_SQ + I_KV + NEXP * (2 * I_G + I_D);
        for (int it = gw; it < NITEMS; it += NGW) {
            int r = it;
            if (r < I_IN) { const int kb = r / 80, nb = r % 80; transpose_item(args.in[3], ZP, kb * 64, nb * 32, Win_t + (size_t)(nb * 32) * DM, DM, nullptr, scr, lane_); continue; } r -= I_IN;
            if (r < I_SQ) { const int kb = r / 32, nb = r % 32; transpose_item(args.in[13], DM, kb * 64, nb * 32, Wout_t + (size_t)(nb * 32) * DM, DM, nullptr, scr, lane_); continue; } r -= I_SQ;
            if (r < I_SQ) { const int kb = r / 32, nb = r % 32; transpose_item(args.in[16], DM, kb * 64, nb * 32, Wq_t + (size_t)(nb * 32) * DM, DM, args.in[14], scr, lane_); continue; } r -= I_SQ;
            if (r < I_KV) { const int kb = r / 64, nb = r % 64; transpose_item(args.in[17], 2 * DM, kb * 64, nb * 32, Wkv_t + (size_t)(nb * 32) * DM, DM, nullptr, scr, lane_); continue; } r -= I_KV;
            if (r < I_SQ) { const int kb = r / 32, nb = r % 32; transpose_item(args.in[18], DM, kb * 64, nb * 32, Wo_t + (size_t)(nb * 32) * DM, DM, nullptr, scr, lane_); continue; } r -= I_SQ;
            const int e = r / (2 * I_G + I_D); r -= e * (2 * I_G + I_D);
            if (r < 2 * I_G) { const int up = r >= I_G; if (up) r -= I_G; const int kb = r / 16, nb = r % 16, n0 = nb * 32;
                const float* W = (up ? args.in[25] : args.in[24]) + (size_t)e * DM * DEXP;
                transpose_item(W, DEXP, kb * 64, n0, Wgu_t + ((size_t)e * 1024 + (n0 >> 7) * 256 + up * 128 + (n0 & 127)) * DM, DM, args.in[19], scr, lane_); continue; }
            r -= 2 * I_G;
            { const int kb = r / 32, nb = r % 32; transpose_item(args.in[26] + (size_t)e * DEXP * DM, DM, kb * 64, nb * 32, Wd_t + ((size_t)e * 1024 + nb * 32) * DEXP, DEXP, nullptr, scr, lane_); }
        }
        for (int i = blockIdx.x * NTHR + tid_; i < 256 * DM; i += F.G * NTHR) { const int n = i >> 10, k = i & 1023; float v = 0.f;
            if (n < 4) v = args.in[20][k * 4 + n] * args.in[19][k]; else if (n < 36) v = args.in[22][k * 32 + (n - 4)] * args.in[19][k];
            Wr_t[i] = (bf16_t)(cvt_pk_bf16(v, 0.f) & 0xffffu); }
        for (int i = blockIdx.x * NTHR + tid_; i < 4 * 128 * 128; i += F.G * NTHR) { const int t = (i >> 7) & 127, s = i & 127; const float v = s <= t ? args.in[6][i] : 0.f; Wsgu[i] = (bf16_t)(cvt_pk_bf16(v, 0.f) & 0xffffu); }
        for (int m = gw; m < M; m += NGW) rms_row_to_bf16(x + (size_t)m * DM, args.in[2], XN + (size_t)m * DM, lane_);
        for (int m = gw; m < MROWS; m += NGW) rms_row_to_bf16(args.in[1] + (size_t)m * DM, args.in[15], memn + (size_t)m * DM, lane_);
        __syncthreads();
    }
    GRID_BAR(0);

    if (IN(1)) {
        { pg8::Gemm g{DM, DM, DM}; pg8::PlainSched S; S.to.init(M / 256, ZP / 256, F.G, (int)blockIdx.x); S.A = (const char*)XN; S.B = (const char*)Win_t; S.tA = (size_t)256 * DM * 2; S.tB = (size_t)256 * DM * 2;
          pg8::EpiZ E{Z}; pg8::gemm_phase(F.lds, F.wave, g, S, E); }
        { pg8::Gemm g{DM, DM, DM}; pg8::PlainSched S; S.to.init(MROWS / 256, 4, F.G, (int)blockIdx.x); S.A = (const char*)memn; S.B = (const char*)Wkv_t; S.tA = (size_t)256 * DM * 2; S.tB = (size_t)256 * DM * 2;
          pg8::EpiBf16 E{Km, DM, nullptr, 1.f}; pg8::gemm_phase(F.lds, F.wave, g, S, E); }
        { pg8::Gemm g{DM, DM, DM}; pg8::PlainSched S; S.to.init(4, MROWS / 256, F.G, (int)((blockIdx.x + 128) % F.G)); S.A = (const char*)(Wkv_t + (size_t)DM * DM); S.B = (const char*)memn; S.tA = (size_t)256 * DM * 2; S.tB = (size_t)256 * DM * 2;
          pg8::EpiBf16 E{Vt, MROWS, nullptr, 1.f}; pg8::gemm_phase(F.lds, F.wave, g, S, E); }
    }
    GRID_BAR(1);

    if (IN(2)) {
        const int lane_ = lane_id(), tid_ = F.wave * 64 + lane_; (void)tid_;
        float lam;
        { const float a = args.in[8][lane_] * args.in[9][lane_], b = args.in[10][lane_] * args.in[11][lane_];
          lam = __expf(wave_sum(a)) - __expf(wave_sum(b)) + 0.2f; }
        const int nitems = 32 * 16, npass = 4;
        const int per = (nitems + F.G - 1) / F.G; const int it0 = F.vcu * per; int it1 = it0 + per; if (it1 > nitems) it1 = nitems;
        if (it0 < it1) {
            int item = it0, pass = 0; da::BlockRef cur = da::mkref(Z, AO, item, pass); da::Seam S;
            da::prime(cur, (char*)lds_raw, S, F.wave);
            for (;;) {
                int ni = item, np = pass + 1; if (np == npass) { np = 0; ni = item + 1; }
                const bool last = ni >= it1;
                const da::BlockRef nxt = last ? cur : da::mkref(Z, AO, ni, np);
                da::block(cur, nxt, (char*)lds_raw, S, lam, args.in[12], F.wave);
                if (last) break;
                cur = nxt; item = ni; pass = np;
            }
        }
        __syncthreads();
        {
            LAS bf16_t* vnT = (LAS bf16_t*)F.lds;
            const int lane = lane_, w = F.wave;
            for (int uidx = F.vcu; uidx < (M / 128) * 4; uidx += F.G) {
                const int c = uidx >> 2, g = uidx & 3; const size_t R0 = (size_t)c * 128;
#pragma unroll
                for (int ps = 0; ps < 4; ++ps) { const int s = 16 * w + 4 * ps + (lane >> 4), ch0 = (lane & 15) * 8;
                    const u32x4 raw = *(const u32x4*)(Z + (R0 + s) * ZP + ZV + g * 128 + ch0);
                    float v[8] = {bf_lo(raw.x), bf_hi(raw.x), bf_lo(raw.y), bf_hi(raw.y), bf_lo(raw.z), bf_hi(raw.z), bf_lo(raw.w), bf_hi(raw.w)};
                    float sm = 0.f;
#pragma unroll
                    for (int j = 0; j < 8; ++j) sm += v[j];
#pragma unroll
                    for (int o = 1; o < 16; o <<= 1) sm += __shfl_xor(sm, o);
                    const float mu = sm * (1.f / 128.f); float q = 0.f;
#pragma unroll
                    for (int j = 0; j < 8; ++j) { v[j] -= mu; q += v[j] * v[j]; }
#pragma unroll
                    for (int o = 1; o < 16; o <<= 1) q += __shfl_xor(q, o);
                    const float rstd = __builtin_amdgcn_rsqf(q * (1.f / 128.f) + LN_EPS);
#pragma unroll
                    for (int j = 0; j < 8; ++j) { const float y = v[j] * rstd * args.in[4][g * 128 + ch0 + j] + args.in[5][g * 128 + ch0 + j];
                        vnT[(ch0 + j) * 136 + s] = (bf16_t)(cvt_pk_bf16(y, 0.f) & 0xffffu); } }
                __syncthreads();
                f32x4 acc[8];
#pragma unroll
                for (int mi = 0; mi < 8; ++mi) acc[mi] = (f32x4){0.f, 0.f, 0.f, 0.f};
                const int t = 16 * w + (lane & 15);
                const int nks = (w + 2) >> 1;
                for (int ks = 0; ks < nks; ++ks) {
                    const bf16x8 bfr = *(const bf16x8*)(Wsgu + ((size_t)g * 128 + t) * 128 + ks * 32 + 8 * (lane >> 4));
#pragma unroll
                    for (int mi = 0; mi < 8; ++mi) { const bf16x8 afr = *(const LAS bf16x8*)(vnT + (16 * mi + (lane & 15)) * 136 + ks * 32 + 8 * (lane >> 4));
                        acc[mi] = __builtin_amdgcn_mfma_f32_16x16x32_bf16(afr, bfr, acc[mi], 0, 0, 0); }
                }
                const float bias = args.in[7][g * 128 + t];
#pragma unroll
                for (int mi = 0; mi < 8; ++mi) { const int ch = 16 * mi + 4 * (lane >> 4);
                    const u32x2 ur = *(const u32x2*)(Z + (R0 + t) * ZP + ZU + g * 128 + ch);
                    const float o0 = bf_lo(ur.x) * (acc[mi][0] + bias), o1 = bf_hi(ur.x) * (acc[mi][1] + bias), o2 = bf_lo(ur.y) * (acc[mi][2] + bias), o3 = bf_hi(ur.y) * (acc[mi][3] + bias);
                    u32x2 wv; wv.x = cvt_pk_bf16(o0, o1); wv.y = cvt_pk_bf16(o2, o3);
                    *(u32x2*)(AO + (R0 + t) * DM + g * 128 + ch) = wv; }
                __syncthreads();
            }
        }
    }
    GRID_BAR(2);

    if (IN(3)) {
        pg8::Gemm g{DM, DM, DM}; pg8::PlainSched S; S.to.init(M / 256, 4, F.G, (int)blockIdx.x); S.A = (const char*)AO; S.B = (const char*)Wout_t; S.tA = (size_t)256 * DM * 2; S.tB = (size_t)256 * DM * 2;
        pg8::EpiResid E{x, out, x1b, ssq1}; pg8::gemm_phase(F.lds, F.wave, g, S, E);
    }
    GRID_BAR(3);

    if (IN(4)) {
        pg8::Gemm g{DM, DM, DM}; pg8::PlainSched S; S.to.init(M / 256, 4, F.G, (int)blockIdx.x); S.A = (const char*)x1b; S.B = (const char*)Wq_t; S.tA = (size_t)256 * DM * 2; S.tB = (size_t)256 * DM * 2;
        pg8::EpiBf16 E{Qm, DM, ssq1, C2_MEM}; pg8::gemm_phase(F.lds, F.wave, g, S, E);
    }
    GRID_BAR(4);

    if (IN(5)) {
        pg8::Gemm g{DM, DM, 256}; pg8::MemAttnSched S; S.to.init(M / 256, 4, F.G, (int)blockIdx.x); S.A = (const char*)Qm; S.B = (const char*)Km; S.bB = (size_t)256 * DM * 2; S.hB = 512;
        pg8::EpiBf16 E{Sc, DM, nullptr, 1.f}; pg8::gemm_phase(F.lds, F.wave, g, S, E);
    }
    GRID_BAR(5);

    if (IN(6)) {
        const int lane_ = lane_id(), tid_ = F.wave * 64 + lane_; (void)tid_;
        for (int rh = gw; rh < M * 4; rh += NGW) { u32x2* p = (u32x2*)(Sc + (size_t)rh * 256) + lane_; const u32x2 raw = *p;
            float v0 = bf_lo(raw.x), v1 = bf_hi(raw.x), v2 = bf_lo(raw.y), v3 = bf_hi(raw.y);
            const float mx = wave_max(fmaxf(fmaxf(v0, v1), fmaxf(v2, v3)));
            v0 = __builtin_amdgcn_exp2f(v0 - mx); v1 = __builtin_amdgcn_exp2f(v1 - mx); v2 = __builtin_amdgcn_exp2f(v2 - mx); v3 = __builtin_amdgcn_exp2f(v3 - mx);
            const float inv = __builtin_amdgcn_rcpf(wave_sum((v0 + v1) + (v2 + v3)));
            u32x2 w; w.x = cvt_pk_bf16(v0 * inv, v1 * inv); w.y = cvt_pk_bf16(v2 * inv, v3 * inv); *p = w; }
    }
    GRID_BAR(6);

    if (IN(7)) {
        pg8::Gemm g{DM, MROWS, 256}; pg8::MemAttnSched S; S.to.init(M / 256, 4, F.G, (int)blockIdx.x); S.A = (const char*)Sc; S.B = (const char*)Vt; S.bB = 512; S.hB = (size_t)256 * MROWS * 2;
        pg8::EpiBf16 E{Om, DM, nullptr, 1.f}; pg8::gemm_phase(F.lds, F.wave, g, S, E);
    }
    GRID_BAR(7);

    if (IN(8)) {
        pg8::Gemm g{DM, DM, DM}; pg8::PlainSched S; S.to.init(M / 256, 4, F.G, (int)blockIdx.x); S.A = (const char*)Om; S.B = (const char*)Wo_t; S.tA = (size_t)256 * DM * 2; S.tB = (size_t)256 * DM * 2;
        pg8::EpiResid E{out, out, x2b, ssq2}; pg8::gemm_phase(F.lds, F.wave, g, S, E);
    }
    GRID_BAR(8);

    if (IN(9)) {
        pg8::Gemm g{DM, DM, DM}; pg8::PlainSched S; S.to.init(M / 256, 1, F.G, (int)blockIdx.x); S.A = (const char*)x2b; S.B = (const char*)Wr_t; S.tA = (size_t)256 * DM * 2; S.tB = 0;
        pg8::EpiRouter E{logit, ssq2, args.in[21], args.in[23]}; pg8::gemm_phase(F.lds, F.wave, g, S, E);
    }
    GRID_BAR(9);

    if (IN(10)) {
        const int lane_ = lane_id(), tid_ = F.wave * 64 + lane_; (void)tid_;
        LAS unsigned* lcnt = (LAS unsigned*)F.lds; LAS unsigned* lbase = lcnt + 32;
        for (int t0 = blockIdx.x * NTHR; t0 < M; t0 += F.G * NTHR) {
            if (tid_ < 32) lcnt[tid_] = 0u;
            __syncthreads();
            const int tok = t0 + tid_;
            const f32x4 lg = *(const f32x4*)(logit + (size_t)tok * 64);
            int gi = 0; float gm = lg[0];
#pragma unroll
            for (int j = 1; j < 4; ++j) if (lg[j] > gm) { gm = lg[j]; gi = j; }
            float gs = 0.f;
#pragma unroll
            for (int j = 0; j < 4; ++j) gs += __expf(lg[j] - gm);
            const float gate = 1.0f / gs;
            const f32x4 ea = *(const f32x4*)(logit + (size_t)tok * 64 + 4 + gi * 8), eb = *(const f32x4*)(logit + (size_t)tok * 64 + 8 + gi * 8);
            const float el[8] = {ea[0], ea[1], ea[2], ea[3], eb[0], eb[1], eb[2], eb[3]};
            int i0 = 0; float m0 = el[0];
#pragma unroll
            for (int j = 1; j < 8; ++j) if (el[j] > m0) { m0 = el[j]; i0 = j; }
            int i1 = -1; float m1 = -__builtin_inff();
#pragma unroll
            for (int j = 0; j < 8; ++j) if (j != i0 && el[j] > m1) { m1 = el[j]; i1 = j; }
            if (i1 < 0) i1 = (i0 == 0) ? 1 : 0;
            const float r = __expf(m1 - m0);
            const float w0 = gate / (1.0f + r), w1 = gate * r / (1.0f + r);
            const int e0 = gi * 8 + i0, e1 = gi * 8 + i1;
            const unsigned r0 = atomicAdd((unsigned*)&lcnt[e0], 1u), r1 = atomicAdd((unsigned*)&lcnt[e1], 1u);
            __syncthreads();
            if (tid_ < 32) lbase[tid_] = atomicAdd(ctl + CW_CNT + tid_, lcnt[tid_]);
            __syncthreads();
            tok_e[tok * 2] = e0; tok_e[tok * 2 + 1] = e1; tok_w[tok * 2] = w0; tok_w[tok * 2 + 1] = w1;
            tok_s[tok * 2] = (int)(lbase[e0] + r0); tok_s[tok * 2 + 1] = (int)(lbase[e1] + r1);
            __syncthreads();
        }
    }
    GRID_BAR(10);

    if (IN(11)) {
        const int lane_ = lane_id(), tid_ = F.wave * 64 + lane_; (void)tid_;
        LAS unsigned* lps = (LAS unsigned*)F.lds;
        if (tid_ == 0) { unsigned acc = 0; for (int e = 0; e < 32; ++e) { lps[e] = acc; const unsigned c = ld_u32_agent(ctl + CW_CNT + e); acc += (c + 255u) & ~255u; } lps[32] = acc; }
        __syncthreads();
        if (blockIdx.x == 0) {
            if (tid_ < 32) { const unsigned s = lps[tid_], e2 = lps[tid_ + 1], c = ld_u32_agent(ctl + CW_CNT + tid_);
                for (unsigned b = s >> 8; b < (e2 >> 8); ++b) ctl[CW_BLKE + b] = (unsigned)tid_;
                for (unsigned r = s + c; r < e2; ++r) row_tok[r] = 0; }
            if (tid_ == 0) ctl[CW_NBLK] = lps[32] >> 8;
        }
        for (int a = gw; a < M * 2; a += NGW) { const int tok = a >> 1; const int e = tok_e[a]; const int pos = (int)lps[e] + tok_s[a];
            const u32x4* src = (const u32x4*)(x2b + (size_t)tok * DM) + lane_; u32x4* dst = (u32x4*)(xg + (size_t)pos * DM) + lane_;
            const u32x4 v0 = src[0], v1 = src[64]; dst[0] = v0; dst[64] = v1;
            if (lane_ == 0) { row_tok[pos] = tok; tok_s[a] = pos; } }
        __syncthreads();
    }
    GRID_BAR(11);

    if (IN(12)) {
        const int nblk = (int)__builtin_amdgcn_readfirstlane(ld_u32_agent(ctl + CW_NBLK));
        pg8::Gemm g{DM, DM, DM}; pg8::MoeSched S{F.G, F.vcu, nblk, ctl + CW_BLKE, (const char*)xg, (const char*)Wgu_t, (size_t)256 * DM * 2, (size_t)1024 * DM * 2, (size_t)256 * DM * 2};
        pg8::EpiGateUp E{act, ssq2, row_tok}; pg8::gemm_phase(F.lds, F.wave, g, S, E);
    }
    GRID_BAR(12);

    if (IN(13)) {
        const int nblk = (int)__builtin_amdgcn_readfirstlane(ld_u32_agent(ctl + CW_NBLK));
        pg8::Gemm g{DEXP, DEXP, DEXP}; pg8::MoeSched S{F.G, F.vcu, nblk, ctl + CW_BLKE, (const char*)act, (const char*)Wd_t, (size_t)256 * DEXP * 2, (size_t)1024 * DEXP * 2, (size_t)256 * DEXP * 2};
        pg8::EpiBf16 E{yb, DM, nullptr, 1.f}; pg8::gemm_phase(F.lds, F.wave, g, S, E);
    }
    GRID_BAR(13);

    if (IN(14)) {
        const int lane_ = lane_id(), tid_ = F.wave * 64 + lane_; (void)tid_;
        for (int m = gw; m < M; m += NGW) {
            const int p0 = tok_s[m * 2], p1 = tok_s[m * 2 + 1]; const float w0 = tok_w[m * 2], w1 = tok_w[m * 2 + 1];
            f32x4* xr = (f32x4*)(out + (size_t)m * DM) + lane_; const u32x2* y0 = (const u32x2*)(yb + (size_t)p0 * DM) + lane_; const u32x2* y1 = (const u32x2*)(yb + (size_t)p1 * DM) + lane_;
            const f32x4* gr = (const f32x4*)args.in[27] + lane_;
            f32x4 v[4]; float s = 0.f;
#pragma unroll
            for (int j = 0; j < 4; ++j) { v[j] = xr[64 * j]; const u32x2 a = y0[64 * j], b = y1[64 * j];
                v[j].x += w0 * bf_lo(a.x) + w1 * bf_lo(b.x); v[j].y += w0 * bf_hi(a.x) + w1 * bf_hi(b.x); v[j].z += w0 * bf_lo(a.y) + w1 * bf_lo(b.y); v[j].w += w0 * bf_hi(a.y) + w1 * bf_hi(b.y);
                s += (v[j].x * v[j].x + v[j].y * v[j].y) + (v[j].z * v[j].z + v[j].w * v[j].w); }
            const float rstd = __builtin_amdgcn_rsqf(wave_sum(s) * (1.f / DM) + RMS_EPS);
#pragma unroll
            for (int j = 0; j < 4; ++j) { const f32x4 gg = gr[64 * j]; xr[64 * j] = (f32x4){v[j].x * rstd * gg.x, v[j].y * rstd * gg.y, v[j].z * rstd * gg.z, v[j].w * rstd * gg.w}; }
        }
    }
#undef IN
#undef GRID_BAR
}

extern "C" void kernel_launch(void* const* d_in, const int* in_sizes, int n_in, void* d_out, int out_size, void* d_ws, size_t ws_size, hipStream_t stream) {
    static int grid = 0;
    if (grid == 0) {
        if (n_in != 28 || in_sizes[0] != M * DM || out_size != M * DM || ws_size < WS_END) { fprintf(stderr, "kernel_launch: unexpected shapes (n_in %d in0 %d out %d ws %zu)\n", n_in, n_in > 0 ? in_sizes[0] : -1, out_size, ws_size); grid = -1; return; }
        int dev = 0, cus = 0, per_cu = 0;
        if (hipGetDevice(&dev) != hipSuccess || hipDeviceGetAttribute(&cus, hipDeviceAttributeMultiprocessorCount, dev) != hipSuccess) { grid = -1; return; }
        if (hipFuncSetAttribute((const void*)mega, hipFuncAttributeMaxDynamicSharedMemorySize, LDS_BYTES) != hipSuccess) { fprintf(stderr, "kernel_launch: hipFuncSetAttribute failed\n"); grid = -1; return; }
        if (hipOccupancyMaxActiveBlocksPerMultiprocessor(&per_cu, (const void*)mega, NTHR, LDS_BYTES) != hipSuccess || per_cu < 1) { fprintf(stderr, "kernel_launch: occupancy query says %d\n", per_cu); per_cu = 1; }
        (void)hipGetLastError();
        grid = cus;
    }
    if (grid < 0) return;
    (void)hipMemsetAsync((char*)d_ws + WS_CTL, 0, CTL_BYTES, stream);
    Args a{};
    for (int i = 0; i < 28; ++i) a.in[i] = (const float*)d_in[i];
    a.out = (float*)d_out; a.ws = (unsigned char*)d_ws;
#if MK_ONE_LAUNCH
    a.ph_lo = 0; a.ph_hi = N_PHASES;
    void* kargs[] = {&a};
    hipError_t e = hipLaunchCooperativeKernel((const void*)mega, dim3(grid), dim3(NTHR), kargs, LDS_BYTES, stream);
    if (e != hipSuccess) fprintf(stderr, "cooperative launch failed: %s (grid %d)\n", hipGetErrorString(e), grid);
#else
    for (int p = 0; p < N_PHASES; ++p) { a.ph_lo = p; a.ph_hi = p + 1; hipLaunchKernelGGL(mega, dim3(grid), dim3(NTHR), LDS_BYTES, stream, a); }
#endif
}
```

```cpp
#include <hip/hip_runtime.h>
#include <hip/hip_cooperative_groups.h>
#include <cstdio>
#include <cstdint>
namespace cg = cooperative_groups;

#ifndef MK_ONE_LAUNCH
#define MK_ONE_LAUNCH 1
#endif

#define LAS __attribute__((address_space(3)))
#define GAS __attribute__((address_space(1)))
typedef unsigned short bf16_t;
typedef short bf16x8 __attribute__((ext_vector_type(8)));
typedef short s16x4 __attribute__((ext_vector_type(4)));
typedef float f32x2 __attribute__((ext_vector_type(2)));
typedef float f32x4 __attribute__((ext_vector_type(4)));
typedef float f32x16 __attribute__((ext_vector_type(16)));
typedef unsigned u32x2 __attribute__((ext_vector_type(2)));
typedef unsigned u32x4 __attribute__((ext_vector_type(4)));

constexpr int NB = 8, SEQ = 8192, DM = 1024, M = NB * SEQ;
constexpr int ZP = 2560;
constexpr int ZU = 0, ZV = 512, ZQ = 1024, ZK = 1536, ZVAL = 2048;
constexpr int MEML = 256, MROWS = NB * MEML;
constexpr int NEXP = 32, DEXP = 512;
constexpr int PROWS = 2 * M + NEXP * 256;
constexpr int MAXBLK = PROWS / 256;
constexpr float RMS_EPS = 1e-6f, LN_EPS = 1e-5f;
constexpr float LOG2E = 1.4426950408889634f;
constexpr float C2_DIFF = 0.125f * LOG2E;
constexpr float C2_MEM = 0.0625f * LOG2E;

constexpr size_t MiB = 1u << 20;
constexpr size_t WS_CTL = 0, CTL_BYTES = 1 * MiB;
constexpr size_t WS_WIN = 1 * MiB;
constexpr size_t WS_WOUT = 6 * MiB;
constexpr size_t WS_WQ = 8 * MiB;
constexpr size_t WS_WKV = 10 * MiB;
constexpr size_t WS_WO = 14 * MiB;
constexpr size_t WS_WR = 16 * MiB;
constexpr size_t WS_WSGU = 17 * MiB;
constexpr size_t WS_MEMN = 18 * MiB;
constexpr size_t WS_KM = 22 * MiB;
constexpr size_t WS_VT = 26 * MiB;
constexpr size_t WS_WGU = 30 * MiB;
constexpr size_t WS_WD = 94 * MiB;
constexpr size_t WS_RA = 128 * MiB;
constexpr size_t WS_RB = 448 * MiB;
constexpr size_t WS_RC = 592 * MiB;
constexpr size_t WS_SSQ1 = 720 * MiB;
constexpr size_t WS_SSQ2 = 724 * MiB;
constexpr size_t WS_LOGIT = 728 * MiB;
constexpr size_t WS_TOKE = 744 * MiB;
constexpr size_t WS_TOKW = 745 * MiB;
constexpr size_t WS_TOKS = 746 * MiB;
constexpr size_t WS_ROWTOK = 747 * MiB;
constexpr size_t WS_END = 752 * MiB;
constexpr int CW_CNT = 64;
constexpr int CW_NBLK = 128;
constexpr int CW_PSTART = 192;
constexpr int CW_BLKE = 256;
constexpr int CW_BAR = 4096;
constexpr int LDS_MISC = 131072;

__device__ __forceinline__ unsigned cvt_pk_bf16(float lo, float hi) { unsigned r; asm volatile("v_cvt_pk_bf16_f32 %0, %1, %2" : "=v"(r) : "v"(lo), "v"(hi)); return r; }
__device__ __forceinline__ float bf_lo(unsigned w) { return __uint_as_float(w << 16); }
__device__ __forceinline__ float bf_hi(unsigned w) { return __uint_as_float(w & 0xffff0000u); }
__device__ __forceinline__ float wave_sum(float v) {
#pragma unroll
    for (int o = 1; o < 64; o <<= 1) v += __shfl_xor(v, o);
    return v;
}
__device__ __forceinline__ float wave_max(float v) {
#pragma unroll
    for (int o = 1; o < 64; o <<= 1) v = fmaxf(v, __shfl_xor(v, o));
    return v;
}
__device__ __forceinline__ int lane_id() { int l; asm volatile("v_mbcnt_lo_u32_b32 %0, -1, 0\n\tv_mbcnt_hi_u32_b32 %0, -1, %0" : "=v"(l)); return l; }
__device__ __forceinline__ unsigned ld_u32_agent(const unsigned* p) { return __hip_atomic_load(p, __ATOMIC_RELAXED, __HIP_MEMORY_SCOPE_AGENT); }

namespace pg8 {
constexpr int BM = 256, BK = 64, HALF = 128, HTB = HALF * BK * 2, STAGE_BYTES = 8 * HTB, NXCD = 8, WGM = 8;
__host__ __device__ __forceinline__ int lds_byte(int r, int c) { const int st = (r >> 4) * 2 + (c >> 5), rr = r & 15, cc = c & 31, ob = rr * 64 + cc * 2; return st * 1024 + (ob ^ (((ob >> 9) & 1) << 5)); }
__host__ __device__ __forceinline__ void stage_rc(int b, int& R, int& C) { const int st = b / 1024, sb = b % 1024, swz = sb ^ (((sb >> 9) & 1) << 5); R = (st >> 1) * 16 + swz / 64; C = (st & 1) * 32 + (swz % 64) / 2; }
__host__ __device__ __forceinline__ int perm32(int rho) { const int n = rho >> 4, i = rho & 15; return 8 * (i >> 2) + 4 * n + (i & 3); }

struct Unit { const char* A; const char* B; int pm, pn, aux; };
struct Gemm { int lda, ldb, K; };

struct TileOrder {
    int nM, nN, nwg, G, c;
    __device__ void init(int nM_, int nN_, int G_, int c_) { nM = nM_; nN = nN_; nwg = nM * nN; G = G_; c = c_; }
    __device__ bool get(int i, int& pm, int& pn) const {
        const long L = (long)i * G + c; if (L >= nwg) return false;
        int wgid = (int)L; { const int q = nwg / NXCD, r = nwg % NXCD, xcd = wgid % NXCD, off = wgid / NXCD; wgid = (xcd < r ? xcd * (q + 1) : r * (q + 1) + (xcd - r) * q) + off; }
        const int nig = WGM * nN, gid = wgid / nig, fm = gid * WGM, gsz = (nM - fm) < WGM ? (nM - fm) : WGM;
        pm = fm + ((wgid % nig) % gsz); pn = (wgid % nig) / gsz; return true;
    }
};

typedef float f32x2g __attribute__((ext_vector_type(2)));
__device__ __forceinline__ f32x2g gelu_pk(f32x2g v) {
    const f32x2g av = __builtin_elementwise_abs(v), d = av * 0.2316418882f + 1.0f;
    f32x2g t; t.x = __builtin_amdgcn_rcpf(d.x); t.y = __builtin_amdgcn_rcpf(d.y);
    f32x2g q = t * 0.5307027145f + (-0.7265760135f); q = q * t + 0.7107068705f; q = q * t + (-0.142248368f); q = q * t + 0.127414796f; q = q * t;
    const f32x2g s = (v * v) * (-0.72134752044f);
    f32x2g e; e.x = __builtin_amdgcn_exp2f(s.x); e.y = __builtin_amdgcn_exp2f(s.y);
    const f32x2g m = v * (q * e), r = v - m;
    f32x2g o; o.x = v.x < 0.f ? m.x : r.x; o.y = v.y < 0.f ? m.y : r.y; return o;
}

template <class Epi, class Sched>
__device__ __forceinline__ void gemm_phase(LAS unsigned char* lds, int wid, const Gemm g, const Sched& S, const Epi& E) {
    const int lane = lane_id(), tid = wid * 64 + lane, wr = wid >> 2, wc = wid & 3, fr = lane & 15, fq = lane >> 4;
    const int nt = g.K / BK;
    unsigned voffA[2], voffB[2];
#pragma unroll
    for (int i = 0; i < 2; ++i) { int R, C; stage_rc(tid * 16 + i * 8192, R, C); const int Rb = Epi::PERM ? ((R & ~31) + perm32(R & 31)) : R;
        voffA[i] = (unsigned)(R * g.lda + C) * 2u; voffB[i] = (unsigned)(Rb * g.ldb + C) * 2u; }
    const size_t kstep = (size_t)(BK * 2);
    const size_t hstepA = (size_t)HALF * g.lda * 2, hstepB = (size_t)HALF * g.ldb * 2;
    const unsigned ldsw = (unsigned)wid * 1024u;
    const int aoff = lds_byte(wr * 64 + fr, fq * 8), boff = lds_byte(wc * 32 + fr, fq * 8);
#define PG8_SA(b, h) (((b) * 2 + (h)) * HTB)
#define PG8_SB(b, h) ((4 + (b) * 2 + (h)) * HTB)
#define PG8_STAGE(bufoff, gbase, voff) do { _Pragma("unroll") for (int _i = 0; _i < 2; ++_i) \
        __builtin_amdgcn_global_load_lds((const unsigned*)((const char*)(gbase) + (voff)[_i]), (LAS unsigned*)(lds + (bufoff) + ldsw + _i * 8192), 16, 0, 0); } while (0)
#define PG8_LDA(dst, b, h) do { _Pragma("unroll") for (int m = 0; m < 4; ++m) _Pragma("unroll") for (int k = 0; k < 2; ++k) dst[m][k] = *(const LAS bf16x8*)(lds + PG8_SA(b, h) + aoff + m * 2048 + k * 1024); } while (0)
#define PG8_LDB(dst, b, h) do { _Pragma("unroll") for (int n = 0; n < 2; ++n) _Pragma("unroll") for (int k = 0; k < 2; ++k) dst[n][k] = *(const LAS bf16x8*)(lds + PG8_SB(b, h) + boff + n * 2048 + k * 1024); } while (0)
#define PG8_MMA(ai, bj, At, Bt) do { __builtin_amdgcn_s_setprio(1); _Pragma("unroll") for (int m = 0; m < 4; ++m) _Pragma("unroll") for (int n = 0; n < 2; ++n) _Pragma("unroll") for (int k = 0; k < 2; ++k) \
        acc[ai][bj][m][n] = __builtin_amdgcn_mfma_f32_16x16x32_bf16(Bt[n][k], At[m][k], acc[ai][bj][m][n], 0, 0, 0); __builtin_amdgcn_s_setprio(0); } while (0)
#define PG8_WAIT_V(n) asm volatile("s_waitcnt vmcnt(" #n ")" ::: "memory")
#define PG8_WAIT_L(n) asm volatile("s_waitcnt lgkmcnt(" #n ")" ::: "memory")
#define PG8_BAR __builtin_amdgcn_s_barrier()
#define PG8_SCHED __builtin_amdgcn_sched_barrier(0)
    Unit cur, nxt; int ui = 0;
    if (!S.next(0, cur)) return;
    f32x4 acc[2][2][4][2];
#pragma unroll
    for (int a = 0; a < 2; ++a)
#pragma unroll
        for (int b = 0; b < 2; ++b)
#pragma unroll
            for (int m = 0; m < 4; ++m)
#pragma unroll
                for (int n = 0; n < 2; ++n) acc[a][b][m][n] = (f32x4){0.f, 0.f, 0.f, 0.f};
    bf16x8 At[4][2], B0[2][2], B1[2][2];
    const char* cA = cur.A; const char* cB = cur.B;
    PG8_STAGE(PG8_SB(0, 0), cB, voffB); PG8_STAGE(PG8_SB(0, 1), cB + hstepB, voffB); PG8_STAGE(PG8_SA(0, 0), cA, voffA); PG8_STAGE(PG8_SA(0, 1), cA + hstepA, voffA);
    if (wr == 1) PG8_BAR;
    PG8_WAIT_V(2); PG8_BAR;
    PG8_STAGE(PG8_SB(1, 0), cB + kstep, voffB); PG8_STAGE(PG8_SA(1, 0), cA + kstep, voffA); PG8_STAGE(PG8_SB(1, 1), cB + hstepB + kstep, voffB);
    PG8_WAIT_V(6); PG8_BAR;
    for (;;) {
        const bool has_next = S.next(ui + 1, nxt);
        const char* nA = has_next ? nxt.A : cA; const char* nB = has_next ? nxt.B : cB;
        for (int t = 0; t < nt; t += 2) {
            const bool last = (t == nt - 2);
            const char* a1 = cA + (size_t)(t + 1) * kstep;
            const char* a2 = last ? nA : cA + (size_t)(t + 2) * kstep; const char* b2 = last ? nB : cB + (size_t)(t + 2) * kstep;
            const char* a3 = a2 + kstep; const char* b3 = b2 + kstep;
            PG8_LDB(B0, 0, 0); PG8_LDB(B1, 0, 1); PG8_SCHED; PG8_LDA(At, 0, 0); PG8_STAGE(PG8_SA(1, 1), a1 + hstepA, voffA);
            PG8_WAIT_V(8); PG8_WAIT_L(0); PG8_BAR; PG8_MMA(0, 0, At, B0); PG8_MMA(0, 1, At, B1); PG8_BAR; PG8_SCHED;
            PG8_LDA(At, 0, 1); PG8_STAGE(PG8_SB(0, 0), b2, voffB); PG8_STAGE(PG8_SB(0, 1), b2 + hstepB, voffB); PG8_STAGE(PG8_SA(0, 0), a2, voffA);
            PG8_WAIT_V(8); PG8_WAIT_L(0); PG8_BAR; PG8_MMA(1, 0, At, B0); PG8_MMA(1, 1, At, B1); PG8_BAR; PG8_SCHED;
            PG8_LDB(B0, 1, 0); PG8_LDB(B1, 1, 1); PG8_SCHED; PG8_LDA(At, 1, 0); PG8_STAGE(PG8_SA(0, 1), a2 + hstepA, voffA);
            PG8_WAIT_V(8); PG8_WAIT_L(0); PG8_BAR; PG8_MMA(0, 0, At, B0); PG8_MMA(0, 1, At, B1); PG8_BAR; PG8_SCHED;
            PG8_LDA(At, 1, 1); PG8_STAGE(PG8_SB(1, 0), b3, voffB); PG8_STAGE(PG8_SB(1, 1), b3 + hstepB, voffB); PG8_STAGE(PG8_SA(1, 0), a3, voffA);
            PG8_WAIT_V(8); PG8_WAIT_L(0); PG8_BAR; PG8_MMA(1, 0, At, B0); PG8_MMA(1, 1, At, B1); PG8_BAR; PG8_SCHED;
        }
        if (wr == 0) PG8_BAR;
        E(acc, cur, wr, wc, fr, fq);
        if (!has_next) break;
#pragma unroll
        for (int a = 0; a < 2; ++a)
#pragma unroll
            for (int b = 0; b < 2; ++b)
#pragma unroll
                for (int m = 0; m < 4; ++m)
#pragma unroll
                    for (int n = 0; n < 2; ++n) acc[a][b][m][n] = (f32x4){0.f, 0.f, 0.f, 0.f};
        cur = nxt; cA = nA; cB = nB; ++ui;
        if (wr == 1) PG8_BAR;
    }
    PG8_WAIT_V(0);
    PG8_BAR;
#undef PG8_SA
#undef PG8_SB
#undef PG8_STAGE
#undef PG8_LDA
#undef PG8_LDB
#undef PG8_MMA
#undef PG8_WAIT_V
#undef PG8_WAIT_L
#undef PG8_BAR
#undef PG8_SCHED
}

struct PlainSched {
    TileOrder to; const char* A; const char* B; size_t tA, tB;
    __device__ __forceinline__ bool next(int i, Unit& u) const { int pm, pn; if (!to.get(i, pm, pn)) return false; u.pm = pm; u.pn = pn; u.aux = 0; u.A = A + (size_t)pm * tA; u.B = B + (size_t)pn * tB; return true; }
};
struct MemAttnSched {
    TileOrder to; const char* A; const char* B; size_t bB, hB;
    __device__ __forceinline__ bool next(int i, Unit& u) const { int pm, pn; if (!to.get(i, pm, pn)) return false; u.pm = pm; u.pn = pn; u.aux = 0;
        u.A = A + (size_t)pm * (256 * DM * 2) + (size_t)pn * 512; const int b = pm >> 5; u.B = B + (size_t)b * bB + (size_t)pn * hB; return true; }
};
struct MoeSched {
    int G, c, nblk; const unsigned* blk_e; const char* A; const char* B; size_t tA, eB, tB;
    __device__ __forceinline__ bool next(int i, Unit& u) const { const int L = i * G + c; if (L >= nblk * 4) return false; const int rb = L >> 2, pn = L & 3;
        const int e = (int)__builtin_amdgcn_readfirstlane(ld_u32_agent(blk_e + rb)); u.pm = rb; u.pn = pn; u.aux = e;
        u.A = A + (size_t)rb * tA; u.B = B + (size_t)e * eB + (size_t)pn * tB; return true; }
};

#define EPI_ARGS const f32x4 (&acc)[2][2][4][2], const Unit& u, int wr, int wc, int fr, int fq
struct EpiZ {
    static constexpr bool PERM = true;
    bf16_t* O;
    __device__ __forceinline__ void operator()(EPI_ARGS) const {
        const int row0 = u.pm * BM + wr * 64 + fr, col0 = u.pn * BM + wc * 32 + 8 * fq;
        const int mode = u.pn < 4 ? 1 : (u.pn < 6 ? 2 : 0);
#pragma unroll
        for (int ai = 0; ai < 2; ++ai)
#pragma unroll
            for (int m = 0; m < 4; ++m) { bf16_t* rowp = O + (size_t)(row0 + ai * HALF + m * 16) * ZP + col0;
#pragma unroll
                for (int bj = 0; bj < 2; ++bj) { f32x4 v0 = acc[ai][bj][m][0], v1 = acc[ai][bj][m][1];
                    if (mode == 1) { f32x2g a = gelu_pk((f32x2g){v0[0], v0[1]}), b = gelu_pk((f32x2g){v0[2], v0[3]}), c = gelu_pk((f32x2g){v1[0], v1[1]}), d = gelu_pk((f32x2g){v1[2], v1[3]});
                        v0 = (f32x4){a.x, a.y, b.x, b.y}; v1 = (f32x4){c.x, c.y, d.x, d.y}; }
                    else if (mode == 2) { v0 = v0 * C2_DIFF; v1 = v1 * C2_DIFF; }
                    u32x4 w; w.x = cvt_pk_bf16(v0[0], v0[1]); w.y = cvt_pk_bf16(v0[2], v0[3]); w.z = cvt_pk_bf16(v1[0], v1[1]); w.w = cvt_pk_bf16(v1[2], v1[3]);
                    *(u32x4*)(rowp + bj * HALF) = w; } }
    }
};
struct EpiBf16 {
    static constexpr bool PERM = true;
    bf16_t* O; int ldc; const float* ssq; float cscale;
    __device__ __forceinline__ void operator()(EPI_ARGS) const {
        const int row0 = u.pm * BM + wr * 64 + fr, col0 = u.pn * BM + wc * 32 + 8 * fq;
#pragma unroll
        for (int ai = 0; ai < 2; ++ai)
#pragma unroll
            for (int m = 0; m < 4; ++m) { const int row = row0 + ai * HALF + m * 16; float sc = cscale;
                if (ssq) { float s = 0.f;
#pragma unroll
                    for (int j = 0; j < 16; ++j) s += ssq[(size_t)j * M + row];
                    sc *= __builtin_amdgcn_rsqf(s * (1.0f / DM) + RMS_EPS); }
                bf16_t* rowp = O + (size_t)row * ldc + col0;
#pragma unroll
                for (int bj = 0; bj < 2; ++bj) { const f32x4 v0 = acc[ai][bj][m][0] * sc, v1 = acc[ai][bj][m][1] * sc;
                    u32x4 w; w.x = cvt_pk_bf16(v0[0], v0[1]); w.y = cvt_pk_bf16(v0[2], v0[3]); w.z = cvt_pk_bf16(v1[0], v1[1]); w.w = cvt_pk_bf16(v1[2], v1[3]);
                    *(u32x4*)(rowp + bj * HALF) = w; } }
    }
};
struct EpiResid {
    static constexpr bool PERM = false;
    const float* base; float* out; bf16_t* ob; float* ssq;
    __device__ __forceinline__ void operator()(EPI_ARGS) const {
        const int row0 = u.pm * BM + wr * 64 + fr, col0 = u.pn * BM + wc * 32 + 4 * fq;
#pragma unroll
        for (int ai = 0; ai < 2; ++ai)
#pragma unroll
            for (int m = 0; m < 4; ++m) { const int row = row0 + ai * HALF + m * 16; const size_t off = (size_t)row * DM + col0; float s = 0.f;
#pragma unroll
                for (int bj = 0; bj < 2; ++bj)
#pragma unroll
                    for (int n = 0; n < 2; ++n) { const f32x4 bs = *(const f32x4*)(base + off + bj * HALF + n * 16); const f32x4 o = bs + acc[ai][bj][m][n];
                        *(f32x4*)(out + off + bj * HALF + n * 16) = o; s += (o[0] * o[0] + o[1] * o[1]) + (o[2] * o[2] + o[3] * o[3]);
                        u32x2 w; w.x = cvt_pk_bf16(o[0], o[1]); w.y = cvt_pk_bf16(o[2], o[3]); *(u32x2*)(ob + off + bj * HALF + n * 16) = w; }
                s += __shfl_xor(s, 16); s += __shfl_xor(s, 32);
                if (fq == 0) ssq[(size_t)(u.pn * 4 + wc) * M + row] = s; }
    }
};
struct EpiRouter {
    static constexpr bool PERM = false;
    float* L; const float* ssq; const float* bg; const float* be;
    __device__ __forceinline__ void operator()(EPI_ARGS) const {
        if (wc >= 2) return;
        const int row0 = u.pm * BM + wr * 64 + fr;
#pragma unroll
        for (int ai = 0; ai < 2; ++ai)
#pragma unroll
            for (int m = 0; m < 4; ++m) { const int row = row0 + ai * HALF + m * 16; float s = 0.f;
#pragma unroll
                for (int j = 0; j < 16; ++j) s += ssq[(size_t)j * M + row];
                const float rs = __builtin_amdgcn_rsqf(s * (1.0f / DM) + RMS_EPS);
#pragma unroll
                for (int n = 0; n < 2; ++n) { const int c0 = wc * 32 + n * 16 + 4 * fq; f32x4 o = acc[ai][0][m][n] * rs;
#pragma unroll
                    for (int j = 0; j < 4; ++j) { const int c = c0 + j; const float b = c < 4 ? bg[c] : (c < 36 ? be[c - 4] : 0.f); o[j] += b; }
                    *(f32x4*)(L + (size_t)row * 64 + c0) = o; } }
    }
};
struct EpiGateUp {
    static constexpr bool PERM = true;
    bf16_t* act; const float* ssq; const int* row_tok;
    __device__ __forceinline__ void operator()(EPI_ARGS) const {
        const int row0 = u.pm * BM + wr * 64 + fr, col0 = u.pn * 128 + wc * 32 + 8 * fq;
#pragma unroll
        for (int ai = 0; ai < 2; ++ai)
#pragma unroll
            for (int m = 0; m < 4; ++m) { const int row = row0 + ai * HALF + m * 16; const int tok = row_tok[row]; float s = 0.f;
#pragma unroll
                for (int j = 0; j < 16; ++j) s += ssq[(size_t)j * M + tok];
                const float rs = __builtin_amdgcn_rsqf(s * (1.0f / DM) + RMS_EPS);
                float r[8];
#pragma unroll
                for (int n = 0; n < 2; ++n)
#pragma unroll
                    for (int j = 0; j < 4; ++j) { const float gg = acc[ai][0][m][n][j] * rs, uu = acc[ai][1][m][n][j] * rs;
                        r[n * 4 + j] = gg * __builtin_amdgcn_rcpf(1.0f + __builtin_amdgcn_exp2f(-gg * LOG2E)) * uu; }
                u32x4 w; w.x = cvt_pk_bf16(r[0], r[1]); w.y = cvt_pk_bf16(r[2], r[3]); w.z = cvt_pk_bf16(r[4], r[5]); w.w = cvt_pk_bf16(r[6], r[7]);
                *(u32x4*)(act + (size_t)row * DEXP + col0) = w; }
    }
};
}

namespace da {
constexpr int NW = 8, QBLK = 32, KVBLK = 64, QB = NW * QBLK, DV = 128;
constexpr int SHM_V = KVBLK * DV * 2, SHM_K = KVBLK * 64 * 2;
constexpr int LDS_V = 0, LDS_K = 2 * SHM_V, LDS_WS = LDS_K + 2 * SHM_K, LDS_STASH = LDS_WS + NW * 64 * 4, LDS_BYTES = LDS_STASH + NW * 8192;
constexpr float THR = 8.f;
#define SBAR() __builtin_amdgcn_sched_barrier(0)
__device__ __forceinline__ int kswz(int row, int chunk) { return row * 128 + ((chunk ^ ((row >> 1) & 7)) << 4); }
__device__ __forceinline__ int v_st(int k, int c) { const int kk = (k & ~0xC) | ((k & 4) << 1) | ((k & 8) >> 1); return ((kk >> 3) * 4 + (c >> 5)) * 512 + ((kk & 7) * 32 + (c & 31)) * 2; }
__device__ __forceinline__ int v_rd_base(int lane) { return ((lane & 3) << 3) | (((lane >> 2) & 3) << 6) | (((lane >> 4) & 1) << 5) | (((lane >> 5) & 1) << 8); }
constexpr int v_rd_off(int d0, int ks, int half) { return d0 * 512 + ks * 4096 + half * 2048; }
__device__ __forceinline__ int crow(int r, int hi) { return (r & 3) + 8 * (r >> 2) + 4 * hi; }
__device__ __forceinline__ bf16x8 load8(const bf16_t* p) { return *reinterpret_cast<const bf16x8*>(p); }

__device__ __forceinline__ void mask_tile(f32x16& p0, f32x16& p1, int dq) {
    const float NEG = -__builtin_inff();
#pragma unroll
    for (int r = 0; r < 16; ++r) { const int c = (r & 3) + 8 * (r >> 2); if (dq - c < 0) p0[r] = NEG; if (dq - c - 32 < 0) p1[r] = NEG; }
}
__device__ __forceinline__ void partialSM(f32x16& p0, f32x16& p1, float& m_reg, float& alpha) {
    float pmax = p0[0];
#pragma unroll
    for (int r = 1; r < 16; ++r) pmax = fmaxf(pmax, p0[r]);
#pragma unroll
    for (int r = 0; r < 16; ++r) pmax = fmaxf(pmax, p1[r]);
    { auto rr = __builtin_amdgcn_permlane32_swap(__float_as_uint(pmax), __float_as_uint(pmax), false, false); pmax = fmaxf(__uint_as_float(rr[0]), __uint_as_float(rr[1])); }
    float mn;
    if (__builtin_expect(__all((pmax - m_reg) <= THR), 1)) { mn = m_reg; alpha = 1.f; }
    else { mn = fmaxf(m_reg, pmax); alpha = __builtin_amdgcn_exp2f(m_reg - mn); m_reg = mn; }
#pragma unroll
    for (int r = 0; r < 16; ++r) p0[r] = p0[r] - mn;
#pragma unroll
    for (int r = 0; r < 16; ++r) p1[r] = p1[r] - mn;
#pragma unroll
    for (int r = 0; r < 16; ++r) p0[r] = __builtin_amdgcn_exp2f(p0[r]);
}
__device__ __forceinline__ void finishSM(f32x16& p0, f32x16& p1, float alpha, float& l_reg, bf16x8& pa0, bf16x8& pa1, bf16x8& pa2, bf16x8& pa3) {
#pragma unroll
    for (int r = 0; r < 16; ++r) p1[r] = __builtin_amdgcn_exp2f(p1[r]);
    float ps = 0;
#pragma unroll
    for (int r = 0; r < 16; ++r) ps += p0[r];
#pragma unroll
    for (int r = 0; r < 16; ++r) ps += p1[r];
    { auto rr = __builtin_amdgcn_permlane32_swap(__float_as_uint(ps), __float_as_uint(ps), false, false); ps = __uint_as_float(rr[0]) + __uint_as_float(rr[1]); }
    l_reg = l_reg * alpha + ps;
#define PK4(P, B_, OUT) do { unsigned a0 = cvt_pk_bf16(P[B_+0], P[B_+1]), a1 = cvt_pk_bf16(P[B_+2], P[B_+3]);                          \
        unsigned b0 = cvt_pk_bf16(P[B_+4], P[B_+5]), b1 = cvt_pk_bf16(P[B_+6], P[B_+7]);                                             \
        auto r0 = __builtin_amdgcn_permlane32_swap(a0, b0, false, false); auto r1 = __builtin_amdgcn_permlane32_swap(a1, b1, false, false); \
        u32x4 w = {r0[0], r1[0], r0[1], r1[1]}; OUT = *reinterpret_cast<bf16x8*>(&w); } while (0)
    PK4(p0, 0, pa0); PK4(p0, 8, pa1); PK4(p1, 0, pa2); PK4(p1, 8, pa3);
#undef PK4
}
template <int KB>
__device__ __forceinline__ void qkt(f32x16& p0, f32x16& p1, const char* K_lds, int r32, int hi, const bf16x8* qr, float ab, float slope2) {
    const float s32 = 32.f * slope2;
#pragma unroll
    for (int r = 0; r < 16; ++r) { p0[r] = fmaf(slope2, (float)((r & 3) + 8 * (r >> 2)), ab); p1[r] = p0[r] + s32; }
#pragma unroll
    for (int d0 = 0; d0 < 4; ++d0) { const char* a = K_lds + KB * SHM_K + kswz(r32, d0 * 2 + hi);
        bf16x8 b0 = *reinterpret_cast<const bf16x8*>(a);
        bf16x8 b1 = *reinterpret_cast<const bf16x8*>(a + 32 * 128);
        p0 = __builtin_amdgcn_mfma_f32_32x32x16_bf16(b0, qr[d0], p0, 0, 0, 0);
        p1 = __builtin_amdgcn_mfma_f32_32x32x16_bf16(b1, qr[d0], p1, 0, 0, 0); }
}
template <int VB>
__device__ __forceinline__ void pv_tile(f32x16* o, int vb0, bf16x8 pa0, bf16x8 pa1, bf16x8 pa2, bf16x8 pa3) {
#define TRRD(dst, off) asm volatile("ds_read_b64_tr_b16 %0, %1 offset:%2" : "=&v"(dst) : "v"(vb0), "i"(off) : "memory")
#define PV_D0(d0) do { s16x4 l0, l1, l2, l3, h0, h1, h2, h3; constexpr int b_ = VB * SHM_V + v_rd_off(d0, 0, 0); \
        TRRD(l0, b_); TRRD(h0, b_ + 2048); TRRD(l1, b_ + 4096); TRRD(h1, b_ + 6144); TRRD(l2, b_ + 8192); TRRD(h2, b_ + 10240); TRRD(l3, b_ + 12288); TRRD(h3, b_ + 14336); \
        asm volatile("s_waitcnt lgkmcnt(0)" ::: "memory"); SBAR();   \
        o[d0] = __builtin_amdgcn_mfma_f32_32x32x16_bf16(pa0, (bf16x8){l0[0], l0[1], l0[2], l0[3], h0[0], h0[1], h0[2], h0[3]}, o[d0], 0, 0, 0);   \
        o[d0] = __builtin_amdgcn_mfma_f32_32x32x16_bf16(pa1, (bf16x8){l1[0], l1[1], l1[2], l1[3], h1[0], h1[1], h1[2], h1[3]}, o[d0], 0, 0, 0);   \
        o[d0] = __builtin_amdgcn_mfma_f32_32x32x16_bf16(pa2, (bf16x8){l2[0], l2[1], l2[2], l2[3], h2[0], h2[1], h2[2], h2[3]}, o[d0], 0, 0, 0);   \
        o[d0] = __builtin_amdgcn_mfma_f32_32x32x16_bf16(pa3, (bf16x8){l3[0], l3[1], l3[2], l3[3], h3[0], h3[1], h3[2], h3[3]}, o[d0], 0, 0, 0); } while (0)
    PV_D0(0); PV_D0(1); PV_D0(2); PV_D0(3);
#undef PV_D0
#undef TRRD
}

struct BlockRef { const bf16_t* Q; const bf16_t* K; const bf16_t* V; bf16_t* O; int P0; int mode; float slope2; int h; };
struct Seam { bf16x8 qr[4]; bf16x8 st_v0, st_v1, st_k0; };
__device__ __forceinline__ BlockRef mkref(const bf16_t* Z, bf16_t* AO, int item, int pass) { BlockRef r; const int bh = item >> 4, y = item & 15, b = bh >> 2, h = bh & 3; const int qb = (pass < 2) ? y : 31 - y, mp = pass & 1;
    const bf16_t* zb = Z + (size_t)b * SEQ * ZP; r.Q = zb + (size_t)(qb * 256) * ZP + ZQ + h * 128 + mp * 64; r.K = zb + ZK + h * 128 + mp * 64; r.V = zb + ZVAL + h * 128;
    r.O = AO + ((size_t)b * SEQ + qb * 256) * DM + 512 + h * 128; r.P0 = qb * 256; r.mode = mp; r.slope2 = exp2f(-2.0f * (float)(h + 1)) * LOG2E; r.h = h; return r; }
#define ROWV(p, k0, rr) ((p) + (size_t)((k0) + (rr)) * ZP + sc)
#define ROWK(p, k0) ((p) + (size_t)((k0) + skr) * ZP + skc * 8)
#define VMW() asm volatile("s_waitcnt vmcnt(0)" ::: "memory")
#define VMWN(n) asm volatile("s_waitcnt vmcnt(%0)" :: "i"(n) : "memory")
#define SLOAD_H(Kp, Vp, k0) do { S.st_v0 = load8(ROWV(Vp, k0, sr)); S.st_v1 = load8(ROWV(Vp, k0, 32 + sr)); S.st_k0 = load8(ROWK(Kp, k0)); } while (0)
#define SWRITE_HK(bf) do { *(bf16x8*)(K_lds + (bf) * SHM_K + kws) = S.st_k0; } while (0)
#define SWRITE_HV(bf) do { *(bf16x8*)(V_lds + (bf) * SHM_V + vst0) = S.st_v0; *(bf16x8*)(V_lds + (bf) * SHM_V + vst1) = S.st_v1; } while (0)
#define SWRITE_H(bf) do { SWRITE_HV(bf); SWRITE_HK(bf); } while (0)
__device__ __forceinline__ void prime(const BlockRef& cur, char* lds, Seam& S, int wid) {
    const int lane = lane_id(), tid = wid * 64 + lane, r32 = lane & 31, hi = lane >> 5;
    const int sr = tid >> 4, sc = (tid & 15) * 8, skr = tid >> 3, skc = tid & 7, kws = kswz(skr, skc); char* K_lds = lds + LDS_K;
#pragma unroll
    for (int d0 = 0; d0 < 4; ++d0) S.qr[d0] = load8(cur.Q + (size_t)(wid * QBLK + r32) * ZP + d0 * 16 + hi * 8);
    SLOAD_H(cur.K, cur.V, 0); VMW(); SWRITE_HK(0);
    __syncthreads();
}
__device__ __forceinline__ void block(const BlockRef& cur, const BlockRef& nxt, char* lds, Seam& S, float lam, const float* __restrict__ subln, int wid) {
    const int lane = lane_id(), tid = wid * 64 + lane, r32 = lane & 31, hi = lane >> 5;
    const int NT = (cur.P0 + QB) / KVBLK;
    const int qlo = cur.P0 + wid * QBLK, qm = qlo + r32 - 4 * hi;
    const float slope2 = cur.slope2;
    char* V_lds = lds + LDS_V; char* K_lds = lds + LDS_K;
    float* ws = (float*)(lds + LDS_WS) + wid * 64; float* li_l = ws, * al_l = ws + 32;
    float m_reg = -1e30f, l_reg = 0; f32x16 o[4] = {};
    const int sr = tid >> 4, sc = (tid & 15) * 8, vst0 = v_st(sr, sc), vst1 = v_st(32 + sr, sc), skr = tid >> 3, skc = tid & 7, kws = kswz(skr, skc);
    const int vb0 = (int)(uintptr_t)V_lds + v_rd_base(lane);
    const bf16_t* Kh = cur.K; const bf16_t* Vh = cur.V;
#define RESC(a) do { if (__any((a) < 1.f)) { if (hi == 0) al_l[r32] = (a); asm volatile("s_waitcnt lgkmcnt(0)" ::: "memory");              \
                     for (int d_ = 0; d_ < 4; ++d_) for (int r = 0; r < 16; ++r) o[d_][r] *= al_l[crow(r, hi)]; } } while (0)
#define KBASE(t) ((t) * KVBLK)
#define AB(t) (slope2 * (float)(KBASE(t) - qm))
#define MASKT(P0_, P1_, t) do { const int kb_ = KBASE(t); if (kb_ + KVBLK - 1 > qlo) mask_tile(P0_, P1_, qm - kb_); } while (0)
    constexpr int NQL = 4;
#define SEAM_K0() do { VMWN(NQL); SWRITE_HK(0); SBAR(); } while (0)
    f32x16 pA0, pA1, pB0, pB1; float alA, alB; bf16x8 pa0, pa1, pa2, pa3;
    SWRITE_HV(0); SBAR();
    if (NT > 1) { SLOAD_H(Kh, Vh, KBASE(1)); }
    SBAR(); qkt<0>(pA0, pA1, K_lds, r32, hi, S.qr, AB(0), slope2);
    MASKT(pA0, pA1, 0); partialSM(pA0, pA1, m_reg, alA);
    if (NT > 1) { VMW(); SWRITE_H(1); }
    __syncthreads();
#define HALF_STEP(PX0, PX1, alX, PY0, PY1, alY, t, KB, VB, SB) do {                                                      \
        SBAR(); qkt<KB>(PX0, PX1, K_lds, r32, hi, S.qr, AB(t), slope2);                                                   \
        finishSM(PY0, PY1, alY, l_reg, pa0, pa1, pa2, pa3); SBAR();                                                       \
        if ((t) + 1 < NT) { SLOAD_H(Kh, Vh, KBASE((t) + 1)); SBAR(); }                                                    \
        pv_tile<VB>(o, vb0, pa0, pa1, pa2, pa3); MASKT(PX0, PX1, (t)); partialSM(PX0, PX1, m_reg, alX);                   \
        __syncthreads();                                                                                                  \
        if ((t) + 1 < NT) { VMW(); SWRITE_H(SB); }                                                                        \
        RESC(alX); __syncthreads(); } while (0)
    for (int t = 1; t + 1 < NT; t += 2) {
        HALF_STEP(pB0, pB1, alB, pA0, pA1, alA, t, 1, 0, 0);
        HALF_STEP(pA0, pA1, alA, pB0, pB1, alB, t + 1, 0, 1, 1);
    }
    SBAR(); qkt<1>(pB0, pB1, K_lds, r32, hi, S.qr, AB(NT - 1), slope2); SBAR();
    SLOAD_H(nxt.K, nxt.V, 0); SBAR();
#pragma unroll
    for (int d0 = 0; d0 < 4; ++d0) S.qr[d0] = load8(nxt.Q + (size_t)(wid * QBLK + r32) * ZP + d0 * 16 + hi * 8);
    SBAR();
    finishSM(pA0, pA1, alA, l_reg, pa0, pa1, pa2, pa3); SBAR();
    pv_tile<0>(o, vb0, pa0, pa1, pa2, pa3);
    MASKT(pB0, pB1, NT - 1); partialSM(pB0, pB1, m_reg, alB); __syncthreads(); RESC(alB);
    finishSM(pB0, pB1, alB, l_reg, pa0, pa1, pa2, pa3); SBAR(); pv_tile<1>(o, vb0, pa0, pa1, pa2, pa3);
    SBAR(); SEAM_K0();
    if (hi == 0) li_l[r32] = l_reg; asm volatile("s_waitcnt lgkmcnt(0)" ::: "memory");
    float rli[16];
#pragma unroll
    for (int r = 0; r < 16; ++r) rli[r] = __builtin_amdgcn_rcpf(li_l[crow(r, hi)]);
    unsigned* stash = (unsigned*)(lds + LDS_STASH) + wid * 2048 + lane;
    if (cur.mode == 0) {
#pragma unroll
        for (int r = 0; r < 16; ++r) { stash[(r * 2 + 0) * 64] = cvt_pk_bf16(o[0][r] * rli[r], o[1][r] * rli[r]); stash[(r * 2 + 1) * 64] = cvt_pk_bf16(o[2][r] * rli[r], o[3][r] * rli[r]); }
    } else {
        float ssq[16];
#pragma unroll
        for (int r = 0; r < 16; ++r) { const unsigned w0 = stash[(r * 2 + 0) * 64], w1 = stash[(r * 2 + 1) * 64];
            o[0][r] = bf_lo(w0) - lam * (o[0][r] * rli[r]); o[1][r] = bf_hi(w0) - lam * (o[1][r] * rli[r]);
            o[2][r] = bf_lo(w1) - lam * (o[2][r] * rli[r]); o[3][r] = bf_hi(w1) - lam * (o[3][r] * rli[r]);
            ssq[r] = (o[0][r] * o[0][r] + o[1][r] * o[1][r]) + (o[2][r] * o[2][r] + o[3][r] * o[3][r]); }
#pragma unroll
        for (int r = 0; r < 16; ++r) {
#pragma unroll
            for (int off = 1; off < 32; off <<= 1) ssq[r] += __shfl_xor(ssq[r], off);
            ssq[r] = __builtin_amdgcn_rsqf(ssq[r] * (1.0f / DV) + RMS_EPS); }
        float g4[4];
#pragma unroll
        for (int d0 = 0; d0 < 4; ++d0) g4[d0] = subln[d0 * 32 + r32] * 0.8f;
        bf16_t* Ow = cur.O + (size_t)(wid * QBLK) * DM;
#pragma unroll
        for (int r = 0; r < 16; ++r) { const int orow = crow(r, hi);
#pragma unroll
            for (int d0 = 0; d0 < 4; ++d0) { const float v = o[d0][r] * ssq[r] * g4[d0]; const float vn = __shfl_xor(v, 1);
                if ((r32 & 1) == 0) *(unsigned*)(Ow + (size_t)orow * DM + d0 * 32 + r32) = cvt_pk_bf16(v, vn); } }
    }
    __syncthreads();
#undef RESC
#undef KBASE
#undef AB
#undef MASKT
#undef SEAM_K0
#undef HALF_STEP
}
#undef ROWV
#undef ROWK
#undef VMW
#undef VMWN
#undef SLOAD_H
#undef SWRITE_HK
#undef SWRITE_HV
#undef SWRITE_H
#undef SBAR
}


#define XB_TMO      128
#define XB_XCNT(j)  (256  + 64 * (j))
#define XB_XSUB(j)  (1280 + 64 * (j))
#define XB_XGEN(j)  (2304 + 64 * (j))
#define XB_TOP      3328
#define XB_TOPGEN   3392
#define XCD_BAR_WORDS 3456
#define XB_SPIN_CAP (1u << 22)
__device__ __forceinline__ unsigned xb_ld(unsigned* p)              { return __hip_atomic_load(p, __ATOMIC_RELAXED, __HIP_MEMORY_SCOPE_AGENT); }
__device__ __forceinline__ unsigned xb_add(unsigned* p, unsigned v) { return __hip_atomic_fetch_add(p, v, __ATOMIC_RELAXED, __HIP_MEMORY_SCOPE_AGENT); }
__device__ __forceinline__ unsigned xb_xcc_id() { return (unsigned)__builtin_amdgcn_s_getreg((3 << 11) | 20) & 0xFu; }
#define XB_SPIN(cond, bar) do { unsigned _sp = 0; while (cond) { __builtin_amdgcn_s_sleep(1); \
    if ((++_sp & 255u) == 0u) { if (xb_ld(&(bar)[XB_TMO])) break; if (_sp > XB_SPIN_CAP) { atomicAdd(&(bar)[XB_TMO], 1u); break; } } } } while (0)
struct XcdBarrier { unsigned* bar; unsigned x; volatile LAS unsigned* st; };
__device__ __forceinline__ XcdBarrier xcd_barrier_post(unsigned* bar, volatile LAS unsigned* st, bool t0) {
    XcdBarrier b; b.bar = bar; b.x = xb_xcc_id(); b.st = st;
    if (t0) (void)xb_add(&bar[XB_XCNT(b.x)], 1u);
    return b;
}
__device__ __forceinline__ void xcd_barrier_complete(unsigned* bar, unsigned x, unsigned& nloc, unsigned& nx) {
    const unsigned G = gridDim.x;
    unsigned sum, cnt, mine, sp = 0u;
    for (;;) {
        sum = 0u; cnt = 0u; mine = 0u;
#pragma unroll
        for (unsigned j = 0; j < 16; ++j) { const unsigned c = xb_ld(&bar[XB_XCNT(j)]); sum += c; cnt += (c > 0u) ? 1u : 0u; mine = (j == x) ? c : mine; }
        if (sum == G) break;
        __builtin_amdgcn_s_sleep(1);
        if ((++sp & 255u) == 0u) { if (xb_ld(&bar[XB_TMO])) break; if (sp > XB_SPIN_CAP) { atomicAdd(&bar[XB_TMO], 1u); break; } }
    }
    nloc = mine > 0u ? mine : 1u; nx = cnt > 0u ? cnt : 1u;
}
__device__ __forceinline__ void xcd_barrier(const XcdBarrier& b, bool t0) {
    asm volatile("s_waitcnt vmcnt(0)" ::: "memory");
    __syncthreads();
    if (t0) {
        unsigned* bar = b.bar;
        __builtin_amdgcn_s_waitcnt(0);
        unsigned nloc = b.st[0], nx = b.st[1];
        if (nloc == 0u) { xcd_barrier_complete(bar, b.x, nloc, nx); b.st[0] = nloc; b.st[1] = nx; }
        const unsigned old = xb_add(&bar[XB_XSUB(b.x)], 1u);
        const unsigned gen = old / nloc;
        if (old + 1u == (gen + 1u) * nloc) {
            __builtin_amdgcn_fence(__ATOMIC_RELEASE, "agent");
            asm volatile("s_waitcnt vmcnt(0)" ::: "memory");
            const unsigned og = xb_add(&bar[XB_TOP], 1u);
            const unsigned tg = og / nx;
            if (og + 1u == (tg + 1u) * nx) xb_add(&bar[XB_TOPGEN], 1u);
            else XB_SPIN(xb_ld(&bar[XB_TOPGEN]) == tg, bar);
            __builtin_amdgcn_fence(__ATOMIC_ACQUIRE, "agent");
            xb_add(&bar[XB_XGEN(b.x)], 1u);
            asm volatile("s_waitcnt vmcnt(0)" ::: "memory");
        } else {
            XB_SPIN(xb_ld(&bar[XB_XGEN(b.x)]) == gen, bar);
            __builtin_amdgcn_fence(__ATOMIC_ACQUIRE, "agent");
            asm volatile("s_waitcnt vmcnt(0)" ::: "memory");
        }
    }
    __syncthreads();
}
constexpr int NWAVES = 8, NTHR = 512;
constexpr int LDS_BYTES = 147456;
struct Args {
    const float* in[28]; float* out; unsigned char* ws; int ph_lo, ph_hi;
};
constexpr int N_PHASES = 15;

struct Frame {
    LAS unsigned char* lds; int wave, vcu, G;
};

__device__ __forceinline__ void transpose_item(const float* W, int ldw, int k0, int n0, bf16_t* dst, int ldt, const float* kscale, LAS float* scr, int lane) {
#pragma unroll 8
    for (int i = 0; i < 32; ++i) { const int kk = 2 * i + (lane >> 5); float v = W[(size_t)(k0 + kk) * ldw + n0 + (lane & 31)]; if (kscale) v *= kscale[k0 + kk]; scr[kk * 33 + (lane & 31)] = v; }
    asm volatile("s_waitcnt lgkmcnt(0)" ::: "memory");
    const int c = lane & 7;
#pragma unroll
    for (int j = 0; j < 4; ++j) { const int n = (lane >> 3) + 8 * j; const LAS float* s = scr + (8 * c) * 33 + n;
        u32x4 o; o.x = cvt_pk_bf16(s[0 * 33], s[1 * 33]); o.y = cvt_pk_bf16(s[2 * 33], s[3 * 33]); o.z = cvt_pk_bf16(s[4 * 33], s[5 * 33]); o.w = cvt_pk_bf16(s[6 * 33], s[7 * 33]);
        *(u32x4*)(dst + (size_t)n * ldt + k0 + 8 * c) = o; }
    asm volatile("s_waitcnt lgkmcnt(0)" ::: "memory");
}
__device__ __forceinline__ void rms_row_to_bf16(const float* xrow, const float* g, bf16_t* orow, int lane) {
    const f32x4* xr = (const f32x4*)xrow + lane; const f32x4* gr = (const f32x4*)g + lane;
    f32x4 v[4]; float s = 0.f;
#pragma unroll
    for (int j = 0; j < 4; ++j) { v[j] = xr[64 * j]; s += (v[j].x * v[j].x + v[j].y * v[j].y) + (v[j].z * v[j].z + v[j].w * v[j].w); }
    const float rstd = __builtin_amdgcn_rsqf(wave_sum(s) * (1.f / DM) + RMS_EPS);
    u32x2* o8 = (u32x2*)orow + lane;
#pragma unroll
    for (int j = 0; j < 4; ++j) { const f32x4 gg = gr[64 * j]; u32x2 w; w.x = cvt_pk_bf16(v[j].x * rstd * gg.x, v[j].y * rstd * gg.y); w.y = cvt_pk_bf16(v[j].z * rstd * gg.z, v[j].w * rstd * gg.w); o8[64 * j] = w; }
}

__global__ void __launch_bounds__(NTHR, 2) mega(Args args) {
    extern __shared__ __attribute__((aligned(16))) unsigned char lds_raw[];
    Frame F; F.lds = (LAS unsigned char*)lds_raw; F.wave = __builtin_amdgcn_readfirstlane(threadIdx.x >> 6);
    F.G = gridDim.x; { const int bx = blockIdx.x; F.vcu = (F.G % 8 == 0) ? (bx % 8) * (F.G / 8) + bx / 8 : bx; }
    unsigned char* ws = args.ws;
    unsigned* ctl = (unsigned*)(ws + WS_CTL);
    const float* x = args.in[0]; float* out = args.out;
    bf16_t* Win_t = (bf16_t*)(ws + WS_WIN); bf16_t* Wout_t = (bf16_t*)(ws + WS_WOUT); bf16_t* Wq_t = (bf16_t*)(ws + WS_WQ); bf16_t* Wkv_t = (bf16_t*)(ws + WS_WKV);
    bf16_t* Wo_t = (bf16_t*)(ws + WS_WO); bf16_t* Wr_t = (bf16_t*)(ws + WS_WR); bf16_t* Wsgu = (bf16_t*)(ws + WS_WSGU); bf16_t* memn = (bf16_t*)(ws + WS_MEMN);
    bf16_t* Km = (bf16_t*)(ws + WS_KM); bf16_t* Vt = (bf16_t*)(ws + WS_VT); bf16_t* Wgu_t = (bf16_t*)(ws + WS_WGU); bf16_t* Wd_t = (bf16_t*)(ws + WS_WD);
    bf16_t* Z = (bf16_t*)(ws + WS_RA); bf16_t* Qm = (bf16_t*)(ws + WS_RA); bf16_t* Sc = (bf16_t*)(ws + WS_RA + 128 * MiB); bf16_t* xg = (bf16_t*)(ws + WS_RA); bf16_t* yb = (bf16_t*)(ws + WS_RA);
    bf16_t* XN = (bf16_t*)(ws + WS_RB); bf16_t* AO = (bf16_t*)(ws + WS_RB); bf16_t* Om = (bf16_t*)(ws + WS_RB); bf16_t* act = (bf16_t*)(ws + WS_RB);
    bf16_t* x1b = (bf16_t*)(ws + WS_RC); bf16_t* x2b = (bf16_t*)(ws + WS_RC);
    float* ssq1 = (float*)(ws + WS_SSQ1); float* ssq2 = (float*)(ws + WS_SSQ2); float* logit = (float*)(ws + WS_LOGIT);
    int* tok_e = (int*)(ws + WS_TOKE); float* tok_w = (float*)(ws + WS_TOKW); int* tok_s = (int*)(ws + WS_TOKS); int* row_tok = (int*)(ws + WS_ROWTOK);
    const int gw = F.vcu * NWAVES + F.wave, NGW = F.G * NWAVES;
    const int lo = args.ph_lo, hi = args.ph_hi;
#define IN(k) (lo <= (k) && (k) < hi)
#if MK_ONE_LAUNCH
    volatile LAS unsigned* misc = (volatile LAS unsigned*)(F.lds + LDS_MISC);
    if (threadIdx.x < 64) misc[threadIdx.x] = 0u;
    __syncthreads();
    XcdBarrier xbar = xcd_barrier_post(ctl + CW_BAR, misc + 8, threadIdx.x == 0);
#define GRID_BAR(k) do { if (IN(k) && IN((k) + 1)) { if ((k) == 0) cg::this_grid().sync(); else xcd_barrier(xbar, F.wave == 0 && lane_id() == 0); } } while (0)
#else
#define GRID_BAR(k) do { } while (0)
#endif

    if (IN(0)) {
        const int lane_ = lane_id(), tid_ = F.wave * 64 + lane_; (void)tid_;
        LAS float* scr = (LAS float*)(F.lds + F.wave * 16384);
        constexpr int I_IN = 16 * 80, I_SQ = 16 * 32, I_KV = 16 * 64, I_G = 16 * 16, I_D = 8 * 32;
        constexpr int NITEMS = I_IN + 3 * I_SQ + I_KV + NEXP * (2 * I_G + I_D);
        for (int it = gw; it < NITEMS; it += NGW) {
            int r = it;
            if (r < I_IN) { const int kb = r / 80, nb = r % 80; transpose_item(args.in[3], ZP, kb * 64, nb * 32, Win_t + (size_t)(nb * 32) * DM, DM, nullptr, scr, lane_); continue; } r -= I_IN;
            if (r < I_SQ) { const int kb = r / 32, nb = r % 32; transpose_item(args.in[13], DM, kb * 64, nb * 32, Wout_t + (size_t)(nb * 32) * DM, DM, nullptr, scr, lane_); continue; } r -= I_SQ;
            if (r < I_SQ) { const int kb = r / 32, nb = r % 32; transpose_item(args.in[16], DM, kb * 64, nb * 32, Wq_t + (size_t)(nb * 32) * DM, DM, args.in[14], scr, lane_); continue; } r -= I_SQ;
            if (r < I_KV) { const int kb = r / 64, nb = r % 64; transpose_item(args.in[17], 2 * DM, kb * 64, nb * 32, Wkv_t + (size_t)(nb * 32) * DM, DM, nullptr, scr, lane_); continue; } r -= I_KV;
            if (r < I_SQ) { const int kb = r / 32, nb = r % 32; transpose_item(args.in[18], DM, kb * 64, nb * 32, Wo_t + (size_t)(nb * 32) * DM, DM, nullptr, scr, lane_); continue; } r -= I_SQ;
            const int e = r / (2 * I_G + I_D); r -= e * (2 * I_G + I_D);
            if (r < 2 * I_G) { const int up = r >= I_G; if (up) r -= I_G; const int kb = r / 16, nb = r % 16, n0 = nb * 32;
                const float* W = (up ? args.in[25] : args.in[24]) + (size_t)e * DM * DEXP;
                transpose_item(W, DEXP, kb * 64, n0, Wgu_t + ((size_t)e * 1024 + (n0 >> 7) * 256 + up * 128 + (n0 & 127)) * DM, DM, args.in[19], scr, lane_); continue; }
            r -= 2 * I_G;
            { const int kb = r / 32, nb = r % 32; transpose_item(args.in[26] + (size_t)e * DEXP * DM, DM, kb * 64, nb * 32, Wd_t + ((size_t)e * 1024 + nb * 32) * DEXP, DEXP, nullptr, scr, lane_); }
        }
        for (int i = blockIdx.x * NTHR + tid_; i < 256 * DM; i += F.G * NTHR) { const int n = i >> 10, k = i & 1023; float v = 0.f;
            if (n < 4) v = args.in[20][k * 4 + n] * args.in[19][k]; else if (n < 36) v = args.in[22][k * 32 + (n - 4)] * args.in[19][k];
            Wr_t[i] = (bf16_t)(cvt_pk_bf16(v, 0.f) & 0xffffu); }
        for (int i = blockIdx.x * NTHR + tid_; i < 4 * 128 * 128; i += F.G * NTHR) { const int t = (i >> 7) & 127, s = i & 127; const float v = s <= t ? args.in[6][i] : 0.f; Wsgu[i] = (bf16_t)(cvt_pk_bf16(v, 0.f) & 0xffffu); }
        for (int m = gw; m < M; m += NGW) rms_row_to_bf16(x + (size_t)m * DM, args.in[2], XN + (size_t)m * DM, lane_);
        for (int m = gw; m < MROWS; m += NGW) rms_row_to_bf16(args.in[1] + (size_t)m * DM, args.in[15], memn + (size_t)m * DM, lane_);
        __syncthreads();
    }
    GRID_BAR(0);

    if (IN(1)) {
        { pg8::Gemm g{DM, DM, DM}; pg8::PlainSched S; S.to.init(M / 256, ZP / 256, F.G, (int)blockIdx.x); S.A = (const char*)XN; S.B = (const char*)Win_t; S.tA = (size_t)256 * DM * 2; S.tB = (size_t)256 * DM * 2;
          pg8::EpiZ E{Z}; pg8::gemm_phase(F.lds, F.wave, g, S, E); }
        { pg8::Gemm g{DM, DM, DM}; pg8::PlainSched S; S.to.init(MROWS / 256, 4, F.G, (int)blockIdx.x); S.A = (const char*)memn; S.B = (const char*)Wkv_t; S.tA = (size_t)256 * DM * 2; S.tB = (size_t)256 * DM * 2;
          pg8::EpiBf16 E{Km, DM, nullptr, 1.f}; pg8::gemm_phase(F.lds, F.wave, g, S, E); }
        { pg8::Gemm g{DM, DM, DM}; pg8::PlainSched S; S.to.init(4, MROWS / 256, F.G, (int)((blockIdx.x + 128) % F.G)); S.A = (const char*)(Wkv_t + (size_t)DM * DM); S.B = (const char*)memn; S.tA = (size_t)256 * DM * 2; S.tB = (size_t)256 * DM * 2;
          pg8::EpiBf16 E{Vt, MROWS, nullptr, 1.f}; pg8::gemm_phase(F.lds, F.wave, g, S, E); }
    }
    GRID_BAR(1);

    if (IN(2)) {
        const int lane_ = lane_id(), tid_ = F.wave * 64 + lane_; (void)tid_;
        float lam;
        { const float a = args.in[8][lane_] * args.in[9][lane_], b = args.in[10][lane_] * args.in[11][lane_];
          lam = __expf(wave_sum(a)) - __expf(wave_sum(b)) + 0.2f; }
        const int nitems = 32 * 16, npass = 4;
        const int per = (nitems + F.G - 1) / F.G; const int it0 = F.vcu * per; int it1 = it0 + per; if (it1 > nitems) it1 = nitems;
        if (it0 < it1) {
            int item = it0, pass = 0; da::BlockRef cur = da::mkref(Z, AO, item, pass); da::Seam S;
            da::prime(cur, (char*)lds_raw, S, F.wave);
            for (;;) {
                int ni = item, np = pass + 1; if (np == npass) { np = 0; ni = item + 1; }
                const bool last = ni >= it1;
                const da::BlockRef nxt = last ? cur : da::mkref(Z, AO, ni, np);
                da::block(cur, nxt, (char*)lds_raw, S, lam, args.in[12], F.wave);
                if (last) break;
                cur = nxt; item = ni; pass = np;
            }
        }
        __syncthreads();
        {
            LAS bf16_t* vnT = (LAS bf16_t*)F.lds;
            const int lane = lane_, w = F.wave;
            for (int uidx = F.vcu; uidx < (M / 128) * 4; uidx += F.G) {
                const int c = uidx >> 2, g = uidx & 3; const size_t R0 = (size_t)c * 128;
#pragma unroll
                for (int ps = 0; ps < 4; ++ps) { const int s = 16 * w + 4 * ps + (lane >> 4), ch0 = (lane & 15) * 8;
                    const u32x4 raw = *(const u32x4*)(Z + (R0 + s) * ZP + ZV + g * 128 + ch0);
                    float v[8] = {bf_lo(raw.x), bf_hi(raw.x), bf_lo(raw.y), bf_hi(raw.y), bf_lo(raw.z), bf_hi(raw.z), bf_lo(raw.w), bf_hi(raw.w)};
                    float sm = 0.f;
#pragma unroll
                    for (int j = 0; j < 8; ++j) sm += v[j];
#pragma unroll
                    for (int o = 1; o < 16; o <<= 1) sm += __shfl_xor(sm, o);
                    const float mu = sm * (1.f / 128.f); float q = 0.f;
#pragma unroll
                    for (int j = 0; j < 8; ++j) { v[j] -= mu; q += v[j] * v[j]; }
#pragma unroll
                    for (int o = 1; o < 16; o <<= 1) q += __shfl_xor(q, o);
                    const float rstd = __builtin_amdgcn_rsqf(q * (1.f / 128.f) + LN_EPS);
#pragma unroll
                    for (int j = 0; j < 8; ++j) { const float y = v[j] * rstd * args.in[4][g * 128 + ch0 + j] + args.in[5][g * 128 + ch0 + j];
                        vnT[(ch0 + j) * 136 + s] = (bf16_t)(cvt_pk_bf16(y, 0.f) & 0xffffu); } }
                __syncthreads();
                f32x4 acc[8];
#pragma unroll
                for (int mi = 0; mi < 8; ++mi) acc[mi] = (f32x4){0.f, 0.f, 0.f, 0.f};
                const int t = 16 * w + (lane & 15);
                const int nks = (w + 2) >> 1;
                for (int ks = 0; ks < nks; ++ks) {
                    const bf16x8 bfr = *(const bf16x8*)(Wsgu + ((size_t)g * 128 + t) * 128 + ks * 32 + 8 * (lane >> 4));
#pragma unroll
                    for (int mi = 0; mi < 8; ++mi) { const bf16x8 afr = *(const LAS bf16x8*)(vnT + (16 * mi + (lane & 15)) * 136 + ks * 32 + 8 * (lane >> 4));
                        acc[mi] = __builtin_amdgcn_mfma_f32_16x16x32_bf16(afr, bfr, acc[mi], 0, 0, 0); }
                }
                const float bias = args.in[7][g * 128 + t];
#pragma unroll
                for (int mi = 0; mi < 8; ++mi) { const int ch = 16 * mi + 4 * (lane >> 4);
                    const u32x2 ur = *(const u32x2*)(Z + (R0 + t) * ZP + ZU + g * 128 + ch);
                    const float o0 = bf_lo(ur.x) * (acc[mi][0] + bias), o1 = bf_hi(ur.x) * (acc[mi][1] + bias), o2 = bf_lo(ur.y) * (acc[mi][2] + bias), o3 = bf_hi(ur.y) * (acc[mi][3] + bias);
                    u32x2 wv; wv.x = cvt_pk_bf16(o0, o1); wv.y = cvt_pk_bf16(o2, o3);
                    *(u32x2*)(AO + (R0 + t) * DM + g * 128 + ch) = wv; }
                __syncthreads();
            }
        }
    }
    GRID_BAR(2);

    if (IN(3)) {
        pg8::Gemm g{DM, DM, DM}; pg8::PlainSched S; S.to.init(M / 256, 4, F.G, (int)blockIdx.x); S.A = (const char*)AO; S.B = (const char*)Wout_t; S.tA = (size_t)256 * DM * 2; S.tB = (size_t)256 * DM * 2;
        pg8::EpiResid E{x, out, x1b, ssq1}; pg8::gemm_phase(F.lds, F.wave, g, S, E);
    }
    GRID_BAR(3);

    if (IN(4)) {
        pg8::Gemm g{DM, DM, DM}; pg8::PlainSched S; S.to.init(M / 256, 4, F.G, (int)blockIdx.x); S.A = (const char*)x1b; S.B = (const char*)Wq_t; S.tA = (size_t)256 * DM * 2; S.tB = (size_t)256 * DM * 2;
        pg8::EpiBf16 E{Qm, DM, ssq1, C2_MEM}; pg8::gemm_phase(F.lds, F.wave, g, S, E);
    }
    GRID_BAR(4);

    if (IN(5)) {
        pg8::Gemm g{DM, DM, 256}; pg8::MemAttnSched S; S.to.init(M / 256, 4, F.G, (int)blockIdx.x); S.A = (const char*)Qm; S.B = (const char*)Km; S.bB = (size_t)256 * DM * 2; S.hB = 512;
        pg8::EpiBf16 E{Sc, DM, nullptr, 1.f}; pg8::gemm_phase(F.lds, F.wave, g, S, E);
    }
    GRID_BAR(5);

    if (IN(6)) {
        const int lane_ = lane_id(), tid_ = F.wave * 64 + lane_; (void)tid_;
        for (int rh = gw; rh < M * 4; rh += NGW) { u32x2* p = (u32x2*)(Sc + (size_t)rh * 256) + lane_; const u32x2 raw = *p;
            float v0 = bf_lo(raw.x), v1 = bf_hi(raw.x), v2 = bf_lo(raw.y), v3 = bf_hi(raw.y);
            const float mx = wave_max(fmaxf(fmaxf(v0, v1), fmaxf(v2, v3)));
            v0 = __builtin_amdgcn_exp2f(v0 - mx); v1 = __builtin_amdgcn_exp2f(v1 - mx); v2 = __builtin_amdgcn_exp2f(v2 - mx); v3 = __builtin_amdgcn_exp2f(v3 - mx);
            const float inv = __builtin_amdgcn_rcpf(wave_sum((v0 + v1) + (v2 + v3)));
            u32x2 w; w.x = cvt_pk_bf16(v0 * inv, v1 * inv); w.y = cvt_pk_bf16(v2 * inv, v3 * inv); *p = w; }
    }
    GRID_BAR(6);

    if (IN(7)) {
        pg8::Gemm g{DM, MROWS, 256}; pg8::MemAttnSched S; S.to.init(M / 256, 4, F.G, (int)blockIdx.x); S.A = (const char*)Sc; S.B = (const char*)Vt; S.bB = 512; S.hB = (size_t)256 * MROWS * 2;
        pg8::EpiBf16 E{Om, DM, nullptr, 1.f}; pg8::gemm_phase(F.lds, F.wave, g, S, E);
    }
    GRID_BAR(7);

    if (IN(8)) {
        pg8::Gemm g{DM, DM, DM}; pg8::PlainSched S; S.to.init(M / 256, 4, F.G, (int)blockIdx.x); S.A = (const char*)Om; S.B = (const char*)Wo_t; S.tA = (size_t)256 * DM * 2; S.tB = (size_t)256 * DM * 2;
        pg8::EpiResid E{out, out, x2b, ssq2}; pg8::gemm_phase(F.lds, F.wave, g, S, E);
    }
    GRID_BAR(8);

    if (IN(9)) {
        pg8::Gemm g{DM, DM, DM}; pg8::PlainSched S; S.to.init(M / 256, 1, F.G, (int)blockIdx.x); S.A = (const char*)x2b; S.B = (const char*)Wr_t; S.tA = (size_t)256 * DM * 2; S.tB = 0;
        pg8::EpiRouter E{logit, ssq2, args.in[21], args.in[23]}; pg8::gemm_phase(F.lds, F.wave, g, S, E);
    }
    GRID_BAR(9);

    if (IN(10)) {
        const int lane_ = lane_id(), tid_ = F.wave * 64 + lane_; (void)tid_;
        LAS unsigned* lcnt = (LAS unsigned*)F.lds; LAS unsigned* lbase = lcnt + 32;
        for (int t0 = blockIdx.x * NTHR; t0 < M; t0 += F.G * NTHR) {
            if (tid_ < 32) lcnt[tid_] = 0u;
            __syncthreads();
            const int tok = t0 + tid_;
            const f32x4 lg = *(const f32x4*)(logit + (size_t)tok * 64);
            int gi = 0; float gm = lg[0];
#pragma unroll
            for (int j = 1; j < 4; ++j) if (lg[j] > gm) { gm = lg[j]; gi = j; }
            float gs = 0.f;
#pragma unroll
            for (int j = 0; j < 4; ++j) gs += __expf(lg[j] - gm);
            const float gate = 1.0f / gs;
            const f32x4 ea = *(const f32x4*)(logit + (size_t)tok * 64 + 4 + gi * 8), eb = *(const f32x4*)(logit + (size_t)tok * 64 + 8 + gi * 8);
            const float el[8] = {ea[0], ea[1], ea[2], ea[3], eb[0], eb[1], eb[2], eb[3]};
            int i0 = 0; float m0 = el[0];
#pragma unroll
            for (int j = 1; j < 8; ++j) if (el[j] > m0) { m0 = el[j]; i0 = j; }
            int i1 = -1; float m1 = -__builtin_inff();
#pragma unroll
            for (int j = 0; j < 8; ++j) if (j != i0 && el[j] > m1) { m1 = el[j]; i1 = j; }
            if (i1 < 0) i1 = (i0 == 0) ? 1 : 0;
            const float r = __expf(m1 - m0);
            const float w0 = gate / (1.0f + r), w1 = gate * r / (1.0f + r);
            const int e0 = gi * 8 + i0, e1 = gi * 8 + i1;
            const unsigned r0 = atomicAdd((unsigned*)&lcnt[e0], 1u), r1 = atomicAdd((unsigned*)&lcnt[e1], 1u);
            __syncthreads();
            if (tid_ < 32) lbase[tid_] = atomicAdd(ctl + CW_CNT + tid_, lcnt[tid_]);
            __syncthreads();
            tok_e[tok * 2] = e0; tok_e[tok * 2 + 1] = e1; tok_w[tok * 2] = w0; tok_w[tok * 2 + 1] = w1;
            tok_s[tok * 2] = (int)(lbase[e0] + r0); tok_s[tok * 2 + 1] = (int)(lbase[e1] + r1);
            __syncthreads();
        }
    }
    GRID_BAR(10);

    if (IN(11)) {
        const int lane_ = lane_id(), tid_ = F.wave * 64 + lane_; (void)tid_;
        LAS unsigned* lps = (LAS unsigned*)F.lds;
        if (tid_ == 0) { unsigned acc = 0; for (int e = 0; e < 32; ++e) { lps[e] = acc; const unsigned c = ld_u32_agent(ctl + CW_CNT + e); acc += (c + 255u) & ~255u; } lps[32] = acc; }
        __syncthreads();
        if (blockIdx.x == 0) {
            if (tid_ < 32) { const unsigned s = lps[tid_], e2 = lps[tid_ + 1], c = ld_u32_agent(ctl + CW_CNT + tid_);
                for (unsigned b = s >> 8; b < (e2 >> 8); ++b) ctl[CW_BLKE + b] = (unsigned)tid_;
                for (unsigned r = s + c; r < e2; ++r) row_tok[r] = 0; }
            if (tid_ == 0) ctl[CW_NBLK] = lps[32] >> 8;
        }
        for (int a = gw; a < M * 2; a += NGW) { const int tok = a >> 1; const int e = tok_e[a]; const int pos = (int)lps[e] + tok_s[a];
            const u32x4* src = (const u32x4*)(x2b + (size_t)tok * DM) + lane_; u32x4* dst = (u32x4*)(xg + (size_t)pos * DM) + lane_;
            const u32x4 v0 = src[0], v1 = src[64]; dst[0] = v0; dst[64] = v1;
            if (lane_ == 0) { row_tok[pos] = tok; tok_s[a] = pos; } }
        __syncthreads();
    }
    GRID_BAR(11);

    if (IN(12)) {
        const int nblk = (int)__builtin_amdgcn_readfirstlane(ld_u32_agent(ctl + CW_NBLK));
        pg8::Gemm g{DM, DM, DM}; pg8::MoeSched S{F.G, F.vcu, nblk, ctl + CW_BLKE, (const char*)xg, (const char*)Wgu_t, (size_t)256 * DM * 2, (size_t)1024 * DM * 2, (size_t)256 * DM * 2};
        pg8::EpiGateUp E{act, ssq2, row_tok}; pg8::gemm_phase(F.lds, F.wave, g, S, E);
    }
    GRID_BAR(12);

    if (IN(13)) {
        const int nblk = (int)__builtin_amdgcn_readfirstlane(ld_u32_agent(ctl + CW_NBLK));
        pg8::Gemm g{DEXP, DEXP, DEXP}; pg8::MoeSched S{F.G, F.vcu, nblk, ctl + CW_BLKE, (const char*)act, (const char*)Wd_t, (size_t)256 * DEXP * 2, (size_t)1024 * DEXP * 2, (size_t)256 * DEXP * 2};
        pg8::EpiBf16 E{yb, DM, nullptr, 1.f}; pg8::gemm_phase(F.lds, F.wave, g, S, E);
    }
    GRID_BAR(13);

    if (IN(14)) {
        const int lane_ = lane_id(), tid_ = F.wave * 64 + lane_; (void)tid_;
        for (int m = gw; m < M; m += NGW) {
            const int p0 = tok_s[m * 2], p1 = tok_s[m * 2 + 1]; const float w0 = tok_w[m * 2], w1 = tok_w[m * 2 + 1];
            f32x4* xr = (f32x4*)(out + (size_t)m * DM) + lane_; const u32x2* y0 = (const u32x2*)(yb + (size_t)p0 * DM) + lane_; const u32x2* y1 = (const u32x2*)(yb + (size_t)p1 * DM) + lane_;
            const f32x4* gr = (const f32x4*)args.in[27] + lane_;
            f32x4 v[4]; float s = 0.f;
#pragma unroll
            for (int j = 0; j < 4; ++j) { v[j] = xr[64 * j]; const u32x2 a = y0[64 * j], b = y1[64 * j];
                v[j].x += w0 * bf_lo(a.x) + w1 * bf_lo(b.x); v[j].y += w0 * bf_hi(a.x) + w1 * bf_hi(b.x); v[j].z += w0 * bf_lo(a.y) + w1 * bf_lo(b.y); v[j].w += w0 * bf_hi(a.y) + w1 * bf_hi(b.y);
                s += (v[j].x * v[j].x + v[j].y * v[j].y) + (v[j].z * v[j].z + v[j].w * v[j].w); }
            const float rstd = __builtin_amdgcn_rsqf(wave_sum(s) * (1.f / DM) + RMS_EPS);
#pragma unroll
            for (int j = 0; j < 4; ++j) { const f32x4 gg = gr[64 * j]; xr[64 * j] = (f32x4){v[j].x * rstd * gg.x, v[j].y * rstd * gg.y, v[j].z * rstd * gg.z, v[j].w * rstd * gg.w}; }
        }
    }
#undef IN
#undef GRID_BAR
}

extern "C" void kernel_launch(void* const* d_in, const int* in_sizes, int n_in, void* d_out, int out_size, void* d_ws, size_t ws_size, hipStream_t stream) {
    static int grid = 0;
    if (grid == 0) {
        if (n_in != 28 || in_sizes[0] != M * DM || out_size != M * DM || ws_size < WS_END) { fprintf(stderr, "kernel_launch: unexpected shapes (n_in %d in0 %d out %d ws %zu)\n", n_in, n_in > 0 ? in_sizes[0] : -1, out_size, ws_size); grid = -1; return; }
        int dev = 0, cus = 0, per_cu = 0;
        if (hipGetDevice(&dev) != hipSuccess || hipDeviceGetAttribute(&cus, hipDeviceAttributeMultiprocessorCount, dev) != hipSuccess) { grid = -1; return; }
        if (hipFuncSetAttribute((const void*)mega, hipFuncAttributeMaxDynamicSharedMemorySize, LDS_BYTES) != hipSuccess) { fprintf(stderr, "kernel_launch: hipFuncSetAttribute failed\n"); grid = -1; return; }
        if (hipOccupancyMaxActiveBlocksPerMultiprocessor(&per_cu, (const void*)mega, NTHR, LDS_BYTES) != hipSuccess || per_cu < 1) { fprintf(stderr, "kernel_launch: occupancy query says %d\n", per_cu); per_cu = 1; }
        (void)hipGetLastError();
        grid = cus;
    }
    if (grid < 0) return;
    (void)hipMemsetAsync((char*)d_ws + WS_CTL, 0, CTL_BYTES, stream);
    Args a{};
    for (int i = 0; i < 28; ++i) a.in[i] = (const float*)d_in[i];
    a.out = (float*)d_out; a.ws = (unsigned char*)d_ws;
#if MK_ONE_LAUNCH
    a.ph_lo = 0; a.ph_hi = N_PHASES;
    void* kargs[] = {&a};
    hipError_t e = hipLaunchCooperativeKernel((const void*)mega, dim3(grid), dim3(NTHR), kargs, LDS_BYTES, stream);
    if (e != hipSuccess) fprintf(stderr, "cooperative launch failed: %s (grid %d)\n", hipGetErrorString(e), grid);
#else
    for (int p = 0; p < N_PHASES; ++p) { a.ph_lo = p; a.ph_hi = p + 1; hipLaunchKernelGGL(mega, dim3(grid), dim3(NTHR), LDS_BYTES, stream, a); }
#endif
}
```

```cpp
#include <hip/hip_runtime.h>
#include <hip/hip_cooperative_groups.h>
#include <cstdio>
#include <cstdint>
namespace cg = cooperative_groups;

#ifndef PROBE_DUP_ATTN
#define PROBE_DUP_ATTN 1
#endif
#ifndef MK_ONE_LAUNCH
#define MK_ONE_LAUNCH 1
#endif

#define LAS __attribute__((address_space(3)))
#define GAS __attribute__((address_space(1)))
typedef unsigned short bf16_t;
typedef short bf16x8 __attribute__((ext_vector_type(8)));
typedef short s16x4 __attribute__((ext_vector_type(4)));
typedef float f32x2 __attribute__((ext_vector_type(2)));
typedef float f32x4 __attribute__((ext_vector_type(4)));
typedef float f32x16 __attribute__((ext_vector_type(16)));
typedef unsigned u32x2 __attribute__((ext_vector_type(2)));
typedef unsigned u32x4 __attribute__((ext_vector_type(4)));

constexpr int NB = 8, SEQ = 8192, DM = 1024, M = NB * SEQ;
constexpr int ZP = 2560;
constexpr int ZU = 0, ZV = 512, ZQ = 1024, ZK = 1536, ZVAL = 2048;
constexpr int MEML = 256, MROWS = NB * MEML;
constexpr int NEXP = 32, DEXP = 512;
constexpr int PROWS = 2 * M + NEXP * 256;
constexpr int MAXBLK = PROWS / 256;
constexpr float RMS_EPS = 1e-6f, LN_EPS = 1e-5f;
constexpr float LOG2E = 1.4426950408889634f;
constexpr float C2_DIFF = 0.125f * LOG2E;
constexpr float C2_MEM = 0.0625f * LOG2E;

constexpr size_t MiB = 1u << 20;
constexpr size_t WS_CTL = 0, CTL_BYTES = 1 * MiB;
constexpr size_t WS_WIN = 1 * MiB;
constexpr size_t WS_WOUT = 6 * MiB;
constexpr size_t WS_WQ = 8 * MiB;
constexpr size_t WS_WKV = 10 * MiB;
constexpr size_t WS_WO = 14 * MiB;
constexpr size_t WS_WR = 16 * MiB;
constexpr size_t WS_WSGU = 17 * MiB;
constexpr size_t WS_MEMN = 18 * MiB;
constexpr size_t WS_KM = 22 * MiB;
constexpr size_t WS_VT = 26 * MiB;
constexpr size_t WS_WGU = 30 * MiB;
constexpr size_t WS_WD = 94 * MiB;
constexpr size_t WS_RA = 128 * MiB;
constexpr size_t WS_RB = 448 * MiB;
constexpr size_t WS_RC = 592 * MiB;
constexpr size_t WS_SSQ1 = 720 * MiB;
constexpr size_t WS_SSQ2 = 724 * MiB;
constexpr size_t WS_LOGIT = 728 * MiB;
constexpr size_t WS_TOKE = 744 * MiB;
constexpr size_t WS_TOKW = 745 * MiB;
constexpr size_t WS_TOKS = 746 * MiB;
constexpr size_t WS_ROWTOK = 747 * MiB;
constexpr size_t WS_END = 752 * MiB;
constexpr int CW_CNT = 64;
constexpr int CW_NBLK = 128;
constexpr int CW_PSTART = 192;
constexpr int CW_BLKE = 256;
constexpr int CW_BAR = 4096;
constexpr int LDS_MISC = 131072;

__device__ __forceinline__ unsigned cvt_pk_bf16(float lo, float hi) { unsigned r; asm volatile("v_cvt_pk_bf16_f32 %0, %1, %2" : "=v"(r) : "v"(lo), "v"(hi)); return r; }
__device__ __forceinline__ float bf_lo(unsigned w) { return __uint_as_float(w << 16); }
__device__ __forceinline__ float bf_hi(unsigned w) { return __uint_as_float(w & 0xffff0000u); }
__device__ __forceinline__ float wave_sum(float v) {
#pragma unroll
    for (int o = 1; o < 64; o <<= 1) v += __shfl_xor(v, o);
    return v;
}
__device__ __forceinline__ float wave_max(float v) {
#pragma unroll
    for (int o = 1; o < 64; o <<= 1) v = fmaxf(v, __shfl_xor(v, o));
    return v;
}
__device__ __forceinline__ int lane_id() { int l; asm volatile("v_mbcnt_lo_u32_b32 %0, -1, 0\n\tv_mbcnt_hi_u32_b32 %0, -1, %0" : "=v"(l)); return l; }
__device__ __forceinline__ unsigned ld_u32_agent(const unsigned* p) { return __hip_atomic_load(p, __ATOMIC_RELAXED, __HIP_MEMORY_SCOPE_AGENT); }

namespace pg8 {
constexpr int BM = 256, BK = 64, HALF = 128, HTB = HALF * BK * 2, STAGE_BYTES = 8 * HTB, NXCD = 8, WGM = 8;
__host__ __device__ __forceinline__ int lds_byte(int r, int c) { const int st = (r >> 4) * 2 + (c >> 5), rr = r & 15, cc = c & 31, ob = rr * 64 + cc * 2; return st * 1024 + (ob ^ (((ob >> 9) & 1) << 5)); }
__host__ __device__ __forceinline__ void stage_rc(int b, int& R, int& C) { const int st = b / 1024, sb = b % 1024, swz = sb ^ (((sb >> 9) & 1) << 5); R = (st >> 1) * 16 + swz / 64; C = (st & 1) * 32 + (swz % 64) / 2; }
__host__ __device__ __forceinline__ int perm32(int rho) { const int n = rho >> 4, i = rho & 15; return 8 * (i >> 2) + 4 * n + (i & 3); }

struct Unit { const char* A; const char* B; int pm, pn, aux; const int* rows; };
struct Gemm { int lda, ldb, K; };

struct TileOrder {
    int nM, nN, nwg, G, c;
    __device__ void init(int nM_, int nN_, int G_, int c_) { nM = nM_; nN = nN_; nwg = nM * nN; G = G_; c = c_; }
    __device__ bool get(int i, int& pm, int& pn) const {
        const long L = (long)i * G + c; if (L >= nwg) return false;
        int wgid = (int)L; { const int q = nwg / NXCD, r = nwg % NXCD, xcd = wgid % NXCD, off = wgid / NXCD; wgid = (xcd < r ? xcd * (q + 1) : r * (q + 1) + (xcd - r) * q) + off; }
        const int nig = WGM * nN, gid = wgid / nig, fm = gid * WGM, gsz = (nM - fm) < WGM ? (nM - fm) : WGM;
        pm = fm + ((wgid % nig) % gsz); pn = (wgid % nig) / gsz; return true;
    }
};

typedef float f32x2g __attribute__((ext_vector_type(2)));
__device__ __forceinline__ f32x2g gelu_pk(f32x2g v) {
    const f32x2g av = __builtin_elementwise_abs(v), d = av * 0.2316418882f + 1.0f;
    f32x2g t; t.x = __builtin_amdgcn_rcpf(d.x); t.y = __builtin_amdgcn_rcpf(d.y);
    f32x2g q = t * 0.5307027145f + (-0.7265760135f); q = q * t + 0.7107068705f; q = q * t + (-0.142248368f); q = q * t + 0.127414796f; q = q * t;
    const f32x2g s = (v * v) * (-0.72134752044f);
    f32x2g e; e.x = __builtin_amdgcn_exp2f(s.x); e.y = __builtin_amdgcn_exp2f(s.y);
    const f32x2g m = v * (q * e), r = v - m;
    f32x2g o; o.x = v.x < 0.f ? m.x : r.x; o.y = v.y < 0.f ? m.y : r.y; return o;
}

template <class Epi, class Sched, bool GATHER = false>
__device__ __forceinline__ void gemm_phase(LAS unsigned char* lds, int wid, const Gemm g, const Sched& S, const Epi& E) {
    const int lane = lane_id(), tid = wid * 64 + lane, wr = wid >> 2, wc = wid & 3, fr = lane & 15, fq = lane >> 4;
    const int nt = g.K / BK;
    unsigned voffB[2]; unsigned vA0[2], vA1[2]; int RA[2], CA[2];
#pragma unroll
    for (int i = 0; i < 2; ++i) { int R, C; stage_rc(tid * 16 + i * 8192, R, C); const int Rb = Epi::PERM ? ((R & ~31) + perm32(R & 31)) : R;
        RA[i] = R; CA[i] = C; voffB[i] = (unsigned)(Rb * g.ldb + C) * 2u;
        vA0[i] = (unsigned)(R * g.lda + C) * 2u; vA1[i] = vA0[i]; }
    const size_t kstep = (size_t)(BK * 2);
    const size_t hstepA = GATHER ? (size_t)0 : (size_t)HALF * g.lda * 2, hstepB = (size_t)HALF * g.ldb * 2;
    LAS u32x4* park = (LAS u32x4*)(lds + 131072 + 1024) + tid;
#define PG8_GOFF(U, d0, d1) do { _Pragma("unroll") for (int _i = 0; _i < 2; ++_i) { \
        d0[_i] = ((unsigned)(U).rows[RA[_i]] * (unsigned)g.lda + (unsigned)CA[_i]) * 2u; d1[_i] = ((unsigned)(U).rows[HALF + RA[_i]] * (unsigned)g.lda + (unsigned)CA[_i]) * 2u; } } while (0)
    const unsigned ldsw = (unsigned)wid * 1024u;
    const int aoff = lds_byte(wr * 64 + fr, fq * 8), boff = lds_byte(wc * 32 + fr, fq * 8);
#define PG8_SA(b, h) (((b) * 2 + (h)) * HTB)
#define PG8_SB(b, h) ((4 + (b) * 2 + (h)) * HTB)
#define PG8_STAGE(bufoff, gbase, voff) do { _Pragma("unroll") for (int _i = 0; _i < 2; ++_i) \
        __builtin_amdgcn_global_load_lds((const unsigned*)((const char*)(gbase) + (voff)[_i]), (LAS unsigned*)(lds + (bufoff) + ldsw + _i * 8192), 16, 0, 0); } while (0)
#define PG8_LDA(dst, b, h) do { _Pragma("unroll") for (int m = 0; m < 4; ++m) _Pragma("unroll") for (int k = 0; k < 2; ++k) dst[m][k] = *(const LAS bf16x8*)(lds + PG8_SA(b, h) + aoff + m * 2048 + k * 1024); } while (0)
#define PG8_LDB(dst, b, h) do { _Pragma("unroll") for (int n = 0; n < 2; ++n) _Pragma("unroll") for (int k = 0; k < 2; ++k) dst[n][k] = *(const LAS bf16x8*)(lds + PG8_SB(b, h) + boff + n * 2048 + k * 1024); } while (0)
#define PG8_MMA(ai, bj, At, Bt) do { __builtin_amdgcn_s_setprio(1); _Pragma("unroll") for (int m = 0; m < 4; ++m) _Pragma("unroll") for (int n = 0; n < 2; ++n) _Pragma("unroll") for (int k = 0; k < 2; ++k) \
        acc[ai][bj][m][n] = __builtin_amdgcn_mfma_f32_16x16x32_bf16(Bt[n][k], At[m][k], acc[ai][bj][m][n], 0, 0, 0); __builtin_amdgcn_s_setprio(0); } while (0)
#define PG8_WAIT_V(n) asm volatile("s_waitcnt vmcnt(" #n ")" ::: "memory")
#define PG8_WAIT_L(n) asm volatile("s_waitcnt lgkmcnt(" #n ")" ::: "memory")
#define PG8_BAR __builtin_amdgcn_s_barrier()
#define PG8_SCHED __builtin_amdgcn_sched_barrier(0)
    Unit cur, nxt; int ui = 0;
    if (!S.next(0, cur)) return;
    f32x4 acc[2][2][4][2];
#pragma unroll
    for (int a = 0; a < 2; ++a)
#pragma unroll
        for (int b = 0; b < 2; ++b)
#pragma unroll
            for (int m = 0; m < 4; ++m)
#pragma unroll
                for (int n = 0; n < 2; ++n) acc[a][b][m][n] = (f32x4){0.f, 0.f, 0.f, 0.f};
    bf16x8 At[4][2], B0[2][2], B1[2][2];
    const char* cA = cur.A; const char* cB = cur.B;
    if constexpr (GATHER) { PG8_GOFF(cur, vA0, vA1); }
    PG8_STAGE(PG8_SB(0, 0), cB, voffB); PG8_STAGE(PG8_SB(0, 1), cB + hstepB, voffB); PG8_STAGE(PG8_SA(0, 0), cA, vA0); PG8_STAGE(PG8_SA(0, 1), cA + hstepA, vA1);
    if (wr == 1) PG8_BAR;
    PG8_WAIT_V(2); PG8_BAR;
    PG8_STAGE(PG8_SB(1, 0), cB + kstep, voffB); PG8_STAGE(PG8_SA(1, 0), cA + kstep, vA0); PG8_STAGE(PG8_SB(1, 1), cB + hstepB + kstep, voffB);
    PG8_WAIT_V(6); PG8_BAR;
    for (;;) {
        const bool has_next = S.next(ui + 1, nxt);
        const char* nA = has_next ? nxt.A : cA; const char* nB = has_next ? nxt.B : cB;
        if constexpr (GATHER) { unsigned n0[2] = {vA0[0], vA0[1]}, n1[2] = {vA1[0], vA1[1]}; if (has_next) { PG8_GOFF(nxt, n0, n1); } *park = (u32x4){n0[0], n0[1], n1[0], n1[1]}; }
        for (int t = 0; t < nt; t += 2) {
            const bool last = (t == nt - 2);
            const char* a1 = cA + (size_t)(t + 1) * kstep;
            const char* a2 = last ? nA : cA + (size_t)(t + 2) * kstep; const char* b2 = last ? nB : cB + (size_t)(t + 2) * kstep;
            const char* a3 = a2 + kstep; const char* b3 = b2 + kstep;
            unsigned w0[2] = {vA0[0], vA0[1]}, w1[2] = {vA1[0], vA1[1]};
            if constexpr (GATHER) { if (last) { const u32x4 pk = *park; w0[0] = pk.x; w0[1] = pk.y; w1[0] = pk.z; w1[1] = pk.w; } }
            PG8_LDB(B0, 0, 0); PG8_LDB(B1, 0, 1); PG8_SCHED; PG8_LDA(At, 0, 0); PG8_STAGE(PG8_SA(1, 1), a1 + hstepA, vA1);
            PG8_WAIT_V(8); PG8_WAIT_L(0); PG8_BAR; PG8_MMA(0, 0, At, B0); PG8_MMA(0, 1, At, B1); PG8_BAR; PG8_SCHED;
            PG8_LDA(At, 0, 1); PG8_STAGE(PG8_SB(0, 0), b2, voffB); PG8_STAGE(PG8_SB(0, 1), b2 + hstepB, voffB); PG8_STAGE(PG8_SA(0, 0), a2, w0);
            PG8_WAIT_V(8); PG8_WAIT_L(0); PG8_BAR; PG8_MMA(1, 0, At, B0); PG8_MMA(1, 1, At, B1); PG8_BAR; PG8_SCHED;
            PG8_LDB(B0, 1, 0); PG8_LDB(B1, 1, 1); PG8_SCHED; PG8_LDA(At, 1, 0); PG8_STAGE(PG8_SA(0, 1), a2 + hstepA, w1);
            PG8_WAIT_V(8); PG8_WAIT_L(0); PG8_BAR; PG8_MMA(0, 0, At, B0); PG8_MMA(0, 1, At, B1); PG8_BAR; PG8_SCHED;
            PG8_LDA(At, 1, 1); PG8_STAGE(PG8_SB(1, 0), b3, voffB); PG8_STAGE(PG8_SB(1, 1), b3 + hstepB, voffB); PG8_STAGE(PG8_SA(1, 0), a3, w0);
            PG8_WAIT_V(8); PG8_WAIT_L(0); PG8_BAR; PG8_MMA(1, 0, At, B0); PG8_MMA(1, 1, At, B1); PG8_BAR; PG8_SCHED;
        }
        if (wr == 0) PG8_BAR;
        E(acc, cur, wr, wc, fr, fq);
        if (!has_next) break;
#pragma unroll
        for (int a = 0; a < 2; ++a)
#pragma unroll
            for (int b = 0; b < 2; ++b)
#pragma unroll
                for (int m = 0; m < 4; ++m)
#pragma unroll
                    for (int n = 0; n < 2; ++n) acc[a][b][m][n] = (f32x4){0.f, 0.f, 0.f, 0.f};
        cur = nxt; cA = nA; cB = nB; ++ui;
        if constexpr (GATHER) { const u32x4 pk = *park; vA0[0] = pk.x; vA0[1] = pk.y; vA1[0] = pk.z; vA1[1] = pk.w; }
        if (wr == 1) PG8_BAR;
    }
    PG8_WAIT_V(0);
    PG8_BAR;
#undef PG8_GOFF
#undef PG8_SA
#undef PG8_SB
#undef PG8_STAGE
#undef PG8_LDA
#undef PG8_LDB
#undef PG8_MMA
#undef PG8_WAIT_V
#undef PG8_WAIT_L
#undef PG8_BAR
#undef PG8_SCHED
}

struct PlainSched {
    TileOrder to; const char* A; const char* B; size_t tA, tB;
    __device__ __forceinline__ bool next(int i, Unit& u) const { int pm, pn; if (!to.get(i, pm, pn)) return false; u.pm = pm; u.pn = pn; u.aux = 0; u.rows = nullptr; u.A = A + (size_t)pm * tA; u.B = B + (size_t)pn * tB; return true; }
};
struct MemAttnSched {
    TileOrder to; const char* A; const char* B; size_t bB, hB;
    __device__ __forceinline__ bool next(int i, Unit& u) const { int pm, pn; if (!to.get(i, pm, pn)) return false; u.pm = pm; u.pn = pn; u.aux = 0; u.rows = nullptr;
        u.A = A + (size_t)pm * (256 * DM * 2) + (size_t)pn * 512; const int b = pm >> 5; u.B = B + (size_t)b * bB + (size_t)pn * hB; return true; }
};
struct MoeSched {
    int G, c, nblk; const unsigned* blk_e; const char* A; const char* B; size_t tA, eB, tB; const int* row_tok;
    __device__ __forceinline__ bool next(int i, Unit& u) const { const int L = i * G + c; if (L >= nblk * 4) return false; const int rb = L >> 2, pn = L & 3;
        const int e = (int)__builtin_amdgcn_readfirstlane(ld_u32_agent(blk_e + rb)); u.pm = rb; u.pn = pn; u.aux = e; u.rows = row_tok + (size_t)rb * 256;
        u.A = A + (size_t)rb * tA; u.B = B + (size_t)e * eB + (size_t)pn * tB; return true; }
};

#define EPI_ARGS f32x4 (&acc)[2][2][4][2], const Unit& u, int wr, int wc, int fr, int fq
struct EpiZ {
    static constexpr bool PERM = true;
    bf16_t* O;
    __device__ __forceinline__ void operator()(EPI_ARGS) const {
        const int row0 = u.pm * BM + wr * 64 + fr, col0 = u.pn * BM + wc * 32 + 8 * fq;
        const int mode = u.pn < 4 ? 1 : (u.pn < 6 ? 2 : 0);
#pragma unroll
        for (int ai = 0; ai < 2; ++ai)
#pragma unroll
            for (int m = 0; m < 4; ++m) { bf16_t* rowp = O + (size_t)(row0 + ai * HALF + m * 16) * ZP + col0;
#pragma unroll
                for (int bj = 0; bj < 2; ++bj) { f32x4 v0 = acc[ai][bj][m][0], v1 = acc[ai][bj][m][1];
                    if (mode == 1) { f32x2g a = gelu_pk((f32x2g){v0[0], v0[1]}), b = gelu_pk((f32x2g){v0[2], v0[3]}), c = gelu_pk((f32x2g){v1[0], v1[1]}), d = gelu_pk((f32x2g){v1[2], v1[3]});
                        v0 = (f32x4){a.x, a.y, b.x, b.y}; v1 = (f32x4){c.x, c.y, d.x, d.y}; }
                    else if (mode == 2) { v0 = v0 * C2_DIFF; v1 = v1 * C2_DIFF; }
                    u32x4 w; w.x = cvt_pk_bf16(v0[0], v0[1]); w.y = cvt_pk_bf16(v0[2], v0[3]); w.z = cvt_pk_bf16(v1[0], v1[1]); w.w = cvt_pk_bf16(v1[2], v1[3]);
                    *(u32x4*)(rowp + bj * HALF) = w; } }
    }
};
struct EpiBf16 {
    static constexpr bool PERM = true;
    bf16_t* O; int ldc; const float* ssq; float cscale;
    __device__ __forceinline__ void operator()(EPI_ARGS) const {
        const int row0 = u.pm * BM + wr * 64 + fr, col0 = u.pn * BM + wc * 32 + 8 * fq;
#pragma unroll
        for (int ai = 0; ai < 2; ++ai)
#pragma unroll
            for (int m = 0; m < 4; ++m) { const int row = row0 + ai * HALF + m * 16; float sc = cscale;
                if (ssq) { float s = 0.f;
#pragma unroll
                    for (int j = 0; j < 16; ++j) s += ssq[(size_t)j * M + row];
                    sc *= __builtin_amdgcn_rsqf(s * (1.0f / DM) + RMS_EPS); }
                bf16_t* rowp = O + (size_t)row * ldc + col0;
#pragma unroll
                for (int bj = 0; bj < 2; ++bj) { const f32x4 v0 = acc[ai][bj][m][0] * sc, v1 = acc[ai][bj][m][1] * sc;
                    u32x4 w; w.x = cvt_pk_bf16(v0[0], v0[1]); w.y = cvt_pk_bf16(v0[2], v0[3]); w.z = cvt_pk_bf16(v1[0], v1[1]); w.w = cvt_pk_bf16(v1[2], v1[3]);
                    *(u32x4*)(rowp + bj * HALF) = w; } }
    }
};
struct EpiSoftmax {
    static constexpr bool PERM = true;
    bf16_t* O; LAS float* xch;
    __device__ __forceinline__ void operator()(EPI_ARGS) const {
        const int row0 = u.pm * BM + wr * 64 + fr, col0 = u.pn * BM + wc * 32 + 8 * fq;
        LAS float* xm = xch; LAS float* xs = xch + 1024;
#pragma unroll
        for (int ai = 0; ai < 2; ++ai)
#pragma unroll
            for (int m = 0; m < 4; ++m) { float v = -__builtin_inff();
#pragma unroll
                for (int bj = 0; bj < 2; ++bj)
#pragma unroll
                    for (int n = 0; n < 2; ++n) { const f32x4 a = acc[ai][bj][m][n]; v = fmaxf(v, fmaxf(fmaxf(a[0], a[1]), fmaxf(a[2], a[3]))); }
                v = fmaxf(v, __shfl_xor(v, 16)); v = fmaxf(v, __shfl_xor(v, 32));
                if (fq == 0) xm[(ai * HALF + wr * 64 + m * 16 + fr) * 4 + wc] = v; }
        asm volatile("s_waitcnt lgkmcnt(0)" ::: "memory"); __builtin_amdgcn_s_barrier(); asm volatile("" ::: "memory");
#pragma unroll
        for (int ai = 0; ai < 2; ++ai)
#pragma unroll
            for (int m = 0; m < 4; ++m) { const f32x4 t = *(const LAS f32x4*)(xm + (ai * HALF + wr * 64 + m * 16 + fr) * 4); const float mx = fmaxf(fmaxf(t[0], t[1]), fmaxf(t[2], t[3])); float sm = 0.f;
#pragma unroll
                for (int bj = 0; bj < 2; ++bj)
#pragma unroll
                    for (int n = 0; n < 2; ++n) { f32x4 a = acc[ai][bj][m][n];
#pragma unroll
                        for (int j = 0; j < 4; ++j) { a[j] = __builtin_amdgcn_exp2f(a[j] - mx); sm += a[j]; }
                        acc[ai][bj][m][n] = a; }
                sm += __shfl_xor(sm, 16); sm += __shfl_xor(sm, 32);
                if (fq == 0) xs[(ai * HALF + wr * 64 + m * 16 + fr) * 4 + wc] = sm; }
        asm volatile("s_waitcnt lgkmcnt(0)" ::: "memory"); __builtin_amdgcn_s_barrier(); asm volatile("" ::: "memory");
#pragma unroll
        for (int ai = 0; ai < 2; ++ai)
#pragma unroll
            for (int m = 0; m < 4; ++m) { const f32x4 t = *(const LAS f32x4*)(xs + (ai * HALF + wr * 64 + m * 16 + fr) * 4); const float inv = __builtin_amdgcn_rcpf((t[0] + t[1]) + (t[2] + t[3]));
                bf16_t* rowp = O + (size_t)(row0 + ai * HALF + m * 16) * DM + col0;
#pragma unroll
                for (int bj = 0; bj < 2; ++bj) { const f32x4 v0 = acc[ai][bj][m][0] * inv, v1 = acc[ai][bj][m][1] * inv;
                    u32x4 w; w.x = cvt_pk_bf16(v0[0], v0[1]); w.y = cvt_pk_bf16(v0[2], v0[3]); w.z = cvt_pk_bf16(v1[0], v1[1]); w.w = cvt_pk_bf16(v1[2], v1[3]);
                    *(u32x4*)(rowp + bj * HALF) = w; } }
    }
};
struct EpiResid {
    static constexpr bool PERM = false;
    const float* base; float* out; bf16_t* ob; float* ssq;
    __device__ __forceinline__ void operator()(EPI_ARGS) const {
        const int row0 = u.pm * BM + wr * 64 + fr, col0 = u.pn * BM + wc * 32 + 4 * fq;
#pragma unroll
        for (int ai = 0; ai < 2; ++ai)
#pragma unroll
            for (int m = 0; m < 4; ++m) { const int row = row0 + ai * HALF + m * 16; const size_t off = (size_t)row * DM + col0; float s = 0.f;
#pragma unroll
                for (int bj = 0; bj < 2; ++bj)
#pragma unroll
                    for (int n = 0; n < 2; ++n) { const f32x4 bs = *(const f32x4*)(base + off + bj * HALF + n * 16); const f32x4 o = bs + acc[ai][bj][m][n];
                        *(f32x4*)(out + off + bj * HALF + n * 16) = o; s += (o[0] * o[0] + o[1] * o[1]) + (o[2] * o[2] + o[3] * o[3]);
                        u32x2 w; w.x = cvt_pk_bf16(o[0], o[1]); w.y = cvt_pk_bf16(o[2], o[3]); *(u32x2*)(ob + off + bj * HALF + n * 16) = w; }
                s += __shfl_xor(s, 16); s += __shfl_xor(s, 32);
                if (fq == 0) ssq[(size_t)(u.pn * 4 + wc) * M + row] = s; }
    }
};
struct EpiRouter {
    static constexpr bool PERM = false;
    float* L; const float* ssq; const float* bg; const float* be;
    __device__ __forceinline__ void operator()(EPI_ARGS) const {
        if (wc >= 2) return;
        const int row0 = u.pm * BM + wr * 64 + fr;
#pragma unroll
        for (int ai = 0; ai < 2; ++ai)
#pragma unroll
            for (int m = 0; m < 4; ++m) { const int row = row0 + ai * HALF + m * 16; float s = 0.f;
#pragma unroll
                for (int j = 0; j < 16; ++j) s += ssq[(size_t)j * M + row];
                const float rs = __builtin_amdgcn_rsqf(s * (1.0f / DM) + RMS_EPS);
#pragma unroll
                for (int n = 0; n < 2; ++n) { const int c0 = wc * 32 + n * 16 + 4 * fq; f32x4 o = acc[ai][0][m][n] * rs;
#pragma unroll
                    for (int j = 0; j < 4; ++j) { const int c = c0 + j; const float b = c < 4 ? bg[c] : (c < 36 ? be[c - 4] : 0.f); o[j] += b; }
                    *(f32x4*)(L + (size_t)row * 64 + c0) = o; } }
    }
};
struct EpiGateUp {
    static constexpr bool PERM = true;
    bf16_t* act; const float* ssq; const int* row_tok;
    __device__ __forceinline__ void operator()(EPI_ARGS) const {
        const int row0 = u.pm * BM + wr * 64 + fr, col0 = u.pn * 128 + wc * 32 + 8 * fq;
#pragma unroll
        for (int ai = 0; ai < 2; ++ai)
#pragma unroll
            for (int m = 0; m < 4; ++m) { const int row = row0 + ai * HALF + m * 16; const int tok = row_tok[row]; float s = 0.f;
#pragma unroll
                for (int j = 0; j < 16; ++j) s += ssq[(size_t)j * M + tok];
                const float rs = __builtin_amdgcn_rsqf(s * (1.0f / DM) + RMS_EPS);
                float r[8];
#pragma unroll
                for (int n = 0; n < 2; ++n)
#pragma unroll
                    for (int j = 0; j < 4; ++j) { const float gg = acc[ai][0][m][n][j] * rs, uu = acc[ai][1][m][n][j] * rs;
                        r[n * 4 + j] = gg * __builtin_amdgcn_rcpf(1.0f + __builtin_amdgcn_exp2f(-gg * LOG2E)) * uu; }
                u32x4 w; w.x = cvt_pk_bf16(r[0], r[1]); w.y = cvt_pk_bf16(r[2], r[3]); w.z = cvt_pk_bf16(r[4], r[5]); w.w = cvt_pk_bf16(r[6], r[7]);
                *(u32x4*)(act + (size_t)row * DEXP + col0) = w; }
    }
};
}

namespace da {
constexpr int NW = 8, QBLK = 32, KVBLK = 64, QB = NW * QBLK, DV = 128;
constexpr int SHM_V = KVBLK * DV * 2, SHM_K = KVBLK * 64 * 2;
constexpr int LDS_V = 0, LDS_K = 2 * SHM_V, LDS_WS = LDS_K + 2 * SHM_K, LDS_STASH = LDS_WS + NW * 64 * 4, LDS_BYTES = LDS_STASH + NW * 8192;
constexpr float THR = 8.f;
#define SBAR() __builtin_amdgcn_sched_barrier(0)
__device__ __forceinline__ int kswz(int row, int chunk) { return row * 128 + ((chunk ^ ((row >> 1) & 7)) << 4); }
__device__ __forceinline__ int v_st(int k, int c) { const int kk = (k & ~0xC) | ((k & 4) << 1) | ((k & 8) >> 1); return ((kk >> 3) * 4 + (c >> 5)) * 512 + ((kk & 7) * 32 + (c & 31)) * 2; }
__device__ __forceinline__ int v_rd_base(int lane) { return ((lane & 3) << 3) | (((lane >> 2) & 3) << 6) | (((lane >> 4) & 1) << 5) | (((lane >> 5) & 1) << 8); }
constexpr int v_rd_off(int d0, int ks, int half) { return d0 * 512 + ks * 4096 + half * 2048; }
__device__ __forceinline__ int crow(int r, int hi) { return (r & 3) + 8 * (r >> 2) + 4 * hi; }
__device__ __forceinline__ bf16x8 load8(const bf16_t* p) { return *reinterpret_cast<const bf16x8*>(p); }

__device__ __forceinline__ void mask_tile(f32x16& p0, f32x16& p1, int dq) {
    const float NEG = -__builtin_inff();
#pragma unroll
    for (int r = 0; r < 16; ++r) { const int c = (r & 3) + 8 * (r >> 2); if (dq - c < 0) p0[r] = NEG; if (dq - c - 32 < 0) p1[r] = NEG; }
}
__device__ __forceinline__ void partialSM(f32x16& p0, f32x16& p1, float& m_reg, float& alpha) {
    float pmax = p0[0];
#pragma unroll
    for (int r = 1; r < 16; ++r) pmax = fmaxf(pmax, p0[r]);
#pragma unroll
    for (int r = 0; r < 16; ++r) pmax = fmaxf(pmax, p1[r]);
    { auto rr = __builtin_amdgcn_permlane32_swap(__float_as_uint(pmax), __float_as_uint(pmax), false, false); pmax = fmaxf(__uint_as_float(rr[0]), __uint_as_float(rr[1])); }
    float mn;
    if (__builtin_expect(__all((pmax - m_reg) <= THR), 1)) { mn = m_reg; alpha = 1.f; }
    else { mn = fmaxf(m_reg, pmax); alpha = __builtin_amdgcn_exp2f(m_reg - mn); m_reg = mn; }
#pragma unroll
    for (int r = 0; r < 16; ++r) p0[r] = p0[r] - mn;
#pragma unroll
    for (int r = 0; r < 16; ++r) p1[r] = p1[r] - mn;
#pragma unroll
    for (int r = 0; r < 16; ++r) p0[r] = __builtin_amdgcn_exp2f(p0[r]);
}
__device__ __forceinline__ void finishSM(f32x16& p0, f32x16& p1, float alpha, float& l_reg, bf16x8& pa0, bf16x8& pa1, bf16x8& pa2, bf16x8& pa3) {
#pragma unroll
    for (int r = 0; r < 16; ++r) p1[r] = __builtin_amdgcn_exp2f(p1[r]);
    float ps = 0;
#pragma unroll
    for (int r = 0; r < 16; ++r) ps += p0[r];
#pragma unroll
    for (int r = 0; r < 16; ++r) ps += p1[r];
    { auto rr = __builtin_amdgcn_permlane32_swap(__float_as_uint(ps), __float_as_uint(ps), false, false); ps = __uint_as_float(rr[0]) + __uint_as_float(rr[1]); }
    l_reg = l_reg * alpha + ps;
#define PK4(P, B_, OUT) do { unsigned a0 = cvt_pk_bf16(P[B_+0], P[B_+1]), a1 = cvt_pk_bf16(P[B_+2], P[B_+3]);                          \
        unsigned b0 = cvt_pk_bf16(P[B_+4], P[B_+5]), b1 = cvt_pk_bf16(P[B_+6], P[B_+7]);                                             \
        auto r0 = __builtin_amdgcn_permlane32_swap(a0, b0, false, false); auto r1 = __builtin_amdgcn_permlane32_swap(a1, b1, false, false); \
        u32x4 w = {r0[0], r1[0], r0[1], r1[1]}; OUT = *reinterpret_cast<bf16x8*>(&w); } while (0)
    PK4(p0, 0, pa0); PK4(p0, 8, pa1); PK4(p1, 0, pa2); PK4(p1, 8, pa3);
#undef PK4
}
template <int KB>
__device__ __forceinline__ void qkt(f32x16& p0, f32x16& p1, const char* K_lds, int r32, int hi, const bf16x8* qr, float ab, float slope2) {
    const float s32 = 32.f * slope2;
#pragma unroll
    for (int r = 0; r < 16; ++r) { p0[r] = fmaf(slope2, (float)((r & 3) + 8 * (r >> 2)), ab); p1[r] = p0[r] + s32; }
#pragma unroll
    for (int d0 = 0; d0 < 4; ++d0) { const char* a = K_lds + KB * SHM_K + kswz(r32, d0 * 2 + hi);
        bf16x8 b0 = *reinterpret_cast<const bf16x8*>(a);
        bf16x8 b1 = *reinterpret_cast<const bf16x8*>(a + 32 * 128);
        p0 = __builtin_amdgcn_mfma_f32_32x32x16_bf16(b0, qr[d0], p0, 0, 0, 0);
        p1 = __builtin_amdgcn_mfma_f32_32x32x16_bf16(b1, qr[d0], p1, 0, 0, 0); }
}
template <int VB>
__device__ __forceinline__ void pv_tile(f32x16* o, int vb0, bf16x8 pa0, bf16x8 pa1, bf16x8 pa2, bf16x8 pa3) {
#define TRRD(dst, off) asm volatile("ds_read_b64_tr_b16 %0, %1 offset:%2" : "=&v"(dst) : "v"(vb0), "i"(off) : "memory")
#define PV_D0(d0) do { s16x4 l0, l1, l2, l3, h0, h1, h2, h3; constexpr int b_ = VB * SHM_V + v_rd_off(d0, 0, 0); \
        TRRD(l0, b_); TRRD(h0, b_ + 2048); TRRD(l1, b_ + 4096); TRRD(h1, b_ + 6144); TRRD(l2, b_ + 8192); TRRD(h2, b_ + 10240); TRRD(l3, b_ + 12288); TRRD(h3, b_ + 14336); \
        asm volatile("s_waitcnt lgkmcnt(0)" ::: "memory"); SBAR();   \
        o[d0] = __builtin_amdgcn_mfma_f32_32x32x16_bf16(pa0, (bf16x8){l0[0], l0[1], l0[2], l0[3], h0[0], h0[1], h0[2], h0[3]}, o[d0], 0, 0, 0);   \
        o[d0] = __builtin_amdgcn_mfma_f32_32x32x16_bf16(pa1, (bf16x8){l1[0], l1[1], l1[2], l1[3], h1[0], h1[1], h1[2], h1[3]}, o[d0], 0, 0, 0);   \
        o[d0] = __builtin_amdgcn_mfma_f32_32x32x16_bf16(pa2, (bf16x8){l2[0], l2[1], l2[2], l2[3], h2[0], h2[1], h2[2], h2[3]}, o[d0], 0, 0, 0);   \
        o[d0] = __builtin_amdgcn_mfma_f32_32x32x16_bf16(pa3, (bf16x8){l3[0], l3[1], l3[2], l3[3], h3[0], h3[1], h3[2], h3[3]}, o[d0], 0, 0, 0); } while (0)
    PV_D0(0); PV_D0(1); PV_D0(2); PV_D0(3);
#undef PV_D0
#undef TRRD
}

struct BlockRef { const bf16_t* Q; const bf16_t* K; const bf16_t* V; bf16_t* O; int P0; int mode; float slope2; int h; };
struct Seam { bf16x8 qr[4]; bf16x8 st_v0, st_v1, st_k0; };
__device__ __forceinline__ BlockRef mkref(const bf16_t* Z, bf16_t* AO, int item, int pass) { BlockRef r; const int bh = item >> 4, y = item & 15, b = bh >> 2, h = bh & 3; const int qb = (pass < 2) ? y : 31 - y, mp = pass & 1;
    const bf16_t* zb = Z + (size_t)b * SEQ * ZP; r.Q = zb + (size_t)(qb * 256) * ZP + ZQ + h * 128 + mp * 64; r.K = zb + ZK + h * 128 + mp * 64; r.V = zb + ZVAL + h * 128;
    r.O = AO + ((size_t)b * SEQ + qb * 256) * DM + 512 + h * 128; r.P0 = qb * 256; r.mode = mp; r.slope2 = exp2f(-2.0f * (float)(h + 1)) * LOG2E; r.h = h; return r; }
#define ROWV(p, k0, rr) ((p) + (size_t)((k0) + (rr)) * ZP + sc)
#define ROWK(p, k0) ((p) + (size_t)((k0) + skr) * ZP + skc * 8)
#define VMW() asm volatile("s_waitcnt vmcnt(0)" ::: "memory")
#define VMWN(n) asm volatile("s_waitcnt vmcnt(%0)" :: "i"(n) : "memory")
#define SLOAD_H(Kp, Vp, k0) do { S.st_v0 = load8(ROWV(Vp, k0, sr)); S.st_v1 = load8(ROWV(Vp, k0, 32 + sr)); S.st_k0 = load8(ROWK(Kp, k0)); } while (0)
#define SWRITE_HK(bf) do { *(bf16x8*)(K_lds + (bf) * SHM_K + kws) = S.st_k0; } while (0)
#define SWRITE_HV(bf) do { *(bf16x8*)(V_lds + (bf) * SHM_V + vst0) = S.st_v0; *(bf16x8*)(V_lds + (bf) * SHM_V + vst1) = S.st_v1; } while (0)
#define SWRITE_H(bf) do { SWRITE_HV(bf); SWRITE_HK(bf); } while (0)
__device__ __forceinline__ void prime(const BlockRef& cur, char* lds, Seam& S, int wid) {
    const int lane = lane_id(), tid = wid * 64 + lane, r32 = lane & 31, hi = lane >> 5;
    const int sr = tid >> 4, sc = (tid & 15) * 8, skr = tid >> 3, skc = tid & 7, kws = kswz(skr, skc); char* K_lds = lds + LDS_K;
#pragma unroll
    for (int d0 = 0; d0 < 4; ++d0) S.qr[d0] = load8(cur.Q + (size_t)(wid * QBLK + r32) * ZP + d0 * 16 + hi * 8);
    SLOAD_H(cur.K, cur.V, 0); VMW(); SWRITE_HK(0);
    __syncthreads();
}
__device__ __forceinline__ void block(const BlockRef& cur, const BlockRef& nxt, char* lds, Seam& S, float lam, const float* __restrict__ subln, int wid) {
    const int lane = lane_id(), tid = wid * 64 + lane, r32 = lane & 31, hi = lane >> 5;
    const int NT = (cur.P0 + QB) / KVBLK;
    const int qlo = cur.P0 + wid * QBLK, qm = qlo + r32 - 4 * hi;
    const float slope2 = cur.slope2;
    char* V_lds = lds + LDS_V; char* K_lds = lds + LDS_K;
    float* ws = (float*)(lds + LDS_WS) + wid * 64; float* li_l = ws, * al_l = ws + 32;
    float m_reg = -1e30f, l_reg = 0; f32x16 o[4] = {};
    const int sr = tid >> 4, sc = (tid & 15) * 8, vst0 = v_st(sr, sc), vst1 = v_st(32 + sr, sc), skr = tid >> 3, skc = tid & 7, kws = kswz(skr, skc);
    const int vb0 = (int)(uintptr_t)V_lds + v_rd_base(lane);
    const bf16_t* Kh = cur.K; const bf16_t* Vh = cur.V;
#define RESC(a) do { if (__any((a) < 1.f)) { if (hi == 0) al_l[r32] = (a); asm volatile("s_waitcnt lgkmcnt(0)" ::: "memory");              \
                     for (int d_ = 0; d_ < 4; ++d_) for (int r = 0; r < 16; ++r) o[d_][r] *= al_l[crow(r, hi)]; } } while (0)
#define KBASE(t) ((t) * KVBLK)
#define AB(t) (slope2 * (float)(KBASE(t) - qm))
#define MASKT(P0_, P1_, t) do { const int kb_ = KBASE(t); if (kb_ + KVBLK - 1 > qlo) mask_tile(P0_, P1_, qm - kb_); } while (0)
    constexpr int NQL = 4;
#define SEAM_K0() do { VMWN(NQL); SWRITE_HK(0); SBAR(); } while (0)
    f32x16 pA0, pA1, pB0, pB1; float alA, alB; bf16x8 pa0, pa1, pa2, pa3;
    SWRITE_HV(0); SBAR();
    if (NT > 1) { SLOAD_H(Kh, Vh, KBASE(1)); }
    SBAR(); qkt<0>(pA0, pA1, K_lds, r32, hi, S.qr, AB(0), slope2);
    MASKT(pA0, pA1, 0); partialSM(pA0, pA1, m_reg, alA);
    if (NT > 1) { VMW(); SWRITE_H(1); }
    __syncthreads();
#define HALF_STEP(PX0, PX1, alX, PY0, PY1, alY, t, KB, VB, SB) do {                                                      \
        SBAR(); qkt<KB>(PX0, PX1, K_lds, r32, hi, S.qr, AB(t), slope2);                                                   \
        finishSM(PY0, PY1, alY, l_reg, pa0, pa1, pa2, pa3); SBAR();                                                       \
        if ((t) + 1 < NT) { SLOAD_H(Kh, Vh, KBASE((t) + 1)); SBAR(); }                                                    \
        pv_tile<VB>(o, vb0, pa0, pa1, pa2, pa3); MASKT(PX0, PX1, (t)); partialSM(PX0, PX1, m_reg, alX);                   \
        __syncthreads();                                                                                                  \
        if ((t) + 1 < NT) { VMW(); SWRITE_H(SB); }                                                                        \
        RESC(alX); __syncthreads(); } while (0)
    for (int t = 1; t + 1 < NT; t += 2) {
        HALF_STEP(pB0, pB1, alB, pA0, pA1, alA, t, 1, 0, 0);
        HALF_STEP(pA0, pA1, alA, pB0, pB1, alB, t + 1, 0, 1, 1);
    }
    SBAR(); qkt<1>(pB0, pB1, K_lds, r32, hi, S.qr, AB(NT - 1), slope2); SBAR();
    SLOAD_H(nxt.K, nxt.V, 0); SBAR();
#pragma unroll
    for (int d0 = 0; d0 < 4; ++d0) S.qr[d0] = load8(nxt.Q + (size_t)(wid * QBLK + r32) * ZP + d0 * 16 + hi * 8);
    SBAR();
    finishSM(pA0, pA1, alA, l_reg, pa0, pa1, pa2, pa3); SBAR();
    pv_tile<0>(o, vb0, pa0, pa1, pa2, pa3);
    MASKT(pB0, pB1, NT - 1); partialSM(pB0, pB1, m_reg, alB); __syncthreads(); RESC(alB);
    finishSM(pB0, pB1, alB, l_reg, pa0, pa1, pa2, pa3); SBAR(); pv_tile<1>(o, vb0, pa0, pa1, pa2, pa3);
    SBAR(); SEAM_K0();
    if (hi == 0) li_l[r32] = l_reg; asm volatile("s_waitcnt lgkmcnt(0)" ::: "memory");
    float rli[16];
#pragma unroll
    for (int r = 0; r < 16; ++r) rli[r] = __builtin_amdgcn_rcpf(li_l[crow(r, hi)]);
    unsigned* stash = (unsigned*)(lds + LDS_STASH) + wid * 2048 + lane;
    if (cur.mode == 0) {
#pragma unroll
        for (int r = 0; r < 16; ++r) { stash[(r * 2 + 0) * 64] = cvt_pk_bf16(o[0][r] * rli[r], o[1][r] * rli[r]); stash[(r * 2 + 1) * 64] = cvt_pk_bf16(o[2][r] * rli[r], o[3][r] * rli[r]); }
    } else {
        float ssq[16];
#pragma unroll
        for (int r = 0; r < 16; ++r) { const unsigned w0 = stash[(r * 2 + 0) * 64], w1 = stash[(r * 2 + 1) * 64];
            o[0][r] = bf_lo(w0) - lam * (o[0][r] * rli[r]); o[1][r] = bf_hi(w0) - lam * (o[1][r] * rli[r]);
            o[2][r] = bf_lo(w1) - lam * (o[2][r] * rli[r]); o[3][r] = bf_hi(w1) - lam * (o[3][r] * rli[r]);
            ssq[r] = (o[0][r] * o[0][r] + o[1][r] * o[1][r]) + (o[2][r] * o[2][r] + o[3][r] * o[3][r]); }
#pragma unroll
        for (int r = 0; r < 16; ++r) {
#pragma unroll
            for (int off = 1; off < 32; off <<= 1) ssq[r] += __shfl_xor(ssq[r], off);
            ssq[r] = __builtin_amdgcn_rsqf(ssq[r] * (1.0f / DV) + RMS_EPS); }
        float g4[4];
#pragma unroll
        for (int d0 = 0; d0 < 4; ++d0) g4[d0] = subln[d0 * 32 + r32] * 0.8f;
        bf16_t* Ow = cur.O + (size_t)(wid * QBLK) * DM;
#pragma unroll
        for (int r = 0; r < 16; ++r) { const int orow = crow(r, hi);
#pragma unroll
            for (int d0 = 0; d0 < 4; ++d0) { const float v = o[d0][r] * ssq[r] * g4[d0]; const float vn = __shfl_xor(v, 1);
                if ((r32 & 1) == 0) *(unsigned*)(Ow + (size_t)orow * DM + d0 * 32 + r32) = cvt_pk_bf16(v, vn); } }
    }
    __syncthreads();
#undef RESC
#undef KBASE
#undef AB
#undef MASKT
#undef SEAM_K0
#undef HALF_STEP
}
#undef ROWV
#undef ROWK
#undef VMW
#undef VMWN
#undef SLOAD_H
#undef SWRITE_HK
#undef SWRITE_HV
#undef SWRITE_H
#undef SBAR
}


#define XB_TMO      128
#define XB_XCNT(j)  (256  + 64 * (j))
#define XB_XSUB(j)  (1280 + 64 * (j))
#define XB_XGEN(j)  (2304 + 64 * (j))
#define XB_TOP      3328
#define XB_TOPGEN   3392
#define XCD_BAR_WORDS 3456
#define XB_SPIN_CAP (1u << 22)
__device__ __forceinline__ unsigned xb_ld(unsigned* p)              { return __hip_atomic_load(p, __ATOMIC_RELAXED, __HIP_MEMORY_SCOPE_AGENT); }
__device__ __forceinline__ unsigned xb_add(unsigned* p, unsigned v) { return __hip_atomic_fetch_add(p, v, __ATOMIC_RELAXED, __HIP_MEMORY_SCOPE_AGENT); }
__device__ __forceinline__ unsigned xb_xcc_id() { return (unsigned)__builtin_amdgcn_s_getreg((3 << 11) | 20) & 0xFu; }
#define XB_SPIN(cond, bar) do { unsigned _sp = 0; while (cond) { __builtin_amdgcn_s_sleep(1); \
    if ((++_sp & 255u) == 0u) { if (xb_ld(&(bar)[XB_TMO])) break; if (_sp > XB_SPIN_CAP) { atomicAdd(&(bar)[XB_TMO], 1u); break; } } } } while (0)
struct XcdBarrier { unsigned* bar; unsigned x; volatile LAS unsigned* st; };
__device__ __forceinline__ XcdBarrier xcd_barrier_post(unsigned* bar, volatile LAS unsigned* st, bool t0) {
    XcdBarrier b; b.bar = bar; b.x = xb_xcc_id(); b.st = st;
    if (t0) (void)xb_add(&bar[XB_XCNT(b.x)], 1u);
    return b;
}
__device__ __forceinline__ void xcd_barrier_complete(unsigned* bar, unsigned x, unsigned& nloc, unsigned& nx) {
    const unsigned G = gridDim.x;
    unsigned sum, cnt, mine, sp = 0u;
    for (;;) {
        sum = 0u; cnt = 0u; mine = 0u;
#pragma unroll
        for (unsigned j = 0; j < 16; ++j) { const unsigned c = xb_ld(&bar[XB_XCNT(j)]); sum += c; cnt += (c > 0u) ? 1u : 0u; mine = (j == x) ? c : mine; }
        if (sum == G) break;
        __builtin_amdgcn_s_sleep(1);
        if ((++sp & 255u) == 0u) { if (xb_ld(&bar[XB_TMO])) break; if (sp > XB_SPIN_CAP) { atomicAdd(&bar[XB_TMO], 1u); break; } }
    }
    nloc = mine > 0u ? mine : 1u; nx = cnt > 0u ? cnt : 1u;
}
__device__ __forceinline__ void xcd_barrier(const XcdBarrier& b, bool t0) {
    asm volatile("s_waitcnt vmcnt(0)" ::: "memory");
    __syncthreads();
    if (t0) {
        unsigned* bar = b.bar;
        __builtin_amdgcn_s_waitcnt(0);
        unsigned nloc = b.st[0], nx = b.st[1];
        if (nloc == 0u) { xcd_barrier_complete(bar, b.x, nloc, nx); b.st[0] = nloc; b.st[1] = nx; }
        const unsigned old = xb_add(&bar[XB_XSUB(b.x)], 1u);
        const unsigned gen = old / nloc;
        if (old + 1u == (gen + 1u) * nloc) {
            __builtin_amdgcn_fence(__ATOMIC_RELEASE, "agent");
            asm volatile("s_waitcnt vmcnt(0)" ::: "memory");
            const unsigned og = xb_add(&bar[XB_TOP], 1u);
            const unsigned tg = og / nx;
            if (og + 1u == (tg + 1u) * nx) xb_add(&bar[XB_TOPGEN], 1u);
            else XB_SPIN(xb_ld(&bar[XB_TOPGEN]) == tg, bar);
            __builtin_amdgcn_fence(__ATOMIC_ACQUIRE, "agent");
            xb_add(&bar[XB_XGEN(b.x)], 1u);
            asm volatile("s_waitcnt vmcnt(0)" ::: "memory");
        } else {
            XB_SPIN(xb_ld(&bar[XB_XGEN(b.x)]) == gen, bar);
            __builtin_amdgcn_fence(__ATOMIC_ACQUIRE, "agent");
            asm volatile("s_waitcnt vmcnt(0)" ::: "memory");
        }
    }
    __syncthreads();
}
constexpr int NWAVES = 8, NTHR = 512;
constexpr int LDS_BYTES = 147456;
struct Args {
    const float* in[28]; float* out; unsigned char* ws; int ph_lo, ph_hi;
};
constexpr int N_PHASES = 15;

struct Frame {
    LAS unsigned char* lds; int wave, vcu, G;
};

__device__ __forceinline__ void transpose_item(const float* W, int ldw, int k0, int n0, bf16_t* dst, int ldt, const float* kscale, LAS float* scr, int lane) {
#pragma unroll 8
    for (int i = 0; i < 32; ++i) { const int kk = 2 * i + (lane >> 5); float v = W[(size_t)(k0 + kk) * ldw + n0 + (lane & 31)]; if (kscale) v *= kscale[k0 + kk]; scr[kk * 33 + (lane & 31)] = v; }
    asm volatile("s_waitcnt lgkmcnt(0)" ::: "memory");
    const int c = lane & 7;
#pragma unroll
    for (int j = 0; j < 4; ++j) { const int n = (lane >> 3) + 8 * j; const LAS float* s = scr + (8 * c) * 33 + n;
        u32x4 o; o.x = cvt_pk_bf16(s[0 * 33], s[1 * 33]); o.y = cvt_pk_bf16(s[2 * 33], s[3 * 33]); o.z = cvt_pk_bf16(s[4 * 33], s[5 * 33]); o.w = cvt_pk_bf16(s[6 * 33], s[7 * 33]);
        *(u32x4*)(dst + (size_t)n * ldt + k0 + 8 * c) = o; }
    asm volatile("s_waitcnt lgkmcnt(0)" ::: "memory");
}
__device__ __forceinline__ void rms_row_to_bf16(const float* xrow, const float* g, bf16_t* orow, int lane) {
    const f32x4* xr = (const f32x4*)xrow + lane; const f32x4* gr = (const f32x4*)g + lane;
    f32x4 v[4]; float s = 0.f;
#pragma unroll
    for (int j = 0; j < 4; ++j) { v[j] = xr[64 * j]; s += (v[j].x * v[j].x + v[j].y * v[j].y) + (v[j].z * v[j].z + v[j].w * v[j].w); }
    const float rstd = __builtin_amdgcn_rsqf(wave_sum(s) * (1.f / DM) + RMS_EPS);
    u32x2* o8 = (u32x2*)orow + lane;
#pragma unroll
    for (int j = 0; j < 4; ++j) { const f32x4 gg = gr[64 * j]; u32x2 w; w.x = cvt_pk_bf16(v[j].x * rstd * gg.x, v[j].y * rstd * gg.y); w.y = cvt_pk_bf16(v[j].z * rstd * gg.z, v[j].w * rstd * gg.w); o8[64 * j] = w; }
}

__global__ void __launch_bounds__(NTHR, 2) mega(Args args) {
    extern __shared__ __attribute__((aligned(16))) unsigned char lds_raw[];
    Frame F; F.lds = (LAS unsigned char*)lds_raw; F.wave = __builtin_amdgcn_readfirstlane(threadIdx.x >> 6);
    F.G = gridDim.x; { const int bx = blockIdx.x; F.vcu = (F.G % 8 == 0) ? (bx % 8) * (F.G / 8) + bx / 8 : bx; }
    unsigned char* ws = args.ws;
    unsigned* ctl = (unsigned*)(ws + WS_CTL);
    const float* x = args.in[0]; float* out = args.out;
    bf16_t* Win_t = (bf16_t*)(ws + WS_WIN); bf16_t* Wout_t = (bf16_t*)(ws + WS_WOUT); bf16_t* Wq_t = (bf16_t*)(ws + WS_WQ); bf16_t* Wkv_t = (bf16_t*)(ws + WS_WKV);
    bf16_t* Wo_t = (bf16_t*)(ws + WS_WO); bf16_t* Wr_t = (bf16_t*)(ws + WS_WR); bf16_t* Wsgu = (bf16_t*)(ws + WS_WSGU); bf16_t* memn = (bf16_t*)(ws + WS_MEMN);
    bf16_t* Km = (bf16_t*)(ws + WS_KM); bf16_t* Vt = (bf16_t*)(ws + WS_VT); bf16_t* Wgu_t = (bf16_t*)(ws + WS_WGU); bf16_t* Wd_t = (bf16_t*)(ws + WS_WD);
    bf16_t* Z = (bf16_t*)(ws + WS_RA); bf16_t* Qm = (bf16_t*)(ws + WS_RA); bf16_t* Sc = (bf16_t*)(ws + WS_RA + 128 * MiB); bf16_t* xg = (bf16_t*)(ws + WS_RA); bf16_t* yb = (bf16_t*)(ws + WS_RA);
    bf16_t* XN = (bf16_t*)(ws + WS_RB); bf16_t* AO = (bf16_t*)(ws + WS_RB); bf16_t* Om = (bf16_t*)(ws + WS_RB); bf16_t* act = (bf16_t*)(ws + WS_RB);
    bf16_t* x1b = (bf16_t*)(ws + WS_RC); bf16_t* x2b = (bf16_t*)(ws + WS_RC);
    float* ssq1 = (float*)(ws + WS_SSQ1); float* ssq2 = (float*)(ws + WS_SSQ2); float* logit = (float*)(ws + WS_LOGIT);
    int* tok_e = (int*)(ws + WS_TOKE); float* tok_w = (float*)(ws + WS_TOKW); int* tok_s = (int*)(ws + WS_TOKS); int* row_tok = (int*)(ws + WS_ROWTOK);
    const int gw = F.vcu * NWAVES + F.wave, NGW = F.G * NWAVES;
    const int lo = args.ph_lo, hi = args.ph_hi;
#define IN(k) (lo <= (k) && (k) < hi)
#if MK_ONE_LAUNCH
    volatile LAS unsigned* misc = (volatile LAS unsigned*)(F.lds + LDS_MISC);
    if (threadIdx.x < 64) misc[threadIdx.x] = 0u;
    __syncthreads();
    XcdBarrier xbar = xcd_barrier_post(ctl + CW_BAR, misc + 8, threadIdx.x == 0);
#define GRID_BAR(k) do { if (IN(k) && IN((k) + 1)) { if ((k) == 0) cg::this_grid().sync(); else xcd_barrier(xbar, F.wave == 0 && lane_id() == 0); } } while (0)
#else
#define GRID_BAR(k) do { } while (0)
#endif

    if (IN(0)) {
        const int lane_ = lane_id(), tid_ = F.wave * 64 + lane_; (void)tid_;
        LAS float* scr = (LAS float*)(F.lds + F.wave * 16384);
        constexpr int I_IN = 16 * 80, I_SQ = 16 * 32, I_KV = 16 * 64, I_G = 16 * 16, I_D = 8 * 32;
        constexpr int NITEMS = I_IN + 3 * I_SQ + I_KV + NEXP * (2 * I_G + I_D);
        for (int it = gw; it < NITEMS; it += NGW) {
            int r = it;
            if (r < I_IN) { const int kb = r / 80, nb = r % 80; transpose_item(args.in[3], ZP, kb * 64, nb * 32, Win_t + (size_t)(nb * 32) * DM, DM, nullptr, scr, lane_); continue; } r -= I_IN;
            if (r < I_SQ) { const int kb = r / 32, nb = r % 32; transpose_item(args.in[13], DM, kb * 64, nb * 32, Wout_t + (size_t)(nb * 32) * DM, DM, nullptr, scr, lane_); continue; } r -= I_SQ;
            if (r < I_SQ) { const int kb = r / 32, nb = r % 32; transpose_item(args.in[16], DM, kb * 64, nb * 32, Wq_t + (size_t)(nb * 32) * DM, DM, args.in[14], scr, lane_); continue; } r -= I_SQ;
            if (r < I_KV) { const int kb = r / 64, nb = r % 64; transpose_item(args.in[17], 2 * DM, kb * 64, nb * 32, Wkv_t + (size_t)(nb * 32) * DM, DM, nullptr, scr, lane_); continue; } r -= I_KV;
            if (r < I_SQ) { const int kb = r / 32, nb = r % 32; transpose_item(args.in[18], DM, kb * 64, nb * 32, Wo_t + (size_t)(nb * 32) * DM, DM, nullptr, scr, lane_); continue; } r -= I_SQ;
            const int e = r / (2 * I_G + I_D); r -= e * (2 * I_G + I_D);
            if (r < 2 * I_G) { const int up = r >= I_G; if (up) r -= I_G; const int kb = r / 16, nb = r % 16, n0 = nb * 32;
                const float* W = (up ? args.in[25] : args.in[24]) + (size_t)e * DM * DEXP;
                transpose_item(W, DEXP, kb * 64, n0, Wgu_t + ((size_t)e * 1024 + (n0 >> 7) * 256 + up * 128 + (n0 & 127)) * DM, DM, args.in[19], scr, lane_); continue; }
            r -= 2 * I_G;
            { const int kb = r / 32, nb = r % 32; transpose_item(args.in[26] + (size_t)e * DEXP * DM, DM, kb * 64, nb * 32, Wd_t + ((size_t)e * 1024 + nb * 32) * DEXP, DEXP, nullptr, scr, lane_); }
        }
        for (int i = blockIdx.x * NTHR + tid_; i < 256 * DM; i += F.G * NTHR) { const int n = i >> 10, k = i & 1023; float v = 0.f;
            if (n < 4) v = args.in[20][k * 4 + n] * args.in[19][k]; else if (n < 36) v = args.in[22][k * 32 + (n - 4)] * args.in[19][k];
            Wr_t[i] = (bf16_t)(cvt_pk_bf16(v, 0.f) & 0xffffu); }
        for (int i = blockIdx.x * NTHR + tid_; i < 4 * 128 * 128; i += F.G * NTHR) { const int t = (i >> 7) & 127, s = i & 127; const float v = s <= t ? args.in[6][i] : 0.f; Wsgu[i] = (bf16_t)(cvt_pk_bf16(v, 0.f) & 0xffffu); }
        for (int m = gw; m < M; m += NGW) rms_row_to_bf16(x + (size_t)m * DM, args.in[2], XN + (size_t)m * DM, lane_);
        for (int m = gw; m < MROWS; m += NGW) rms_row_to_bf16(args.in[1] + (size_t)m * DM, args.in[15], memn + (size_t)m * DM, lane_);
        __syncthreads();
    }
    GRID_BAR(0);

    if (IN(1)) {
        { pg8::Gemm g{DM, DM, DM}; pg8::PlainSched S; S.to.init(M / 256, ZP / 256, F.G, (int)blockIdx.x); S.A = (const char*)XN; S.B = (const char*)Win_t; S.tA = (size_t)256 * DM * 2; S.tB = (size_t)256 * DM * 2;
          pg8::EpiZ E{Z}; pg8::gemm_phase(F.lds, F.wave, g, S, E); }
        { pg8::Gemm g{DM, DM, DM}; pg8::PlainSched S; S.to.init(MROWS / 256, 4, F.G, (int)blockIdx.x); S.A = (const char*)memn; S.B = (const char*)Wkv_t; S.tA = (size_t)256 * DM * 2; S.tB = (size_t)256 * DM * 2;
          pg8::EpiBf16 E{Km, DM, nullptr, 1.f}; pg8::gemm_phase(F.lds, F.wave, g, S, E); }
        { pg8::Gemm g{DM, DM, DM}; pg8::PlainSched S; S.to.init(4, MROWS / 256, F.G, (int)((blockIdx.x + 128) % F.G)); S.A = (const char*)(Wkv_t + (size_t)DM * DM); S.B = (const char*)memn; S.tA = (size_t)256 * DM * 2; S.tB = (size_t)256 * DM * 2;
          pg8::EpiBf16 E{Vt, MROWS, nullptr, 1.f}; pg8::gemm_phase(F.lds, F.wave, g, S, E); }
    }
    GRID_BAR(1);

    if (IN(2)) {
        const int lane_ = lane_id(), tid_ = F.wave * 64 + lane_; (void)tid_;
        float lam;
        { const float a = args.in[8][lane_] * args.in[9][lane_], b = args.in[10][lane_] * args.in[11][lane_];
          lam = __expf(wave_sum(a)) - __expf(wave_sum(b)) + 0.2f; }
        const int nitems = 32 * 16, npass = 4;
        const int per = (nitems + F.G - 1) / F.G; const int it0 = F.vcu * per; int it1 = it0 + per; if (it1 > nitems) it1 = nitems;
        if (it0 < it1) {
            int item = it0, pass = 0, rep_ = 0; (void)rep_; da::BlockRef cur = da::mkref(Z, AO, item, pass); da::Seam S;
            da::prime(cur, (char*)lds_raw, S, F.wave);
            for (;;) {
                int ni = item, np = pass + 1; if (np == npass) { np = 0; ni = item + 1; }
                if (PROBE_DUP_ATTN > 1 && ni >= it1 && rep_ + 1 < PROBE_DUP_ATTN) { ni = it0; ++rep_; }
                const bool last = ni >= it1;
                const da::BlockRef nxt = last ? cur : da::mkref(Z, AO, ni, np);
                da::block(cur, nxt, (char*)lds_raw, S, lam, args.in[12], F.wave);
                if (last) break;
                cur = nxt; item = ni; pass = np;
            }
        }
        __syncthreads();
        {
            LAS bf16_t* vnT = (LAS bf16_t*)F.lds;
            const int lane = lane_, w = F.wave;
            for (int uidx = F.vcu; uidx < (M / 128) * 4; uidx += F.G) {
                const int c = uidx >> 2, g = uidx & 3; const size_t R0 = (size_t)c * 128;
#pragma unroll
                for (int ps = 0; ps < 4; ++ps) { const int s = 16 * w + 4 * ps + (lane >> 4), ch0 = (lane & 15) * 8;
                    const u32x4 raw = *(const u32x4*)(Z + (R0 + s) * ZP + ZV + g * 128 + ch0);
                    float v[8] = {bf_lo(raw.x), bf_hi(raw.x), bf_lo(raw.y), bf_hi(raw.y), bf_lo(raw.z), bf_hi(raw.z), bf_lo(raw.w), bf_hi(raw.w)};
                    float sm = 0.f;
#pragma unroll
                    for (int j = 0; j < 8; ++j) sm += v[j];
#pragma unroll
                    for (int o = 1; o < 16; o <<= 1) sm += __shfl_xor(sm, o);
                    const float mu = sm * (1.f / 128.f); float q = 0.f;
#pragma unroll
                    for (int j = 0; j < 8; ++j) { v[j] -= mu; q += v[j] * v[j]; }
#pragma unroll
                    for (int o = 1; o < 16; o <<= 1) q += __shfl_xor(q, o);
                    const float rstd = __builtin_amdgcn_rsqf(q * (1.f / 128.f) + LN_EPS);
#pragma unroll
                    for (int j = 0; j < 8; ++j) { const float y = v[j] * rstd * args.in[4][g * 128 + ch0 + j] + args.in[5][g * 128 + ch0 + j];
                        vnT[(ch0 + j) * 136 + s] = (bf16_t)(cvt_pk_bf16(y, 0.f) & 0xffffu); } }
                __syncthreads();
                f32x4 acc[8];
#pragma unroll
                for (int mi = 0; mi < 8; ++mi) acc[mi] = (f32x4){0.f, 0.f, 0.f, 0.f};
                const int t = 16 * w + (lane & 15);
                const int nks = (w + 2) >> 1;
                for (int ks = 0; ks < nks; ++ks) {
                    const bf16x8 bfr = *(const bf16x8*)(Wsgu + ((size_t)g * 128 + t) * 128 + ks * 32 + 8 * (lane >> 4));
#pragma unroll
                    for (int mi = 0; mi < 8; ++mi) { const bf16x8 afr = *(const LAS bf16x8*)(vnT + (16 * mi + (lane & 15)) * 136 + ks * 32 + 8 * (lane >> 4));
                        acc[mi] = __builtin_amdgcn_mfma_f32_16x16x32_bf16(afr, bfr, acc[mi], 0, 0, 0); }
                }
                const float bias = args.in[7][g * 128 + t];
#pragma unroll
                for (int mi = 0; mi < 8; ++mi) { const int ch = 16 * mi + 4 * (lane >> 4);
                    const u32x2 ur = *(const u32x2*)(Z + (R0 + t) * ZP + ZU + g * 128 + ch);
                    const float o0 = bf_lo(ur.x) * (acc[mi][0] + bias), o1 = bf_hi(ur.x) * (acc[mi][1] + bias), o2 = bf_lo(ur.y) * (acc[mi][2] + bias), o3 = bf_hi(ur.y) * (acc[mi][3] + bias);
                    u32x2 wv; wv.x = cvt_pk_bf16(o0, o1); wv.y = cvt_pk_bf16(o2, o3);
                    *(u32x2*)(AO + (R0 + t) * DM + g * 128 + ch) = wv; }
                __syncthreads();
            }
        }
    }
    GRID_BAR(2);

    if (IN(3)) {
        pg8::Gemm g{DM, DM, DM}; pg8::PlainSched S; S.to.init(M / 256, 4, F.G, (int)blockIdx.x); S.A = (const char*)AO; S.B = (const char*)Wout_t; S.tA = (size_t)256 * DM * 2; S.tB = (size_t)256 * DM * 2;
        pg8::EpiResid E{x, out, x1b, ssq1}; pg8::gemm_phase(F.lds, F.wave, g, S, E);
    }
    GRID_BAR(3);

    if (IN(4)) {
        pg8::Gemm g{DM, DM, DM}; pg8::PlainSched S; S.to.init(M / 256, 4, F.G, (int)blockIdx.x); S.A = (const char*)x1b; S.B = (const char*)Wq_t; S.tA = (size_t)256 * DM * 2; S.tB = (size_t)256 * DM * 2;
        pg8::EpiBf16 E{Qm, DM, ssq1, C2_MEM}; pg8::gemm_phase(F.lds, F.wave, g, S, E);
    }
    GRID_BAR(4);

    if (IN(5)) {
        pg8::Gemm g{DM, DM, 256}; pg8::MemAttnSched S; S.to.init(M / 256, 4, F.G, (int)blockIdx.x); S.A = (const char*)Qm; S.B = (const char*)Km; S.bB = (size_t)256 * DM * 2; S.hB = 512;
        pg8::EpiSoftmax E{Sc, (LAS float*)(F.lds + LDS_MISC + 1024)}; pg8::gemm_phase(F.lds, F.wave, g, S, E);
    }
    GRID_BAR(5);

    if (IN(7)) {
        pg8::Gemm g{DM, MROWS, 256}; pg8::MemAttnSched S; S.to.init(M / 256, 4, F.G, (int)blockIdx.x); S.A = (const char*)Sc; S.B = (const char*)Vt; S.bB = 512; S.hB = (size_t)256 * MROWS * 2;
        pg8::EpiBf16 E{Om, DM, nullptr, 1.f}; pg8::gemm_phase(F.lds, F.wave, g, S, E);
    }
    GRID_BAR(7);

    if (IN(8)) {
        pg8::Gemm g{DM, DM, DM}; pg8::PlainSched S; S.to.init(M / 256, 4, F.G, (int)blockIdx.x); S.A = (const char*)Om; S.B = (const char*)Wo_t; S.tA = (size_t)256 * DM * 2; S.tB = (size_t)256 * DM * 2;
        pg8::EpiResid E{out, out, x2b, ssq2}; pg8::gemm_phase(F.lds, F.wave, g, S, E);
    }
    GRID_BAR(8);

    if (IN(9)) {
        pg8::Gemm g{DM, DM, DM}; pg8::PlainSched S; S.to.init(M / 256, 1, F.G, (int)blockIdx.x); S.A = (const char*)x2b; S.B = (const char*)Wr_t; S.tA = (size_t)256 * DM * 2; S.tB = 0;
        pg8::EpiRouter E{logit, ssq2, args.in[21], args.in[23]}; pg8::gemm_phase(F.lds, F.wave, g, S, E);
    }
    GRID_BAR(9);

    if (IN(10)) {
        const int lane_ = lane_id(), tid_ = F.wave * 64 + lane_; (void)tid_;
        LAS unsigned* lcnt = (LAS unsigned*)F.lds; LAS unsigned* lbase = lcnt + 32;
        for (int t0 = blockIdx.x * NTHR; t0 < M; t0 += F.G * NTHR) {
            if (tid_ < 32) lcnt[tid_] = 0u;
            __syncthreads();
            const int tok = t0 + tid_;
            const f32x4 lg = *(const f32x4*)(logit + (size_t)tok * 64);
            int gi = 0; float gm = lg[0];
#pragma unroll
            for (int j = 1; j < 4; ++j) if (lg[j] > gm) { gm = lg[j]; gi = j; }
            float gs = 0.f;
#pragma unroll
            for (int j = 0; j < 4; ++j) gs += __expf(lg[j] - gm);
            const float gate = 1.0f / gs;
            const f32x4 ea = *(const f32x4*)(logit + (size_t)tok * 64 + 4 + gi * 8), eb = *(const f32x4*)(logit + (size_t)tok * 64 + 8 + gi * 8);
            const float el[8] = {ea[0], ea[1], ea[2], ea[3], eb[0], eb[1], eb[2], eb[3]};
            int i0 = 0; float m0 = el[0];
#pragma unroll
            for (int j = 1; j < 8; ++j) if (el[j] > m0) { m0 = el[j]; i0 = j; }
            int i1 = -1; float m1 = -__builtin_inff();
#pragma unroll
            for (int j = 0; j < 8; ++j) if (j != i0 && el[j] > m1) { m1 = el[j]; i1 = j; }
            if (i1 < 0) i1 = (i0 == 0) ? 1 : 0;
            const float r = __expf(m1 - m0);
            const float w0 = gate / (1.0f + r), w1 = gate * r / (1.0f + r);
            const int e0 = gi * 8 + i0, e1 = gi * 8 + i1;
            const unsigned r0 = atomicAdd((unsigned*)&lcnt[e0], 1u), r1 = atomicAdd((unsigned*)&lcnt[e1], 1u);
            __syncthreads();
            if (tid_ < 32) lbase[tid_] = atomicAdd(ctl + CW_CNT + tid_, lcnt[tid_]);
            __syncthreads();
            tok_e[tok * 2] = e0; tok_e[tok * 2 + 1] = e1; tok_w[tok * 2] = w0; tok_w[tok * 2 + 1] = w1;
            tok_s[tok * 2] = (int)(lbase[e0] + r0); tok_s[tok * 2 + 1] = (int)(lbase[e1] + r1);
            __syncthreads();
        }
    }
    GRID_BAR(10);

    if (IN(11)) {
        const int lane_ = lane_id(), tid_ = F.wave * 64 + lane_; (void)tid_;
        LAS unsigned* lps = (LAS unsigned*)F.lds;
        if (tid_ == 0) { unsigned acc = 0; for (int e = 0; e < 32; ++e) { lps[e] = acc; const unsigned c = ld_u32_agent(ctl + CW_CNT + e); acc += (c + 255u) & ~255u; } lps[32] = acc; }
        __syncthreads();
        if (blockIdx.x == 0) {
            if (tid_ < 32) { const unsigned s = lps[tid_], e2 = lps[tid_ + 1], c = ld_u32_agent(ctl + CW_CNT + tid_);
                for (unsigned b = s >> 8; b < (e2 >> 8); ++b) ctl[CW_BLKE + b] = (unsigned)tid_;
                for (unsigned r = s + c; r < e2; ++r) row_tok[r] = 0; }
            if (tid_ == 0) ctl[CW_NBLK] = lps[32] >> 8;
        }
        for (int a = blockIdx.x * NTHR + tid_; a < M * 2; a += F.G * NTHR) { const int e = tok_e[a]; const int pos = (int)lps[e] + tok_s[a]; row_tok[pos] = a >> 1; tok_s[a] = pos; }
        __syncthreads();
    }
    GRID_BAR(11);

    if (IN(12)) {
        const int nblk = (int)__builtin_amdgcn_readfirstlane(ld_u32_agent(ctl + CW_NBLK));
        pg8::Gemm g{DM, DM, DM}; pg8::MoeSched S{F.G, F.vcu, nblk, ctl + CW_BLKE, (const char*)x2b, (const char*)Wgu_t, (size_t)0, (size_t)1024 * DM * 2, (size_t)256 * DM * 2, row_tok};
        pg8::EpiGateUp E{act, ssq2, row_tok}; pg8::gemm_phase<pg8::EpiGateUp, pg8::MoeSched, true>(F.lds, F.wave, g, S, E);
    }
    GRID_BAR(12);

    if (IN(13)) {
        const int nblk = (int)__builtin_amdgcn_readfirstlane(ld_u32_agent(ctl + CW_NBLK));
        pg8::Gemm g{DEXP, DEXP, DEXP}; pg8::MoeSched S{F.G, F.vcu, nblk, ctl + CW_BLKE, (const char*)act, (const char*)Wd_t, (size_t)256 * DEXP * 2, (size_t)1024 * DEXP * 2, (size_t)256 * DEXP * 2, row_tok};
        pg8::EpiBf16 E{yb, DM, nullptr, 1.f}; pg8::gemm_phase(F.lds, F.wave, g, S, E);
    }
    GRID_BAR(13);

    if (IN(14)) {
        const int lane_ = lane_id(), tid_ = F.wave * 64 + lane_; (void)tid_;
        for (int m = gw; m < M; m += NGW) {
            const int p0 = tok_s[m * 2], p1 = tok_s[m * 2 + 1]; const float w0 = tok_w[m * 2], w1 = tok_w[m * 2 + 1];
            f32x4* xr = (f32x4*)(out + (size_t)m * DM) + lane_; const u32x2* y0 = (const u32x2*)(yb + (size_t)p0 * DM) + lane_; const u32x2* y1 = (const u32x2*)(yb + (size_t)p1 * DM) + lane_;
            const f32x4* gr = (const f32x4*)args.in[27] + lane_;
            f32x4 v[4]; float s = 0.f;
#pragma unroll
            for (int j = 0; j < 4; ++j) { v[j] = xr[64 * j]; const u32x2 a = y0[64 * j], b = y1[64 * j];
                v[j].x += w0 * bf_lo(a.x) + w1 * bf_lo(b.x); v[j].y += w0 * bf_hi(a.x) + w1 * bf_hi(b.x); v[j].z += w0 * bf_lo(a.y) + w1 * bf_lo(b.y); v[j].w += w0 * bf_hi(a.y) + w1 * bf_hi(b.y);
                s += (v[j].x * v[j].x + v[j].y * v[j].y) + (v[j].z * v[j].z + v[j].w * v[j].w); }
            const float rstd = __builtin_amdgcn_rsqf(wave_sum(s) * (1.f / DM) + RMS_EPS);
#pragma unroll
            for (int j = 0; j < 4; ++j) { const f32x4 gg = gr[64 * j]; xr[64 * j] = (f32x4){v[j].x * rstd * gg.x, v[j].y * rstd * gg.y, v[j].z * rstd * gg.z, v[j].w * rstd * gg.w}; }
        }
    }
#undef IN
#undef GRID_BAR
}

extern "C" void kernel_launch(void* const* d_in, const int* in_sizes, int n_in, void* d_out, int out_size, void* d_ws, size_t ws_size, hipStream_t stream) {
    static int grid = 0;
    if (grid == 0) {
        if (n_in != 28 || in_sizes[0] != M * DM || out_size != M * DM || ws_size < WS_END) { fprintf(stderr, "kernel_launch: unexpected shapes (n_in %d in0 %d out %d ws %zu)\n", n_in, n_in > 0 ? in_sizes[0] : -1, out_size, ws_size); grid = -1; return; }
        int dev = 0, cus = 0, per_cu = 0;
        if (hipGetDevice(&dev) != hipSuccess || hipDeviceGetAttribute(&cus, hipDeviceAttributeMultiprocessorCount, dev) != hipSuccess) { grid = -1; return; }
        if (hipFuncSetAttribute((const void*)mega, hipFuncAttributeMaxDynamicSharedMemorySize, LDS_BYTES) != hipSuccess) { fprintf(stderr, "kernel_launch: hipFuncSetAttribute failed\n"); grid = -1; return; }
        if (hipOccupancyMaxActiveBlocksPerMultiprocessor(&per_cu, (const void*)mega, NTHR, LDS_BYTES) != hipSuccess || per_cu < 1) { fprintf(stderr, "kernel_launch: occupancy query says %d\n", per_cu); per_cu = 1; }
        (void)hipGetLastError();
        grid = cus;
    }
    if (grid < 0) return;
    (void)hipMemsetAsync((char*)d_ws + WS_CTL, 0, CTL_BYTES, stream);
    Args a{};
    for (int i = 0; i < 28; ++i) a.in[i] = (const float*)d_in[i];
    a.out = (float*)d_out; a.ws = (unsigned char*)d_ws;
#if MK_ONE_LAUNCH
    a.ph_lo = 0; a.ph_hi = N_PHASES;
    void* kargs[] = {&a};
    hipError_t e = hipLaunchCooperativeKernel((const void*)mega, dim3(grid), dim3(NTHR), kargs, LDS_BYTES, stream);
    if (e != hipSuccess) fprintf(stderr, "cooperative launch failed: %s (grid %d)\n", hipGetErrorString(e), grid);
#else
    for (int p = 0; p < N_PHASES; ++p) { a.ph_lo = p; a.ph_hi = p + 1; hipLaunchKernelGGL(mega, dim3(grid), dim3(NTHR), LDS_BYTES, stream, a); }
#endif
}
```

```cpp
#include <hip/hip_runtime.h>
#include <hip/hip_cooperative_groups.h>
#include <cstdio>
#include <cstdint>
namespace cg = cooperative_groups;

#ifndef PROBE_DUP
#define PROBE_DUP -1
#endif
#ifndef PROBE_DUP_ATTN
#define PROBE_DUP_ATTN 1
#endif
#ifndef MK_ONE_LAUNCH
#define MK_ONE_LAUNCH 1
#endif

#define LAS __attribute__((address_space(3)))
#define GAS __attribute__((address_space(1)))
typedef unsigned short bf16_t;
typedef short bf16x8 __attribute__((ext_vector_type(8)));
typedef short s16x4 __attribute__((ext_vector_type(4)));
typedef float f32x2 __attribute__((ext_vector_type(2)));
typedef float f32x4 __attribute__((ext_vector_type(4)));
typedef float f32x16 __attribute__((ext_vector_type(16)));
typedef unsigned u32x2 __attribute__((ext_vector_type(2)));
typedef unsigned u32x4 __attribute__((ext_vector_type(4)));

constexpr int NB = 8, SEQ = 8192, DM = 1024, M = NB * SEQ;
constexpr int ZP = 2560;
constexpr int ZU = 0, ZV = 512, ZQ = 1024, ZK = 1536, ZVAL = 2048;
constexpr int MEML = 256, MROWS = NB * MEML;
constexpr int NEXP = 32, DEXP = 512;
constexpr int PROWS = 2 * M + NEXP * 256;
constexpr int MAXBLK = PROWS / 256;
constexpr float RMS_EPS = 1e-6f, LN_EPS = 1e-5f;
constexpr float LOG2E = 1.4426950408889634f;
constexpr float C2_DIFF = 0.125f * LOG2E;
constexpr float C2_MEM = 0.0625f * LOG2E;

constexpr size_t MiB = 1u << 20;
constexpr size_t WS_CTL = 0, CTL_BYTES = 1 * MiB;
constexpr size_t WS_WIN = 1 * MiB;
constexpr size_t WS_WOUT = 6 * MiB;
constexpr size_t WS_WQ = 8 * MiB;
constexpr size_t WS_WKV = 10 * MiB;
constexpr size_t WS_WO = 14 * MiB;
constexpr size_t WS_WR = 16 * MiB;
constexpr size_t WS_WSGU = 17 * MiB;
constexpr size_t WS_MEMN = 18 * MiB;
constexpr size_t WS_KM = 22 * MiB;
constexpr size_t WS_VT = 26 * MiB;
constexpr size_t WS_WGU = 30 * MiB;
constexpr size_t WS_WD = 94 * MiB;
constexpr size_t WS_RA = 128 * MiB;
constexpr size_t WS_RB = 448 * MiB;
constexpr size_t WS_RC = 592 * MiB;
constexpr size_t WS_SSQ1 = 720 * MiB;
constexpr size_t WS_SSQ2 = 724 * MiB;
constexpr size_t WS_LOGIT = 728 * MiB;
constexpr size_t WS_TOKE = 744 * MiB;
constexpr size_t WS_TOKW = 745 * MiB;
constexpr size_t WS_TOKS = 746 * MiB;
constexpr size_t WS_ROWTOK = 747 * MiB;
constexpr size_t WS_END = 752 * MiB;
constexpr int CW_CNT = 64;
constexpr int CW_NBLK = 128;
constexpr int CW_PSTART = 192;
constexpr int CW_BLKE = 256;
constexpr int CW_KMX = 1024;
constexpr int CW_BAR = 4096;
constexpr int LDS_MISC = 131072;

__device__ __forceinline__ unsigned cvt_pk_bf16(float lo, float hi) { unsigned r; asm volatile("v_cvt_pk_bf16_f32 %0, %1, %2" : "=v"(r) : "v"(lo), "v"(hi)); return r; }
__device__ __forceinline__ float bf_lo(unsigned w) { return __uint_as_float(w << 16); }
__device__ __forceinline__ float bf_hi(unsigned w) { return __uint_as_float(w & 0xffff0000u); }
__device__ __forceinline__ float wave_sum(float v) {
#pragma unroll
    for (int o = 1; o < 64; o <<= 1) v += __shfl_xor(v, o);
    return v;
}
__device__ __forceinline__ float wave_max(float v) {
#pragma unroll
    for (int o = 1; o < 64; o <<= 1) v = fmaxf(v, __shfl_xor(v, o));
    return v;
}
__device__ __forceinline__ int lane_id() { int l; asm volatile("v_mbcnt_lo_u32_b32 %0, -1, 0\n\tv_mbcnt_hi_u32_b32 %0, -1, %0" : "=v"(l)); return l; }
__device__ __forceinline__ unsigned ld_u32_agent(const unsigned* p) { return __hip_atomic_load(p, __ATOMIC_RELAXED, __HIP_MEMORY_SCOPE_AGENT); }

namespace pg8 {
constexpr int BM = 256, BK = 64, HALF = 128, HTB = HALF * BK * 2, STAGE_BYTES = 8 * HTB, NXCD = 8, WGM = 8;
__host__ __device__ __forceinline__ int lds_byte(int r, int c) { const int st = (r >> 4) * 2 + (c >> 5), rr = r & 15, cc = c & 31, ob = rr * 64 + cc * 2; return st * 1024 + (ob ^ (((ob >> 9) & 1) << 5)); }
__host__ __device__ __forceinline__ void stage_rc(int b, int& R, int& C) { const int st = b / 1024, sb = b % 1024, swz = sb ^ (((sb >> 9) & 1) << 5); R = (st >> 1) * 16 + swz / 64; C = (st & 1) * 32 + (swz % 64) / 2; }
__host__ __device__ __forceinline__ int perm32(int rho) { const int n = rho >> 4, i = rho & 15; return 8 * (i >> 2) + 4 * n + (i & 3); }

struct Unit { const char* A; const char* B; int pm, pn, aux; const int* rows; };
struct Gemm { int lda, ldb, K; };

struct TileOrder {
    int nM, nN, nwg, G, c;
    __device__ void init(int nM_, int nN_, int G_, int c_) { nM = nM_; nN = nN_; nwg = nM * nN; G = G_; c = c_; }
    __device__ bool get(int i, int& pm, int& pn) const {
        const long L = (long)i * G + c; if (L >= nwg) return false;
        int wgid = (int)L; { const int q = nwg / NXCD, r = nwg % NXCD, xcd = wgid % NXCD, off = wgid / NXCD; wgid = (xcd < r ? xcd * (q + 1) : r * (q + 1) + (xcd - r) * q) + off; }
        const int nig = WGM * nN, gid = wgid / nig, fm = gid * WGM, gsz = (nM - fm) < WGM ? (nM - fm) : WGM;
        pm = fm + ((wgid % nig) % gsz); pn = (wgid % nig) / gsz; return true;
    }
};

typedef float f32x2g __attribute__((ext_vector_type(2)));
__device__ __forceinline__ f32x2g gelu_pk(f32x2g v) {
    const f32x2g av = __builtin_elementwise_abs(v), d = av * 0.2316418882f + 1.0f;
    f32x2g t; t.x = __builtin_amdgcn_rcpf(d.x); t.y = __builtin_amdgcn_rcpf(d.y);
    f32x2g q = t * 0.5307027145f + (-0.7265760135f); q = q * t + 0.7107068705f; q = q * t + (-0.142248368f); q = q * t + 0.127414796f; q = q * t;
    const f32x2g s = (v * v) * (-0.72134752044f);
    f32x2g e; e.x = __builtin_amdgcn_exp2f(s.x); e.y = __builtin_amdgcn_exp2f(s.y);
    const f32x2g m = v * (q * e), r = v - m;
    f32x2g o; o.x = v.x < 0.f ? m.x : r.x; o.y = v.y < 0.f ? m.y : r.y; return o;
}

template <class Epi, class Sched, bool GATHER = false>
__device__ __forceinline__ void gemm_phase(LAS unsigned char* lds, int wid, const Gemm g, const Sched& S, const Epi& E) {
    const int lane = lane_id(), tid = wid * 64 + lane, wr = wid >> 2, wc = wid & 3, fr = lane & 15, fq = lane >> 4;
    const int nt = g.K / BK;
    unsigned voffB[2]; unsigned vA0[2], vA1[2]; int RA[2], CA[2];
#pragma unroll
    for (int i = 0; i < 2; ++i) { int R, C; stage_rc(tid * 16 + i * 8192, R, C); const int Rb = Epi::PERM ? ((R & ~31) + perm32(R & 31)) : R;
        RA[i] = R; CA[i] = C; voffB[i] = (unsigned)(Rb * g.ldb + C) * 2u;
        vA0[i] = (unsigned)(R * g.lda + C) * 2u; vA1[i] = vA0[i]; }
    const size_t kstep = (size_t)(BK * 2);
    const size_t hstepA = GATHER ? (size_t)0 : (size_t)HALF * g.lda * 2, hstepB = (size_t)HALF * g.ldb * 2;
    LAS u32x4* park = (LAS u32x4*)(lds + 131072 + 1024) + tid;
#define PG8_GOFF(U, d0, d1) do { _Pragma("unroll") for (int _i = 0; _i < 2; ++_i) { \
        d0[_i] = ((unsigned)(U).rows[RA[_i]] * (unsigned)g.lda + (unsigned)CA[_i]) * 2u; d1[_i] = ((unsigned)(U).rows[HALF + RA[_i]] * (unsigned)g.lda + (unsigned)CA[_i]) * 2u; } } while (0)
    const unsigned ldsw = (unsigned)wid * 1024u;
    const int aoff = lds_byte(wr * 64 + fr, fq * 8), boff = lds_byte(wc * 32 + fr, fq * 8);
#define PG8_SA(b, h) (((b) * 2 + (h)) * HTB)
#define PG8_SB(b, h) ((4 + (b) * 2 + (h)) * HTB)
#define PG8_STAGE(bufoff, gbase, voff) do { _Pragma("unroll") for (int _i = 0; _i < 2; ++_i) \
        __builtin_amdgcn_global_load_lds((const unsigned*)((const char*)(gbase) + (voff)[_i]), (LAS unsigned*)(lds + (bufoff) + ldsw + _i * 8192), 16, 0, 0); } while (0)
#define PG8_LDA(dst, b, h) do { _Pragma("unroll") for (int m = 0; m < 4; ++m) _Pragma("unroll") for (int k = 0; k < 2; ++k) dst[m][k] = *(const LAS bf16x8*)(lds + PG8_SA(b, h) + aoff + m * 2048 + k * 1024); } while (0)
#define PG8_LDB(dst, b, h) do { _Pragma("unroll") for (int n = 0; n < 2; ++n) _Pragma("unroll") for (int k = 0; k < 2; ++k) dst[n][k] = *(const LAS bf16x8*)(lds + PG8_SB(b, h) + boff + n * 2048 + k * 1024); } while (0)
#define PG8_MMA(ai, bj, At, Bt) do { __builtin_amdgcn_s_setprio(1); _Pragma("unroll") for (int m = 0; m < 4; ++m) _Pragma("unroll") for (int n = 0; n < 2; ++n) _Pragma("unroll") for (int k = 0; k < 2; ++k) \
        acc[ai][bj][m][n] = __builtin_amdgcn_mfma_f32_16x16x32_bf16(Bt[n][k], At[m][k], acc[ai][bj][m][n], 0, 0, 0); __builtin_amdgcn_s_setprio(0); } while (0)
#define PG8_WAIT_V(n) asm volatile("s_waitcnt vmcnt(" #n ")" ::: "memory")
#define PG8_WAIT_L(n) asm volatile("s_waitcnt lgkmcnt(" #n ")" ::: "memory")
#define PG8_BAR __builtin_amdgcn_s_barrier()
#define PG8_SCHED __builtin_amdgcn_sched_barrier(0)
    Unit cur, nxt; int ui = 0;
    if (!S.next(0, cur)) return;
    f32x4 acc[2][2][4][2];
#pragma unroll
    for (int a = 0; a < 2; ++a)
#pragma unroll
        for (int b = 0; b < 2; ++b)
#pragma unroll
            for (int m = 0; m < 4; ++m)
#pragma unroll
                for (int n = 0; n < 2; ++n) acc[a][b][m][n] = (f32x4){0.f, 0.f, 0.f, 0.f};
    bf16x8 At[4][2], B0[2][2], B1[2][2];
    const char* cA = cur.A; const char* cB = cur.B;
    if constexpr (GATHER) { PG8_GOFF(cur, vA0, vA1); }
    PG8_STAGE(PG8_SB(0, 0), cB, voffB); PG8_STAGE(PG8_SB(0, 1), cB + hstepB, voffB); PG8_STAGE(PG8_SA(0, 0), cA, vA0); PG8_STAGE(PG8_SA(0, 1), cA + hstepA, vA1);
    if (wr == 1) PG8_BAR;
    PG8_WAIT_V(2); PG8_BAR;
    PG8_STAGE(PG8_SB(1, 0), cB + kstep, voffB); PG8_STAGE(PG8_SA(1, 0), cA + kstep, vA0); PG8_STAGE(PG8_SB(1, 1), cB + hstepB + kstep, voffB);
    PG8_WAIT_V(6); PG8_BAR;
    for (;;) {
        const bool has_next = S.next(ui + 1, nxt);
        const char* nA = has_next ? nxt.A : cA; const char* nB = has_next ? nxt.B : cB;
        if constexpr (GATHER) { unsigned n0[2] = {vA0[0], vA0[1]}, n1[2] = {vA1[0], vA1[1]}; if (has_next) { PG8_GOFF(nxt, n0, n1); } *park = (u32x4){n0[0], n0[1], n1[0], n1[1]}; }
        for (int t = 0; t < nt; t += 2) {
            const bool last = (t == nt - 2);
            const char* a1 = cA + (size_t)(t + 1) * kstep;
            const char* a2 = last ? nA : cA + (size_t)(t + 2) * kstep; const char* b2 = last ? nB : cB + (size_t)(t + 2) * kstep;
            const char* a3 = a2 + kstep; const char* b3 = b2 + kstep;
            unsigned w0[2] = {vA0[0], vA0[1]}, w1[2] = {vA1[0], vA1[1]};
            if constexpr (GATHER) { if (last) { const u32x4 pk = *park; w0[0] = pk.x; w0[1] = pk.y; w1[0] = pk.z; w1[1] = pk.w; } }
            PG8_LDB(B0, 0, 0); PG8_LDB(B1, 0, 1); PG8_SCHED; PG8_LDA(At, 0, 0); PG8_STAGE(PG8_SA(1, 1), a1 + hstepA, vA1);
            PG8_WAIT_V(8); PG8_WAIT_L(0); PG8_BAR; PG8_MMA(0, 0, At, B0); PG8_MMA(0, 1, At, B1); PG8_BAR; PG8_SCHED;
            PG8_LDA(At, 0, 1); PG8_STAGE(PG8_SB(0, 0), b2, voffB); PG8_STAGE(PG8_SB(0, 1), b2 + hstepB, voffB); PG8_STAGE(PG8_SA(0, 0), a2, w0);
            PG8_WAIT_V(8); PG8_WAIT_L(0); PG8_BAR; PG8_MMA(1, 0, At, B0); PG8_MMA(1, 1, At, B1); PG8_BAR; PG8_SCHED;
            PG8_LDB(B0, 1, 0); PG8_LDB(B1, 1, 1); PG8_SCHED; PG8_LDA(At, 1, 0); PG8_STAGE(PG8_SA(0, 1), a2 + hstepA, w1);
            PG8_WAIT_V(8); PG8_WAIT_L(0); PG8_BAR; PG8_MMA(0, 0, At, B0); PG8_MMA(0, 1, At, B1); PG8_BAR; PG8_SCHED;
            PG8_LDA(At, 1, 1); PG8_STAGE(PG8_SB(1, 0), b3, voffB); PG8_STAGE(PG8_SB(1, 1), b3 + hstepB, voffB); PG8_STAGE(PG8_SA(1, 0), a3, w0);
            PG8_WAIT_V(8); PG8_WAIT_L(0); PG8_BAR; PG8_MMA(1, 0, At, B0); PG8_MMA(1, 1, At, B1); PG8_BAR; PG8_SCHED;
        }
        if (wr == 0) PG8_BAR;
        E(acc, cur, wr, wc, fr, fq);
        if (!has_next) break;
#pragma unroll
        for (int a = 0; a < 2; ++a)
#pragma unroll
            for (int b = 0; b < 2; ++b)
#pragma unroll
                for (int m = 0; m < 4; ++m)
#pragma unroll
                    for (int n = 0; n < 2; ++n) acc[a][b][m][n] = (f32x4){0.f, 0.f, 0.f, 0.f};
        cur = nxt; cA = nA; cB = nB; ++ui;
        if constexpr (GATHER) { const u32x4 pk = *park; vA0[0] = pk.x; vA0[1] = pk.y; vA1[0] = pk.z; vA1[1] = pk.w; }
        if (wr == 1) PG8_BAR;
    }
    PG8_WAIT_V(0);
    PG8_BAR;
#undef PG8_GOFF
#undef PG8_SA
#undef PG8_SB
#undef PG8_STAGE
#undef PG8_LDA
#undef PG8_LDB
#undef PG8_MMA
#undef PG8_WAIT_V
#undef PG8_WAIT_L
#undef PG8_BAR
#undef PG8_SCHED
}

struct PlainSched {
    TileOrder to; const char* A; const char* B; size_t tA, tB;
    __device__ __forceinline__ bool next(int i, Unit& u) const { int pm, pn; if (!to.get(i, pm, pn)) return false; u.pm = pm; u.pn = pn; u.aux = 0; u.rows = nullptr; u.A = A + (size_t)pm * tA; u.B = B + (size_t)pn * tB; return true; }
};
struct MemAttnSched {
    TileOrder to; const char* A; const char* B; size_t bB, hB;
    __device__ __forceinline__ bool next(int i, Unit& u) const { int pm, pn; if (!to.get(i, pm, pn)) return false; u.pm = pm; u.pn = pn; u.aux = 0; u.rows = nullptr;
        u.A = A + (size_t)pm * (256 * DM * 2) + (size_t)pn * 512; const int b = pm >> 5; u.B = B + (size_t)b * bB + (size_t)pn * hB; return true; }
};
struct MoeSched {
    int G, c, nblk; const unsigned* blk_e; const char* A; const char* B; size_t tA, eB, tB; const int* row_tok;
    __device__ __forceinline__ bool next(int i, Unit& u) const { const int L = i * G + c; if (L >= nblk * 4) return false; const int rb = L >> 2, pn = L & 3;
        const int e = (int)__builtin_amdgcn_readfirstlane(ld_u32_agent(blk_e + rb)); u.pm = rb; u.pn = pn; u.aux = e; u.rows = row_tok + (size_t)rb * 256;
        u.A = A + (size_t)rb * tA; u.B = B + (size_t)e * eB + (size_t)pn * tB; return true; }
};

#define EPI_ARGS f32x4 (&acc)[2][2][4][2], const Unit& u, int wr, int wc, int fr, int fq
struct EpiZ {
    static constexpr bool PERM = true;
    bf16_t* O; unsigned* kmx;
    __device__ __forceinline__ void operator()(EPI_ARGS) const {
        const int row0 = u.pm * BM + wr * 64 + fr, col0 = u.pn * BM + wc * 32 + 8 * fq;
        const int mode = u.pn < 4 ? 1 : (u.pn < 6 ? 2 : 0);
        if (u.pn == 6 || u.pn == 7) {
#pragma unroll
            for (int bj = 0; bj < 2; ++bj) { float mx = 0.f;
#pragma unroll
                for (int ai = 0; ai < 2; ++ai)
#pragma unroll
                    for (int m = 0; m < 4; ++m) { const f32x4 a = acc[ai][bj][m][0], b = acc[ai][bj][m][1];
                        float q = (a[0] * a[0] + a[1] * a[1]) + (a[2] * a[2] + a[3] * a[3]) + (b[0] * b[0] + b[1] * b[1]) + (b[2] * b[2] + b[3] * b[3]);
                        q += __shfl_xor(q, 16); q += __shfl_xor(q, 32); mx = fmaxf(mx, q); }
#pragma unroll
                for (int o_ = 1; o_ < 16; o_ <<= 1) mx = fmaxf(mx, __shfl_xor(mx, o_));
                if (fr == 0 && fq == 0) { const int b_ = u.pm >> 5, h_ = (u.pn - 6) * 2 + bj; atomicMax(kmx + (((b_ * 4 + h_) * 2 + (wc >> 1)) * 2 + (wc & 1)), __float_as_uint(mx)); } }
        }
#pragma unroll
        for (int ai = 0; ai < 2; ++ai)
#pragma unroll
            for (int m = 0; m < 4; ++m) { bf16_t* rowp = O + (size_t)(row0 + ai * HALF + m * 16) * ZP + col0;
#pragma unroll
                for (int bj = 0; bj < 2; ++bj) { f32x4 v0 = acc[ai][bj][m][0], v1 = acc[ai][bj][m][1];
                    if (mode == 1) { f32x2g a = gelu_pk((f32x2g){v0[0], v0[1]}), b = gelu_pk((f32x2g){v0[2], v0[3]}), c = gelu_pk((f32x2g){v1[0], v1[1]}), d = gelu_pk((f32x2g){v1[2], v1[3]});
                        v0 = (f32x4){a.x, a.y, b.x, b.y}; v1 = (f32x4){c.x, c.y, d.x, d.y}; }
                    else if (mode == 2) { v0 = v0 * C2_DIFF; v1 = v1 * C2_DIFF; }
                    u32x4 w; w.x = cvt_pk_bf16(v0[0], v0[1]); w.y = cvt_pk_bf16(v0[2], v0[3]); w.z = cvt_pk_bf16(v1[0], v1[1]); w.w = cvt_pk_bf16(v1[2], v1[3]);
                    *(u32x4*)(rowp + bj * HALF) = w; } }
    }
};
struct EpiBf16 {
    static constexpr bool PERM = true;
    bf16_t* O; int ldc; const float* ssq; float cscale;
    __device__ __forceinline__ void operator()(EPI_ARGS) const {
        const int row0 = u.pm * BM + wr * 64 + fr, col0 = u.pn * BM + wc * 32 + 8 * fq;
#pragma unroll
        for (int ai = 0; ai < 2; ++ai)
#pragma unroll
            for (int m = 0; m < 4; ++m) { const int row = row0 + ai * HALF + m * 16; float sc = cscale;
                if (ssq) { const f32x4* sp = (const f32x4*)(ssq + (size_t)row * 16); const f32x4 s4 = (sp[0] + sp[1]) + (sp[2] + sp[3]);
                    sc *= __builtin_amdgcn_rsqf(((s4[0] + s4[1]) + (s4[2] + s4[3])) * (1.0f / DM) + RMS_EPS); }
                bf16_t* rowp = O + (size_t)row * ldc + col0;
#pragma unroll
                for (int bj = 0; bj < 2; ++bj) { const f32x4 v0 = acc[ai][bj][m][0] * sc, v1 = acc[ai][bj][m][1] * sc;
                    u32x4 w; w.x = cvt_pk_bf16(v0[0], v0[1]); w.y = cvt_pk_bf16(v0[2], v0[3]); w.z = cvt_pk_bf16(v1[0], v1[1]); w.w = cvt_pk_bf16(v1[2], v1[3]);
                    *(u32x4*)(rowp + bj * HALF) = w; } }
    }
};
struct EpiSoftmax {
    static constexpr bool PERM = true;
    bf16_t* O; LAS float* xch;
    __device__ __forceinline__ void operator()(EPI_ARGS) const {
        const int row0 = u.pm * BM + wr * 64 + fr, col0 = u.pn * BM + wc * 32 + 8 * fq;
        LAS float* xm = xch; LAS float* xs = xch + 1024;
#pragma unroll
        for (int ai = 0; ai < 2; ++ai)
#pragma unroll
            for (int m = 0; m < 4; ++m) { float v = -__builtin_inff();
#pragma unroll
                for (int bj = 0; bj < 2; ++bj)
#pragma unroll
                    for (int n = 0; n < 2; ++n) { const f32x4 a = acc[ai][bj][m][n]; v = fmaxf(v, fmaxf(fmaxf(a[0], a[1]), fmaxf(a[2], a[3]))); }
                v = fmaxf(v, __shfl_xor(v, 16)); v = fmaxf(v, __shfl_xor(v, 32));
                if (fq == 0) xm[(ai * HALF + wr * 64 + m * 16 + fr) * 4 + wc] = v; }
        asm volatile("s_waitcnt lgkmcnt(0)" ::: "memory"); __builtin_amdgcn_s_barrier(); asm volatile("" ::: "memory");
#pragma unroll
        for (int ai = 0; ai < 2; ++ai)
#pragma unroll
            for (int m = 0; m < 4; ++m) { const f32x4 t = *(const LAS f32x4*)(xm + (ai * HALF + wr * 64 + m * 16 + fr) * 4); const float mx = fmaxf(fmaxf(t[0], t[1]), fmaxf(t[2], t[3])); float sm = 0.f;
#pragma unroll
                for (int bj = 0; bj < 2; ++bj)
#pragma unroll
                    for (int n = 0; n < 2; ++n) { f32x4 a = acc[ai][bj][m][n];
#pragma unroll
                        for (int j = 0; j < 4; ++j) { a[j] = __builtin_amdgcn_exp2f(a[j] - mx); sm += a[j]; }
                        acc[ai][bj][m][n] = a; }
                sm += __shfl_xor(sm, 16); sm += __shfl_xor(sm, 32);
                if (fq == 0) xs[(ai * HALF + wr * 64 + m * 16 + fr) * 4 + wc] = sm; }
        asm volatile("s_waitcnt lgkmcnt(0)" ::: "memory"); __builtin_amdgcn_s_barrier(); asm volatile("" ::: "memory");
#pragma unroll
        for (int ai = 0; ai < 2; ++ai)
#pragma unroll
            for (int m = 0; m < 4; ++m) { const f32x4 t = *(const LAS f32x4*)(xs + (ai * HALF + wr * 64 + m * 16 + fr) * 4); const float inv = __builtin_amdgcn_rcpf((t[0] + t[1]) + (t[2] + t[3]));
                bf16_t* rowp = O + (size_t)(row0 + ai * HALF + m * 16) * DM + col0;
#pragma unroll
                for (int bj = 0; bj < 2; ++bj) { const f32x4 v0 = acc[ai][bj][m][0] * inv, v1 = acc[ai][bj][m][1] * inv;
                    u32x4 w; w.x = cvt_pk_bf16(v0[0], v0[1]); w.y = cvt_pk_bf16(v0[2], v0[3]); w.z = cvt_pk_bf16(v1[0], v1[1]); w.w = cvt_pk_bf16(v1[2], v1[3]);
                    *(u32x4*)(rowp + bj * HALF) = w; } }
    }
};
struct EpiResid {
    static constexpr bool PERM = false;
    const float* base; float* out; bf16_t* ob; float* ssq;
    __device__ __forceinline__ void operator()(EPI_ARGS) const {
        const int row0 = u.pm * BM + wr * 64 + fr, col0 = u.pn * BM + wc * 32 + 4 * fq;
#pragma unroll
        for (int ai = 0; ai < 2; ++ai)
#pragma unroll
            for (int m = 0; m < 4; ++m) { const int row = row0 + ai * HALF + m * 16; const size_t off = (size_t)row * DM + col0; float s = 0.f;
#pragma unroll
                for (int bj = 0; bj < 2; ++bj)
#pragma unroll
                    for (int n = 0; n < 2; ++n) { const f32x4 bs = *(const f32x4*)(base + off + bj * HALF + n * 16); const f32x4 o = bs + acc[ai][bj][m][n];
                        *(f32x4*)(out + off + bj * HALF + n * 16) = o; s += (o[0] * o[0] + o[1] * o[1]) + (o[2] * o[2] + o[3] * o[3]);
                        u32x2 w; w.x = cvt_pk_bf16(o[0], o[1]); w.y = cvt_pk_bf16(o[2], o[3]); *(u32x2*)(ob + off + bj * HALF + n * 16) = w; }
                s += __shfl_xor(s, 16); s += __shfl_xor(s, 32);
                if (fq == 0) ssq[(size_t)row * 16 + u.pn * 4 + wc] = s; }
    }
};
struct EpiRouter {
    static constexpr bool PERM = false;
    float* L; const float* ssq; const float* bg; const float* be; float* rstd_out;
    __device__ __forceinline__ void operator()(EPI_ARGS) const {
        if (wc >= 2) return;
        const int row0 = u.pm * BM + wr * 64 + fr;
#pragma unroll
        for (int ai = 0; ai < 2; ++ai)
#pragma unroll
            for (int m = 0; m < 4; ++m) { const int row = row0 + ai * HALF + m * 16;
                const f32x4* sp = (const f32x4*)(ssq + (size_t)row * 16); const f32x4 s4 = (sp[0] + sp[1]) + (sp[2] + sp[3]);
                const float rs = __builtin_amdgcn_rsqf(((s4[0] + s4[1]) + (s4[2] + s4[3])) * (1.0f / DM) + RMS_EPS);
                if (wc == 0 && fq == 0) rstd_out[row] = rs;
#pragma unroll
                for (int n = 0; n < 2; ++n) { const int c0 = wc * 32 + n * 16 + 4 * fq; f32x4 o = acc[ai][0][m][n] * rs;
#pragma unroll
                    for (int j = 0; j < 4; ++j) { const int c = c0 + j; const float b = c < 4 ? bg[c] : (c < 36 ? be[c - 4] : 0.f); o[j] += b; }
                    *(f32x4*)(L + (size_t)row * 64 + c0) = o; } }
    }
};
struct EpiGateUp {
    static constexpr bool PERM = true;
    bf16_t* act; const float* rstd; const int* row_tok;
    __device__ __forceinline__ void operator()(EPI_ARGS) const {
        const int row0 = u.pm * BM + wr * 64 + fr, col0 = u.pn * 128 + wc * 32 + 8 * fq;
#pragma unroll
        for (int ai = 0; ai < 2; ++ai)
#pragma unroll
            for (int m = 0; m < 4; ++m) { const int row = row0 + ai * HALF + m * 16; const float rs = rstd[row_tok[row]];
                float r[8];
#pragma unroll
                for (int n = 0; n < 2; ++n)
#pragma unroll
                    for (int j = 0; j < 4; ++j) { const float gg = acc[ai][0][m][n][j] * rs, uu = acc[ai][1][m][n][j] * rs;
                        r[n * 4 + j] = gg * __builtin_amdgcn_rcpf(1.0f + __builtin_amdgcn_exp2f(-gg * LOG2E)) * uu; }
                u32x4 w; w.x = cvt_pk_bf16(r[0], r[1]); w.y = cvt_pk_bf16(r[2], r[3]); w.z = cvt_pk_bf16(r[4], r[5]); w.w = cvt_pk_bf16(r[6], r[7]);
                *(u32x4*)(act + (size_t)row * DEXP + col0) = w; }
    }
};
}

namespace da {
constexpr int NW = 8, QBLK = 32, KVBLK = 64, QB = NW * QBLK, DV = 128;
constexpr int SHM_V = KVBLK * DV * 2, SHM_K = KVBLK * 64 * 2;
constexpr int LDS_V = 0, LDS_K = 2 * SHM_V, LDS_WS = LDS_K + 2 * SHM_K, LDS_CX = LDS_WS + NW * 64 * 4, LDS_STASH = LDS_CX + 256, LDS_BYTES = LDS_STASH + NW * 8192;
constexpr float SKIP_MARGIN = 64.f;
constexpr float THR = 8.f;
#define SBAR() __builtin_amdgcn_sched_barrier(0)
__device__ __forceinline__ int kswz(int row, int chunk) { return row * 128 + ((chunk ^ ((row >> 1) & 7)) << 4); }
__device__ __forceinline__ int v_st(int k, int c) { const int kk = (k & ~0xC) | ((k & 4) << 1) | ((k & 8) >> 1); return ((kk >> 3) * 4 + (c >> 5)) * 512 + ((kk & 7) * 32 + (c & 31)) * 2; }
__device__ __forceinline__ int v_rd_base(int lane) { return ((lane & 3) << 3) | (((lane >> 2) & 3) << 6) | (((lane >> 4) & 1) << 5) | (((lane >> 5) & 1) << 8); }
constexpr int v_rd_off(int d0, int ks, int half) { return d0 * 512 + ks * 4096 + half * 2048; }
__device__ __forceinline__ int crow(int r, int hi) { return (r & 3) + 8 * (r >> 2) + 4 * hi; }
__device__ __forceinline__ bf16x8 load8(const bf16_t* p) { return *reinterpret_cast<const bf16x8*>(p); }

__device__ __forceinline__ void mask_tile(f32x16& p0, f32x16& p1, int dq) {
    const float NEG = -__builtin_inff();
#pragma unroll
    for (int r = 0; r < 16; ++r) { const int c = (r & 3) + 8 * (r >> 2); if (dq - c < 0) p0[r] = NEG; if (dq - c - 32 < 0) p1[r] = NEG; }
}
__device__ __forceinline__ void partialSM(f32x16& p0, f32x16& p1, float& m_reg, float& alpha) {
    float pmax = p0[0];
#pragma unroll
    for (int r = 1; r < 16; ++r) pmax = fmaxf(pmax, p0[r]);
#pragma unroll
    for (int r = 0; r < 16; ++r) pmax = fmaxf(pmax, p1[r]);
    { auto rr = __builtin_amdgcn_permlane32_swap(__float_as_uint(pmax), __float_as_uint(pmax), false, false); pmax = fmaxf(__uint_as_float(rr[0]), __uint_as_float(rr[1])); }
    float mn;
    if (__builtin_expect(__all((pmax - m_reg) <= THR), 1)) { mn = m_reg; alpha = 1.f; }
    else { mn = fmaxf(m_reg, pmax); alpha = __builtin_amdgcn_exp2f(m_reg - mn); m_reg = mn; }
#pragma unroll
    for (int r = 0; r < 16; ++r) p0[r] = p0[r] - mn;
#pragma unroll
    for (int r = 0; r < 16; ++r) p1[r] = p1[r] - mn;
#pragma unroll
    for (int r = 0; r < 16; ++r) p0[r] = __builtin_amdgcn_exp2f(p0[r]);
}
__device__ __forceinline__ void finishSM(f32x16& p0, f32x16& p1, float alpha, float& l_reg, bf16x8& pa0, bf16x8& pa1, bf16x8& pa2, bf16x8& pa3) {
#pragma unroll
    for (int r = 0; r < 16; ++r) p1[r] = __builtin_amdgcn_exp2f(p1[r]);
    float ps = 0;
#pragma unroll
    for (int r = 0; r < 16; ++r) ps += p0[r];
#pragma unroll
    for (int r = 0; r < 16; ++r) ps += p1[r];
    { auto rr = __builtin_amdgcn_permlane32_swap(__float_as_uint(ps), __float_as_uint(ps), false, false); ps = __uint_as_float(rr[0]) + __uint_as_float(rr[1]); }
    l_reg = l_reg * alpha + ps;
#define PK4(P, B_, OUT) do { unsigned a0 = cvt_pk_bf16(P[B_+0], P[B_+1]), a1 = cvt_pk_bf16(P[B_+2], P[B_+3]);                          \
        unsigned b0 = cvt_pk_bf16(P[B_+4], P[B_+5]), b1 = cvt_pk_bf16(P[B_+6], P[B_+7]);                                             \
        auto r0 = __builtin_amdgcn_permlane32_swap(a0, b0, false, false); auto r1 = __builtin_amdgcn_permlane32_swap(a1, b1, false, false); \
        u32x4 w = {r0[0], r1[0], r0[1], r1[1]}; OUT = *reinterpret_cast<bf16x8*>(&w); } while (0)
    PK4(p0, 0, pa0); PK4(p0, 8, pa1); PK4(p1, 0, pa2); PK4(p1, 8, pa3);
#undef PK4
}
template <int KB>
__device__ __forceinline__ void qkt(f32x16& p0, f32x16& p1, const char* K_lds, int r32, int hi, const bf16x8* qr, float ab, float slope2) {
    const float s32 = 32.f * slope2;
#pragma unroll
    for (int r = 0; r < 16; ++r) { p0[r] = fmaf(slope2, (float)((r & 3) + 8 * (r >> 2)), ab); p1[r] = p0[r] + s32; }
#pragma unroll
    for (int d0 = 0; d0 < 4; ++d0) { const char* a = K_lds + KB * SHM_K + kswz(r32, d0 * 2 + hi);
        bf16x8 b0 = *reinterpret_cast<const bf16x8*>(a);
        bf16x8 b1 = *reinterpret_cast<const bf16x8*>(a + 32 * 128);
        p0 = __builtin_amdgcn_mfma_f32_32x32x16_bf16(b0, qr[d0], p0, 0, 0, 0);
        p1 = __builtin_amdgcn_mfma_f32_32x32x16_bf16(b1, qr[d0], p1, 0, 0, 0); }
}
template <int VB>
__device__ __forceinline__ void pv_tile(f32x16* o, int vb0, bf16x8 pa0, bf16x8 pa1, bf16x8 pa2, bf16x8 pa3) {
#define TRRD(dst, off) asm volatile("ds_read_b64_tr_b16 %0, %1 offset:%2" : "=&v"(dst) : "v"(vb0), "i"(off) : "memory")
#define PV_D0(d0) do { s16x4 l0, l1, l2, l3, h0, h1, h2, h3; constexpr int b_ = VB * SHM_V + v_rd_off(d0, 0, 0); \
        TRRD(l0, b_); TRRD(h0, b_ + 2048); TRRD(l1, b_ + 4096); TRRD(h1, b_ + 6144); TRRD(l2, b_ + 8192); TRRD(h2, b_ + 10240); TRRD(l3, b_ + 12288); TRRD(h3, b_ + 14336); \
        asm volatile("s_waitcnt lgkmcnt(0)" ::: "memory"); SBAR();   \
        o[d0] = __builtin_amdgcn_mfma_f32_32x32x16_bf16(pa0, (bf16x8){l0[0], l0[1], l0[2], l0[3], h0[0], h0[1], h0[2], h0[3]}, o[d0], 0, 0, 0);   \
        o[d0] = __builtin_amdgcn_mfma_f32_32x32x16_bf16(pa1, (bf16x8){l1[0], l1[1], l1[2], l1[3], h1[0], h1[1], h1[2], h1[3]}, o[d0], 0, 0, 0);   \
        o[d0] = __builtin_amdgcn_mfma_f32_32x32x16_bf16(pa2, (bf16x8){l2[0], l2[1], l2[2], l2[3], h2[0], h2[1], h2[2], h2[3]}, o[d0], 0, 0, 0);   \
        o[d0] = __builtin_amdgcn_mfma_f32_32x32x16_bf16(pa3, (bf16x8){l3[0], l3[1], l3[2], l3[3], h3[0], h3[1], h3[2], h3[3]}, o[d0], 0, 0, 0); } while (0)
    PV_D0(0); PV_D0(1); PV_D0(2); PV_D0(3);
#undef PV_D0
#undef TRRD
}

struct BlockRef { const bf16_t* Q; const bf16_t* K; const bf16_t* V; bf16_t* O; int P0; int mode; float slope2; float kmax; };
struct Seam { bf16x8 qr[4]; bf16x8 st_v0, st_v1, st_k0; };
__device__ __forceinline__ BlockRef mkref(const bf16_t* Z, bf16_t* AO, const unsigned* kmx, int item, int pass) { BlockRef r; const int bh = item >> 4, y = item & 15, b = bh >> 2, h = bh & 3; const int qb = (pass < 2) ? y : 31 - y, mp = pass & 1;
    const bf16_t* zb = Z + (size_t)b * SEQ * ZP; r.Q = zb + (size_t)(qb * 256) * ZP + ZQ + h * 128 + mp * 64; r.K = zb + ZK + h * 128 + mp * 64; r.V = zb + ZVAL + h * 128;
    r.O = AO + ((size_t)b * SEQ + qb * 256) * DM + 512 + h * 128; r.P0 = qb * 256; r.mode = mp; r.slope2 = exp2f(-2.0f * (float)(h + 1)) * LOG2E;
    const unsigned* kp = kmx + ((bh * 2 + mp) * 2); r.kmax = 1.01f * sqrtf(__uint_as_float(ld_u32_agent(kp)) + __uint_as_float(ld_u32_agent(kp + 1))); return r; }
#define ROWV(p, k0, rr) ((p) + (size_t)((k0) + (rr)) * ZP + sc)
#define ROWK(p, k0) ((p) + (size_t)((k0) + skr) * ZP + skc * 8)
#define VMW() asm volatile("s_waitcnt vmcnt(0)" ::: "memory")
#define VMWN(n) asm volatile("s_waitcnt vmcnt(%0)" :: "i"(n) : "memory")
#define SLOAD_H(Kp, Vp, k0) do { S.st_v0 = load8(ROWV(Vp, k0, sr)); S.st_v1 = load8(ROWV(Vp, k0, 32 + sr)); S.st_k0 = load8(ROWK(Kp, k0)); } while (0)
#define SWRITE_HK(bf) do { *(bf16x8*)(K_lds + (bf) * SHM_K + kws) = S.st_k0; } while (0)
#define SWRITE_HV(bf) do { *(bf16x8*)(V_lds + (bf) * SHM_V + vst0) = S.st_v0; *(bf16x8*)(V_lds + (bf) * SHM_V + vst1) = S.st_v1; } while (0)
#define SWRITE_H(bf) do { SWRITE_HV(bf); SWRITE_HK(bf); } while (0)
__device__ __forceinline__ void prime(const BlockRef& cur, char* lds, Seam& S, int wid) {
    const int lane = lane_id(), tid = wid * 64 + lane, r32 = lane & 31, hi = lane >> 5;
    const int sr = tid >> 4, sc = (tid & 15) * 8, skr = tid >> 3, skc = tid & 7, kws = kswz(skr, skc); char* K_lds = lds + LDS_K;
#pragma unroll
    for (int d0 = 0; d0 < 4; ++d0) S.qr[d0] = load8(cur.Q + (size_t)(wid * QBLK + r32) * ZP + d0 * 16 + hi * 8);
    SLOAD_H(cur.K, cur.V, cur.P0 + QB - KVBLK); VMW(); SWRITE_HK(0);
    __syncthreads();
}
__device__ __forceinline__ void block(const BlockRef& cur, const BlockRef& nxt, char* lds, Seam& S, float lam, const float* __restrict__ subln, int wid) {
    const int lane = lane_id(), tid = wid * 64 + lane, r32 = lane & 31, hi = lane >> 5;
    const int NT0 = (cur.P0 + QB) / KVBLK;
    int NT = NT0;
    const int qlo = cur.P0 + wid * QBLK, qm = qlo + r32 - 4 * hi;
    const float slope2 = cur.slope2;
    char* V_lds = lds + LDS_V; char* K_lds = lds + LDS_K;
    float* ws = (float*)(lds + LDS_WS) + wid * 64; float* li_l = ws, * al_l = ws + 32;
    float m_reg = -1e30f, l_reg = 0; f32x16 o[4] = {};
    const int sr = tid >> 4, sc = (tid & 15) * 8, vst0 = v_st(sr, sc), vst1 = v_st(32 + sr, sc), skr = tid >> 3, skc = tid & 7, kws = kswz(skr, skc);
    const int vb0 = (int)(uintptr_t)V_lds + v_rd_base(lane);
    const bf16_t* Kh = cur.K; const bf16_t* Vh = cur.V;
#define RESC(a) do { if (__any((a) < 1.f)) { if (hi == 0) al_l[r32] = (a); asm volatile("s_waitcnt lgkmcnt(0)" ::: "memory");              \
                     for (int d_ = 0; d_ < 4; ++d_) for (int r = 0; r < 16; ++r) o[d_][r] *= al_l[crow(r, hi)]; } } while (0)
#define KBASE(t) ((NT0 - 1 - (t)) * KVBLK)
#define AB(t) (slope2 * (float)(KBASE(t) - qm))
#define MASKT(P0_, P1_, t) do { const int kb_ = KBASE(t); if (kb_ + KVBLK - 1 > qlo) mask_tile(P0_, P1_, qm - kb_); } while (0)
    constexpr int NQL = 4;
#define SEAM_K0() do { VMWN(NQL); SWRITE_HK(0); SBAR(); } while (0)
    f32x16 pA0, pA1, pB0, pB1; float alA, alB; bf16x8 pa0, pa1, pa2, pa3;
    float cbase;
    { float q2 = 0.f;
#pragma unroll
      for (int d0 = 0; d0 < 4; ++d0)
#pragma unroll
          for (int j = 0; j < 8; ++j) { const float v = __uint_as_float(((unsigned)(unsigned short)S.qr[d0][j]) << 16); q2 = fmaf(v, v, q2); }
      { auto rr = __builtin_amdgcn_permlane32_swap(__float_as_uint(q2), __float_as_uint(q2), false, false); q2 = __uint_as_float(rr[0]) + __uint_as_float(rr[1]); }
      cbase = sqrtf(q2) * cur.kmax * 1.0001f - slope2 * (float)(qlo + r32); }
    SWRITE_HV(0); SBAR();
    if (NT > 1) { SLOAD_H(Kh, Vh, KBASE(1)); }
    SBAR(); qkt<0>(pA0, pA1, K_lds, r32, hi, S.qr, AB(0), slope2);
    MASKT(pA0, pA1, 0); partialSM(pA0, pA1, m_reg, alA);
    if (NT > 1) { VMW(); SWRITE_H(1); }
    __syncthreads();
#define HALF_STEP(PX0, PX1, alX, PY0, PY1, alY, t, KB, VB, SB) do {                                                      \
        SBAR(); qkt<KB>(PX0, PX1, K_lds, r32, hi, S.qr, AB(t), slope2);                                                   \
        finishSM(PY0, PY1, alY, l_reg, pa0, pa1, pa2, pa3); SBAR();                                                       \
        if ((t) + 1 < NT) { SLOAD_H(Kh, Vh, KBASE((t) + 1)); SBAR(); }                                                    \
        pv_tile<VB>(o, vb0, pa0, pa1, pa2, pa3); MASKT(PX0, PX1, (t)); partialSM(PX0, PX1, m_reg, alX);                   \
        __syncthreads();                                                                                                  \
        if ((t) + 1 < NT) { VMW(); SWRITE_H(SB); }                                                                        \
        RESC(alX); __syncthreads(); } while (0)
    for (int t = 1; t + 1 < NT; t += 2) {
        HALF_STEP(pB0, pB1, alB, pA0, pA1, alA, t, 1, 0, 0);
        HALF_STEP(pA0, pA1, alA, pB0, pB1, alB, t + 1, 0, 1, 1);
        if (t == 3 && NT0 > 6) {
            float c = cbase - m_reg;
#pragma unroll
            for (int o_ = 1; o_ < 64; o_ <<= 1) c = fmaxf(c, __shfl_xor(c, o_));
            float* cx = (float*)(lds + LDS_CX);
            if (lane == 0) cx[wid] = c;
            __syncthreads();
            float C = cx[0];
#pragma unroll
            for (int w_ = 1; w_ < NW; ++w_) C = fmaxf(C, cx[w_]);
            const float X = (-SKIP_MARGIN - C) / slope2 - 63.f;
            const float need_f = (float)(NT0 - 1) - X * (1.0f / 64.0f);
            if (need_f < (float)NT0) { int n = (int)ceilf(need_f); n = n < 6 ? 6 : n; n = (n + 1) & ~1; NT = n < NT0 ? n : NT0; }
        }
    }
    SBAR(); qkt<1>(pB0, pB1, K_lds, r32, hi, S.qr, AB(NT - 1), slope2); SBAR();
    SLOAD_H(nxt.K, nxt.V, nxt.P0 + QB - KVBLK); SBAR();
#pragma unroll
    for (int d0 = 0; d0 < 4; ++d0) S.qr[d0] = load8(nxt.Q + (size_t)(wid * QBLK + r32) * ZP + d0 * 16 + hi * 8);
    SBAR();
    finishSM(pA0, pA1, alA, l_reg, pa0, pa1, pa2, pa3); SBAR();
    pv_tile<0>(o, vb0, pa0, pa1, pa2, pa3);
    MASKT(pB0, pB1, NT - 1); partialSM(pB0, pB1, m_reg, alB); __syncthreads(); RESC(alB);
    finishSM(pB0, pB1, alB, l_reg, pa0, pa1, pa2, pa3); SBAR(); pv_tile<1>(o, vb0, pa0, pa1, pa2, pa3);
    SBAR(); SEAM_K0();
    if (hi == 0) li_l[r32] = l_reg; asm volatile("s_waitcnt lgkmcnt(0)" ::: "memory");
    float rli[16];
#pragma unroll
    for (int r = 0; r < 16; ++r) rli[r] = __builtin_amdgcn_rcpf(li_l[crow(r, hi)]);
    unsigned* stash = (unsigned*)(lds + LDS_STASH) + wid * 2048 + lane;
    if (cur.mode == 0) {
#pragma unroll
        for (int r = 0; r < 16; ++r) { stash[(r * 2 + 0) * 64] = cvt_pk_bf16(o[0][r] * rli[r], o[1][r] * rli[r]); stash[(r * 2 + 1) * 64] = cvt_pk_bf16(o[2][r] * rli[r], o[3][r] * rli[r]); }
    } else {
        float ssq[16];
#pragma unroll
        for (int r = 0; r < 16; ++r) { const unsigned w0 = stash[(r * 2 + 0) * 64], w1 = stash[(r * 2 + 1) * 64];
            o[0][r] = bf_lo(w0) - lam * (o[0][r] * rli[r]); o[1][r] = bf_hi(w0) - lam * (o[1][r] * rli[r]);
            o[2][r] = bf_lo(w1) - lam * (o[2][r] * rli[r]); o[3][r] = bf_hi(w1) - lam * (o[3][r] * rli[r]);
            ssq[r] = (o[0][r] * o[0][r] + o[1][r] * o[1][r]) + (o[2][r] * o[2][r] + o[3][r] * o[3][r]); }
#pragma unroll
        for (int r = 0; r < 16; ++r) {
#pragma unroll
            for (int off = 1; off < 32; off <<= 1) ssq[r] += __shfl_xor(ssq[r], off);
            ssq[r] = __builtin_amdgcn_rsqf(ssq[r] * (1.0f / DV) + RMS_EPS); }
        float g4[4];
#pragma unroll
        for (int d0 = 0; d0 < 4; ++d0) g4[d0] = subln[d0 * 32 + r32] * 0.8f;
        bf16_t* Ow = cur.O + (size_t)(wid * QBLK) * DM;
#pragma unroll
        for (int r = 0; r < 16; ++r) { const int orow = crow(r, hi);
#pragma unroll
            for (int d0 = 0; d0 < 4; ++d0) { const float v = o[d0][r] * ssq[r] * g4[d0]; const float vn = __shfl_xor(v, 1);
                if ((r32 & 1) == 0) *(unsigned*)(Ow + (size_t)orow * DM + d0 * 32 + r32) = cvt_pk_bf16(v, vn); } }
    }
    __syncthreads();
#undef RESC
#undef KBASE
#undef AB
#undef MASKT
#undef SEAM_K0
#undef HALF_STEP
}
#undef ROWV
#undef ROWK
#undef VMW
#undef VMWN
#undef SLOAD_H
#undef SWRITE_HK
#undef SWRITE_HV
#undef SWRITE_H
#undef SBAR
}


#define XB_TMO      128
#define XB_XCNT(j)  (256  + 64 * (j))
#define XB_XSUB(j)  (1280 + 64 * (j))
#define XB_XGEN(j)  (2304 + 64 * (j))
#define XB_TOP      3328
#define XB_TOPGEN   3392
#define XCD_BAR_WORDS 3456
#define XB_SPIN_CAP (1u << 22)
__device__ __forceinline__ unsigned xb_ld(unsigned* p)              { return __hip_atomic_load(p, __ATOMIC_RELAXED, __HIP_MEMORY_SCOPE_AGENT); }
__device__ __forceinline__ unsigned xb_add(unsigned* p, unsigned v) { return __hip_atomic_fetch_add(p, v, __ATOMIC_RELAXED, __HIP_MEMORY_SCOPE_AGENT); }
__device__ __forceinline__ unsigned xb_xcc_id() { return (unsigned)__builtin_amdgcn_s_getreg((3 << 11) | 20) & 0xFu; }
#define XB_SPIN(cond, bar) do { unsigned _sp = 0; while (cond) { __builtin_amdgcn_s_sleep(1); \
    if ((++_sp & 255u) == 0u) { if (xb_ld(&(bar)[XB_TMO])) break; if (_sp > XB_SPIN_CAP) { atomicAdd(&(bar)[XB_TMO], 1u); break; } } } } while (0)
struct XcdBarrier { unsigned* bar; unsigned x; volatile LAS unsigned* st; };
__device__ __forceinline__ XcdBarrier xcd_barrier_post(unsigned* bar, volatile LAS unsigned* st, bool t0) {
    XcdBarrier b; b.bar = bar; b.x = xb_xcc_id(); b.st = st;
    if (t0) (void)xb_add(&bar[XB_XCNT(b.x)], 1u);
    return b;
}
__device__ __forceinline__ void xcd_barrier_complete(unsigned* bar, unsigned x, unsigned& nloc, unsigned& nx) {
    const unsigned G = gridDim.x;
    unsigned sum, cnt, mine, sp = 0u;
    for (;;) {
        sum = 0u; cnt = 0u; mine = 0u;
#pragma unroll
        for (unsigned j = 0; j < 16; ++j) { const unsigned c = xb_ld(&bar[XB_XCNT(j)]); sum += c; cnt += (c > 0u) ? 1u : 0u; mine = (j == x) ? c : mine; }
        if (sum == G) break;
        __builtin_amdgcn_s_sleep(1);
        if ((++sp & 255u) == 0u) { if (xb_ld(&bar[XB_TMO])) break; if (sp > XB_SPIN_CAP) { atomicAdd(&bar[XB_TMO], 1u); break; } }
    }
    nloc = mine > 0u ? mine : 1u; nx = cnt > 0u ? cnt : 1u;
}
__device__ __forceinline__ void xcd_barrier(const XcdBarrier& b, bool t0) {
    asm volatile("s_waitcnt vmcnt(0)" ::: "memory");
    __syncthreads();
    if (t0) {
        unsigned* bar = b.bar;
        __builtin_amdgcn_s_waitcnt(0);
        unsigned nloc = b.st[0], nx = b.st[1];
        if (nloc == 0u) { xcd_barrier_complete(bar, b.x, nloc, nx); b.st[0] = nloc; b.st[1] = nx; }
        const unsigned old = xb_add(&bar[XB_XSUB(b.x)], 1u);
        const unsigned gen = old / nloc;
        if (old + 1u == (gen + 1u) * nloc) {
            __builtin_amdgcn_fence(__ATOMIC_RELEASE, "agent");
            asm volatile("s_waitcnt vmcnt(0)" ::: "memory");
            const unsigned og = xb_add(&bar[XB_TOP], 1u);
            const unsigned tg = og / nx;
            if (og + 1u == (tg + 1u) * nx) xb_add(&bar[XB_TOPGEN], 1u);
            else XB_SPIN(xb_ld(&bar[XB_TOPGEN]) == tg, bar);
            __builtin_amdgcn_fence(__ATOMIC_ACQUIRE, "agent");
            xb_add(&bar[XB_XGEN(b.x)], 1u);
            asm volatile("s_waitcnt vmcnt(0)" ::: "memory");
        } else {
            XB_SPIN(xb_ld(&bar[XB_XGEN(b.x)]) == gen, bar);
            __builtin_amdgcn_fence(__ATOMIC_ACQUIRE, "agent");
            asm volatile("s_waitcnt vmcnt(0)" ::: "memory");
        }
    }
    __syncthreads();
}
constexpr int NWAVES = 8, NTHR = 512;
constexpr int LDS_BYTES = 147456;
struct Args {
    const float* in[28]; float* out; unsigned char* ws; int ph_lo, ph_hi;
};
constexpr int N_PHASES = 15;

struct Frame {
    LAS unsigned char* lds; int wave, vcu, G;
};

__device__ __forceinline__ void transpose_item(const float* W, int ldw, int k0, int n0, bf16_t* dst, int ldt, const float* kscale, LAS float* scr, int lane) {
    f32x4 v[8]; const int kr = lane >> 3, n4 = (lane & 7) * 4;
#pragma unroll
    for (int i = 0; i < 8; ++i) v[i] = *(const f32x4*)(W + (size_t)(k0 + i * 8 + kr) * ldw + n0 + n4);
#pragma unroll
    for (int i = 0; i < 8; ++i) { const int kk = i * 8 + kr; f32x4 x = v[i]; if (kscale) x = x * kscale[k0 + kk];
        scr[kk * 33 + n4 + 0] = x[0]; scr[kk * 33 + n4 + 1] = x[1]; scr[kk * 33 + n4 + 2] = x[2]; scr[kk * 33 + n4 + 3] = x[3]; }
    asm volatile("s_waitcnt lgkmcnt(0)" ::: "memory");
    const int c = lane & 7;
#pragma unroll
    for (int j = 0; j < 4; ++j) { const int n = (lane >> 3) + 8 * j; const LAS float* s = scr + (8 * c) * 33 + n;
        u32x4 o; o.x = cvt_pk_bf16(s[0 * 33], s[1 * 33]); o.y = cvt_pk_bf16(s[2 * 33], s[3 * 33]); o.z = cvt_pk_bf16(s[4 * 33], s[5 * 33]); o.w = cvt_pk_bf16(s[6 * 33], s[7 * 33]);
        *(u32x4*)(dst + (size_t)n * ldt + k0 + 8 * c) = o; }
    asm volatile("s_waitcnt lgkmcnt(0)" ::: "memory");
}
__device__ __forceinline__ void rms_rows2_to_bf16(const float* xa, const float* xb, const float* g, bf16_t* oa, bf16_t* ob, int lane) {
    const f32x4* ra = (const f32x4*)xa + lane; const f32x4* rb = (const f32x4*)xb + lane; const f32x4* gr = (const f32x4*)g + lane;
    f32x4 va[4], vb[4]; float sa = 0.f, sb = 0.f;
#pragma unroll
    for (int j = 0; j < 4; ++j) { va[j] = ra[64 * j]; vb[j] = rb[64 * j]; }
#pragma unroll
    for (int j = 0; j < 4; ++j) { sa += (va[j].x * va[j].x + va[j].y * va[j].y) + (va[j].z * va[j].z + va[j].w * va[j].w); sb += (vb[j].x * vb[j].x + vb[j].y * vb[j].y) + (vb[j].z * vb[j].z + vb[j].w * vb[j].w); }
    const float rsa = __builtin_amdgcn_rsqf(wave_sum(sa) * (1.f / DM) + RMS_EPS), rsb = __builtin_amdgcn_rsqf(wave_sum(sb) * (1.f / DM) + RMS_EPS);
    u32x2* pa = (u32x2*)oa + lane; u32x2* pb = (u32x2*)ob + lane;
#pragma unroll
    for (int j = 0; j < 4; ++j) { const f32x4 gg = gr[64 * j]; u32x2 w;
        w.x = cvt_pk_bf16(va[j].x * rsa * gg.x, va[j].y * rsa * gg.y); w.y = cvt_pk_bf16(va[j].z * rsa * gg.z, va[j].w * rsa * gg.w); pa[64 * j] = w;
        w.x = cvt_pk_bf16(vb[j].x * rsb * gg.x, vb[j].y * rsb * gg.y); w.y = cvt_pk_bf16(vb[j].z * rsb * gg.z, vb[j].w * rsb * gg.w); pb[64 * j] = w; }
}

__global__ void __launch_bounds__(NTHR, 2) mega(Args args) {
    extern __shared__ __attribute__((aligned(16))) unsigned char lds_raw[];
    Frame F; F.lds = (LAS unsigned char*)lds_raw; F.wave = __builtin_amdgcn_readfirstlane(threadIdx.x >> 6);
    F.G = gridDim.x; { const int bx = blockIdx.x; F.vcu = (F.G % 8 == 0) ? (bx % 8) * (F.G / 8) + bx / 8 : bx; }
    unsigned char* ws = args.ws;
    unsigned* ctl = (unsigned*)(ws + WS_CTL);
    const float* x = args.in[0]; float* out = args.out;
    bf16_t* Win_t = (bf16_t*)(ws + WS_WIN); bf16_t* Wout_t = (bf16_t*)(ws + WS_WOUT); bf16_t* Wq_t = (bf16_t*)(ws + WS_WQ); bf16_t* Wkv_t = (bf16_t*)(ws + WS_WKV);
    bf16_t* Wo_t = (bf16_t*)(ws + WS_WO); bf16_t* Wr_t = (bf16_t*)(ws + WS_WR); bf16_t* Wsgu = (bf16_t*)(ws + WS_WSGU); bf16_t* memn = (bf16_t*)(ws + WS_MEMN);
    bf16_t* Km = (bf16_t*)(ws + WS_KM); bf16_t* Vt = (bf16_t*)(ws + WS_VT); bf16_t* Wgu_t = (bf16_t*)(ws + WS_WGU); bf16_t* Wd_t = (bf16_t*)(ws + WS_WD);
    bf16_t* Z = (bf16_t*)(ws + WS_RA); bf16_t* Qm = (bf16_t*)(ws + WS_RA); bf16_t* Sc = (bf16_t*)(ws + WS_RA + 128 * MiB); bf16_t* xg = (bf16_t*)(ws + WS_RA); bf16_t* yb = (bf16_t*)(ws + WS_RA);
    bf16_t* XN = (bf16_t*)(ws + WS_RB); bf16_t* AO = (bf16_t*)(ws + WS_RB); bf16_t* Om = (bf16_t*)(ws + WS_RB); bf16_t* act = (bf16_t*)(ws + WS_RB);
    bf16_t* x1b = (bf16_t*)(ws + WS_RC); bf16_t* x2b = (bf16_t*)(ws + WS_RC);
    float* ssq1 = (float*)(ws + WS_SSQ1); float* ssq2 = (float*)(ws + WS_SSQ2); float* rstd2 = (float*)(ws + WS_SSQ1);     float* logit = (float*)(ws + WS_LOGIT);
    int* tok_e = (int*)(ws + WS_TOKE); float* tok_w = (float*)(ws + WS_TOKW); int* tok_s = (int*)(ws + WS_TOKS); int* row_tok = (int*)(ws + WS_ROWTOK);
    const int gw = F.vcu * NWAVES + F.wave, NGW = F.G * NWAVES;
    const int lo = args.ph_lo, hi = args.ph_hi;
#define IN(k) (lo <= (k) && (k) < hi)
#if MK_ONE_LAUNCH
    volatile LAS unsigned* misc = (volatile LAS unsigned*)(F.lds + LDS_MISC);
    if (threadIdx.x < 64) misc[threadIdx.x] = 0u;
    __syncthreads();
    XcdBarrier xbar = xcd_barrier_post(ctl + CW_BAR, misc + 8, threadIdx.x == 0);
#define GRID_BAR(k) do { if (IN(k) && IN((k) + 1)) { if ((k) == 0) cg::this_grid().sync(); else xcd_barrier(xbar, F.wave == 0 && lane_id() == 0); } } while (0)
#else
#define GRID_BAR(k) do { } while (0)
#endif

    if (IN(0)) {
        const int lane_ = lane_id(), tid_ = F.wave * 64 + lane_; (void)tid_;
        LAS float* scr = (LAS float*)(F.lds + F.wave * 16384);
        constexpr int I_IN = 16 * 80, I_SQ = 16 * 32, I_KV = 16 * 64, I_G = 16 * 16, I_D = 8 * 32;
        constexpr int NITEMS = I_IN + 3 * I_SQ + I_KV + NEXP * (2 * I_G + I_D);
        for (int it = gw; it < NITEMS; it += NGW) {
            int r = it;
            if (r < I_IN) { const int kb = r / 80, nb = r % 80; transpose_item(args.in[3], ZP, kb * 64, nb * 32, Win_t + (size_t)(nb * 32) * DM, DM, nullptr, scr, lane_); continue; } r -= I_IN;
            if (r < I_SQ) { const int kb = r / 32, nb = r % 32; transpose_item(args.in[13], DM, kb * 64, nb * 32, Wout_t + (size_t)(nb * 32) * DM, DM, nullptr, scr, lane_); continue; } r -= I_SQ;
            if (r < I_SQ) { const int kb = r / 32, nb = r % 32; transpose_item(args.in[16], DM, kb * 64, nb * 32, Wq_t + (size_t)(nb * 32) * DM, DM, args.in[14], scr, lane_); continue; } r -= I_SQ;
            if (r < I_KV) { const int kb = r / 64, nb = r % 64; transpose_item(args.in[17], 2 * DM, kb * 64, nb * 32, Wkv_t + (size_t)(nb * 32) * DM, DM, nullptr, scr, lane_); continue; } r -= I_KV;
            if (r < I_SQ) { const int kb = r / 32, nb = r % 32; transpose_item(args.in[18], DM, kb * 64, nb * 32, Wo_t + (size_t)(nb * 32) * DM, DM, nullptr, scr, lane_); continue; } r -= I_SQ;
            const int e = r / (2 * I_G + I_D); r -= e * (2 * I_G + I_D);
            if (r < 2 * I_G) { const int up = r >= I_G; if (up) r -= I_G; const int kb = r / 16, nb = r % 16, n0 = nb * 32;
                const float* W = (up ? args.in[25] : args.in[24]) + (size_t)e * DM * DEXP;
                transpose_item(W, DEXP, kb * 64, n0, Wgu_t + ((size_t)e * 1024 + (n0 >> 7) * 256 + up * 128 + (n0 & 127)) * DM, DM, args.in[19], scr, lane_); continue; }
            r -= 2 * I_G;
            { const int kb = r / 32, nb = r % 32; transpose_item(args.in[26] + (size_t)e * DEXP * DM, DM, kb * 64, nb * 32, Wd_t + ((size_t)e * 1024 + nb * 32) * DEXP, DEXP, nullptr, scr, lane_); }
        }
        for (int i = blockIdx.x * NTHR + tid_; i < 256 * DM; i += F.G * NTHR) { const int n = i >> 10, k = i & 1023; float v = 0.f;
            if (n < 4) v = args.in[20][k * 4 + n] * args.in[19][k]; else if (n < 36) v = args.in[22][k * 32 + (n - 4)] * args.in[19][k];
            Wr_t[i] = (bf16_t)(cvt_pk_bf16(v, 0.f) & 0xffffu); }
        for (int i = blockIdx.x * NTHR + tid_; i < 4 * 128 * 128; i += F.G * NTHR) { const int t = (i >> 7) & 127, s = i & 127; const float v = s <= t ? args.in[6][i] : 0.f; Wsgu[i] = (bf16_t)(cvt_pk_bf16(v, 0.f) & 0xffffu); }
        for (int m = gw; m < M; m += 2 * NGW) rms_rows2_to_bf16(x + (size_t)m * DM, x + (size_t)(m + NGW) * DM, args.in[2], XN + (size_t)m * DM, XN + (size_t)(m + NGW) * DM, lane_);
        for (int m = gw; m < MROWS / 2; m += NGW) rms_rows2_to_bf16(args.in[1] + (size_t)m * DM, args.in[1] + (size_t)(m + MROWS / 2) * DM, args.in[15], memn + (size_t)m * DM, memn + (size_t)(m + MROWS / 2) * DM, lane_);
        __syncthreads();
    }
    GRID_BAR(0);

    if (IN(1)) {
        { pg8::Gemm g{DM, DM, DM}; pg8::PlainSched S; S.to.init(M / 256, ZP / 256, F.G, (int)blockIdx.x); S.A = (const char*)XN; S.B = (const char*)Win_t; S.tA = (size_t)256 * DM * 2; S.tB = (size_t)256 * DM * 2;
          pg8::EpiZ E{Z, ctl + CW_KMX}; pg8::gemm_phase(F.lds, F.wave, g, S, E); }
        { pg8::Gemm g{DM, DM, DM}; pg8::PlainSched S; S.to.init(MROWS / 256, 4, F.G, (int)blockIdx.x); S.A = (const char*)memn; S.B = (const char*)Wkv_t; S.tA = (size_t)256 * DM * 2; S.tB = (size_t)256 * DM * 2;
          pg8::EpiBf16 E{Km, DM, nullptr, 1.f}; pg8::gemm_phase(F.lds, F.wave, g, S, E); }
        { pg8::Gemm g{DM, DM, DM}; pg8::PlainSched S; S.to.init(4, MROWS / 256, F.G, (int)((blockIdx.x + 128) % F.G)); S.A = (const char*)(Wkv_t + (size_t)DM * DM); S.B = (const char*)memn; S.tA = (size_t)256 * DM * 2; S.tB = (size_t)256 * DM * 2;
          pg8::EpiBf16 E{Vt, MROWS, nullptr, 1.f}; pg8::gemm_phase(F.lds, F.wave, g, S, E); }
    }
    GRID_BAR(1);

    if (IN(2)) {
        const int lane_ = lane_id(), tid_ = F.wave * 64 + lane_; (void)tid_;
        float lam;
        { const float a = args.in[8][lane_] * args.in[9][lane_], b = args.in[10][lane_] * args.in[11][lane_];
          lam = __expf(wave_sum(a)) - __expf(wave_sum(b)) + 0.2f; }
        const int nitems = 32 * 16, npass = 4;
        int nit, itA, itB;
        if (F.G == 256) { const int b = F.vcu >> 5, rem = F.vcu & 31, hp = rem >> 4, y = rem & 15; nit = 2; itA = ((b * 4 + (hp ? 2 : 3)) << 4) | y; itB = ((b * 4 + (hp ? 1 : 0)) << 4) | y; }
        else { const int per = (nitems + F.G - 1) / F.G; itA = F.vcu * per; int e_ = itA + per; if (e_ > nitems) e_ = nitems; nit = e_ - itA; itB = itA + 1; }
#define ITEM_OF(i) ((F.G == 256) ? ((i) == 0 ? itA : itB) : itA + (i))
        if (nit > 0) {
            int ii = 0, pass = 0; da::BlockRef cur = da::mkref(Z, AO, ctl + CW_KMX, ITEM_OF(0), 0); da::Seam S;
            da::prime(cur, (char*)lds_raw, S, F.wave);
            for (;;) {
                int ni = ii, np = pass + 1; if (np == npass) { np = 0; ni = ii + 1; }
                const bool last = ni >= nit;
                const da::BlockRef nxt = last ? cur : da::mkref(Z, AO, ctl + CW_KMX, ITEM_OF(ni), np);
                da::block(cur, nxt, (char*)lds_raw, S, lam, args.in[12], F.wave);
                if (last) break;
                cur = nxt; ii = ni; pass = np;
            }
        }
#undef ITEM_OF
        __syncthreads();
        {
            LAS bf16_t* vnT = (LAS bf16_t*)F.lds;
            const int lane = lane_, w = F.wave;
            for (int uidx = F.vcu; uidx < (M / 128) * 4; uidx += F.G) {
                const int c = uidx >> 2, g = uidx & 3; const size_t R0 = (size_t)c * 128;
#pragma unroll
                for (int ps = 0; ps < 4; ++ps) { const int s = 16 * w + 4 * ps + (lane >> 4), ch0 = (lane & 15) * 8;
                    const u32x4 raw = *(const u32x4*)(Z + (R0 + s) * ZP + ZV + g * 128 + ch0);
                    float v[8] = {bf_lo(raw.x), bf_hi(raw.x), bf_lo(raw.y), bf_hi(raw.y), bf_lo(raw.z), bf_hi(raw.z), bf_lo(raw.w), bf_hi(raw.w)};
                    float sm = 0.f;
#pragma unroll
                    for (int j = 0; j < 8; ++j) sm += v[j];
#pragma unroll
                    for (int o = 1; o < 16; o <<= 1) sm += __shfl_xor(sm, o);
                    const float mu = sm * (1.f / 128.f); float q = 0.f;
#pragma unroll
                    for (int j = 0; j < 8; ++j) { v[j] -= mu; q += v[j] * v[j]; }
#pragma unroll
                    for (int o = 1; o < 16; o <<= 1) q += __shfl_xor(q, o);
                    const float rstd = __builtin_amdgcn_rsqf(q * (1.f / 128.f) + LN_EPS);
#pragma unroll
                    for (int j = 0; j < 8; ++j) { const float y = v[j] * rstd * args.in[4][g * 128 + ch0 + j] + args.in[5][g * 128 + ch0 + j];
                        vnT[(ch0 + j) * 136 + s] = (bf16_t)(cvt_pk_bf16(y, 0.f) & 0xffffu); } }
                __syncthreads();
                f32x4 acc[8];
#pragma unroll
                for (int mi = 0; mi < 8; ++mi) acc[mi] = (f32x4){0.f, 0.f, 0.f, 0.f};
                const int t = 16 * w + (lane & 15);
                const int nks = (w + 2) >> 1;
                for (int ks = 0; ks < nks; ++ks) {
                    const bf16x8 bfr = *(const bf16x8*)(Wsgu + ((size_t)g * 128 + t) * 128 + ks * 32 + 8 * (lane >> 4));
#pragma unroll
                    for (int mi = 0; mi < 8; ++mi) { const bf16x8 afr = *(const LAS bf16x8*)(vnT + (16 * mi + (lane & 15)) * 136 + ks * 32 + 8 * (lane >> 4));
                        acc[mi] = __builtin_amdgcn_mfma_f32_16x16x32_bf16(afr, bfr, acc[mi], 0, 0, 0); }
                }
                const float bias = args.in[7][g * 128 + t];
#pragma unroll
                for (int mi = 0; mi < 8; ++mi) { const int ch = 16 * mi + 4 * (lane >> 4);
                    const u32x2 ur = *(const u32x2*)(Z + (R0 + t) * ZP + ZU + g * 128 + ch);
                    const float o0 = bf_lo(ur.x) * (acc[mi][0] + bias), o1 = bf_hi(ur.x) * (acc[mi][1] + bias), o2 = bf_lo(ur.y) * (acc[mi][2] + bias), o3 = bf_hi(ur.y) * (acc[mi][3] + bias);
                    u32x2 wv; wv.x = cvt_pk_bf16(o0, o1); wv.y = cvt_pk_bf16(o2, o3);
                    *(u32x2*)(AO + (R0 + t) * DM + g * 128 + ch) = wv; }
                __syncthreads();
            }
        }
    }
    GRID_BAR(2);

    if (IN(3)) {
        pg8::Gemm g{DM, DM, DM}; pg8::PlainSched S; S.to.init(M / 256, 4, F.G, (int)blockIdx.x); S.A = (const char*)AO; S.B = (const char*)Wout_t; S.tA = (size_t)256 * DM * 2; S.tB = (size_t)256 * DM * 2;
        pg8::EpiResid E{x, out, x1b, ssq1}; pg8::gemm_phase(F.lds, F.wave, g, S, E);
    }
    GRID_BAR(3);

    if (IN(4)) {
        pg8::Gemm g{DM, DM, DM}; pg8::PlainSched S; S.to.init(M / 256, 4, F.G, (int)blockIdx.x); S.A = (const char*)x1b; S.B = (const char*)Wq_t; S.tA = (size_t)256 * DM * 2; S.tB = (size_t)256 * DM * 2;
        pg8::EpiBf16 E{Qm, DM, ssq1, C2_MEM}; pg8::gemm_phase(F.lds, F.wave, g, S, E);
    }
    GRID_BAR(4);

    if (IN(5)) {
        pg8::Gemm g{DM, DM, 256}; pg8::MemAttnSched S; S.to.init(M / 256, 4, F.G, (int)blockIdx.x); S.A = (const char*)Qm; S.B = (const char*)Km; S.bB = (size_t)256 * DM * 2; S.hB = 512;
        pg8::EpiSoftmax E{Sc, (LAS float*)(F.lds + LDS_MISC + 1024)}; pg8::gemm_phase(F.lds, F.wave, g, S, E);
    }
    GRID_BAR(5);

    if (IN(7)) {
        pg8::Gemm g{DM, MROWS, 256}; pg8::MemAttnSched S; S.to.init(M / 256, 4, F.G, (int)blockIdx.x); S.A = (const char*)Sc; S.B = (const char*)Vt; S.bB = 512; S.hB = (size_t)256 * MROWS * 2;
        pg8::EpiBf16 E{Om, DM, nullptr, 1.f}; pg8::gemm_phase(F.lds, F.wave, g, S, E);
    }
    GRID_BAR(7);

    if (IN(8)) {
        pg8::Gemm g{DM, DM, DM}; pg8::PlainSched S; S.to.init(M / 256, 4, F.G, (int)blockIdx.x); S.A = (const char*)Om; S.B = (const char*)Wo_t; S.tA = (size_t)256 * DM * 2; S.tB = (size_t)256 * DM * 2;
        pg8::EpiResid E{out, out, x2b, ssq2}; pg8::gemm_phase(F.lds, F.wave, g, S, E);
    }
    GRID_BAR(8);

    if (IN(9)) {
        pg8::Gemm g{DM, DM, DM}; pg8::PlainSched S; S.to.init(M / 256, 1, F.G, (int)blockIdx.x); S.A = (const char*)x2b; S.B = (const char*)Wr_t; S.tA = (size_t)256 * DM * 2; S.tB = 0;
        pg8::EpiRouter E{logit, ssq2, args.in[21], args.in[23], rstd2}; pg8::gemm_phase(F.lds, F.wave, g, S, E);
    }
    GRID_BAR(9);

    if (IN(10)) {
        const int lane_ = lane_id(), tid_ = F.wave * 64 + lane_; (void)tid_;
        LAS unsigned* lcnt = (LAS unsigned*)F.lds; LAS unsigned* lbase = lcnt + 32;
        for (int t0 = blockIdx.x * NTHR; t0 < M; t0 += F.G * NTHR) {
            if (tid_ < 32) lcnt[tid_] = 0u;
            __syncthreads();
            const int tok = t0 + tid_;
            const f32x4 lg = *(const f32x4*)(logit + (size_t)tok * 64);
            int gi = 0; float gm = lg[0];
#pragma unroll
            for (int j = 1; j < 4; ++j) if (lg[j] > gm) { gm = lg[j]; gi = j; }
            float gs = 0.f;
#pragma unroll
            for (int j = 0; j < 4; ++j) gs += __expf(lg[j] - gm);
            const float gate = 1.0f / gs;
            const f32x4 ea = *(const f32x4*)(logit + (size_t)tok * 64 + 4 + gi * 8), eb = *(const f32x4*)(logit + (size_t)tok * 64 + 8 + gi * 8);
            const float el[8] = {ea[0], ea[1], ea[2], ea[3], eb[0], eb[1], eb[2], eb[3]};
            int i0 = 0; float m0 = el[0];
#pragma unroll
            for (int j = 1; j < 8; ++j) if (el[j] > m0) { m0 = el[j]; i0 = j; }
            int i1 = -1; float m1 = -__builtin_inff();
#pragma unroll
            for (int j = 0; j < 8; ++j) if (j != i0 && el[j] > m1) { m1 = el[j]; i1 = j; }
            if (i1 < 0) i1 = (i0 == 0) ? 1 : 0;
            const float r = __expf(m1 - m0);
            const float w0 = gate / (1.0f + r), w1 = gate * r / (1.0f + r);
            const int e0 = gi * 8 + i0, e1 = gi * 8 + i1;
            const unsigned r0 = atomicAdd((unsigned*)&lcnt[e0], 1u), r1 = atomicAdd((unsigned*)&lcnt[e1], 1u);
            __syncthreads();
            if (tid_ < 32) lbase[tid_] = atomicAdd(ctl + CW_CNT + tid_, lcnt[tid_]);
            __syncthreads();
            tok_e[tok * 2] = e0; tok_e[tok * 2 + 1] = e1; tok_w[tok * 2] = w0; tok_w[tok * 2 + 1] = w1;
            tok_s[tok * 2] = (int)(lbase[e0] + r0); tok_s[tok * 2 + 1] = (int)(lbase[e1] + r1);
            __syncthreads();
        }
    }
    GRID_BAR(10);

    if (IN(11)) {
        const int lane_ = lane_id(), tid_ = F.wave * 64 + lane_; (void)tid_;
        LAS unsigned* lps = (LAS unsigned*)F.lds;
        if (tid_ == 0) { unsigned acc = 0; for (int e = 0; e < 32; ++e) { lps[e] = acc; const unsigned c = ld_u32_agent(ctl + CW_CNT + e); acc += (c + 255u) & ~255u; } lps[32] = acc; }
        __syncthreads();
        if (blockIdx.x == 0) {
            if (tid_ < 32) { const unsigned s = lps[tid_], e2 = lps[tid_ + 1], c = ld_u32_agent(ctl + CW_CNT + tid_);
                for (unsigned b = s >> 8; b < (e2 >> 8); ++b) ctl[CW_BLKE + b] = (unsigned)tid_;
                for (unsigned r = s + c; r < e2; ++r) row_tok[r] = 0; }
            if (tid_ == 0) ctl[CW_NBLK] = lps[32] >> 8;
        }
        for (int a = blockIdx.x * NTHR + tid_; a < M * 2; a += F.G * NTHR) { const int e = tok_e[a]; const int pos = (int)lps[e] + tok_s[a]; row_tok[pos] = a >> 1; tok_s[a] = pos; }
        __syncthreads();
    }
    GRID_BAR(11);

    if (IN(12)) {
        const int nblk = (int)__builtin_amdgcn_readfirstlane(ld_u32_agent(ctl + CW_NBLK));
        pg8::Gemm g{DM, DM, DM}; pg8::MoeSched S{F.G, F.vcu, nblk, ctl + CW_BLKE, (const char*)x2b, (const char*)Wgu_t, (size_t)0, (size_t)1024 * DM * 2, (size_t)256 * DM * 2, row_tok};
        pg8::EpiGateUp E{act, rstd2, row_tok}; pg8::gemm_phase<pg8::EpiGateUp, pg8::MoeSched, true>(F.lds, F.wave, g, S, E);
    }
    GRID_BAR(12);

    if (IN(13)) {
        const int nblk = (int)__builtin_amdgcn_readfirstlane(ld_u32_agent(ctl + CW_NBLK));
        pg8::Gemm g{DEXP, DEXP, DEXP}; pg8::MoeSched S{F.G, F.vcu, nblk, ctl + CW_BLKE, (const char*)act, (const char*)Wd_t, (size_t)256 * DEXP * 2, (size_t)1024 * DEXP * 2, (size_t)256 * DEXP * 2, row_tok};
        pg8::EpiBf16 E{yb, DM, nullptr, 1.f}; pg8::gemm_phase(F.lds, F.wave, g, S, E);
    }
    GRID_BAR(13);

    if (IN(14)) {
        const int lane_ = lane_id(), tid_ = F.wave * 64 + lane_; (void)tid_;
        for (int m = gw; m < M; m += NGW) {
            const int p0 = tok_s[m * 2], p1 = tok_s[m * 2 + 1]; const float w0 = tok_w[m * 2], w1 = tok_w[m * 2 + 1];
            f32x4* xr = (f32x4*)(out + (size_t)m * DM) + lane_; const u32x2* y0 = (const u32x2*)(yb + (size_t)p0 * DM) + lane_; const u32x2* y1 = (const u32x2*)(yb + (size_t)p1 * DM) + lane_;
            const f32x4* gr = (const f32x4*)args.in[27] + lane_;
            f32x4 v[4]; float s = 0.f;
#pragma unroll
            for (int j = 0; j < 4; ++j) { v[j] = xr[64 * j]; const u32x2 a = y0[64 * j], b = y1[64 * j];
                v[j].x += w0 * bf_lo(a.x) + w1 * bf_lo(b.x); v[j].y += w0 * bf_hi(a.x) + w1 * bf_hi(b.x); v[j].z += w0 * bf_lo(a.y) + w1 * bf_lo(b.y); v[j].w += w0 * bf_hi(a.y) + w1 * bf_hi(b.y);
                s += (v[j].x * v[j].x + v[j].y * v[j].y) + (v[j].z * v[j].z + v[j].w * v[j].w); }
            const float rstd = __builtin_amdgcn_rsqf(wave_sum(s) * (1.f / DM) + RMS_EPS);
#pragma unroll
            for (int j = 0; j < 4; ++j) { const f32x4 gg = gr[64 * j]; xr[64 * j] = (f32x4){v[j].x * rstd * gg.x, v[j].y * rstd * gg.y, v[j].z * rstd * gg.z, v[j].w * rstd * gg.w}; }
        }
    }
#undef IN
#undef GRID_BAR
}

extern "C" void kernel_launch(void* const* d_in, const int* in_sizes, int n_in, void* d_out, int out_size, void* d_ws, size_t ws_size, hipStream_t stream) {
    static int grid = 0;
    if (grid == 0) {
        if (n_in != 28 || in_sizes[0] != M * DM || out_size != M * DM || ws_size < WS_END) { fprintf(stderr, "kernel_launch: unexpected shapes (n_in %d in0 %d out %d ws %zu)\n", n_in, n_in > 0 ? in_sizes[0] : -1, out_size, ws_size); grid = -1; return; }
        int dev = 0, cus = 0, per_cu = 0;
        if (hipGetDevice(&dev) != hipSuccess || hipDeviceGetAttribute(&cus, hipDeviceAttributeMultiprocessorCount, dev) != hipSuccess) { grid = -1; return; }
        if (hipFuncSetAttribute((const void*)mega, hipFuncAttributeMaxDynamicSharedMemorySize, LDS_BYTES) != hipSuccess) { fprintf(stderr, "kernel_launch: hipFuncSetAttribute failed\n"); grid = -1; return; }
        if (hipOccupancyMaxActiveBlocksPerMultiprocessor(&per_cu, (const void*)mega, NTHR, LDS_BYTES) != hipSuccess || per_cu < 1) { fprintf(stderr, "kernel_launch: occupancy query says %d\n", per_cu); per_cu = 1; }
        (void)hipGetLastError();
        grid = cus;
    }
    if (grid < 0) return;
    (void)hipMemsetAsync((char*)d_ws + WS_CTL, 0, CTL_BYTES, stream);
    Args a{};
    for (int i = 0; i < 28; ++i) a.in[i] = (const float*)d_in[i];
    a.out = (float*)d_out; a.ws = (unsigned char*)d_ws;
#if MK_ONE_LAUNCH
    a.ph_lo = 0; a.ph_hi = N_PHASES;
    void* kargs[] = {&a};
    hipError_t e = hipLaunchCooperativeKernel((const void*)mega, dim3(grid), dim3(NTHR), kargs, LDS_BYTES, stream);
    if (e != hipSuccess) fprintf(stderr, "cooperative launch failed: %s (grid %d)\n", hipGetErrorString(e), grid);
#else
    for (int p = 0; p < N_PHASES; ++p) { a.ph_lo = p; a.ph_hi = p + 1; hipLaunchKernelGGL(mega, dim3(grid), dim3(NTHR), LDS_BYTES, stream, a); }
#endif
}
```

```cpp
#include <hip/hip_runtime.h>
#include <hip/hip_cooperative_groups.h>
#include <cstdio>
#include <cstdint>
namespace cg = cooperative_groups;

#ifndef PROBE_DUP
#define PROBE_DUP -1
#endif
#ifndef PROBE_DUP_ATTN
#define PROBE_DUP_ATTN 1
#endif
#ifndef MK_ONE_LAUNCH
#define MK_ONE_LAUNCH 1
#endif

#define LAS __attribute__((address_space(3)))
#define GAS __attribute__((address_space(1)))
typedef unsigned short bf16_t;
typedef short bf16x8 __attribute__((ext_vector_type(8)));
typedef short s16x4 __attribute__((ext_vector_type(4)));
typedef float f32x2 __attribute__((ext_vector_type(2)));
typedef float f32x4 __attribute__((ext_vector_type(4)));
typedef float f32x16 __attribute__((ext_vector_type(16)));
typedef unsigned u32x2 __attribute__((ext_vector_type(2)));
typedef unsigned u32x4 __attribute__((ext_vector_type(4)));

constexpr int NB = 8, SEQ = 8192, DM = 1024, M = NB * SEQ;
constexpr int ZP = 2560;
constexpr int ZU = 0, ZV = 512, ZQ = 1024, ZK = 1536, ZVAL = 2048;
constexpr int MEML = 256, MROWS = NB * MEML;
constexpr int NEXP = 32, DEXP = 512;
constexpr int PROWS = 2 * M + NEXP * 256;
constexpr int MAXBLK = PROWS / 256;
constexpr float RMS_EPS = 1e-6f, LN_EPS = 1e-5f;
constexpr float LOG2E = 1.4426950408889634f;
constexpr float C2_DIFF = 0.125f * LOG2E;
constexpr float C2_MEM = 0.0625f * LOG2E;

constexpr size_t MiB = 1u << 20;
constexpr size_t WS_CTL = 0, CTL_BYTES = 1 * MiB;
constexpr size_t WS_WIN = 1 * MiB;
constexpr size_t WS_WOUT = 6 * MiB;
constexpr size_t WS_WQ = 8 * MiB;
constexpr size_t WS_WKV = 10 * MiB;
constexpr size_t WS_WO = 14 * MiB;
constexpr size_t WS_WR = 16 * MiB;
constexpr size_t WS_WSGU = 17 * MiB;
constexpr size_t WS_MEMN = 18 * MiB;
constexpr size_t WS_KM = 22 * MiB;
constexpr size_t WS_VT = 26 * MiB;
constexpr size_t WS_WGU = 30 * MiB;
constexpr size_t WS_WD = 94 * MiB;
constexpr size_t WS_RA = 128 * MiB;
constexpr size_t WS_RB = 448 * MiB;
constexpr size_t WS_RC = 592 * MiB;
constexpr size_t WS_SSQ1 = 720 * MiB;
constexpr size_t WS_SSQ2 = 724 * MiB;
constexpr size_t WS_LOGIT = 728 * MiB;
constexpr size_t WS_TOKE = 744 * MiB;
constexpr size_t WS_TOKW = 745 * MiB;
constexpr size_t WS_TOKS = 746 * MiB;
constexpr size_t WS_ROWTOK = 747 * MiB;
constexpr size_t WS_END = 752 * MiB;
constexpr int CW_CNT = 64;
constexpr int CW_NBLK = 128;
constexpr int CW_PSTART = 192;
constexpr int CW_BLKE = 256;
constexpr int CW_KMX = 1024;
constexpr int CW_BAR = 4096;
constexpr int LDS_MISC = 131072;

__device__ __forceinline__ unsigned cvt_pk_bf16(float lo, float hi) { unsigned r; asm volatile("v_cvt_pk_bf16_f32 %0, %1, %2" : "=v"(r) : "v"(lo), "v"(hi)); return r; }
__device__ __forceinline__ float bf_lo(unsigned w) { return __uint_as_float(w << 16); }
__device__ __forceinline__ float bf_hi(unsigned w) { return __uint_as_float(w & 0xffff0000u); }
__device__ __forceinline__ float wave_sum(float v) {
#pragma unroll
    for (int o = 1; o < 64; o <<= 1) v += __shfl_xor(v, o);
    return v;
}
__device__ __forceinline__ float wave_max(float v) {
#pragma unroll
    for (int o = 1; o < 64; o <<= 1) v = fmaxf(v, __shfl_xor(v, o));
    return v;
}
__device__ __forceinline__ int lane_id() { int l; asm volatile("v_mbcnt_lo_u32_b32 %0, -1, 0\n\tv_mbcnt_hi_u32_b32 %0, -1, %0" : "=v"(l)); return l; }
__device__ __forceinline__ unsigned ld_u32_agent(const unsigned* p) { return __hip_atomic_load(p, __ATOMIC_RELAXED, __HIP_MEMORY_SCOPE_AGENT); }

namespace pg8 {
constexpr int BM = 256, BK = 64, HALF = 128, HTB = HALF * BK * 2, STAGE_BYTES = 8 * HTB, NXCD = 8, WGM = 8;
__host__ __device__ __forceinline__ int lds_byte(int r, int c) { const int st = (r >> 4) * 2 + (c >> 5), rr = r & 15, cc = c & 31, ob = rr * 64 + cc * 2; return st * 1024 + (ob ^ (((ob >> 9) & 1) << 5)); }
__host__ __device__ __forceinline__ void stage_rc(int b, int& R, int& C) { const int st = b / 1024, sb = b % 1024, swz = sb ^ (((sb >> 9) & 1) << 5); R = (st >> 1) * 16 + swz / 64; C = (st & 1) * 32 + (swz % 64) / 2; }
__host__ __device__ __forceinline__ int perm32(int rho) { const int n = rho >> 4, i = rho & 15; return 8 * (i >> 2) + 4 * n + (i & 3); }

struct Unit { const char* A; const char* B; int pm, pn, aux; const int* rows; };
struct Gemm { int lda, ldb, K; };

struct TileOrder {
    int nM, nN, nwg, G, c;
    __device__ void init(int nM_, int nN_, int G_, int c_) { nM = nM_; nN = nN_; nwg = nM * nN; G = G_; c = c_; }
    __device__ bool get(int i, int& pm, int& pn) const {
        const long L = (long)i * G + c; if (L >= nwg) return false;
        int wgid = (int)L; { const int q = nwg / NXCD, r = nwg % NXCD, xcd = wgid % NXCD, off = wgid / NXCD; wgid = (xcd < r ? xcd * (q + 1) : r * (q + 1) + (xcd - r) * q) + off; }
        const int nig = WGM * nN, gid = wgid / nig, fm = gid * WGM, gsz = (nM - fm) < WGM ? (nM - fm) : WGM;
        pm = fm + ((wgid % nig) % gsz); pn = (wgid % nig) / gsz; return true;
    }
};

typedef float f32x2g __attribute__((ext_vector_type(2)));
__device__ __forceinline__ f32x2g gelu_pk(f32x2g v) {
    const f32x2g av = __builtin_elementwise_abs(v), d = av * 0.2316418882f + 1.0f;
    f32x2g t; t.x = __builtin_amdgcn_rcpf(d.x); t.y = __builtin_amdgcn_rcpf(d.y);
    f32x2g q = t * 0.5307027145f + (-0.7265760135f); q = q * t + 0.7107068705f; q = q * t + (-0.142248368f); q = q * t + 0.127414796f; q = q * t;
    const f32x2g s = (v * v) * (-0.72134752044f);
    f32x2g e; e.x = __builtin_amdgcn_exp2f(s.x); e.y = __builtin_amdgcn_exp2f(s.y);
    const f32x2g m = v * (q * e), r = v - m;
    f32x2g o; o.x = v.x < 0.f ? m.x : r.x; o.y = v.y < 0.f ? m.y : r.y; return o;
}

template <class Epi, class Sched, bool GATHER = false>
__device__ __forceinline__ void gemm_phase(LAS unsigned char* lds, int wid, const Gemm g, const Sched& S, const Epi& E) {
    const int lane = lane_id(), tid = wid * 64 + lane, wr = wid >> 2, wc = wid & 3, fr = lane & 15, fq = lane >> 4;
    const int nt = g.K / BK;
    unsigned voffB[2]; unsigned vA0[2], vA1[2]; int RA[2], CA[2];
#pragma unroll
    for (int i = 0; i < 2; ++i) { int R, C; stage_rc(tid * 16 + i * 8192, R, C); const int Rb = Epi::PERM ? ((R & ~31) + perm32(R & 31)) : R;
        RA[i] = R; CA[i] = C; voffB[i] = (unsigned)(Rb * g.ldb + C) * 2u;
        vA0[i] = (unsigned)(R * g.lda + C) * 2u; vA1[i] = vA0[i]; }
    const size_t kstep = (size_t)(BK * 2);
    const size_t hstepA = GATHER ? (size_t)0 : (size_t)HALF * g.lda * 2, hstepB = (size_t)HALF * g.ldb * 2;
    LAS u32x4* park = (LAS u32x4*)(lds + 131072 + 1024) + tid;
#define PG8_GOFF(U, d0, d1) do { _Pragma("unroll") for (int _i = 0; _i < 2; ++_i) { \
        d0[_i] = ((unsigned)(U).rows[RA[_i]] * (unsigned)g.lda + (unsigned)CA[_i]) * 2u; d1[_i] = ((unsigned)(U).rows[HALF + RA[_i]] * (unsigned)g.lda + (unsigned)CA[_i]) * 2u; } } while (0)
    const unsigned ldsw = (unsigned)wid * 1024u;
    const int aoff = lds_byte(wr * 64 + fr, fq * 8), boff = lds_byte(wc * 32 + fr, fq * 8);
#define PG8_SA(b, h) (((b) * 2 + (h)) * HTB)
#define PG8_SB(b, h) ((4 + (b) * 2 + (h)) * HTB)
#define PG8_STAGE(bufoff, gbase, voff) do { _Pragma("unroll") for (int _i = 0; _i < 2; ++_i) \
        __builtin_amdgcn_global_load_lds((const unsigned*)((const char*)(gbase) + (voff)[_i]), (LAS unsigned*)(lds + (bufoff) + ldsw + _i * 8192), 16, 0, 0); } while (0)
#define PG8_LDA(dst, b, h) do { _Pragma("unroll") for (int m = 0; m < 4; ++m) _Pragma("unroll") for (int k = 0; k < 2; ++k) dst[m][k] = *(const LAS bf16x8*)(lds + PG8_SA(b, h) + aoff + m * 2048 + k * 1024); } while (0)
#define PG8_LDB(dst, b, h) do { _Pragma("unroll") for (int n = 0; n < 2; ++n) _Pragma("unroll") for (int k = 0; k < 2; ++k) dst[n][k] = *(const LAS bf16x8*)(lds + PG8_SB(b, h) + boff + n * 2048 + k * 1024); } while (0)
#define PG8_MMA(ai, bj, At, Bt) do { __builtin_amdgcn_s_setprio(1); _Pragma("unroll") for (int m = 0; m < 4; ++m) _Pragma("unroll") for (int n = 0; n < 2; ++n) _Pragma("unroll") for (int k = 0; k < 2; ++k) \
        acc[ai][bj][m][n] = __builtin_amdgcn_mfma_f32_16x16x32_bf16(Bt[n][k], At[m][k], acc[ai][bj][m][n], 0, 0, 0); __builtin_amdgcn_s_setprio(0); } while (0)
#define PG8_WAIT_V(n) asm volatile("s_waitcnt vmcnt(" #n ")" ::: "memory")
#define PG8_WAIT_L(n) asm volatile("s_waitcnt lgkmcnt(" #n ")" ::: "memory")
#define PG8_BAR __builtin_amdgcn_s_barrier()
#define PG8_SCHED __builtin_amdgcn_sched_barrier(0)
    Unit cur, nxt; int ui = 0;
    if (!S.next(0, cur)) return;
    f32x4 acc[2][2][4][2];
#pragma unroll
    for (int a = 0; a < 2; ++a)
#pragma unroll
        for (int b = 0; b < 2; ++b)
#pragma unroll
            for (int m = 0; m < 4; ++m)
#pragma unroll
                for (int n = 0; n < 2; ++n) acc[a][b][m][n] = (f32x4){0.f, 0.f, 0.f, 0.f};
    bf16x8 At[4][2], B0[2][2], B1[2][2];
    const char* cA = cur.A; const char* cB = cur.B;
    if constexpr (GATHER) { PG8_GOFF(cur, vA0, vA1); }
    PG8_STAGE(PG8_SB(0, 0), cB, voffB); PG8_STAGE(PG8_SB(0, 1), cB + hstepB, voffB); PG8_STAGE(PG8_SA(0, 0), cA, vA0); PG8_STAGE(PG8_SA(0, 1), cA + hstepA, vA1);
    if (wr == 1) PG8_BAR;
    PG8_WAIT_V(2); PG8_BAR;
    PG8_STAGE(PG8_SB(1, 0), cB + kstep, voffB); PG8_STAGE(PG8_SA(1, 0), cA + kstep, vA0); PG8_STAGE(PG8_SB(1, 1), cB + hstepB + kstep, voffB);
    PG8_WAIT_V(6); PG8_BAR;
    for (;;) {
        const bool has_next = S.next(ui + 1, nxt);
        const char* nA = has_next ? nxt.A : cA; const char* nB = has_next ? nxt.B : cB;
        if constexpr (GATHER) { unsigned n0[2] = {vA0[0], vA0[1]}, n1[2] = {vA1[0], vA1[1]}; if (has_next) { PG8_GOFF(nxt, n0, n1); } *park = (u32x4){n0[0], n0[1], n1[0], n1[1]}; }
        for (int t = 0; t < nt; t += 2) {
            const bool last = (t == nt - 2);
            const char* a1 = cA + (size_t)(t + 1) * kstep;
            const char* a2 = last ? nA : cA + (size_t)(t + 2) * kstep; const char* b2 = last ? nB : cB + (size_t)(t + 2) * kstep;
            const char* a3 = a2 + kstep; const char* b3 = b2 + kstep;
            unsigned w0[2] = {vA0[0], vA0[1]}, w1[2] = {vA1[0], vA1[1]};
            if constexpr (GATHER) { if (last) { const u32x4 pk = *park; w0[0] = pk.x; w0[1] = pk.y; w1[0] = pk.z; w1[1] = pk.w; } }
            PG8_LDB(B0, 0, 0); PG8_LDB(B1, 0, 1); PG8_SCHED; PG8_LDA(At, 0, 0); PG8_STAGE(PG8_SA(1, 1), a1 + hstepA, vA1);
            PG8_WAIT_V(8); PG8_WAIT_L(0); PG8_BAR; PG8_MMA(0, 0, At, B0); PG8_MMA(0, 1, At, B1); PG8_BAR; PG8_SCHED;
            PG8_LDA(At, 0, 1); PG8_STAGE(PG8_SB(0, 0), b2, voffB); PG8_STAGE(PG8_SB(0, 1), b2 + hstepB, voffB); PG8_STAGE(PG8_SA(0, 0), a2, w0);
            PG8_WAIT_V(8); PG8_WAIT_L(0); PG8_BAR; PG8_MMA(1, 0, At, B0); PG8_MMA(1, 1, At, B1); PG8_BAR; PG8_SCHED;
            PG8_LDB(B0, 1, 0); PG8_LDB(B1, 1, 1); PG8_SCHED; PG8_LDA(At, 1, 0); PG8_STAGE(PG8_SA(0, 1), a2 + hstepA, w1);
            PG8_WAIT_V(8); PG8_WAIT_L(0); PG8_BAR; PG8_MMA(0, 0, At, B0); PG8_MMA(0, 1, At, B1); PG8_BAR; PG8_SCHED;
            PG8_LDA(At, 1, 1); PG8_STAGE(PG8_SB(1, 0), b3, voffB); PG8_STAGE(PG8_SB(1, 1), b3 + hstepB, voffB); PG8_STAGE(PG8_SA(1, 0), a3, w0);
            PG8_WAIT_V(8); PG8_WAIT_L(0); PG8_BAR; PG8_MMA(1, 0, At, B0); PG8_MMA(1, 1, At, B1); PG8_BAR; PG8_SCHED;
        }
        if (wr == 0) PG8_BAR;
        { const int l2_ = lane_id(); E(acc, cur, wr, wc, l2_ & 15, l2_ >> 4); }
        if (!has_next) break;
#pragma unroll
        for (int a = 0; a < 2; ++a)
#pragma unroll
            for (int b = 0; b < 2; ++b)
#pragma unroll
                for (int m = 0; m < 4; ++m)
#pragma unroll
                    for (int n = 0; n < 2; ++n) acc[a][b][m][n] = (f32x4){0.f, 0.f, 0.f, 0.f};
        cur = nxt; cA = nA; cB = nB; ++ui;
        if constexpr (GATHER) { const u32x4 pk = *park; vA0[0] = pk.x; vA0[1] = pk.y; vA1[0] = pk.z; vA1[1] = pk.w; }
        if (wr == 1) PG8_BAR;
    }
    PG8_WAIT_V(0);
    PG8_BAR;
#undef PG8_GOFF
#undef PG8_SA
#undef PG8_SB
#undef PG8_STAGE
#undef PG8_LDA
#undef PG8_LDB
#undef PG8_MMA
#undef PG8_WAIT_V
#undef PG8_WAIT_L
#undef PG8_BAR
#undef PG8_SCHED
}

struct PlainSched {
    TileOrder to; const char* A; const char* B; size_t tA, tB;
    __device__ __forceinline__ bool next(int i, Unit& u) const { int pm, pn; if (!to.get(i, pm, pn)) return false; u.pm = pm; u.pn = pn; u.aux = 0; u.rows = nullptr; u.A = A + (size_t)pm * tA; u.B = B + (size_t)pn * tB; return true; }
};
struct MemAttnSched {
    TileOrder to; const char* A; const char* B; size_t bB, hB;
    __device__ __forceinline__ bool next(int i, Unit& u) const { int pm, pn; if (!to.get(i, pm, pn)) return false; u.pm = pm; u.pn = pn; u.aux = 0; u.rows = nullptr;
        u.A = A + (size_t)pm * (256 * DM * 2) + (size_t)pn * 512; const int b = pm >> 5; u.B = B + (size_t)b * bB + (size_t)pn * hB; return true; }
};
struct MoeSched {
    int G, c, nblk; const unsigned* blk_e; const char* A; const char* B; size_t tA, eB, tB; const int* row_tok;
    __device__ __forceinline__ bool next(int i, Unit& u) const { const int L = i * G + c; if (L >= nblk * 4) return false; const int rb = L >> 2, pn = L & 3;
        const int e = (int)__builtin_amdgcn_readfirstlane(ld_u32_agent(blk_e + rb)); u.pm = rb; u.pn = pn; u.aux = e; u.rows = row_tok + (size_t)rb * 256;
        u.A = A + (size_t)rb * tA; u.B = B + (size_t)e * eB + (size_t)pn * tB; return true; }
};

#define EPI_ARGS f32x4 (&acc)[2][2][4][2], const Unit& u, int wr, int wc, int fr, int fq
struct EpiZ {
    static constexpr bool PERM = true;
    bf16_t* O; unsigned* kmx;
    __device__ __forceinline__ void operator()(EPI_ARGS) const {
        const int row0 = u.pm * BM + wr * 64 + fr, col0 = u.pn * BM + wc * 32 + 8 * fq;
        const int mode = u.pn < 4 ? 1 : (u.pn < 6 ? 2 : 0);
        if (u.pn == 6 || u.pn == 7) {
#pragma unroll
            for (int bj = 0; bj < 2; ++bj) { float mx = 0.f;
#pragma unroll
                for (int ai = 0; ai < 2; ++ai)
#pragma unroll
                    for (int m = 0; m < 4; ++m) { const f32x4 a = acc[ai][bj][m][0], b = acc[ai][bj][m][1];
                        float q = (a[0] * a[0] + a[1] * a[1]) + (a[2] * a[2] + a[3] * a[3]) + (b[0] * b[0] + b[1] * b[1]) + (b[2] * b[2] + b[3] * b[3]);
                        q += __shfl_xor(q, 16); q += __shfl_xor(q, 32); mx = fmaxf(mx, q); }
#pragma unroll
                for (int o_ = 1; o_ < 16; o_ <<= 1) mx = fmaxf(mx, __shfl_xor(mx, o_));
                if (fr == 0 && fq == 0) { const int b_ = u.pm >> 5, h_ = (u.pn - 6) * 2 + bj; atomicMax(kmx + (((b_ * 4 + h_) * 2 + (wc >> 1)) * 2 + (wc & 1)), __float_as_uint(mx)); } }
        }
#pragma unroll
        for (int ai = 0; ai < 2; ++ai)
#pragma unroll
            for (int m = 0; m < 4; ++m) { bf16_t* rowp = O + (size_t)(row0 + ai * HALF + m * 16) * ZP + col0;
#pragma unroll
                for (int bj = 0; bj < 2; ++bj) { f32x4 v0 = acc[ai][bj][m][0], v1 = acc[ai][bj][m][1];
                    if (mode == 1) { f32x2g a = gelu_pk((f32x2g){v0[0], v0[1]}), b = gelu_pk((f32x2g){v0[2], v0[3]}), c = gelu_pk((f32x2g){v1[0], v1[1]}), d = gelu_pk((f32x2g){v1[2], v1[3]});
                        v0 = (f32x4){a.x, a.y, b.x, b.y}; v1 = (f32x4){c.x, c.y, d.x, d.y}; }
                    else if (mode == 2) { v0 = v0 * C2_DIFF; v1 = v1 * C2_DIFF; }
                    u32x4 w; w.x = cvt_pk_bf16(v0[0], v0[1]); w.y = cvt_pk_bf16(v0[2], v0[3]); w.z = cvt_pk_bf16(v1[0], v1[1]); w.w = cvt_pk_bf16(v1[2], v1[3]);
                    *(u32x4*)(rowp + bj * HALF) = w; } }
    }
};
struct EpiBf16 {
    static constexpr bool PERM = true;
    bf16_t* O; int ldc; const float* ssq; float cscale;
    __device__ __forceinline__ void operator()(EPI_ARGS) const {
        const int row0 = u.pm * BM + wr * 64 + fr, col0 = u.pn * BM + wc * 32 + 8 * fq;
#pragma unroll
        for (int ai = 0; ai < 2; ++ai)
#pragma unroll
            for (int m = 0; m < 4; ++m) { const int row = row0 + ai * HALF + m * 16; float sc = cscale;
                if (ssq) { const f32x4* sp = (const f32x4*)(ssq + (size_t)row * 16); const f32x4 s4 = (sp[0] + sp[1]) + (sp[2] + sp[3]);
                    sc *= __builtin_amdgcn_rsqf(((s4[0] + s4[1]) + (s4[2] + s4[3])) * (1.0f / DM) + RMS_EPS); }
                bf16_t* rowp = O + (size_t)row * ldc + col0;
#pragma unroll
                for (int bj = 0; bj < 2; ++bj) { const f32x4 v0 = acc[ai][bj][m][0] * sc, v1 = acc[ai][bj][m][1] * sc;
                    u32x4 w; w.x = cvt_pk_bf16(v0[0], v0[1]); w.y = cvt_pk_bf16(v0[2], v0[3]); w.z = cvt_pk_bf16(v1[0], v1[1]); w.w = cvt_pk_bf16(v1[2], v1[3]);
                    *(u32x4*)(rowp + bj * HALF) = w; } }
    }
};
struct EpiSoftmax {
    static constexpr bool PERM = true;
    bf16_t* O; LAS float* xch;
    __device__ __forceinline__ void operator()(EPI_ARGS) const {
        const int row0 = u.pm * BM + wr * 64 + fr, col0 = u.pn * BM + wc * 32 + 8 * fq;
        LAS float* xm = xch; LAS float* xs = xch + 1024;
#pragma unroll
        for (int ai = 0; ai < 2; ++ai)
#pragma unroll
            for (int m = 0; m < 4; ++m) { float v = -__builtin_inff();
#pragma unroll
                for (int bj = 0; bj < 2; ++bj)
#pragma unroll
                    for (int n = 0; n < 2; ++n) { const f32x4 a = acc[ai][bj][m][n]; v = fmaxf(v, fmaxf(fmaxf(a[0], a[1]), fmaxf(a[2], a[3]))); }
                v = fmaxf(v, __shfl_xor(v, 16)); v = fmaxf(v, __shfl_xor(v, 32));
                if (fq == 0) xm[(ai * HALF + wr * 64 + m * 16 + fr) * 4 + wc] = v; }
        asm volatile("s_waitcnt lgkmcnt(0)" ::: "memory"); __builtin_amdgcn_s_barrier(); asm volatile("" ::: "memory");
#pragma unroll
        for (int ai = 0; ai < 2; ++ai)
#pragma unroll
            for (int m = 0; m < 4; ++m) { const f32x4 t = *(const LAS f32x4*)(xm + (ai * HALF + wr * 64 + m * 16 + fr) * 4); const float mx = fmaxf(fmaxf(t[0], t[1]), fmaxf(t[2], t[3])); float sm = 0.f;
#pragma unroll
                for (int bj = 0; bj < 2; ++bj)
#pragma unroll
                    for (int n = 0; n < 2; ++n) { f32x4 a = acc[ai][bj][m][n];
#pragma unroll
                        for (int j = 0; j < 4; ++j) { a[j] = __builtin_amdgcn_exp2f(a[j] - mx); sm += a[j]; }
                        acc[ai][bj][m][n] = a; }
                sm += __shfl_xor(sm, 16); sm += __shfl_xor(sm, 32);
                if (fq == 0) xs[(ai * HALF + wr * 64 + m * 16 + fr) * 4 + wc] = sm; }
        asm volatile("s_waitcnt lgkmcnt(0)" ::: "memory"); __builtin_amdgcn_s_barrier(); asm volatile("" ::: "memory");
#pragma unroll
        for (int ai = 0; ai < 2; ++ai)
#pragma unroll
            for (int m = 0; m < 4; ++m) { const f32x4 t = *(const LAS f32x4*)(xs + (ai * HALF + wr * 64 + m * 16 + fr) * 4); const float inv = __builtin_amdgcn_rcpf((t[0] + t[1]) + (t[2] + t[3]));
                bf16_t* rowp = O + (size_t)(row0 + ai * HALF + m * 16) * DM + col0;
#pragma unroll
                for (int bj = 0; bj < 2; ++bj) { const f32x4 v0 = acc[ai][bj][m][0] * inv, v1 = acc[ai][bj][m][1] * inv;
                    u32x4 w; w.x = cvt_pk_bf16(v0[0], v0[1]); w.y = cvt_pk_bf16(v0[2], v0[3]); w.z = cvt_pk_bf16(v1[0], v1[1]); w.w = cvt_pk_bf16(v1[2], v1[3]);
                    *(u32x4*)(rowp + bj * HALF) = w; } }
    }
};
template <bool BF>
struct EpiResid {
    static constexpr bool PERM = true;
    const void* base; bf16_t* ob; float* ssq;
    __device__ __forceinline__ void operator()(EPI_ARGS) const {
        const int row0 = u.pm * BM + wr * 64 + fr, col0 = u.pn * BM + wc * 32 + 8 * fq;
#pragma unroll
        for (int ai = 0; ai < 2; ++ai)
#pragma unroll
            for (int m = 0; m < 4; ++m) { const int row = row0 + ai * HALF + m * 16; const size_t off = (size_t)row * DM + col0; float s = 0.f;
#pragma unroll
                for (int bj = 0; bj < 2; ++bj) { f32x4 b0, b1;
                    if constexpr (BF) { const u32x4 r = *(const u32x4*)((const bf16_t*)base + off + bj * HALF); b0 = (f32x4){bf_lo(r.x), bf_hi(r.x), bf_lo(r.y), bf_hi(r.y)}; b1 = (f32x4){bf_lo(r.z), bf_hi(r.z), bf_lo(r.w), bf_hi(r.w)}; }
                    else { b0 = *(const f32x4*)((const float*)base + off + bj * HALF); b1 = *(const f32x4*)((const float*)base + off + bj * HALF + 4); }
                    const f32x4 o0 = b0 + acc[ai][bj][m][0], o1 = b1 + acc[ai][bj][m][1];
                    s += (o0[0] * o0[0] + o0[1] * o0[1]) + (o0[2] * o0[2] + o0[3] * o0[3]) + (o1[0] * o1[0] + o1[1] * o1[1]) + (o1[2] * o1[2] + o1[3] * o1[3]);
                    u32x4 w; w.x = cvt_pk_bf16(o0[0], o0[1]); w.y = cvt_pk_bf16(o0[2], o0[3]); w.z = cvt_pk_bf16(o1[0], o1[1]); w.w = cvt_pk_bf16(o1[2], o1[3]);
                    *(u32x4*)(ob + off + bj * HALF) = w; }
                s += __shfl_xor(s, 16); s += __shfl_xor(s, 32);
                if (fq == 0) ssq[(size_t)row * 16 + u.pn * 4 + wc] = s; }
    }
};
struct EpiRouter {
    static constexpr bool PERM = false;
    float* L; const float* ssq; const float* bg; const float* be; float* rstd_out;
    __device__ __forceinline__ void operator()(EPI_ARGS) const {
        if (wc >= 2) return;
        const int row0 = u.pm * BM + wr * 64 + fr;
#pragma unroll
        for (int ai = 0; ai < 2; ++ai)
#pragma unroll
            for (int m = 0; m < 4; ++m) { const int row = row0 + ai * HALF + m * 16;
                const f32x4* sp = (const f32x4*)(ssq + (size_t)row * 16); const f32x4 s4 = (sp[0] + sp[1]) + (sp[2] + sp[3]);
                const float rs = __builtin_amdgcn_rsqf(((s4[0] + s4[1]) + (s4[2] + s4[3])) * (1.0f / DM) + RMS_EPS);
                if (wc == 0 && fq == 0) rstd_out[row] = rs;
#pragma unroll
                for (int n = 0; n < 2; ++n) { const int c0 = wc * 32 + n * 16 + 4 * fq; f32x4 o = acc[ai][0][m][n] * rs;
#pragma unroll
                    for (int j = 0; j < 4; ++j) { const int c = c0 + j; const float b = c < 4 ? bg[c] : (c < 36 ? be[c - 4] : 0.f); o[j] += b; }
                    *(f32x4*)(L + (size_t)row * 64 + c0) = o; } }
    }
};
struct EpiGateUp {
    static constexpr bool PERM = true;
    bf16_t* act; const float* rstd; const int* row_tok;
    __device__ __forceinline__ void operator()(EPI_ARGS) const {
        const int row0 = u.pm * BM + wr * 64 + fr, col0 = u.pn * 128 + wc * 32 + 8 * fq;
#pragma unroll
        for (int ai = 0; ai < 2; ++ai)
#pragma unroll
            for (int m = 0; m < 4; ++m) { const int row = row0 + ai * HALF + m * 16; const float rs = rstd[row];
                float r[8];
#pragma unroll
                for (int n = 0; n < 2; ++n)
#pragma unroll
                    for (int j = 0; j < 4; ++j) { const float gg = acc[ai][0][m][n][j] * rs, uu = acc[ai][1][m][n][j] * rs;
                        r[n * 4 + j] = gg * __builtin_amdgcn_rcpf(1.0f + __builtin_amdgcn_exp2f(-gg * LOG2E)) * uu; }
                u32x4 w; w.x = cvt_pk_bf16(r[0], r[1]); w.y = cvt_pk_bf16(r[2], r[3]); w.z = cvt_pk_bf16(r[4], r[5]); w.w = cvt_pk_bf16(r[6], r[7]);
                *(u32x4*)(act + (size_t)row * DEXP + col0) = w; }
    }
};
}

namespace da {
constexpr int NW = 8, QBLK = 32, KVBLK = 64, QB = NW * QBLK, DV = 128;
constexpr int SHM_V = KVBLK * DV * 2, SHM_K = KVBLK * 64 * 2;
constexpr int LDS_V = 0, LDS_K = 2 * SHM_V, LDS_WS = LDS_K + 2 * SHM_K, LDS_CX = LDS_WS + NW * 64 * 4, LDS_STASH = LDS_CX + 256, LDS_BYTES = LDS_STASH + NW * 8192;
constexpr float SKIP_MARGIN = 40.f;
constexpr float THR = 8.f;
#define SBAR() __builtin_amdgcn_sched_barrier(0)
__device__ __forceinline__ int kswz(int row, int chunk) { return row * 128 + ((chunk ^ ((row >> 1) & 7)) << 4); }
__device__ __forceinline__ int v_st(int k, int c) { const int kk = (k & ~0xC) | ((k & 4) << 1) | ((k & 8) >> 1); return ((kk >> 3) * 4 + (c >> 5)) * 512 + ((kk & 7) * 32 + (c & 31)) * 2; }
__device__ __forceinline__ int v_rd_base(int lane) { return ((lane & 3) << 3) | (((lane >> 2) & 3) << 6) | (((lane >> 4) & 1) << 5) | (((lane >> 5) & 1) << 8); }
constexpr int v_rd_off(int d0, int ks, int half) { return d0 * 512 + ks * 4096 + half * 2048; }
__device__ __forceinline__ int crow(int r, int hi) { return (r & 3) + 8 * (r >> 2) + 4 * hi; }
__device__ __forceinline__ bf16x8 load8(const bf16_t* p) { return *reinterpret_cast<const bf16x8*>(p); }

__device__ __forceinline__ void mask_tile(f32x16& p0, f32x16& p1, int dq) {
    const float NEG = -__builtin_inff();
#pragma unroll
    for (int r = 0; r < 16; ++r) { const int c = (r & 3) + 8 * (r >> 2); if (dq - c < 0) p0[r] = NEG; if (dq - c - 32 < 0) p1[r] = NEG; }
}
__device__ __forceinline__ void partialSM(f32x16& p0, f32x16& p1, float& m_reg, float& alpha) {
    float pmax = p0[0];
#pragma unroll
    for (int r = 1; r < 16; ++r) pmax = fmaxf(pmax, p0[r]);
#pragma unroll
    for (int r = 0; r < 16; ++r) pmax = fmaxf(pmax, p1[r]);
    { auto rr = __builtin_amdgcn_permlane32_swap(__float_as_uint(pmax), __float_as_uint(pmax), false, false); pmax = fmaxf(__uint_as_float(rr[0]), __uint_as_float(rr[1])); }
    float mn;
    if (__builtin_expect(__all((pmax - m_reg) <= THR), 1)) { mn = m_reg; alpha = 1.f; }
    else { mn = fmaxf(m_reg, pmax); alpha = __builtin_amdgcn_exp2f(m_reg - mn); m_reg = mn; }
#pragma unroll
    for (int r = 0; r < 16; ++r) p0[r] = p0[r] - mn;
#pragma unroll
    for (int r = 0; r < 16; ++r) p1[r] = p1[r] - mn;
#pragma unroll
    for (int r = 0; r < 16; ++r) p0[r] = __builtin_amdgcn_exp2f(p0[r]);
}
__device__ __forceinline__ void finishSM(f32x16& p0, f32x16& p1, float alpha, float& l_reg, bf16x8& pa0, bf16x8& pa1, bf16x8& pa2, bf16x8& pa3) {
#pragma unroll
    for (int r = 0; r < 16; ++r) p1[r] = __builtin_amdgcn_exp2f(p1[r]);
    float ps = 0;
#pragma unroll
    for (int r = 0; r < 16; ++r) ps += p0[r];
#pragma unroll
    for (int r = 0; r < 16; ++r) ps += p1[r];
    { auto rr = __builtin_amdgcn_permlane32_swap(__float_as_uint(ps), __float_as_uint(ps), false, false); ps = __uint_as_float(rr[0]) + __uint_as_float(rr[1]); }
    l_reg = l_reg * alpha + ps;
#define PK4(P, B_, OUT) do { unsigned a0 = cvt_pk_bf16(P[B_+0], P[B_+1]), a1 = cvt_pk_bf16(P[B_+2], P[B_+3]);                          \
        unsigned b0 = cvt_pk_bf16(P[B_+4], P[B_+5]), b1 = cvt_pk_bf16(P[B_+6], P[B_+7]);                                             \
        auto r0 = __builtin_amdgcn_permlane32_swap(a0, b0, false, false); auto r1 = __builtin_amdgcn_permlane32_swap(a1, b1, false, false); \
        u32x4 w = {r0[0], r1[0], r0[1], r1[1]}; OUT = *reinterpret_cast<bf16x8*>(&w); } while (0)
    PK4(p0, 0, pa0); PK4(p0, 8, pa1); PK4(p1, 0, pa2); PK4(p1, 8, pa3);
#undef PK4
}
template <int KB>
__device__ __forceinline__ void qkt(f32x16& p0, f32x16& p1, const char* K_lds, int r32, int hi, const bf16x8* qr, float ab, float slope2) {
    const float s32 = 32.f * slope2;
#pragma unroll
    for (int r = 0; r < 16; ++r) { p0[r] = fmaf(slope2, (float)((r & 3) + 8 * (r >> 2)), ab); p1[r] = p0[r] + s32; }
#pragma unroll
    for (int d0 = 0; d0 < 4; ++d0) { const char* a = K_lds + KB * SHM_K + kswz(r32, d0 * 2 + hi);
        bf16x8 b0 = *reinterpret_cast<const bf16x8*>(a);
        bf16x8 b1 = *reinterpret_cast<const bf16x8*>(a + 32 * 128);
        p0 = __builtin_amdgcn_mfma_f32_32x32x16_bf16(b0, qr[d0], p0, 0, 0, 0);
        p1 = __builtin_amdgcn_mfma_f32_32x32x16_bf16(b1, qr[d0], p1, 0, 0, 0); }
}
template <int VB>
__device__ __forceinline__ void pv_tile(f32x16* o, int vb0, bf16x8 pa0, bf16x8 pa1, bf16x8 pa2, bf16x8 pa3) {
#define TRRD(dst, off) asm volatile("ds_read_b64_tr_b16 %0, %1 offset:%2" : "=&v"(dst) : "v"(vb0), "i"(off) : "memory")
#define PV_D0(d0) do { s16x4 l0, l1, l2, l3, h0, h1, h2, h3; constexpr int b_ = VB * SHM_V + v_rd_off(d0, 0, 0); \
        TRRD(l0, b_); TRRD(h0, b_ + 2048); TRRD(l1, b_ + 4096); TRRD(h1, b_ + 6144); TRRD(l2, b_ + 8192); TRRD(h2, b_ + 10240); TRRD(l3, b_ + 12288); TRRD(h3, b_ + 14336); \
        asm volatile("s_waitcnt lgkmcnt(0)" ::: "memory"); SBAR();   \
        o[d0] = __builtin_amdgcn_mfma_f32_32x32x16_bf16(pa0, (bf16x8){l0[0], l0[1], l0[2], l0[3], h0[0], h0[1], h0[2], h0[3]}, o[d0], 0, 0, 0);   \
        o[d0] = __builtin_amdgcn_mfma_f32_32x32x16_bf16(pa1, (bf16x8){l1[0], l1[1], l1[2], l1[3], h1[0], h1[1], h1[2], h1[3]}, o[d0], 0, 0, 0);   \
        o[d0] = __builtin_amdgcn_mfma_f32_32x32x16_bf16(pa2, (bf16x8){l2[0], l2[1], l2[2], l2[3], h2[0], h2[1], h2[2], h2[3]}, o[d0], 0, 0, 0);   \
        o[d0] = __builtin_amdgcn_mfma_f32_32x32x16_bf16(pa3, (bf16x8){l3[0], l3[1], l3[2], l3[3], h3[0], h3[1], h3[2], h3[3]}, o[d0], 0, 0, 0); } while (0)
    PV_D0(0); PV_D0(1); PV_D0(2); PV_D0(3);
#undef PV_D0
#undef TRRD
}

struct BlockRef { const bf16_t* Q; const bf16_t* K; const bf16_t* V; bf16_t* O; int P0; int mode; float slope2; float kmax; };
struct Seam { bf16x8 qr[4]; bf16x8 st_v0, st_v1, st_k0; };
__device__ __forceinline__ BlockRef mkref(const bf16_t* Z, bf16_t* AO, const unsigned* kmx, int item, int pass) { BlockRef r; const int bh = item >> 4, y = item & 15, b = bh >> 2, h = bh & 3; const int qb = (pass < 2) ? y : 31 - y, mp = pass & 1;
    const bf16_t* zb = Z + (size_t)b * SEQ * ZP; r.Q = zb + (size_t)(qb * 256) * ZP + ZQ + h * 128 + mp * 64; r.K = zb + ZK + h * 128 + mp * 64; r.V = zb + ZVAL + h * 128;
    r.O = AO + ((size_t)b * SEQ + qb * 256) * DM + 512 + h * 128; r.P0 = qb * 256; r.mode = mp; r.slope2 = exp2f(-2.0f * (float)(h + 1)) * LOG2E;
    const unsigned* kp = kmx + ((bh * 2 + mp) * 2); r.kmax = 1.01f * sqrtf(__uint_as_float(ld_u32_agent(kp)) + __uint_as_float(ld_u32_agent(kp + 1))); return r; }
#define ROWV(p, k0, rr) ((p) + (size_t)((k0) + (rr)) * ZP + sc)
#define ROWK(p, k0) ((p) + (size_t)((k0) + skr) * ZP + skc * 8)
#define VMW() asm volatile("s_waitcnt vmcnt(0)" ::: "memory")
#define VMWN(n) asm volatile("s_waitcnt vmcnt(%0)" :: "i"(n) : "memory")
#define SLOAD_H(Kp, Vp, k0) do { S.st_v0 = load8(ROWV(Vp, k0, sr)); S.st_v1 = load8(ROWV(Vp, k0, 32 + sr)); S.st_k0 = load8(ROWK(Kp, k0)); } while (0)
#define SWRITE_HK(bf) do { *(bf16x8*)(K_lds + (bf) * SHM_K + kws) = S.st_k0; } while (0)
#define SWRITE_HV(bf) do { *(bf16x8*)(V_lds + (bf) * SHM_V + vst0) = S.st_v0; *(bf16x8*)(V_lds + (bf) * SHM_V + vst1) = S.st_v1; } while (0)
#define SWRITE_H(bf) do { SWRITE_HV(bf); SWRITE_HK(bf); } while (0)
__device__ __forceinline__ void prime(const BlockRef& cur, char* lds, Seam& S, int wid) {
    const int lane = lane_id(), tid = wid * 64 + lane, r32 = lane & 31, hi = lane >> 5;
    const int sr = tid >> 4, sc = (tid & 15) * 8, skr = tid >> 3, skc = tid & 7, kws = kswz(skr, skc); char* K_lds = lds + LDS_K;
#pragma unroll
    for (int d0 = 0; d0 < 4; ++d0) S.qr[d0] = load8(cur.Q + (size_t)(wid * QBLK + r32) * ZP + d0 * 16 + hi * 8);
    SLOAD_H(cur.K, cur.V, cur.P0 + QB - KVBLK); VMW(); SWRITE_HK(0);
    __syncthreads();
}
__device__ __forceinline__ void block(const BlockRef& cur, const BlockRef& nxt, char* lds, Seam& S, float lam, const float* __restrict__ subln, int wid) {
    const int lane = lane_id(), tid = wid * 64 + lane, r32 = lane & 31, hi = lane >> 5;
    const int NT0 = (cur.P0 + QB) / KVBLK;
    int NT = NT0;
    const int qlo = cur.P0 + wid * QBLK, qm = qlo + r32 - 4 * hi;
    const float slope2 = cur.slope2;
    char* V_lds = lds + LDS_V; char* K_lds = lds + LDS_K;
    float* ws = (float*)(lds + LDS_WS) + wid * 64; float* li_l = ws, * al_l = ws + 32;
    float m_reg = -1e30f, l_reg = 0; f32x16 o[4] = {};
    const int sr = tid >> 4, sc = (tid & 15) * 8, vst0 = v_st(sr, sc), vst1 = v_st(32 + sr, sc), skr = tid >> 3, skc = tid & 7, kws = kswz(skr, skc);
    const int vb0 = (int)(uintptr_t)V_lds + v_rd_base(lane);
    const bf16_t* Kh = cur.K; const bf16_t* Vh = cur.V;
#define RESC(a) do { if (__any((a) < 1.f)) { if (hi == 0) al_l[r32] = (a); asm volatile("s_waitcnt lgkmcnt(0)" ::: "memory");              \
                     for (int d_ = 0; d_ < 4; ++d_) for (int r = 0; r < 16; ++r) o[d_][r] *= al_l[crow(r, hi)]; } } while (0)
#define KBASE(t) ((NT0 - 1 - (t)) * KVBLK)
#define AB(t) (slope2 * (float)(KBASE(t) - qm))
#define MASKT(P0_, P1_, t) do { const int kb_ = KBASE(t); if (kb_ + KVBLK - 1 > qlo) mask_tile(P0_, P1_, qm - kb_); } while (0)
    constexpr int NQL = 4;
#define SEAM_K0() do { VMWN(NQL); SWRITE_HK(0); SBAR(); } while (0)
    f32x16 pA0, pA1, pB0, pB1; float alA, alB; bf16x8 pa0, pa1, pa2, pa3;
    float cbase;
    { float q2 = 0.f;
#pragma unroll
      for (int d0 = 0; d0 < 4; ++d0)
#pragma unroll
          for (int j = 0; j < 8; ++j) { const float v = __uint_as_float(((unsigned)(unsigned short)S.qr[d0][j]) << 16); q2 = fmaf(v, v, q2); }
      { auto rr = __builtin_amdgcn_permlane32_swap(__float_as_uint(q2), __float_as_uint(q2), false, false); q2 = __uint_as_float(rr[0]) + __uint_as_float(rr[1]); }
      cbase = sqrtf(q2) * cur.kmax * 1.0001f - slope2 * (float)(qlo + r32); }
    SWRITE_HV(0); SBAR();
    if (NT > 1) { SLOAD_H(Kh, Vh, KBASE(1)); }
    SBAR(); qkt<0>(pA0, pA1, K_lds, r32, hi, S.qr, AB(0), slope2);
    MASKT(pA0, pA1, 0); partialSM(pA0, pA1, m_reg, alA);
    if (NT > 1) { VMW(); SWRITE_H(1); }
    __syncthreads();
#define HALF_STEP(PX0, PX1, alX, PY0, PY1, alY, t, KB, VB, SB) do {                                                      \
        SBAR(); qkt<KB>(PX0, PX1, K_lds, r32, hi, S.qr, AB(t), slope2);                                                   \
        finishSM(PY0, PY1, alY, l_reg, pa0, pa1, pa2, pa3); SBAR();                                                       \
        if ((t) + 1 < NT) { SLOAD_H(Kh, Vh, KBASE((t) + 1)); SBAR(); }                                                    \
        pv_tile<VB>(o, vb0, pa0, pa1, pa2, pa3); MASKT(PX0, PX1, (t)); partialSM(PX0, PX1, m_reg, alX);                   \
        __syncthreads();                                                                                                  \
        if ((t) + 1 < NT) { VMW(); SWRITE_H(SB); }                                                                        \
        RESC(alX); __syncthreads(); } while (0)
    for (int t = 1; t + 1 < NT; t += 2) {
        HALF_STEP(pB0, pB1, alB, pA0, pA1, alA, t, 1, 0, 0);
        HALF_STEP(pA0, pA1, alA, pB0, pB1, alB, t + 1, 0, 1, 1);
        if (t == 3 && NT0 > 6) {
            float c = cbase - m_reg;
#pragma unroll
            for (int o_ = 1; o_ < 64; o_ <<= 1) c = fmaxf(c, __shfl_xor(c, o_));
            float* cx = (float*)(lds + LDS_CX);
            if (lane == 0) cx[wid] = c;
            __syncthreads();
            float C = cx[0];
#pragma unroll
            for (int w_ = 1; w_ < NW; ++w_) C = fmaxf(C, cx[w_]);
            const float X = (-SKIP_MARGIN - C) / slope2 - 63.f;
            const float need_f = (float)(NT0 - 1) - X * (1.0f / 64.0f);
            if (need_f < (float)NT0) { int n = (int)ceilf(need_f); n = n < 6 ? 6 : n; n = (n + 1) & ~1; NT = n < NT0 ? n : NT0; }
        }
    }
    SBAR(); qkt<1>(pB0, pB1, K_lds, r32, hi, S.qr, AB(NT - 1), slope2); SBAR();
    SLOAD_H(nxt.K, nxt.V, nxt.P0 + QB - KVBLK); SBAR();
#pragma unroll
    for (int d0 = 0; d0 < 4; ++d0) S.qr[d0] = load8(nxt.Q + (size_t)(wid * QBLK + r32) * ZP + d0 * 16 + hi * 8);
    SBAR();
    finishSM(pA0, pA1, alA, l_reg, pa0, pa1, pa2, pa3); SBAR();
    pv_tile<0>(o, vb0, pa0, pa1, pa2, pa3);
    MASKT(pB0, pB1, NT - 1); partialSM(pB0, pB1, m_reg, alB); __syncthreads(); RESC(alB);
    finishSM(pB0, pB1, alB, l_reg, pa0, pa1, pa2, pa3); SBAR(); pv_tile<1>(o, vb0, pa0, pa1, pa2, pa3);
    SBAR(); SEAM_K0();
    if (hi == 0) li_l[r32] = l_reg; asm volatile("s_waitcnt lgkmcnt(0)" ::: "memory");
    float rli[16];
#pragma unroll
    for (int r = 0; r < 16; ++r) rli[r] = __builtin_amdgcn_rcpf(li_l[crow(r, hi)]);
    unsigned* stash = (unsigned*)(lds + LDS_STASH) + wid * 2048 + lane;
    if (cur.mode == 0) {
#pragma unroll
        for (int r = 0; r < 16; ++r) { stash[(r * 2 + 0) * 64] = cvt_pk_bf16(o[0][r] * rli[r], o[1][r] * rli[r]); stash[(r * 2 + 1) * 64] = cvt_pk_bf16(o[2][r] * rli[r], o[3][r] * rli[r]); }
    } else {
        float ssq[16];
#pragma unroll
        for (int r = 0; r < 16; ++r) { const unsigned w0 = stash[(r * 2 + 0) * 64], w1 = stash[(r * 2 + 1) * 64];
            o[0][r] = bf_lo(w0) - lam * (o[0][r] * rli[r]); o[1][r] = bf_hi(w0) - lam * (o[1][r] * rli[r]);
            o[2][r] = bf_lo(w1) - lam * (o[2][r] * rli[r]); o[3][r] = bf_hi(w1) - lam * (o[3][r] * rli[r]);
            ssq[r] = (o[0][r] * o[0][r] + o[1][r] * o[1][r]) + (o[2][r] * o[2][r] + o[3][r] * o[3][r]); }
#pragma unroll
        for (int r = 0; r < 16; ++r) {
#pragma unroll
            for (int off = 1; off < 32; off <<= 1) ssq[r] += __shfl_xor(ssq[r], off);
            ssq[r] = __builtin_amdgcn_rsqf(ssq[r] * (1.0f / DV) + RMS_EPS); }
        float g4[4];
#pragma unroll
        for (int d0 = 0; d0 < 4; ++d0) g4[d0] = subln[d0 * 32 + r32] * 0.8f;
        bf16_t* Ow = cur.O + (size_t)(wid * QBLK) * DM;
#pragma unroll
        for (int r = 0; r < 16; ++r) { const int orow = crow(r, hi);
#pragma unroll
            for (int d0 = 0; d0 < 4; ++d0) { const float v = o[d0][r] * ssq[r] * g4[d0]; const float vn = __shfl_xor(v, 1);
                if ((r32 & 1) == 0) *(unsigned*)(Ow + (size_t)orow * DM + d0 * 32 + r32) = cvt_pk_bf16(v, vn); } }
    }
    __syncthreads();
#undef RESC
#undef KBASE
#undef AB
#undef MASKT
#undef SEAM_K0
#undef HALF_STEP
}
#undef ROWV
#undef ROWK
#undef VMW
#undef VMWN
#undef SLOAD_H
#undef SWRITE_HK
#undef SWRITE_HV
#undef SWRITE_H
#undef SBAR
}


#define XB_TMO      128
#define XB_XCNT(j)  (256  + 64 * (j))
#define XB_XSUB(j)  (1280 + 64 * (j))
#define XB_XGEN(j)  (2304 + 64 * (j))
#define XB_TOP      3328
#define XB_TOPGEN   3392
#define XCD_BAR_WORDS 3456
#define XB_SPIN_CAP (1u << 22)
__device__ __forceinline__ unsigned xb_ld(unsigned* p)              { return __hip_atomic_load(p, __ATOMIC_RELAXED, __HIP_MEMORY_SCOPE_AGENT); }
__device__ __forceinline__ unsigned xb_add(unsigned* p, unsigned v) { return __hip_atomic_fetch_add(p, v, __ATOMIC_RELAXED, __HIP_MEMORY_SCOPE_AGENT); }
__device__ __forceinline__ unsigned xb_xcc_id() { return (unsigned)__builtin_amdgcn_s_getreg((3 << 11) | 20) & 0xFu; }
#define XB_SPIN(cond, bar) do { unsigned _sp = 0; while (cond) { __builtin_amdgcn_s_sleep(1); \
    if ((++_sp & 255u) == 0u) { if (xb_ld(&(bar)[XB_TMO])) break; if (_sp > XB_SPIN_CAP) { atomicAdd(&(bar)[XB_TMO], 1u); break; } } } } while (0)
struct XcdBarrier { unsigned* bar; unsigned x; volatile LAS unsigned* st; };
__device__ __forceinline__ XcdBarrier xcd_barrier_post(unsigned* bar, volatile LAS unsigned* st, bool t0) {
    XcdBarrier b; b.bar = bar; b.x = xb_xcc_id(); b.st = st;
    if (t0) (void)xb_add(&bar[XB_XCNT(b.x)], 1u);
    return b;
}
__device__ __forceinline__ void xcd_barrier_complete(unsigned* bar, unsigned x, unsigned& nloc, unsigned& nx) {
    const unsigned G = gridDim.x;
    unsigned sum, cnt, mine, sp = 0u;
    for (;;) {
        sum = 0u; cnt = 0u; mine = 0u;
#pragma unroll
        for (unsigned j = 0; j < 16; ++j) { const unsigned c = xb_ld(&bar[XB_XCNT(j)]); sum += c; cnt += (c > 0u) ? 1u : 0u; mine = (j == x) ? c : mine; }
        if (sum == G) break;
        __builtin_amdgcn_s_sleep(1);
        if ((++sp & 255u) == 0u) { if (xb_ld(&bar[XB_TMO])) break; if (sp > XB_SPIN_CAP) { atomicAdd(&bar[XB_TMO], 1u); break; } }
    }
    nloc = mine > 0u ? mine : 1u; nx = cnt > 0u ? cnt : 1u;
}
__device__ __forceinline__ void xcd_barrier(const XcdBarrier& b, bool t0) {
    asm volatile("s_waitcnt vmcnt(0)" ::: "memory");
    __syncthreads();
    if (t0) {
        unsigned* bar = b.bar;
        __builtin_amdgcn_s_waitcnt(0);
        unsigned nloc = b.st[0], nx = b.st[1];
        if (nloc == 0u) { xcd_barrier_complete(bar, b.x, nloc, nx); b.st[0] = nloc; b.st[1] = nx; }
        const unsigned old = xb_add(&bar[XB_XSUB(b.x)], 1u);
        const unsigned gen = old / nloc;
        if (old + 1u == (gen + 1u) * nloc) {
            __builtin_amdgcn_fence(__ATOMIC_RELEASE, "agent");
            asm volatile("s_waitcnt vmcnt(0)" ::: "memory");
            const unsigned og = xb_add(&bar[XB_TOP], 1u);
            const unsigned tg = og / nx;
            if (og + 1u == (tg + 1u) * nx) xb_add(&bar[XB_TOPGEN], 1u);
            else XB_SPIN(xb_ld(&bar[XB_TOPGEN]) == tg, bar);
            __builtin_amdgcn_fence(__ATOMIC_ACQUIRE, "agent");
            xb_add(&bar[XB_XGEN(b.x)], 1u);
            asm volatile("s_waitcnt vmcnt(0)" ::: "memory");
        } else {
            XB_SPIN(xb_ld(&bar[XB_XGEN(b.x)]) == gen, bar);
            __builtin_amdgcn_fence(__ATOMIC_ACQUIRE, "agent");
            asm volatile("s_waitcnt vmcnt(0)" ::: "memory");
        }
    }
    __syncthreads();
}
constexpr int NWAVES = 8, NTHR = 512;
constexpr int LDS_BYTES = 147456;
struct Args {
    const float* in[28]; float* out; unsigned char* ws; int ph_lo, ph_hi;
};
constexpr int N_PHASES = 15;

struct Frame {
    LAS unsigned char* lds; int wave, vcu, G;
};

__device__ __forceinline__ void transpose_item(const float* W, int ldw, int k0, int n0, bf16_t* dst, int ldt, const float* kscale, LAS float* scr, int lane) {
    f32x4 v[8]; const int kr = lane >> 3, n4 = (lane & 7) * 4;
#pragma unroll
    for (int i = 0; i < 8; ++i) v[i] = *(const f32x4*)(W + (size_t)(k0 + i * 8 + kr) * ldw + n0 + n4);
#pragma unroll
    for (int i = 0; i < 8; ++i) { const int kk = i * 8 + kr; f32x4 x = v[i]; if (kscale) x = x * kscale[k0 + kk];
        scr[kk * 33 + n4 + 0] = x[0]; scr[kk * 33 + n4 + 1] = x[1]; scr[kk * 33 + n4 + 2] = x[2]; scr[kk * 33 + n4 + 3] = x[3]; }
    asm volatile("s_waitcnt lgkmcnt(0)" ::: "memory");
    const int c = lane & 7;
#pragma unroll
    for (int j = 0; j < 4; ++j) { const int n = (lane >> 3) + 8 * j; const LAS float* s = scr + (8 * c) * 33 + n;
        u32x4 o; o.x = cvt_pk_bf16(s[0 * 33], s[1 * 33]); o.y = cvt_pk_bf16(s[2 * 33], s[3 * 33]); o.z = cvt_pk_bf16(s[4 * 33], s[5 * 33]); o.w = cvt_pk_bf16(s[6 * 33], s[7 * 33]);
        *(u32x4*)(dst + (size_t)n * ldt + k0 + 8 * c) = o; }
    asm volatile("s_waitcnt lgkmcnt(0)" ::: "memory");
}
__device__ __forceinline__ void rms_rows2_to_bf16(const float* xa, const float* xb, const float* g, bf16_t* oa, bf16_t* ob, int lane) {
    const f32x4* ra = (const f32x4*)xa + lane; const f32x4* rb = (const f32x4*)xb + lane; const f32x4* gr = (const f32x4*)g + lane;
    f32x4 va[4], vb[4]; float sa = 0.f, sb = 0.f;
#pragma unroll
    for (int j = 0; j < 4; ++j) { va[j] = ra[64 * j]; vb[j] = rb[64 * j]; }
#pragma unroll
    for (int j = 0; j < 4; ++j) { sa += (va[j].x * va[j].x + va[j].y * va[j].y) + (va[j].z * va[j].z + va[j].w * va[j].w); sb += (vb[j].x * vb[j].x + vb[j].y * vb[j].y) + (vb[j].z * vb[j].z + vb[j].w * vb[j].w); }
    const float rsa = __builtin_amdgcn_rsqf(wave_sum(sa) * (1.f / DM) + RMS_EPS), rsb = __builtin_amdgcn_rsqf(wave_sum(sb) * (1.f / DM) + RMS_EPS);
    u32x2* pa = (u32x2*)oa + lane; u32x2* pb = (u32x2*)ob + lane;
#pragma unroll
    for (int j = 0; j < 4; ++j) { const f32x4 gg = gr[64 * j]; u32x2 w;
        w.x = cvt_pk_bf16(va[j].x * rsa * gg.x, va[j].y * rsa * gg.y); w.y = cvt_pk_bf16(va[j].z * rsa * gg.z, va[j].w * rsa * gg.w); pa[64 * j] = w;
        w.x = cvt_pk_bf16(vb[j].x * rsb * gg.x, vb[j].y * rsb * gg.y); w.y = cvt_pk_bf16(vb[j].z * rsb * gg.z, vb[j].w * rsb * gg.w); pb[64 * j] = w; }
}

__global__ void __launch_bounds__(NTHR, 2) mega(Args args) {
    extern __shared__ __attribute__((aligned(16))) unsigned char lds_raw[];
    Frame F; F.lds = (LAS unsigned char*)lds_raw; F.wave = __builtin_amdgcn_readfirstlane(threadIdx.x >> 6);
    F.G = gridDim.x; { const int bx = blockIdx.x; F.vcu = (F.G % 8 == 0) ? (bx % 8) * (F.G / 8) + bx / 8 : bx; }
    unsigned char* ws = args.ws;
    unsigned* ctl = (unsigned*)(ws + WS_CTL);
    const float* x = args.in[0]; float* out = args.out;
    bf16_t* Win_t = (bf16_t*)(ws + WS_WIN); bf16_t* Wout_t = (bf16_t*)(ws + WS_WOUT); bf16_t* Wq_t = (bf16_t*)(ws + WS_WQ); bf16_t* Wkv_t = (bf16_t*)(ws + WS_WKV);
    bf16_t* Wo_t = (bf16_t*)(ws + WS_WO); bf16_t* Wr_t = (bf16_t*)(ws + WS_WR); bf16_t* Wsgu = (bf16_t*)(ws + WS_WSGU); bf16_t* memn = (bf16_t*)(ws + WS_MEMN);
    bf16_t* Km = (bf16_t*)(ws + WS_KM); bf16_t* Vt = (bf16_t*)(ws + WS_VT); bf16_t* Wgu_t = (bf16_t*)(ws + WS_WGU); bf16_t* Wd_t = (bf16_t*)(ws + WS_WD);
    bf16_t* Z = (bf16_t*)(ws + WS_RA); bf16_t* Qm = (bf16_t*)(ws + WS_RA); bf16_t* Sc = (bf16_t*)(ws + WS_RA + 128 * MiB); bf16_t* xg = (bf16_t*)(ws + WS_RA); bf16_t* yb = (bf16_t*)(ws + WS_RA);
    bf16_t* XN = (bf16_t*)(ws + WS_RB); bf16_t* AO = (bf16_t*)(ws + WS_RB); bf16_t* Om = (bf16_t*)(ws + WS_RB); bf16_t* act = (bf16_t*)(ws + WS_RB);
    bf16_t* x1b = (bf16_t*)(ws + WS_RC); bf16_t* x2b = (bf16_t*)(ws + WS_RC);
    float* ssq1 = (float*)(ws + WS_SSQ1); float* ssq2 = (float*)(ws + WS_SSQ2); float* rstd2 = (float*)(ws + WS_SSQ1);     float* logit = (float*)(ws + WS_LOGIT);
    int* tok_e = (int*)(ws + WS_TOKE); float* tok_w = (float*)(ws + WS_TOKW); int* tok_s = (int*)(ws + WS_TOKS); int* row_tok = (int*)(ws + WS_ROWTOK); float* rowrs = (float*)(ws + WS_ROWTOK + 1 * MiB);
    const int gw = F.vcu * NWAVES + F.wave, NGW = F.G * NWAVES;
    const int lo = args.ph_lo, hi = args.ph_hi;
#define IN(k) (lo <= (k) && (k) < hi)
#if MK_ONE_LAUNCH
    volatile LAS unsigned* misc = (volatile LAS unsigned*)(F.lds + LDS_MISC);
    if (threadIdx.x < 64) misc[threadIdx.x] = 0u;
    __syncthreads();
    XcdBarrier xbar = xcd_barrier_post(ctl + CW_BAR, misc + 8, threadIdx.x == 0);
#define GRID_BAR(k) do { if (IN(k) && IN((k) + 1)) { if ((k) == 0) cg::this_grid().sync(); else xcd_barrier(xbar, F.wave == 0 && lane_id() == 0); } } while (0)
#else
#define GRID_BAR(k) do { } while (0)
#endif

    if (IN(0)) {
        const int lane_ = lane_id(), tid_ = F.wave * 64 + lane_; (void)tid_;
        LAS float* scr = (LAS float*)(F.lds + F.wave * 16384);
        constexpr int I_IN = 16 * 80, I_SQ = 16 * 32, I_KV = 16 * 64, I_G = 16 * 16, I_D = 8 * 32;
        constexpr int NITEMS = I_IN + 3 * I_SQ + I_KV + NEXP * (2 * I_G + I_D);
        for (int it = gw; it < NITEMS; it += NGW) {
            int r = it;
            if (r < I_IN) { const int kb = r / 80, nb = r % 80; transpose_item(args.in[3], ZP, kb * 64, nb * 32, Win_t + (size_t)(nb * 32) * DM, DM, nullptr, scr, lane_); continue; } r -= I_IN;
            if (r < I_SQ) { const int kb = r / 32, nb = r % 32; transpose_item(args.in[13], DM, kb * 64, nb * 32, Wout_t + (size_t)(nb * 32) * DM, DM, nullptr, scr, lane_); continue; } r -= I_SQ;
            if (r < I_SQ) { const int kb = r / 32, nb = r % 32; transpose_item(args.in[16], DM, kb * 64, nb * 32, Wq_t + (size_t)(nb * 32) * DM, DM, args.in[14], scr, lane_); continue; } r -= I_SQ;
            if (r < I_KV) { const int kb = r / 64, nb = r % 64; transpose_item(args.in[17], 2 * DM, kb * 64, nb * 32, Wkv_t + (size_t)(nb * 32) * DM, DM, nullptr, scr, lane_); continue; } r -= I_KV;
            if (r < I_SQ) { const int kb = r / 32, nb = r % 32; transpose_item(args.in[18], DM, kb * 64, nb * 32, Wo_t + (size_t)(nb * 32) * DM, DM, nullptr, scr, lane_); continue; } r -= I_SQ;
            const int e = r / (2 * I_G + I_D); r -= e * (2 * I_G + I_D);
            if (r < 2 * I_G) { const int up = r >= I_G; if (up) r -= I_G; const int kb = r / 16, nb = r % 16, n0 = nb * 32;
                const float* W = (up ? args.in[25] : args.in[24]) + (size_t)e * DM * DEXP;
                transpose_item(W, DEXP, kb * 64, n0, Wgu_t + ((size_t)e * 1024 + (n0 >> 7) * 256 + up * 128 + (n0 & 127)) * DM, DM, args.in[19], scr, lane_); continue; }
            r -= 2 * I_G;
            { const int kb = r / 32, nb = r % 32; transpose_item(args.in[26] + (size_t)e * DEXP * DM, DM, kb * 64, nb * 32, Wd_t + ((size_t)e * 1024 + nb * 32) * DEXP, DEXP, nullptr, scr, lane_); }
        }
        for (int i = blockIdx.x * NTHR + tid_; i < 256 * DM; i += F.G * NTHR) { const int n = i >> 10, k = i & 1023; float v = 0.f;
            if (n < 4) v = args.in[20][k * 4 + n] * args.in[19][k]; else if (n < 36) v = args.in[22][k * 32 + (n - 4)] * args.in[19][k];
            Wr_t[i] = (bf16_t)(cvt_pk_bf16(v, 0.f) & 0xffffu); }
        for (int i = blockIdx.x * NTHR + tid_; i < 4 * 128 * 128; i += F.G * NTHR) { const int t = (i >> 7) & 127, s = i & 127; const float v = s <= t ? args.in[6][i] : 0.f; Wsgu[i] = (bf16_t)(cvt_pk_bf16(v, 0.f) & 0xffffu); }
        for (int m = gw; m < M; m += 2 * NGW) rms_rows2_to_bf16(x + (size_t)m * DM, x + (size_t)(m + NGW) * DM, args.in[2], XN + (size_t)m * DM, XN + (size_t)(m + NGW) * DM, lane_);
        for (int m = gw; m < MROWS / 2; m += NGW) rms_rows2_to_bf16(args.in[1] + (size_t)m * DM, args.in[1] + (size_t)(m + MROWS / 2) * DM, args.in[15], memn + (size_t)m * DM, memn + (size_t)(m + MROWS / 2) * DM, lane_);
        __syncthreads();
    }
    GRID_BAR(0);

    if (IN(1)) {
        { pg8::Gemm g{DM, DM, DM}; pg8::PlainSched S; S.to.init(M / 256, ZP / 256, F.G, (int)blockIdx.x); S.A = (const char*)XN; S.B = (const char*)Win_t; S.tA = (size_t)256 * DM * 2; S.tB = (size_t)256 * DM * 2;
          pg8::EpiZ E{Z, ctl + CW_KMX}; pg8::gemm_phase(F.lds, F.wave, g, S, E); }
        { pg8::Gemm g{DM, DM, DM}; pg8::PlainSched S; S.to.init(MROWS / 256, 4, F.G, (int)blockIdx.x); S.A = (const char*)memn; S.B = (const char*)Wkv_t; S.tA = (size_t)256 * DM * 2; S.tB = (size_t)256 * DM * 2;
          pg8::EpiBf16 E{Km, DM, nullptr, 1.f}; pg8::gemm_phase(F.lds, F.wave, g, S, E); }
        { pg8::Gemm g{DM, DM, DM}; pg8::PlainSched S; S.to.init(4, MROWS / 256, F.G, (int)((blockIdx.x + 128) % F.G)); S.A = (const char*)(Wkv_t + (size_t)DM * DM); S.B = (const char*)memn; S.tA = (size_t)256 * DM * 2; S.tB = (size_t)256 * DM * 2;
          pg8::EpiBf16 E{Vt, MROWS, nullptr, 1.f}; pg8::gemm_phase(F.lds, F.wave, g, S, E); }
    }
    GRID_BAR(1);

    if (IN(2)) {
        const int lane_ = lane_id(), tid_ = F.wave * 64 + lane_; (void)tid_;
        float lam;
        { const float a = args.in[8][lane_] * args.in[9][lane_], b = args.in[10][lane_] * args.in[11][lane_];
          lam = __expf(wave_sum(a)) - __expf(wave_sum(b)) + 0.2f; }
        const int nitems = 32 * 16, npass = 4;
        int nit, itA, itB, itC;
        if (F.G == 256) { const int b = F.vcu >> 5, r = F.vcu & 31; if (r < 16) { nit = 1; itA = ((b * 4 + 3) << 4) | r; itB = itA; itC = itA; }
            else { const int y = r - 16; nit = 3; itA = ((b * 4 + 2) << 4) | y; itB = ((b * 4 + 1) << 4) | (15 - y); itC = ((b * 4 + 0) << 4) | y; } }
        else { const int per = (nitems + F.G - 1) / F.G; itA = F.vcu * per; int e_ = itA + per; if (e_ > nitems) e_ = nitems; nit = e_ - itA; itB = itA + 1; itC = itA + 2; }
#define ITEM_OF(i) ((F.G == 256) ? ((i) == 0 ? itA : ((i) == 1 ? itB : itC)) : itA + (i))
        if (nit > 0) {
            int ii = 0, pass = 0; da::BlockRef cur = da::mkref(Z, AO, ctl + CW_KMX, ITEM_OF(0), 0); da::Seam S;
            da::prime(cur, (char*)lds_raw, S, F.wave);
            for (;;) {
                int ni = ii, np = pass + 1; if (np == npass) { np = 0; ni = ii + 1; }
                const bool last = ni >= nit * PROBE_DUP_ATTN;
                const da::BlockRef nxt = last ? cur : da::mkref(Z, AO, ctl + CW_KMX, ITEM_OF(ni % nit), np);
                da::block(cur, nxt, (char*)lds_raw, S, lam, args.in[12], F.wave);
                if (last) break;
                cur = nxt; ii = ni; pass = np;
            }
        }
#undef ITEM_OF
        __syncthreads();
        {
            const int lane = lane_, w = F.wave;
            const int nun = (M / 128) * 4;
            const int ch0 = (lane & 15) * 8, t = 16 * w + (lane & 15), nks = (w + 2) >> 1;
            u32x4 vr[4];
            int uidx = F.vcu;
            if (uidx < nun) { const size_t R0 = (size_t)(uidx >> 2) * 128; const int g = uidx & 3;
#pragma unroll
                for (int ps = 0; ps < 4; ++ps) vr[ps] = *(const u32x4*)(Z + (R0 + 16 * w + 4 * ps + (lane >> 4)) * ZP + ZV + g * 128 + ch0); }
            int gcur = -1; float lg[8], lb[8]; bf16x8 wf[4]; float bias = 0.f; int buf = 0;
#pragma unroll
            for (int j = 0; j < 8; ++j) { lg[j] = 0.f; lb[j] = 0.f; }
#pragma unroll
            for (int ks = 0; ks < 4; ++ks) wf[ks] = (bf16x8){0, 0, 0, 0, 0, 0, 0, 0};
            for (; uidx < nun; uidx += F.G, buf ^= 1) {
                const int c = uidx >> 2, g = uidx & 3; const size_t R0 = (size_t)c * 128;
                LAS bf16_t* vnT = (LAS bf16_t*)(F.lds + buf * 34816);
                if (g != gcur) { gcur = g;
#pragma unroll
                    for (int j = 0; j < 8; ++j) { lg[j] = args.in[4][g * 128 + ch0 + j]; lb[j] = args.in[5][g * 128 + ch0 + j]; }
#pragma unroll
                    for (int ks = 0; ks < 4; ++ks) if (ks < nks) wf[ks] = *(const bf16x8*)(Wsgu + ((size_t)g * 128 + t) * 128 + ks * 32 + 8 * (lane >> 4));
                    bias = args.in[7][g * 128 + t]; }
#pragma unroll
                for (int ps = 0; ps < 4; ++ps) { const int sr = 16 * w + 4 * ps + (lane >> 4); const u32x4 raw = vr[ps];
                    float v[8] = {bf_lo(raw.x), bf_hi(raw.x), bf_lo(raw.y), bf_hi(raw.y), bf_lo(raw.z), bf_hi(raw.z), bf_lo(raw.w), bf_hi(raw.w)};
                    float sm = 0.f;
#pragma unroll
                    for (int j = 0; j < 8; ++j) sm += v[j];
#pragma unroll
                    for (int o = 1; o < 16; o <<= 1) sm += __shfl_xor(sm, o);
                    const float mu = sm * (1.f / 128.f); float q = 0.f;
#pragma unroll
                    for (int j = 0; j < 8; ++j) { v[j] -= mu; q += v[j] * v[j]; }
#pragma unroll
                    for (int o = 1; o < 16; o <<= 1) q += __shfl_xor(q, o);
                    const float rstd = __builtin_amdgcn_rsqf(q * (1.f / 128.f) + LN_EPS);
#pragma unroll
                    for (int j = 0; j < 8; ++j) { const float y = v[j] * rstd * lg[j] + lb[j]; vnT[(ch0 + j) * 136 + sr] = (bf16_t)(cvt_pk_bf16(y, 0.f) & 0xffffu); } }
                u32x2 ur[8];
#pragma unroll
                for (int mi = 0; mi < 8; ++mi) ur[mi] = *(const u32x2*)(Z + (R0 + t) * ZP + ZU + g * 128 + 16 * mi + 4 * (lane >> 4));
                { const int un = uidx + F.G; if (un < nun) { const size_t Rn = (size_t)(un >> 2) * 128; const int gn = un & 3;
#pragma unroll
                    for (int ps = 0; ps < 4; ++ps) vr[ps] = *(const u32x4*)(Z + (Rn + 16 * w + 4 * ps + (lane >> 4)) * ZP + ZV + gn * 128 + ch0); } }
                __syncthreads();
                f32x4 acc[8];
#pragma unroll
                for (int mi = 0; mi < 8; ++mi) acc[mi] = (f32x4){0.f, 0.f, 0.f, 0.f};
#pragma unroll
                for (int ks = 0; ks < 4; ++ks) if (ks < nks) {
#pragma unroll
                    for (int mi = 0; mi < 8; ++mi) { const bf16x8 afr = *(const LAS bf16x8*)(vnT + (16 * mi + (lane & 15)) * 136 + ks * 32 + 8 * (lane >> 4));
                        acc[mi] = __builtin_amdgcn_mfma_f32_16x16x32_bf16(afr, wf[ks], acc[mi], 0, 0, 0); } }
#pragma unroll
                for (int mi = 0; mi < 8; ++mi) { const int ch = 16 * mi + 4 * (lane >> 4); const u32x2 u2 = ur[mi];
                    const float o0 = bf_lo(u2.x) * (acc[mi][0] + bias), o1 = bf_hi(u2.x) * (acc[mi][1] + bias), o2 = bf_lo(u2.y) * (acc[mi][2] + bias), o3 = bf_hi(u2.y) * (acc[mi][3] + bias);
                    u32x2 wv; wv.x = cvt_pk_bf16(o0, o1); wv.y = cvt_pk_bf16(o2, o3);
                    *(u32x2*)(AO + (R0 + t) * DM + g * 128 + ch) = wv; }
            }
            __syncthreads();
        }
    }
    GRID_BAR(2);

    if (IN(3)) {
        pg8::Gemm g{DM, DM, DM}; pg8::PlainSched S; S.to.init(M / 256, 4, F.G, (int)blockIdx.x); S.A = (const char*)AO; S.B = (const char*)Wout_t; S.tA = (size_t)256 * DM * 2; S.tB = (size_t)256 * DM * 2;
        pg8::EpiResid<false> E{x, x1b, ssq1}; pg8::gemm_phase(F.lds, F.wave, g, S, E);
    }
    GRID_BAR(3);

    if (IN(4)) {
        pg8::Gemm g{DM, DM, DM}; pg8::PlainSched S; S.to.init(M / 256, 4, F.G, (int)blockIdx.x); S.A = (const char*)x1b; S.B = (const char*)Wq_t; S.tA = (size_t)256 * DM * 2; S.tB = (size_t)256 * DM * 2;
        pg8::EpiBf16 E{Qm, DM, ssq1, C2_MEM}; pg8::gemm_phase(F.lds, F.wave, g, S, E);
    }
    GRID_BAR(4);

    if (IN(5)) {
        pg8::Gemm g{DM, DM, 256}; pg8::MemAttnSched S; S.to.init(M / 256, 4, F.G, (int)blockIdx.x); S.A = (const char*)Qm; S.B = (const char*)Km; S.bB = (size_t)256 * DM * 2; S.hB = 512;
        pg8::EpiSoftmax E{Sc, (LAS float*)(F.lds + LDS_MISC + 1024)}; pg8::gemm_phase(F.lds, F.wave, g, S, E);
    }
    GRID_BAR(5);

    if (IN(7)) {
        pg8::Gemm g{DM, MROWS, 256}; pg8::MemAttnSched S; S.to.init(M / 256, 4, F.G, (int)blockIdx.x); S.A = (const char*)Sc; S.B = (const char*)Vt; S.bB = 512; S.hB = (size_t)256 * MROWS * 2;
        pg8::EpiBf16 E{Om, DM, nullptr, 1.f}; pg8::gemm_phase(F.lds, F.wave, g, S, E);
    }
    GRID_BAR(7);

    if (IN(8)) {
        pg8::Gemm g{DM, DM, DM}; pg8::PlainSched S; S.to.init(M / 256, 4, F.G, (int)blockIdx.x); S.A = (const char*)Om; S.B = (const char*)Wo_t; S.tA = (size_t)256 * DM * 2; S.tB = (size_t)256 * DM * 2;
        pg8::EpiResid<true> E{x1b, x2b, ssq2}; pg8::gemm_phase(F.lds, F.wave, g, S, E);
    }
    GRID_BAR(8);

    if (IN(9)) {
        pg8::Gemm g{DM, DM, DM}; pg8::PlainSched S; S.to.init(M / 256, 1, F.G, (int)blockIdx.x); S.A = (const char*)x2b; S.B = (const char*)Wr_t; S.tA = (size_t)256 * DM * 2; S.tB = 0;
        pg8::EpiRouter E{logit, ssq2, args.in[21], args.in[23], rstd2}; pg8::gemm_phase(F.lds, F.wave, g, S, E);
    }
    GRID_BAR(9);

    if (IN(10)) {
        const int lane_ = lane_id(), tid_ = F.wave * 64 + lane_; (void)tid_;
        LAS unsigned* lcnt = (LAS unsigned*)F.lds; LAS unsigned* lbase = lcnt + 32;
        for (int t0 = blockIdx.x * NTHR; t0 < M; t0 += F.G * NTHR) {
            if (tid_ < 32) lcnt[tid_] = 0u;
            __syncthreads();
            const int tok = t0 + tid_;
            const f32x4 lg = *(const f32x4*)(logit + (size_t)tok * 64);
            int gi = 0; float gm = lg[0];
#pragma unroll
            for (int j = 1; j < 4; ++j) if (lg[j] > gm) { gm = lg[j]; gi = j; }
            float gs = 0.f;
#pragma unroll
            for (int j = 0; j < 4; ++j) gs += __expf(lg[j] - gm);
            const float gate = 1.0f / gs;
            const f32x4 ea = *(const f32x4*)(logit + (size_t)tok * 64 + 4 + gi * 8), eb = *(const f32x4*)(logit + (size_t)tok * 64 + 8 + gi * 8);
            const float el[8] = {ea[0], ea[1], ea[2], ea[3], eb[0], eb[1], eb[2], eb[3]};
            int i0 = 0; float m0 = el[0];
#pragma unroll
            for (int j = 1; j < 8; ++j) if (el[j] > m0) { m0 = el[j]; i0 = j; }
            int i1 = -1; float m1 = -__builtin_inff();
#pragma unroll
            for (int j = 0; j < 8; ++j) if (j != i0 && el[j] > m1) { m1 = el[j]; i1 = j; }
            if (i1 < 0) i1 = (i0 == 0) ? 1 : 0;
            const float r = __expf(m1 - m0);
            const float w0 = gate / (1.0f + r), w1 = gate * r / (1.0f + r);
            const int e0 = gi * 8 + i0, e1 = gi * 8 + i1;
            const unsigned r0 = atomicAdd((unsigned*)&lcnt[e0], 1u), r1 = atomicAdd((unsigned*)&lcnt[e1], 1u);
            __syncthreads();
            if (tid_ < 32) lbase[tid_] = atomicAdd(ctl + CW_CNT + tid_, lcnt[tid_]);
            __syncthreads();
            tok_e[tok * 2] = e0; tok_e[tok * 2 + 1] = e1; tok_w[tok * 2] = w0; tok_w[tok * 2 + 1] = w1;
            tok_s[tok * 2] = (int)(lbase[e0] + r0); tok_s[tok * 2 + 1] = (int)(lbase[e1] + r1);
            __syncthreads();
        }
    }
    GRID_BAR(10);

    if (IN(11)) {
        const int lane_ = lane_id(), tid_ = F.wave * 64 + lane_; (void)tid_;
        LAS unsigned* lps = (LAS unsigned*)F.lds;
        if (tid_ == 0) { unsigned acc = 0; for (int e = 0; e < 32; ++e) { lps[e] = acc; const unsigned c = ld_u32_agent(ctl + CW_CNT + e); acc += (c + 255u) & ~255u; } lps[32] = acc; }
        __syncthreads();
        if (blockIdx.x == 0) {
            if (tid_ < 32) { const unsigned s = lps[tid_], e2 = lps[tid_ + 1], c = ld_u32_agent(ctl + CW_CNT + tid_);
                for (unsigned b = s >> 8; b < (e2 >> 8); ++b) ctl[CW_BLKE + b] = (unsigned)tid_;
                for (unsigned r = s + c; r < e2; ++r) { row_tok[r] = 0; rowrs[r] = 0.f; } }
            if (tid_ == 0) ctl[CW_NBLK] = lps[32] >> 8;
        }
        for (int a = blockIdx.x * NTHR + tid_; a < M * 2; a += F.G * NTHR) { const int e = tok_e[a]; const int pos = (int)lps[e] + tok_s[a]; row_tok[pos] = a >> 1; tok_s[a] = pos; rowrs[pos] = rstd2[a >> 1]; }
        __syncthreads();
    }
    GRID_BAR(11);

    if (IN(12)) {
        const int nblk = (int)__builtin_amdgcn_readfirstlane(ld_u32_agent(ctl + CW_NBLK));
        pg8::Gemm g{DM, DM, DM}; pg8::MoeSched S{F.G, F.vcu, nblk, ctl + CW_BLKE, (const char*)x2b, (const char*)Wgu_t, (size_t)0, (size_t)1024 * DM * 2, (size_t)256 * DM * 2, row_tok};
        pg8::EpiGateUp E{act, rowrs, row_tok}; pg8::gemm_phase<pg8::EpiGateUp, pg8::MoeSched, true>(F.lds, F.wave, g, S, E);
    }
    GRID_BAR(12);

    if (IN(13)) {
        const int nblk = (int)__builtin_amdgcn_readfirstlane(ld_u32_agent(ctl + CW_NBLK));
        pg8::Gemm g{DEXP, DEXP, DEXP}; pg8::MoeSched S{F.G, F.vcu, nblk, ctl + CW_BLKE, (const char*)act, (const char*)Wd_t, (size_t)256 * DEXP * 2, (size_t)1024 * DEXP * 2, (size_t)256 * DEXP * 2, row_tok};
        pg8::EpiBf16 E{yb, DM, nullptr, 1.f}; pg8::gemm_phase(F.lds, F.wave, g, S, E);
    }
    GRID_BAR(13);

    if (IN(14)) {
        const int lane_ = lane_id(), tid_ = F.wave * 64 + lane_; (void)tid_;
        const f32x4* gr = (const f32x4*)args.in[27] + lane_;
        f32x4 gg[4];
#pragma unroll
        for (int j = 0; j < 4; ++j) gg[j] = gr[64 * j];
        for (int m = gw; m < M; m += 2 * NGW) {
            const int ma = m, mb = m + NGW;
            const int pa0 = tok_s[ma * 2], pa1 = tok_s[ma * 2 + 1], pb0 = tok_s[mb * 2], pb1 = tok_s[mb * 2 + 1];
            const float wa0 = tok_w[ma * 2], wa1 = tok_w[ma * 2 + 1], wb0 = tok_w[mb * 2], wb1 = tok_w[mb * 2 + 1];
            const u32x2* xa = (const u32x2*)(x2b + (size_t)ma * DM) + lane_; const u32x2* xb = (const u32x2*)(x2b + (size_t)mb * DM) + lane_;
            const u32x2* ya0 = (const u32x2*)(yb + (size_t)pa0 * DM) + lane_; const u32x2* ya1 = (const u32x2*)(yb + (size_t)pa1 * DM) + lane_;
            const u32x2* yb0 = (const u32x2*)(yb + (size_t)pb0 * DM) + lane_; const u32x2* yb1 = (const u32x2*)(yb + (size_t)pb1 * DM) + lane_;
            u32x2 ca[4], cb[4], a0[4], a1[4], b0[4], b1[4];
#pragma unroll
            for (int j = 0; j < 4; ++j) { ca[j] = xa[64 * j]; cb[j] = xb[64 * j]; a0[j] = ya0[64 * j]; a1[j] = ya1[64 * j]; b0[j] = yb0[64 * j]; b1[j] = yb1[64 * j]; }
            f32x4 va[4], vb[4]; float sa = 0.f, sb = 0.f;
#pragma unroll
            for (int j = 0; j < 4; ++j) {
                va[j].x = bf_lo(ca[j].x) + wa0 * bf_lo(a0[j].x) + wa1 * bf_lo(a1[j].x); va[j].y = bf_hi(ca[j].x) + wa0 * bf_hi(a0[j].x) + wa1 * bf_hi(a1[j].x);
                va[j].z = bf_lo(ca[j].y) + wa0 * bf_lo(a0[j].y) + wa1 * bf_lo(a1[j].y); va[j].w = bf_hi(ca[j].y) + wa0 * bf_hi(a0[j].y) + wa1 * bf_hi(a1[j].y);
                vb[j].x = bf_lo(cb[j].x) + wb0 * bf_lo(b0[j].x) + wb1 * bf_lo(b1[j].x); vb[j].y = bf_hi(cb[j].x) + wb0 * bf_hi(b0[j].x) + wb1 * bf_hi(b1[j].x);
                vb[j].z = bf_lo(cb[j].y) + wb0 * bf_lo(b0[j].y) + wb1 * bf_lo(b1[j].y); vb[j].w = bf_hi(cb[j].y) + wb0 * bf_hi(b0[j].y) + wb1 * bf_hi(b1[j].y);
                sa += (va[j].x * va[j].x + va[j].y * va[j].y) + (va[j].z * va[j].z + va[j].w * va[j].w); sb += (vb[j].x * vb[j].x + vb[j].y * vb[j].y) + (vb[j].z * vb[j].z + vb[j].w * vb[j].w); }
            const float ra = __builtin_amdgcn_rsqf(wave_sum(sa) * (1.f / DM) + RMS_EPS), rb = __builtin_amdgcn_rsqf(wave_sum(sb) * (1.f / DM) + RMS_EPS);
            f32x4* oa = (f32x4*)(out + (size_t)ma * DM) + lane_; f32x4* ob = (f32x4*)(out + (size_t)mb * DM) + lane_;
#pragma unroll
            for (int j = 0; j < 4; ++j) { oa[64 * j] = va[j] * ra * gg[j]; ob[64 * j] = vb[j] * rb * gg[j]; }
        }
    }
#undef IN
#undef GRID_BAR
}

extern "C" void kernel_launch(void* const* d_in, const int* in_sizes, int n_in, void* d_out, int out_size, void* d_ws, size_t ws_size, hipStream_t stream) {
    static int grid = 0;
    if (grid == 0) {
        if (n_in != 28 || in_sizes[0] != M * DM || out_size != M * DM || ws_size < WS_END) { fprintf(stderr, "kernel_launch: unexpected shapes (n_in %d in0 %d out %d ws %zu)\n", n_in, n_in > 0 ? in_sizes[0] : -1, out_size, ws_size); grid = -1; return; }
        int dev = 0, cus = 0, per_cu = 0;
        if (hipGetDevice(&dev) != hipSuccess || hipDeviceGetAttribute(&cus, hipDeviceAttributeMultiprocessorCount, dev) != hipSuccess) { grid = -1; return; }
        if (hipFuncSetAttribute((const void*)mega, hipFuncAttributeMaxDynamicSharedMemorySize, LDS_BYTES) != hipSuccess) { fprintf(stderr, "kernel_launch: hipFuncSetAttribute failed\n"); grid = -1; return; }
        if (hipOccupancyMaxActiveBlocksPerMultiprocessor(&per_cu, (const void*)mega, NTHR, LDS_BYTES) != hipSuccess || per_cu < 1) { fprintf(stderr, "kernel_launch: occupancy query says %d\n", per_cu); per_cu = 1; }
        (void)hipGetLastError();
        grid = cus;
    }
    if (grid < 0) return;
    (void)hipMemsetAsync((char*)d_ws + WS_CTL, 0, CTL_BYTES, stream);
    Args a{};
    for (int i = 0; i < 28; ++i) a.in[i] = (const float*)d_in[i];
    a.out = (float*)d_out; a.ws = (unsigned char*)d_ws;
#if MK_ONE_LAUNCH
    a.ph_lo = 0; a.ph_hi = N_PHASES;
    void* kargs[] = {&a};
    hipError_t e = hipLaunchCooperativeKernel((const void*)mega, dim3(grid), dim3(NTHR), kargs, LDS_BYTES, stream);
    if (e != hipSuccess) fprintf(stderr, "cooperative launch failed: %s (grid %d)\n", hipGetErrorString(e), grid);
#else
    for (int p = 0; p < N_PHASES; ++p) { a.ph_lo = p; a.ph_hi = p + 1; hipLaunchKernelGGL(mega, dim3(grid), dim3(NTHR), LDS_BYTES, stream, a); }
#endif
}
```

```cpp
#include <hip/hip_runtime.h>
#include <hip/hip_cooperative_groups.h>
#include <cstdio>
#include <cstdint>
namespace cg = cooperative_groups;

#ifndef PROBE_DUP
#define PROBE_DUP -1
#endif
#ifndef PROBE_DUP_ATTN
#define PROBE_DUP_ATTN 1
#endif
#ifndef MK_ONE_LAUNCH
#define MK_ONE_LAUNCH 1
#endif

#define LAS __attribute__((address_space(3)))
#define GAS __attribute__((address_space(1)))
typedef unsigned short bf16_t;
typedef short bf16x8 __attribute__((ext_vector_type(8)));
typedef short s16x4 __attribute__((ext_vector_type(4)));
typedef float f32x2 __attribute__((ext_vector_type(2)));
typedef float f32x4 __attribute__((ext_vector_type(4)));
typedef float f32x16 __attribute__((ext_vector_type(16)));
typedef unsigned u32x2 __attribute__((ext_vector_type(2)));
typedef unsigned u32x4 __attribute__((ext_vector_type(4)));

constexpr int NB = 8, SEQ = 8192, DM = 1024, M = NB * SEQ;
constexpr int ZP = 2560;
constexpr int ZU = 0, ZV = 512, ZQ = 1024, ZK = 1536, ZVAL = 2048;
constexpr int MEML = 256, MROWS = NB * MEML;
constexpr int NEXP = 32, DEXP = 512;
constexpr int PROWS = 2 * M + NEXP * 256;
constexpr int MAXBLK = PROWS / 256;
constexpr float RMS_EPS = 1e-6f, LN_EPS = 1e-5f;
constexpr float LOG2E = 1.4426950408889634f;
constexpr float C2_DIFF = 0.125f * LOG2E;
constexpr float C2_MEM = 0.0625f * LOG2E;

constexpr size_t MiB = 1u << 20;
constexpr size_t WS_CTL = 0, CTL_BYTES = 1 * MiB;
constexpr size_t WS_WIN = 1 * MiB;
constexpr size_t WS_WOUT = 6 * MiB;
constexpr size_t WS_WQ = 8 * MiB;
constexpr size_t WS_WKV = 10 * MiB;
constexpr size_t WS_WO = 14 * MiB;
constexpr size_t WS_WR = 16 * MiB;
constexpr size_t WS_WSGU = 17 * MiB;
constexpr size_t WS_MEMN = 18 * MiB;
constexpr size_t WS_KM = 22 * MiB;
constexpr size_t WS_VT = 26 * MiB;
constexpr size_t WS_WGU = 30 * MiB;
constexpr size_t WS_WD = 94 * MiB;
constexpr size_t WS_RA = 128 * MiB;
constexpr size_t WS_RB = 448 * MiB;
constexpr size_t WS_RC = 592 * MiB;
constexpr size_t WS_SSQ1 = 720 * MiB;
constexpr size_t WS_SSQ2 = 724 * MiB;
constexpr size_t WS_LOGIT = 728 * MiB;
constexpr size_t WS_TOKE = 744 * MiB;
constexpr size_t WS_TOKW = 745 * MiB;
constexpr size_t WS_TOKS = 746 * MiB;
constexpr size_t WS_ROWTOK = 747 * MiB;
constexpr size_t WS_END = 752 * MiB;
constexpr int CW_CNT = 64;
constexpr int CW_NBLK = 128;
constexpr int CW_PSTART = 192;
constexpr int CW_BLKE = 256;
constexpr int CW_KMX = 1024;
constexpr int CW_SGUQ = 1344;
constexpr int CW_BAR = 4096;
constexpr int LDS_MISC = 131072;
constexpr int LDS_TBUF = 140288, TBUF_W = 2304;

__device__ __forceinline__ unsigned cvt_pk_bf16(float lo, float hi) { unsigned r; asm volatile("v_cvt_pk_bf16_f32 %0, %1, %2" : "=v"(r) : "v"(lo), "v"(hi)); return r; }
__device__ __forceinline__ float bf_lo(unsigned w) { return __uint_as_float(w << 16); }
__device__ __forceinline__ float bf_hi(unsigned w) { return __uint_as_float(w & 0xffff0000u); }
__device__ __forceinline__ float wave_sum(float v) {
#pragma unroll
    for (int o = 1; o < 64; o <<= 1) v += __shfl_xor(v, o);
    return v;
}
__device__ __forceinline__ float wave_max(float v) {
#pragma unroll
    for (int o = 1; o < 64; o <<= 1) v = fmaxf(v, __shfl_xor(v, o));
    return v;
}
__device__ __forceinline__ int lane_id() { int l; asm volatile("v_mbcnt_lo_u32_b32 %0, -1, 0\n\tv_mbcnt_hi_u32_b32 %0, -1, %0" : "=v"(l)); return l; }
__device__ __forceinline__ unsigned ld_u32_agent(const unsigned* p) { return __hip_atomic_load(p, __ATOMIC_RELAXED, __HIP_MEMORY_SCOPE_AGENT); }

namespace pg8 {
constexpr int BM = 256, BK = 64, HALF = 128, HTB = HALF * BK * 2, STAGE_BYTES = 8 * HTB, NXCD = 8, WGM = 8;
__host__ __device__ __forceinline__ int lds_byte(int r, int c) { const int st = (r >> 4) * 2 + (c >> 5), rr = r & 15, cc = c & 31, ob = rr * 64 + cc * 2; return st * 1024 + (ob ^ (((ob >> 9) & 1) << 5)); }
__host__ __device__ __forceinline__ void stage_rc(int b, int& R, int& C) { const int st = b / 1024, sb = b % 1024, swz = sb ^ (((sb >> 9) & 1) << 5); R = (st >> 1) * 16 + swz / 64; C = (st & 1) * 32 + (swz % 64) / 2; }
__host__ __device__ __forceinline__ int perm32(int rho) { const int n = rho >> 4, i = rho & 15; return 8 * (i >> 2) + 4 * n + (i & 3); }

struct Unit { const char* A; const char* B; int pm, pn, aux; const int* rows; };
struct Gemm { int lda, ldb, K; };

struct TileOrder {
    int nM, nN, nwg, G, c;
    __device__ void init(int nM_, int nN_, int G_, int c_) { nM = nM_; nN = nN_; nwg = nM * nN; G = G_; c = c_; }
    __device__ bool get(int i, int& pm, int& pn) const {
        const long L = (long)i * G + c; if (L >= nwg) return false;
        int wgid = (int)L; { const int q = nwg / NXCD, r = nwg % NXCD, xcd = wgid % NXCD, off = wgid / NXCD; wgid = (xcd < r ? xcd * (q + 1) : r * (q + 1) + (xcd - r) * q) + off; }
        const int nig = WGM * nN, gid = wgid / nig, fm = gid * WGM, gsz = (nM - fm) < WGM ? (nM - fm) : WGM;
        pm = fm + ((wgid % nig) % gsz); pn = (wgid % nig) / gsz; return true;
    }
};

typedef float f32x2g __attribute__((ext_vector_type(2)));
__device__ __forceinline__ f32x2g gelu_pk(f32x2g v) {
    const f32x2g av = __builtin_elementwise_abs(v), d = av * 0.2316418882f + 1.0f;
    f32x2g t; t.x = __builtin_amdgcn_rcpf(d.x); t.y = __builtin_amdgcn_rcpf(d.y);
    f32x2g q = t * 0.5307027145f + (-0.7265760135f); q = q * t + 0.7107068705f; q = q * t + (-0.142248368f); q = q * t + 0.127414796f; q = q * t;
    const f32x2g s = (v * v) * (-0.72134752044f);
    f32x2g e; e.x = __builtin_amdgcn_exp2f(s.x); e.y = __builtin_amdgcn_exp2f(s.y);
    const f32x2g m = v * (q * e), r = v - m;
    f32x2g o; o.x = v.x < 0.f ? m.x : r.x; o.y = v.y < 0.f ? m.y : r.y; return o;
}

__device__ __forceinline__ const char* uniform_ptr(const char* p) { const unsigned long long v = (unsigned long long)p; const unsigned lo = __builtin_amdgcn_readfirstlane((unsigned)v), hi = __builtin_amdgcn_readfirstlane((unsigned)(v >> 32)); return (const char*)(((unsigned long long)hi << 32) | lo); }
template <class Epi, class Sched, bool GATHER = false>
__device__ __forceinline__ void gemm_phase(LAS unsigned char* lds, int wid, const Gemm g, const Sched& S, const Epi& E) {
    const int lane = lane_id(), tid = wid * 64 + lane, wr = wid >> 2, wc = wid & 3, fr = lane & 15, fq = lane >> 4;
    const int nt = g.K / BK;
    unsigned voffB[2]; unsigned vA0[2], vA1[2]; int RA[2], CA[2];
#pragma unroll
    for (int i = 0; i < 2; ++i) { int R, C; stage_rc(tid * 16 + i * 8192, R, C); const int pr = Epi::PERM ? perm32(R & 31) : (R & 31);
        RA[i] = R; CA[i] = C; voffB[i] = (unsigned)((64 * (R >> 5) + pr) * g.ldb + C) * 2u;
        vA0[i] = (unsigned)(R * g.lda + C) * 2u; vA1[i] = vA0[i]; }
    const size_t kstep = (size_t)(BK * 2);
    const size_t hstepA = GATHER ? (size_t)0 : (size_t)HALF * g.lda * 2, hstepB = (size_t)32 * g.ldb * 2;
    LAS u32x4* park = (LAS u32x4*)(lds + 131072 + 1024) + tid;
#define PG8_GOFF(U, d0, d1) do { _Pragma("unroll") for (int _i = 0; _i < 2; ++_i) { \
        d0[_i] = ((unsigned)(U).rows[RA[_i]] * (unsigned)g.lda + (unsigned)CA[_i]) * 2u; d1[_i] = ((unsigned)(U).rows[HALF + RA[_i]] * (unsigned)g.lda + (unsigned)CA[_i]) * 2u; } } while (0)
    const unsigned ldsw = (unsigned)wid * 1024u;
    const int aoff = lds_byte(wr * 64 + fr, fq * 8), boff = lds_byte(wc * 32 + fr, fq * 8);
#define PG8_SA(b, h) (((b) * 2 + (h)) * HTB)
#define PG8_SB(b, h) ((4 + (b) * 2 + (h)) * HTB)
#define PG8_STAGE(bufoff, gbase, voff) do { _Pragma("unroll") for (int _i = 0; _i < 2; ++_i) \
        __builtin_amdgcn_global_load_lds((const unsigned*)((const char*)(gbase) + (voff)[_i]), (LAS unsigned*)(lds + (bufoff) + ldsw + _i * 8192), 16, 0, 0); } while (0)
#define PG8_LDA(dst, b, h) do { _Pragma("unroll") for (int m = 0; m < 4; ++m) _Pragma("unroll") for (int k = 0; k < 2; ++k) dst[m][k] = *(const LAS bf16x8*)(lds + PG8_SA(b, h) + aoff + m * 2048 + k * 1024); } while (0)
#define PG8_LDB(dst, b, h) do { _Pragma("unroll") for (int n = 0; n < 2; ++n) _Pragma("unroll") for (int k = 0; k < 2; ++k) dst[n][k] = *(const LAS bf16x8*)(lds + PG8_SB(b, h) + boff + n * 2048 + k * 1024); } while (0)
#define PG8_MMA(ai, bj, At, Bt) do { __builtin_amdgcn_s_setprio(1); _Pragma("unroll") for (int m = 0; m < 4; ++m) _Pragma("unroll") for (int n = 0; n < 2; ++n) _Pragma("unroll") for (int k = 0; k < 2; ++k) \
        acc[ai][bj][m][n] = __builtin_amdgcn_mfma_f32_16x16x32_bf16(Bt[n][k], At[m][k], acc[ai][bj][m][n], 0, 0, 0); __builtin_amdgcn_s_setprio(0); } while (0)
#define PG8_WAIT_V(n) asm volatile("s_waitcnt vmcnt(" #n ")" ::: "memory")
#define PG8_WAIT_L(n) asm volatile("s_waitcnt lgkmcnt(" #n ")" ::: "memory")
#define PG8_BAR __builtin_amdgcn_s_barrier()
#define PG8_SCHED __builtin_amdgcn_sched_barrier(0)
    Unit cur, nxt; int ui = 0;
    if (!S.next(0, cur)) return;
    f32x4 acc[2][2][4][2];
#pragma unroll
    for (int a = 0; a < 2; ++a)
#pragma unroll
        for (int b = 0; b < 2; ++b)
#pragma unroll
            for (int m = 0; m < 4; ++m)
#pragma unroll
                for (int n = 0; n < 2; ++n) acc[a][b][m][n] = (f32x4){0.f, 0.f, 0.f, 0.f};
    bf16x8 At[4][2], B0[2][2], B1[2][2];
    const char* cA = uniform_ptr(cur.A); const char* cB = uniform_ptr(cur.B);
    if constexpr (GATHER) { PG8_GOFF(cur, vA0, vA1); }
    PG8_STAGE(PG8_SB(0, 0), cB, voffB); PG8_STAGE(PG8_SB(0, 1), cB + hstepB, voffB); PG8_STAGE(PG8_SA(0, 0), cA, vA0); PG8_STAGE(PG8_SA(0, 1), cA + hstepA, vA1);
    if (wr == 1) PG8_BAR;
    PG8_WAIT_V(2); PG8_BAR;
    PG8_STAGE(PG8_SB(1, 0), cB + kstep, voffB); PG8_STAGE(PG8_SA(1, 0), cA + kstep, vA0); PG8_STAGE(PG8_SB(1, 1), cB + hstepB + kstep, voffB);
    PG8_WAIT_V(6); PG8_BAR;
    for (;;) {
        const bool has_next = S.next(ui + 1, nxt);
        const char* nA = has_next ? uniform_ptr(nxt.A) : cA; const char* nB = has_next ? uniform_ptr(nxt.B) : cB;
        if constexpr (GATHER) { unsigned n0[2] = {vA0[0], vA0[1]}, n1[2] = {vA1[0], vA1[1]}; if (has_next) { PG8_GOFF(nxt, n0, n1); } *park = (u32x4){n0[0], n0[1], n1[0], n1[1]}; }
#pragma nounroll
        for (int t = 0; t < nt; t += 2) {
            const bool last = (t == nt - 2);
            const char* a1 = cA + (size_t)(t + 1) * kstep;
            const char* a2 = last ? nA : cA + (size_t)(t + 2) * kstep; const char* b2 = last ? nB : cB + (size_t)(t + 2) * kstep;
            const char* a3 = a2 + kstep; const char* b3 = b2 + kstep;
            unsigned w0[2] = {vA0[0], vA0[1]}, w1[2] = {vA1[0], vA1[1]};
            if constexpr (GATHER) { if (last) { const u32x4 pk = *park; w0[0] = pk.x; w0[1] = pk.y; w1[0] = pk.z; w1[1] = pk.w; } }
            PG8_LDB(B0, 0, 0); PG8_LDB(B1, 0, 1); PG8_SCHED; PG8_LDA(At, 0, 0); PG8_STAGE(PG8_SA(1, 1), a1 + hstepA, vA1);
            PG8_WAIT_V(8); PG8_WAIT_L(0); PG8_BAR; PG8_MMA(0, 0, At, B0); PG8_MMA(0, 1, At, B1); PG8_BAR; PG8_SCHED;
            PG8_LDA(At, 0, 1); PG8_STAGE(PG8_SB(0, 0), b2, voffB); PG8_STAGE(PG8_SB(0, 1), b2 + hstepB, voffB); PG8_STAGE(PG8_SA(0, 0), a2, w0);
            PG8_WAIT_V(8); PG8_WAIT_L(0); PG8_BAR; PG8_MMA(1, 0, At, B0); PG8_MMA(1, 1, At, B1); PG8_BAR; PG8_SCHED;
            PG8_LDB(B0, 1, 0); PG8_LDB(B1, 1, 1); PG8_SCHED; PG8_LDA(At, 1, 0); PG8_STAGE(PG8_SA(0, 1), a2 + hstepA, w1);
            PG8_WAIT_V(8); PG8_WAIT_L(0); PG8_BAR; PG8_MMA(0, 0, At, B0); PG8_MMA(0, 1, At, B1); PG8_BAR; PG8_SCHED;
            PG8_LDA(At, 1, 1); PG8_STAGE(PG8_SB(1, 0), b3, voffB); PG8_STAGE(PG8_SB(1, 1), b3 + hstepB, voffB); PG8_STAGE(PG8_SA(1, 0), a3, w0);
            PG8_WAIT_V(8); PG8_WAIT_L(0); PG8_BAR; PG8_MMA(1, 0, At, B0); PG8_MMA(1, 1, At, B1); PG8_BAR; PG8_SCHED;
        }
        if (wr == 0) PG8_BAR;
        { const int l2_ = lane_id(); E(acc, cur, wr, wc, l2_ & 15, l2_ >> 4, lds + LDS_TBUF + wid * TBUF_W); }
        if (!has_next) break;
#pragma unroll
        for (int a = 0; a < 2; ++a)
#pragma unroll
            for (int b = 0; b < 2; ++b)
#pragma unroll
                for (int m = 0; m < 4; ++m)
#pragma unroll
                    for (int n = 0; n < 2; ++n) acc[a][b][m][n] = (f32x4){0.f, 0.f, 0.f, 0.f};
        cur = nxt; cA = nA; cB = nB; ++ui;
        if constexpr (GATHER) { const u32x4 pk = *park; vA0[0] = pk.x; vA0[1] = pk.y; vA1[0] = pk.z; vA1[1] = pk.w; }
        if (wr == 1) PG8_BAR;
    }
    PG8_WAIT_V(0);
    PG8_BAR;
#undef PG8_GOFF
#undef PG8_SA
#undef PG8_SB
#undef PG8_STAGE
#undef PG8_LDA
#undef PG8_LDB
#undef PG8_MMA
#undef PG8_WAIT_V
#undef PG8_WAIT_L
#undef PG8_BAR
#undef PG8_SCHED
}

struct PlainSched {
    TileOrder to; const char* A; const char* B; size_t tA, tB;
    __device__ __forceinline__ bool next(int i, Unit& u) const { int pm, pn; if (!to.get(i, pm, pn)) return false; u.pm = pm; u.pn = pn; u.aux = 0; u.rows = nullptr; u.A = A + (size_t)pm * tA; u.B = B + (size_t)pn * tB; return true; }
};
struct OneUnitSched {
    Unit u0;
    __device__ __forceinline__ bool next(int i, Unit& u) const { if (i != 0) return false; u = u0; return true; }
};
struct MemAttnSched {
    TileOrder to; const char* A; const char* B; size_t bB, hB;
    __device__ __forceinline__ bool next(int i, Unit& u) const { int pm, pn; if (!to.get(i, pm, pn)) return false; u.pm = pm; u.pn = pn; u.aux = 0; u.rows = nullptr;
        u.A = A + (size_t)pm * (256 * DM * 2) + (size_t)pn * 512; const int b = pm >> 5; u.B = B + (size_t)b * bB + (size_t)pn * hB; return true; }
};
struct MoeSched {
    int G, c, nblk; const unsigned* blk_e; const char* A; const char* B; size_t tA, eB, tB; const int* row_tok;
    __device__ __forceinline__ bool next(int i, Unit& u) const { const int L = i * G + c; if (L >= nblk * 4) return false; const int rb = L >> 2, pn = L & 3;
        const int e = (int)__builtin_amdgcn_readfirstlane(ld_u32_agent(blk_e + rb)); u.pm = rb; u.pn = pn; u.aux = e; u.rows = row_tok + (size_t)rb * 256;
        u.A = A + (size_t)rb * tA; u.B = B + (size_t)e * eB + (size_t)pn * tB; return true; }
};

#define EPI_ARGS f32x4 (&acc)[2][2][4][2], const Unit& u, int wr, int wc, int fr, int fq, LAS unsigned char* tb
__device__ __forceinline__ void st128(bf16_t* rowbase, size_t ldc, const u32x4 w0, const u32x4 w1, int fr, int fq, LAS unsigned char* tb) {
    *(LAS u32x4*)(tb + fr * 144 + fq * 16) = w0; *(LAS u32x4*)(tb + fr * 144 + 64 + fq * 16) = w1;
    const int L = fq * 16 + fr, r = L >> 3, c = L & 7;
    const u32x4 a = *(const LAS u32x4*)(tb + r * 144 + c * 16), b = *(const LAS u32x4*)(tb + (8 + r) * 144 + c * 16);
    *(u32x4*)(rowbase + (size_t)r * ldc + c * 8) = a; *(u32x4*)(rowbase + (size_t)(8 + r) * ldc + c * 8) = b;
}
__device__ __forceinline__ u32x4 pk8(const f32x4 v0, const f32x4 v1) { u32x4 w; w.x = cvt_pk_bf16(v0[0], v0[1]); w.y = cvt_pk_bf16(v0[2], v0[3]); w.z = cvt_pk_bf16(v1[0], v1[1]); w.w = cvt_pk_bf16(v1[2], v1[3]); return w; }
struct EpiZ {
    static constexpr bool PERM = true;
    bf16_t* O; unsigned* kmx;
    __device__ __forceinline__ void operator()(EPI_ARGS) const {
        const int mode = u.pn < 4 ? 1 : (u.pn < 6 ? 2 : 0);
        if (u.pn == 6 || u.pn == 7) {
#pragma unroll
            for (int bj = 0; bj < 2; ++bj) { float mx = 0.f;
#pragma unroll
                for (int ai = 0; ai < 2; ++ai)
#pragma unroll
                    for (int m = 0; m < 4; ++m) { const f32x4 a = acc[ai][bj][m][0], b = acc[ai][bj][m][1];
                        float q = (a[0] * a[0] + a[1] * a[1]) + (a[2] * a[2] + a[3] * a[3]) + (b[0] * b[0] + b[1] * b[1]) + (b[2] * b[2] + b[3] * b[3]);
                        q += __shfl_xor(q, 16); q += __shfl_xor(q, 32); mx = fmaxf(mx, q); }
#pragma unroll
                for (int o_ = 1; o_ < 16; o_ <<= 1) mx = fmaxf(mx, __shfl_xor(mx, o_));
                if (fr == 0 && fq == 0) { const int b_ = u.pm >> 5, h_ = (u.pn - 6) * 2 + (wc >> 1); atomicMax(kmx + (((b_ * 4 + h_) * 2 + (wc & 1)) * 2 + bj), __float_as_uint(mx)); } }
        }
#pragma unroll
        for (int ai = 0; ai < 2; ++ai)
#pragma unroll
            for (int m = 0; m < 4; ++m) { u32x4 w[2];
#pragma unroll
                for (int bj = 0; bj < 2; ++bj) { f32x4 v0 = acc[ai][bj][m][0], v1 = acc[ai][bj][m][1];
                    if (mode == 1) { f32x2g a = gelu_pk((f32x2g){v0[0], v0[1]}), b = gelu_pk((f32x2g){v0[2], v0[3]}), c = gelu_pk((f32x2g){v1[0], v1[1]}), d = gelu_pk((f32x2g){v1[2], v1[3]});
                        v0 = (f32x4){a.x, a.y, b.x, b.y}; v1 = (f32x4){c.x, c.y, d.x, d.y}; }
                    else if (mode == 2) { v0 = v0 * C2_DIFF; v1 = v1 * C2_DIFF; }
                    w[bj] = pk8(v0, v1); }
                st128(O + (size_t)(u.pm * BM + ai * HALF + wr * 64 + m * 16) * ZP + u.pn * BM + wc * 64, ZP, w[0], w[1], fr, fq, tb); }
    }
};
struct EpiBf16 {
    static constexpr bool PERM = true;
    bf16_t* O; int ldc; const float* ssq; float cscale;
    __device__ __forceinline__ void operator()(EPI_ARGS) const {
#pragma unroll
        for (int ai = 0; ai < 2; ++ai)
#pragma unroll
            for (int m = 0; m < 4; ++m) { const int rowg = u.pm * BM + ai * HALF + wr * 64 + m * 16; float sc = cscale;
                if (ssq) { const f32x4* sp = (const f32x4*)(ssq + (size_t)(rowg + fr) * 16); const f32x4 s4 = (sp[0] + sp[1]) + (sp[2] + sp[3]);
                    sc *= __builtin_amdgcn_rsqf(((s4[0] + s4[1]) + (s4[2] + s4[3])) * (1.0f / DM) + RMS_EPS); }
                st128(O + (size_t)rowg * ldc + u.pn * BM + wc * 64, (size_t)ldc, pk8(acc[ai][0][m][0] * sc, acc[ai][0][m][1] * sc), pk8(acc[ai][1][m][0] * sc, acc[ai][1][m][1] * sc), fr, fq, tb); }
    }
};
struct EpiSoftmax {
    static constexpr bool PERM = true;
    bf16_t* O; LAS float* xch;
    __device__ __forceinline__ void operator()(EPI_ARGS) const {
        LAS float* xm = xch; LAS float* xs = xch + 1024;
#pragma unroll
        for (int ai = 0; ai < 2; ++ai)
#pragma unroll
            for (int m = 0; m < 4; ++m) { float v = -__builtin_inff();
#pragma unroll
                for (int bj = 0; bj < 2; ++bj)
#pragma unroll
                    for (int n = 0; n < 2; ++n) { const f32x4 a = acc[ai][bj][m][n]; v = fmaxf(v, fmaxf(fmaxf(a[0], a[1]), fmaxf(a[2], a[3]))); }
                v = fmaxf(v, __shfl_xor(v, 16)); v = fmaxf(v, __shfl_xor(v, 32));
                if (fq == 0) xm[(ai * HALF + wr * 64 + m * 16 + fr) * 4 + wc] = v; }
        asm volatile("s_waitcnt lgkmcnt(0)" ::: "memory"); __builtin_amdgcn_s_barrier(); asm volatile("" ::: "memory");
#pragma unroll
        for (int ai = 0; ai < 2; ++ai)
#pragma unroll
            for (int m = 0; m < 4; ++m) { const f32x4 t = *(const LAS f32x4*)(xm + (ai * HALF + wr * 64 + m * 16 + fr) * 4); const float mx = fmaxf(fmaxf(t[0], t[1]), fmaxf(t[2], t[3])); float sm = 0.f;
#pragma unroll
                for (int bj = 0; bj < 2; ++bj)
#pragma unroll
                    for (int n = 0; n < 2; ++n) { f32x4 a = acc[ai][bj][m][n];
#pragma unroll
                        for (int j = 0; j < 4; ++j) { a[j] = __builtin_amdgcn_exp2f(a[j] - mx); sm += a[j]; }
                        acc[ai][bj][m][n] = a; }
                sm += __shfl_xor(sm, 16); sm += __shfl_xor(sm, 32);
                if (fq == 0) xs[(ai * HALF + wr * 64 + m * 16 + fr) * 4 + wc] = sm; }
        asm volatile("s_waitcnt lgkmcnt(0)" ::: "memory"); __builtin_amdgcn_s_barrier(); asm volatile("" ::: "memory");
#pragma unroll
        for (int ai = 0; ai < 2; ++ai)
#pragma unroll
            for (int m = 0; m < 4; ++m) { const f32x4 t = *(const LAS f32x4*)(xs + (ai * HALF + wr * 64 + m * 16 + fr) * 4); const float inv = __builtin_amdgcn_rcpf((t[0] + t[1]) + (t[2] + t[3]));
                st128(O + (size_t)(u.pm * BM + ai * HALF + wr * 64 + m * 16) * DM + u.pn * BM + wc * 64, (size_t)DM, pk8(acc[ai][0][m][0] * inv, acc[ai][0][m][1] * inv), pk8(acc[ai][1][m][0] * inv, acc[ai][1][m][1] * inv), fr, fq, tb); }
    }
};
template <bool BF>
struct EpiResid {
    static constexpr bool PERM = true;
    const void* base; bf16_t* ob; float* ssq;
    __device__ __forceinline__ void operator()(EPI_ARGS) const {
        const int col0 = u.pn * BM + wc * 64 + 8 * fq;
#pragma unroll
        for (int ai = 0; ai < 2; ++ai)
#pragma unroll
            for (int m = 0; m < 4; ++m) { const int rowg = u.pm * BM + ai * HALF + wr * 64 + m * 16, row = rowg + fr; const size_t off = (size_t)row * DM + col0; float s = 0.f; u32x4 w[2];
#pragma unroll
                for (int bj = 0; bj < 2; ++bj) { f32x4 b0, b1;
                    if constexpr (BF) { const u32x4 r = *(const u32x4*)((const bf16_t*)base + off + bj * 32); b0 = (f32x4){bf_lo(r.x), bf_hi(r.x), bf_lo(r.y), bf_hi(r.y)}; b1 = (f32x4){bf_lo(r.z), bf_hi(r.z), bf_lo(r.w), bf_hi(r.w)}; }
                    else { b0 = *(const f32x4*)((const float*)base + off + bj * 32); b1 = *(const f32x4*)((const float*)base + off + bj * 32 + 4); }
                    const f32x4 o0 = b0 + acc[ai][bj][m][0], o1 = b1 + acc[ai][bj][m][1];
                    s += (o0[0] * o0[0] + o0[1] * o0[1]) + (o0[2] * o0[2] + o0[3] * o0[3]) + (o1[0] * o1[0] + o1[1] * o1[1]) + (o1[2] * o1[2] + o1[3] * o1[3]);
                    w[bj] = pk8(o0, o1); }
                st128(ob + (size_t)rowg * DM + u.pn * BM + wc * 64, (size_t)DM, w[0], w[1], fr, fq, tb);
                s += __shfl_xor(s, 16); s += __shfl_xor(s, 32);
                if (fq == 0) ssq[(size_t)row * 16 + u.pn * 4 + wc] = s; }
    }
};
struct EpiRouter {
    static constexpr bool PERM = false;
    float* L; const float* ssq; const float* bg; const float* be; float* rstd_out;
    __device__ __forceinline__ void operator()(EPI_ARGS) const {
        if (wc != 0) return;
        const int row0 = u.pm * BM + wr * 64 + fr;
#pragma unroll
        for (int ai = 0; ai < 2; ++ai)
#pragma unroll
            for (int m = 0; m < 4; ++m) { const int row = row0 + ai * HALF + m * 16;
                const f32x4* sp = (const f32x4*)(ssq + (size_t)row * 16); const f32x4 s4 = (sp[0] + sp[1]) + (sp[2] + sp[3]);
                const float rs = __builtin_amdgcn_rsqf(((s4[0] + s4[1]) + (s4[2] + s4[3])) * (1.0f / DM) + RMS_EPS);
                if (fq == 0) rstd_out[row] = rs;
#pragma unroll
                for (int bj = 0; bj < 2; ++bj)
#pragma unroll
                    for (int n = 0; n < 2; ++n) { const int c0 = bj * 32 + n * 16 + 4 * fq; f32x4 o = acc[ai][bj][m][n] * rs;
#pragma unroll
                        for (int j = 0; j < 4; ++j) { const int c = c0 + j; const float b = c < 4 ? bg[c] : (c < 36 ? be[c - 4] : 0.f); o[j] += b; }
                        *(f32x4*)(L + (size_t)row * 64 + c0) = o; } }
    }
};
struct EpiGateUp {
    static constexpr bool PERM = true;
    bf16_t* act; const float* rstd; const int* row_tok;
    __device__ __forceinline__ void operator()(EPI_ARGS) const {
        const int row0 = u.pm * BM + wr * 64 + fr, col0 = u.pn * 128 + wc * 32 + 8 * fq;
#pragma unroll
        for (int ai = 0; ai < 2; ++ai)
#pragma unroll
            for (int m = 0; m < 4; ++m) { const int row = row0 + ai * HALF + m * 16; const float rs = rstd[row];
                float r[8];
#pragma unroll
                for (int n = 0; n < 2; ++n)
#pragma unroll
                    for (int j = 0; j < 4; ++j) { const float gg = acc[ai][0][m][n][j] * rs, uu = acc[ai][1][m][n][j] * rs;
                        r[n * 4 + j] = gg * __builtin_amdgcn_rcpf(1.0f + __builtin_amdgcn_exp2f(-gg * LOG2E)) * uu; }
                u32x4 w; w.x = cvt_pk_bf16(r[0], r[1]); w.y = cvt_pk_bf16(r[2], r[3]); w.z = cvt_pk_bf16(r[4], r[5]); w.w = cvt_pk_bf16(r[6], r[7]);
                *(u32x4*)(act + (size_t)row * DEXP + col0) = w; }
    }
};
}

namespace da {
constexpr int NW = 8, QBLK = 32, KVBLK = 64, QB = NW * QBLK, DV = 128;
constexpr int SHM_V = KVBLK * DV * 2, SHM_K = KVBLK * 64 * 2;
constexpr int LDS_V = 0, LDS_K = 2 * SHM_V, LDS_WS = LDS_K + 2 * SHM_K, LDS_CX = LDS_WS + NW * 64 * 4, LDS_STASH = LDS_CX + 256, LDS_BYTES = LDS_STASH + NW * 8192;
constexpr float SKIP_MARGIN = 40.f;
constexpr float THR = 8.f;
#define SBAR() __builtin_amdgcn_sched_barrier(0)
__device__ __forceinline__ int kswz(int row, int chunk) { return row * 128 + ((chunk ^ ((row >> 1) & 7)) << 4); }
__device__ __forceinline__ int v_st(int k, int c) { const int kk = (k & ~0xC) | ((k & 4) << 1) | ((k & 8) >> 1); return ((kk >> 3) * 4 + (c >> 5)) * 512 + ((kk & 7) * 32 + (c & 31)) * 2; }
__device__ __forceinline__ int v_rd_base(int lane) { return ((lane & 3) << 3) | (((lane >> 2) & 3) << 6) | (((lane >> 4) & 1) << 5) | (((lane >> 5) & 1) << 8); }
constexpr int v_rd_off(int d0, int ks, int half) { return d0 * 512 + ks * 4096 + half * 2048; }
__device__ __forceinline__ int crow(int r, int hi) { return (r & 3) + 8 * (r >> 2) + 4 * hi; }
__device__ __forceinline__ bf16x8 load8(const bf16_t* p) { return *reinterpret_cast<const bf16x8*>(p); }

__device__ __forceinline__ void mask_tile(f32x16& p0, f32x16& p1, int dq) {
    const float NEG = -__builtin_inff();
#pragma unroll
    for (int r = 0; r < 16; ++r) { const int c = (r & 3) + 8 * (r >> 2); if (dq - c < 0) p0[r] = NEG; if (dq - c - 32 < 0) p1[r] = NEG; }
}
__device__ __forceinline__ void partialSM(f32x16& p0, f32x16& p1, float& m_reg, float& alpha) {
    float pmax = p0[0];
#pragma unroll
    for (int r = 1; r < 16; ++r) pmax = fmaxf(pmax, p0[r]);
#pragma unroll
    for (int r = 0; r < 16; ++r) pmax = fmaxf(pmax, p1[r]);
    { auto rr = __builtin_amdgcn_permlane32_swap(__float_as_uint(pmax), __float_as_uint(pmax), false, false); pmax = fmaxf(__uint_as_float(rr[0]), __uint_as_float(rr[1])); }
    float mn;
    if (__builtin_expect(__all((pmax - m_reg) <= THR), 1)) { mn = m_reg; alpha = 1.f; }
    else { mn = fmaxf(m_reg, pmax); alpha = __builtin_amdgcn_exp2f(m_reg - mn); m_reg = mn; }
#pragma unroll
    for (int r = 0; r < 16; ++r) p0[r] = p0[r] - mn;
#pragma unroll
    for (int r = 0; r < 16; ++r) p1[r] = p1[r] - mn;
#pragma unroll
    for (int r = 0; r < 16; ++r) p0[r] = __builtin_amdgcn_exp2f(p0[r]);
}
__device__ __forceinline__ void finishSM(f32x16& p0, f32x16& p1, float alpha, float& l_reg, bf16x8& pa0, bf16x8& pa1, bf16x8& pa2, bf16x8& pa3) {
#pragma unroll
    for (int r = 0; r < 16; ++r) p1[r] = __builtin_amdgcn_exp2f(p1[r]);
    float ps = 0;
#pragma unroll
    for (int r = 0; r < 16; ++r) ps += p0[r];
#pragma unroll
    for (int r = 0; r < 16; ++r) ps += p1[r];
    { auto rr = __builtin_amdgcn_permlane32_swap(__float_as_uint(ps), __float_as_uint(ps), false, false); ps = __uint_as_float(rr[0]) + __uint_as_float(rr[1]); }
    l_reg = l_reg * alpha + ps;
#define PK4(P, B_, OUT) do { unsigned a0 = cvt_pk_bf16(P[B_+0], P[B_+1]), a1 = cvt_pk_bf16(P[B_+2], P[B_+3]);                          \
        unsigned b0 = cvt_pk_bf16(P[B_+4], P[B_+5]), b1 = cvt_pk_bf16(P[B_+6], P[B_+7]);                                             \
        auto r0 = __builtin_amdgcn_permlane32_swap(a0, b0, false, false); auto r1 = __builtin_amdgcn_permlane32_swap(a1, b1, false, false); \
        u32x4 w = {r0[0], r1[0], r0[1], r1[1]}; OUT = *reinterpret_cast<bf16x8*>(&w); } while (0)
    PK4(p0, 0, pa0); PK4(p0, 8, pa1); PK4(p1, 0, pa2); PK4(p1, 8, pa3);
#undef PK4
}
template <int KB>
__device__ __forceinline__ void qkt(f32x16& p0, f32x16& p1, const char* K_lds, int r32, int hi, const bf16x8* qr, float ab, float slope2) {
    const float s32 = 32.f * slope2;
#pragma unroll
    for (int r = 0; r < 16; ++r) { p0[r] = fmaf(slope2, (float)((r & 3) + 8 * (r >> 2)), ab); p1[r] = p0[r] + s32; }
#pragma unroll
    for (int d0 = 0; d0 < 4; ++d0) { const char* a = K_lds + KB * SHM_K + kswz(r32, d0 * 2 + hi);
        bf16x8 b0 = *reinterpret_cast<const bf16x8*>(a);
        bf16x8 b1 = *reinterpret_cast<const bf16x8*>(a + 32 * 128);
        p0 = __builtin_amdgcn_mfma_f32_32x32x16_bf16(b0, qr[d0], p0, 0, 0, 0);
        p1 = __builtin_amdgcn_mfma_f32_32x32x16_bf16(b1, qr[d0], p1, 0, 0, 0); }
}
template <int VB>
__device__ __forceinline__ void pv_tile(f32x16* o, int vb0, bf16x8 pa0, bf16x8 pa1, bf16x8 pa2, bf16x8 pa3) {
#define TRRD(dst, off) asm volatile("ds_read_b64_tr_b16 %0, %1 offset:%2" : "=&v"(dst) : "v"(vb0), "i"(off) : "memory")
#define PV_D0(d0) do { s16x4 l0, l1, l2, l3, h0, h1, h2, h3; constexpr int b_ = VB * SHM_V + v_rd_off(d0, 0, 0); \
        TRRD(l0, b_); TRRD(h0, b_ + 2048); TRRD(l1, b_ + 4096); TRRD(h1, b_ + 6144); TRRD(l2, b_ + 8192); TRRD(h2, b_ + 10240); TRRD(l3, b_ + 12288); TRRD(h3, b_ + 14336); \
        asm volatile("s_waitcnt lgkmcnt(0)" ::: "memory"); SBAR();   \
        o[d0] = __builtin_amdgcn_mfma_f32_32x32x16_bf16(pa0, (bf16x8){l0[0], l0[1], l0[2], l0[3], h0[0], h0[1], h0[2], h0[3]}, o[d0], 0, 0, 0);   \
        o[d0] = __builtin_amdgcn_mfma_f32_32x32x16_bf16(pa1, (bf16x8){l1[0], l1[1], l1[2], l1[3], h1[0], h1[1], h1[2], h1[3]}, o[d0], 0, 0, 0);   \
        o[d0] = __builtin_amdgcn_mfma_f32_32x32x16_bf16(pa2, (bf16x8){l2[0], l2[1], l2[2], l2[3], h2[0], h2[1], h2[2], h2[3]}, o[d0], 0, 0, 0);   \
        o[d0] = __builtin_amdgcn_mfma_f32_32x32x16_bf16(pa3, (bf16x8){l3[0], l3[1], l3[2], l3[3], h3[0], h3[1], h3[2], h3[3]}, o[d0], 0, 0, 0); } while (0)
    PV_D0(0); PV_D0(1); PV_D0(2); PV_D0(3);
#undef PV_D0
#undef TRRD
}

struct BlockRef { const bf16_t* Q; const bf16_t* K; const bf16_t* V; bf16_t* O; int P0; int mode; float slope2; float kmax; };
struct Seam { bf16x8 qr[4]; bf16x8 st_v0, st_v1, st_k0; };
__device__ __forceinline__ BlockRef mkref(const bf16_t* Z, bf16_t* AO, const unsigned* kmx, int item, int pass) { BlockRef r; const int bh = item >> 4, y = item & 15, b = bh >> 2, h = bh & 3; const int qb = (pass < 2) ? y : 31 - y, mp = pass & 1;
    const bf16_t* zb = Z + (size_t)b * SEQ * ZP; r.Q = zb + (size_t)(qb * 256) * ZP + ZQ + h * 128 + mp * 64; r.K = zb + ZK + h * 128 + mp * 64; r.V = zb + ZVAL + h * 128;
    r.O = AO + ((size_t)b * SEQ + qb * 256) * DM + 512 + h * 128; r.P0 = qb * 256; r.mode = mp; r.slope2 = exp2f(-2.0f * (float)(h + 1)) * LOG2E;
    const unsigned* kp = kmx + ((bh * 2 + mp) * 2); r.kmax = 1.01f * sqrtf(__uint_as_float(ld_u32_agent(kp)) + __uint_as_float(ld_u32_agent(kp + 1))); return r; }
#define ROWV(p, k0, rr) ((p) + (size_t)((k0) + (rr)) * ZP + sc)
#define ROWK(p, k0) ((p) + (size_t)((k0) + skr) * ZP + skc * 8)
#define VMW() asm volatile("s_waitcnt vmcnt(0)" ::: "memory")
#define VMWN(n) asm volatile("s_waitcnt vmcnt(%0)" :: "i"(n) : "memory")
#define SLOAD_H(Kp, Vp, k0) do { S.st_v0 = load8(ROWV(Vp, k0, sr)); S.st_v1 = load8(ROWV(Vp, k0, 32 + sr)); S.st_k0 = load8(ROWK(Kp, k0)); } while (0)
#define SWRITE_HK(bf) do { *(bf16x8*)(K_lds + (bf) * SHM_K + kws) = S.st_k0; } while (0)
#define SWRITE_HV(bf) do { *(bf16x8*)(V_lds + (bf) * SHM_V + vst0) = S.st_v0; *(bf16x8*)(V_lds + (bf) * SHM_V + vst1) = S.st_v1; } while (0)
#define SWRITE_H(bf) do { SWRITE_HV(bf); SWRITE_HK(bf); } while (0)
__device__ __forceinline__ void prime(const BlockRef& cur, char* lds, Seam& S, int wid) {
    const int lane = lane_id(), tid = wid * 64 + lane, r32 = lane & 31, hi = lane >> 5;
    const int sr = tid >> 4, sc = (tid & 15) * 8, skr = tid >> 3, skc = tid & 7, kws = kswz(skr, skc); char* K_lds = lds + LDS_K;
#pragma unroll
    for (int d0 = 0; d0 < 4; ++d0) S.qr[d0] = load8(cur.Q + (size_t)(wid * QBLK + r32) * ZP + d0 * 16 + hi * 8);
    SLOAD_H(cur.K, cur.V, cur.P0 + QB - KVBLK); VMW(); SWRITE_HK(0);
    __syncthreads();
}
__device__ __forceinline__ void block(const BlockRef& cur, const BlockRef& nxt, char* lds, Seam& S, float lam, const float* __restrict__ subln, int wid) {
    const int lane = lane_id(), tid = wid * 64 + lane, r32 = lane & 31, hi = lane >> 5;
    const int NT0 = (cur.P0 + QB) / KVBLK;
    int NT = NT0;
    const int qlo = cur.P0 + wid * QBLK, qm = qlo + r32 - 4 * hi;
    const float slope2 = cur.slope2;
    char* V_lds = lds + LDS_V; char* K_lds = lds + LDS_K;
    float* ws = (float*)(lds + LDS_WS) + wid * 64; float* li_l = ws, * al_l = ws + 32;
    float m_reg = -1e30f, l_reg = 0; f32x16 o[4] = {};
    const int sr = tid >> 4, sc = (tid & 15) * 8, vst0 = v_st(sr, sc), vst1 = v_st(32 + sr, sc), skr = tid >> 3, skc = tid & 7, kws = kswz(skr, skc);
    const int vb0 = (int)(uintptr_t)V_lds + v_rd_base(lane);
    const bf16_t* Kh = cur.K; const bf16_t* Vh = cur.V;
#define RESC(a) do { if (__any((a) < 1.f)) { if (hi == 0) al_l[r32] = (a); asm volatile("s_waitcnt lgkmcnt(0)" ::: "memory");              \
                     for (int d_ = 0; d_ < 4; ++d_) for (int r = 0; r < 16; ++r) o[d_][r] *= al_l[crow(r, hi)]; } } while (0)
#define KBASE(t) ((NT0 - 1 - (t)) * KVBLK)
#define AB(t) (slope2 * (float)(KBASE(t) - qm))
#define MASKT(P0_, P1_, t) do { const int kb_ = KBASE(t); if (kb_ + KVBLK - 1 > qlo) mask_tile(P0_, P1_, qm - kb_); } while (0)
    constexpr int NQL = 4;
#define SEAM_K0() do { VMWN(NQL); SWRITE_HK(0); SBAR(); } while (0)
    f32x16 pA0, pA1, pB0, pB1; float alA, alB; bf16x8 pa0, pa1, pa2, pa3;
    float cbase;
    { float q2 = 0.f;
#pragma unroll
      for (int d0 = 0; d0 < 4; ++d0)
#pragma unroll
          for (int j = 0; j < 8; ++j) { const float v = __uint_as_float(((unsigned)(unsigned short)S.qr[d0][j]) << 16); q2 = fmaf(v, v, q2); }
      { auto rr = __builtin_amdgcn_permlane32_swap(__float_as_uint(q2), __float_as_uint(q2), false, false); q2 = __uint_as_float(rr[0]) + __uint_as_float(rr[1]); }
      cbase = sqrtf(q2) * cur.kmax * 1.0001f - slope2 * (float)(qlo + r32); }
    SWRITE_HV(0); SBAR();
    if (NT > 1) { SLOAD_H(Kh, Vh, KBASE(1)); }
    SBAR(); qkt<0>(pA0, pA1, K_lds, r32, hi, S.qr, AB(0), slope2);
    MASKT(pA0, pA1, 0); partialSM(pA0, pA1, m_reg, alA);
    if (NT > 1) { VMW(); SWRITE_H(1); }
    __syncthreads();
#define HALF_STEP(PX0, PX1, alX, PY0, PY1, alY, t, KB, VB, SB) do {                                                      \
        SBAR(); qkt<KB>(PX0, PX1, K_lds, r32, hi, S.qr, AB(t), slope2);                                                   \
        finishSM(PY0, PY1, alY, l_reg, pa0, pa1, pa2, pa3); SBAR();                                                       \
        if ((t) + 1 < NT) { SLOAD_H(Kh, Vh, KBASE((t) + 1)); SBAR(); }                                                    \
        pv_tile<VB>(o, vb0, pa0, pa1, pa2, pa3); MASKT(PX0, PX1, (t)); partialSM(PX0, PX1, m_reg, alX);                   \
        __syncthreads();                                                                                                  \
        if ((t) + 1 < NT) { VMW(); SWRITE_H(SB); }                                                                        \
        RESC(alX); __syncthreads(); } while (0)
    for (int t = 1; t + 1 < NT; t += 2) {
        HALF_STEP(pB0, pB1, alB, pA0, pA1, alA, t, 1, 0, 0);
        HALF_STEP(pA0, pA1, alA, pB0, pB1, alB, t + 1, 0, 1, 1);
        if (t == 3 && NT0 > 6) {
            float c = cbase - m_reg;
#pragma unroll
            for (int o_ = 1; o_ < 64; o_ <<= 1) c = fmaxf(c, __shfl_xor(c, o_));
            float* cx = (float*)(lds + LDS_CX);
            if (lane == 0) cx[wid] = c;
            __syncthreads();
            float C = cx[0];
#pragma unroll
            for (int w_ = 1; w_ < NW; ++w_) C = fmaxf(C, cx[w_]);
            const float X = (-SKIP_MARGIN - C) / slope2 - 63.f;
            const float need_f = (float)(NT0 - 1) - X * (1.0f / 64.0f);
            if (need_f < (float)NT0) { int n = (int)ceilf(need_f); n = n < 6 ? 6 : n; n = (n + 1) & ~1; NT = n < NT0 ? n : NT0; }
        }
    }
    SBAR(); qkt<1>(pB0, pB1, K_lds, r32, hi, S.qr, AB(NT - 1), slope2); SBAR();
    SLOAD_H(nxt.K, nxt.V, nxt.P0 + QB - KVBLK); SBAR();
#pragma unroll
    for (int d0 = 0; d0 < 4; ++d0) S.qr[d0] = load8(nxt.Q + (size_t)(wid * QBLK + r32) * ZP + d0 * 16 + hi * 8);
    SBAR();
    finishSM(pA0, pA1, alA, l_reg, pa0, pa1, pa2, pa3); SBAR();
    pv_tile<0>(o, vb0, pa0, pa1, pa2, pa3);
    MASKT(pB0, pB1, NT - 1); partialSM(pB0, pB1, m_reg, alB); __syncthreads(); RESC(alB);
    finishSM(pB0, pB1, alB, l_reg, pa0, pa1, pa2, pa3); SBAR(); pv_tile<1>(o, vb0, pa0, pa1, pa2, pa3);
    SBAR(); SEAM_K0();
    if (hi == 0) li_l[r32] = l_reg; asm volatile("s_waitcnt lgkmcnt(0)" ::: "memory");
    float rli[16];
#pragma unroll
    for (int r = 0; r < 16; ++r) rli[r] = __builtin_amdgcn_rcpf(li_l[crow(r, hi)]);
    unsigned* stash = (unsigned*)(lds + LDS_STASH) + wid * 2048 + lane;
    if (cur.mode == 0) {
#pragma unroll
        for (int r = 0; r < 16; ++r) { stash[(r * 2 + 0) * 64] = cvt_pk_bf16(o[0][r] * rli[r], o[1][r] * rli[r]); stash[(r * 2 + 1) * 64] = cvt_pk_bf16(o[2][r] * rli[r], o[3][r] * rli[r]); }
    } else {
        float ssq[16];
#pragma unroll
        for (int r = 0; r < 16; ++r) { const unsigned w0 = stash[(r * 2 + 0) * 64], w1 = stash[(r * 2 + 1) * 64];
            o[0][r] = bf_lo(w0) - lam * (o[0][r] * rli[r]); o[1][r] = bf_hi(w0) - lam * (o[1][r] * rli[r]);
            o[2][r] = bf_lo(w1) - lam * (o[2][r] * rli[r]); o[3][r] = bf_hi(w1) - lam * (o[3][r] * rli[r]);
            ssq[r] = (o[0][r] * o[0][r] + o[1][r] * o[1][r]) + (o[2][r] * o[2][r] + o[3][r] * o[3][r]); }
#pragma unroll
        for (int r = 0; r < 16; ++r) {
#pragma unroll
            for (int off = 1; off < 32; off <<= 1) ssq[r] += __shfl_xor(ssq[r], off);
            ssq[r] = __builtin_amdgcn_rsqf(ssq[r] * (1.0f / DV) + RMS_EPS); }
        float g4[4];
#pragma unroll
        for (int d0 = 0; d0 < 4; ++d0) g4[d0] = subln[d0 * 32 + r32] * 0.8f;
        bf16_t* Ow = cur.O + (size_t)(wid * QBLK) * DM;
#pragma unroll
        for (int r = 0; r < 16; ++r) { const int orow = crow(r, hi);
#pragma unroll
            for (int d0 = 0; d0 < 4; ++d0) { const float v = o[d0][r] * ssq[r] * g4[d0]; const float vn = __shfl_xor(v, 1);
                if ((r32 & 1) == 0) *(unsigned*)(Ow + (size_t)orow * DM + d0 * 32 + r32) = cvt_pk_bf16(v, vn); } }
    }
    __syncthreads();
#undef RESC
#undef KBASE
#undef AB
#undef MASKT
#undef SEAM_K0
#undef HALF_STEP
}
#undef ROWV
#undef ROWK
#undef VMW
#undef VMWN
#undef SLOAD_H
#undef SWRITE_HK
#undef SWRITE_HV
#undef SWRITE_H
#undef SBAR
}


#define XB_TMO      128
#define XB_XCNT(j)  (256  + 64 * (j))
#define XB_XSUB(j)  (1280 + 64 * (j))
#define XB_XGEN(j)  (2304 + 64 * (j))
#define XB_TOP      3328
#define XB_TOPGEN   3392
#define XCD_BAR_WORDS 3456
#define XB_SPIN_CAP (1u << 22)
__device__ __forceinline__ unsigned xb_ld(unsigned* p)              { return __hip_atomic_load(p, __ATOMIC_RELAXED, __HIP_MEMORY_SCOPE_AGENT); }
__device__ __forceinline__ unsigned xb_add(unsigned* p, unsigned v) { return __hip_atomic_fetch_add(p, v, __ATOMIC_RELAXED, __HIP_MEMORY_SCOPE_AGENT); }
__device__ __forceinline__ unsigned xb_xcc_id() { return (unsigned)__builtin_amdgcn_s_getreg((3 << 11) | 20) & 0xFu; }
#define XB_SPIN(cond, bar) do { unsigned _sp = 0; while (cond) { __builtin_amdgcn_s_sleep(1); \
    if ((++_sp & 255u) == 0u) { if (xb_ld(&(bar)[XB_TMO])) break; if (_sp > XB_SPIN_CAP) { atomicAdd(&(bar)[XB_TMO], 1u); break; } } } } while (0)
struct XcdBarrier { unsigned* bar; unsigned x; volatile LAS unsigned* st; };
__device__ __forceinline__ XcdBarrier xcd_barrier_post(unsigned* bar, volatile LAS unsigned* st, bool t0) {
    XcdBarrier b; b.bar = bar; b.x = xb_xcc_id(); b.st = st;
    if (t0) (void)xb_add(&bar[XB_XCNT(b.x)], 1u);
    return b;
}
__device__ __forceinline__ void xcd_barrier_complete(unsigned* bar, unsigned x, unsigned& nloc, unsigned& nx) {
    const unsigned G = gridDim.x;
    unsigned sum, cnt, mine, sp = 0u;
    for (;;) {
        sum = 0u; cnt = 0u; mine = 0u;
#pragma unroll
        for (unsigned j = 0; j < 16; ++j) { const unsigned c = xb_ld(&bar[XB_XCNT(j)]); sum += c; cnt += (c > 0u) ? 1u : 0u; mine = (j == x) ? c : mine; }
        if (sum == G) break;
        __builtin_amdgcn_s_sleep(1);
        if ((++sp & 255u) == 0u) { if (xb_ld(&bar[XB_TMO])) break; if (sp > XB_SPIN_CAP) { atomicAdd(&bar[XB_TMO], 1u); break; } }
    }
    nloc = mine > 0u ? mine : 1u; nx = cnt > 0u ? cnt : 1u;
}
__device__ __forceinline__ void xcd_barrier(const XcdBarrier& b, bool t0) {
    asm volatile("s_waitcnt vmcnt(0)" ::: "memory");
    __syncthreads();
    if (t0) {
        unsigned* bar = b.bar;
        __builtin_amdgcn_s_waitcnt(0);
        unsigned nloc = b.st[0], nx = b.st[1];
        if (nloc == 0u) { xcd_barrier_complete(bar, b.x, nloc, nx); b.st[0] = nloc; b.st[1] = nx; }
        const unsigned old = xb_add(&bar[XB_XSUB(b.x)], 1u);
        const unsigned gen = old / nloc;
        if (old + 1u == (gen + 1u) * nloc) {
            __builtin_amdgcn_fence(__ATOMIC_RELEASE, "agent");
            asm volatile("s_waitcnt vmcnt(0)" ::: "memory");
            const unsigned og = xb_add(&bar[XB_TOP], 1u);
            const unsigned tg = og / nx;
            if (og + 1u == (tg + 1u) * nx) xb_add(&bar[XB_TOPGEN], 1u);
            else XB_SPIN(xb_ld(&bar[XB_TOPGEN]) == tg, bar);
            __builtin_amdgcn_fence(__ATOMIC_ACQUIRE, "agent");
            xb_add(&bar[XB_XGEN(b.x)], 1u);
            asm volatile("s_waitcnt vmcnt(0)" ::: "memory");
        } else {
            XB_SPIN(xb_ld(&bar[XB_XGEN(b.x)]) == gen, bar);
            __builtin_amdgcn_fence(__ATOMIC_ACQUIRE, "agent");
            asm volatile("s_waitcnt vmcnt(0)" ::: "memory");
        }
    }
    __syncthreads();
}
constexpr int NWAVES = 8, NTHR = 512;
constexpr int LDS_BYTES = 163840;
struct Args {
    const float* in[28]; float* out; unsigned char* ws; int ph_lo, ph_hi;
};
constexpr int N_PHASES = 15;

struct Frame {
    LAS unsigned char* lds; int wave, vcu, G;
};

__device__ __forceinline__ void transpose_item(const float* W, int ldw, int k0, int n0, bf16_t* dst, int ldt, const float* kscale, LAS float* scr, int lane) {
    f32x4 v[8]; const int kr = lane >> 3, n4 = (lane & 7) * 4;
#pragma unroll
    for (int i = 0; i < 8; ++i) v[i] = *(const f32x4*)(W + (size_t)(k0 + i * 8 + kr) * ldw + n0 + n4);
#pragma unroll
    for (int i = 0; i < 8; ++i) { const int kk = i * 8 + kr; f32x4 x = v[i]; if (kscale) x = x * kscale[k0 + kk];
        scr[kk * 33 + n4 + 0] = x[0]; scr[kk * 33 + n4 + 1] = x[1]; scr[kk * 33 + n4 + 2] = x[2]; scr[kk * 33 + n4 + 3] = x[3]; }
    asm volatile("s_waitcnt lgkmcnt(0)" ::: "memory");
    const int c = lane & 7;
#pragma unroll
    for (int j = 0; j < 4; ++j) { const int n = (lane >> 3) + 8 * j; const LAS float* s = scr + (8 * c) * 33 + n;
        u32x4 o; o.x = cvt_pk_bf16(s[0 * 33], s[1 * 33]); o.y = cvt_pk_bf16(s[2 * 33], s[3 * 33]); o.z = cvt_pk_bf16(s[4 * 33], s[5 * 33]); o.w = cvt_pk_bf16(s[6 * 33], s[7 * 33]);
        *(u32x4*)(dst + (size_t)n * ldt + k0 + 8 * c) = o; }
    asm volatile("s_waitcnt lgkmcnt(0)" ::: "memory");
}
__device__ __forceinline__ void rms_rows2_to_bf16(const float* xa, const float* xb, const float* g, bf16_t* oa, bf16_t* ob, int lane) {
    const f32x4* ra = (const f32x4*)xa + lane; const f32x4* rb = (const f32x4*)xb + lane; const f32x4* gr = (const f32x4*)g + lane;
    f32x4 va[4], vb[4]; float sa = 0.f, sb = 0.f;
#pragma unroll
    for (int j = 0; j < 4; ++j) { va[j] = ra[64 * j]; vb[j] = rb[64 * j]; }
#pragma unroll
    for (int j = 0; j < 4; ++j) { sa += (va[j].x * va[j].x + va[j].y * va[j].y) + (va[j].z * va[j].z + va[j].w * va[j].w); sb += (vb[j].x * vb[j].x + vb[j].y * vb[j].y) + (vb[j].z * vb[j].z + vb[j].w * vb[j].w); }
    const float rsa = __builtin_amdgcn_rsqf(wave_sum(sa) * (1.f / DM) + RMS_EPS), rsb = __builtin_amdgcn_rsqf(wave_sum(sb) * (1.f / DM) + RMS_EPS);
    u32x2* pa = (u32x2*)oa + lane; u32x2* pb = (u32x2*)ob + lane;
#pragma unroll
    for (int j = 0; j < 4; ++j) { const f32x4 gg = gr[64 * j]; u32x2 w;
        w.x = cvt_pk_bf16(va[j].x * rsa * gg.x, va[j].y * rsa * gg.y); w.y = cvt_pk_bf16(va[j].z * rsa * gg.z, va[j].w * rsa * gg.w); pa[64 * j] = w;
        w.x = cvt_pk_bf16(vb[j].x * rsb * gg.x, vb[j].y * rsb * gg.y); w.y = cvt_pk_bf16(vb[j].z * rsb * gg.z, vb[j].w * rsb * gg.w); pb[64 * j] = w; }
}

__global__ void __launch_bounds__(NTHR, 2) mega(Args args) {
    extern __shared__ __attribute__((aligned(16))) unsigned char lds_raw[];
    Frame F; F.lds = (LAS unsigned char*)lds_raw; F.wave = __builtin_amdgcn_readfirstlane(threadIdx.x >> 6);
    F.G = gridDim.x; { const int bx = blockIdx.x; F.vcu = (F.G % 8 == 0) ? (bx % 8) * (F.G / 8) + bx / 8 : bx; }
    unsigned char* ws = args.ws;
    unsigned* ctl = (unsigned*)(ws + WS_CTL);
    const float* x = args.in[0]; float* out = args.out;
    bf16_t* Win_t = (bf16_t*)(ws + WS_WIN); bf16_t* Wout_t = (bf16_t*)(ws + WS_WOUT); bf16_t* Wq_t = (bf16_t*)(ws + WS_WQ); bf16_t* Wkv_t = (bf16_t*)(ws + WS_WKV);
    bf16_t* Wo_t = (bf16_t*)(ws + WS_WO); bf16_t* Wr_t = (bf16_t*)(ws + WS_WR); bf16_t* Wsgu = (bf16_t*)(ws + WS_WSGU); bf16_t* memn = (bf16_t*)(ws + WS_MEMN);
    bf16_t* Km = (bf16_t*)(ws + WS_KM); bf16_t* Vt = (bf16_t*)(ws + WS_VT); bf16_t* Wgu_t = (bf16_t*)(ws + WS_WGU); bf16_t* Wd_t = (bf16_t*)(ws + WS_WD);
    bf16_t* Z = (bf16_t*)(ws + WS_RA); bf16_t* Qm = (bf16_t*)(ws + WS_RA); bf16_t* Sc = (bf16_t*)(ws + WS_RA + 128 * MiB); bf16_t* xg = (bf16_t*)(ws + WS_RA); bf16_t* yb = (bf16_t*)(ws + WS_RA);
    bf16_t* XN = (bf16_t*)(ws + WS_RB); bf16_t* AO = (bf16_t*)(ws + WS_RB); bf16_t* Om = (bf16_t*)(ws + WS_RB); bf16_t* act = (bf16_t*)(ws + WS_RB);
    bf16_t* x1b = (bf16_t*)(ws + WS_RC); bf16_t* x2b = (bf16_t*)(ws + WS_RC);
    float* ssq1 = (float*)(ws + WS_SSQ1); float* ssq2 = (float*)(ws + WS_SSQ2); float* rstd2 = (float*)(ws + WS_SSQ1);     float* logit = (float*)(ws + WS_LOGIT);
    int* tok_e = (int*)(ws + WS_TOKE); float* tok_w = (float*)(ws + WS_TOKW); int* tok_s = (int*)(ws + WS_TOKS); int* row_tok = (int*)(ws + WS_ROWTOK); float* rowrs = (float*)(ws + WS_ROWTOK + 1 * MiB);
    const int gw = F.vcu * NWAVES + F.wave, NGW = F.G * NWAVES;
    const int lo = args.ph_lo, hi = args.ph_hi;
#define IN(k) (lo <= (k) && (k) < hi)
#if MK_ONE_LAUNCH
    volatile LAS unsigned* misc = (volatile LAS unsigned*)(F.lds + LDS_MISC);
    if (threadIdx.x < 64) misc[threadIdx.x] = 0u;
    __syncthreads();
    XcdBarrier xbar = xcd_barrier_post(ctl + CW_BAR, misc + 8, threadIdx.x == 0);
#define GRID_BAR(k) do { if (IN(k) && IN((k) + 1)) { if ((k) == 0) cg::this_grid().sync(); else xcd_barrier(xbar, F.wave == 0 && lane_id() == 0); } } while (0)
#else
#define GRID_BAR(k) do { } while (0)
#endif

    if (IN(0)) {
        const int lane_ = lane_id(), tid_ = F.wave * 64 + lane_; (void)tid_;
        LAS float* scr = (LAS float*)(F.lds + F.wave * 16384);
        constexpr int I_IN = 16 * 80, I_SQ = 16 * 32, I_KV = 16 * 64, I_G = 16 * 16, I_D = 8 * 32;
        constexpr int NITEMS = I_IN + 3 * I_SQ + I_KV + NEXP * (2 * I_G + I_D);
        for (int it = gw; it < NITEMS; it += NGW) {
            int r = it;
            if (r < I_IN) { const int kb = r / 80, nb = r % 80; transpose_item(args.in[3], ZP, kb * 64, nb * 32, Win_t + (size_t)(nb * 32) * DM, DM, nullptr, scr, lane_); continue; } r -= I_IN;
            if (r < I_SQ) { const int kb = r / 32, nb = r % 32; transpose_item(args.in[13], DM, kb * 64, nb * 32, Wout_t + (size_t)(nb * 32) * DM, DM, nullptr, scr, lane_); continue; } r -= I_SQ;
            if (r < I_SQ) { const int kb = r / 32, nb = r % 32; transpose_item(args.in[16], DM, kb * 64, nb * 32, Wq_t + (size_t)(nb * 32) * DM, DM, args.in[14], scr, lane_); continue; } r -= I_SQ;
            if (r < I_KV) { const int kb = r / 64, nb = r % 64; transpose_item(args.in[17], 2 * DM, kb * 64, nb * 32, Wkv_t + (size_t)(nb * 32) * DM, DM, nullptr, scr, lane_); continue; } r -= I_KV;
            if (r < I_SQ) { const int kb = r / 32, nb = r % 32; transpose_item(args.in[18], DM, kb * 64, nb * 32, Wo_t + (size_t)(nb * 32) * DM, DM, nullptr, scr, lane_); continue; } r -= I_SQ;
            const int e = r / (2 * I_G + I_D); r -= e * (2 * I_G + I_D);
            if (r < 2 * I_G) { const int up = r >= I_G; if (up) r -= I_G; const int kb = r / 16, nb = r % 16, n0 = nb * 32;
                const float* W = (up ? args.in[25] : args.in[24]) + (size_t)e * DM * DEXP;
                transpose_item(W, DEXP, kb * 64, n0, Wgu_t + ((size_t)e * 1024 + (n0 >> 7) * 256 + 64 * ((n0 & 127) >> 5) + 32 * up) * DM, DM, args.in[19], scr, lane_); continue; }
            r -= 2 * I_G;
            { const int kb = r / 32, nb = r % 32; transpose_item(args.in[26] + (size_t)e * DEXP * DM, DM, kb * 64, nb * 32, Wd_t + ((size_t)e * 1024 + nb * 32) * DEXP, DEXP, nullptr, scr, lane_); }
        }
        for (int i = blockIdx.x * NTHR + tid_; i < 256 * DM; i += F.G * NTHR) { const int n = i >> 10, k = i & 1023; float v = 0.f;
            if (n < 4) v = args.in[20][k * 4 + n] * args.in[19][k]; else if (n < 36) v = args.in[22][k * 32 + (n - 4)] * args.in[19][k];
            Wr_t[i] = (bf16_t)(cvt_pk_bf16(v, 0.f) & 0xffffu); }
        for (int i = blockIdx.x * NTHR + tid_; i < 4 * 128 * 128; i += F.G * NTHR) { const int t = (i >> 7) & 127, s = i & 127; const float v = s <= t ? args.in[6][i] : 0.f; Wsgu[i] = (bf16_t)(cvt_pk_bf16(v, 0.f) & 0xffffu); }
        for (int m = gw; m < M; m += 2 * NGW) rms_rows2_to_bf16(x + (size_t)m * DM, x + (size_t)(m + NGW) * DM, args.in[2], XN + (size_t)m * DM, XN + (size_t)(m + NGW) * DM, lane_);
        for (int m = gw; m < MROWS / 2; m += NGW) rms_rows2_to_bf16(args.in[1] + (size_t)m * DM, args.in[1] + (size_t)(m + MROWS / 2) * DM, args.in[15], memn + (size_t)m * DM, memn + (size_t)(m + MROWS / 2) * DM, lane_);
        __syncthreads();
    }
    GRID_BAR(0);

    if (IN(1)) {
        { pg8::Gemm g{DM, DM, DM}; pg8::PlainSched S; S.to.init(M / 256, ZP / 256, F.G, (int)blockIdx.x); S.A = (const char*)XN; S.B = (const char*)Win_t; S.tA = (size_t)256 * DM * 2; S.tB = (size_t)256 * DM * 2;
          pg8::EpiZ E{Z, ctl + CW_KMX}; pg8::gemm_phase(F.lds, F.wave, g, S, E); }
    }
    GRID_BAR(1);

    if (IN(2)) {
        const int lane_ = lane_id(), tid_ = F.wave * 64 + lane_; (void)tid_;
        float lam;
        { const float a = args.in[8][lane_] * args.in[9][lane_], b = args.in[10][lane_] * args.in[11][lane_];
          lam = __expf(wave_sum(a)) - __expf(wave_sum(b)) + 0.2f; }
        const int nitems = 32 * 16, npass = 4;
        int nit, itA, itB, itC;
        if (F.G == 256) { const int b = F.vcu >> 5, r = F.vcu & 31; if (r < 16) { nit = 1; itA = ((b * 4 + 3) << 4) | r; itB = itA; itC = itA; }
            else { const int y = r - 16; nit = 3; itA = ((b * 4 + 2) << 4) | y; itB = ((b * 4 + 1) << 4) | (15 - y); itC = ((b * 4 + 0) << 4) | y; } }
        else { const int per = (nitems + F.G - 1) / F.G; itA = F.vcu * per; int e_ = itA + per; if (e_ > nitems) e_ = nitems; nit = e_ - itA; itB = itA + 1; itC = itA + 2; }
#define ITEM_OF(i) ((F.G == 256) ? ((i) == 0 ? itA : ((i) == 1 ? itB : itC)) : itA + (i))
        if (nit > 0) {
            int ii = 0, pass = 0; da::BlockRef cur = da::mkref(Z, AO, ctl + CW_KMX, ITEM_OF(0), 0); da::Seam S;
            da::prime(cur, (char*)lds_raw, S, F.wave);
            for (;;) {
                int ni = ii, np = pass + 1; if (np == npass) { np = 0; ni = ii + 1; }
                const bool last = ni >= nit * PROBE_DUP_ATTN;
                const da::BlockRef nxt = last ? cur : da::mkref(Z, AO, ctl + CW_KMX, ITEM_OF(ni % nit), np);
                da::block(cur, nxt, (char*)lds_raw, S, lam, args.in[12], F.wave);
                if (last) break;
                cur = nxt; ii = ni; pass = np;
            }
        }
#undef ITEM_OF
        __syncthreads();
        {
            const int lane = lane_, w = F.wave;
            const int nun = (M / 128) * 4;
            const int ch0 = (lane & 15) * 8, t = 16 * w + (lane & 15), nks = (w + 2) >> 1;
            u32x4 vr[4];
            LAS int* sq = (LAS int*)(F.lds + 2 * 34816);
            const bool puller = (w == 0 && lane == 0);
            if (puller) { sq[0] = (int)atomicAdd(ctl + CW_SGUQ, 1u); sq[1] = (int)atomicAdd(ctl + CW_SGUQ, 1u); }
            __syncthreads();
            int uidx = __builtin_amdgcn_readfirstlane(sq[0]), unext = __builtin_amdgcn_readfirstlane(sq[1]), kk = 0;
            if (uidx < nun) { const size_t R0 = (size_t)(uidx >> 2) * 128; const int g = uidx & 3;
#pragma unroll
                for (int ps = 0; ps < 4; ++ps) vr[ps] = *(const u32x4*)(Z + (R0 + 16 * w + 4 * ps + (lane >> 4)) * ZP + ZV + g * 128 + ch0); }
            int gcur = -1; float lg[8], lb[8]; bf16x8 wf[4]; float bias = 0.f; int buf = 0;
#pragma unroll
            for (int j = 0; j < 8; ++j) { lg[j] = 0.f; lb[j] = 0.f; }
#pragma unroll
            for (int ks = 0; ks < 4; ++ks) wf[ks] = (bf16x8){0, 0, 0, 0, 0, 0, 0, 0};
            for (; uidx < nun; uidx = unext, unext = __builtin_amdgcn_readfirstlane(sq[(kk + 1) & 3]), buf ^= 1) {
                int pulled_ = 0; if (puller) pulled_ = (int)atomicAdd(ctl + CW_SGUQ, 1u);
                const int c = uidx >> 2, g = uidx & 3; const size_t R0 = (size_t)c * 128;
                LAS bf16_t* vnT = (LAS bf16_t*)(F.lds + buf * 34816);
                if (g != gcur) { gcur = g;
#pragma unroll
                    for (int j = 0; j < 8; ++j) { lg[j] = args.in[4][g * 128 + ch0 + j]; lb[j] = args.in[5][g * 128 + ch0 + j]; }
#pragma unroll
                    for (int ks = 0; ks < 4; ++ks) if (ks < nks) wf[ks] = *(const bf16x8*)(Wsgu + ((size_t)g * 128 + t) * 128 + ks * 32 + 8 * (lane >> 4));
                    bias = args.in[7][g * 128 + t]; }
#pragma unroll
                for (int ps = 0; ps < 4; ++ps) { const int sr = 16 * w + 4 * ps + (lane >> 4); const u32x4 raw = vr[ps];
                    float v[8] = {bf_lo(raw.x), bf_hi(raw.x), bf_lo(raw.y), bf_hi(raw.y), bf_lo(raw.z), bf_hi(raw.z), bf_lo(raw.w), bf_hi(raw.w)};
                    float sm = 0.f;
#pragma unroll
                    for (int j = 0; j < 8; ++j) sm += v[j];
#pragma unroll
                    for (int o = 1; o < 16; o <<= 1) sm += __shfl_xor(sm, o);
                    const float mu = sm * (1.f / 128.f); float q = 0.f;
#pragma unroll
                    for (int j = 0; j < 8; ++j) { v[j] -= mu; q += v[j] * v[j]; }
#pragma unroll
                    for (int o = 1; o < 16; o <<= 1) q += __shfl_xor(q, o);
                    const float rstd = __builtin_amdgcn_rsqf(q * (1.f / 128.f) + LN_EPS);
#pragma unroll
                    for (int j = 0; j < 8; ++j) { const float y = v[j] * rstd * lg[j] + lb[j]; vnT[(ch0 + j) * 136 + sr] = (bf16_t)(cvt_pk_bf16(y, 0.f) & 0xffffu); } }
                u32x2 ur[8];
#pragma unroll
                for (int mi = 0; mi < 8; ++mi) ur[mi] = *(const u32x2*)(Z + (R0 + t) * ZP + ZU + g * 128 + 16 * mi + 4 * (lane >> 4));
                { const int un = unext; if (un < nun) { const size_t Rn = (size_t)(un >> 2) * 128; const int gn = un & 3;
#pragma unroll
                    for (int ps = 0; ps < 4; ++ps) vr[ps] = *(const u32x4*)(Z + (Rn + 16 * w + 4 * ps + (lane >> 4)) * ZP + ZV + gn * 128 + ch0); } }
                if (puller) sq[(kk + 2) & 3] = pulled_;
                ++kk;
                __syncthreads();
                f32x4 acc[8];
#pragma unroll
                for (int mi = 0; mi < 8; ++mi) acc[mi] = (f32x4){0.f, 0.f, 0.f, 0.f};
#pragma unroll
                for (int ks = 0; ks < 4; ++ks) if (ks < nks) {
#pragma unroll
                    for (int mi = 0; mi < 8; ++mi) { const bf16x8 afr = *(const LAS bf16x8*)(vnT + (16 * mi + (lane & 15)) * 136 + ks * 32 + 8 * (lane >> 4));
                        acc[mi] = __builtin_amdgcn_mfma_f32_16x16x32_bf16(afr, wf[ks], acc[mi], 0, 0, 0); } }
#pragma unroll
                for (int mi = 0; mi < 8; ++mi) { const int ch = 16 * mi + 4 * (lane >> 4); const u32x2 u2 = ur[mi];
                    const float o0 = bf_lo(u2.x) * (acc[mi][0] + bias), o1 = bf_hi(u2.x) * (acc[mi][1] + bias), o2 = bf_lo(u2.y) * (acc[mi][2] + bias), o3 = bf_hi(u2.y) * (acc[mi][3] + bias);
                    u32x2 wv; wv.x = cvt_pk_bf16(o0, o1); wv.y = cvt_pk_bf16(o2, o3);
                    *(u32x2*)(AO + (R0 + t) * DM + g * 128 + ch) = wv; }
            }
            __syncthreads();
        }
        {
            int e = -1;
            if (F.G == 256) { const int b = F.vcu >> 5, r = F.vcu & 31; if (r >= 16 && r < 24) e = b * 8 + (r - 16); }
            for (int e2 = (F.G == 256 ? e : F.vcu); e2 >= 0 && e2 < 64; e2 = (F.G == 256 ? 64 : e2 + F.G)) {
                pg8::Gemm g{DM, DM, DM}; pg8::OneUnitSched S;
                if (e2 < 32) { S.u0.pm = e2 >> 2; S.u0.pn = e2 & 3; S.u0.aux = 0; S.u0.rows = nullptr; S.u0.A = (const char*)(memn + (size_t)S.u0.pm * 256 * DM); S.u0.B = (const char*)(Wkv_t + (size_t)S.u0.pn * 256 * DM);
                    pg8::EpiBf16 E{Km, DM, nullptr, 1.f}; pg8::gemm_phase(F.lds, F.wave, g, S, E); }
                else { const int e3 = e2 - 32; S.u0.pm = e3 >> 3; S.u0.pn = e3 & 7; S.u0.aux = 0; S.u0.rows = nullptr; S.u0.A = (const char*)(Wkv_t + (size_t)(1024 + S.u0.pm * 256) * DM); S.u0.B = (const char*)(memn + (size_t)S.u0.pn * 256 * DM);
                    pg8::EpiBf16 E{Vt, MROWS, nullptr, 1.f}; pg8::gemm_phase(F.lds, F.wave, g, S, E); }
            }
        }
    }
    GRID_BAR(2);

    if (IN(3)) {
        pg8::Gemm g{DM, DM, DM}; pg8::PlainSched S; S.to.init(M / 256, 4, F.G, (int)blockIdx.x); S.A = (const char*)AO; S.B = (const char*)Wout_t; S.tA = (size_t)256 * DM * 2; S.tB = (size_t)256 * DM * 2;
        pg8::EpiResid<false> E{x, x1b, ssq1}; pg8::gemm_phase(F.lds, F.wave, g, S, E);
    }
    GRID_BAR(3);

    if (IN(4)) {
        pg8::Gemm g{DM, DM, DM}; pg8::PlainSched S; S.to.init(M / 256, 4, F.G, (int)blockIdx.x); S.A = (const char*)x1b; S.B = (const char*)Wq_t; S.tA = (size_t)256 * DM * 2; S.tB = (size_t)256 * DM * 2;
        pg8::EpiBf16 E{Qm, DM, ssq1, C2_MEM}; pg8::gemm_phase(F.lds, F.wave, g, S, E);
    }
    GRID_BAR(4);

    if (IN(5)) {
        pg8::Gemm g{DM, DM, 256}; pg8::MemAttnSched S; S.to.init(M / 256, 4, F.G, (int)blockIdx.x); S.A = (const char*)Qm; S.B = (const char*)Km; S.bB = (size_t)256 * DM * 2; S.hB = 512;
        pg8::EpiSoftmax E{Sc, (LAS float*)(F.lds + LDS_MISC + 1024)}; pg8::gemm_phase(F.lds, F.wave, g, S, E);
    }
    GRID_BAR(5);

    if (IN(7)) {
        pg8::Gemm g{DM, MROWS, 256}; pg8::MemAttnSched S; S.to.init(M / 256, 4, F.G, (int)blockIdx.x); S.A = (const char*)Sc; S.B = (const char*)Vt; S.bB = 512; S.hB = (size_t)256 * MROWS * 2;
        pg8::EpiBf16 E{Om, DM, nullptr, 1.f}; pg8::gemm_phase(F.lds, F.wave, g, S, E);
    }
    GRID_BAR(7);

    if (IN(8)) {
        pg8::Gemm g{DM, DM, DM}; pg8::PlainSched S; S.to.init(M / 256, 4, F.G, (int)blockIdx.x); S.A = (const char*)Om; S.B = (const char*)Wo_t; S.tA = (size_t)256 * DM * 2; S.tB = (size_t)256 * DM * 2;
        pg8::EpiResid<true> E{x1b, x2b, ssq2}; pg8::gemm_phase(F.lds, F.wave, g, S, E);
    }
    GRID_BAR(8);

    if (IN(9)) {
        pg8::Gemm g{DM, DM, DM}; pg8::PlainSched S; S.to.init(M / 256, 1, F.G, (int)blockIdx.x); S.A = (const char*)x2b; S.B = (const char*)Wr_t; S.tA = (size_t)256 * DM * 2; S.tB = 0;
        pg8::EpiRouter E{logit, ssq2, args.in[21], args.in[23], rstd2}; pg8::gemm_phase(F.lds, F.wave, g, S, E);
    }
    GRID_BAR(9);

    if (IN(10)) {
        const int lane_ = lane_id(), tid_ = F.wave * 64 + lane_; (void)tid_;
        LAS unsigned* lcnt = (LAS unsigned*)F.lds; LAS unsigned* lbase = lcnt + 32;
        for (int t0 = blockIdx.x * NTHR; t0 < M; t0 += F.G * NTHR) {
            if (tid_ < 32) lcnt[tid_] = 0u;
            __syncthreads();
            const int tok = t0 + tid_;
            const f32x4 lg = *(const f32x4*)(logit + (size_t)tok * 64);
            int gi = 0; float gm = lg[0];
#pragma unroll
            for (int j = 1; j < 4; ++j) if (lg[j] > gm) { gm = lg[j]; gi = j; }
            float gs = 0.f;
#pragma unroll
            for (int j = 0; j < 4; ++j) gs += __expf(lg[j] - gm);
            const float gate = 1.0f / gs;
            const f32x4 ea = *(const f32x4*)(logit + (size_t)tok * 64 + 4 + gi * 8), eb = *(const f32x4*)(logit + (size_t)tok * 64 + 8 + gi * 8);
            const float el[8] = {ea[0], ea[1], ea[2], ea[3], eb[0], eb[1], eb[2], eb[3]};
            int i0 = 0; float m0 = el[0];
#pragma unroll
            for (int j = 1; j < 8; ++j) if (el[j] > m0) { m0 = el[j]; i0 = j; }
            int i1 = -1; float m1 = -__builtin_inff();
#pragma unroll
            for (int j = 0; j < 8; ++j) if (j != i0 && el[j] > m1) { m1 = el[j]; i1 = j; }
            if (i1 < 0) i1 = (i0 == 0) ? 1 : 0;
            const float r = __expf(m1 - m0);
            const float w0 = gate / (1.0f + r), w1 = gate * r / (1.0f + r);
            const int e0 = gi * 8 + i0, e1 = gi * 8 + i1;
            const unsigned r0 = atomicAdd((unsigned*)&lcnt[e0], 1u), r1 = atomicAdd((unsigned*)&lcnt[e1], 1u);
            __syncthreads();
            if (tid_ < 32) lbase[tid_] = atomicAdd(ctl + CW_CNT + tid_, lcnt[tid_]);
            __syncthreads();
            tok_e[tok * 2] = e0; tok_e[tok * 2 + 1] = e1; tok_w[tok * 2] = w0; tok_w[tok * 2 + 1] = w1;
            tok_s[tok * 2] = (int)(lbase[e0] + r0); tok_s[tok * 2 + 1] = (int)(lbase[e1] + r1);
            __syncthreads();
        }
    }
    GRID_BAR(10);

    if (IN(11)) {
        const int lane_ = lane_id(), tid_ = F.wave * 64 + lane_; (void)tid_;
        LAS unsigned* lps = (LAS unsigned*)F.lds;
        if (tid_ == 0) { unsigned acc = 0; for (int e = 0; e < 32; ++e) { lps[e] = acc; const unsigned c = ld_u32_agent(ctl + CW_CNT + e); acc += (c + 255u) & ~255u; } lps[32] = acc; }
        __syncthreads();
        if (blockIdx.x == 0) {
            if (tid_ < 32) { const unsigned s = lps[tid_], e2 = lps[tid_ + 1], c = ld_u32_agent(ctl + CW_CNT + tid_);
                for (unsigned b = s >> 8; b < (e2 >> 8); ++b) ctl[CW_BLKE + b] = (unsigned)tid_;
                for (unsigned r = s + c; r < e2; ++r) { row_tok[r] = 0; rowrs[r] = 0.f; } }
            if (tid_ == 0) ctl[CW_NBLK] = lps[32] >> 8;
        }
        for (int a = blockIdx.x * NTHR + tid_; a < M * 2; a += F.G * NTHR) { const int e = tok_e[a]; const int pos = (int)lps[e] + tok_s[a]; row_tok[pos] = a >> 1; tok_s[a] = pos; rowrs[pos] = rstd2[a >> 1]; }
        __syncthreads();
    }
    GRID_BAR(11);

    if (IN(12)) {
        const int nblk = (int)__builtin_amdgcn_readfirstlane(ld_u32_agent(ctl + CW_NBLK));
        pg8::Gemm g{DM, DM, DM}; pg8::MoeSched S{F.G, F.vcu, nblk, ctl + CW_BLKE, (const char*)x2b, (const char*)Wgu_t, (size_t)0, (size_t)1024 * DM * 2, (size_t)256 * DM * 2, row_tok};
        pg8::EpiGateUp E{act, rowrs, row_tok}; pg8::gemm_phase<pg8::EpiGateUp, pg8::MoeSched, true>(F.lds, F.wave, g, S, E);
    }
    GRID_BAR(12);

    if (IN(13)) {
        const int nblk = (int)__builtin_amdgcn_readfirstlane(ld_u32_agent(ctl + CW_NBLK));
        pg8::Gemm g{DEXP, DEXP, DEXP}; pg8::MoeSched S{F.G, F.vcu, nblk, ctl + CW_BLKE, (const char*)act, (const char*)Wd_t, (size_t)256 * DEXP * 2, (size_t)1024 * DEXP * 2, (size_t)256 * DEXP * 2, row_tok};
        pg8::EpiBf16 E{yb, DM, nullptr, 1.f}; pg8::gemm_phase(F.lds, F.wave, g, S, E);
    }
    GRID_BAR(13);

    if (IN(14)) {
        const int lane_ = lane_id(), tid_ = F.wave * 64 + lane_; (void)tid_;
        const f32x4* gr = (const f32x4*)args.in[27] + lane_;
        f32x4 gg[4];
#pragma unroll
        for (int j = 0; j < 4; ++j) gg[j] = gr[64 * j];
        for (int m = gw; m < M; m += 2 * NGW) {
            const int ma = m, mb = m + NGW;
            const int pa0 = tok_s[ma * 2], pa1 = tok_s[ma * 2 + 1], pb0 = tok_s[mb * 2], pb1 = tok_s[mb * 2 + 1];
            const float wa0 = tok_w[ma * 2], wa1 = tok_w[ma * 2 + 1], wb0 = tok_w[mb * 2], wb1 = tok_w[mb * 2 + 1];
            const u32x2* xa = (const u32x2*)(x2b + (size_t)ma * DM) + lane_; const u32x2* xb = (const u32x2*)(x2b + (size_t)mb * DM) + lane_;
            const u32x2* ya0 = (const u32x2*)(yb + (size_t)pa0 * DM) + lane_; const u32x2* ya1 = (const u32x2*)(yb + (size_t)pa1 * DM) + lane_;
            const u32x2* yb0 = (const u32x2*)(yb + (size_t)pb0 * DM) + lane_; const u32x2* yb1 = (const u32x2*)(yb + (size_t)pb1 * DM) + lane_;
            u32x2 ca[4], cb[4], a0[4], a1[4], b0[4], b1[4];
#pragma unroll
            for (int j = 0; j < 4; ++j) { ca[j] = xa[64 * j]; cb[j] = xb[64 * j]; a0[j] = ya0[64 * j]; a1[j] = ya1[64 * j]; b0[j] = yb0[64 * j]; b1[j] = yb1[64 * j]; }
            f32x4 va[4], vb[4]; float sa = 0.f, sb = 0.f;
#pragma unroll
            for (int j = 0; j < 4; ++j) {
                va[j].x = bf_lo(ca[j].x) + wa0 * bf_lo(a0[j].x) + wa1 * bf_lo(a1[j].x); va[j].y = bf_hi(ca[j].x) + wa0 * bf_hi(a0[j].x) + wa1 * bf_hi(a1[j].x);
                va[j].z = bf_lo(ca[j].y) + wa0 * bf_lo(a0[j].y) + wa1 * bf_lo(a1[j].y); va[j].w = bf_hi(ca[j].y) + wa0 * bf_hi(a0[j].y) + wa1 * bf_hi(a1[j].y);
                vb[j].x = bf_lo(cb[j].x) + wb0 * bf_lo(b0[j].x) + wb1 * bf_lo(b1[j].x); vb[j].y = bf_hi(cb[j].x) + wb0 * bf_hi(b0[j].x) + wb1 * bf_hi(b1[j].x);
                vb[j].z = bf_lo(cb[j].y) + wb0 * bf_lo(b0[j].y) + wb1 * bf_lo(b1[j].y); vb[j].w = bf_hi(cb[j].y) + wb0 * bf_hi(b0[j].y) + wb1 * bf_hi(b1[j].y);
                sa += (va[j].x * va[j].x + va[j].y * va[j].y) + (va[j].z * va[j].z + va[j].w * va[j].w); sb += (vb[j].x * vb[j].x + vb[j].y * vb[j].y) + (vb[j].z * vb[j].z + vb[j].w * vb[j].w); }
            const float ra = __builtin_amdgcn_rsqf(wave_sum(sa) * (1.f / DM) + RMS_EPS), rb = __builtin_amdgcn_rsqf(wave_sum(sb) * (1.f / DM) + RMS_EPS);
            f32x4* oa = (f32x4*)(out + (size_t)ma * DM) + lane_; f32x4* ob = (f32x4*)(out + (size_t)mb * DM) + lane_;
#pragma unroll
            for (int j = 0; j < 4; ++j) { oa[64 * j] = va[j] * ra * gg[j]; ob[64 * j] = vb[j] * rb * gg[j]; }
        }
    }
#undef IN
#undef GRID_BAR
}

extern "C" void kernel_launch(void* const* d_in, const int* in_sizes, int n_in, void* d_out, int out_size, void* d_ws, size_t ws_size, hipStream_t stream) {
    static int grid = 0;
    if (grid == 0) {
        if (n_in != 28 || in_sizes[0] != M * DM || out_size != M * DM || ws_size < WS_END) { fprintf(stderr, "kernel_launch: unexpected shapes (n_in %d in0 %d out %d ws %zu)\n", n_in, n_in > 0 ? in_sizes[0] : -1, out_size, ws_size); grid = -1; return; }
        int dev = 0, cus = 0, per_cu = 0;
        if (hipGetDevice(&dev) != hipSuccess || hipDeviceGetAttribute(&cus, hipDeviceAttributeMultiprocessorCount, dev) != hipSuccess) { grid = -1; return; }
        if (hipFuncSetAttribute((const void*)mega, hipFuncAttributeMaxDynamicSharedMemorySize, LDS_BYTES) != hipSuccess) { fprintf(stderr, "kernel_launch: hipFuncSetAttribute failed\n"); grid = -1; return; }
        if (hipOccupancyMaxActiveBlocksPerMultiprocessor(&per_cu, (const void*)mega, NTHR, LDS_BYTES) != hipSuccess || per_cu < 1) { fprintf(stderr, "kernel_launch: occupancy query says %d\n", per_cu); per_cu = 1; }
        (void)hipGetLastError();
        grid = cus;
    }
    if (grid < 0) return;
    (void)hipMemsetAsync((char*)d_ws + WS_CTL, 0, CTL_BYTES, stream);
    Args a{};
    for (int i = 0; i < 28; ++i) a.in[i] = (const float*)d_in[i];
    a.out = (float*)d_out; a.ws = (unsigned char*)d_ws;
#if MK_ONE_LAUNCH
    a.ph_lo = 0; a.ph_hi = N_PHASES;
    void* kargs[] = {&a};
    hipError_t e = hipLaunchCooperativeKernel((const void*)mega, dim3(grid), dim3(NTHR), kargs, LDS_BYTES, stream);
    if (e != hipSuccess) fprintf(stderr, "cooperative launch failed: %s (grid %d)\n", hipGetErrorString(e), grid);
#else
    for (int p = 0; p < N_PHASES; ++p) { a.ph_lo = p; a.ph_hi = p + 1; hipLaunchKernelGGL(mega, dim3(grid), dim3(NTHR), LDS_BYTES, stream, a); }
#endif
}
```

```cpp
#include <hip/hip_runtime.h>
#include <hip/hip_cooperative_groups.h>
#include <cstdio>
#include <cstdint>
namespace cg = cooperative_groups;

#ifndef PROBE_DUP
#define PROBE_DUP -1
#endif
#ifndef PROBE_DUP_ATTN
#define PROBE_DUP_ATTN 1
#endif
#ifndef MK_ONE_LAUNCH
#define MK_ONE_LAUNCH 1
#endif

#define LAS __attribute__((address_space(3)))
#define GAS __attribute__((address_space(1)))
typedef unsigned short bf16_t;
typedef short bf16x8 __attribute__((ext_vector_type(8)));
typedef short s16x4 __attribute__((ext_vector_type(4)));
typedef float f32x2 __attribute__((ext_vector_type(2)));
typedef float f32x4 __attribute__((ext_vector_type(4)));
typedef float f32x16 __attribute__((ext_vector_type(16)));
typedef unsigned u32x2 __attribute__((ext_vector_type(2)));
typedef unsigned u32x4 __attribute__((ext_vector_type(4)));
typedef int v8i32 __attribute__((ext_vector_type(8)));

constexpr int NB = 8, SEQ = 8192, DM = 1024, M = NB * SEQ;
constexpr int ZP = 2560;
constexpr int ZU = 0, ZV = 512, ZQ = 1024, ZK = 1536, ZVAL = 2048;
constexpr int MEML = 256, MROWS = NB * MEML;
constexpr int NEXP = 32, DEXP = 512;
constexpr int PROWS = 2 * M + NEXP * 256;
constexpr int MAXBLK = PROWS / 256;
constexpr float RMS_EPS = 1e-6f, LN_EPS = 1e-5f;
constexpr float LOG2E = 1.4426950408889634f;
constexpr float C2_DIFF = 0.125f * LOG2E;
constexpr float C2_MEM = 0.0625f * LOG2E;

constexpr size_t MiB = 1u << 20;
constexpr size_t WS_CTL = 0, CTL_BYTES = 1 * MiB;
constexpr size_t WS_WIN = 1 * MiB;
constexpr size_t WS_WOUT = 6 * MiB;
constexpr size_t WS_WQ = 8 * MiB;
constexpr size_t WS_WKV = 10 * MiB;
constexpr size_t WS_WO = 14 * MiB;
constexpr size_t WS_WR = 16 * MiB;
constexpr size_t WS_WSGU = 17 * MiB;
constexpr size_t WS_MEMN = 18 * MiB;
constexpr size_t WS_KM = 22 * MiB;
constexpr size_t WS_VT = 26 * MiB;
constexpr size_t WS_WGU = 30 * MiB;
constexpr size_t WS_WD = 94 * MiB;
constexpr size_t WS_RA = 128 * MiB;
constexpr size_t WS_RB = 448 * MiB;
constexpr size_t WS_RC = 592 * MiB;
constexpr size_t WS_SSQ1 = 720 * MiB;
constexpr size_t WS_SSQ2 = 724 * MiB;
constexpr size_t WS_LOGIT = 728 * MiB;
constexpr size_t WS_TOKE = 744 * MiB;
constexpr size_t WS_TOKW = 745 * MiB;
constexpr size_t WS_TOKS = 746 * MiB;
constexpr size_t WS_ROWTOK = 747 * MiB;
constexpr size_t WS_X2F8 = 752 * MiB;
constexpr size_t WS_END = 816 * MiB;
constexpr int CW_CNT = 64;
constexpr int CW_NBLK = 128;
constexpr int CW_PSTART = 192;
constexpr int CW_BLKE = 256;
constexpr int CW_KMX = 1024;
constexpr int CW_SGUQ = 1344;
constexpr int CW_BAR = 4096;
constexpr int LDS_MISC = 131072;
constexpr int LDS_TBUF = 140288, TBUF_W = 2304;

__device__ __forceinline__ unsigned cvt_pk_bf16(float lo, float hi) { unsigned r; asm volatile("v_cvt_pk_bf16_f32 %0, %1, %2" : "=v"(r) : "v"(lo), "v"(hi)); return r; }
__device__ __forceinline__ float bf_lo(unsigned w) { return __uint_as_float(w << 16); }
__device__ __forceinline__ float bf_hi(unsigned w) { return __uint_as_float(w & 0xffff0000u); }
constexpr float F8_WSCALE = 256.f, F8_ASCALE = 8.f, F8_XSCALE = 4.f;
__device__ __forceinline__ unsigned pk4_fp8(float a, float b, float c, float d) {
    a = fminf(fmaxf(a, -448.f), 448.f); b = fminf(fmaxf(b, -448.f), 448.f); c = fminf(fmaxf(c, -448.f), 448.f); d = fminf(fmaxf(d, -448.f), 448.f);
    int w = 0; w = __builtin_amdgcn_cvt_pk_fp8_f32(a, b, w, false); w = __builtin_amdgcn_cvt_pk_fp8_f32(c, d, w, true); return (unsigned)w; }
__device__ __forceinline__ float wave_sum(float v) {
#pragma unroll
    for (int o = 1; o < 64; o <<= 1) v += __shfl_xor(v, o);
    return v;
}
__device__ __forceinline__ float wave_max(float v) {
#pragma unroll
    for (int o = 1; o < 64; o <<= 1) v = fmaxf(v, __shfl_xor(v, o));
    return v;
}
__device__ __forceinline__ int lane_id() { int l; asm volatile("v_mbcnt_lo_u32_b32 %0, -1, 0\n\tv_mbcnt_hi_u32_b32 %0, -1, %0" : "=v"(l)); return l; }
__device__ __forceinline__ unsigned ld_u32_agent(const unsigned* p) { return __hip_atomic_load(p, __ATOMIC_RELAXED, __HIP_MEMORY_SCOPE_AGENT); }

namespace pg8 {
constexpr int BM = 256, BK = 64, HALF = 128, HTB = HALF * BK * 2, STAGE_BYTES = 8 * HTB, NXCD = 8, WGM = 8;
__host__ __device__ __forceinline__ int lds_byte(int r, int c) { const int st = (r >> 4) * 2 + (c >> 5), rr = r & 15, cc = c & 31, ob = rr * 64 + cc * 2; return st * 1024 + (ob ^ (((ob >> 9) & 1) << 5)); }
__host__ __device__ __forceinline__ void stage_rc(int b, int& R, int& C) { const int st = b / 1024, sb = b % 1024, swz = sb ^ (((sb >> 9) & 1) << 5); R = (st >> 1) * 16 + swz / 64; C = (st & 1) * 32 + (swz % 64) / 2; }
__host__ __device__ __forceinline__ int perm32(int rho) { const int n = rho >> 4, i = rho & 15; return 8 * (i >> 2) + 4 * n + (i & 3); }

struct Unit { const char* A; const char* B; int pm, pn, aux; const int* rows; };
struct Gemm { int lda, ldb, K; };

struct TileOrder {
    int nM, nN, nwg, G, c;
    __device__ void init(int nM_, int nN_, int G_, int c_) { nM = nM_; nN = nN_; nwg = nM * nN; G = G_; c = c_; }
    __device__ bool get(int i, int& pm, int& pn) const {
        const long L = (long)i * G + c; if (L >= nwg) return false;
        int wgid = (int)L; { const int q = nwg / NXCD, r = nwg % NXCD, xcd = wgid % NXCD, off = wgid / NXCD; wgid = (xcd < r ? xcd * (q + 1) : r * (q + 1) + (xcd - r) * q) + off; }
        const int nig = WGM * nN, gid = wgid / nig, fm = gid * WGM, gsz = (nM - fm) < WGM ? (nM - fm) : WGM;
        pm = fm + ((wgid % nig) % gsz); pn = (wgid % nig) / gsz; return true;
    }
};

typedef float f32x2g __attribute__((ext_vector_type(2)));
__device__ __forceinline__ f32x2g gelu_pk(f32x2g v) {
    const f32x2g av = __builtin_elementwise_abs(v), d = av * 0.2316418882f + 1.0f;
    f32x2g t; t.x = __builtin_amdgcn_rcpf(d.x); t.y = __builtin_amdgcn_rcpf(d.y);
    f32x2g q = t * 0.5307027145f + (-0.7265760135f); q = q * t + 0.7107068705f; q = q * t + (-0.142248368f); q = q * t + 0.127414796f; q = q * t;
    const f32x2g s = (v * v) * (-0.72134752044f);
    f32x2g e; e.x = __builtin_amdgcn_exp2f(s.x); e.y = __builtin_amdgcn_exp2f(s.y);
    const f32x2g m = v * (q * e), r = v - m;
    f32x2g o; o.x = v.x < 0.f ? m.x : r.x; o.y = v.y < 0.f ? m.y : r.y; return o;
}

__device__ __forceinline__ const char* uniform_ptr(const char* p) { const unsigned long long v = (unsigned long long)p; const unsigned lo = __builtin_amdgcn_readfirstlane((unsigned)v), hi = __builtin_amdgcn_readfirstlane((unsigned)(v >> 32)); return (const char*)(((unsigned long long)hi << 32) | lo); }
template <class Epi, class Sched, bool GATHER = false, bool FP8 = false>
__device__ __forceinline__ void gemm_phase(LAS unsigned char* lds, int wid, const Gemm g, const Sched& S, const Epi& E) {
    const int lane = lane_id(), tid = wid * 64 + lane, wr = wid >> 2, wc = wid & 3, fr = lane & 15, fq = lane >> 4;
    const int nt = g.K / BK;
    unsigned voffB[2]; unsigned vA0[2], vA1[2]; int RA[2], CA[2];
#pragma unroll
    for (int i = 0; i < 2; ++i) { int R, C; stage_rc(tid * 16 + i * 8192, R, C); const int pr = Epi::PERM ? perm32(R & 31) : (R & 31);
        RA[i] = R; CA[i] = C; voffB[i] = (unsigned)((64 * (R >> 5) + pr) * g.ldb + C) * 2u;
        vA0[i] = (unsigned)(R * g.lda + C) * 2u; vA1[i] = vA0[i]; }
    const size_t kstep = (size_t)(BK * 2);
    const size_t hstepA = GATHER ? (size_t)0 : (size_t)HALF * g.lda * 2, hstepB = (size_t)32 * g.ldb * 2;
    LAS u32x4* park = (LAS u32x4*)(lds + 131072 + 1024) + tid;
#define PG8_GOFF(U, d0, d1) do { _Pragma("unroll") for (int _i = 0; _i < 2; ++_i) { \
        d0[_i] = ((unsigned)(U).rows[RA[_i]] * (unsigned)g.lda + (unsigned)CA[_i]) * 2u; d1[_i] = ((unsigned)(U).rows[HALF + RA[_i]] * (unsigned)g.lda + (unsigned)CA[_i]) * 2u; } } while (0)
    const unsigned ldsw = (unsigned)wid * 1024u;
    const int aoff = lds_byte(wr * 64 + fr, fq * 8), boff = lds_byte(wc * 32 + fr, fq * 8);
#define PG8_SA(b, h) (((b) * 2 + (h)) * HTB)
#define PG8_SB(b, h) ((4 + (b) * 2 + (h)) * HTB)
#define PG8_STAGE(bufoff, gbase, voff) do { _Pragma("unroll") for (int _i = 0; _i < 2; ++_i) \
        __builtin_amdgcn_global_load_lds((const unsigned*)((const char*)(gbase) + (voff)[_i]), (LAS unsigned*)(lds + (bufoff) + ldsw + _i * 8192), 16, 0, 0); } while (0)
#define PG8_LD8(dst_, addr_) do { const u32x4 lo_ = *(const LAS u32x4*)(addr_), hi_ = *(const LAS u32x4*)((addr_) + 1024); \
        dst_ = (v8i32){(int)lo_.x, (int)lo_.y, (int)lo_.z, (int)lo_.w, (int)hi_.x, (int)hi_.y, (int)hi_.z, (int)hi_.w}; } while (0)
#define PG8_LDA(dst, b, h) do { _Pragma("unroll") for (int m = 0; m < 4; ++m) PG8_LD8(dst[m], lds + PG8_SA(b, h) + aoff + m * 2048); } while (0)
#define PG8_LDB(dst, b, h) do { _Pragma("unroll") for (int n = 0; n < 2; ++n) PG8_LD8(dst[n], lds + PG8_SB(b, h) + boff + n * 2048); } while (0)
#define PG8_HALF(v_, k_) __builtin_bit_cast(bf16x8, __builtin_shufflevector(v_, v_, 4 * (k_) + 0, 4 * (k_) + 1, 4 * (k_) + 2, 4 * (k_) + 3))
#define PG8_MMA(ai, bj, At, Bt) do { __builtin_amdgcn_s_setprio(1); _Pragma("unroll") for (int m = 0; m < 4; ++m) _Pragma("unroll") for (int n = 0; n < 2; ++n) { \
        if constexpr (FP8) asm volatile("v_mfma_scale_f32_16x16x128_f8f6f4 %0, %1, %2, %0, %3, %3 op_sel_hi:[0,0,0]" : "+v"(acc[ai][bj][m][n]) : "v"(Bt[n]), "v"(At[m]), "v"(one8_));   \
        else { acc[ai][bj][m][n] = __builtin_amdgcn_mfma_f32_16x16x32_bf16(PG8_HALF(Bt[n], 0), PG8_HALF(At[m], 0), acc[ai][bj][m][n], 0, 0, 0); \
               acc[ai][bj][m][n] = __builtin_amdgcn_mfma_f32_16x16x32_bf16(PG8_HALF(Bt[n], 1), PG8_HALF(At[m], 1), acc[ai][bj][m][n], 0, 0, 0); } } \
        __builtin_amdgcn_s_setprio(0); } while (0)
#define PG8_WAIT_V(n) asm volatile("s_waitcnt vmcnt(" #n ")" ::: "memory")
#define PG8_WAIT_L(n) asm volatile("s_waitcnt lgkmcnt(" #n ")" ::: "memory")
#define PG8_BAR __builtin_amdgcn_s_barrier()
#define PG8_SCHED __builtin_amdgcn_sched_barrier(0)
    Unit cur, nxt; int ui = 0;
    if (!S.next(0, cur)) return;
    f32x4 acc[2][2][4][2];
#pragma unroll
    for (int a = 0; a < 2; ++a)
#pragma unroll
        for (int b = 0; b < 2; ++b)
#pragma unroll
            for (int m = 0; m < 4; ++m)
#pragma unroll
                for (int n = 0; n < 2; ++n) acc[a][b][m][n] = (f32x4){0.f, 0.f, 0.f, 0.f};
    v8i32 At[4], B0[2], B1[2];
    const int one8_ = 0x7f7f7f7f;
    const char* cA = uniform_ptr(cur.A); const char* cB = uniform_ptr(cur.B);
    if constexpr (GATHER) { PG8_GOFF(cur, vA0, vA1); }
    PG8_STAGE(PG8_SB(0, 0), cB, voffB); PG8_STAGE(PG8_SB(0, 1), cB + hstepB, voffB); PG8_STAGE(PG8_SA(0, 0), cA, vA0); PG8_STAGE(PG8_SA(0, 1), cA + hstepA, vA1);
    if (wr == 1) PG8_BAR;
    PG8_WAIT_V(2); PG8_BAR;
    PG8_STAGE(PG8_SB(1, 0), cB + kstep, voffB); PG8_STAGE(PG8_SA(1, 0), cA + kstep, vA0); PG8_STAGE(PG8_SB(1, 1), cB + hstepB + kstep, voffB);
    PG8_WAIT_V(6); PG8_BAR;
    for (;;) {
        const bool has_next = S.next(ui + 1, nxt);
        const char* nA = has_next ? uniform_ptr(nxt.A) : cA; const char* nB = has_next ? uniform_ptr(nxt.B) : cB;
        if constexpr (GATHER) { unsigned n0[2] = {vA0[0], vA0[1]}, n1[2] = {vA1[0], vA1[1]}; if (has_next) { PG8_GOFF(nxt, n0, n1); } *park = (u32x4){n0[0], n0[1], n1[0], n1[1]}; }
#pragma nounroll
        for (int t = 0; t < nt; t += 2) {
            const bool last = (t == nt - 2);
            const char* a1 = cA + (size_t)(t + 1) * kstep;
            const char* a2 = uniform_ptr(last ? nA : cA + (size_t)(t + 2) * kstep); const char* b2 = uniform_ptr(last ? nB : cB + (size_t)(t + 2) * kstep);
            const char* a3 = a2 + kstep; const char* b3 = b2 + kstep;
            unsigned w0[2] = {vA0[0], vA0[1]}, w1[2] = {vA1[0], vA1[1]};
            if constexpr (GATHER) { if (last) { const u32x4 pk = *park; w0[0] = pk.x; w0[1] = pk.y; w1[0] = pk.z; w1[1] = pk.w; } }
            PG8_LDB(B0, 0, 0); PG8_LDB(B1, 0, 1); PG8_SCHED; PG8_LDA(At, 0, 0); PG8_STAGE(PG8_SA(1, 1), a1 + hstepA, vA1);
            PG8_WAIT_V(8); PG8_WAIT_L(0); PG8_BAR; PG8_MMA(0, 0, At, B0); PG8_MMA(0, 1, At, B1); PG8_BAR; PG8_SCHED;
            PG8_LDA(At, 0, 1); PG8_STAGE(PG8_SB(0, 0), b2, voffB); PG8_STAGE(PG8_SB(0, 1), b2 + hstepB, voffB); PG8_STAGE(PG8_SA(0, 0), a2, w0);
            PG8_WAIT_V(8); PG8_WAIT_L(0); PG8_BAR; PG8_MMA(1, 0, At, B0); PG8_MMA(1, 1, At, B1); PG8_BAR; PG8_SCHED;
            PG8_LDB(B0, 1, 0); PG8_LDB(B1, 1, 1); PG8_SCHED; PG8_LDA(At, 1, 0); PG8_STAGE(PG8_SA(0, 1), a2 + hstepA, w1);
            PG8_WAIT_V(8); PG8_WAIT_L(0); PG8_BAR; PG8_MMA(0, 0, At, B0); PG8_MMA(0, 1, At, B1); PG8_BAR; PG8_SCHED;
            PG8_LDA(At, 1, 1); PG8_STAGE(PG8_SB(1, 0), b3, voffB); PG8_STAGE(PG8_SB(1, 1), b3 + hstepB, voffB); PG8_STAGE(PG8_SA(1, 0), a3, w0);
            PG8_WAIT_V(8); PG8_WAIT_L(0); PG8_BAR; PG8_MMA(1, 0, At, B0); PG8_MMA(1, 1, At, B1); PG8_BAR; PG8_SCHED;
        }
        if (wr == 0) PG8_BAR;
        if constexpr (FP8) asm volatile("s_nop 15\n\ts_nop 7" ::: "memory");
        asm volatile("" ::: "memory");
        { const int l2_ = lane_id(); E(acc, cur, wr, wc, l2_ & 15, l2_ >> 4, lds + LDS_TBUF + wid * TBUF_W); }
        if (!has_next) break;
#pragma unroll
        for (int a = 0; a < 2; ++a)
#pragma unroll
            for (int b = 0; b < 2; ++b)
#pragma unroll
                for (int m = 0; m < 4; ++m)
#pragma unroll
                    for (int n = 0; n < 2; ++n) acc[a][b][m][n] = (f32x4){0.f, 0.f, 0.f, 0.f};
        cur = nxt; cA = nA; cB = nB; ++ui;
        if constexpr (GATHER) { const u32x4 pk = *park; vA0[0] = pk.x; vA0[1] = pk.y; vA1[0] = pk.z; vA1[1] = pk.w; }
        if (wr == 1) PG8_BAR;
    }
    PG8_WAIT_V(0);
    PG8_BAR;
#undef PG8_GOFF
#undef PG8_SA
#undef PG8_SB
#undef PG8_STAGE
#undef PG8_LD8
#undef PG8_HALF
#undef PG8_LDA
#undef PG8_LDB
#undef PG8_MMA
#undef PG8_WAIT_V
#undef PG8_WAIT_L
#undef PG8_BAR
#undef PG8_SCHED
}

struct PlainSched {
    TileOrder to; const char* A; const char* B; size_t tA, tB;
    __device__ __forceinline__ bool next(int i, Unit& u) const { int pm, pn; if (!to.get(i, pm, pn)) return false; u.pm = pm; u.pn = pn; u.aux = 0; u.rows = nullptr; u.A = A + (size_t)pm * tA; u.B = B + (size_t)pn * tB; return true; }
};
struct OneUnitSched {
    Unit u0;
    __device__ __forceinline__ bool next(int i, Unit& u) const { if (i != 0) return false; u = u0; return true; }
};
struct MemAttnSched {
    TileOrder to; const char* A; const char* B; size_t bB, hB;
    __device__ __forceinline__ bool next(int i, Unit& u) const { int pm, pn; if (!to.get(i, pm, pn)) return false; u.pm = pm; u.pn = pn; u.aux = 0; u.rows = nullptr;
        u.A = A + (size_t)pm * (256 * DM * 2) + (size_t)pn * 512; const int b = pm >> 5; u.B = B + (size_t)b * bB + (size_t)pn * hB; return true; }
};
struct MoeSched {
    int G, c, nblk; const unsigned* blk_e; const char* A; const char* B; size_t tA, eB, tB; const int* row_tok;
    __device__ __forceinline__ bool next(int i, Unit& u) const { const int L = i * G + c; if (L >= nblk * 4) return false; const int rb = L >> 2, pn = L & 3;
        const int e = (int)__builtin_amdgcn_readfirstlane(ld_u32_agent(blk_e + rb)); u.pm = rb; u.pn = pn; u.aux = e; u.rows = row_tok + (size_t)rb * 256;
        u.A = A + (size_t)rb * tA; u.B = B + (size_t)e * eB + (size_t)pn * tB; return true; }
};

#define EPI_ARGS f32x4 (&acc)[2][2][4][2], const Unit& u, int wr, int wc, int fr, int fq, LAS unsigned char* tb
__device__ __forceinline__ void st128(bf16_t* rowbase, size_t ldc, const u32x4 w0, const u32x4 w1, int fr, int fq, LAS unsigned char* tb) {
    *(LAS u32x4*)(tb + fr * 144 + fq * 16) = w0; *(LAS u32x4*)(tb + fr * 144 + 64 + fq * 16) = w1;
    const int L = fq * 16 + fr, r = L >> 3, c = L & 7;
    const u32x4 a = *(const LAS u32x4*)(tb + r * 144 + c * 16), b = *(const LAS u32x4*)(tb + (8 + r) * 144 + c * 16);
    *(u32x4*)(rowbase + (size_t)r * ldc + c * 8) = a; *(u32x4*)(rowbase + (size_t)(8 + r) * ldc + c * 8) = b;
}
__device__ __forceinline__ u32x4 pk8(const f32x4 v0, const f32x4 v1) { u32x4 w; w.x = cvt_pk_bf16(v0[0], v0[1]); w.y = cvt_pk_bf16(v0[2], v0[3]); w.z = cvt_pk_bf16(v1[0], v1[1]); w.w = cvt_pk_bf16(v1[2], v1[3]); return w; }
struct EpiZ {
    static constexpr bool PERM = true;
    bf16_t* O; unsigned* kmx;
    __device__ __forceinline__ void operator()(EPI_ARGS) const {
        const int mode = u.pn < 4 ? 1 : (u.pn < 6 ? 2 : 0);
        if (u.pn == 6 || u.pn == 7) {
#pragma unroll
            for (int bj = 0; bj < 2; ++bj) { float mx = 0.f;
#pragma unroll
                for (int ai = 0; ai < 2; ++ai)
#pragma unroll
                    for (int m = 0; m < 4; ++m) { const f32x4 a = acc[ai][bj][m][0], b = acc[ai][bj][m][1];
                        float q = (a[0] * a[0] + a[1] * a[1]) + (a[2] * a[2] + a[3] * a[3]) + (b[0] * b[0] + b[1] * b[1]) + (b[2] * b[2] + b[3] * b[3]);
                        q += __shfl_xor(q, 16); q += __shfl_xor(q, 32); mx = fmaxf(mx, q); }
#pragma unroll
                for (int o_ = 1; o_ < 16; o_ <<= 1) mx = fmaxf(mx, __shfl_xor(mx, o_));
                if (fr == 0 && fq == 0) { const int b_ = u.pm >> 5, h_ = (u.pn - 6) * 2 + (wc >> 1); atomicMax(kmx + (((b_ * 4 + h_) * 2 + (wc & 1)) * 2 + bj), __float_as_uint(mx)); } }
        }
#pragma unroll
        for (int ai = 0; ai < 2; ++ai)
#pragma unroll
            for (int m = 0; m < 4; ++m) { u32x4 w[2];
#pragma unroll
                for (int bj = 0; bj < 2; ++bj) { f32x4 v0 = acc[ai][bj][m][0], v1 = acc[ai][bj][m][1];
                    if (mode == 1) { f32x2g a = gelu_pk((f32x2g){v0[0], v0[1]}), b = gelu_pk((f32x2g){v0[2], v0[3]}), c = gelu_pk((f32x2g){v1[0], v1[1]}), d = gelu_pk((f32x2g){v1[2], v1[3]});
                        v0 = (f32x4){a.x, a.y, b.x, b.y}; v1 = (f32x4){c.x, c.y, d.x, d.y}; }
                    else if (mode == 2) { v0 = v0 * C2_DIFF; v1 = v1 * C2_DIFF; }
                    w[bj] = pk8(v0, v1); }
                st128(O + (size_t)(u.pm * BM + ai * HALF + wr * 64 + m * 16) * ZP + u.pn * BM + wc * 64, ZP, w[0], w[1], fr, fq, tb); }
    }
};
struct EpiBf16 {
    static constexpr bool PERM = true;
    bf16_t* O; int ldc; const float* ssq; float cscale;
    __device__ __forceinline__ void operator()(EPI_ARGS) const {
        float sc[2][4];
#pragma unroll
        for (int ai = 0; ai < 2; ++ai)
#pragma unroll
            for (int m = 0; m < 4; ++m) sc[ai][m] = cscale;
        if (ssq) {
#pragma unroll
            for (int ai = 0; ai < 2; ++ai)
#pragma unroll
                for (int m = 0; m < 4; ++m) { const f32x4 s4 = *(const f32x4*)(ssq + (size_t)(u.pm * BM + ai * HALF + wr * 64 + m * 16 + fr) * 4);
                    sc[ai][m] = cscale * __builtin_amdgcn_rsqf(((s4[0] + s4[1]) + (s4[2] + s4[3])) * (1.0f / DM) + RMS_EPS); }
        }
#pragma unroll
        for (int ai = 0; ai < 2; ++ai)
#pragma unroll
            for (int m = 0; m < 4; ++m) { const int rowg = u.pm * BM + ai * HALF + wr * 64 + m * 16; const float c = sc[ai][m];
                st128(O + (size_t)rowg * ldc + u.pn * BM + wc * 64, (size_t)ldc, pk8(acc[ai][0][m][0] * c, acc[ai][0][m][1] * c), pk8(acc[ai][1][m][0] * c, acc[ai][1][m][1] * c), fr, fq, tb); }
    }
};
struct EpiSoftmax {
    static constexpr bool PERM = true;
    bf16_t* O; LAS float* xch;
    __device__ __forceinline__ void operator()(EPI_ARGS) const {
        LAS float* xm = xch; LAS float* xs = xch + 1024;
#pragma unroll
        for (int ai = 0; ai < 2; ++ai)
#pragma unroll
            for (int m = 0; m < 4; ++m) { float v = -__builtin_inff();
#pragma unroll
                for (int bj = 0; bj < 2; ++bj)
#pragma unroll
                    for (int n = 0; n < 2; ++n) { const f32x4 a = acc[ai][bj][m][n]; v = fmaxf(v, fmaxf(fmaxf(a[0], a[1]), fmaxf(a[2], a[3]))); }
                v = fmaxf(v, __shfl_xor(v, 16)); v = fmaxf(v, __shfl_xor(v, 32));
                if (fq == 0) xm[(ai * HALF + wr * 64 + m * 16 + fr) * 4 + wc] = v; }
        asm volatile("s_waitcnt lgkmcnt(0)" ::: "memory"); __builtin_amdgcn_s_barrier(); asm volatile("" ::: "memory");
#pragma unroll
        for (int ai = 0; ai < 2; ++ai)
#pragma unroll
            for (int m = 0; m < 4; ++m) { const f32x4 t = *(const LAS f32x4*)(xm + (ai * HALF + wr * 64 + m * 16 + fr) * 4); const float mx = fmaxf(fmaxf(t[0], t[1]), fmaxf(t[2], t[3])); float sm = 0.f;
#pragma unroll
                for (int bj = 0; bj < 2; ++bj)
#pragma unroll
                    for (int n = 0; n < 2; ++n) { f32x4 a = acc[ai][bj][m][n];
#pragma unroll
                        for (int j = 0; j < 4; ++j) { a[j] = __builtin_amdgcn_exp2f(a[j] - mx); sm += a[j]; }
                        acc[ai][bj][m][n] = a; }
                sm += __shfl_xor(sm, 16); sm += __shfl_xor(sm, 32);
                if (fq == 0) xs[(ai * HALF + wr * 64 + m * 16 + fr) * 4 + wc] = sm; }
        asm volatile("s_waitcnt lgkmcnt(0)" ::: "memory"); __builtin_amdgcn_s_barrier(); asm volatile("" ::: "memory");
#pragma unroll
        for (int ai = 0; ai < 2; ++ai)
#pragma unroll
            for (int m = 0; m < 4; ++m) { const f32x4 t = *(const LAS f32x4*)(xs + (ai * HALF + wr * 64 + m * 16 + fr) * 4); const float inv = __builtin_amdgcn_rcpf((t[0] + t[1]) + (t[2] + t[3]));
                st128(O + (size_t)(u.pm * BM + ai * HALF + wr * 64 + m * 16) * DM + u.pn * BM + wc * 64, (size_t)DM, pk8(acc[ai][0][m][0] * inv, acc[ai][0][m][1] * inv), pk8(acc[ai][1][m][0] * inv, acc[ai][1][m][1] * inv), fr, fq, tb); }
    }
};
template <bool BF>
struct EpiResid {
    static constexpr bool PERM = true;
    const void* base; bf16_t* ob; float* ssq; LAS float* xs; unsigned char* o8;
    __device__ __forceinline__ void operator()(EPI_ARGS) const {
        const int col0 = u.pn * BM + wc * 64 + 8 * fq;
        if constexpr (BF) {
            u32x4 br[2][4][2];
#pragma unroll
            for (int ai = 0; ai < 2; ++ai)
#pragma unroll
                for (int m = 0; m < 4; ++m)
#pragma unroll
                    for (int bj = 0; bj < 2; ++bj) br[ai][m][bj] = *(const u32x4*)((const bf16_t*)base + (size_t)(u.pm * BM + ai * HALF + wr * 64 + m * 16 + fr) * DM + col0 + bj * 32);
#pragma unroll
            for (int ai = 0; ai < 2; ++ai)
#pragma unroll
                for (int m = 0; m < 4; ++m) asm volatile("" : "+v"(br[ai][m][0]), "+v"(br[ai][m][1]));
#pragma unroll
            for (int ai = 0; ai < 2; ++ai)
#pragma unroll
                for (int m = 0; m < 4; ++m) { const int rowg = u.pm * BM + ai * HALF + wr * 64 + m * 16, row = rowg + fr; float s = 0.f; u32x4 w[2]; u32x2 f8[2];
#pragma unroll
                    for (int bj = 0; bj < 2; ++bj) { const u32x4 r = br[ai][m][bj];
                        const f32x4 o0 = (f32x4){bf_lo(r.x), bf_hi(r.x), bf_lo(r.y), bf_hi(r.y)} + acc[ai][bj][m][0], o1 = (f32x4){bf_lo(r.z), bf_hi(r.z), bf_lo(r.w), bf_hi(r.w)} + acc[ai][bj][m][1];
                        s += (o0[0] * o0[0] + o0[1] * o0[1]) + (o0[2] * o0[2] + o0[3] * o0[3]) + (o1[0] * o1[0] + o1[1] * o1[1]) + (o1[2] * o1[2] + o1[3] * o1[3]);
                        w[bj] = pk8(o0, o1);
                        f8[bj].x = pk4_fp8(o0[0] * F8_XSCALE, o0[1] * F8_XSCALE, o0[2] * F8_XSCALE, o0[3] * F8_XSCALE); f8[bj].y = pk4_fp8(o1[0] * F8_XSCALE, o1[1] * F8_XSCALE, o1[2] * F8_XSCALE, o1[3] * F8_XSCALE); }
                    st128(ob + (size_t)rowg * DM + u.pn * BM + wc * 64, (size_t)DM, w[0], w[1], fr, fq, tb);
                    if (o8) {
                        *(LAS u32x2*)(tb + fr * 144 + fq * 8) = f8[0]; *(LAS u32x2*)(tb + fr * 144 + 32 + fq * 8) = f8[1];
                        const int L = fq * 16 + fr; const u32x4 v8 = *(const LAS u32x4*)(tb + (L >> 2) * 144 + (L & 3) * 16);
                        *(u32x4*)(o8 + (size_t)(rowg + (L >> 2)) * DM + u.pn * BM + wc * 64 + (L & 3) * 16) = v8; }
                    s += __shfl_xor(s, 16); s += __shfl_xor(s, 32);
                    if (fq == 0) xs[(ai * HALF + wr * 64 + m * 16 + fr) * 4 + wc] = s; }
        } else {
#pragma unroll
            for (int ai = 0; ai < 2; ++ai) {
                f32x4 br[4][2][2];
#pragma unroll
                for (int m = 0; m < 4; ++m)
#pragma unroll
                    for (int bj = 0; bj < 2; ++bj) { const float* p = (const float*)base + (size_t)(u.pm * BM + ai * HALF + wr * 64 + m * 16 + fr) * DM + col0 + bj * 32; br[m][bj][0] = *(const f32x4*)p; br[m][bj][1] = *(const f32x4*)(p + 4); }
#pragma unroll
                for (int m = 0; m < 4; ++m) asm volatile("" : "+v"(br[m][0][0]), "+v"(br[m][0][1]), "+v"(br[m][1][0]), "+v"(br[m][1][1]));
#pragma unroll
                for (int m = 0; m < 4; ++m) { const int rowg = u.pm * BM + ai * HALF + wr * 64 + m * 16, row = rowg + fr; float s = 0.f; u32x4 w[2];
#pragma unroll
                    for (int bj = 0; bj < 2; ++bj) { const f32x4 o0 = br[m][bj][0] + acc[ai][bj][m][0], o1 = br[m][bj][1] + acc[ai][bj][m][1];
                        s += (o0[0] * o0[0] + o0[1] * o0[1]) + (o0[2] * o0[2] + o0[3] * o0[3]) + (o1[0] * o1[0] + o1[1] * o1[1]) + (o1[2] * o1[2] + o1[3] * o1[3]);
                        w[bj] = pk8(o0, o1); }
                    st128(ob + (size_t)rowg * DM + u.pn * BM + wc * 64, (size_t)DM, w[0], w[1], fr, fq, tb);
                    s += __shfl_xor(s, 16); s += __shfl_xor(s, 32);
                    if (fq == 0) xs[(ai * HALF + wr * 64 + m * 16 + fr) * 4 + wc] = s; }
            }
        }
        asm volatile("s_waitcnt lgkmcnt(0)" ::: "memory"); __builtin_amdgcn_s_barrier(); asm volatile("" ::: "memory");
        { const int t_ = (wr * 4 + wc) * 64 + fq * 16 + fr;
          if (t_ < 256) { const f32x4 p = *(const LAS f32x4*)(xs + t_ * 4); ssq[(size_t)(u.pm * BM + t_) * 4 + u.pn] = (p[0] + p[1]) + (p[2] + p[3]); } }
    }
};
struct EpiRouter {
    static constexpr bool PERM = false;
    float* L; const float* ssq; const float* bg; const float* be; float* rstd_out;
    __device__ __forceinline__ void operator()(EPI_ARGS) const {
        if (wc != 0) return;
        const int row0 = u.pm * BM + wr * 64 + fr;
        float rsv[2][4];
#pragma unroll
        for (int ai = 0; ai < 2; ++ai)
#pragma unroll
            for (int m = 0; m < 4; ++m) { const f32x4 s4 = *(const f32x4*)(ssq + (size_t)(row0 + ai * HALF + m * 16) * 4);
                rsv[ai][m] = __builtin_amdgcn_rsqf(((s4[0] + s4[1]) + (s4[2] + s4[3])) * (1.0f / DM) + RMS_EPS); }
#pragma unroll
        for (int ai = 0; ai < 2; ++ai)
#pragma unroll
            for (int m = 0; m < 4; ++m) { const int row = row0 + ai * HALF + m * 16; const float rs = rsv[ai][m];
                if (fq == 0) rstd_out[row] = rs;
#pragma unroll
                for (int bj = 0; bj < 2; ++bj)
#pragma unroll
                    for (int n = 0; n < 2; ++n) { const int c0 = bj * 32 + n * 16 + 4 * fq; f32x4 o = acc[ai][bj][m][n] * rs;
#pragma unroll
                        for (int j = 0; j < 4; ++j) { const int c = c0 + j; const float b = c < 4 ? bg[c] : (c < 36 ? be[c - 4] : 0.f); o[j] += b; }
                        *(f32x4*)(L + (size_t)row * 64 + c0) = o; } }
    }
};
struct EpiGateUp {
    static constexpr bool PERM = true;
    unsigned char* act; const float* rstd; const int* row_tok;
    __device__ __forceinline__ void operator()(EPI_ARGS) const {
        const int row0 = u.pm * BM + wr * 64 + fr, col0 = u.pn * 128 + wc * 32 + 8 * fq;
        float rsv[2][4];
#pragma unroll
        for (int ai = 0; ai < 2; ++ai)
#pragma unroll
            for (int m = 0; m < 4; ++m) rsv[ai][m] = rstd[row0 + ai * HALF + m * 16];
#pragma unroll
        for (int ai = 0; ai < 2; ++ai)
#pragma unroll
            for (int m = 0; m < 4; ++m) { const int row = row0 + ai * HALF + m * 16; const float rs = rsv[ai][m];
                float r[8];
#pragma unroll
                for (int n = 0; n < 2; ++n)
#pragma unroll
                    for (int j = 0; j < 4; ++j) { const float gg = acc[ai][0][m][n][j] * rs, uu = acc[ai][1][m][n][j] * rs;
                        r[n * 4 + j] = gg * __builtin_amdgcn_rcpf(1.0f + __builtin_amdgcn_exp2f(-gg * LOG2E)) * uu; }
                u32x2 w; w.x = pk4_fp8(r[0] * F8_ASCALE, r[1] * F8_ASCALE, r[2] * F8_ASCALE, r[3] * F8_ASCALE); w.y = pk4_fp8(r[4] * F8_ASCALE, r[5] * F8_ASCALE, r[6] * F8_ASCALE, r[7] * F8_ASCALE);
                *(u32x2*)(act + (size_t)row * DEXP + col0) = w; }
    }
};
}

namespace da {
constexpr int NW = 8, QBLK = 32, KVBLK = 64, QB = NW * QBLK, DV = 128;
constexpr int SHM_V = KVBLK * DV * 2, SHM_K = KVBLK * 64 * 2;
constexpr int LDS_V = 0, LDS_K = 2 * SHM_V, LDS_WS = LDS_K + 2 * SHM_K, LDS_CX = LDS_WS + NW * 64 * 4, LDS_STASH = LDS_CX + 256, LDS_BYTES = LDS_STASH + NW * 8192;
constexpr float SKIP_MARGIN = 40.f;
constexpr float THR = 8.f;
#define SBAR() __builtin_amdgcn_sched_barrier(0)
__device__ __forceinline__ int kswz(int row, int chunk) { return row * 128 + ((chunk ^ ((row >> 1) & 7)) << 4); }
__device__ __forceinline__ int v_st(int k, int c) { const int kk = (k & ~0xC) | ((k & 4) << 1) | ((k & 8) >> 1); return ((kk >> 3) * 4 + (c >> 5)) * 512 + ((kk & 7) * 32 + (c & 31)) * 2; }
__device__ __forceinline__ int v_rd_base(int lane) { return ((lane & 3) << 3) | (((lane >> 2) & 3) << 6) | (((lane >> 4) & 1) << 5) | (((lane >> 5) & 1) << 8); }
constexpr int v_rd_off(int d0, int ks, int half) { return d0 * 512 + ks * 4096 + half * 2048; }
__device__ __forceinline__ int crow(int r, int hi) { return (r & 3) + 8 * (r >> 2) + 4 * hi; }
__device__ __forceinline__ bf16x8 load8(const bf16_t* p) { return *reinterpret_cast<const bf16x8*>(p); }

__device__ __forceinline__ void mask_tile(f32x16& p0, f32x16& p1, int dq) {
    const float NEG = -__builtin_inff();
#pragma unroll
    for (int r = 0; r < 16; ++r) { const int c = (r & 3) + 8 * (r >> 2); if (dq - c < 0) p0[r] = NEG; if (dq - c - 32 < 0) p1[r] = NEG; }
}
__device__ __forceinline__ void partialSM(f32x16& p0, f32x16& p1, float& m_reg, float& alpha) {
    float pmax = p0[0];
#pragma unroll
    for (int r = 1; r < 16; ++r) pmax = fmaxf(pmax, p0[r]);
#pragma unroll
    for (int r = 0; r < 16; ++r) pmax = fmaxf(pmax, p1[r]);
    { auto rr = __builtin_amdgcn_permlane32_swap(__float_as_uint(pmax), __float_as_uint(pmax), false, false); pmax = fmaxf(__uint_as_float(rr[0]), __uint_as_float(rr[1])); }
    float mn;
    if (__builtin_expect(__all((pmax - m_reg) <= THR), 1)) { mn = m_reg; alpha = 1.f; }
    else { mn = fmaxf(m_reg, pmax); alpha = __builtin_amdgcn_exp2f(m_reg - mn); m_reg = mn; }
#pragma unroll
    for (int r = 0; r < 16; ++r) p0[r] = p0[r] - mn;
#pragma unroll
    for (int r = 0; r < 16; ++r) p1[r] = p1[r] - mn;
#pragma unroll
    for (int r = 0; r < 16; ++r) p0[r] = __builtin_amdgcn_exp2f(p0[r]);
}
__device__ __forceinline__ void finishSM(f32x16& p0, f32x16& p1, float alpha, float& l_reg, bf16x8& pa0, bf16x8& pa1, bf16x8& pa2, bf16x8& pa3) {
#pragma unroll
    for (int r = 0; r < 16; ++r) p1[r] = __builtin_amdgcn_exp2f(p1[r]);
    float ps = 0;
#pragma unroll
    for (int r = 0; r < 16; ++r) ps += p0[r];
#pragma unroll
    for (int r = 0; r < 16; ++r) ps += p1[r];
    { auto rr = __builtin_amdgcn_permlane32_swap(__float_as_uint(ps), __float_as_uint(ps), false, false); ps = __uint_as_float(rr[0]) + __uint_as_float(rr[1]); }
    l_reg = l_reg * alpha + ps;
#define PK4(P, B_, OUT) do { unsigned a0 = cvt_pk_bf16(P[B_+0], P[B_+1]), a1 = cvt_pk_bf16(P[B_+2], P[B_+3]);                          \
        unsigned b0 = cvt_pk_bf16(P[B_+4], P[B_+5]), b1 = cvt_pk_bf16(P[B_+6], P[B_+7]);                                             \
        auto r0 = __builtin_amdgcn_permlane32_swap(a0, b0, false, false); auto r1 = __builtin_amdgcn_permlane32_swap(a1, b1, false, false); \
        u32x4 w = {r0[0], r1[0], r0[1], r1[1]}; OUT = *reinterpret_cast<bf16x8*>(&w); } while (0)
    PK4(p0, 0, pa0); PK4(p0, 8, pa1); PK4(p1, 0, pa2); PK4(p1, 8, pa3);
#undef PK4
}
template <int KB>
__device__ __forceinline__ void qkt(f32x16& p0, f32x16& p1, const char* K_lds, int r32, int hi, const bf16x8* qr, float ab, float slope2) {
    const float s32 = 32.f * slope2;
#pragma unroll
    for (int r = 0; r < 16; ++r) { p0[r] = fmaf(slope2, (float)((r & 3) + 8 * (r >> 2)), ab); p1[r] = p0[r] + s32; }
#pragma unroll
    for (int d0 = 0; d0 < 4; ++d0) { const char* a = K_lds + KB * SHM_K + kswz(r32, d0 * 2 + hi);
        bf16x8 b0 = *reinterpret_cast<const bf16x8*>(a);
        bf16x8 b1 = *reinterpret_cast<const bf16x8*>(a + 32 * 128);
        p0 = __builtin_amdgcn_mfma_f32_32x32x16_bf16(b0, qr[d0], p0, 0, 0, 0);
        p1 = __builtin_amdgcn_mfma_f32_32x32x16_bf16(b1, qr[d0], p1, 0, 0, 0); }
}
template <int VB>
__device__ __forceinline__ void pv_tile(f32x16* o, int vb0, bf16x8 pa0, bf16x8 pa1, bf16x8 pa2, bf16x8 pa3) {
#define TRRD(dst, off) asm volatile("ds_read_b64_tr_b16 %0, %1 offset:%2" : "=&v"(dst) : "v"(vb0), "i"(off) : "memory")
#define PV_D0(d0) do { s16x4 l0, l1, l2, l3, h0, h1, h2, h3; constexpr int b_ = VB * SHM_V + v_rd_off(d0, 0, 0); \
        TRRD(l0, b_); TRRD(h0, b_ + 2048); TRRD(l1, b_ + 4096); TRRD(h1, b_ + 6144); TRRD(l2, b_ + 8192); TRRD(h2, b_ + 10240); TRRD(l3, b_ + 12288); TRRD(h3, b_ + 14336); \
        asm volatile("s_waitcnt lgkmcnt(0)" ::: "memory"); SBAR();   \
        o[d0] = __builtin_amdgcn_mfma_f32_32x32x16_bf16(pa0, (bf16x8){l0[0], l0[1], l0[2], l0[3], h0[0], h0[1], h0[2], h0[3]}, o[d0], 0, 0, 0);   \
        o[d0] = __builtin_amdgcn_mfma_f32_32x32x16_bf16(pa1, (bf16x8){l1[0], l1[1], l1[2], l1[3], h1[0], h1[1], h1[2], h1[3]}, o[d0], 0, 0, 0);   \
        o[d0] = __builtin_amdgcn_mfma_f32_32x32x16_bf16(pa2, (bf16x8){l2[0], l2[1], l2[2], l2[3], h2[0], h2[1], h2[2], h2[3]}, o[d0], 0, 0, 0);   \
        o[d0] = __builtin_amdgcn_mfma_f32_32x32x16_bf16(pa3, (bf16x8){l3[0], l3[1], l3[2], l3[3], h3[0], h3[1], h3[2], h3[3]}, o[d0], 0, 0, 0); } while (0)
    PV_D0(0); PV_D0(1); PV_D0(2); PV_D0(3);
#undef PV_D0
#undef TRRD
}

struct BlockRef { const bf16_t* Q; const bf16_t* K; const bf16_t* V; bf16_t* O; int P0; int mode; float slope2; float kmax; };
struct Seam { bf16x8 qr[4]; bf16x8 st_v0, st_v1, st_k0; };
__device__ __forceinline__ BlockRef mkref(const bf16_t* Z, bf16_t* AO, const unsigned* kmx, int item, int pass) { BlockRef r; const int bh = item >> 4, y = item & 15, b = bh >> 2, h = bh & 3; const int qb = (pass < 2) ? y : 31 - y, mp = pass & 1;
    const bf16_t* zb = Z + (size_t)b * SEQ * ZP; r.Q = zb + (size_t)(qb * 256) * ZP + ZQ + h * 128 + mp * 64; r.K = zb + ZK + h * 128 + mp * 64; r.V = zb + ZVAL + h * 128;
    r.O = AO + ((size_t)b * SEQ + qb * 256) * DM + 512 + h * 128; r.P0 = qb * 256; r.mode = mp; r.slope2 = exp2f(-2.0f * (float)(h + 1)) * LOG2E;
    const unsigned* kp = kmx + ((bh * 2 + mp) * 2); r.kmax = 1.01f * sqrtf(__uint_as_float(ld_u32_agent(kp)) + __uint_as_float(ld_u32_agent(kp + 1))); return r; }
#define ROWV(p, k0, rr) ((p) + (size_t)((k0) + (rr)) * ZP + sc)
#define ROWK(p, k0) ((p) + (size_t)((k0) + skr) * ZP + skc * 8)
#define VMW() asm volatile("s_waitcnt vmcnt(0)" ::: "memory")
#define VMWN(n) asm volatile("s_waitcnt vmcnt(%0)" :: "i"(n) : "memory")
#define SLOAD_H(Kp, Vp, k0) do { S.st_v0 = load8(ROWV(Vp, k0, sr)); S.st_v1 = load8(ROWV(Vp, k0, 32 + sr)); S.st_k0 = load8(ROWK(Kp, k0)); } while (0)
#define SWRITE_HK(bf) do { *(bf16x8*)(K_lds + (bf) * SHM_K + kws) = S.st_k0; } while (0)
#define SWRITE_HV(bf) do { *(bf16x8*)(V_lds + (bf) * SHM_V + vst0) = S.st_v0; *(bf16x8*)(V_lds + (bf) * SHM_V + vst1) = S.st_v1; } while (0)
#define SWRITE_H(bf) do { SWRITE_HV(bf); SWRITE_HK(bf); } while (0)
__device__ __forceinline__ void prime(const BlockRef& cur, char* lds, Seam& S, int wid) {
    const int lane = lane_id(), tid = wid * 64 + lane, r32 = lane & 31, hi = lane >> 5;
    const int sr = tid >> 4, sc = (tid & 15) * 8, skr = tid >> 3, skc = tid & 7, kws = kswz(skr, skc); char* K_lds = lds + LDS_K;
#pragma unroll
    for (int d0 = 0; d0 < 4; ++d0) S.qr[d0] = load8(cur.Q + (size_t)(wid * QBLK + r32) * ZP + d0 * 16 + hi * 8);
    SLOAD_H(cur.K, cur.V, cur.P0 + QB - KVBLK); VMW(); SWRITE_HK(0);
    __syncthreads();
}
__device__ __forceinline__ void block(const BlockRef& cur, const BlockRef& nxt, char* lds, Seam& S, float lam, const float* __restrict__ subln, int wid) {
    const int lane = lane_id(), tid = wid * 64 + lane, r32 = lane & 31, hi = lane >> 5;
    const int NT0 = (cur.P0 + QB) / KVBLK;
    int NT = NT0;
    const int qlo = cur.P0 + wid * QBLK, qm = qlo + r32 - 4 * hi;
    const float slope2 = cur.slope2;
    char* V_lds = lds + LDS_V; char* K_lds = lds + LDS_K;
    float* ws = (float*)(lds + LDS_WS) + wid * 64; float* li_l = ws, * al_l = ws + 32;
    float m_reg = -1e30f, l_reg = 0; f32x16 o[4] = {};
    const int sr = tid >> 4, sc = (tid & 15) * 8, vst0 = v_st(sr, sc), vst1 = v_st(32 + sr, sc), skr = tid >> 3, skc = tid & 7, kws = kswz(skr, skc);
    const int vb0 = (int)(uintptr_t)V_lds + v_rd_base(lane);
    const bf16_t* Kh = cur.K; const bf16_t* Vh = cur.V;
#define RESC(a) do { if (__any((a) < 1.f)) { if (hi == 0) al_l[r32] = (a); asm volatile("s_waitcnt lgkmcnt(0)" ::: "memory");              \
                     for (int d_ = 0; d_ < 4; ++d_) for (int r = 0; r < 16; ++r) o[d_][r] *= al_l[crow(r, hi)]; } } while (0)
#define KBASE(t) ((NT0 - 1 - (t)) * KVBLK)
#define AB(t) (slope2 * (float)(KBASE(t) - qm))
#define MASKT(P0_, P1_, t) do { const int kb_ = KBASE(t); if (kb_ + KVBLK - 1 > qlo) mask_tile(P0_, P1_, qm - kb_); } while (0)
    constexpr int NQL = 4;
#define SEAM_K0() do { VMWN(NQL); SWRITE_HK(0); SBAR(); } while (0)
    f32x16 pA0, pA1, pB0, pB1; float alA, alB; bf16x8 pa0, pa1, pa2, pa3;
    float cbase;
    { float q2 = 0.f;
#pragma unroll
      for (int d0 = 0; d0 < 4; ++d0)
#pragma unroll
          for (int j = 0; j < 8; ++j) { const float v = __uint_as_float(((unsigned)(unsigned short)S.qr[d0][j]) << 16); q2 = fmaf(v, v, q2); }
      { auto rr = __builtin_amdgcn_permlane32_swap(__float_as_uint(q2), __float_as_uint(q2), false, false); q2 = __uint_as_float(rr[0]) + __uint_as_float(rr[1]); }
      cbase = sqrtf(q2) * cur.kmax * 1.0001f - slope2 * (float)(qlo + r32); }
    SWRITE_HV(0); SBAR();
    if (NT > 1) { SLOAD_H(Kh, Vh, KBASE(1)); }
    SBAR(); qkt<0>(pA0, pA1, K_lds, r32, hi, S.qr, AB(0), slope2);
    MASKT(pA0, pA1, 0); partialSM(pA0, pA1, m_reg, alA);
    if (NT > 1) { VMW(); SWRITE_H(1); }
    __syncthreads();
#define HALF_STEP(PX0, PX1, alX, PY0, PY1, alY, t, KB, VB, SB) do {                                                      \
        SBAR(); qkt<KB>(PX0, PX1, K_lds, r32, hi, S.qr, AB(t), slope2);                                                   \
        finishSM(PY0, PY1, alY, l_reg, pa0, pa1, pa2, pa3); SBAR();                                                       \
        if ((t) + 1 < NT) { SLOAD_H(Kh, Vh, KBASE((t) + 1)); SBAR(); }                                                    \
        pv_tile<VB>(o, vb0, pa0, pa1, pa2, pa3); MASKT(PX0, PX1, (t)); partialSM(PX0, PX1, m_reg, alX);                   \
        __syncthreads();                                                                                                  \
        if ((t) + 1 < NT) { VMW(); SWRITE_H(SB); }                                                                        \
        RESC(alX); __syncthreads(); } while (0)
    for (int t = 1; t + 1 < NT; t += 2) {
        HALF_STEP(pB0, pB1, alB, pA0, pA1, alA, t, 1, 0, 0);
        HALF_STEP(pA0, pA1, alA, pB0, pB1, alB, t + 1, 0, 1, 1);
        if (t == 3 && NT0 > 6) {
            float c = cbase - m_reg;
#pragma unroll
            for (int o_ = 1; o_ < 64; o_ <<= 1) c = fmaxf(c, __shfl_xor(c, o_));
            float* cx = (float*)(lds + LDS_CX);
            if (lane == 0) cx[wid] = c;
            __syncthreads();
            float C = cx[0];
#pragma unroll
            for (int w_ = 1; w_ < NW; ++w_) C = fmaxf(C, cx[w_]);
            const float X = (-SKIP_MARGIN - C) / slope2 - 63.f;
            const float need_f = (float)(NT0 - 1) - X * (1.0f / 64.0f);
            if (need_f < (float)NT0) { int n = (int)ceilf(need_f); n = n < 6 ? 6 : n; n = (n + 1) & ~1; NT = n < NT0 ? n : NT0; }
        }
    }
    SBAR(); qkt<1>(pB0, pB1, K_lds, r32, hi, S.qr, AB(NT - 1), slope2); SBAR();
    SLOAD_H(nxt.K, nxt.V, nxt.P0 + QB - KVBLK); SBAR();
#pragma unroll
    for (int d0 = 0; d0 < 4; ++d0) S.qr[d0] = load8(nxt.Q + (size_t)(wid * QBLK + r32) * ZP + d0 * 16 + hi * 8);
    SBAR();
    finishSM(pA0, pA1, alA, l_reg, pa0, pa1, pa2, pa3); SBAR();
    pv_tile<0>(o, vb0, pa0, pa1, pa2, pa3);
    MASKT(pB0, pB1, NT - 1); partialSM(pB0, pB1, m_reg, alB); __syncthreads(); RESC(alB);
    finishSM(pB0, pB1, alB, l_reg, pa0, pa1, pa2, pa3); SBAR(); pv_tile<1>(o, vb0, pa0, pa1, pa2, pa3);
    SBAR(); SEAM_K0();
    if (hi == 0) li_l[r32] = l_reg; asm volatile("s_waitcnt lgkmcnt(0)" ::: "memory");
    float rli[16];
#pragma unroll
    for (int r = 0; r < 16; ++r) rli[r] = __builtin_amdgcn_rcpf(li_l[crow(r, hi)]);
    unsigned* stash = (unsigned*)(lds + LDS_STASH) + wid * 2048 + lane;
    if (cur.mode == 0) {
#pragma unroll
        for (int r = 0; r < 16; ++r) { stash[(r * 2 + 0) * 64] = cvt_pk_bf16(o[0][r] * rli[r], o[1][r] * rli[r]); stash[(r * 2 + 1) * 64] = cvt_pk_bf16(o[2][r] * rli[r], o[3][r] * rli[r]); }
    } else {
        float ssq[16];
#pragma unroll
        for (int r = 0; r < 16; ++r) { const unsigned w0 = stash[(r * 2 + 0) * 64], w1 = stash[(r * 2 + 1) * 64];
            o[0][r] = bf_lo(w0) - lam * (o[0][r] * rli[r]); o[1][r] = bf_hi(w0) - lam * (o[1][r] * rli[r]);
            o[2][r] = bf_lo(w1) - lam * (o[2][r] * rli[r]); o[3][r] = bf_hi(w1) - lam * (o[3][r] * rli[r]);
            ssq[r] = (o[0][r] * o[0][r] + o[1][r] * o[1][r]) + (o[2][r] * o[2][r] + o[3][r] * o[3][r]); }
#pragma unroll
        for (int r = 0; r < 16; ++r) {
#pragma unroll
            for (int off = 1; off < 32; off <<= 1) ssq[r] += __shfl_xor(ssq[r], off);
            ssq[r] = __builtin_amdgcn_rsqf(ssq[r] * (1.0f / DV) + RMS_EPS); }
        float g4[4];
#pragma unroll
        for (int d0 = 0; d0 < 4; ++d0) g4[d0] = subln[d0 * 32 + r32] * 0.8f;
        bf16_t* Ow = cur.O + (size_t)(wid * QBLK) * DM;
#pragma unroll
        for (int r = 0; r < 16; ++r) { const int orow = crow(r, hi);
#pragma unroll
            for (int d0 = 0; d0 < 4; ++d0) { const float v = o[d0][r] * ssq[r] * g4[d0]; const float vn = __shfl_xor(v, 1);
                if ((r32 & 1) == 0) *(unsigned*)(Ow + (size_t)orow * DM + d0 * 32 + r32) = cvt_pk_bf16(v, vn); } }
    }
    __syncthreads();
#undef RESC
#undef KBASE
#undef AB
#undef MASKT
#undef SEAM_K0
#undef HALF_STEP
}
#undef ROWV
#undef ROWK
#undef VMW
#undef VMWN
#undef SLOAD_H
#undef SWRITE_HK
#undef SWRITE_HV
#undef SWRITE_H
#undef SBAR
}


#define XB_TMO      128
#define XB_XCNT(j)  (256  + 64 * (j))
#define XB_XSUB(j)  (1280 + 64 * (j))
#define XB_XGEN(j)  (2304 + 64 * (j))
#define XB_TOP      3328
#define XB_TOPGEN   3392
#define XCD_BAR_WORDS 3456
#define XB_SPIN_CAP (1u << 22)
__device__ __forceinline__ unsigned xb_ld(unsigned* p)              { return __hip_atomic_load(p, __ATOMIC_RELAXED, __HIP_MEMORY_SCOPE_AGENT); }
__device__ __forceinline__ unsigned xb_add(unsigned* p, unsigned v) { return __hip_atomic_fetch_add(p, v, __ATOMIC_RELAXED, __HIP_MEMORY_SCOPE_AGENT); }
__device__ __forceinline__ unsigned xb_xcc_id() { return (unsigned)__builtin_amdgcn_s_getreg((3 << 11) | 20) & 0xFu; }
#define XB_SPIN(cond, bar) do { unsigned _sp = 0; while (cond) { __builtin_amdgcn_s_sleep(1); \
    if ((++_sp & 255u) == 0u) { if (xb_ld(&(bar)[XB_TMO])) break; if (_sp > XB_SPIN_CAP) { atomicAdd(&(bar)[XB_TMO], 1u); break; } } } } while (0)
struct XcdBarrier { unsigned* bar; unsigned x; volatile LAS unsigned* st; };
__device__ __forceinline__ XcdBarrier xcd_barrier_post(unsigned* bar, volatile LAS unsigned* st, bool t0) {
    XcdBarrier b; b.bar = bar; b.x = xb_xcc_id(); b.st = st;
    if (t0) (void)xb_add(&bar[XB_XCNT(b.x)], 1u);
    return b;
}
__device__ __forceinline__ void xcd_barrier_complete(unsigned* bar, unsigned x, unsigned& nloc, unsigned& nx) {
    const unsigned G = gridDim.x;
    unsigned sum, cnt, mine, sp = 0u;
    for (;;) {
        sum = 0u; cnt = 0u; mine = 0u;
#pragma unroll
        for (unsigned j = 0; j < 16; ++j) { const unsigned c = xb_ld(&bar[XB_XCNT(j)]); sum += c; cnt += (c > 0u) ? 1u : 0u; mine = (j == x) ? c : mine; }
        if (sum == G) break;
        __builtin_amdgcn_s_sleep(1);
        if ((++sp & 255u) == 0u) { if (xb_ld(&bar[XB_TMO])) break; if (sp > XB_SPIN_CAP) { atomicAdd(&bar[XB_TMO], 1u); break; } }
    }
    nloc = mine > 0u ? mine : 1u; nx = cnt > 0u ? cnt : 1u;
}
__device__ __forceinline__ void xcd_barrier(const XcdBarrier& b, bool t0) {
    asm volatile("s_waitcnt vmcnt(0)" ::: "memory");
    __syncthreads();
    if (t0) {
        unsigned* bar = b.bar;
        __builtin_amdgcn_s_waitcnt(0);
        unsigned nloc = b.st[0], nx = b.st[1];
        if (nloc == 0u) { xcd_barrier_complete(bar, b.x, nloc, nx); b.st[0] = nloc; b.st[1] = nx; }
        const unsigned old = xb_add(&bar[XB_XSUB(b.x)], 1u);
        const unsigned gen = old / nloc;
        if (old + 1u == (gen + 1u) * nloc) {
            __builtin_amdgcn_fence(__ATOMIC_RELEASE, "agent");
            asm volatile("s_waitcnt vmcnt(0)" ::: "memory");
            const unsigned og = xb_add(&bar[XB_TOP], 1u);
            const unsigned tg = og / nx;
            if (og + 1u == (tg + 1u) * nx) xb_add(&bar[XB_TOPGEN], 1u);
            else XB_SPIN(xb_ld(&bar[XB_TOPGEN]) == tg, bar);
            __builtin_amdgcn_fence(__ATOMIC_ACQUIRE, "agent");
            xb_add(&bar[XB_XGEN(b.x)], 1u);
            asm volatile("s_waitcnt vmcnt(0)" ::: "memory");
        } else {
            XB_SPIN(xb_ld(&bar[XB_XGEN(b.x)]) == gen, bar);
            __builtin_amdgcn_fence(__ATOMIC_ACQUIRE, "agent");
            asm volatile("s_waitcnt vmcnt(0)" ::: "memory");
        }
    }
    __syncthreads();
}
constexpr int NWAVES = 8, NTHR = 512;
constexpr int LDS_BYTES = 163840;
struct Args {
    const float* in[28]; float* out; unsigned char* ws; int ph_lo, ph_hi;
};
constexpr int N_PHASES = 15;

struct Frame {
    LAS unsigned char* lds; int wave, vcu, G;
};

__device__ __forceinline__ void transpose_item(const float* W, int ldw, int k0, int n0, bf16_t* dst, int ldt, const float* kscale, LAS float* scr, int lane) {
    f32x4 v[8]; const int kr = lane >> 3, n4 = (lane & 7) * 4;
#pragma unroll
    for (int i = 0; i < 8; ++i) v[i] = *(const f32x4*)(W + (size_t)(k0 + i * 8 + kr) * ldw + n0 + n4);
#pragma unroll
    for (int i = 0; i < 8; ++i) { const int kk = i * 8 + kr; f32x4 x = v[i]; if (kscale) x = x * kscale[k0 + kk];
        scr[kk * 33 + n4 + 0] = x[0]; scr[kk * 33 + n4 + 1] = x[1]; scr[kk * 33 + n4 + 2] = x[2]; scr[kk * 33 + n4 + 3] = x[3]; }
    asm volatile("s_waitcnt lgkmcnt(0)" ::: "memory");
    const int c = lane & 7;
#pragma unroll
    for (int j = 0; j < 4; ++j) { const int n = (lane >> 3) + 8 * j; const LAS float* s = scr + (8 * c) * 33 + n;
        u32x4 o; o.x = cvt_pk_bf16(s[0 * 33], s[1 * 33]); o.y = cvt_pk_bf16(s[2 * 33], s[3 * 33]); o.z = cvt_pk_bf16(s[4 * 33], s[5 * 33]); o.w = cvt_pk_bf16(s[6 * 33], s[7 * 33]);
        *(u32x4*)(dst + (size_t)n * ldt + k0 + 8 * c) = o; }
    asm volatile("s_waitcnt lgkmcnt(0)" ::: "memory");
}
__device__ __forceinline__ void transpose_item_fp8(const float* W, int ldw, int k0, int n0, unsigned char* dst, int ldt, float scale, const float* kscale, LAS float* scr, int lane) {
    f32x4 v[8]; const int kr = lane >> 3, n4 = (lane & 7) * 4;
#pragma unroll
    for (int i = 0; i < 8; ++i) v[i] = *(const f32x4*)(W + (size_t)(k0 + i * 8 + kr) * ldw + n0 + n4);
#pragma unroll
    for (int i = 0; i < 8; ++i) { const int kk = i * 8 + kr; const f32x4 x = v[i] * (kscale ? scale * kscale[k0 + kk] : scale);
        scr[kk * 33 + n4 + 0] = x[0]; scr[kk * 33 + n4 + 1] = x[1]; scr[kk * 33 + n4 + 2] = x[2]; scr[kk * 33 + n4 + 3] = x[3]; }
    asm volatile("s_waitcnt lgkmcnt(0)" ::: "memory");
    const int n = lane >> 1, kh = (lane & 1) * 32; const LAS float* s = scr + kh * 33 + n;
    u32x4 o0, o1;
    o0.x = pk4_fp8(s[0 * 33], s[1 * 33], s[2 * 33], s[3 * 33]); o0.y = pk4_fp8(s[4 * 33], s[5 * 33], s[6 * 33], s[7 * 33]); o0.z = pk4_fp8(s[8 * 33], s[9 * 33], s[10 * 33], s[11 * 33]); o0.w = pk4_fp8(s[12 * 33], s[13 * 33], s[14 * 33], s[15 * 33]);
    o1.x = pk4_fp8(s[16 * 33], s[17 * 33], s[18 * 33], s[19 * 33]); o1.y = pk4_fp8(s[20 * 33], s[21 * 33], s[22 * 33], s[23 * 33]); o1.z = pk4_fp8(s[24 * 33], s[25 * 33], s[26 * 33], s[27 * 33]); o1.w = pk4_fp8(s[28 * 33], s[29 * 33], s[30 * 33], s[31 * 33]);
    *(u32x4*)(dst + (size_t)n * ldt + k0 + kh) = o0; *(u32x4*)(dst + (size_t)n * ldt + k0 + kh + 16) = o1;
    asm volatile("s_waitcnt lgkmcnt(0)" ::: "memory");
}
__device__ __forceinline__ void rms_rows2_to_bf16(const float* xa, const float* xb, const float* g, bf16_t* oa, bf16_t* ob, int lane) {
    const f32x4* ra = (const f32x4*)xa + lane; const f32x4* rb = (const f32x4*)xb + lane; const f32x4* gr = (const f32x4*)g + lane;
    f32x4 va[4], vb[4]; float sa = 0.f, sb = 0.f;
#pragma unroll
    for (int j = 0; j < 4; ++j) { va[j] = ra[64 * j]; vb[j] = rb[64 * j]; }
#pragma unroll
    for (int j = 0; j < 4; ++j) { sa += (va[j].x * va[j].x + va[j].y * va[j].y) + (va[j].z * va[j].z + va[j].w * va[j].w); sb += (vb[j].x * vb[j].x + vb[j].y * vb[j].y) + (vb[j].z * vb[j].z + vb[j].w * vb[j].w); }
    const float rsa = __builtin_amdgcn_rsqf(wave_sum(sa) * (1.f / DM) + RMS_EPS), rsb = __builtin_amdgcn_rsqf(wave_sum(sb) * (1.f / DM) + RMS_EPS);
    u32x2* pa = (u32x2*)oa + lane; u32x2* pb = (u32x2*)ob + lane;
#pragma unroll
    for (int j = 0; j < 4; ++j) { const f32x4 gg = gr[64 * j]; u32x2 w;
        w.x = cvt_pk_bf16(va[j].x * rsa * gg.x, va[j].y * rsa * gg.y); w.y = cvt_pk_bf16(va[j].z * rsa * gg.z, va[j].w * rsa * gg.w); pa[64 * j] = w;
        w.x = cvt_pk_bf16(vb[j].x * rsb * gg.x, vb[j].y * rsb * gg.y); w.y = cvt_pk_bf16(vb[j].z * rsb * gg.z, vb[j].w * rsb * gg.w); pb[64 * j] = w; }
}

__global__ void __launch_bounds__(NTHR, 2) mega(Args args) {
    extern __shared__ __attribute__((aligned(16))) unsigned char lds_raw[];
    Frame F; F.lds = (LAS unsigned char*)lds_raw; F.wave = __builtin_amdgcn_readfirstlane(threadIdx.x >> 6);
    F.G = gridDim.x; { const int bx = blockIdx.x; F.vcu = (F.G % 8 == 0) ? (bx % 8) * (F.G / 8) + bx / 8 : bx; }
    unsigned char* ws = args.ws;
    unsigned* ctl = (unsigned*)(ws + WS_CTL);
    const float* x = args.in[0]; float* out = args.out;
    bf16_t* Win_t = (bf16_t*)(ws + WS_WIN); bf16_t* Wout_t = (bf16_t*)(ws + WS_WOUT); bf16_t* Wq_t = (bf16_t*)(ws + WS_WQ); bf16_t* Wkv_t = (bf16_t*)(ws + WS_WKV);
    bf16_t* Wo_t = (bf16_t*)(ws + WS_WO); bf16_t* Wr_t = (bf16_t*)(ws + WS_WR); bf16_t* Wsgu = (bf16_t*)(ws + WS_WSGU); bf16_t* memn = (bf16_t*)(ws + WS_MEMN);
    bf16_t* Km = (bf16_t*)(ws + WS_KM); bf16_t* Vt = (bf16_t*)(ws + WS_VT); bf16_t* Wgu_t = (bf16_t*)(ws + WS_WGU); bf16_t* Wd_t = (bf16_t*)(ws + WS_WD);
    bf16_t* Z = (bf16_t*)(ws + WS_RA); bf16_t* Qm = (bf16_t*)(ws + WS_RA); bf16_t* Sc = (bf16_t*)(ws + WS_RA + 128 * MiB); bf16_t* xg = (bf16_t*)(ws + WS_RA); bf16_t* yb = (bf16_t*)(ws + WS_RA);
    bf16_t* XN = (bf16_t*)(ws + WS_RB); bf16_t* AO = (bf16_t*)(ws + WS_RB); bf16_t* Om = (bf16_t*)(ws + WS_RB); bf16_t* act = (bf16_t*)(ws + WS_RB);
    bf16_t* x1b = (bf16_t*)(ws + WS_RC); bf16_t* x2b = (bf16_t*)(ws + WS_RC); unsigned char* x2f8 = ws + WS_X2F8;
    float* ssq1 = (float*)(ws + WS_SSQ1); float* ssq2 = (float*)(ws + WS_SSQ2); float* rstd2 = (float*)(ws + WS_SSQ1);     float* logit = (float*)(ws + WS_LOGIT);
    int* tok_e = (int*)(ws + WS_TOKE); float* tok_w = (float*)(ws + WS_TOKW); int* tok_s = (int*)(ws + WS_TOKS); int* row_tok = (int*)(ws + WS_ROWTOK); float* rowrs = (float*)(ws + WS_ROWTOK + 1 * MiB);
    const int gw = F.vcu * NWAVES + F.wave, NGW = F.G * NWAVES;
    const int lo = args.ph_lo, hi = args.ph_hi;
#define IN(k) (lo <= (k) && (k) < hi)
#if MK_ONE_LAUNCH
    volatile LAS unsigned* misc = (volatile LAS unsigned*)(F.lds + LDS_MISC);
    if (threadIdx.x < 64) misc[threadIdx.x] = 0u;
    __syncthreads();
    XcdBarrier xbar = xcd_barrier_post(ctl + CW_BAR, misc + 8, threadIdx.x == 0);
#define GRID_BAR(k) do { if (IN(k) && IN((k) + 1)) { if ((k) == 0) cg::this_grid().sync(); else xcd_barrier(xbar, F.wave == 0 && lane_id() == 0); } } while (0)
#else
#define GRID_BAR(k) do { } while (0)
#endif
#define LOCAL_SEAM() do { asm volatile("s_waitcnt vmcnt(0)" ::: "memory"); __syncthreads(); __builtin_amdgcn_fence(__ATOMIC_ACQUIRE, "agent"); asm volatile("s_waitcnt vmcnt(0)" ::: "memory"); __syncthreads(); } while (0)

    if (IN(0)) {
        const int lane_ = lane_id(), tid_ = F.wave * 64 + lane_; (void)tid_;
        LAS float* scr = (LAS float*)(F.lds + F.wave * 16384);
        constexpr int I_IN = 16 * 80, I_SQ = 16 * 32, I_KV = 16 * 64, I_G = 16 * 16, I_D = 8 * 32;
        constexpr int NITEMS = I_IN + 3 * I_SQ + I_KV + NEXP * (2 * I_G + I_D);
        for (int it = gw; it < NITEMS; it += NGW) {
            int r = it;
            if (r < I_IN) { const int kb = r / 80, nb = r % 80; transpose_item(args.in[3], ZP, kb * 64, nb * 32, Win_t + (size_t)(nb * 32) * DM, DM, nullptr, scr, lane_); continue; } r -= I_IN;
            if (r < I_SQ) { const int kb = r / 32, nb = r % 32; transpose_item(args.in[13], DM, kb * 64, nb * 32, Wout_t + (size_t)(nb * 32) * DM, DM, nullptr, scr, lane_); continue; } r -= I_SQ;
            if (r < I_SQ) { const int kb = r / 32, nb = r % 32; transpose_item(args.in[16], DM, kb * 64, nb * 32, Wq_t + (size_t)(nb * 32) * DM, DM, args.in[14], scr, lane_); continue; } r -= I_SQ;
            if (r < I_KV) { const int kb = r / 64, nb = r % 64; transpose_item(args.in[17], 2 * DM, kb * 64, nb * 32, Wkv_t + (size_t)(nb * 32) * DM, DM, nullptr, scr, lane_); continue; } r -= I_KV;
            if (r < I_SQ) { const int kb = r / 32, nb = r % 32; transpose_item(args.in[18], DM, kb * 64, nb * 32, Wo_t + (size_t)(nb * 32) * DM, DM, nullptr, scr, lane_); continue; } r -= I_SQ;
            const int e = r / (2 * I_G + I_D); r -= e * (2 * I_G + I_D);
            if (r < 2 * I_G) { const int up = r >= I_G; if (up) r -= I_G; const int kb = r / 16, nb = r % 16, n0 = nb * 32;
                const float* W = (up ? args.in[25] : args.in[24]) + (size_t)e * DM * DEXP;
                transpose_item_fp8(W, DEXP, kb * 64, n0, (unsigned char*)Wgu_t + ((size_t)e * 1024 + (n0 >> 7) * 256 + 64 * ((n0 & 127) >> 5) + 32 * up) * DM, DM, F8_WSCALE, args.in[19], scr, lane_); continue; }
            r -= 2 * I_G;
            { const int kb = r / 32, nb = r % 32; transpose_item_fp8(args.in[26] + (size_t)e * DEXP * DM, DM, kb * 64, nb * 32, (unsigned char*)Wd_t + ((size_t)e * 1024 + nb * 32) * DEXP, DEXP, F8_WSCALE, nullptr, scr, lane_); }
        }
        for (int i = blockIdx.x * NTHR + tid_; i < 256 * DM; i += F.G * NTHR) { const int n = i >> 10, k = i & 1023; float v = 0.f;
            if (n < 4) v = args.in[20][k * 4 + n] * args.in[19][k]; else if (n < 36) v = args.in[22][k * 32 + (n - 4)] * args.in[19][k];
            Wr_t[i] = (bf16_t)(cvt_pk_bf16(v, 0.f) & 0xffffu); }
        for (int i = blockIdx.x * NTHR + tid_; i < 4 * 128 * 128; i += F.G * NTHR) { const int t = (i >> 7) & 127, s = i & 127; const float v = s <= t ? args.in[6][i] : 0.f; Wsgu[i] = (bf16_t)(cvt_pk_bf16(v, 0.f) & 0xffffu); }
        for (int m = gw; m < M; m += 2 * NGW) rms_rows2_to_bf16(x + (size_t)m * DM, x + (size_t)(m + NGW) * DM, args.in[2], XN + (size_t)m * DM, XN + (size_t)(m + NGW) * DM, lane_);
        for (int m = gw; m < MROWS / 2; m += NGW) rms_rows2_to_bf16(args.in[1] + (size_t)m * DM, args.in[1] + (size_t)(m + MROWS / 2) * DM, args.in[15], memn + (size_t)m * DM, memn + (size_t)(m + MROWS / 2) * DM, lane_);
        __syncthreads();
    }
    GRID_BAR(0);

    if (IN(1)) {
        { pg8::Gemm g{DM, DM, DM}; pg8::PlainSched S; S.to.init(M / 256, ZP / 256, F.G, (int)blockIdx.x); S.A = (const char*)XN; S.B = (const char*)Win_t; S.tA = (size_t)256 * DM * 2; S.tB = (size_t)256 * DM * 2;
          pg8::EpiZ E{Z, ctl + CW_KMX}; pg8::gemm_phase(F.lds, F.wave, g, S, E); }
    }
    GRID_BAR(1);

    if (IN(2)) {
        const int lane_ = lane_id(), tid_ = F.wave * 64 + lane_; (void)tid_;
        float lam;
        { const float a = args.in[8][lane_] * args.in[9][lane_], b = args.in[10][lane_] * args.in[11][lane_];
          lam = __expf(wave_sum(a)) - __expf(wave_sum(b)) + 0.2f; }
        const int nitems = 32 * 16, npass = 4;
        int nit, itA, itB, itC;
        if (F.G == 256) { const int b = F.vcu >> 5, r = F.vcu & 31; if (r < 16) { nit = 1; itA = ((b * 4 + 3) << 4) | r; itB = itA; itC = itA; }
            else { const int y = r - 16; nit = 3; itA = ((b * 4 + 2) << 4) | y; itB = ((b * 4 + 1) << 4) | (15 - y); itC = ((b * 4 + 0) << 4) | y; } }
        else { const int per = (nitems + F.G - 1) / F.G; itA = F.vcu * per; int e_ = itA + per; if (e_ > nitems) e_ = nitems; nit = e_ - itA; itB = itA + 1; itC = itA + 2; }
#define ITEM_OF(i) ((F.G == 256) ? ((i) == 0 ? itA : ((i) == 1 ? itB : itC)) : itA + (i))
        if (nit > 0) {
            int ii = 0, pass = 0; da::BlockRef cur = da::mkref(Z, AO, ctl + CW_KMX, ITEM_OF(0), 0); da::Seam S;
            da::prime(cur, (char*)lds_raw, S, F.wave);
            for (;;) {
                int ni = ii, np = pass + 1; if (np == npass) { np = 0; ni = ii + 1; }
                const bool last = ni >= nit * PROBE_DUP_ATTN;
                const da::BlockRef nxt = last ? cur : da::mkref(Z, AO, ctl + CW_KMX, ITEM_OF(ni % nit), np);
                da::block(cur, nxt, (char*)lds_raw, S, lam, args.in[12], F.wave);
                if (last) break;
                cur = nxt; ii = ni; pass = np;
            }
        }
#undef ITEM_OF
        __syncthreads();
        {
            const int lane = lane_, w = F.wave;
            const int nun = (M / 128) * 4;
            const int ch0 = (lane & 15) * 8, t = 16 * w + (lane & 15), nks = (w + 2) >> 1;
            u32x4 vr[4];
            LAS int* sq = (LAS int*)(F.lds + 2 * 34816);
            const bool puller = (w == 0 && lane == 0);
            if (puller) { sq[0] = (int)atomicAdd(ctl + CW_SGUQ, 1u); sq[1] = (int)atomicAdd(ctl + CW_SGUQ, 1u); }
            __syncthreads();
            int uidx = __builtin_amdgcn_readfirstlane(sq[0]), unext = __builtin_amdgcn_readfirstlane(sq[1]), kk = 0;
            if (uidx < nun) { const size_t R0 = (size_t)(uidx >> 2) * 128; const int g = uidx & 3;
#pragma unroll
                for (int ps = 0; ps < 4; ++ps) vr[ps] = *(const u32x4*)(Z + (R0 + 16 * w + 4 * ps + (lane >> 4)) * ZP + ZV + g * 128 + ch0); }
            int gcur = -1; float lg[8], lb[8]; bf16x8 wf[4]; float bias = 0.f; int buf = 0;
#pragma unroll
            for (int j = 0; j < 8; ++j) { lg[j] = 0.f; lb[j] = 0.f; }
#pragma unroll
            for (int ks = 0; ks < 4; ++ks) wf[ks] = (bf16x8){0, 0, 0, 0, 0, 0, 0, 0};
            for (; uidx < nun; uidx = unext, unext = __builtin_amdgcn_readfirstlane(sq[(kk + 1) & 3]), buf ^= 1) {
                int pulled_ = 0; if (puller) pulled_ = (int)atomicAdd(ctl + CW_SGUQ, 1u);
                const int c = uidx >> 2, g = uidx & 3; const size_t R0 = (size_t)c * 128;
                LAS bf16_t* vnT = (LAS bf16_t*)(F.lds + buf * 34816);
                if (g != gcur) { gcur = g;
#pragma unroll
                    for (int j = 0; j < 8; ++j) { lg[j] = args.in[4][g * 128 + ch0 + j]; lb[j] = args.in[5][g * 128 + ch0 + j]; }
#pragma unroll
                    for (int ks = 0; ks < 4; ++ks) if (ks < nks) wf[ks] = *(const bf16x8*)(Wsgu + ((size_t)g * 128 + t) * 128 + ks * 32 + 8 * (lane >> 4));
                    bias = args.in[7][g * 128 + t]; }
#pragma unroll
                for (int ps = 0; ps < 4; ++ps) { const int sr = 16 * w + 4 * ps + (lane >> 4); const u32x4 raw = vr[ps];
                    float v[8] = {bf_lo(raw.x), bf_hi(raw.x), bf_lo(raw.y), bf_hi(raw.y), bf_lo(raw.z), bf_hi(raw.z), bf_lo(raw.w), bf_hi(raw.w)};
                    float sm = 0.f;
#pragma unroll
                    for (int j = 0; j < 8; ++j) sm += v[j];
#pragma unroll
                    for (int o = 1; o < 16; o <<= 1) sm += __shfl_xor(sm, o);
                    const float mu = sm * (1.f / 128.f); float q = 0.f;
#pragma unroll
                    for (int j = 0; j < 8; ++j) { v[j] -= mu; q += v[j] * v[j]; }
#pragma unroll
                    for (int o = 1; o < 16; o <<= 1) q += __shfl_xor(q, o);
                    const float rstd = __builtin_amdgcn_rsqf(q * (1.f / 128.f) + LN_EPS);
#pragma unroll
                    for (int j = 0; j < 8; ++j) { const float y = v[j] * rstd * lg[j] + lb[j]; vnT[(ch0 + j) * 136 + sr] = (bf16_t)(cvt_pk_bf16(y, 0.f) & 0xffffu); } }
                u32x2 ur[8];
#pragma unroll
                for (int mi = 0; mi < 8; ++mi) ur[mi] = *(const u32x2*)(Z + (R0 + t) * ZP + ZU + g * 128 + 16 * mi + 4 * (lane >> 4));
                { const int un = unext; if (un < nun) { const size_t Rn = (size_t)(un >> 2) * 128; const int gn = un & 3;
#pragma unroll
                    for (int ps = 0; ps < 4; ++ps) vr[ps] = *(const u32x4*)(Z + (Rn + 16 * w + 4 * ps + (lane >> 4)) * ZP + ZV + gn * 128 + ch0); } }
                if (puller) sq[(kk + 2) & 3] = pulled_;
                ++kk;
                __syncthreads();
                f32x4 acc[8];
#pragma unroll
                for (int mi = 0; mi < 8; ++mi) acc[mi] = (f32x4){0.f, 0.f, 0.f, 0.f};
#pragma unroll
                for (int ks = 0; ks < 4; ++ks) if (ks < nks) {
#pragma unroll
                    for (int mi = 0; mi < 8; ++mi) { const bf16x8 afr = *(const LAS bf16x8*)(vnT + (16 * mi + (lane & 15)) * 136 + ks * 32 + 8 * (lane >> 4));
                        acc[mi] = __builtin_amdgcn_mfma_f32_16x16x32_bf16(afr, wf[ks], acc[mi], 0, 0, 0); } }
#pragma unroll
                for (int mi = 0; mi < 8; ++mi) { const int ch = 16 * mi + 4 * (lane >> 4); const u32x2 u2 = ur[mi];
                    const float o0 = bf_lo(u2.x) * (acc[mi][0] + bias), o1 = bf_hi(u2.x) * (acc[mi][1] + bias), o2 = bf_lo(u2.y) * (acc[mi][2] + bias), o3 = bf_hi(u2.y) * (acc[mi][3] + bias);
                    u32x2 wv; wv.x = cvt_pk_bf16(o0, o1); wv.y = cvt_pk_bf16(o2, o3);
                    *(u32x2*)(AO + (R0 + t) * DM + g * 128 + ch) = wv; }
            }
            __syncthreads();
        }
        {
            int e = -1;
            if (F.G == 256) { const int b = F.vcu >> 5, r = F.vcu & 31; if (r >= 16 && r < 24) e = b * 8 + (r - 16); }
            for (int e2 = (F.G == 256 ? e : F.vcu); e2 >= 0 && e2 < 64; e2 = (F.G == 256 ? 64 : e2 + F.G)) {
                pg8::Gemm g{DM, DM, DM}; pg8::OneUnitSched S;
                if (e2 < 32) { S.u0.pm = e2 >> 2; S.u0.pn = e2 & 3; S.u0.aux = 0; S.u0.rows = nullptr; S.u0.A = (const char*)(memn + (size_t)S.u0.pm * 256 * DM); S.u0.B = (const char*)(Wkv_t + (size_t)S.u0.pn * 256 * DM);
                    pg8::EpiBf16 E{Km, DM, nullptr, 1.f}; pg8::gemm_phase(F.lds, F.wave, g, S, E); }
                else { const int e3 = e2 - 32; S.u0.pm = e3 >> 3; S.u0.pn = e3 & 7; S.u0.aux = 0; S.u0.rows = nullptr; S.u0.A = (const char*)(Wkv_t + (size_t)(1024 + S.u0.pm * 256) * DM); S.u0.B = (const char*)(memn + (size_t)S.u0.pn * 256 * DM);
                    pg8::EpiBf16 E{Vt, MROWS, nullptr, 1.f}; pg8::gemm_phase(F.lds, F.wave, g, S, E); }
            }
        }
    }
    GRID_BAR(2);

    if (IN(3)) {
        pg8::Gemm g{DM, DM, DM}; pg8::PlainSched S; S.to.init(M / 256, 4, F.G, (int)blockIdx.x); S.A = (const char*)AO; S.B = (const char*)Wout_t; S.tA = (size_t)256 * DM * 2; S.tB = (size_t)256 * DM * 2;
        pg8::EpiResid<false> E{x, x1b, ssq1, (LAS float*)(F.lds + 131072 + 1024), nullptr}; pg8::gemm_phase(F.lds, F.wave, g, S, E);
    }
    GRID_BAR(3);

    if (IN(4)) {
        pg8::Gemm g{DM, DM, DM}; pg8::PlainSched S; S.to.init(M / 256, 4, F.G, (int)blockIdx.x); S.A = (const char*)x1b; S.B = (const char*)Wq_t; S.tA = (size_t)256 * DM * 2; S.tB = (size_t)256 * DM * 2;
        pg8::EpiBf16 E{Qm, DM, ssq1, C2_MEM}; pg8::gemm_phase(F.lds, F.wave, g, S, E);
    }
    if (MK_ONE_LAUNCH && IN(4) && IN(5)) LOCAL_SEAM();

    if (IN(5)) {
        pg8::Gemm g{DM, DM, 256}; pg8::MemAttnSched S; S.to.init(M / 256, 4, F.G, (int)blockIdx.x); S.A = (const char*)Qm; S.B = (const char*)Km; S.bB = (size_t)256 * DM * 2; S.hB = 512;
        pg8::EpiSoftmax E{Sc, (LAS float*)(F.lds + LDS_MISC + 1024)}; pg8::gemm_phase(F.lds, F.wave, g, S, E);
    }
    if (MK_ONE_LAUNCH && IN(5) && IN(6 + 1)) LOCAL_SEAM();

    if (IN(7)) {
        pg8::Gemm g{DM, MROWS, 256}; pg8::MemAttnSched S; S.to.init(M / 256, 4, F.G, (int)blockIdx.x); S.A = (const char*)Sc; S.B = (const char*)Vt; S.bB = 512; S.hB = (size_t)256 * MROWS * 2;
        pg8::EpiBf16 E{Om, DM, nullptr, 1.f}; pg8::gemm_phase(F.lds, F.wave, g, S, E);
    }
    GRID_BAR(7);

    if (IN(8)) {
        pg8::Gemm g{DM, DM, DM}; pg8::PlainSched S; S.to.init(M / 256, 4, F.G, (int)blockIdx.x); S.A = (const char*)Om; S.B = (const char*)Wo_t; S.tA = (size_t)256 * DM * 2; S.tB = (size_t)256 * DM * 2;
        pg8::EpiResid<true> E{x1b, x2b, ssq2, (LAS float*)(F.lds + 131072 + 1024), x2f8}; pg8::gemm_phase(F.lds, F.wave, g, S, E);
    }
    GRID_BAR(8);

    if (IN(9)) {
        pg8::Gemm g{DM, DM, DM}; pg8::PlainSched S; S.to.init(M / 256, 1, F.G, (int)blockIdx.x); S.A = (const char*)x2b; S.B = (const char*)Wr_t; S.tA = (size_t)256 * DM * 2; S.tB = 0;
        pg8::EpiRouter E{logit, ssq2, args.in[21], args.in[23], rstd2}; pg8::gemm_phase(F.lds, F.wave, g, S, E);
    }
    GRID_BAR(9);

    if (IN(10)) {
        const int lane_ = lane_id(), tid_ = F.wave * 64 + lane_; (void)tid_;
        LAS unsigned* lcnt = (LAS unsigned*)F.lds; LAS unsigned* lbase = lcnt + 32;
        for (int t0 = blockIdx.x * NTHR; t0 < M; t0 += F.G * NTHR) {
            if (tid_ < 32) lcnt[tid_] = 0u;
            __syncthreads();
            const int tok = t0 + tid_;
            const f32x4 lg = *(const f32x4*)(logit + (size_t)tok * 64);
            int gi = 0; float gm = lg[0];
#pragma unroll
            for (int j = 1; j < 4; ++j) if (lg[j] > gm) { gm = lg[j]; gi = j; }
            float gs = 0.f;
#pragma unroll
            for (int j = 0; j < 4; ++j) gs += __expf(lg[j] - gm);
            const float gate = 1.0f / gs;
            const f32x4 ea = *(const f32x4*)(logit + (size_t)tok * 64 + 4 + gi * 8), eb = *(const f32x4*)(logit + (size_t)tok * 64 + 8 + gi * 8);
            const float el[8] = {ea[0], ea[1], ea[2], ea[3], eb[0], eb[1], eb[2], eb[3]};
            int i0 = 0; float m0 = el[0];
#pragma unroll
            for (int j = 1; j < 8; ++j) if (el[j] > m0) { m0 = el[j]; i0 = j; }
            int i1 = -1; float m1 = -__builtin_inff();
#pragma unroll
            for (int j = 0; j < 8; ++j) if (j != i0 && el[j] > m1) { m1 = el[j]; i1 = j; }
            if (i1 < 0) i1 = (i0 == 0) ? 1 : 0;
            const float r = __expf(m1 - m0);
            const float w0 = gate / (1.0f + r), w1 = gate * r / (1.0f + r);
            const int e0 = gi * 8 + i0, e1 = gi * 8 + i1;
            const unsigned r0 = atomicAdd((unsigned*)&lcnt[e0], 1u), r1 = atomicAdd((unsigned*)&lcnt[e1], 1u);
            __syncthreads();
            if (tid_ < 32) lbase[tid_] = atomicAdd(ctl + CW_CNT + tid_, lcnt[tid_]);
            __syncthreads();
            tok_e[tok * 2] = e0; tok_e[tok * 2 + 1] = e1; tok_w[tok * 2] = w0; tok_w[tok * 2 + 1] = w1;
            tok_s[tok * 2] = (int)(lbase[e0] + r0); tok_s[tok * 2 + 1] = (int)(lbase[e1] + r1);
            __syncthreads();
        }
    }
    GRID_BAR(10);

    if (IN(11)) {
        const int lane_ = lane_id(), tid_ = F.wave * 64 + lane_; (void)tid_;
        LAS unsigned* lps = (LAS unsigned*)F.lds;
        if (tid_ == 0) { unsigned acc = 0; for (int e = 0; e < 32; ++e) { lps[e] = acc; const unsigned c = ld_u32_agent(ctl + CW_CNT + e); acc += (c + 255u) & ~255u; } lps[32] = acc; }
        __syncthreads();
        if (blockIdx.x == 0) {
            if (tid_ < 32) { const unsigned s = lps[tid_], e2 = lps[tid_ + 1], c = ld_u32_agent(ctl + CW_CNT + tid_);
                for (unsigned b = s >> 8; b < (e2 >> 8); ++b) ctl[CW_BLKE + b] = (unsigned)tid_;
                for (unsigned r = s + c; r < e2; ++r) { row_tok[r] = 0; rowrs[r] = 0.f; } }
            if (tid_ == 0) ctl[CW_NBLK] = lps[32] >> 8;
        }
        for (int a = blockIdx.x * NTHR + tid_; a < M * 2; a += F.G * NTHR) { const int e = tok_e[a]; const int pos = (int)lps[e] + tok_s[a]; row_tok[pos] = a >> 1; tok_s[a] = pos; rowrs[pos] = rstd2[a >> 1] * (1.0f / (F8_XSCALE * F8_WSCALE)); }
        __syncthreads();
    }
    GRID_BAR(11);

    if (IN(12)) {
        const int nblk = (int)__builtin_amdgcn_readfirstlane(ld_u32_agent(ctl + CW_NBLK));
        pg8::Gemm g{DM / 2, DM / 2, DM / 2}; pg8::MoeSched S{F.G, F.vcu, nblk, ctl + CW_BLKE, (const char*)x2f8, (const char*)Wgu_t, (size_t)0, (size_t)1024 * DM, (size_t)256 * DM, row_tok};
        pg8::EpiGateUp E{(unsigned char*)act, rowrs, row_tok}; pg8::gemm_phase<pg8::EpiGateUp, pg8::MoeSched, true, true>(F.lds, F.wave, g, S, E);
    }
    GRID_BAR(12);

    if (IN(13)) {
        const int nblk = (int)__builtin_amdgcn_readfirstlane(ld_u32_agent(ctl + CW_NBLK));
        pg8::Gemm g{DEXP / 2, DEXP / 2, DEXP / 2}; pg8::MoeSched S{F.G, F.vcu, nblk, ctl + CW_BLKE, (const char*)act, (const char*)Wd_t, (size_t)256 * DEXP, (size_t)1024 * DEXP, (size_t)256 * DEXP, row_tok};
        pg8::EpiBf16 E{yb, DM, nullptr, 1.0f / (F8_WSCALE * F8_ASCALE)}; pg8::gemm_phase<pg8::EpiBf16, pg8::MoeSched, false, true>(F.lds, F.wave, g, S, E);
    }
    GRID_BAR(13);

    if (IN(14)) {
        const int lane_ = lane_id(), tid_ = F.wave * 64 + lane_; (void)tid_;
        const f32x4* gr = (const f32x4*)args.in[27] + lane_;
        f32x4 gg[4];
#pragma unroll
        for (int j = 0; j < 4; ++j) gg[j] = gr[64 * j];
        for (int m = gw; m < M; m += 2 * NGW) {
            const int ma = m, mb = m + NGW;
            const int pa0 = tok_s[ma * 2], pa1 = tok_s[ma * 2 + 1], pb0 = tok_s[mb * 2], pb1 = tok_s[mb * 2 + 1];
            const float wa0 = tok_w[ma * 2], wa1 = tok_w[ma * 2 + 1], wb0 = tok_w[mb * 2], wb1 = tok_w[mb * 2 + 1];
            const u32x2* xa = (const u32x2*)(x2b + (size_t)ma * DM) + lane_; const u32x2* xb = (const u32x2*)(x2b + (size_t)mb * DM) + lane_;
            const u32x2* ya0 = (const u32x2*)(yb + (size_t)pa0 * DM) + lane_; const u32x2* ya1 = (const u32x2*)(yb + (size_t)pa1 * DM) + lane_;
            const u32x2* yb0 = (const u32x2*)(yb + (size_t)pb0 * DM) + lane_; const u32x2* yb1 = (const u32x2*)(yb + (size_t)pb1 * DM) + lane_;
            u32x2 ca[4], cb[4], a0[4], a1[4], b0[4], b1[4];
#pragma unroll
            for (int j = 0; j < 4; ++j) { ca[j] = xa[64 * j]; cb[j] = xb[64 * j]; a0[j] = ya0[64 * j]; a1[j] = ya1[64 * j]; b0[j] = yb0[64 * j]; b1[j] = yb1[64 * j]; }
            f32x4 va[4], vb[4]; float sa = 0.f, sb = 0.f;
#pragma unroll
            for (int j = 0; j < 4; ++j) {
                va[j].x = bf_lo(ca[j].x) + wa0 * bf_lo(a0[j].x) + wa1 * bf_lo(a1[j].x); va[j].y = bf_hi(ca[j].x) + wa0 * bf_hi(a0[j].x) + wa1 * bf_hi(a1[j].x);
                va[j].z = bf_lo(ca[j].y) + wa0 * bf_lo(a0[j].y) + wa1 * bf_lo(a1[j].y); va[j].w = bf_hi(ca[j].y) + wa0 * bf_hi(a0[j].y) + wa1 * bf_hi(a1[j].y);
                vb[j].x = bf_lo(cb[j].x) + wb0 * bf_lo(b0[j].x) + wb1 * bf_lo(b1[j].x); vb[j].y = bf_hi(cb[j].x) + wb0 * bf_hi(b0[j].x) + wb1 * bf_hi(b1[j].x);
                vb[j].z = bf_lo(cb[j].y) + wb0 * bf_lo(b0[j].y) + wb1 * bf_lo(b1[j].y); vb[j].w = bf_hi(cb[j].y) + wb0 * bf_hi(b0[j].y) + wb1 * bf_hi(b1[j].y);
                sa += (va[j].x * va[j].x + va[j].y * va[j].y) + (va[j].z * va[j].z + va[j].w * va[j].w); sb += (vb[j].x * vb[j].x + vb[j].y * vb[j].y) + (vb[j].z * vb[j].z + vb[j].w * vb[j].w); }
            const float ra = __builtin_amdgcn_rsqf(wave_sum(sa) * (1.f / DM) + RMS_EPS), rb = __builtin_amdgcn_rsqf(wave_sum(sb) * (1.f / DM) + RMS_EPS);
            f32x4* oa = (f32x4*)(out + (size_t)ma * DM) + lane_; f32x4* ob = (f32x4*)(out + (size_t)mb * DM) + lane_;
#pragma unroll
            for (int j = 0; j < 4; ++j) { oa[64 * j] = va[j] * ra * gg[j]; ob[64 * j] = vb[j] * rb * gg[j]; }
        }
    }
#undef IN
#undef GRID_BAR
}

extern "C" void kernel_launch(void* const* d_in, const int* in_sizes, int n_in, void* d_out, int out_size, void* d_ws, size_t ws_size, hipStream_t stream) {
    static int grid = 0;
    if (grid == 0) {
        if (n_in != 28 || in_sizes[0] != M * DM || out_size != M * DM || ws_size < WS_END) { fprintf(stderr, "kernel_launch: unexpected shapes (n_in %d in0 %d out %d ws %zu)\n", n_in, n_in > 0 ? in_sizes[0] : -1, out_size, ws_size); grid = -1; return; }
        int dev = 0, cus = 0, per_cu = 0;
        if (hipGetDevice(&dev) != hipSuccess || hipDeviceGetAttribute(&cus, hipDeviceAttributeMultiprocessorCount, dev) != hipSuccess) { grid = -1; return; }
        if (hipFuncSetAttribute((const void*)mega, hipFuncAttributeMaxDynamicSharedMemorySize, LDS_BYTES) != hipSuccess) { fprintf(stderr, "kernel_launch: hipFuncSetAttribute failed\n"); grid = -1; return; }
        if (hipOccupancyMaxActiveBlocksPerMultiprocessor(&per_cu, (const void*)mega, NTHR, LDS_BYTES) != hipSuccess || per_cu < 1) { fprintf(stderr, "kernel_launch: occupancy query says %d\n", per_cu); per_cu = 1; }
        (void)hipGetLastError();
        grid = cus;
    }
    if (grid < 0) return;
    (void)hipMemsetAsync((char*)d_ws + WS_CTL, 0, CTL_BYTES, stream);
    Args a{};
    for (int i = 0; i < 28; ++i) a.in[i] = (const float*)d_in[i];
    a.out = (float*)d_out; a.ws = (unsigned char*)d_ws;
#if MK_ONE_LAUNCH
    a.ph_lo = 0; a.ph_hi = N_PHASES;
    void* kargs[] = {&a};
    hipError_t e = hipLaunchCooperativeKernel((const void*)mega, dim3(grid), dim3(NTHR), kargs, LDS_BYTES, stream);
    if (e != hipSuccess) fprintf(stderr, "cooperative launch failed: %s (grid %d)\n", hipGetErrorString(e), grid);
#else
    for (int p = 0; p < N_PHASES; ++p) { a.ph_lo = p; a.ph_hi = p + 1; hipLaunchKernelGGL(mega, dim3(grid), dim3(NTHR), LDS_BYTES, stream, a); }
#endif
}
```

```cpp
#include <hip/hip_runtime.h>
#include <hip/hip_cooperative_groups.h>
#include <cstdio>
#include <cstdint>
namespace cg = cooperative_groups;

#ifndef PROBE_DUP
#define PROBE_DUP -1
#endif
#ifndef PROBE_DUP_ATTN
#define PROBE_DUP_ATTN 1
#endif
#ifndef MK_ONE_LAUNCH
#define MK_ONE_LAUNCH 1
#endif

#define LAS __attribute__((address_space(3)))
#define GAS __attribute__((address_space(1)))
typedef unsigned short bf16_t;
typedef short bf16x8 __attribute__((ext_vector_type(8)));
typedef short s16x4 __attribute__((ext_vector_type(4)));
typedef float f32x2 __attribute__((ext_vector_type(2)));
typedef float f32x4 __attribute__((ext_vector_type(4)));
typedef float f32x16 __attribute__((ext_vector_type(16)));
typedef unsigned u32x2 __attribute__((ext_vector_type(2)));
typedef unsigned u32x4 __attribute__((ext_vector_type(4)));
typedef int v8i32 __attribute__((ext_vector_type(8)));

constexpr int NB = 8, SEQ = 8192, DM = 1024, M = NB * SEQ;
constexpr int ZP = 2560;
constexpr int ZU = 0, ZV = 512, ZQ = 1024, ZK = 1536, ZVAL = 2048;
constexpr int MEML = 256, MROWS = NB * MEML;
constexpr int NEXP = 32, DEXP = 512;
constexpr int PROWS = 2 * M + NEXP * 256;
constexpr int MAXBLK = PROWS / 256;
constexpr float RMS_EPS = 1e-6f, LN_EPS = 1e-5f;
constexpr float LOG2E = 1.4426950408889634f;
constexpr float C2_DIFF = 0.125f * LOG2E;
constexpr float C2_MEM = 0.0625f * LOG2E;

constexpr size_t MiB = 1u << 20;
constexpr size_t WS_CTL = 0, CTL_BYTES = 1 * MiB;
constexpr size_t WS_WIN = 1 * MiB;
constexpr size_t WS_WOUT = 6 * MiB;
constexpr size_t WS_WQ = 8 * MiB;
constexpr size_t WS_WKV = 10 * MiB;
constexpr size_t WS_WO = 14 * MiB;
constexpr size_t WS_WR = 16 * MiB;
constexpr size_t WS_WSGU = 17 * MiB;
constexpr size_t WS_MEMN = 18 * MiB;
constexpr size_t WS_KM = 22 * MiB;
constexpr size_t WS_VT = 26 * MiB;
constexpr size_t WS_WGU = 30 * MiB;
constexpr size_t WS_WD = 94 * MiB;
constexpr size_t WS_RA = 128 * MiB;
constexpr size_t WS_RB = 448 * MiB;
constexpr size_t WS_RC = 592 * MiB;
constexpr size_t WS_SSQ1 = 720 * MiB;
constexpr size_t WS_SSQ2 = 724 * MiB;
constexpr size_t WS_LOGIT = 728 * MiB;
constexpr size_t WS_TOKE = 744 * MiB;
constexpr size_t WS_TOKW = 745 * MiB;
constexpr size_t WS_TOKS = 746 * MiB;
constexpr size_t WS_ROWTOK = 747 * MiB;
constexpr size_t WS_X2F8 = 752 * MiB;
constexpr size_t WS_END = 816 * MiB;
constexpr int CW_CNT = 64;
constexpr int CW_NBLK = 128;
constexpr int CW_PSTART = 192;
constexpr int CW_BLKE = 256;
constexpr int CW_KMX = 1024;
constexpr int CW_SGUQ = 1344;
constexpr int CW_BAR = 4096;
constexpr int LDS_MISC = 131072;
constexpr int LDS_TBUF = 140288, TBUF_W = 2304;

__device__ __forceinline__ unsigned cvt_pk_bf16(float lo, float hi) { unsigned r; asm volatile("v_cvt_pk_bf16_f32 %0, %1, %2" : "=v"(r) : "v"(lo), "v"(hi)); return r; }
__device__ __forceinline__ float bf_lo(unsigned w) { return __uint_as_float(w << 16); }
__device__ __forceinline__ float bf_hi(unsigned w) { return __uint_as_float(w & 0xffff0000u); }
constexpr float F8_WSCALE = 256.f, F8_ASCALE = 8.f, F8_XSCALE = 4.f, F8_OSCALE = 16.f;
__device__ __forceinline__ unsigned pk4_fp8(float a, float b, float c, float d) {
    a = fminf(fmaxf(a, -448.f), 448.f); b = fminf(fmaxf(b, -448.f), 448.f); c = fminf(fmaxf(c, -448.f), 448.f); d = fminf(fmaxf(d, -448.f), 448.f);
    int w = 0; w = __builtin_amdgcn_cvt_pk_fp8_f32(a, b, w, false); w = __builtin_amdgcn_cvt_pk_fp8_f32(c, d, w, true); return (unsigned)w; }
__device__ __forceinline__ float wave_sum(float v) {
#pragma unroll
    for (int o = 1; o < 64; o <<= 1) v += __shfl_xor(v, o);
    return v;
}
__device__ __forceinline__ float wave_max(float v) {
#pragma unroll
    for (int o = 1; o < 64; o <<= 1) v = fmaxf(v, __shfl_xor(v, o));
    return v;
}
__device__ __forceinline__ int lane_id() { int l; asm volatile("v_mbcnt_lo_u32_b32 %0, -1, 0\n\tv_mbcnt_hi_u32_b32 %0, -1, %0" : "=v"(l)); return l; }
__device__ __forceinline__ unsigned ld_u32_agent(const unsigned* p) { return __hip_atomic_load(p, __ATOMIC_RELAXED, __HIP_MEMORY_SCOPE_AGENT); }

namespace pg8 {
constexpr int BM = 256, BK = 64, HALF = 128, HTB = HALF * BK * 2, STAGE_BYTES = 8 * HTB, NXCD = 8, WGM = 8;
__host__ __device__ __forceinline__ int lds_byte(int r, int c) { const int st = (r >> 4) * 2 + (c >> 5), rr = r & 15, cc = c & 31, ob = rr * 64 + cc * 2; return st * 1024 + (ob ^ (((ob >> 9) & 1) << 5)); }
__host__ __device__ __forceinline__ void stage_rc(int b, int& R, int& C) { const int st = b / 1024, sb = b % 1024, swz = sb ^ (((sb >> 9) & 1) << 5); R = (st >> 1) * 16 + swz / 64; C = (st & 1) * 32 + (swz % 64) / 2; }
__host__ __device__ __forceinline__ int perm32(int rho) { const int n = rho >> 4, i = rho & 15; return 8 * (i >> 2) + 4 * n + (i & 3); }

struct Unit { const char* A; const char* B; int pm, pn, aux; const int* rows; };
struct Gemm { int lda, ldb, K; };

struct TileOrder {
    int nM, nN, nwg, G, c;
    __device__ void init(int nM_, int nN_, int G_, int c_) { nM = nM_; nN = nN_; nwg = nM * nN; G = G_; c = c_; }
    __device__ bool get(int i, int& pm, int& pn) const {
        const long L = (long)i * G + c; if (L >= nwg) return false;
        int wgid = (int)L; { const int q = nwg / NXCD, r = nwg % NXCD, xcd = wgid % NXCD, off = wgid / NXCD; wgid = (xcd < r ? xcd * (q + 1) : r * (q + 1) + (xcd - r) * q) + off; }
        const int nig = WGM * nN, gid = wgid / nig, fm = gid * WGM, gsz = (nM - fm) < WGM ? (nM - fm) : WGM;
        pm = fm + ((wgid % nig) % gsz); pn = (wgid % nig) / gsz; return true;
    }
};

typedef float f32x2g __attribute__((ext_vector_type(2)));
__device__ __forceinline__ f32x2g gelu_pk(f32x2g v) {
    const f32x2g av = __builtin_elementwise_abs(v), d = av * 0.2316418882f + 1.0f;
    f32x2g t; t.x = __builtin_amdgcn_rcpf(d.x); t.y = __builtin_amdgcn_rcpf(d.y);
    f32x2g q = t * 0.5307027145f + (-0.7265760135f); q = q * t + 0.7107068705f; q = q * t + (-0.142248368f); q = q * t + 0.127414796f; q = q * t;
    const f32x2g s = (v * v) * (-0.72134752044f);
    f32x2g e; e.x = __builtin_amdgcn_exp2f(s.x); e.y = __builtin_amdgcn_exp2f(s.y);
    const f32x2g m = v * (q * e), r = v - m;
    f32x2g o; o.x = v.x < 0.f ? m.x : r.x; o.y = v.y < 0.f ? m.y : r.y; return o;
}

__device__ __forceinline__ const char* uniform_ptr(const char* p) { const unsigned long long v = (unsigned long long)p; const unsigned lo = __builtin_amdgcn_readfirstlane((unsigned)v), hi = __builtin_amdgcn_readfirstlane((unsigned)(v >> 32)); return (const char*)(((unsigned long long)hi << 32) | lo); }
template <class Epi, class Sched, bool GATHER = false, bool FP8 = false>
__device__ __forceinline__ void gemm_phase(LAS unsigned char* lds, int wid, const Gemm g, const Sched& S, const Epi& E) {
    const int lane = lane_id(), tid = wid * 64 + lane, wr = wid >> 2, wc = wid & 3, fr = lane & 15, fq = lane >> 4;
    const int nt = g.K / BK;
    unsigned voffB[2]; unsigned vA0[2], vA1[2]; int RA[2], CA[2];
#pragma unroll
    for (int i = 0; i < 2; ++i) { int R, C; stage_rc(tid * 16 + i * 8192, R, C); const int pr = Epi::PERM ? perm32(R & 31) : (R & 31);
        RA[i] = R; CA[i] = C; voffB[i] = (unsigned)((64 * (R >> 5) + pr) * g.ldb + C) * 2u;
        vA0[i] = (unsigned)(R * g.lda + C) * 2u; vA1[i] = vA0[i]; }
    const size_t kstep = (size_t)(BK * 2);
    const size_t hstepA = GATHER ? (size_t)0 : (size_t)HALF * g.lda * 2, hstepB = (size_t)32 * g.ldb * 2;
    LAS u32x4* park = (LAS u32x4*)(lds + 131072 + 1024) + tid;
#define PG8_GOFF(U, d0, d1) do { _Pragma("unroll") for (int _i = 0; _i < 2; ++_i) { \
        d0[_i] = ((unsigned)(U).rows[RA[_i]] * (unsigned)g.lda + (unsigned)CA[_i]) * 2u; d1[_i] = ((unsigned)(U).rows[HALF + RA[_i]] * (unsigned)g.lda + (unsigned)CA[_i]) * 2u; } } while (0)
    const unsigned ldsw = (unsigned)wid * 1024u;
    const int aoff = lds_byte(wr * 64 + fr, fq * 8), boff = lds_byte(wc * 32 + fr, fq * 8);
#define PG8_SA(b, h) (((b) * 2 + (h)) * HTB)
#define PG8_SB(b, h) ((4 + (b) * 2 + (h)) * HTB)
#define PG8_STAGE(bufoff, gbase, voff) do { _Pragma("unroll") for (int _i = 0; _i < 2; ++_i) \
        __builtin_amdgcn_global_load_lds((const unsigned*)((const char*)(gbase) + (voff)[_i]), (LAS unsigned*)(lds + (bufoff) + ldsw + _i * 8192), 16, 0, 0); } while (0)
#define PG8_LD8(dst_, addr_) do { const u32x4 lo_ = *(const LAS u32x4*)(addr_), hi_ = *(const LAS u32x4*)((addr_) + 1024); \
        dst_ = (v8i32){(int)lo_.x, (int)lo_.y, (int)lo_.z, (int)lo_.w, (int)hi_.x, (int)hi_.y, (int)hi_.z, (int)hi_.w}; } while (0)
#define PG8_LDA(dst, b, h) do { _Pragma("unroll") for (int m = 0; m < 4; ++m) PG8_LD8(dst[m], lds + PG8_SA(b, h) + aoff + m * 2048); } while (0)
#define PG8_LDB(dst, b, h) do { _Pragma("unroll") for (int n = 0; n < 2; ++n) PG8_LD8(dst[n], lds + PG8_SB(b, h) + boff + n * 2048); } while (0)
#define PG8_HALF(v_, k_) __builtin_bit_cast(bf16x8, __builtin_shufflevector(v_, v_, 4 * (k_) + 0, 4 * (k_) + 1, 4 * (k_) + 2, 4 * (k_) + 3))
#define PG8_MMA(ai, bj, At, Bt) do { __builtin_amdgcn_s_setprio(1); _Pragma("unroll") for (int m = 0; m < 4; ++m) _Pragma("unroll") for (int n = 0; n < 2; ++n) { \
        if constexpr (FP8) asm volatile("v_mfma_scale_f32_16x16x128_f8f6f4 %0, %1, %2, %0, %3, %3 op_sel_hi:[0,0,0]" : "+v"(acc[ai][bj][m][n]) : "v"(Bt[n]), "v"(At[m]), "v"(one8_));   \
        else { acc[ai][bj][m][n] = __builtin_amdgcn_mfma_f32_16x16x32_bf16(PG8_HALF(Bt[n], 0), PG8_HALF(At[m], 0), acc[ai][bj][m][n], 0, 0, 0); \
               acc[ai][bj][m][n] = __builtin_amdgcn_mfma_f32_16x16x32_bf16(PG8_HALF(Bt[n], 1), PG8_HALF(At[m], 1), acc[ai][bj][m][n], 0, 0, 0); } } \
        __builtin_amdgcn_s_setprio(0); } while (0)
#define PG8_WAIT_V(n) asm volatile("s_waitcnt vmcnt(" #n ")" ::: "memory")
#define PG8_WAIT_L(n) asm volatile("s_waitcnt lgkmcnt(" #n ")" ::: "memory")
#define PG8_BAR __builtin_amdgcn_s_barrier()
#define PG8_SCHED __builtin_amdgcn_sched_barrier(0)
    Unit cur, nxt; int ui = 0;
    if (!S.next(0, cur)) return;
    f32x4 acc[2][2][4][2];
#pragma unroll
    for (int a = 0; a < 2; ++a)
#pragma unroll
        for (int b = 0; b < 2; ++b)
#pragma unroll
            for (int m = 0; m < 4; ++m)
#pragma unroll
                for (int n = 0; n < 2; ++n) acc[a][b][m][n] = (f32x4){0.f, 0.f, 0.f, 0.f};
    v8i32 At[4], B0[2], B1[2];
    const int one8_ = 0x7f7f7f7f;
    const char* cA = uniform_ptr(cur.A); const char* cB = uniform_ptr(cur.B);
    if constexpr (GATHER) { PG8_GOFF(cur, vA0, vA1); }
    PG8_STAGE(PG8_SB(0, 0), cB, voffB); PG8_STAGE(PG8_SB(0, 1), cB + hstepB, voffB); PG8_STAGE(PG8_SA(0, 0), cA, vA0); PG8_STAGE(PG8_SA(0, 1), cA + hstepA, vA1);
    if (wr == 1) PG8_BAR;
    PG8_WAIT_V(2); PG8_BAR;
    PG8_STAGE(PG8_SB(1, 0), cB + kstep, voffB); PG8_STAGE(PG8_SA(1, 0), cA + kstep, vA0); PG8_STAGE(PG8_SB(1, 1), cB + hstepB + kstep, voffB);
    PG8_WAIT_V(6); PG8_BAR;
    for (;;) {
        const bool has_next = S.next(ui + 1, nxt);
        const char* nA = has_next ? uniform_ptr(nxt.A) : cA; const char* nB = has_next ? uniform_ptr(nxt.B) : cB;
        if constexpr (GATHER) { unsigned n0[2] = {vA0[0], vA0[1]}, n1[2] = {vA1[0], vA1[1]}; if (has_next) { PG8_GOFF(nxt, n0, n1); } *park = (u32x4){n0[0], n0[1], n1[0], n1[1]}; }
#pragma nounroll
        for (int t = 0; t < nt; t += 2) {
            const bool last = (t == nt - 2);
            const char* a1 = cA + (size_t)(t + 1) * kstep;
            const char* a2 = uniform_ptr(last ? nA : cA + (size_t)(t + 2) * kstep); const char* b2 = uniform_ptr(last ? nB : cB + (size_t)(t + 2) * kstep);
            const char* a3 = a2 + kstep; const char* b3 = b2 + kstep;
            unsigned w0[2] = {vA0[0], vA0[1]}, w1[2] = {vA1[0], vA1[1]};
            if constexpr (GATHER) { if (last) { const u32x4 pk = *park; w0[0] = pk.x; w0[1] = pk.y; w1[0] = pk.z; w1[1] = pk.w; } }
            PG8_LDB(B0, 0, 0); PG8_LDB(B1, 0, 1); PG8_SCHED; PG8_LDA(At, 0, 0); PG8_STAGE(PG8_SA(1, 1), a1 + hstepA, vA1);
            PG8_WAIT_V(8); PG8_WAIT_L(0); PG8_BAR; PG8_MMA(0, 0, At, B0); PG8_MMA(0, 1, At, B1); PG8_BAR; PG8_SCHED;
            PG8_LDA(At, 0, 1); PG8_STAGE(PG8_SB(0, 0), b2, voffB); PG8_STAGE(PG8_SB(0, 1), b2 + hstepB, voffB); PG8_STAGE(PG8_SA(0, 0), a2, w0);
            PG8_WAIT_V(8); PG8_WAIT_L(0); PG8_BAR; PG8_MMA(1, 0, At, B0); PG8_MMA(1, 1, At, B1); PG8_BAR; PG8_SCHED;
            PG8_LDB(B0, 1, 0); PG8_LDB(B1, 1, 1); PG8_SCHED; PG8_LDA(At, 1, 0); PG8_STAGE(PG8_SA(0, 1), a2 + hstepA, w1);
            PG8_WAIT_V(8); PG8_WAIT_L(0); PG8_BAR; PG8_MMA(0, 0, At, B0); PG8_MMA(0, 1, At, B1); PG8_BAR; PG8_SCHED;
            PG8_LDA(At, 1, 1); PG8_STAGE(PG8_SB(1, 0), b3, voffB); PG8_STAGE(PG8_SB(1, 1), b3 + hstepB, voffB); PG8_STAGE(PG8_SA(1, 0), a3, w0);
            PG8_WAIT_V(8); PG8_WAIT_L(0); PG8_BAR; PG8_MMA(1, 0, At, B0); PG8_MMA(1, 1, At, B1); PG8_BAR; PG8_SCHED;
        }
        if (wr == 0) PG8_BAR;
        if constexpr (FP8) asm volatile("s_nop 15\n\ts_nop 7" ::: "memory");
        asm volatile("" ::: "memory");
        { const int l2_ = lane_id(); E(acc, cur, wr, wc, l2_ & 15, l2_ >> 4, lds + LDS_TBUF + wid * TBUF_W); }
        if (!has_next) break;
#pragma unroll
        for (int a = 0; a < 2; ++a)
#pragma unroll
            for (int b = 0; b < 2; ++b)
#pragma unroll
                for (int m = 0; m < 4; ++m)
#pragma unroll
                    for (int n = 0; n < 2; ++n) acc[a][b][m][n] = (f32x4){0.f, 0.f, 0.f, 0.f};
        cur = nxt; cA = nA; cB = nB; ++ui;
        if constexpr (GATHER) { const u32x4 pk = *park; vA0[0] = pk.x; vA0[1] = pk.y; vA1[0] = pk.z; vA1[1] = pk.w; }
        if (wr == 1) PG8_BAR;
    }
    PG8_WAIT_V(0);
    PG8_BAR;
#undef PG8_GOFF
#undef PG8_SA
#undef PG8_SB
#undef PG8_STAGE
#undef PG8_LD8
#undef PG8_HALF
#undef PG8_LDA
#undef PG8_LDB
#undef PG8_MMA
#undef PG8_WAIT_V
#undef PG8_WAIT_L
#undef PG8_BAR
#undef PG8_SCHED
}

struct PlainSched {
    TileOrder to; const char* A; const char* B; size_t tA, tB;
    __device__ __forceinline__ bool next(int i, Unit& u) const { int pm, pn; if (!to.get(i, pm, pn)) return false; u.pm = pm; u.pn = pn; u.aux = 0; u.rows = nullptr; u.A = A + (size_t)pm * tA; u.B = B + (size_t)pn * tB; return true; }
};
struct OneUnitSched {
    Unit u0;
    __device__ __forceinline__ bool next(int i, Unit& u) const { if (i != 0) return false; u = u0; return true; }
};
struct MemAttnSched {
    TileOrder to; const char* A; const char* B; size_t bB, hB;
    __device__ __forceinline__ bool next(int i, Unit& u) const { int pm, pn; if (!to.get(i, pm, pn)) return false; u.pm = pm; u.pn = pn; u.aux = 0; u.rows = nullptr;
        u.A = A + (size_t)pm * (256 * DM * 2) + (size_t)pn * 512; const int b = pm >> 5; u.B = B + (size_t)b * bB + (size_t)pn * hB; return true; }
};
struct MoeSched {
    int G, c, nblk; const unsigned* blk_e; const char* A; const char* B; size_t tA, eB, tB; const int* row_tok;
    __device__ __forceinline__ bool next(int i, Unit& u) const { const int L = i * G + c; if (L >= nblk * 4) return false; const int rb = L >> 2, pn = L & 3;
        const int e = (int)__builtin_amdgcn_readfirstlane(ld_u32_agent(blk_e + rb)); u.pm = rb; u.pn = pn; u.aux = e; u.rows = row_tok + (size_t)rb * 256;
        u.A = A + (size_t)rb * tA; u.B = B + (size_t)e * eB + (size_t)pn * tB; return true; }
};

#define EPI_ARGS f32x4 (&acc)[2][2][4][2], const Unit& u, int wr, int wc, int fr, int fq, LAS unsigned char* tb
__device__ __forceinline__ void st128(bf16_t* rowbase, size_t ldc, const u32x4 w0, const u32x4 w1, int fr, int fq, LAS unsigned char* tb) {
    *(LAS u32x4*)(tb + fr * 144 + fq * 16) = w0; *(LAS u32x4*)(tb + fr * 144 + 64 + fq * 16) = w1;
    const int L = fq * 16 + fr, r = L >> 3, c = L & 7;
    const u32x4 a = *(const LAS u32x4*)(tb + r * 144 + c * 16), b = *(const LAS u32x4*)(tb + (8 + r) * 144 + c * 16);
    *(u32x4*)(rowbase + (size_t)r * ldc + c * 8) = a; *(u32x4*)(rowbase + (size_t)(8 + r) * ldc + c * 8) = b;
}
__device__ __forceinline__ u32x4 pk8(const f32x4 v0, const f32x4 v1) { u32x4 w; w.x = cvt_pk_bf16(v0[0], v0[1]); w.y = cvt_pk_bf16(v0[2], v0[3]); w.z = cvt_pk_bf16(v1[0], v1[1]); w.w = cvt_pk_bf16(v1[2], v1[3]); return w; }
struct EpiZ {
    static constexpr bool PERM = true;
    bf16_t* O; unsigned* kmx;
    __device__ __forceinline__ void operator()(EPI_ARGS) const {
        const int mode = u.pn < 4 ? 1 : (u.pn < 6 ? 2 : 0);
        if (u.pn == 6 || u.pn == 7) {
#pragma unroll
            for (int bj = 0; bj < 2; ++bj) { float mx = 0.f;
#pragma unroll
                for (int ai = 0; ai < 2; ++ai)
#pragma unroll
                    for (int m = 0; m < 4; ++m) { const f32x4 a = acc[ai][bj][m][0], b = acc[ai][bj][m][1];
                        float q = (a[0] * a[0] + a[1] * a[1]) + (a[2] * a[2] + a[3] * a[3]) + (b[0] * b[0] + b[1] * b[1]) + (b[2] * b[2] + b[3] * b[3]);
                        q += __shfl_xor(q, 16); q += __shfl_xor(q, 32); mx = fmaxf(mx, q); }
#pragma unroll
                for (int o_ = 1; o_ < 16; o_ <<= 1) mx = fmaxf(mx, __shfl_xor(mx, o_));
                if (fr == 0 && fq == 0) { const int b_ = u.pm >> 5, h_ = (u.pn - 6) * 2 + (wc >> 1); atomicMax(kmx + (((b_ * 4 + h_) * 2 + (wc & 1)) * 2 + bj), __float_as_uint(mx)); } }
        }
#pragma unroll
        for (int ai = 0; ai < 2; ++ai)
#pragma unroll
            for (int m = 0; m < 4; ++m) { u32x4 w[2];
#pragma unroll
                for (int bj = 0; bj < 2; ++bj) { f32x4 v0 = acc[ai][bj][m][0], v1 = acc[ai][bj][m][1];
                    if (mode == 1) { f32x2g a = gelu_pk((f32x2g){v0[0], v0[1]}), b = gelu_pk((f32x2g){v0[2], v0[3]}), c = gelu_pk((f32x2g){v1[0], v1[1]}), d = gelu_pk((f32x2g){v1[2], v1[3]});
                        v0 = (f32x4){a.x, a.y, b.x, b.y}; v1 = (f32x4){c.x, c.y, d.x, d.y}; }
                    else if (mode == 2) { v0 = v0 * C2_DIFF; v1 = v1 * C2_DIFF; }
                    w[bj] = pk8(v0, v1); }
                st128(O + (size_t)(u.pm * BM + ai * HALF + wr * 64 + m * 16) * ZP + u.pn * BM + wc * 64, ZP, w[0], w[1], fr, fq, tb); }
    }
};
struct EpiBf16 {
    static constexpr bool PERM = true;
    bf16_t* O; int ldc; const float* ssq; float cscale;
    __device__ __forceinline__ void operator()(EPI_ARGS) const {
        float sc[2][4];
#pragma unroll
        for (int ai = 0; ai < 2; ++ai)
#pragma unroll
            for (int m = 0; m < 4; ++m) sc[ai][m] = cscale;
        if (ssq) {
#pragma unroll
            for (int ai = 0; ai < 2; ++ai)
#pragma unroll
                for (int m = 0; m < 4; ++m) { const f32x4 s4 = *(const f32x4*)(ssq + (size_t)(u.pm * BM + ai * HALF + wr * 64 + m * 16 + fr) * 4);
                    sc[ai][m] = cscale * __builtin_amdgcn_rsqf(((s4[0] + s4[1]) + (s4[2] + s4[3])) * (1.0f / DM) + RMS_EPS); }
        }
#pragma unroll
        for (int ai = 0; ai < 2; ++ai)
#pragma unroll
            for (int m = 0; m < 4; ++m) { const int rowg = u.pm * BM + ai * HALF + wr * 64 + m * 16; const float c = sc[ai][m];
                st128(O + (size_t)rowg * ldc + u.pn * BM + wc * 64, (size_t)ldc, pk8(acc[ai][0][m][0] * c, acc[ai][0][m][1] * c), pk8(acc[ai][1][m][0] * c, acc[ai][1][m][1] * c), fr, fq, tb); }
    }
};
struct EpiF8 {
    static constexpr bool PERM = true;
    unsigned char* O; float cscale;
    __device__ __forceinline__ void operator()(EPI_ARGS) const {
        const int L = fq * 16 + fr;
#pragma unroll
        for (int ai = 0; ai < 2; ++ai)
#pragma unroll
            for (int m = 0; m < 4; ++m) { const int rowg = u.pm * BM + ai * HALF + wr * 64 + m * 16;
#pragma unroll
                for (int bj = 0; bj < 2; ++bj) { const f32x4 a = acc[ai][bj][m][0] * cscale, b = acc[ai][bj][m][1] * cscale; u32x2 f; f.x = pk4_fp8(a[0], a[1], a[2], a[3]); f.y = pk4_fp8(b[0], b[1], b[2], b[3]);
                    *(LAS u32x2*)(tb + fr * 144 + bj * 32 + fq * 8) = f; }
                const u32x4 v8 = *(const LAS u32x4*)(tb + (L >> 2) * 144 + (L & 3) * 16);
                *(u32x4*)(O + (size_t)(rowg + (L >> 2)) * DM + u.pn * BM + wc * 64 + (L & 3) * 16) = v8; }
    }
};
struct EpiSoftmax {
    static constexpr bool PERM = true;
    bf16_t* O; LAS float* xch;
    __device__ __forceinline__ void operator()(EPI_ARGS) const {
        LAS float* xm = xch; LAS float* xs = xch + 1024;
#pragma unroll
        for (int ai = 0; ai < 2; ++ai)
#pragma unroll
            for (int m = 0; m < 4; ++m) { float v = -__builtin_inff();
#pragma unroll
                for (int bj = 0; bj < 2; ++bj)
#pragma unroll
                    for (int n = 0; n < 2; ++n) { const f32x4 a = acc[ai][bj][m][n]; v = fmaxf(v, fmaxf(fmaxf(a[0], a[1]), fmaxf(a[2], a[3]))); }
                v = fmaxf(v, __shfl_xor(v, 16)); v = fmaxf(v, __shfl_xor(v, 32));
                if (fq == 0) xm[(ai * HALF + wr * 64 + m * 16 + fr) * 4 + wc] = v; }
        asm volatile("s_waitcnt lgkmcnt(0)" ::: "memory"); __builtin_amdgcn_s_barrier(); asm volatile("" ::: "memory");
#pragma unroll
        for (int ai = 0; ai < 2; ++ai)
#pragma unroll
            for (int m = 0; m < 4; ++m) { const f32x4 t = *(const LAS f32x4*)(xm + (ai * HALF + wr * 64 + m * 16 + fr) * 4); const float mx = fmaxf(fmaxf(t[0], t[1]), fmaxf(t[2], t[3])); float sm = 0.f;
#pragma unroll
                for (int bj = 0; bj < 2; ++bj)
#pragma unroll
                    for (int n = 0; n < 2; ++n) { f32x4 a = acc[ai][bj][m][n];
#pragma unroll
                        for (int j = 0; j < 4; ++j) { a[j] = __builtin_amdgcn_exp2f(a[j] - mx); sm += a[j]; }
                        acc[ai][bj][m][n] = a; }
                sm += __shfl_xor(sm, 16); sm += __shfl_xor(sm, 32);
                if (fq == 0) xs[(ai * HALF + wr * 64 + m * 16 + fr) * 4 + wc] = sm; }
        asm volatile("s_waitcnt lgkmcnt(0)" ::: "memory"); __builtin_amdgcn_s_barrier(); asm volatile("" ::: "memory");
#pragma unroll
        for (int ai = 0; ai < 2; ++ai)
#pragma unroll
            for (int m = 0; m < 4; ++m) { const f32x4 t = *(const LAS f32x4*)(xs + (ai * HALF + wr * 64 + m * 16 + fr) * 4); const float inv = __builtin_amdgcn_rcpf((t[0] + t[1]) + (t[2] + t[3]));
                st128(O + (size_t)(u.pm * BM + ai * HALF + wr * 64 + m * 16) * DM + u.pn * BM + wc * 64, (size_t)DM, pk8(acc[ai][0][m][0] * inv, acc[ai][0][m][1] * inv), pk8(acc[ai][1][m][0] * inv, acc[ai][1][m][1] * inv), fr, fq, tb); }
    }
};
template <bool BF>
struct EpiResid {
    static constexpr bool PERM = true;
    const void* base; bf16_t* ob; float* ssq; LAS float* xs; unsigned char* o8; float as;
    __device__ __forceinline__ void operator()(EPI_ARGS) const {
        const int col0 = u.pn * BM + wc * 64 + 8 * fq;
        if constexpr (BF) {
            u32x4 br[2][4][2];
#pragma unroll
            for (int ai = 0; ai < 2; ++ai)
#pragma unroll
                for (int m = 0; m < 4; ++m)
#pragma unroll
                    for (int bj = 0; bj < 2; ++bj) br[ai][m][bj] = *(const u32x4*)((const bf16_t*)base + (size_t)(u.pm * BM + ai * HALF + wr * 64 + m * 16 + fr) * DM + col0 + bj * 32);
#pragma unroll
            for (int ai = 0; ai < 2; ++ai)
#pragma unroll
                for (int m = 0; m < 4; ++m) asm volatile("" : "+v"(br[ai][m][0]), "+v"(br[ai][m][1]));
#pragma unroll
            for (int ai = 0; ai < 2; ++ai)
#pragma unroll
                for (int m = 0; m < 4; ++m) { const int rowg = u.pm * BM + ai * HALF + wr * 64 + m * 16, row = rowg + fr; float s = 0.f; u32x4 w[2]; u32x2 f8[2];
#pragma unroll
                    for (int bj = 0; bj < 2; ++bj) { const u32x4 r = br[ai][m][bj];
                        const f32x4 o0 = (f32x4){bf_lo(r.x), bf_hi(r.x), bf_lo(r.y), bf_hi(r.y)} + acc[ai][bj][m][0] * as, o1 = (f32x4){bf_lo(r.z), bf_hi(r.z), bf_lo(r.w), bf_hi(r.w)} + acc[ai][bj][m][1] * as;
                        s += (o0[0] * o0[0] + o0[1] * o0[1]) + (o0[2] * o0[2] + o0[3] * o0[3]) + (o1[0] * o1[0] + o1[1] * o1[1]) + (o1[2] * o1[2] + o1[3] * o1[3]);
                        w[bj] = pk8(o0, o1);
                        f8[bj].x = pk4_fp8(o0[0] * F8_XSCALE, o0[1] * F8_XSCALE, o0[2] * F8_XSCALE, o0[3] * F8_XSCALE); f8[bj].y = pk4_fp8(o1[0] * F8_XSCALE, o1[1] * F8_XSCALE, o1[2] * F8_XSCALE, o1[3] * F8_XSCALE); }
                    st128(ob + (size_t)rowg * DM + u.pn * BM + wc * 64, (size_t)DM, w[0], w[1], fr, fq, tb);
                    if (o8) {
                        *(LAS u32x2*)(tb + fr * 144 + fq * 8) = f8[0]; *(LAS u32x2*)(tb + fr * 144 + 32 + fq * 8) = f8[1];
                        const int L = fq * 16 + fr; const u32x4 v8 = *(const LAS u32x4*)(tb + (L >> 2) * 144 + (L & 3) * 16);
                        *(u32x4*)(o8 + (size_t)(rowg + (L >> 2)) * DM + u.pn * BM + wc * 64 + (L & 3) * 16) = v8; }
                    s += __shfl_xor(s, 16); s += __shfl_xor(s, 32);
                    if (fq == 0) xs[(ai * HALF + wr * 64 + m * 16 + fr) * 4 + wc] = s; }
        } else {
#pragma unroll
            for (int ai = 0; ai < 2; ++ai) {
                f32x4 br[4][2][2];
#pragma unroll
                for (int m = 0; m < 4; ++m)
#pragma unroll
                    for (int bj = 0; bj < 2; ++bj) { const float* p = (const float*)base + (size_t)(u.pm * BM + ai * HALF + wr * 64 + m * 16 + fr) * DM + col0 + bj * 32; br[m][bj][0] = *(const f32x4*)p; br[m][bj][1] = *(const f32x4*)(p + 4); }
#pragma unroll
                for (int m = 0; m < 4; ++m) asm volatile("" : "+v"(br[m][0][0]), "+v"(br[m][0][1]), "+v"(br[m][1][0]), "+v"(br[m][1][1]));
#pragma unroll
                for (int m = 0; m < 4; ++m) { const int rowg = u.pm * BM + ai * HALF + wr * 64 + m * 16; float s = 0.f; u32x4 w[2]; u32x2 f8[2];
#pragma unroll
                    for (int bj = 0; bj < 2; ++bj) { const f32x4 o0 = br[m][bj][0] + acc[ai][bj][m][0] * as, o1 = br[m][bj][1] + acc[ai][bj][m][1] * as;
                        s += (o0[0] * o0[0] + o0[1] * o0[1]) + (o0[2] * o0[2] + o0[3] * o0[3]) + (o1[0] * o1[0] + o1[1] * o1[1]) + (o1[2] * o1[2] + o1[3] * o1[3]);
                        w[bj] = pk8(o0, o1);
                        f8[bj].x = pk4_fp8(o0[0] * F8_XSCALE, o0[1] * F8_XSCALE, o0[2] * F8_XSCALE, o0[3] * F8_XSCALE); f8[bj].y = pk4_fp8(o1[0] * F8_XSCALE, o1[1] * F8_XSCALE, o1[2] * F8_XSCALE, o1[3] * F8_XSCALE); }
                    st128(ob + (size_t)rowg * DM + u.pn * BM + wc * 64, (size_t)DM, w[0], w[1], fr, fq, tb);
                    if (o8) {
                        *(LAS u32x2*)(tb + fr * 144 + fq * 8) = f8[0]; *(LAS u32x2*)(tb + fr * 144 + 32 + fq * 8) = f8[1];
                        const int L = fq * 16 + fr; const u32x4 v8 = *(const LAS u32x4*)(tb + (L >> 2) * 144 + (L & 3) * 16);
                        *(u32x4*)(o8 + (size_t)(rowg + (L >> 2)) * DM + u.pn * BM + wc * 64 + (L & 3) * 16) = v8; }
                    s += __shfl_xor(s, 16); s += __shfl_xor(s, 32);
                    if (fq == 0) xs[(ai * HALF + wr * 64 + m * 16 + fr) * 4 + wc] = s; }
            }
        }
        asm volatile("s_waitcnt lgkmcnt(0)" ::: "memory"); __builtin_amdgcn_s_barrier(); asm volatile("" ::: "memory");
        { const int t_ = (wr * 4 + wc) * 64 + fq * 16 + fr;
          if (t_ < 256) { const f32x4 p = *(const LAS f32x4*)(xs + t_ * 4); ssq[(size_t)(u.pm * BM + t_) * 4 + u.pn] = (p[0] + p[1]) + (p[2] + p[3]); } }
    }
};
struct EpiRouter {
    static constexpr bool PERM = false;
    float* L; const float* ssq; const float* bg; const float* be; float* rstd_out;
    __device__ __forceinline__ void operator()(EPI_ARGS) const {
        if (wc != 0) return;
        const int row0 = u.pm * BM + wr * 64 + fr;
        float rsv[2][4];
#pragma unroll
        for (int ai = 0; ai < 2; ++ai)
#pragma unroll
            for (int m = 0; m < 4; ++m) { const f32x4 s4 = *(const f32x4*)(ssq + (size_t)(row0 + ai * HALF + m * 16) * 4);
                rsv[ai][m] = __builtin_amdgcn_rsqf(((s4[0] + s4[1]) + (s4[2] + s4[3])) * (1.0f / DM) + RMS_EPS); }
#pragma unroll
        for (int ai = 0; ai < 2; ++ai)
#pragma unroll
            for (int m = 0; m < 4; ++m) { const int row = row0 + ai * HALF + m * 16; const float rs = rsv[ai][m];
                if (fq == 0) rstd_out[row] = rs;
#pragma unroll
                for (int bj = 0; bj < 2; ++bj)
#pragma unroll
                    for (int n = 0; n < 2; ++n) { const int c0 = bj * 32 + n * 16 + 4 * fq; f32x4 o = acc[ai][bj][m][n] * rs;
#pragma unroll
                        for (int j = 0; j < 4; ++j) { const int c = c0 + j; const float b = c < 4 ? bg[c] : (c < 36 ? be[c - 4] : 0.f); o[j] += b; }
                        *(f32x4*)(L + (size_t)row * 64 + c0) = o; } }
    }
};
struct EpiGateUp {
    static constexpr bool PERM = true;
    unsigned char* act; const float* rstd; const int* row_tok;
    __device__ __forceinline__ void operator()(EPI_ARGS) const {
        const int row0 = u.pm * BM + wr * 64 + fr, col0 = u.pn * 128 + wc * 32 + 8 * fq;
        float rsv[2][4];
#pragma unroll
        for (int ai = 0; ai < 2; ++ai)
#pragma unroll
            for (int m = 0; m < 4; ++m) rsv[ai][m] = rstd[row0 + ai * HALF + m * 16];
#pragma unroll
        for (int ai = 0; ai < 2; ++ai)
#pragma unroll
            for (int m = 0; m < 4; ++m) { const int row = row0 + ai * HALF + m * 16; const float rs = rsv[ai][m];
                float r[8];
#pragma unroll
                for (int n = 0; n < 2; ++n)
#pragma unroll
                    for (int j = 0; j < 4; ++j) { const float gg = acc[ai][0][m][n][j] * rs, uu = acc[ai][1][m][n][j] * rs;
                        r[n * 4 + j] = gg * __builtin_amdgcn_rcpf(1.0f + __builtin_amdgcn_exp2f(-gg * LOG2E)) * uu; }
                u32x2 w; w.x = pk4_fp8(r[0] * F8_ASCALE, r[1] * F8_ASCALE, r[2] * F8_ASCALE, r[3] * F8_ASCALE); w.y = pk4_fp8(r[4] * F8_ASCALE, r[5] * F8_ASCALE, r[6] * F8_ASCALE, r[7] * F8_ASCALE);
                *(u32x2*)(act + (size_t)row * DEXP + col0) = w; }
    }
};
}

namespace da {
constexpr int NW = 8, QBLK = 32, KVBLK = 64, QB = NW * QBLK, DV = 128;
constexpr int SHM_V = KVBLK * DV * 2, SHM_K = KVBLK * 64 * 2;
constexpr int LDS_V = 0, LDS_K = 2 * SHM_V, LDS_WS = LDS_K + 2 * SHM_K, LDS_CX = LDS_WS + NW * 64 * 4, LDS_STASH = LDS_CX + 256, LDS_BYTES = LDS_STASH + NW * 8192;
constexpr float SKIP_MARGIN = 40.f;
constexpr float THR = 8.f;
#define SBAR() __builtin_amdgcn_sched_barrier(0)
__device__ __forceinline__ int kswz(int row, int chunk) { return row * 128 + ((chunk ^ ((row >> 1) & 7)) << 4); }
__device__ __forceinline__ int v_st(int k, int c) { const int kk = (k & ~0xC) | ((k & 4) << 1) | ((k & 8) >> 1); return ((kk >> 3) * 4 + (c >> 5)) * 512 + ((kk & 7) * 32 + (c & 31)) * 2; }
__device__ __forceinline__ int v_rd_base(int lane) { return ((lane & 3) << 3) | (((lane >> 2) & 3) << 6) | (((lane >> 4) & 1) << 5) | (((lane >> 5) & 1) << 8); }
constexpr int v_rd_off(int d0, int ks, int half) { return d0 * 512 + ks * 4096 + half * 2048; }
__device__ __forceinline__ int crow(int r, int hi) { return (r & 3) + 8 * (r >> 2) + 4 * hi; }
__device__ __forceinline__ bf16x8 load8(const bf16_t* p) { return *reinterpret_cast<const bf16x8*>(p); }

__device__ __forceinline__ void mask_tile(f32x16& p0, f32x16& p1, int dq) {
    const float NEG = -__builtin_inff();
#pragma unroll
    for (int r = 0; r < 16; ++r) { const int c = (r & 3) + 8 * (r >> 2); if (dq - c < 0) p0[r] = NEG; if (dq - c - 32 < 0) p1[r] = NEG; }
}
__device__ __forceinline__ void partialSM(f32x16& p0, f32x16& p1, float& m_reg, float& alpha) {
    float pmax = p0[0];
#pragma unroll
    for (int r = 1; r < 16; ++r) pmax = fmaxf(pmax, p0[r]);
#pragma unroll
    for (int r = 0; r < 16; ++r) pmax = fmaxf(pmax, p1[r]);
    { auto rr = __builtin_amdgcn_permlane32_swap(__float_as_uint(pmax), __float_as_uint(pmax), false, false); pmax = fmaxf(__uint_as_float(rr[0]), __uint_as_float(rr[1])); }
    float mn;
    if (__builtin_expect(__all((pmax - m_reg) <= THR), 1)) { mn = m_reg; alpha = 1.f; }
    else { mn = fmaxf(m_reg, pmax); alpha = __builtin_amdgcn_exp2f(m_reg - mn); m_reg = mn; }
#pragma unroll
    for (int r = 0; r < 16; ++r) p0[r] = p0[r] - mn;
#pragma unroll
    for (int r = 0; r < 16; ++r) p1[r] = p1[r] - mn;
#pragma unroll
    for (int r = 0; r < 16; ++r) p0[r] = __builtin_amdgcn_exp2f(p0[r]);
}
__device__ __forceinline__ void finishSM(f32x16& p0, f32x16& p1, float alpha, float& l_reg, bf16x8& pa0, bf16x8& pa1, bf16x8& pa2, bf16x8& pa3) {
#pragma unroll
    for (int r = 0; r < 16; ++r) p1[r] = __builtin_amdgcn_exp2f(p1[r]);
    float ps = 0;
#pragma unroll
    for (int r = 0; r < 16; ++r) ps += p0[r];
#pragma unroll
    for (int r = 0; r < 16; ++r) ps += p1[r];
    { auto rr = __builtin_amdgcn_permlane32_swap(__float_as_uint(ps), __float_as_uint(ps), false, false); ps = __uint_as_float(rr[0]) + __uint_as_float(rr[1]); }
    l_reg = l_reg * alpha + ps;
#define PK4(P, B_, OUT) do { unsigned a0 = cvt_pk_bf16(P[B_+0], P[B_+1]), a1 = cvt_pk_bf16(P[B_+2], P[B_+3]);                          \
        unsigned b0 = cvt_pk_bf16(P[B_+4], P[B_+5]), b1 = cvt_pk_bf16(P[B_+6], P[B_+7]);                                             \
        auto r0 = __builtin_amdgcn_permlane32_swap(a0, b0, false, false); auto r1 = __builtin_amdgcn_permlane32_swap(a1, b1, false, false); \
        u32x4 w = {r0[0], r1[0], r0[1], r1[1]}; OUT = *reinterpret_cast<bf16x8*>(&w); } while (0)
    PK4(p0, 0, pa0); PK4(p0, 8, pa1); PK4(p1, 0, pa2); PK4(p1, 8, pa3);
#undef PK4
}
template <int KB>
__device__ __forceinline__ void qkt(f32x16& p0, f32x16& p1, const char* K_lds, int r32, int hi, const bf16x8* qr, float ab, float slope2) {
    const float s32 = 32.f * slope2;
#pragma unroll
    for (int r = 0; r < 16; ++r) { p0[r] = fmaf(slope2, (float)((r & 3) + 8 * (r >> 2)), ab); p1[r] = p0[r] + s32; }
#pragma unroll
    for (int d0 = 0; d0 < 4; ++d0) { const char* a = K_lds + KB * SHM_K + kswz(r32, d0 * 2 + hi);
        bf16x8 b0 = *reinterpret_cast<const bf16x8*>(a);
        bf16x8 b1 = *reinterpret_cast<const bf16x8*>(a + 32 * 128);
        p0 = __builtin_amdgcn_mfma_f32_32x32x16_bf16(b0, qr[d0], p0, 0, 0, 0);
        p1 = __builtin_amdgcn_mfma_f32_32x32x16_bf16(b1, qr[d0], p1, 0, 0, 0); }
}
template <int VB>
__device__ __forceinline__ void pv_tile(f32x16* o, int vb0, bf16x8 pa0, bf16x8 pa1, bf16x8 pa2, bf16x8 pa3) {
#define TRRD(dst, off) asm volatile("ds_read_b64_tr_b16 %0, %1 offset:%2" : "=&v"(dst) : "v"(vb0), "i"(off) : "memory")
#define PV_D0(d0) do { s16x4 l0, l1, l2, l3, h0, h1, h2, h3; constexpr int b_ = VB * SHM_V + v_rd_off(d0, 0, 0); \
        TRRD(l0, b_); TRRD(h0, b_ + 2048); TRRD(l1, b_ + 4096); TRRD(h1, b_ + 6144); TRRD(l2, b_ + 8192); TRRD(h2, b_ + 10240); TRRD(l3, b_ + 12288); TRRD(h3, b_ + 14336); \
        asm volatile("s_waitcnt lgkmcnt(0)" ::: "memory"); SBAR();   \
        o[d0] = __builtin_amdgcn_mfma_f32_32x32x16_bf16(pa0, (bf16x8){l0[0], l0[1], l0[2], l0[3], h0[0], h0[1], h0[2], h0[3]}, o[d0], 0, 0, 0);   \
        o[d0] = __builtin_amdgcn_mfma_f32_32x32x16_bf16(pa1, (bf16x8){l1[0], l1[1], l1[2], l1[3], h1[0], h1[1], h1[2], h1[3]}, o[d0], 0, 0, 0);   \
        o[d0] = __builtin_amdgcn_mfma_f32_32x32x16_bf16(pa2, (bf16x8){l2[0], l2[1], l2[2], l2[3], h2[0], h2[1], h2[2], h2[3]}, o[d0], 0, 0, 0);   \
        o[d0] = __builtin_amdgcn_mfma_f32_32x32x16_bf16(pa3, (bf16x8){l3[0], l3[1], l3[2], l3[3], h3[0], h3[1], h3[2], h3[3]}, o[d0], 0, 0, 0); } while (0)
    PV_D0(0); PV_D0(1); PV_D0(2); PV_D0(3);
#undef PV_D0
#undef TRRD
}

struct BlockRef { const bf16_t* Q; const bf16_t* K; const bf16_t* V; bf16_t* O; int P0; int mode; float slope2; float kmax; };
struct Seam { bf16x8 qr[4]; bf16x8 st_v0, st_v1, st_k0; };
__device__ __forceinline__ BlockRef mkref(const bf16_t* Z, bf16_t* AO, const unsigned* kmx, int item, int pass) { BlockRef r; const int bh = item >> 4, y = item & 15, b = bh >> 2, h = bh & 3; const int qb = (pass < 2) ? y : 31 - y, mp = pass & 1;
    const bf16_t* zb = Z + (size_t)b * SEQ * ZP; r.Q = zb + (size_t)(qb * 256) * ZP + ZQ + h * 128 + mp * 64; r.K = zb + ZK + h * 128 + mp * 64; r.V = zb + ZVAL + h * 128;
    r.O = AO + ((size_t)b * SEQ + qb * 256) * DM + 512 + h * 128; r.P0 = qb * 256; r.mode = mp; r.slope2 = exp2f(-2.0f * (float)(h + 1)) * LOG2E;
    const unsigned* kp = kmx + ((bh * 2 + mp) * 2); r.kmax = 1.01f * sqrtf(__uint_as_float(ld_u32_agent(kp)) + __uint_as_float(ld_u32_agent(kp + 1))); return r; }
#define ROWV(p, k0, rr) ((p) + (size_t)((k0) + (rr)) * ZP + sc)
#define ROWK(p, k0) ((p) + (size_t)((k0) + skr) * ZP + skc * 8)
#define VMW() asm volatile("s_waitcnt vmcnt(0)" ::: "memory")
#define VMWN(n) asm volatile("s_waitcnt vmcnt(%0)" :: "i"(n) : "memory")
#define SLOAD_H(Kp, Vp, k0) do { S.st_v0 = load8(ROWV(Vp, k0, sr)); S.st_v1 = load8(ROWV(Vp, k0, 32 + sr)); S.st_k0 = load8(ROWK(Kp, k0)); } while (0)
#define SWRITE_HK(bf) do { *(bf16x8*)(K_lds + (bf) * SHM_K + kws) = S.st_k0; } while (0)
#define SWRITE_HV(bf) do { *(bf16x8*)(V_lds + (bf) * SHM_V + vst0) = S.st_v0; *(bf16x8*)(V_lds + (bf) * SHM_V + vst1) = S.st_v1; } while (0)
#define SWRITE_H(bf) do { SWRITE_HV(bf); SWRITE_HK(bf); } while (0)
__device__ __forceinline__ void prime(const BlockRef& cur, char* lds, Seam& S, int wid) {
    const int lane = lane_id(), tid = wid * 64 + lane, r32 = lane & 31, hi = lane >> 5;
    const int sr = tid >> 4, sc = (tid & 15) * 8, skr = tid >> 3, skc = tid & 7, kws = kswz(skr, skc); char* K_lds = lds + LDS_K;
#pragma unroll
    for (int d0 = 0; d0 < 4; ++d0) S.qr[d0] = load8(cur.Q + (size_t)(wid * QBLK + r32) * ZP + d0 * 16 + hi * 8);
    SLOAD_H(cur.K, cur.V, cur.P0 + QB - KVBLK); VMW(); SWRITE_HK(0);
    __syncthreads();
}
__device__ __forceinline__ void block(const BlockRef& cur, const BlockRef& nxt, char* lds, Seam& S, float lam, const float* __restrict__ subln, int wid) {
    const int lane = lane_id(), tid = wid * 64 + lane, r32 = lane & 31, hi = lane >> 5;
    const int NT0 = (cur.P0 + QB) / KVBLK;
    int NT = NT0;
    const int qlo = cur.P0 + wid * QBLK, qm = qlo + r32 - 4 * hi;
    const float slope2 = cur.slope2;
    char* V_lds = lds + LDS_V; char* K_lds = lds + LDS_K;
    float* ws = (float*)(lds + LDS_WS) + wid * 64; float* li_l = ws, * al_l = ws + 32;
    float m_reg = -1e30f, l_reg = 0; f32x16 o[4] = {};
    const int sr = tid >> 4, sc = (tid & 15) * 8, vst0 = v_st(sr, sc), vst1 = v_st(32 + sr, sc), skr = tid >> 3, skc = tid & 7, kws = kswz(skr, skc);
    const int vb0 = (int)(uintptr_t)V_lds + v_rd_base(lane);
    const bf16_t* Kh = cur.K; const bf16_t* Vh = cur.V;
#define RESC(a) do { if (__any((a) < 1.f)) { if (hi == 0) al_l[r32] = (a); asm volatile("s_waitcnt lgkmcnt(0)" ::: "memory");              \
                     for (int d_ = 0; d_ < 4; ++d_) for (int r = 0; r < 16; ++r) o[d_][r] *= al_l[crow(r, hi)]; } } while (0)
#define KBASE(t) ((NT0 - 1 - (t)) * KVBLK)
#define AB(t) (slope2 * (float)(KBASE(t) - qm))
#define MASKT(P0_, P1_, t) do { const int kb_ = KBASE(t); if (kb_ + KVBLK - 1 > qlo) mask_tile(P0_, P1_, qm - kb_); } while (0)
    constexpr int NQL = 4;
#define SEAM_K0() do { VMWN(NQL); SWRITE_HK(0); SBAR(); } while (0)
    f32x16 pA0, pA1, pB0, pB1; float alA, alB; bf16x8 pa0, pa1, pa2, pa3;
    float cbase;
    { float q2 = 0.f;
#pragma unroll
      for (int d0 = 0; d0 < 4; ++d0)
#pragma unroll
          for (int j = 0; j < 8; ++j) { const float v = __uint_as_float(((unsigned)(unsigned short)S.qr[d0][j]) << 16); q2 = fmaf(v, v, q2); }
      { auto rr = __builtin_amdgcn_permlane32_swap(__float_as_uint(q2), __float_as_uint(q2), false, false); q2 = __uint_as_float(rr[0]) + __uint_as_float(rr[1]); }
      cbase = sqrtf(q2) * cur.kmax * 1.0001f - slope2 * (float)(qlo + r32); }
    SWRITE_HV(0); SBAR();
    if (NT > 1) { SLOAD_H(Kh, Vh, KBASE(1)); }
    SBAR(); qkt<0>(pA0, pA1, K_lds, r32, hi, S.qr, AB(0), slope2);
    MASKT(pA0, pA1, 0); partialSM(pA0, pA1, m_reg, alA);
    if (NT > 1) { VMW(); SWRITE_H(1); }
    __syncthreads();
#define HALF_STEP(PX0, PX1, alX, PY0, PY1, alY, t, KB, VB, SB) do {                                                      \
        SBAR(); qkt<KB>(PX0, PX1, K_lds, r32, hi, S.qr, AB(t), slope2);                                                   \
        finishSM(PY0, PY1, alY, l_reg, pa0, pa1, pa2, pa3); SBAR();                                                       \
        if ((t) + 1 < NT) { SLOAD_H(Kh, Vh, KBASE((t) + 1)); SBAR(); }                                                    \
        pv_tile<VB>(o, vb0, pa0, pa1, pa2, pa3); MASKT(PX0, PX1, (t)); partialSM(PX0, PX1, m_reg, alX);                   \
        __syncthreads();                                                                                                  \
        if ((t) + 1 < NT) { VMW(); SWRITE_H(SB); }                                                                        \
        RESC(alX); __syncthreads(); } while (0)
    for (int t = 1; t + 1 < NT; t += 2) {
        HALF_STEP(pB0, pB1, alB, pA0, pA1, alA, t, 1, 0, 0);
        HALF_STEP(pA0, pA1, alA, pB0, pB1, alB, t + 1, 0, 1, 1);
        if (t == 3 && NT0 > 6) {
            float c = cbase - m_reg;
#pragma unroll
            for (int o_ = 1; o_ < 64; o_ <<= 1) c = fmaxf(c, __shfl_xor(c, o_));
            float* cx = (float*)(lds + LDS_CX);
            if (lane == 0) cx[wid] = c;
            __syncthreads();
            float C = cx[0];
#pragma unroll
            for (int w_ = 1; w_ < NW; ++w_) C = fmaxf(C, cx[w_]);
            const float X = (-SKIP_MARGIN - C) / slope2 - 63.f;
            const float need_f = (float)(NT0 - 1) - X * (1.0f / 64.0f);
            if (need_f < (float)NT0) { int n = (int)ceilf(need_f); n = n < 6 ? 6 : n; n = (n + 1) & ~1; NT = n < NT0 ? n : NT0; }
        }
    }
    SBAR(); qkt<1>(pB0, pB1, K_lds, r32, hi, S.qr, AB(NT - 1), slope2); SBAR();
    SLOAD_H(nxt.K, nxt.V, nxt.P0 + QB - KVBLK); SBAR();
#pragma unroll
    for (int d0 = 0; d0 < 4; ++d0) S.qr[d0] = load8(nxt.Q + (size_t)(wid * QBLK + r32) * ZP + d0 * 16 + hi * 8);
    SBAR();
    finishSM(pA0, pA1, alA, l_reg, pa0, pa1, pa2, pa3); SBAR();
    pv_tile<0>(o, vb0, pa0, pa1, pa2, pa3);
    MASKT(pB0, pB1, NT - 1); partialSM(pB0, pB1, m_reg, alB); __syncthreads(); RESC(alB);
    finishSM(pB0, pB1, alB, l_reg, pa0, pa1, pa2, pa3); SBAR(); pv_tile<1>(o, vb0, pa0, pa1, pa2, pa3);
    SBAR(); SEAM_K0();
    if (hi == 0) li_l[r32] = l_reg; asm volatile("s_waitcnt lgkmcnt(0)" ::: "memory");
    float rli[16];
#pragma unroll
    for (int r = 0; r < 16; ++r) rli[r] = __builtin_amdgcn_rcpf(li_l[crow(r, hi)]);
    unsigned* stash = (unsigned*)(lds + LDS_STASH) + wid * 2048 + lane;
    if (cur.mode == 0) {
#pragma unroll
        for (int r = 0; r < 16; ++r) { stash[(r * 2 + 0) * 64] = cvt_pk_bf16(o[0][r] * rli[r], o[1][r] * rli[r]); stash[(r * 2 + 1) * 64] = cvt_pk_bf16(o[2][r] * rli[r], o[3][r] * rli[r]); }
    } else {
        float ssq[16];
#pragma unroll
        for (int r = 0; r < 16; ++r) { const unsigned w0 = stash[(r * 2 + 0) * 64], w1 = stash[(r * 2 + 1) * 64];
            o[0][r] = bf_lo(w0) - lam * (o[0][r] * rli[r]); o[1][r] = bf_hi(w0) - lam * (o[1][r] * rli[r]);
            o[2][r] = bf_lo(w1) - lam * (o[2][r] * rli[r]); o[3][r] = bf_hi(w1) - lam * (o[3][r] * rli[r]);
            ssq[r] = (o[0][r] * o[0][r] + o[1][r] * o[1][r]) + (o[2][r] * o[2][r] + o[3][r] * o[3][r]); }
#pragma unroll
        for (int r = 0; r < 16; ++r) {
#pragma unroll
            for (int off = 1; off < 32; off <<= 1) ssq[r] += __shfl_xor(ssq[r], off);
            ssq[r] = __builtin_amdgcn_rsqf(ssq[r] * (1.0f / DV) + RMS_EPS); }
        float g4[4];
#pragma unroll
        for (int d0 = 0; d0 < 4; ++d0) g4[d0] = subln[d0 * 32 + r32] * 0.8f;
        bf16_t* Ow = cur.O + (size_t)(wid * QBLK) * DM;
#pragma unroll
        for (int r = 0; r < 16; ++r) { const int orow = crow(r, hi);
#pragma unroll
            for (int d0 = 0; d0 < 4; ++d0) { const float v = o[d0][r] * ssq[r] * g4[d0]; const float vn = __shfl_xor(v, 1);
                if ((r32 & 1) == 0) *(unsigned*)(Ow + (size_t)orow * DM + d0 * 32 + r32) = cvt_pk_bf16(v, vn); } }
    }
    __syncthreads();
#undef RESC
#undef KBASE
#undef AB
#undef MASKT
#undef SEAM_K0
#undef HALF_STEP
}
#undef ROWV
#undef ROWK
#undef VMW
#undef VMWN
#undef SLOAD_H
#undef SWRITE_HK
#undef SWRITE_HV
#undef SWRITE_H
#undef SBAR
}


#define XB_TMO      128
#define XB_XCNT(j)  (256  + 64 * (j))
#define XB_XSUB(j)  (1280 + 64 * (j))
#define XB_XGEN(j)  (2304 + 64 * (j))
#define XB_TOP      3328
#define XB_TOPGEN   3392
#define XCD_BAR_WORDS 3456
#define XB_SPIN_CAP (1u << 22)
__device__ __forceinline__ unsigned xb_ld(unsigned* p)              { return __hip_atomic_load(p, __ATOMIC_RELAXED, __HIP_MEMORY_SCOPE_AGENT); }
__device__ __forceinline__ unsigned xb_add(unsigned* p, unsigned v) { return __hip_atomic_fetch_add(p, v, __ATOMIC_RELAXED, __HIP_MEMORY_SCOPE_AGENT); }
__device__ __forceinline__ unsigned xb_xcc_id() { return (unsigned)__builtin_amdgcn_s_getreg((3 << 11) | 20) & 0xFu; }
#define XB_SPIN(cond, bar) do { unsigned _sp = 0; while (cond) { __builtin_amdgcn_s_sleep(1); \
    if ((++_sp & 255u) == 0u) { if (xb_ld(&(bar)[XB_TMO])) break; if (_sp > XB_SPIN_CAP) { atomicAdd(&(bar)[XB_TMO], 1u); break; } } } } while (0)
struct XcdBarrier { unsigned* bar; unsigned x; volatile LAS unsigned* st; };
__device__ __forceinline__ XcdBarrier xcd_barrier_post(unsigned* bar, volatile LAS unsigned* st, bool t0) {
    XcdBarrier b; b.bar = bar; b.x = xb_xcc_id(); b.st = st;
    if (t0) (void)xb_add(&bar[XB_XCNT(b.x)], 1u);
    return b;
}
__device__ __forceinline__ void xcd_barrier_complete(unsigned* bar, unsigned x, unsigned& nloc, unsigned& nx) {
    const unsigned G = gridDim.x;
    unsigned sum, cnt, mine, sp = 0u;
    for (;;) {
        sum = 0u; cnt = 0u; mine = 0u;
#pragma unroll
        for (unsigned j = 0; j < 16; ++j) { const unsigned c = xb_ld(&bar[XB_XCNT(j)]); sum += c; cnt += (c > 0u) ? 1u : 0u; mine = (j == x) ? c : mine; }
        if (sum == G) break;
        __builtin_amdgcn_s_sleep(1);
        if ((++sp & 255u) == 0u) { if (xb_ld(&bar[XB_TMO])) break; if (sp > XB_SPIN_CAP) { atomicAdd(&bar[XB_TMO], 1u); break; } }
    }
    nloc = mine > 0u ? mine : 1u; nx = cnt > 0u ? cnt : 1u;
}
__device__ __forceinline__ void xcd_barrier(const XcdBarrier& b, bool t0) {
    asm volatile("s_waitcnt vmcnt(0)" ::: "memory");
    __syncthreads();
    if (t0) {
        unsigned* bar = b.bar;
        __builtin_amdgcn_s_waitcnt(0);
        unsigned nloc = b.st[0], nx = b.st[1];
        if (nloc == 0u) { xcd_barrier_complete(bar, b.x, nloc, nx); b.st[0] = nloc; b.st[1] = nx; }
        const unsigned old = xb_add(&bar[XB_XSUB(b.x)], 1u);
        const unsigned gen = old / nloc;
        if (old + 1u == (gen + 1u) * nloc) {
            __builtin_amdgcn_fence(__ATOMIC_RELEASE, "agent");
            asm volatile("s_waitcnt vmcnt(0)" ::: "memory");
            const unsigned og = xb_add(&bar[XB_TOP], 1u);
            const unsigned tg = og / nx;
            if (og + 1u == (tg + 1u) * nx) xb_add(&bar[XB_TOPGEN], 1u);
            else XB_SPIN(xb_ld(&bar[XB_TOPGEN]) == tg, bar);
            __builtin_amdgcn_fence(__ATOMIC_ACQUIRE, "agent");
            xb_add(&bar[XB_XGEN(b.x)], 1u);
            asm volatile("s_waitcnt vmcnt(0)" ::: "memory");
        } else {
            XB_SPIN(xb_ld(&bar[XB_XGEN(b.x)]) == gen, bar);
            __builtin_amdgcn_fence(__ATOMIC_ACQUIRE, "agent");
            asm volatile("s_waitcnt vmcnt(0)" ::: "memory");
        }
    }
    __syncthreads();
}
constexpr int NWAVES = 8, NTHR = 512;
constexpr int LDS_BYTES = 163840;
struct Args {
    const float* in[28]; float* out; unsigned char* ws; int ph_lo, ph_hi;
};
constexpr int N_PHASES = 15;

struct Frame {
    LAS unsigned char* lds; int wave, vcu, G;
};

__device__ __forceinline__ void transpose_item(const float* W, int ldw, int k0, int n0, bf16_t* dst, int ldt, const float* kscale, LAS float* scr, int lane) {
    f32x4 v[8]; const int kr = lane >> 3, n4 = (lane & 7) * 4;
#pragma unroll
    for (int i = 0; i < 8; ++i) v[i] = *(const f32x4*)(W + (size_t)(k0 + i * 8 + kr) * ldw + n0 + n4);
#pragma unroll
    for (int i = 0; i < 8; ++i) { const int kk = i * 8 + kr; f32x4 x = v[i]; if (kscale) x = x * kscale[k0 + kk];
        scr[kk * 33 + n4 + 0] = x[0]; scr[kk * 33 + n4 + 1] = x[1]; scr[kk * 33 + n4 + 2] = x[2]; scr[kk * 33 + n4 + 3] = x[3]; }
    asm volatile("s_waitcnt lgkmcnt(0)" ::: "memory");
    const int c = lane & 7;
#pragma unroll
    for (int j = 0; j < 4; ++j) { const int n = (lane >> 3) + 8 * j; const LAS float* s = scr + (8 * c) * 33 + n;
        u32x4 o; o.x = cvt_pk_bf16(s[0 * 33], s[1 * 33]); o.y = cvt_pk_bf16(s[2 * 33], s[3 * 33]); o.z = cvt_pk_bf16(s[4 * 33], s[5 * 33]); o.w = cvt_pk_bf16(s[6 * 33], s[7 * 33]);
        *(u32x4*)(dst + (size_t)n * ldt + k0 + 8 * c) = o; }
    asm volatile("s_waitcnt lgkmcnt(0)" ::: "memory");
}
__device__ __forceinline__ void transpose_item_fp8(const float* W, int ldw, int k0, int n0, unsigned char* dst, int ldt, float scale, const float* kscale, LAS float* scr, int lane) {
    f32x4 v[8]; const int kr = lane >> 3, n4 = (lane & 7) * 4;
#pragma unroll
    for (int i = 0; i < 8; ++i) v[i] = *(const f32x4*)(W + (size_t)(k0 + i * 8 + kr) * ldw + n0 + n4);
#pragma unroll
    for (int i = 0; i < 8; ++i) { const int kk = i * 8 + kr; const f32x4 x = v[i] * (kscale ? scale * kscale[k0 + kk] : scale);
        scr[kk * 33 + n4 + 0] = x[0]; scr[kk * 33 + n4 + 1] = x[1]; scr[kk * 33 + n4 + 2] = x[2]; scr[kk * 33 + n4 + 3] = x[3]; }
    asm volatile("s_waitcnt lgkmcnt(0)" ::: "memory");
    const int n = lane >> 1, kh = (lane & 1) * 32; const LAS float* s = scr + kh * 33 + n;
    u32x4 o0, o1;
    o0.x = pk4_fp8(s[0 * 33], s[1 * 33], s[2 * 33], s[3 * 33]); o0.y = pk4_fp8(s[4 * 33], s[5 * 33], s[6 * 33], s[7 * 33]); o0.z = pk4_fp8(s[8 * 33], s[9 * 33], s[10 * 33], s[11 * 33]); o0.w = pk4_fp8(s[12 * 33], s[13 * 33], s[14 * 33], s[15 * 33]);
    o1.x = pk4_fp8(s[16 * 33], s[17 * 33], s[18 * 33], s[19 * 33]); o1.y = pk4_fp8(s[20 * 33], s[21 * 33], s[22 * 33], s[23 * 33]); o1.z = pk4_fp8(s[24 * 33], s[25 * 33], s[26 * 33], s[27 * 33]); o1.w = pk4_fp8(s[28 * 33], s[29 * 33], s[30 * 33], s[31 * 33]);
    *(u32x4*)(dst + (size_t)n * ldt + k0 + kh) = o0; *(u32x4*)(dst + (size_t)n * ldt + k0 + kh + 16) = o1;
    asm volatile("s_waitcnt lgkmcnt(0)" ::: "memory");
}
__device__ __forceinline__ void rms_rows2_to_bf16(const float* xa, const float* xb, const float* g, bf16_t* oa, bf16_t* ob, int lane) {
    const f32x4* ra = (const f32x4*)xa + lane; const f32x4* rb = (const f32x4*)xb + lane; const f32x4* gr = (const f32x4*)g + lane;
    f32x4 va[4], vb[4]; float sa = 0.f, sb = 0.f;
#pragma unroll
    for (int j = 0; j < 4; ++j) { va[j] = ra[64 * j]; vb[j] = rb[64 * j]; }
#pragma unroll
    for (int j = 0; j < 4; ++j) { sa += (va[j].x * va[j].x + va[j].y * va[j].y) + (va[j].z * va[j].z + va[j].w * va[j].w); sb += (vb[j].x * vb[j].x + vb[j].y * vb[j].y) + (vb[j].z * vb[j].z + vb[j].w * vb[j].w); }
    const float rsa = __builtin_amdgcn_rsqf(wave_sum(sa) * (1.f / DM) + RMS_EPS), rsb = __builtin_amdgcn_rsqf(wave_sum(sb) * (1.f / DM) + RMS_EPS);
    u32x2* pa = (u32x2*)oa + lane; u32x2* pb = (u32x2*)ob + lane;
#pragma unroll
    for (int j = 0; j < 4; ++j) { const f32x4 gg = gr[64 * j]; u32x2 w;
        w.x = cvt_pk_bf16(va[j].x * rsa * gg.x, va[j].y * rsa * gg.y); w.y = cvt_pk_bf16(va[j].z * rsa * gg.z, va[j].w * rsa * gg.w); pa[64 * j] = w;
        w.x = cvt_pk_bf16(vb[j].x * rsb * gg.x, vb[j].y * rsb * gg.y); w.y = cvt_pk_bf16(vb[j].z * rsb * gg.z, vb[j].w * rsb * gg.w); pb[64 * j] = w; }
}

__global__ void __launch_bounds__(NTHR, 2) mega(Args args) {
    extern __shared__ __attribute__((aligned(16))) unsigned char lds_raw[];
    Frame F; F.lds = (LAS unsigned char*)lds_raw; F.wave = __builtin_amdgcn_readfirstlane(threadIdx.x >> 6);
    F.G = gridDim.x; { const int bx = blockIdx.x; F.vcu = (F.G % 8 == 0) ? (bx % 8) * (F.G / 8) + bx / 8 : bx; }
    unsigned char* ws = args.ws;
    unsigned* ctl = (unsigned*)(ws + WS_CTL);
    const float* x = args.in[0]; float* out = args.out;
    bf16_t* Win_t = (bf16_t*)(ws + WS_WIN); bf16_t* Wout_t = (bf16_t*)(ws + WS_WOUT); bf16_t* Wq_t = (bf16_t*)(ws + WS_WQ); bf16_t* Wkv_t = (bf16_t*)(ws + WS_WKV);
    bf16_t* Wo_t = (bf16_t*)(ws + WS_WO); bf16_t* Wr_t = (bf16_t*)(ws + WS_WR); bf16_t* Wsgu = (bf16_t*)(ws + WS_WSGU); bf16_t* memn = (bf16_t*)(ws + WS_MEMN);
    bf16_t* Km = (bf16_t*)(ws + WS_KM); bf16_t* Vt = (bf16_t*)(ws + WS_VT); bf16_t* Wgu_t = (bf16_t*)(ws + WS_WGU); bf16_t* Wd_t = (bf16_t*)(ws + WS_WD);
    bf16_t* Z = (bf16_t*)(ws + WS_RA); bf16_t* Qm = (bf16_t*)(ws + WS_RA); bf16_t* Sc = (bf16_t*)(ws + WS_RA + 128 * MiB); bf16_t* xg = (bf16_t*)(ws + WS_RA); bf16_t* yb = (bf16_t*)(ws + WS_RA);
    bf16_t* XN = (bf16_t*)(ws + WS_RB); bf16_t* AO = (bf16_t*)(ws + WS_RB); bf16_t* Om = (bf16_t*)(ws + WS_RB); bf16_t* act = (bf16_t*)(ws + WS_RB);
    bf16_t* x1b = (bf16_t*)(ws + WS_RC); bf16_t* x2b = (bf16_t*)(ws + WS_RC); unsigned char* x2f8 = ws + WS_X2F8;
    float* ssq1 = (float*)(ws + WS_SSQ1); float* ssq2 = (float*)(ws + WS_SSQ2); float* rstd2 = (float*)(ws + WS_SSQ1);     float* logit = (float*)(ws + WS_LOGIT);
    int* tok_e = (int*)(ws + WS_TOKE); float* tok_w = (float*)(ws + WS_TOKW); int* tok_s = (int*)(ws + WS_TOKS); int* row_tok = (int*)(ws + WS_ROWTOK); float* rowrs = (float*)(ws + WS_ROWTOK + 1 * MiB);
    const int gw = F.vcu * NWAVES + F.wave, NGW = F.G * NWAVES;
    const int lo = args.ph_lo, hi = args.ph_hi;
#define IN(k) (lo <= (k) && (k) < hi)
#if MK_ONE_LAUNCH
    volatile LAS unsigned* misc = (volatile LAS unsigned*)(F.lds + LDS_MISC);
    if (threadIdx.x < 64) misc[threadIdx.x] = 0u;
    __syncthreads();
    XcdBarrier xbar = xcd_barrier_post(ctl + CW_BAR, misc + 8, threadIdx.x == 0);
#define GRID_BAR(k) do { if (IN(k) && IN((k) + 1)) { if ((k) == 0) cg::this_grid().sync(); else xcd_barrier(xbar, F.wave == 0 && lane_id() == 0); } } while (0)
#else
#define GRID_BAR(k) do { } while (0)
#endif
#define LOCAL_SEAM() do { asm volatile("s_waitcnt vmcnt(0)" ::: "memory"); __syncthreads(); __builtin_amdgcn_fence(__ATOMIC_ACQUIRE, "agent"); asm volatile("s_waitcnt vmcnt(0)" ::: "memory"); __syncthreads(); } while (0)

    if (IN(0)) {
        const int lane_ = lane_id(), tid_ = F.wave * 64 + lane_; (void)tid_;
        LAS float* scr = (LAS float*)(F.lds + F.wave * 16384);
        constexpr int I_IN = 16 * 80, I_SQ = 16 * 32, I_KV = 16 * 64, I_G = 16 * 16, I_D = 8 * 32;
        constexpr int NITEMS = I_IN + 3 * I_SQ + I_KV + NEXP * (2 * I_G + I_D);
        for (int it = gw; it < NITEMS; it += NGW) {
            int r = it;
            if (r < I_IN) { const int kb = r / 80, nb = r % 80; transpose_item(args.in[3], ZP, kb * 64, nb * 32, Win_t + (size_t)(nb * 32) * DM, DM, nullptr, scr, lane_); continue; } r -= I_IN;
            if (r < I_SQ) { const int kb = r / 32, nb = r % 32; transpose_item(args.in[13], DM, kb * 64, nb * 32, Wout_t + (size_t)(nb * 32) * DM, DM, nullptr, scr, lane_); continue; } r -= I_SQ;
            if (r < I_SQ) { const int kb = r / 32, nb = r % 32; transpose_item_fp8(args.in[16], DM, kb * 64, nb * 32, (unsigned char*)Wq_t + (size_t)(nb * 32) * DM, DM, F8_WSCALE, args.in[14], scr, lane_); continue; } r -= I_SQ;
            if (r < I_KV) { const int kb = r / 64, nb = r % 64; transpose_item(args.in[17], 2 * DM, kb * 64, nb * 32, Wkv_t + (size_t)(nb * 32) * DM, DM, nullptr, scr, lane_); continue; } r -= I_KV;
            if (r < I_SQ) { const int kb = r / 32, nb = r % 32; transpose_item_fp8(args.in[18], DM, kb * 64, nb * 32, (unsigned char*)Wo_t + (size_t)(nb * 32) * DM, DM, F8_WSCALE, nullptr, scr, lane_); continue; } r -= I_SQ;
            const int e = r / (2 * I_G + I_D); r -= e * (2 * I_G + I_D);
            if (r < 2 * I_G) { const int up = r >= I_G; if (up) r -= I_G; const int kb = r / 16, nb = r % 16, n0 = nb * 32;
                const float* W = (up ? args.in[25] : args.in[24]) + (size_t)e * DM * DEXP;
                transpose_item_fp8(W, DEXP, kb * 64, n0, (unsigned char*)Wgu_t + ((size_t)e * 1024 + (n0 >> 7) * 256 + 64 * ((n0 & 127) >> 5) + 32 * up) * DM, DM, F8_WSCALE, args.in[19], scr, lane_); continue; }
            r -= 2 * I_G;
            { const int kb = r / 32, nb = r % 32; transpose_item_fp8(args.in[26] + (size_t)e * DEXP * DM, DM, kb * 64, nb * 32, (unsigned char*)Wd_t + ((size_t)e * 1024 + nb * 32) * DEXP, DEXP, F8_WSCALE, nullptr, scr, lane_); }
        }
        for (int i = blockIdx.x * NTHR + tid_; i < 256 * DM; i += F.G * NTHR) { const int n = i >> 10, k = i & 1023; float v = 0.f;
            if (n < 4) v = args.in[20][k * 4 + n] * args.in[19][k]; else if (n < 36) v = args.in[22][k * 32 + (n - 4)] * args.in[19][k];
            Wr_t[i] = (bf16_t)(cvt_pk_bf16(v, 0.f) & 0xffffu); }
        for (int i = blockIdx.x * NTHR + tid_; i < 4 * 128 * 128; i += F.G * NTHR) { const int t = (i >> 7) & 127, s = i & 127; const float v = s <= t ? args.in[6][i] : 0.f; Wsgu[i] = (bf16_t)(cvt_pk_bf16(v, 0.f) & 0xffffu); }
        for (int m = gw; m < M; m += 2 * NGW) rms_rows2_to_bf16(x + (size_t)m * DM, x + (size_t)(m + NGW) * DM, args.in[2], XN + (size_t)m * DM, XN + (size_t)(m + NGW) * DM, lane_);
        for (int m = gw; m < MROWS / 2; m += NGW) rms_rows2_to_bf16(args.in[1] + (size_t)m * DM, args.in[1] + (size_t)(m + MROWS / 2) * DM, args.in[15], memn + (size_t)m * DM, memn + (size_t)(m + MROWS / 2) * DM, lane_);
        __syncthreads();
    }
    GRID_BAR(0);

    if (IN(1)) {
        { pg8::Gemm g{DM, DM, DM}; pg8::PlainSched S; S.to.init(M / 256, ZP / 256, F.G, (int)blockIdx.x); S.A = (const char*)XN; S.B = (const char*)Win_t; S.tA = (size_t)256 * DM * 2; S.tB = (size_t)256 * DM * 2;
          pg8::EpiZ E{Z, ctl + CW_KMX}; pg8::gemm_phase(F.lds, F.wave, g, S, E); }
    }
    GRID_BAR(1);

    if (IN(2)) {
        const int lane_ = lane_id(), tid_ = F.wave * 64 + lane_; (void)tid_;
        float lam;
        { const float a = args.in[8][lane_] * args.in[9][lane_], b = args.in[10][lane_] * args.in[11][lane_];
          lam = __expf(wave_sum(a)) - __expf(wave_sum(b)) + 0.2f; }
        const int nitems = 32 * 16, npass = 4;
        int nit, itA, itB, itC;
        if (F.G == 256) { const int b = F.vcu >> 5, r = F.vcu & 31; if (r < 16) { nit = 1; itA = ((b * 4 + 3) << 4) | r; itB = itA; itC = itA; }
            else { const int y = r - 16; nit = 3; itA = ((b * 4 + 2) << 4) | y; itB = ((b * 4 + 1) << 4) | (15 - y); itC = ((b * 4 + 0) << 4) | y; } }
        else { const int per = (nitems + F.G - 1) / F.G; itA = F.vcu * per; int e_ = itA + per; if (e_ > nitems) e_ = nitems; nit = e_ - itA; itB = itA + 1; itC = itA + 2; }
#define ITEM_OF(i) ((F.G == 256) ? ((i) == 0 ? itA : ((i) == 1 ? itB : itC)) : itA + (i))
        if (nit > 0) {
            int ii = 0, pass = 0; da::BlockRef cur = da::mkref(Z, AO, ctl + CW_KMX, ITEM_OF(0), 0); da::Seam S;
            da::prime(cur, (char*)lds_raw, S, F.wave);
            for (;;) {
                int ni = ii, np = pass + 1; if (np == npass) { np = 0; ni = ii + 1; }
                const bool last = ni >= nit * PROBE_DUP_ATTN;
                const da::BlockRef nxt = last ? cur : da::mkref(Z, AO, ctl + CW_KMX, ITEM_OF(ni % nit), np);
                da::block(cur, nxt, (char*)lds_raw, S, lam, args.in[12], F.wave);
                if (last) break;
                cur = nxt; ii = ni; pass = np;
            }
        }
#undef ITEM_OF
        __syncthreads();
        {
            const int lane = lane_, w = F.wave;
            const int nun = (M / 128) * 4;
            const int ch0 = (lane & 15) * 8, t = 16 * w + (lane & 15), nks = (w + 2) >> 1;
            u32x4 vr[4];
            LAS int* sq = (LAS int*)(F.lds + 2 * 34816);
            const bool puller = (w == 0 && lane == 0);
            if (puller) { sq[0] = (int)atomicAdd(ctl + CW_SGUQ, 1u); sq[1] = (int)atomicAdd(ctl + CW_SGUQ, 1u); }
            __syncthreads();
            int uidx = __builtin_amdgcn_readfirstlane(sq[0]), unext = __builtin_amdgcn_readfirstlane(sq[1]), kk = 0;
            if (uidx < nun) { const size_t R0 = (size_t)(uidx >> 2) * 128; const int g = uidx & 3;
#pragma unroll
                for (int ps = 0; ps < 4; ++ps) vr[ps] = *(const u32x4*)(Z + (R0 + 16 * w + 4 * ps + (lane >> 4)) * ZP + ZV + g * 128 + ch0); }
            int gcur = -1; float lg[8], lb[8]; bf16x8 wf[4]; float bias = 0.f; int buf = 0;
#pragma unroll
            for (int j = 0; j < 8; ++j) { lg[j] = 0.f; lb[j] = 0.f; }
#pragma unroll
            for (int ks = 0; ks < 4; ++ks) wf[ks] = (bf16x8){0, 0, 0, 0, 0, 0, 0, 0};
            for (; uidx < nun; uidx = unext, unext = __builtin_amdgcn_readfirstlane(sq[(kk + 1) & 3]), buf ^= 1) {
                int pulled_ = 0; if (puller) pulled_ = (int)atomicAdd(ctl + CW_SGUQ, 1u);
                const int c = uidx >> 2, g = uidx & 3; const size_t R0 = (size_t)c * 128;
                LAS bf16_t* vnT = (LAS bf16_t*)(F.lds + buf * 34816);
                if (g != gcur) { gcur = g;
#pragma unroll
                    for (int j = 0; j < 8; ++j) { lg[j] = args.in[4][g * 128 + ch0 + j]; lb[j] = args.in[5][g * 128 + ch0 + j]; }
#pragma unroll
                    for (int ks = 0; ks < 4; ++ks) if (ks < nks) wf[ks] = *(const bf16x8*)(Wsgu + ((size_t)g * 128 + t) * 128 + ks * 32 + 8 * (lane >> 4));
                    bias = args.in[7][g * 128 + t]; }
#pragma unroll
                for (int ps = 0; ps < 4; ++ps) { const int sr = 16 * w + 4 * ps + (lane >> 4); const u32x4 raw = vr[ps];
                    float v[8] = {bf_lo(raw.x), bf_hi(raw.x), bf_lo(raw.y), bf_hi(raw.y), bf_lo(raw.z), bf_hi(raw.z), bf_lo(raw.w), bf_hi(raw.w)};
                    float sm = 0.f;
#pragma unroll
                    for (int j = 0; j < 8; ++j) sm += v[j];
#pragma unroll
                    for (int o = 1; o < 16; o <<= 1) sm += __shfl_xor(sm, o);
                    const float mu = sm * (1.f / 128.f); float q = 0.f;
#pragma unroll
                    for (int j = 0; j < 8; ++j) { v[j] -= mu; q += v[j] * v[j]; }
#pragma unroll
                    for (int o = 1; o < 16; o <<= 1) q += __shfl_xor(q, o);
                    const float rstd = __builtin_amdgcn_rsqf(q * (1.f / 128.f) + LN_EPS);
#pragma unroll
                    for (int j = 0; j < 8; ++j) { const float y = v[j] * rstd * lg[j] + lb[j]; vnT[(ch0 + j) * 136 + sr] = (bf16_t)(cvt_pk_bf16(y, 0.f) & 0xffffu); } }
                u32x2 ur[8];
#pragma unroll
                for (int mi = 0; mi < 8; ++mi) ur[mi] = *(const u32x2*)(Z + (R0 + t) * ZP + ZU + g * 128 + 16 * mi + 4 * (lane >> 4));
                { const int un = unext; if (un < nun) { const size_t Rn = (size_t)(un >> 2) * 128; const int gn = un & 3;
#pragma unroll
                    for (int ps = 0; ps < 4; ++ps) vr[ps] = *(const u32x4*)(Z + (Rn + 16 * w + 4 * ps + (lane >> 4)) * ZP + ZV + gn * 128 + ch0); } }
                if (puller) sq[(kk + 2) & 3] = pulled_;
                ++kk;
                __syncthreads();
                f32x4 acc[8];
#pragma unroll
                for (int mi = 0; mi < 8; ++mi) acc[mi] = (f32x4){0.f, 0.f, 0.f, 0.f};
#pragma unroll
                for (int ks = 0; ks < 4; ++ks) if (ks < nks) {
#pragma unroll
                    for (int mi = 0; mi < 8; ++mi) { const bf16x8 afr = *(const LAS bf16x8*)(vnT + (16 * mi + (lane & 15)) * 136 + ks * 32 + 8 * (lane >> 4));
                        acc[mi] = __builtin_amdgcn_mfma_f32_16x16x32_bf16(afr, wf[ks], acc[mi], 0, 0, 0); } }
#pragma unroll
                for (int mi = 0; mi < 8; ++mi) { const int ch = 16 * mi + 4 * (lane >> 4); const u32x2 u2 = ur[mi];
                    const float o0 = bf_lo(u2.x) * (acc[mi][0] + bias), o1 = bf_hi(u2.x) * (acc[mi][1] + bias), o2 = bf_lo(u2.y) * (acc[mi][2] + bias), o3 = bf_hi(u2.y) * (acc[mi][3] + bias);
                    u32x2 wv; wv.x = cvt_pk_bf16(o0, o1); wv.y = cvt_pk_bf16(o2, o3);
                    *(u32x2*)(AO + (R0 + t) * DM + g * 128 + ch) = wv; }
            }
            __syncthreads();
        }
        {
            int e = -1;
            if (F.G == 256) { const int b = F.vcu >> 5, r = F.vcu & 31; if (r >= 16 && r < 24) e = b * 8 + (r - 16); }
            for (int e2 = (F.G == 256 ? e : F.vcu); e2 >= 0 && e2 < 64; e2 = (F.G == 256 ? 64 : e2 + F.G)) {
                pg8::Gemm g{DM, DM, DM}; pg8::OneUnitSched S;
                if (e2 < 32) { S.u0.pm = e2 >> 2; S.u0.pn = e2 & 3; S.u0.aux = 0; S.u0.rows = nullptr; S.u0.A = (const char*)(memn + (size_t)S.u0.pm * 256 * DM); S.u0.B = (const char*)(Wkv_t + (size_t)S.u0.pn * 256 * DM);
                    pg8::EpiBf16 E{Km, DM, nullptr, 1.f}; pg8::gemm_phase(F.lds, F.wave, g, S, E); }
                else { const int e3 = e2 - 32; S.u0.pm = e3 >> 3; S.u0.pn = e3 & 7; S.u0.aux = 0; S.u0.rows = nullptr; S.u0.A = (const char*)(Wkv_t + (size_t)(1024 + S.u0.pm * 256) * DM); S.u0.B = (const char*)(memn + (size_t)S.u0.pn * 256 * DM);
                    pg8::EpiBf16 E{Vt, MROWS, nullptr, 1.f}; pg8::gemm_phase(F.lds, F.wave, g, S, E); }
            }
        }
    }
    GRID_BAR(2);

    if (IN(3)) {
        pg8::Gemm g{DM, DM, DM}; pg8::PlainSched S; S.to.init(M / 256, 4, F.G, (int)blockIdx.x); S.A = (const char*)AO; S.B = (const char*)Wout_t; S.tA = (size_t)256 * DM * 2; S.tB = (size_t)256 * DM * 2;
        pg8::EpiResid<false> E{x, x1b, ssq1, (LAS float*)(F.lds + 131072 + 1024), x2f8, 1.f}; pg8::gemm_phase(F.lds, F.wave, g, S, E);
    }
    GRID_BAR(3);

    if (IN(4)) {
        pg8::Gemm g{DM / 2, DM / 2, DM / 2}; pg8::PlainSched S; S.to.init(M / 256, 4, F.G, (int)blockIdx.x); S.A = (const char*)x2f8; S.B = (const char*)Wq_t; S.tA = (size_t)256 * DM; S.tB = (size_t)256 * DM;
        pg8::EpiBf16 E{Qm, DM, ssq1, C2_MEM / (F8_XSCALE * F8_WSCALE)}; pg8::gemm_phase<pg8::EpiBf16, pg8::PlainSched, false, true>(F.lds, F.wave, g, S, E);
    }
    if (MK_ONE_LAUNCH && IN(4) && IN(5)) LOCAL_SEAM();

    if (IN(5)) {
        pg8::Gemm g{DM, DM, 256}; pg8::MemAttnSched S; S.to.init(M / 256, 4, F.G, (int)blockIdx.x); S.A = (const char*)Qm; S.B = (const char*)Km; S.bB = (size_t)256 * DM * 2; S.hB = 512;
        pg8::EpiSoftmax E{Sc, (LAS float*)(F.lds + LDS_MISC + 1024)}; pg8::gemm_phase(F.lds, F.wave, g, S, E);
    }
    if (MK_ONE_LAUNCH && IN(5) && IN(6 + 1)) LOCAL_SEAM();

    if (IN(7)) {
        pg8::Gemm g{DM, MROWS, 256}; pg8::MemAttnSched S; S.to.init(M / 256, 4, F.G, (int)blockIdx.x); S.A = (const char*)Sc; S.B = (const char*)Vt; S.bB = 512; S.hB = (size_t)256 * MROWS * 2;
        pg8::EpiF8 E{(unsigned char*)Om, F8_OSCALE}; pg8::gemm_phase(F.lds, F.wave, g, S, E);
    }
    GRID_BAR(7);

    if (IN(8)) {
        pg8::Gemm g{DM / 2, DM / 2, DM / 2}; pg8::PlainSched S; S.to.init(M / 256, 4, F.G, (int)blockIdx.x); S.A = (const char*)Om; S.B = (const char*)Wo_t; S.tA = (size_t)256 * DM; S.tB = (size_t)256 * DM;
        pg8::EpiResid<true> E{x1b, x2b, ssq2, (LAS float*)(F.lds + 131072 + 1024), x2f8, 1.0f / (F8_OSCALE * F8_WSCALE)}; pg8::gemm_phase<pg8::EpiResid<true>, pg8::PlainSched, false, true>(F.lds, F.wave, g, S, E);
    }
    GRID_BAR(8);

    if (IN(9)) {
        pg8::Gemm g{DM, DM, DM}; pg8::PlainSched S; S.to.init(M / 256, 1, F.G, (int)blockIdx.x); S.A = (const char*)x2b; S.B = (const char*)Wr_t; S.tA = (size_t)256 * DM * 2; S.tB = 0;
        pg8::EpiRouter E{logit, ssq2, args.in[21], args.in[23], rstd2}; pg8::gemm_phase(F.lds, F.wave, g, S, E);
    }
    GRID_BAR(9);

    if (IN(10)) {
        const int lane_ = lane_id(), tid_ = F.wave * 64 + lane_; (void)tid_;
        LAS unsigned* lcnt = (LAS unsigned*)F.lds; LAS unsigned* lbase = lcnt + 32;
        for (int t0 = blockIdx.x * NTHR; t0 < M; t0 += F.G * NTHR) {
            if (tid_ < 32) lcnt[tid_] = 0u;
            __syncthreads();
            const int tok = t0 + tid_;
            const f32x4 lg = *(const f32x4*)(logit + (size_t)tok * 64);
            int gi = 0; float gm = lg[0];
#pragma unroll
            for (int j = 1; j < 4; ++j) if (lg[j] > gm) { gm = lg[j]; gi = j; }
            float gs = 0.f;
#pragma unroll
            for (int j = 0; j < 4; ++j) gs += __expf(lg[j] - gm);
            const float gate = 1.0f / gs;
            const f32x4 ea = *(const f32x4*)(logit + (size_t)tok * 64 + 4 + gi * 8), eb = *(const f32x4*)(logit + (size_t)tok * 64 + 8 + gi * 8);
            const float el[8] = {ea[0], ea[1], ea[2], ea[3], eb[0], eb[1], eb[2], eb[3]};
            int i0 = 0; float m0 = el[0];
#pragma unroll
            for (int j = 1; j < 8; ++j) if (el[j] > m0) { m0 = el[j]; i0 = j; }
            int i1 = -1; float m1 = -__builtin_inff();
#pragma unroll
            for (int j = 0; j < 8; ++j) if (j != i0 && el[j] > m1) { m1 = el[j]; i1 = j; }
            if (i1 < 0) i1 = (i0 == 0) ? 1 : 0;
            const float r = __expf(m1 - m0);
            const float w0 = gate / (1.0f + r), w1 = gate * r / (1.0f + r);
            const int e0 = gi * 8 + i0, e1 = gi * 8 + i1;
            const unsigned r0 = atomicAdd((unsigned*)&lcnt[e0], 1u), r1 = atomicAdd((unsigned*)&lcnt[e1], 1u);
            __syncthreads();
            if (tid_ < 32) lbase[tid_] = atomicAdd(ctl + CW_CNT + tid_, lcnt[tid_]);
            __syncthreads();
            tok_e[tok * 2] = e0; tok_e[tok * 2 + 1] = e1; tok_w[tok * 2] = w0; tok_w[tok * 2 + 1] = w1;
            tok_s[tok * 2] = (int)(lbase[e0] + r0); tok_s[tok * 2 + 1] = (int)(lbase[e1] + r1);
            __syncthreads();
        }
    }
    GRID_BAR(10);

    if (IN(11)) {
        const int lane_ = lane_id(), tid_ = F.wave * 64 + lane_; (void)tid_;
        LAS unsigned* lps = (LAS unsigned*)F.lds;
        if (tid_ == 0) { unsigned acc = 0; for (int e = 0; e < 32; ++e) { lps[e] = acc; const unsigned c = ld_u32_agent(ctl + CW_CNT + e); acc += (c + 255u) & ~255u; } lps[32] = acc; }
        __syncthreads();
        if (blockIdx.x == 0) {
            if (tid_ < 32) { const unsigned s = lps[tid_], e2 = lps[tid_ + 1], c = ld_u32_agent(ctl + CW_CNT + tid_);
                for (unsigned b = s >> 8; b < (e2 >> 8); ++b) ctl[CW_BLKE + b] = (unsigned)tid_;
                for (unsigned r = s + c; r < e2; ++r) { row_tok[r] = 0; rowrs[r] = 0.f; } }
            if (tid_ == 0) ctl[CW_NBLK] = lps[32] >> 8;
        }
        for (int a = blockIdx.x * NTHR + tid_; a < M * 2; a += F.G * NTHR) { const int e = tok_e[a]; const int pos = (int)lps[e] + tok_s[a]; row_tok[pos] = a >> 1; tok_s[a] = pos; rowrs[pos] = rstd2[a >> 1] * (1.0f / (F8_XSCALE * F8_WSCALE)); }
        __syncthreads();
    }
    GRID_BAR(11);

    if (IN(12)) {
        const int nblk = (int)__builtin_amdgcn_readfirstlane(ld_u32_agent(ctl + CW_NBLK));
        pg8::Gemm g{DM / 2, DM / 2, DM / 2}; pg8::MoeSched S{F.G, F.vcu, nblk, ctl + CW_BLKE, (const char*)x2f8, (const char*)Wgu_t, (size_t)0, (size_t)1024 * DM, (size_t)256 * DM, row_tok};
        pg8::EpiGateUp E{(unsigned char*)act, rowrs, row_tok}; pg8::gemm_phase<pg8::EpiGateUp, pg8::MoeSched, true, true>(F.lds, F.wave, g, S, E);
    }
    GRID_BAR(12);

    if (IN(13)) {
        const int nblk = (int)__builtin_amdgcn_readfirstlane(ld_u32_agent(ctl + CW_NBLK));
        pg8::Gemm g{DEXP / 2, DEXP / 2, DEXP / 2}; pg8::MoeSched S{F.G, F.vcu, nblk, ctl + CW_BLKE, (const char*)act, (const char*)Wd_t, (size_t)256 * DEXP, (size_t)1024 * DEXP, (size_t)256 * DEXP, row_tok};
        pg8::EpiBf16 E{yb, DM, nullptr, 1.0f / (F8_WSCALE * F8_ASCALE)}; pg8::gemm_phase<pg8::EpiBf16, pg8::MoeSched, false, true>(F.lds, F.wave, g, S, E);
    }
    GRID_BAR(13);

    if (IN(14)) {
        const int lane_ = lane_id(), tid_ = F.wave * 64 + lane_; (void)tid_;
        const f32x4* gr = (const f32x4*)args.in[27] + lane_;
        f32x4 gg[4];
#pragma unroll
        for (int j = 0; j < 4; ++j) gg[j] = gr[64 * j];
        for (int m = gw; m < M; m += 2 * NGW) {
            const int ma = m, mb = m + NGW;
            const int pa0 = tok_s[ma * 2], pa1 = tok_s[ma * 2 + 1], pb0 = tok_s[mb * 2], pb1 = tok_s[mb * 2 + 1];
            const float wa0 = tok_w[ma * 2], wa1 = tok_w[ma * 2 + 1], wb0 = tok_w[mb * 2], wb1 = tok_w[mb * 2 + 1];
            const u32x2* xa = (const u32x2*)(x2b + (size_t)ma * DM) + lane_; const u32x2* xb = (const u32x2*)(x2b + (size_t)mb * DM) + lane_;
            const u32x2* ya0 = (const u32x2*)(yb + (size_t)pa0 * DM) + lane_; const u32x2* ya1 = (const u32x2*)(yb + (size_t)pa1 * DM) + lane_;
            const u32x2* yb0 = (const u32x2*)(yb + (size_t)pb0 * DM) + lane_; const u32x2* yb1 = (const u32x2*)(yb + (size_t)pb1 * DM) + lane_;
            u32x2 ca[4], cb[4], a0[4], a1[4], b0[4], b1[4];
#pragma unroll
            for (int j = 0; j < 4; ++j) { ca[j] = xa[64 * j]; cb[j] = xb[64 * j]; a0[j] = ya0[64 * j]; a1[j] = ya1[64 * j]; b0[j] = yb0[64 * j]; b1[j] = yb1[64 * j]; }
            f32x4 va[4], vb[4]; float sa = 0.f, sb = 0.f;
#pragma unroll
            for (int j = 0; j < 4; ++j) {
                va[j].x = bf_lo(ca[j].x) + wa0 * bf_lo(a0[j].x) + wa1 * bf_lo(a1[j].x); va[j].y = bf_hi(ca[j].x) + wa0 * bf_hi(a0[j].x) + wa1 * bf_hi(a1[j].x);
                va[j].z = bf_lo(ca[j].y) + wa0 * bf_lo(a0[j].y) + wa1 * bf_lo(a1[j].y); va[j].w = bf_hi(ca[j].y) + wa0 * bf_hi(a0[j].y) + wa1 * bf_hi(a1[j].y);
                vb[j].x = bf_lo(cb[j].x) + wb0 * bf_lo(b0[j].x) + wb1 * bf_lo(b1[j].x); vb[j].y = bf_hi(cb[j].x) + wb0 * bf_hi(b0[j].x) + wb1 * bf_hi(b1[j].x);
                vb[j].z = bf_lo(cb[j].y) + wb0 * bf_lo(b0[j].y) + wb1 * bf_lo(b1[j].y); vb[j].w = bf_hi(cb[j].y) + wb0 * bf_hi(b0[j].y) + wb1 * bf_hi(b1[j].y);
                sa += (va[j].x * va[j].x + va[j].y * va[j].y) + (va[j].z * va[j].z + va[j].w * va[j].w); sb += (vb[j].x * vb[j].x + vb[j].y * vb[j].y) + (vb[j].z * vb[j].z + vb[j].w * vb[j].w); }
            const float ra = __builtin_amdgcn_rsqf(wave_sum(sa) * (1.f / DM) + RMS_EPS), rb = __builtin_amdgcn_rsqf(wave_sum(sb) * (1.f / DM) + RMS_EPS);
            f32x4* oa = (f32x4*)(out + (size_t)ma * DM) + lane_; f32x4* ob = (f32x4*)(out + (size_t)mb * DM) + lane_;
#pragma unroll
            for (int j = 0; j < 4; ++j) { oa[64 * j] = va[j] * ra * gg[j]; ob[64 * j] = vb[j] * rb * gg[j]; }
        }
    }
#undef IN
#undef GRID_BAR
}

extern "C" void kernel_launch(void* const* d_in, const int* in_sizes, int n_in, void* d_out, int out_size, void* d_ws, size_t ws_size, hipStream_t stream) {
    static int grid = 0;
    if (grid == 0) {
        if (n_in != 28 || in_sizes[0] != M * DM || out_size != M * DM || ws_size < WS_END) { fprintf(stderr, "kernel_launch: unexpected shapes (n_in %d in0 %d out %d ws %zu)\n", n_in, n_in > 0 ? in_sizes[0] : -1, out_size, ws_size); grid = -1; return; }
        int dev = 0, cus = 0, per_cu = 0;
        if (hipGetDevice(&dev) != hipSuccess || hipDeviceGetAttribute(&cus, hipDeviceAttributeMultiprocessorCount, dev) != hipSuccess) { grid = -1; return; }
        if (hipFuncSetAttribute((const void*)mega, hipFuncAttributeMaxDynamicSharedMemorySize, LDS_BYTES) != hipSuccess) { fprintf(stderr, "kernel_launch: hipFuncSetAttribute failed\n"); grid = -1; return; }
        if (hipOccupancyMaxActiveBlocksPerMultiprocessor(&per_cu, (const void*)mega, NTHR, LDS_BYTES) != hipSuccess || per_cu < 1) { fprintf(stderr, "kernel_launch: occupancy query says %d\n", per_cu); per_cu = 1; }
        (void)hipGetLastError();
        grid = cus;
    }
    if (grid < 0) return;
    (void)hipMemsetAsync((char*)d_ws + WS_CTL, 0, CTL_BYTES, stream);
    Args a{};
    for (int i = 0; i < 28; ++i) a.in[i] = (const float*)d_in[i];
    a.out = (float*)d_out; a.ws = (unsigned char*)d_ws;
#if MK_ONE_LAUNCH
    a.ph_lo = 0; a.ph_hi = N_PHASES;
    void* kargs[] = {&a};
    hipError_t e = hipLaunchCooperativeKernel((const void*)mega, dim3(grid), dim3(NTHR), kargs, LDS_BYTES, stream);
    if (e != hipSuccess) fprintf(stderr, "cooperative launch failed: %s (grid %d)\n", hipGetErrorString(e), grid);
#else
    for (int p = 0; p < N_PHASES; ++p) { a.ph_lo = p; a.ph_hi = p + 1; hipLaunchKernelGGL(mega, dim3(grid), dim3(NTHR), LDS_BYTES, stream, a); }
#endif
}
```

```cpp
#include <hip/hip_runtime.h>
#include <hip/hip_cooperative_groups.h>
#include <cstdio>
#include <cstdint>
namespace cg = cooperative_groups;

#ifndef PROBE_DUP
#define PROBE_DUP -1
#endif
#ifndef PROBE_DUP_ATTN
#define PROBE_DUP_ATTN 1
#endif
#ifndef MK_ONE_LAUNCH
#define MK_ONE_LAUNCH 1
#endif

#define LAS __attribute__((address_space(3)))
#define GAS __attribute__((address_space(1)))
typedef unsigned short bf16_t;
typedef short bf16x8 __attribute__((ext_vector_type(8)));
typedef short s16x4 __attribute__((ext_vector_type(4)));
typedef float f32x2 __attribute__((ext_vector_type(2)));
typedef float f32x4 __attribute__((ext_vector_type(4)));
typedef float f32x16 __attribute__((ext_vector_type(16)));
typedef unsigned u32x2 __attribute__((ext_vector_type(2)));
typedef unsigned u32x4 __attribute__((ext_vector_type(4)));
typedef int v8i32 __attribute__((ext_vector_type(8)));

constexpr int NB = 8, SEQ = 8192, DM = 1024, M = NB * SEQ;
constexpr int ZP = 2560;
constexpr int ZU = 0, ZV = 512, ZQ = 1024, ZK = 1536, ZVAL = 2048;
constexpr int MEML = 256, MROWS = NB * MEML;
constexpr int NEXP = 32, DEXP = 512;
constexpr int PROWS = 2 * M + NEXP * 256;
constexpr int MAXBLK = PROWS / 256;
constexpr float RMS_EPS = 1e-6f, LN_EPS = 1e-5f;
constexpr float LOG2E = 1.4426950408889634f;
constexpr float C2_DIFF = 0.125f * LOG2E;
constexpr float C2_MEM = 0.0625f * LOG2E;

constexpr size_t MiB = 1u << 20;
constexpr size_t WS_CTL = 0, CTL_BYTES = 1 * MiB;
constexpr size_t WS_WIN = 1 * MiB;
constexpr size_t WS_WOUT = 6 * MiB;
constexpr size_t WS_WQ = 8 * MiB;
constexpr size_t WS_WKV = 10 * MiB;
constexpr size_t WS_WO = 14 * MiB;
constexpr size_t WS_WR = 16 * MiB;
constexpr size_t WS_WSGU = 17 * MiB;
constexpr size_t WS_MEMN = 18 * MiB;
constexpr size_t WS_KM = 22 * MiB;
constexpr size_t WS_VT = 26 * MiB;
constexpr size_t WS_WGU = 30 * MiB;
constexpr size_t WS_WD = 94 * MiB;
constexpr size_t WS_RA = 128 * MiB;
constexpr size_t WS_RB = 448 * MiB;
constexpr size_t WS_RC = 592 * MiB;
constexpr size_t WS_SSQ1 = 720 * MiB;
constexpr size_t WS_SSQ2 = 724 * MiB;
constexpr size_t WS_LOGIT = 728 * MiB;
constexpr size_t WS_TOKE = 744 * MiB;
constexpr size_t WS_TOKW = 745 * MiB;
constexpr size_t WS_TOKS = 746 * MiB;
constexpr size_t WS_ROWTOK = 747 * MiB;
constexpr size_t WS_X2F8 = 752 * MiB;
constexpr size_t WS_END = 816 * MiB;
constexpr int CW_CNT = 64;
constexpr int CW_NBLK = 128;
constexpr int CW_PSTART = 192;
constexpr int CW_BLKE = 256;
constexpr int CW_KMX = 1024;
constexpr int CW_SGUQ = 1344;
constexpr int CW_BAR = 4096;
constexpr int LDS_MISC = 131072;
constexpr int LDS_TBUF = 140288, TBUF_W = 2304;

__device__ __forceinline__ unsigned cvt_pk_bf16(float lo, float hi) { unsigned r; asm volatile("v_cvt_pk_bf16_f32 %0, %1, %2" : "=v"(r) : "v"(lo), "v"(hi)); return r; }
__device__ __forceinline__ float bf_lo(unsigned w) { return __uint_as_float(w << 16); }
__device__ __forceinline__ float bf_hi(unsigned w) { return __uint_as_float(w & 0xffff0000u); }
constexpr float F8_WSCALE = 256.f, F8_ASCALE = 8.f, F8_XSCALE = 4.f, F8_OSCALE = 16.f, F8_YSCALE = 16.f, F8_QSCALE = 64.f, F8_KSCALE = 16.f, F8_PSCALE = 256.f, F8_VSCALE = 16.f;
__device__ __forceinline__ unsigned pk4_fp8(float a, float b, float c, float d) {
    a = fminf(fmaxf(a, -448.f), 448.f); b = fminf(fmaxf(b, -448.f), 448.f); c = fminf(fmaxf(c, -448.f), 448.f); d = fminf(fmaxf(d, -448.f), 448.f);
    int w = 0; w = __builtin_amdgcn_cvt_pk_fp8_f32(a, b, w, false); w = __builtin_amdgcn_cvt_pk_fp8_f32(c, d, w, true); return (unsigned)w; }
__device__ __forceinline__ float wave_sum(float v) {
#pragma unroll
    for (int o = 1; o < 64; o <<= 1) v += __shfl_xor(v, o);
    return v;
}
__device__ __forceinline__ float wave_max(float v) {
#pragma unroll
    for (int o = 1; o < 64; o <<= 1) v = fmaxf(v, __shfl_xor(v, o));
    return v;
}
__device__ __forceinline__ int lane_id() { int l; asm volatile("v_mbcnt_lo_u32_b32 %0, -1, 0\n\tv_mbcnt_hi_u32_b32 %0, -1, %0" : "=v"(l)); return l; }
__device__ __forceinline__ unsigned ld_u32_agent(const unsigned* p) { return __hip_atomic_load(p, __ATOMIC_RELAXED, __HIP_MEMORY_SCOPE_AGENT); }

namespace pg8 {
constexpr int BM = 256, BK = 64, HALF = 128, HTB = HALF * BK * 2, STAGE_BYTES = 8 * HTB, NXCD = 8, WGM = 8;
__host__ __device__ __forceinline__ int lds_byte(int r, int c) { const int st = (r >> 4) * 2 + (c >> 5), rr = r & 15, cc = c & 31, ob = rr * 64 + cc * 2; return st * 1024 + (ob ^ (((ob >> 9) & 1) << 5)); }
__host__ __device__ __forceinline__ void stage_rc(int b, int& R, int& C) { const int st = b / 1024, sb = b % 1024, swz = sb ^ (((sb >> 9) & 1) << 5); R = (st >> 1) * 16 + swz / 64; C = (st & 1) * 32 + (swz % 64) / 2; }
__host__ __device__ __forceinline__ int perm32(int rho) { const int n = rho >> 4, i = rho & 15; return 8 * (i >> 2) + 4 * n + (i & 3); }

struct Unit { const char* A; const char* B; int pm, pn, aux; const int* rows; };
struct Gemm { int lda, ldb, K; };

struct TileOrder {
    int nM, nN, nwg, G, c;
    __device__ void init(int nM_, int nN_, int G_, int c_) { nM = nM_; nN = nN_; nwg = nM * nN; G = G_; c = c_; }
    __device__ bool get(int i, int& pm, int& pn) const {
        const long L = (long)i * G + c; if (L >= nwg) return false;
        int wgid = (int)L; { const int q = nwg / NXCD, r = nwg % NXCD, xcd = wgid % NXCD, off = wgid / NXCD; wgid = (xcd < r ? xcd * (q + 1) : r * (q + 1) + (xcd - r) * q) + off; }
        const int nig = WGM * nN, gid = wgid / nig, fm = gid * WGM, gsz = (nM - fm) < WGM ? (nM - fm) : WGM;
        pm = fm + ((wgid % nig) % gsz); pn = (wgid % nig) / gsz; return true;
    }
};

typedef float f32x2g __attribute__((ext_vector_type(2)));
__device__ __forceinline__ f32x2g gelu_pk(f32x2g v) {
    const f32x2g av = __builtin_elementwise_abs(v), d = av * 0.2316418882f + 1.0f;
    f32x2g t; t.x = __builtin_amdgcn_rcpf(d.x); t.y = __builtin_amdgcn_rcpf(d.y);
    f32x2g q = t * 0.5307027145f + (-0.7265760135f); q = q * t + 0.7107068705f; q = q * t + (-0.142248368f); q = q * t + 0.127414796f; q = q * t;
    const f32x2g s = (v * v) * (-0.72134752044f);
    f32x2g e; e.x = __builtin_amdgcn_exp2f(s.x); e.y = __builtin_amdgcn_exp2f(s.y);
    const f32x2g m = v * (q * e), r = v - m;
    f32x2g o; o.x = v.x < 0.f ? m.x : r.x; o.y = v.y < 0.f ? m.y : r.y; return o;
}

__device__ __forceinline__ const char* uniform_ptr(const char* p) { const unsigned long long v = (unsigned long long)p; const unsigned lo = __builtin_amdgcn_readfirstlane((unsigned)v), hi = __builtin_amdgcn_readfirstlane((unsigned)(v >> 32)); return (const char*)(((unsigned long long)hi << 32) | lo); }
template <class Epi, class Sched, bool GATHER = false, bool FP8 = false>
__device__ __forceinline__ void gemm_phase(LAS unsigned char* lds, int wid, const Gemm g, const Sched& S, const Epi& E) {
    const int lane = lane_id(), tid = wid * 64 + lane, wr = wid >> 2, wc = wid & 3, fr = lane & 15, fq = lane >> 4;
    const int nt = g.K / BK;
    unsigned voffB[2]; unsigned vA0[2], vA1[2]; int RA[2], CA[2];
#pragma unroll
    for (int i = 0; i < 2; ++i) { int R, C; stage_rc(tid * 16 + i * 8192, R, C); const int pr = Epi::PERM ? perm32(R & 31) : (R & 31);
        RA[i] = R; CA[i] = C; voffB[i] = (unsigned)((64 * (R >> 5) + pr) * g.ldb + C) * 2u;
        vA0[i] = (unsigned)(R * g.lda + C) * 2u; vA1[i] = vA0[i]; }
    const size_t kstep = (size_t)(BK * 2);
    const size_t hstepA = GATHER ? (size_t)0 : (size_t)HALF * g.lda * 2, hstepB = (size_t)32 * g.ldb * 2;
    LAS u32x4* park = (LAS u32x4*)(lds + 131072 + 1024) + tid;
#define PG8_GOFF(U, d0, d1) do { _Pragma("unroll") for (int _i = 0; _i < 2; ++_i) { \
        d0[_i] = ((unsigned)(U).rows[RA[_i]] * (unsigned)g.lda + (unsigned)CA[_i]) * 2u; d1[_i] = ((unsigned)(U).rows[HALF + RA[_i]] * (unsigned)g.lda + (unsigned)CA[_i]) * 2u; } } while (0)
    const unsigned ldsw = (unsigned)wid * 1024u;
    const int aoff = lds_byte(wr * 64 + fr, fq * 8), boff = lds_byte(wc * 32 + fr, fq * 8);
#define PG8_SA(b, h) (((b) * 2 + (h)) * HTB)
#define PG8_SB(b, h) ((4 + (b) * 2 + (h)) * HTB)
#define PG8_STAGE(bufoff, gbase, voff) do { _Pragma("unroll") for (int _i = 0; _i < 2; ++_i) \
        __builtin_amdgcn_global_load_lds((const unsigned*)((const char*)(gbase) + (voff)[_i]), (LAS unsigned*)(lds + (bufoff) + ldsw + _i * 8192), 16, 0, 0); } while (0)
#define PG8_LD8(dst_, addr_) do { const u32x4 lo_ = *(const LAS u32x4*)(addr_), hi_ = *(const LAS u32x4*)((addr_) + 1024); \
        dst_ = (v8i32){(int)lo_.x, (int)lo_.y, (int)lo_.z, (int)lo_.w, (int)hi_.x, (int)hi_.y, (int)hi_.z, (int)hi_.w}; } while (0)
#define PG8_LDA(dst, b, h) do { _Pragma("unroll") for (int m = 0; m < 4; ++m) PG8_LD8(dst[m], lds + PG8_SA(b, h) + aoff + m * 2048); } while (0)
#define PG8_LDB(dst, b, h) do { _Pragma("unroll") for (int n = 0; n < 2; ++n) PG8_LD8(dst[n], lds + PG8_SB(b, h) + boff + n * 2048); } while (0)
#define PG8_HALF(v_, k_) __builtin_bit_cast(bf16x8, __builtin_shufflevector(v_, v_, 4 * (k_) + 0, 4 * (k_) + 1, 4 * (k_) + 2, 4 * (k_) + 3))
#define PG8_MMA(ai, bj, At, Bt) do { __builtin_amdgcn_s_setprio(1); _Pragma("unroll") for (int m = 0; m < 4; ++m) _Pragma("unroll") for (int n = 0; n < 2; ++n) { \
        if constexpr (FP8) asm volatile("v_mfma_scale_f32_16x16x128_f8f6f4 %0, %1, %2, %0, %3, %3 op_sel_hi:[0,0,0]" : "+v"(acc[ai][bj][m][n]) : "v"(Bt[n]), "v"(At[m]), "v"(one8_));   \
        else { acc[ai][bj][m][n] = __builtin_amdgcn_mfma_f32_16x16x32_bf16(PG8_HALF(Bt[n], 0), PG8_HALF(At[m], 0), acc[ai][bj][m][n], 0, 0, 0); \
               acc[ai][bj][m][n] = __builtin_amdgcn_mfma_f32_16x16x32_bf16(PG8_HALF(Bt[n], 1), PG8_HALF(At[m], 1), acc[ai][bj][m][n], 0, 0, 0); } } \
        __builtin_amdgcn_s_setprio(0); } while (0)
#define PG8_WAIT_V(n) asm volatile("s_waitcnt vmcnt(" #n ")" ::: "memory")
#define PG8_WAIT_L(n) asm volatile("s_waitcnt lgkmcnt(" #n ")" ::: "memory")
#define PG8_BAR __builtin_amdgcn_s_barrier()
#define PG8_SCHED __builtin_amdgcn_sched_barrier(0)
    Unit cur, nxt; int ui = 0;
    if (!S.next(0, cur)) return;
    f32x4 acc[2][2][4][2];
#pragma unroll
    for (int a = 0; a < 2; ++a)
#pragma unroll
        for (int b = 0; b < 2; ++b)
#pragma unroll
            for (int m = 0; m < 4; ++m)
#pragma unroll
                for (int n = 0; n < 2; ++n) acc[a][b][m][n] = (f32x4){0.f, 0.f, 0.f, 0.f};
    v8i32 At[4], B0[2], B1[2];
    const int one8_ = 0x7f7f7f7f;
    const char* cA = uniform_ptr(cur.A); const char* cB = uniform_ptr(cur.B);
    if constexpr (GATHER) { PG8_GOFF(cur, vA0, vA1); }
    PG8_STAGE(PG8_SB(0, 0), cB, voffB); PG8_STAGE(PG8_SB(0, 1), cB + hstepB, voffB); PG8_STAGE(PG8_SA(0, 0), cA, vA0); PG8_STAGE(PG8_SA(0, 1), cA + hstepA, vA1);
    if (wr == 1) PG8_BAR;
    PG8_WAIT_V(2); PG8_BAR;
    PG8_STAGE(PG8_SB(1, 0), cB + kstep, voffB); PG8_STAGE(PG8_SA(1, 0), cA + kstep, vA0); PG8_STAGE(PG8_SB(1, 1), cB + hstepB + kstep, voffB);
    PG8_WAIT_V(6); PG8_BAR;
    for (;;) {
        const bool has_next = S.next(ui + 1, nxt);
        const char* nA = has_next ? uniform_ptr(nxt.A) : cA; const char* nB = has_next ? uniform_ptr(nxt.B) : cB;
        if constexpr (GATHER) { unsigned n0[2] = {vA0[0], vA0[1]}, n1[2] = {vA1[0], vA1[1]}; if (has_next) { PG8_GOFF(nxt, n0, n1); } *park = (u32x4){n0[0], n0[1], n1[0], n1[1]}; }
#pragma nounroll
        for (int t = 0; t < nt; t += 2) {
            const bool last = (t == nt - 2);
            const char* a1 = cA + (size_t)(t + 1) * kstep;
            const char* a2 = uniform_ptr(last ? nA : cA + (size_t)(t + 2) * kstep); const char* b2 = uniform_ptr(last ? nB : cB + (size_t)(t + 2) * kstep);
            const char* a3 = a2 + kstep; const char* b3 = b2 + kstep;
            unsigned w0[2] = {vA0[0], vA0[1]}, w1[2] = {vA1[0], vA1[1]};
            if constexpr (GATHER) { if (last) { const u32x4 pk = *park; w0[0] = pk.x; w0[1] = pk.y; w1[0] = pk.z; w1[1] = pk.w; } }
            PG8_LDB(B0, 0, 0); PG8_LDB(B1, 0, 1); PG8_SCHED; PG8_LDA(At, 0, 0); PG8_STAGE(PG8_SA(1, 1), a1 + hstepA, vA1);
            PG8_WAIT_V(8); PG8_WAIT_L(0); PG8_BAR; PG8_MMA(0, 0, At, B0); PG8_MMA(0, 1, At, B1); PG8_BAR; PG8_SCHED;
            PG8_LDA(At, 0, 1); PG8_STAGE(PG8_SB(0, 0), b2, voffB); PG8_STAGE(PG8_SB(0, 1), b2 + hstepB, voffB); PG8_STAGE(PG8_SA(0, 0), a2, w0);
            PG8_WAIT_V(8); PG8_WAIT_L(0); PG8_BAR; PG8_MMA(1, 0, At, B0); PG8_MMA(1, 1, At, B1); PG8_BAR; PG8_SCHED;
            PG8_LDB(B0, 1, 0); PG8_LDB(B1, 1, 1); PG8_SCHED; PG8_LDA(At, 1, 0); PG8_STAGE(PG8_SA(0, 1), a2 + hstepA, w1);
            PG8_WAIT_V(8); PG8_WAIT_L(0); PG8_BAR; PG8_MMA(0, 0, At, B0); PG8_MMA(0, 1, At, B1); PG8_BAR; PG8_SCHED;
            PG8_LDA(At, 1, 1); PG8_STAGE(PG8_SB(1, 0), b3, voffB); PG8_STAGE(PG8_SB(1, 1), b3 + hstepB, voffB); PG8_STAGE(PG8_SA(1, 0), a3, w0);
            PG8_WAIT_V(8); PG8_WAIT_L(0); PG8_BAR; PG8_MMA(1, 0, At, B0); PG8_MMA(1, 1, At, B1); PG8_BAR; PG8_SCHED;
        }
        if (wr == 0) PG8_BAR;
        if constexpr (FP8) asm volatile("s_nop 15\n\ts_nop 7" ::: "memory");
        asm volatile("" ::: "memory");
        { const int l2_ = lane_id(); E(acc, cur, wr, wc, l2_ & 15, l2_ >> 4, lds + LDS_TBUF + wid * TBUF_W); }
        if (!has_next) break;
#pragma unroll
        for (int a = 0; a < 2; ++a)
#pragma unroll
            for (int b = 0; b < 2; ++b)
#pragma unroll
                for (int m = 0; m < 4; ++m)
#pragma unroll
                    for (int n = 0; n < 2; ++n) acc[a][b][m][n] = (f32x4){0.f, 0.f, 0.f, 0.f};
        cur = nxt; cA = nA; cB = nB; ++ui;
        if constexpr (GATHER) { const u32x4 pk = *park; vA0[0] = pk.x; vA0[1] = pk.y; vA1[0] = pk.z; vA1[1] = pk.w; }
        if (wr == 1) PG8_BAR;
    }
    PG8_WAIT_V(0);
    PG8_BAR;
#undef PG8_GOFF
#undef PG8_SA
#undef PG8_SB
#undef PG8_STAGE
#undef PG8_LD8
#undef PG8_HALF
#undef PG8_LDA
#undef PG8_LDB
#undef PG8_MMA
#undef PG8_WAIT_V
#undef PG8_WAIT_L
#undef PG8_BAR
#undef PG8_SCHED
}

struct PlainSched {
    TileOrder to; const char* A; const char* B; size_t tA, tB;
    __device__ __forceinline__ bool next(int i, Unit& u) const { int pm, pn; if (!to.get(i, pm, pn)) return false; u.pm = pm; u.pn = pn; u.aux = 0; u.rows = nullptr; u.A = A + (size_t)pm * tA; u.B = B + (size_t)pn * tB; return true; }
};
struct OneUnitSched {
    Unit u0;
    __device__ __forceinline__ bool next(int i, Unit& u) const { if (i != 0) return false; u = u0; return true; }
};
struct MemAttnSched {
    TileOrder to; const char* A; const char* B; size_t tA, hA, bB, hB;
    __device__ __forceinline__ bool next(int i, Unit& u) const { int pm, pn; if (!to.get(i, pm, pn)) return false; u.pm = pm; u.pn = pn; u.aux = 0; u.rows = nullptr;
        u.A = A + (size_t)pm * tA + (size_t)pn * hA; const int b = pm >> 5; u.B = B + (size_t)b * bB + (size_t)pn * hB; return true; }
};
struct MoeSched {
    int G, c, nblk; const unsigned* blk_e; const char* A; const char* B; size_t tA, eB, tB; const int* row_tok;
    __device__ __forceinline__ bool next(int i, Unit& u) const { const int L = i * G + c; if (L >= nblk * 4) return false; const int rb = L >> 2, pn = L & 3;
        const int e = (int)__builtin_amdgcn_readfirstlane(ld_u32_agent(blk_e + rb)); u.pm = rb; u.pn = pn; u.aux = e; u.rows = row_tok + (size_t)rb * 256;
        u.A = A + (size_t)rb * tA; u.B = B + (size_t)e * eB + (size_t)pn * tB; return true; }
};

#define EPI_ARGS f32x4 (&acc)[2][2][4][2], const Unit& u, int wr, int wc, int fr, int fq, LAS unsigned char* tb
__device__ __forceinline__ void st128(bf16_t* rowbase, size_t ldc, const u32x4 w0, const u32x4 w1, int fr, int fq, LAS unsigned char* tb) {
    *(LAS u32x4*)(tb + fr * 144 + fq * 16) = w0; *(LAS u32x4*)(tb + fr * 144 + 64 + fq * 16) = w1;
    const int L = fq * 16 + fr, r = L >> 3, c = L & 7;
    const u32x4 a = *(const LAS u32x4*)(tb + r * 144 + c * 16), b = *(const LAS u32x4*)(tb + (8 + r) * 144 + c * 16);
    *(u32x4*)(rowbase + (size_t)r * ldc + c * 8) = a; *(u32x4*)(rowbase + (size_t)(8 + r) * ldc + c * 8) = b;
}
__device__ __forceinline__ u32x4 pk8(const f32x4 v0, const f32x4 v1) { u32x4 w; w.x = cvt_pk_bf16(v0[0], v0[1]); w.y = cvt_pk_bf16(v0[2], v0[3]); w.z = cvt_pk_bf16(v1[0], v1[1]); w.w = cvt_pk_bf16(v1[2], v1[3]); return w; }
struct EpiZ {
    static constexpr bool PERM = true;
    bf16_t* O; unsigned* kmx;
    __device__ __forceinline__ void operator()(EPI_ARGS) const {
        const int mode = u.pn < 4 ? 1 : (u.pn < 6 ? 2 : 0);
        if (u.pn == 6 || u.pn == 7) {
#pragma unroll
            for (int bj = 0; bj < 2; ++bj) { float mx = 0.f;
#pragma unroll
                for (int ai = 0; ai < 2; ++ai)
#pragma unroll
                    for (int m = 0; m < 4; ++m) { const f32x4 a = acc[ai][bj][m][0], b = acc[ai][bj][m][1];
                        float q = (a[0] * a[0] + a[1] * a[1]) + (a[2] * a[2] + a[3] * a[3]) + (b[0] * b[0] + b[1] * b[1]) + (b[2] * b[2] + b[3] * b[3]);
                        q += __shfl_xor(q, 16); q += __shfl_xor(q, 32); mx = fmaxf(mx, q); }
#pragma unroll
                for (int o_ = 1; o_ < 16; o_ <<= 1) mx = fmaxf(mx, __shfl_xor(mx, o_));
                if (fr == 0 && fq == 0) { const int b_ = u.pm >> 5, h_ = (u.pn - 6) * 2 + (wc >> 1); atomicMax(kmx + (((b_ * 4 + h_) * 2 + (wc & 1)) * 2 + bj), __float_as_uint(mx)); } }
        }
#pragma unroll
        for (int ai = 0; ai < 2; ++ai)
#pragma unroll
            for (int m = 0; m < 4; ++m) { u32x4 w[2];
#pragma unroll
                for (int bj = 0; bj < 2; ++bj) { f32x4 v0 = acc[ai][bj][m][0], v1 = acc[ai][bj][m][1];
                    if (mode == 1) { f32x2g a = gelu_pk((f32x2g){v0[0], v0[1]}), b = gelu_pk((f32x2g){v0[2], v0[3]}), c = gelu_pk((f32x2g){v1[0], v1[1]}), d = gelu_pk((f32x2g){v1[2], v1[3]});
                        v0 = (f32x4){a.x, a.y, b.x, b.y}; v1 = (f32x4){c.x, c.y, d.x, d.y}; }
                    else if (mode == 2) { v0 = v0 * C2_DIFF; v1 = v1 * C2_DIFF; }
                    w[bj] = pk8(v0, v1); }
                st128(O + (size_t)(u.pm * BM + ai * HALF + wr * 64 + m * 16) * ZP + u.pn * BM + wc * 64, ZP, w[0], w[1], fr, fq, tb); }
    }
};
struct EpiBf16 {
    static constexpr bool PERM = true;
    bf16_t* O; int ldc; const float* ssq; float cscale;
    __device__ __forceinline__ void operator()(EPI_ARGS) const {
        float sc[2][4];
#pragma unroll
        for (int ai = 0; ai < 2; ++ai)
#pragma unroll
            for (int m = 0; m < 4; ++m) sc[ai][m] = cscale;
        if (ssq) {
#pragma unroll
            for (int ai = 0; ai < 2; ++ai)
#pragma unroll
                for (int m = 0; m < 4; ++m) { const f32x4 s4 = *(const f32x4*)(ssq + (size_t)(u.pm * BM + ai * HALF + wr * 64 + m * 16 + fr) * 4);
                    sc[ai][m] = cscale * __builtin_amdgcn_rsqf(((s4[0] + s4[1]) + (s4[2] + s4[3])) * (1.0f / DM) + RMS_EPS); }
        }
#pragma unroll
        for (int ai = 0; ai < 2; ++ai)
#pragma unroll
            for (int m = 0; m < 4; ++m) { const int rowg = u.pm * BM + ai * HALF + wr * 64 + m * 16; const float c = sc[ai][m];
                st128(O + (size_t)rowg * ldc + u.pn * BM + wc * 64, (size_t)ldc, pk8(acc[ai][0][m][0] * c, acc[ai][0][m][1] * c), pk8(acc[ai][1][m][0] * c, acc[ai][1][m][1] * c), fr, fq, tb); }
    }
};
struct EpiF8 {
    static constexpr bool PERM = true;
    unsigned char* O; int ldc; const float* ssq; float cscale;
    __device__ __forceinline__ void operator()(EPI_ARGS) const {
        const int L = fq * 16 + fr;
        float sc[2][4];
#pragma unroll
        for (int ai = 0; ai < 2; ++ai)
#pragma unroll
            for (int m = 0; m < 4; ++m) sc[ai][m] = cscale;
        if (ssq) {
#pragma unroll
            for (int ai = 0; ai < 2; ++ai)
#pragma unroll
                for (int m = 0; m < 4; ++m) { const f32x4 s4 = *(const f32x4*)(ssq + (size_t)(u.pm * BM + ai * HALF + wr * 64 + m * 16 + fr) * 4);
                    sc[ai][m] = cscale * __builtin_amdgcn_rsqf(((s4[0] + s4[1]) + (s4[2] + s4[3])) * (1.0f / DM) + RMS_EPS); }
        }
#pragma unroll
        for (int ai = 0; ai < 2; ++ai)
#pragma unroll
            for (int m = 0; m < 4; ++m) { const int rowg = u.pm * BM + ai * HALF + wr * 64 + m * 16; const float c = sc[ai][m];
#pragma unroll
                for (int bj = 0; bj < 2; ++bj) { const f32x4 a = acc[ai][bj][m][0] * c, b = acc[ai][bj][m][1] * c; u32x2 f; f.x = pk4_fp8(a[0], a[1], a[2], a[3]); f.y = pk4_fp8(b[0], b[1], b[2], b[3]);
                    *(LAS u32x2*)(tb + fr * 144 + bj * 32 + fq * 8) = f; }
                const u32x4 v8 = *(const LAS u32x4*)(tb + (L >> 2) * 144 + (L & 3) * 16);
                *(u32x4*)(O + (size_t)(rowg + (L >> 2)) * ldc + u.pn * BM + wc * 64 + (L & 3) * 16) = v8; }
    }
};
struct EpiSoftmax {
    static constexpr bool PERM = true;
    unsigned char* O; LAS float* xch; float sscale;
    __device__ __forceinline__ void operator()(EPI_ARGS) const {
        LAS float* xm = xch; LAS float* xs = xch + 1024;
#pragma unroll
        for (int ai = 0; ai < 2; ++ai)
#pragma unroll
            for (int bj = 0; bj < 2; ++bj)
#pragma unroll
                for (int m = 0; m < 4; ++m)
#pragma unroll
                    for (int n = 0; n < 2; ++n) acc[ai][bj][m][n] = acc[ai][bj][m][n] * sscale;
#pragma unroll
        for (int ai = 0; ai < 2; ++ai)
#pragma unroll
            for (int m = 0; m < 4; ++m) { float v = -__builtin_inff();
#pragma unroll
                for (int bj = 0; bj < 2; ++bj)
#pragma unroll
                    for (int n = 0; n < 2; ++n) { const f32x4 a = acc[ai][bj][m][n]; v = fmaxf(v, fmaxf(fmaxf(a[0], a[1]), fmaxf(a[2], a[3]))); }
                v = fmaxf(v, __shfl_xor(v, 16)); v = fmaxf(v, __shfl_xor(v, 32));
                if (fq == 0) xm[(ai * HALF + wr * 64 + m * 16 + fr) * 4 + wc] = v; }
        asm volatile("s_waitcnt lgkmcnt(0)" ::: "memory"); __builtin_amdgcn_s_barrier(); asm volatile("" ::: "memory");
#pragma unroll
        for (int ai = 0; ai < 2; ++ai)
#pragma unroll
            for (int m = 0; m < 4; ++m) { const f32x4 t = *(const LAS f32x4*)(xm + (ai * HALF + wr * 64 + m * 16 + fr) * 4); const float mx = fmaxf(fmaxf(t[0], t[1]), fmaxf(t[2], t[3])); float sm = 0.f;
#pragma unroll
                for (int bj = 0; bj < 2; ++bj)
#pragma unroll
                    for (int n = 0; n < 2; ++n) { f32x4 a = acc[ai][bj][m][n];
#pragma unroll
                        for (int j = 0; j < 4; ++j) { a[j] = __builtin_amdgcn_exp2f(a[j] - mx); sm += a[j]; }
                        acc[ai][bj][m][n] = a; }
                sm += __shfl_xor(sm, 16); sm += __shfl_xor(sm, 32);
                if (fq == 0) xs[(ai * HALF + wr * 64 + m * 16 + fr) * 4 + wc] = sm; }
        asm volatile("s_waitcnt lgkmcnt(0)" ::: "memory"); __builtin_amdgcn_s_barrier(); asm volatile("" ::: "memory");
#pragma unroll
        for (int ai = 0; ai < 2; ++ai)
#pragma unroll
            for (int m = 0; m < 4; ++m) { const f32x4 t = *(const LAS f32x4*)(xs + (ai * HALF + wr * 64 + m * 16 + fr) * 4); const float inv = F8_PSCALE * __builtin_amdgcn_rcpf((t[0] + t[1]) + (t[2] + t[3]));
                const int rowg = u.pm * BM + ai * HALF + wr * 64 + m * 16, L = fq * 16 + fr;
#pragma unroll
                for (int bj = 0; bj < 2; ++bj) { const f32x4 a = acc[ai][bj][m][0] * inv, b = acc[ai][bj][m][1] * inv; u32x2 f; f.x = pk4_fp8(a[0], a[1], a[2], a[3]); f.y = pk4_fp8(b[0], b[1], b[2], b[3]);
                    *(LAS u32x2*)(tb + fr * 144 + bj * 32 + fq * 8) = f; }
                const u32x4 v8 = *(const LAS u32x4*)(tb + (L >> 2) * 144 + (L & 3) * 16);
                *(u32x4*)(O + (size_t)(rowg + (L >> 2)) * DM + u.pn * BM + wc * 64 + (L & 3) * 16) = v8; }
    }
};
template <bool BF>
struct EpiResid {
    static constexpr bool PERM = true;
    const void* base; bf16_t* ob; float* ssq; LAS float* xs; unsigned char* o8; float as;
    __device__ __forceinline__ void operator()(EPI_ARGS) const {
        const int col0 = u.pn * BM + wc * 64 + 8 * fq;
        if constexpr (BF) {
            u32x4 br[2][4][2];
#pragma unroll
            for (int ai = 0; ai < 2; ++ai)
#pragma unroll
                for (int m = 0; m < 4; ++m)
#pragma unroll
                    for (int bj = 0; bj < 2; ++bj) br[ai][m][bj] = *(const u32x4*)((const bf16_t*)base + (size_t)(u.pm * BM + ai * HALF + wr * 64 + m * 16 + fr) * DM + col0 + bj * 32);
#pragma unroll
            for (int ai = 0; ai < 2; ++ai)
#pragma unroll
                for (int m = 0; m < 4; ++m) asm volatile("" : "+v"(br[ai][m][0]), "+v"(br[ai][m][1]));
#pragma unroll
            for (int ai = 0; ai < 2; ++ai)
#pragma unroll
                for (int m = 0; m < 4; ++m) { const int rowg = u.pm * BM + ai * HALF + wr * 64 + m * 16, row = rowg + fr; float s = 0.f; u32x4 w[2]; u32x2 f8[2];
#pragma unroll
                    for (int bj = 0; bj < 2; ++bj) { const u32x4 r = br[ai][m][bj];
                        const f32x4 o0 = (f32x4){bf_lo(r.x), bf_hi(r.x), bf_lo(r.y), bf_hi(r.y)} + acc[ai][bj][m][0] * as, o1 = (f32x4){bf_lo(r.z), bf_hi(r.z), bf_lo(r.w), bf_hi(r.w)} + acc[ai][bj][m][1] * as;
                        s += (o0[0] * o0[0] + o0[1] * o0[1]) + (o0[2] * o0[2] + o0[3] * o0[3]) + (o1[0] * o1[0] + o1[1] * o1[1]) + (o1[2] * o1[2] + o1[3] * o1[3]);
                        w[bj] = pk8(o0, o1);
                        f8[bj].x = pk4_fp8(o0[0] * F8_XSCALE, o0[1] * F8_XSCALE, o0[2] * F8_XSCALE, o0[3] * F8_XSCALE); f8[bj].y = pk4_fp8(o1[0] * F8_XSCALE, o1[1] * F8_XSCALE, o1[2] * F8_XSCALE, o1[3] * F8_XSCALE); }
                    st128(ob + (size_t)rowg * DM + u.pn * BM + wc * 64, (size_t)DM, w[0], w[1], fr, fq, tb);
                    if (o8) {
                        *(LAS u32x2*)(tb + fr * 144 + fq * 8) = f8[0]; *(LAS u32x2*)(tb + fr * 144 + 32 + fq * 8) = f8[1];
                        const int L = fq * 16 + fr; const u32x4 v8 = *(const LAS u32x4*)(tb + (L >> 2) * 144 + (L & 3) * 16);
                        *(u32x4*)(o8 + (size_t)(rowg + (L >> 2)) * DM + u.pn * BM + wc * 64 + (L & 3) * 16) = v8; }
                    s += __shfl_xor(s, 16); s += __shfl_xor(s, 32);
                    if (fq == 0) xs[(ai * HALF + wr * 64 + m * 16 + fr) * 4 + wc] = s; }
        } else {
#pragma unroll
            for (int ai = 0; ai < 2; ++ai) {
                f32x4 br[4][2][2];
#pragma unroll
                for (int m = 0; m < 4; ++m)
#pragma unroll
                    for (int bj = 0; bj < 2; ++bj) { const float* p = (const float*)base + (size_t)(u.pm * BM + ai * HALF + wr * 64 + m * 16 + fr) * DM + col0 + bj * 32; br[m][bj][0] = *(const f32x4*)p; br[m][bj][1] = *(const f32x4*)(p + 4); }
#pragma unroll
                for (int m = 0; m < 4; ++m) asm volatile("" : "+v"(br[m][0][0]), "+v"(br[m][0][1]), "+v"(br[m][1][0]), "+v"(br[m][1][1]));
#pragma unroll
                for (int m = 0; m < 4; ++m) { const int rowg = u.pm * BM + ai * HALF + wr * 64 + m * 16; float s = 0.f; u32x4 w[2]; u32x2 f8[2];
#pragma unroll
                    for (int bj = 0; bj < 2; ++bj) { const f32x4 o0 = br[m][bj][0] + acc[ai][bj][m][0] * as, o1 = br[m][bj][1] + acc[ai][bj][m][1] * as;
                        s += (o0[0] * o0[0] + o0[1] * o0[1]) + (o0[2] * o0[2] + o0[3] * o0[3]) + (o1[0] * o1[0] + o1[1] * o1[1]) + (o1[2] * o1[2] + o1[3] * o1[3]);
                        w[bj] = pk8(o0, o1);
                        f8[bj].x = pk4_fp8(o0[0] * F8_XSCALE, o0[1] * F8_XSCALE, o0[2] * F8_XSCALE, o0[3] * F8_XSCALE); f8[bj].y = pk4_fp8(o1[0] * F8_XSCALE, o1[1] * F8_XSCALE, o1[2] * F8_XSCALE, o1[3] * F8_XSCALE); }
                    st128(ob + (size_t)rowg * DM + u.pn * BM + wc * 64, (size_t)DM, w[0], w[1], fr, fq, tb);
                    if (o8) {
                        *(LAS u32x2*)(tb + fr * 144 + fq * 8) = f8[0]; *(LAS u32x2*)(tb + fr * 144 + 32 + fq * 8) = f8[1];
                        const int L = fq * 16 + fr; const u32x4 v8 = *(const LAS u32x4*)(tb + (L >> 2) * 144 + (L & 3) * 16);
                        *(u32x4*)(o8 + (size_t)(rowg + (L >> 2)) * DM + u.pn * BM + wc * 64 + (L & 3) * 16) = v8; }
                    s += __shfl_xor(s, 16); s += __shfl_xor(s, 32);
                    if (fq == 0) xs[(ai * HALF + wr * 64 + m * 16 + fr) * 4 + wc] = s; }
            }
        }
        asm volatile("s_waitcnt lgkmcnt(0)" ::: "memory"); __builtin_amdgcn_s_barrier(); asm volatile("" ::: "memory");
        { const int t_ = (wr * 4 + wc) * 64 + fq * 16 + fr;
          if (t_ < 256) { const f32x4 p = *(const LAS f32x4*)(xs + t_ * 4); ssq[(size_t)(u.pm * BM + t_) * 4 + u.pn] = (p[0] + p[1]) + (p[2] + p[3]); } }
    }
};
struct EpiRouter {
    static constexpr bool PERM = false;
    float* L; const float* ssq; const float* bg; const float* be; float* rstd_out;
    __device__ __forceinline__ void operator()(EPI_ARGS) const {
        if (wc != 0) return;
        const int row0 = u.pm * BM + wr * 64 + fr;
        float rsv[2][4];
#pragma unroll
        for (int ai = 0; ai < 2; ++ai)
#pragma unroll
            for (int m = 0; m < 4; ++m) { const f32x4 s4 = *(const f32x4*)(ssq + (size_t)(row0 + ai * HALF + m * 16) * 4);
                rsv[ai][m] = __builtin_amdgcn_rsqf(((s4[0] + s4[1]) + (s4[2] + s4[3])) * (1.0f / DM) + RMS_EPS); }
#pragma unroll
        for (int ai = 0; ai < 2; ++ai)
#pragma unroll
            for (int m = 0; m < 4; ++m) { const int row = row0 + ai * HALF + m * 16; const float rs = rsv[ai][m];
                if (fq == 0) rstd_out[row] = rs;
#pragma unroll
                for (int bj = 0; bj < 2; ++bj)
#pragma unroll
                    for (int n = 0; n < 2; ++n) { const int c0 = bj * 32 + n * 16 + 4 * fq; f32x4 o = acc[ai][bj][m][n] * rs;
#pragma unroll
                        for (int j = 0; j < 4; ++j) { const int c = c0 + j; const float b = c < 4 ? bg[c] : (c < 36 ? be[c - 4] : 0.f); o[j] += b; }
                        *(f32x4*)(L + (size_t)row * 64 + c0) = o; } }
    }
};
struct EpiGateUp {
    static constexpr bool PERM = true;
    unsigned char* act; const float* rstd; const int* row_tok;
    __device__ __forceinline__ void operator()(EPI_ARGS) const {
        const int row0 = u.pm * BM + wr * 64 + fr, col0 = u.pn * 128 + wc * 32 + 8 * fq;
        float rsv[2][4];
#pragma unroll
        for (int ai = 0; ai < 2; ++ai)
#pragma unroll
            for (int m = 0; m < 4; ++m) rsv[ai][m] = rstd[row0 + ai * HALF + m * 16];
#pragma unroll
        for (int ai = 0; ai < 2; ++ai)
#pragma unroll
            for (int m = 0; m < 4; ++m) { const int row = row0 + ai * HALF + m * 16; const float rs = rsv[ai][m];
                float r[8];
#pragma unroll
                for (int n = 0; n < 2; ++n)
#pragma unroll
                    for (int j = 0; j < 4; ++j) { const float gg = acc[ai][0][m][n][j] * rs, uu = acc[ai][1][m][n][j] * rs;
                        r[n * 4 + j] = gg * __builtin_amdgcn_rcpf(1.0f + __builtin_amdgcn_exp2f(-gg * LOG2E)) * uu; }
                u32x2 w; w.x = pk4_fp8(r[0] * F8_ASCALE, r[1] * F8_ASCALE, r[2] * F8_ASCALE, r[3] * F8_ASCALE); w.y = pk4_fp8(r[4] * F8_ASCALE, r[5] * F8_ASCALE, r[6] * F8_ASCALE, r[7] * F8_ASCALE);
                *(u32x2*)(act + (size_t)row * DEXP + col0) = w; }
    }
};
}

namespace da {
constexpr int NW = 8, QBLK = 32, KVBLK = 64, QB = NW * QBLK, DV = 128;
constexpr int SHM_V = KVBLK * DV * 2, SHM_K = KVBLK * 64 * 2;
constexpr int LDS_V = 0, LDS_K = 2 * SHM_V, LDS_WS = LDS_K + 2 * SHM_K, LDS_CX = LDS_WS + NW * 64 * 4, LDS_STASH = LDS_CX + 256, LDS_BYTES = LDS_STASH + NW * 8192;
constexpr float SKIP_MARGIN = 40.f;
constexpr float THR = 8.f;
#define SBAR() __builtin_amdgcn_sched_barrier(0)
__device__ __forceinline__ int kswz(int row, int chunk) { return row * 128 + ((chunk ^ ((row >> 1) & 7)) << 4); }
__device__ __forceinline__ int v_st(int k, int c) { const int kk = (k & ~0xC) | ((k & 4) << 1) | ((k & 8) >> 1); return ((kk >> 3) * 4 + (c >> 5)) * 512 + ((kk & 7) * 32 + (c & 31)) * 2; }
__device__ __forceinline__ int v_rd_base(int lane) { return ((lane & 3) << 3) | (((lane >> 2) & 3) << 6) | (((lane >> 4) & 1) << 5) | (((lane >> 5) & 1) << 8); }
constexpr int v_rd_off(int d0, int ks, int half) { return d0 * 512 + ks * 4096 + half * 2048; }
__device__ __forceinline__ int crow(int r, int hi) { return (r & 3) + 8 * (r >> 2) + 4 * hi; }
__device__ __forceinline__ bf16x8 load8(const bf16_t* p) { return *reinterpret_cast<const bf16x8*>(p); }

__device__ __forceinline__ void mask_tile(f32x16& p0, f32x16& p1, int dq) {
    const float NEG = -__builtin_inff();
#pragma unroll
    for (int r = 0; r < 16; ++r) { const int c = (r & 3) + 8 * (r >> 2); if (dq - c < 0) p0[r] = NEG; if (dq - c - 32 < 0) p1[r] = NEG; }
}
__device__ __forceinline__ void partialSM(f32x16& p0, f32x16& p1, float& m_reg, float& alpha) {
    float pmax = p0[0];
#pragma unroll
    for (int r = 1; r < 16; ++r) pmax = fmaxf(pmax, p0[r]);
#pragma unroll
    for (int r = 0; r < 16; ++r) pmax = fmaxf(pmax, p1[r]);
    { auto rr = __builtin_amdgcn_permlane32_swap(__float_as_uint(pmax), __float_as_uint(pmax), false, false); pmax = fmaxf(__uint_as_float(rr[0]), __uint_as_float(rr[1])); }
    float mn;
    if (__builtin_expect(__all((pmax - m_reg) <= THR), 1)) { mn = m_reg; alpha = 1.f; }
    else { mn = fmaxf(m_reg, pmax); alpha = __builtin_amdgcn_exp2f(m_reg - mn); m_reg = mn; }
#pragma unroll
    for (int r = 0; r < 16; ++r) p0[r] = p0[r] - mn;
#pragma unroll
    for (int r = 0; r < 16; ++r) p1[r] = p1[r] - mn;
#pragma unroll
    for (int r = 0; r < 16; ++r) p0[r] = __builtin_amdgcn_exp2f(p0[r]);
}
__device__ __forceinline__ void finishSM(f32x16& p0, f32x16& p1, float alpha, float& l_reg, bf16x8& pa0, bf16x8& pa1, bf16x8& pa2, bf16x8& pa3) {
#pragma unroll
    for (int r = 0; r < 16; ++r) p1[r] = __builtin_amdgcn_exp2f(p1[r]);
    float ps = 0;
#pragma unroll
    for (int r = 0; r < 16; ++r) ps += p0[r];
#pragma unroll
    for (int r = 0; r < 16; ++r) ps += p1[r];
    { auto rr = __builtin_amdgcn_permlane32_swap(__float_as_uint(ps), __float_as_uint(ps), false, false); ps = __uint_as_float(rr[0]) + __uint_as_float(rr[1]); }
    l_reg = l_reg * alpha + ps;
#define PK4(P, B_, OUT) do { unsigned a0 = cvt_pk_bf16(P[B_+0], P[B_+1]), a1 = cvt_pk_bf16(P[B_+2], P[B_+3]);                          \
        unsigned b0 = cvt_pk_bf16(P[B_+4], P[B_+5]), b1 = cvt_pk_bf16(P[B_+6], P[B_+7]);                                             \
        auto r0 = __builtin_amdgcn_permlane32_swap(a0, b0, false, false); auto r1 = __builtin_amdgcn_permlane32_swap(a1, b1, false, false); \
        u32x4 w = {r0[0], r1[0], r0[1], r1[1]}; OUT = *reinterpret_cast<bf16x8*>(&w); } while (0)
    PK4(p0, 0, pa0); PK4(p0, 8, pa1); PK4(p1, 0, pa2); PK4(p1, 8, pa3);
#undef PK4
}
template <int KB>
__device__ __forceinline__ void qkt(f32x16& p0, f32x16& p1, const char* K_lds, int r32, int hi, const bf16x8* qr, float ab, float slope2) {
    const float s32 = 32.f * slope2;
#pragma unroll
    for (int r = 0; r < 16; ++r) { p0[r] = fmaf(slope2, (float)((r & 3) + 8 * (r >> 2)), ab); p1[r] = p0[r] + s32; }
#pragma unroll
    for (int d0 = 0; d0 < 4; ++d0) { const char* a = K_lds + KB * SHM_K + kswz(r32, d0 * 2 + hi);
        bf16x8 b0 = *reinterpret_cast<const bf16x8*>(a);
        bf16x8 b1 = *reinterpret_cast<const bf16x8*>(a + 32 * 128);
        p0 = __builtin_amdgcn_mfma_f32_32x32x16_bf16(b0, qr[d0], p0, 0, 0, 0);
        p1 = __builtin_amdgcn_mfma_f32_32x32x16_bf16(b1, qr[d0], p1, 0, 0, 0); }
}
template <int VB>
__device__ __forceinline__ void pv_tile(f32x16* o, int vb0, bf16x8 pa0, bf16x8 pa1, bf16x8 pa2, bf16x8 pa3) {
#define TRRD(dst, off) asm volatile("ds_read_b64_tr_b16 %0, %1 offset:%2" : "=&v"(dst) : "v"(vb0), "i"(off) : "memory")
#define PV_D0(d0) do { s16x4 l0, l1, l2, l3, h0, h1, h2, h3; constexpr int b_ = VB * SHM_V + v_rd_off(d0, 0, 0); \
        TRRD(l0, b_); TRRD(h0, b_ + 2048); TRRD(l1, b_ + 4096); TRRD(h1, b_ + 6144); TRRD(l2, b_ + 8192); TRRD(h2, b_ + 10240); TRRD(l3, b_ + 12288); TRRD(h3, b_ + 14336); \
        asm volatile("s_waitcnt lgkmcnt(0)" ::: "memory"); SBAR();   \
        o[d0] = __builtin_amdgcn_mfma_f32_32x32x16_bf16(pa0, (bf16x8){l0[0], l0[1], l0[2], l0[3], h0[0], h0[1], h0[2], h0[3]}, o[d0], 0, 0, 0);   \
        o[d0] = __builtin_amdgcn_mfma_f32_32x32x16_bf16(pa1, (bf16x8){l1[0], l1[1], l1[2], l1[3], h1[0], h1[1], h1[2], h1[3]}, o[d0], 0, 0, 0);   \
        o[d0] = __builtin_amdgcn_mfma_f32_32x32x16_bf16(pa2, (bf16x8){l2[0], l2[1], l2[2], l2[3], h2[0], h2[1], h2[2], h2[3]}, o[d0], 0, 0, 0);   \
        o[d0] = __builtin_amdgcn_mfma_f32_32x32x16_bf16(pa3, (bf16x8){l3[0], l3[1], l3[2], l3[3], h3[0], h3[1], h3[2], h3[3]}, o[d0], 0, 0, 0); } while (0)
    PV_D0(0); PV_D0(1); PV_D0(2); PV_D0(3);
#undef PV_D0
#undef TRRD
}

struct BlockRef { const bf16_t* Q; const bf16_t* K; const bf16_t* V; bf16_t* O; int P0; int mode; float slope2; float kmax; };
struct Seam { bf16x8 qr[4]; bf16x8 st_v0, st_v1, st_k0; };
__device__ __forceinline__ BlockRef mkref(const bf16_t* Z, bf16_t* AO, const unsigned* kmx, int item, int pass) { BlockRef r; const int bh = item >> 4, y = item & 15, b = bh >> 2, h = bh & 3; const int qb = (pass < 2) ? y : 31 - y, mp = pass & 1;
    const bf16_t* zb = Z + (size_t)b * SEQ * ZP; r.Q = zb + (size_t)(qb * 256) * ZP + ZQ + h * 128 + mp * 64; r.K = zb + ZK + h * 128 + mp * 64; r.V = zb + ZVAL + h * 128;
    r.O = AO + ((size_t)b * SEQ + qb * 256) * DM + 512 + h * 128; r.P0 = qb * 256; r.mode = mp; r.slope2 = exp2f(-2.0f * (float)(h + 1)) * LOG2E;
    const unsigned* kp = kmx + ((bh * 2 + mp) * 2); r.kmax = 1.01f * sqrtf(__uint_as_float(ld_u32_agent(kp)) + __uint_as_float(ld_u32_agent(kp + 1))); return r; }
#define ROWV(p, k0, rr) ((p) + (size_t)((k0) + (rr)) * ZP + sc)
#define ROWK(p, k0) ((p) + (size_t)((k0) + skr) * ZP + skc * 8)
#define VMW() asm volatile("s_waitcnt vmcnt(0)" ::: "memory")
#define VMWN(n) asm volatile("s_waitcnt vmcnt(%0)" :: "i"(n) : "memory")
#define SLOAD_H(Kp, Vp, k0) do { S.st_v0 = load8(ROWV(Vp, k0, sr)); S.st_v1 = load8(ROWV(Vp, k0, 32 + sr)); S.st_k0 = load8(ROWK(Kp, k0)); } while (0)
#define SWRITE_HK(bf) do { *(bf16x8*)(K_lds + (bf) * SHM_K + kws) = S.st_k0; } while (0)
#define SWRITE_HV(bf) do { *(bf16x8*)(V_lds + (bf) * SHM_V + vst0) = S.st_v0; *(bf16x8*)(V_lds + (bf) * SHM_V + vst1) = S.st_v1; } while (0)
#define SWRITE_H(bf) do { SWRITE_HV(bf); SWRITE_HK(bf); } while (0)
__device__ __forceinline__ void prime(const BlockRef& cur, char* lds, Seam& S, int wid) {
    const int lane = lane_id(), tid = wid * 64 + lane, r32 = lane & 31, hi = lane >> 5;
    const int sr = tid >> 4, sc = (tid & 15) * 8, skr = tid >> 3, skc = tid & 7, kws = kswz(skr, skc); char* K_lds = lds + LDS_K;
#pragma unroll
    for (int d0 = 0; d0 < 4; ++d0) S.qr[d0] = load8(cur.Q + (size_t)(wid * QBLK + r32) * ZP + d0 * 16 + hi * 8);
    SLOAD_H(cur.K, cur.V, cur.P0 + QB - KVBLK); VMW(); SWRITE_HK(0);
    __syncthreads();
}
__device__ __forceinline__ void block(const BlockRef& cur, const BlockRef& nxt, char* lds, Seam& S, float lam, const float* __restrict__ subln, int wid) {
    const int lane = lane_id(), tid = wid * 64 + lane, r32 = lane & 31, hi = lane >> 5;
    const int NT0 = (cur.P0 + QB) / KVBLK;
    int NT = NT0;
    const int qlo = cur.P0 + wid * QBLK, qm = qlo + r32 - 4 * hi;
    const float slope2 = cur.slope2;
    char* V_lds = lds + LDS_V; char* K_lds = lds + LDS_K;
    float* ws = (float*)(lds + LDS_WS) + wid * 64; float* li_l = ws, * al_l = ws + 32;
    float m_reg = -1e30f, l_reg = 0; f32x16 o[4] = {};
    const int sr = tid >> 4, sc = (tid & 15) * 8, vst0 = v_st(sr, sc), vst1 = v_st(32 + sr, sc), skr = tid >> 3, skc = tid & 7, kws = kswz(skr, skc);
    const int vb0 = (int)(uintptr_t)V_lds + v_rd_base(lane);
    const bf16_t* Kh = cur.K; const bf16_t* Vh = cur.V;
#define RESC(a) do { if (__any((a) < 1.f)) { if (hi == 0) al_l[r32] = (a); asm volatile("s_waitcnt lgkmcnt(0)" ::: "memory");              \
                     for (int d_ = 0; d_ < 4; ++d_) for (int r = 0; r < 16; ++r) o[d_][r] *= al_l[crow(r, hi)]; } } while (0)
#define KBASE(t) ((NT0 - 1 - (t)) * KVBLK)
#define AB(t) (slope2 * (float)(KBASE(t) - qm))
#define MASKT(P0_, P1_, t) do { const int kb_ = KBASE(t); if (kb_ + KVBLK - 1 > qlo) mask_tile(P0_, P1_, qm - kb_); } while (0)
    constexpr int NQL = 4;
#define SEAM_K0() do { VMWN(NQL); SWRITE_HK(0); SBAR(); } while (0)
    f32x16 pA0, pA1, pB0, pB1; float alA, alB; bf16x8 pa0, pa1, pa2, pa3;
    float cbase;
    { float q2 = 0.f;
#pragma unroll
      for (int d0 = 0; d0 < 4; ++d0)
#pragma unroll
          for (int j = 0; j < 8; ++j) { const float v = __uint_as_float(((unsigned)(unsigned short)S.qr[d0][j]) << 16); q2 = fmaf(v, v, q2); }
      { auto rr = __builtin_amdgcn_permlane32_swap(__float_as_uint(q2), __float_as_uint(q2), false, false); q2 = __uint_as_float(rr[0]) + __uint_as_float(rr[1]); }
      cbase = sqrtf(q2) * cur.kmax * 1.0001f - slope2 * (float)(qlo + r32); }
    SWRITE_HV(0); SBAR();
    if (NT > 1) { SLOAD_H(Kh, Vh, KBASE(1)); }
    SBAR(); qkt<0>(pA0, pA1, K_lds, r32, hi, S.qr, AB(0), slope2);
    MASKT(pA0, pA1, 0); partialSM(pA0, pA1, m_reg, alA);
    if (NT > 1) { VMW(); SWRITE_H(1); }
    __syncthreads();
#define HALF_STEP(PX0, PX1, alX, PY0, PY1, alY, t, KB, VB, SB) do {                                                      \
        SBAR(); qkt<KB>(PX0, PX1, K_lds, r32, hi, S.qr, AB(t), slope2);                                                   \
        finishSM(PY0, PY1, alY, l_reg, pa0, pa1, pa2, pa3); SBAR();                                                       \
        if ((t) + 1 < NT) { SLOAD_H(Kh, Vh, KBASE((t) + 1)); SBAR(); }                                                    \
        pv_tile<VB>(o, vb0, pa0, pa1, pa2, pa3); MASKT(PX0, PX1, (t)); partialSM(PX0, PX1, m_reg, alX);                   \
        __syncthreads();                                                                                                  \
        if ((t) + 1 < NT) { VMW(); SWRITE_H(SB); }                                                                        \
        RESC(alX); __syncthreads(); } while (0)
    for (int t = 1; t + 1 < NT; t += 2) {
        HALF_STEP(pB0, pB1, alB, pA0, pA1, alA, t, 1, 0, 0);
        HALF_STEP(pA0, pA1, alA, pB0, pB1, alB, t + 1, 0, 1, 1);
        if (t == 3 && NT0 > 6) {
            float c = cbase - m_reg;
#pragma unroll
            for (int o_ = 1; o_ < 64; o_ <<= 1) c = fmaxf(c, __shfl_xor(c, o_));
            float* cx = (float*)(lds + LDS_CX);
            if (lane == 0) cx[wid] = c;
            __syncthreads();
            float C = cx[0];
#pragma unroll
            for (int w_ = 1; w_ < NW; ++w_) C = fmaxf(C, cx[w_]);
            const float X = (-SKIP_MARGIN - C) / slope2 - 63.f;
            const float need_f = (float)(NT0 - 1) - X * (1.0f / 64.0f);
            if (need_f < (float)NT0) { int n = (int)ceilf(need_f); n = n < 6 ? 6 : n; n = (n + 1) & ~1; NT = n < NT0 ? n : NT0; }
        }
    }
    SBAR(); qkt<1>(pB0, pB1, K_lds, r32, hi, S.qr, AB(NT - 1), slope2); SBAR();
    SLOAD_H(nxt.K, nxt.V, nxt.P0 + QB - KVBLK); SBAR();
#pragma unroll
    for (int d0 = 0; d0 < 4; ++d0) S.qr[d0] = load8(nxt.Q + (size_t)(wid * QBLK + r32) * ZP + d0 * 16 + hi * 8);
    SBAR();
    finishSM(pA0, pA1, alA, l_reg, pa0, pa1, pa2, pa3); SBAR();
    pv_tile<0>(o, vb0, pa0, pa1, pa2, pa3);
    MASKT(pB0, pB1, NT - 1); partialSM(pB0, pB1, m_reg, alB); __syncthreads(); RESC(alB);
    finishSM(pB0, pB1, alB, l_reg, pa0, pa1, pa2, pa3); SBAR(); pv_tile<1>(o, vb0, pa0, pa1, pa2, pa3);
    SBAR(); SEAM_K0();
    if (hi == 0) li_l[r32] = l_reg; asm volatile("s_waitcnt lgkmcnt(0)" ::: "memory");
    float rli[16];
#pragma unroll
    for (int r = 0; r < 16; ++r) rli[r] = __builtin_amdgcn_rcpf(li_l[crow(r, hi)]);
    unsigned* stash = (unsigned*)(lds + LDS_STASH) + wid * 2048 + lane;
    if (cur.mode == 0) {
#pragma unroll
        for (int r = 0; r < 16; ++r) { stash[(r * 2 + 0) * 64] = cvt_pk_bf16(o[0][r] * rli[r], o[1][r] * rli[r]); stash[(r * 2 + 1) * 64] = cvt_pk_bf16(o[2][r] * rli[r], o[3][r] * rli[r]); }
    } else {
        float ssq[16];
#pragma unroll
        for (int r = 0; r < 16; ++r) { const unsigned w0 = stash[(r * 2 + 0) * 64], w1 = stash[(r * 2 + 1) * 64];
            o[0][r] = bf_lo(w0) - lam * (o[0][r] * rli[r]); o[1][r] = bf_hi(w0) - lam * (o[1][r] * rli[r]);
            o[2][r] = bf_lo(w1) - lam * (o[2][r] * rli[r]); o[3][r] = bf_hi(w1) - lam * (o[3][r] * rli[r]);
            ssq[r] = (o[0][r] * o[0][r] + o[1][r] * o[1][r]) + (o[2][r] * o[2][r] + o[3][r] * o[3][r]); }
#pragma unroll
        for (int r = 0; r < 16; ++r) {
#pragma unroll
            for (int off = 1; off < 32; off <<= 1) ssq[r] += __shfl_xor(ssq[r], off);
            ssq[r] = __builtin_amdgcn_rsqf(ssq[r] * (1.0f / DV) + RMS_EPS); }
        float g4[4];
#pragma unroll
        for (int d0 = 0; d0 < 4; ++d0) g4[d0] = subln[d0 * 32 + r32] * 0.8f;
        bf16_t* Ow = cur.O + (size_t)(wid * QBLK) * DM;
#pragma unroll
        for (int r = 0; r < 16; ++r) { const int orow = crow(r, hi);
#pragma unroll
            for (int d0 = 0; d0 < 4; ++d0) { const float v = o[d0][r] * ssq[r] * g4[d0]; const float vn = __shfl_xor(v, 1);
                if ((r32 & 1) == 0) *(unsigned*)(Ow + (size_t)orow * DM + d0 * 32 + r32) = cvt_pk_bf16(v, vn); } }
    }
    __syncthreads();
#undef RESC
#undef KBASE
#undef AB
#undef MASKT
#undef SEAM_K0
#undef HALF_STEP
}
#undef ROWV
#undef ROWK
#undef VMW
#undef VMWN
#undef SLOAD_H
#undef SWRITE_HK
#undef SWRITE_HV
#undef SWRITE_H
#undef SBAR
}


#define XB_TMO      128
#define XB_XCNT(j)  (256  + 64 * (j))
#define XB_XSUB(j)  (1280 + 64 * (j))
#define XB_XGEN(j)  (2304 + 64 * (j))
#define XB_TOP      3328
#define XB_TOPGEN   3392
#define XCD_BAR_WORDS 3456
#define XB_SPIN_CAP (1u << 22)
__device__ __forceinline__ unsigned xb_ld(unsigned* p)              { return __hip_atomic_load(p, __ATOMIC_RELAXED, __HIP_MEMORY_SCOPE_AGENT); }
__device__ __forceinline__ unsigned xb_add(unsigned* p, unsigned v) { return __hip_atomic_fetch_add(p, v, __ATOMIC_RELAXED, __HIP_MEMORY_SCOPE_AGENT); }
__device__ __forceinline__ unsigned xb_xcc_id() { return (unsigned)__builtin_amdgcn_s_getreg((3 << 11) | 20) & 0xFu; }
#define XB_SPIN(cond, bar) do { unsigned _sp = 0; while (cond) { __builtin_amdgcn_s_sleep(1); \
    if ((++_sp & 255u) == 0u) { if (xb_ld(&(bar)[XB_TMO])) break; if (_sp > XB_SPIN_CAP) { atomicAdd(&(bar)[XB_TMO], 1u); break; } } } } while (0)
struct XcdBarrier { unsigned* bar; unsigned x; volatile LAS unsigned* st; };
__device__ __forceinline__ XcdBarrier xcd_barrier_post(unsigned* bar, volatile LAS unsigned* st, bool t0) {
    XcdBarrier b; b.bar = bar; b.x = xb_xcc_id(); b.st = st;
    if (t0) (void)xb_add(&bar[XB_XCNT(b.x)], 1u);
    return b;
}
__device__ __forceinline__ void xcd_barrier_complete(unsigned* bar, unsigned x, unsigned& nloc, unsigned& nx) {
    const unsigned G = gridDim.x;
    unsigned sum, cnt, mine, sp = 0u;
    for (;;) {
        sum = 0u; cnt = 0u; mine = 0u;
#pragma unroll
        for (unsigned j = 0; j < 16; ++j) { const unsigned c = xb_ld(&bar[XB_XCNT(j)]); sum += c; cnt += (c > 0u) ? 1u : 0u; mine = (j == x) ? c : mine; }
        if (sum == G) break;
        __builtin_amdgcn_s_sleep(1);
        if ((++sp & 255u) == 0u) { if (xb_ld(&bar[XB_TMO])) break; if (sp > XB_SPIN_CAP) { atomicAdd(&bar[XB_TMO], 1u); break; } }
    }
    nloc = mine > 0u ? mine : 1u; nx = cnt > 0u ? cnt : 1u;
}
__device__ __forceinline__ void xcd_barrier(const XcdBarrier& b, bool t0) {
    asm volatile("s_waitcnt vmcnt(0)" ::: "memory");
    __syncthreads();
    if (t0) {
        unsigned* bar = b.bar;
        __builtin_amdgcn_s_waitcnt(0);
        unsigned nloc = b.st[0], nx = b.st[1];
        if (nloc == 0u) { xcd_barrier_complete(bar, b.x, nloc, nx); b.st[0] = nloc; b.st[1] = nx; }
        const unsigned old = xb_add(&bar[XB_XSUB(b.x)], 1u);
        const unsigned gen = old / nloc;
        if (old + 1u == (gen + 1u) * nloc) {
            __builtin_amdgcn_fence(__ATOMIC_RELEASE, "agent");
            asm volatile("s_waitcnt vmcnt(0)" ::: "memory");
            const unsigned og = xb_add(&bar[XB_TOP], 1u);
            const unsigned tg = og / nx;
            if (og + 1u == (tg + 1u) * nx) xb_add(&bar[XB_TOPGEN], 1u);
            else XB_SPIN(xb_ld(&bar[XB_TOPGEN]) == tg, bar);
            __builtin_amdgcn_fence(__ATOMIC_ACQUIRE, "agent");
            xb_add(&bar[XB_XGEN(b.x)], 1u);
            asm volatile("s_waitcnt vmcnt(0)" ::: "memory");
        } else {
            XB_SPIN(xb_ld(&bar[XB_XGEN(b.x)]) == gen, bar);
            __builtin_amdgcn_fence(__ATOMIC_ACQUIRE, "agent");
            asm volatile("s_waitcnt vmcnt(0)" ::: "memory");
        }
    }
    __syncthreads();
}
constexpr int NWAVES = 8, NTHR = 512;
constexpr int LDS_BYTES = 163840;
struct Args {
    const float* in[28]; float* out; unsigned char* ws; int ph_lo, ph_hi;
};
constexpr int N_PHASES = 15;

struct Frame {
    LAS unsigned char* lds; int wave, vcu, G;
};

__device__ __forceinline__ void transpose_item(const float* W, int ldw, int k0, int n0, bf16_t* dst, int ldt, const float* kscale, LAS float* scr, int lane) {
    f32x4 v[8]; const int kr = lane >> 3, n4 = (lane & 7) * 4;
#pragma unroll
    for (int i = 0; i < 8; ++i) v[i] = *(const f32x4*)(W + (size_t)(k0 + i * 8 + kr) * ldw + n0 + n4);
#pragma unroll
    for (int i = 0; i < 8; ++i) { const int kk = i * 8 + kr; f32x4 x = v[i]; if (kscale) x = x * kscale[k0 + kk];
        scr[kk * 33 + n4 + 0] = x[0]; scr[kk * 33 + n4 + 1] = x[1]; scr[kk * 33 + n4 + 2] = x[2]; scr[kk * 33 + n4 + 3] = x[3]; }
    asm volatile("s_waitcnt lgkmcnt(0)" ::: "memory");
    const int c = lane & 7;
#pragma unroll
    for (int j = 0; j < 4; ++j) { const int n = (lane >> 3) + 8 * j; const LAS float* s = scr + (8 * c) * 33 + n;
        u32x4 o; o.x = cvt_pk_bf16(s[0 * 33], s[1 * 33]); o.y = cvt_pk_bf16(s[2 * 33], s[3 * 33]); o.z = cvt_pk_bf16(s[4 * 33], s[5 * 33]); o.w = cvt_pk_bf16(s[6 * 33], s[7 * 33]);
        *(u32x4*)(dst + (size_t)n * ldt + k0 + 8 * c) = o; }
    asm volatile("s_waitcnt lgkmcnt(0)" ::: "memory");
}
__device__ __forceinline__ void transpose_item_fp8(const float* W, int ldw, int k0, int n0, unsigned char* dst, int ldt, float scale, const float* kscale, LAS float* scr, int lane) {
    f32x4 v[8]; const int kr = lane >> 3, n4 = (lane & 7) * 4;
#pragma unroll
    for (int i = 0; i < 8; ++i) v[i] = *(const f32x4*)(W + (size_t)(k0 + i * 8 + kr) * ldw + n0 + n4);
#pragma unroll
    for (int i = 0; i < 8; ++i) { const int kk = i * 8 + kr; const f32x4 x = v[i] * (kscale ? scale * kscale[k0 + kk] : scale);
        scr[kk * 33 + n4 + 0] = x[0]; scr[kk * 33 + n4 + 1] = x[1]; scr[kk * 33 + n4 + 2] = x[2]; scr[kk * 33 + n4 + 3] = x[3]; }
    asm volatile("s_waitcnt lgkmcnt(0)" ::: "memory");
    const int n = lane >> 1, kh = (lane & 1) * 32; const LAS float* s = scr + kh * 33 + n;
    u32x4 o0, o1;
    o0.x = pk4_fp8(s[0 * 33], s[1 * 33], s[2 * 33], s[3 * 33]); o0.y = pk4_fp8(s[4 * 33], s[5 * 33], s[6 * 33], s[7 * 33]); o0.z = pk4_fp8(s[8 * 33], s[9 * 33], s[10 * 33], s[11 * 33]); o0.w = pk4_fp8(s[12 * 33], s[13 * 33], s[14 * 33], s[15 * 33]);
    o1.x = pk4_fp8(s[16 * 33], s[17 * 33], s[18 * 33], s[19 * 33]); o1.y = pk4_fp8(s[20 * 33], s[21 * 33], s[22 * 33], s[23 * 33]); o1.z = pk4_fp8(s[24 * 33], s[25 * 33], s[26 * 33], s[27 * 33]); o1.w = pk4_fp8(s[28 * 33], s[29 * 33], s[30 * 33], s[31 * 33]);
    *(u32x4*)(dst + (size_t)n * ldt + k0 + kh) = o0; *(u32x4*)(dst + (size_t)n * ldt + k0 + kh + 16) = o1;
    asm volatile("s_waitcnt lgkmcnt(0)" ::: "memory");
}
__device__ __forceinline__ void rms_rows2_to_bf16(const float* xa, const float* xb, const float* g, bf16_t* oa, bf16_t* ob, int lane) {
    const f32x4* ra = (const f32x4*)xa + lane; const f32x4* rb = (const f32x4*)xb + lane; const f32x4* gr = (const f32x4*)g + lane;
    f32x4 va[4], vb[4]; float sa = 0.f, sb = 0.f;
#pragma unroll
    for (int j = 0; j < 4; ++j) { va[j] = ra[64 * j]; vb[j] = rb[64 * j]; }
#pragma unroll
    for (int j = 0; j < 4; ++j) { sa += (va[j].x * va[j].x + va[j].y * va[j].y) + (va[j].z * va[j].z + va[j].w * va[j].w); sb += (vb[j].x * vb[j].x + vb[j].y * vb[j].y) + (vb[j].z * vb[j].z + vb[j].w * vb[j].w); }
    const float rsa = __builtin_amdgcn_rsqf(wave_sum(sa) * (1.f / DM) + RMS_EPS), rsb = __builtin_amdgcn_rsqf(wave_sum(sb) * (1.f / DM) + RMS_EPS);
    u32x2* pa = (u32x2*)oa + lane; u32x2* pb = (u32x2*)ob + lane;
#pragma unroll
    for (int j = 0; j < 4; ++j) { const f32x4 gg = gr[64 * j]; u32x2 w;
        w.x = cvt_pk_bf16(va[j].x * rsa * gg.x, va[j].y * rsa * gg.y); w.y = cvt_pk_bf16(va[j].z * rsa * gg.z, va[j].w * rsa * gg.w); pa[64 * j] = w;
        w.x = cvt_pk_bf16(vb[j].x * rsb * gg.x, vb[j].y * rsb * gg.y); w.y = cvt_pk_bf16(vb[j].z * rsb * gg.z, vb[j].w * rsb * gg.w); pb[64 * j] = w; }
}

__global__ void __launch_bounds__(NTHR, 2) mega(Args args) {
    extern __shared__ __attribute__((aligned(16))) unsigned char lds_raw[];
    Frame F; F.lds = (LAS unsigned char*)lds_raw; F.wave = __builtin_amdgcn_readfirstlane(threadIdx.x >> 6);
    F.G = gridDim.x; { const int bx = blockIdx.x; F.vcu = (F.G % 8 == 0) ? (bx % 8) * (F.G / 8) + bx / 8 : bx; }
    unsigned char* ws = args.ws;
    unsigned* ctl = (unsigned*)(ws + WS_CTL);
    const float* x = args.in[0]; float* out = args.out;
    bf16_t* Win_t = (bf16_t*)(ws + WS_WIN); bf16_t* Wout_t = (bf16_t*)(ws + WS_WOUT); bf16_t* Wq_t = (bf16_t*)(ws + WS_WQ); bf16_t* Wkv_t = (bf16_t*)(ws + WS_WKV);
    bf16_t* Wo_t = (bf16_t*)(ws + WS_WO); bf16_t* Wr_t = (bf16_t*)(ws + WS_WR); bf16_t* Wsgu = (bf16_t*)(ws + WS_WSGU); bf16_t* memn = (bf16_t*)(ws + WS_MEMN);
    bf16_t* Km = (bf16_t*)(ws + WS_KM); bf16_t* Vt = (bf16_t*)(ws + WS_VT); bf16_t* Wgu_t = (bf16_t*)(ws + WS_WGU); bf16_t* Wd_t = (bf16_t*)(ws + WS_WD);
    bf16_t* Z = (bf16_t*)(ws + WS_RA); bf16_t* Qm = (bf16_t*)(ws + WS_RA); bf16_t* Sc = (bf16_t*)(ws + WS_RA + 128 * MiB); bf16_t* xg = (bf16_t*)(ws + WS_RA); bf16_t* yb = (bf16_t*)(ws + WS_RA);
    bf16_t* XN = (bf16_t*)(ws + WS_RB); bf16_t* AO = (bf16_t*)(ws + WS_RB); bf16_t* Om = (bf16_t*)(ws + WS_RB); bf16_t* act = (bf16_t*)(ws + WS_RB);
    bf16_t* x1b = (bf16_t*)(ws + WS_RC); bf16_t* x2b = (bf16_t*)(ws + WS_RC); unsigned char* x2f8 = ws + WS_X2F8;
    float* ssq1 = (float*)(ws + WS_SSQ1); float* ssq2 = (float*)(ws + WS_SSQ2); float* rstd2 = (float*)(ws + WS_SSQ1);     float* logit = (float*)(ws + WS_LOGIT);
    int* tok_e = (int*)(ws + WS_TOKE); float* tok_w = (float*)(ws + WS_TOKW); int* tok_s = (int*)(ws + WS_TOKS); int* row_tok = (int*)(ws + WS_ROWTOK); float* rowrs = (float*)(ws + WS_ROWTOK + 1 * MiB);
    const int gw = F.vcu * NWAVES + F.wave, NGW = F.G * NWAVES;
    const int lo = args.ph_lo, hi = args.ph_hi;
#define IN(k) (lo <= (k) && (k) < hi)
#if MK_ONE_LAUNCH
    volatile LAS unsigned* misc = (volatile LAS unsigned*)(F.lds + LDS_MISC);
    if (threadIdx.x < 64) misc[threadIdx.x] = 0u;
    __syncthreads();
    XcdBarrier xbar = xcd_barrier_post(ctl + CW_BAR, misc + 8, threadIdx.x == 0);
#define GRID_BAR(k) do { if (IN(k) && IN((k) + 1)) { if ((k) == 0) cg::this_grid().sync(); else xcd_barrier(xbar, F.wave == 0 && lane_id() == 0); } } while (0)
#else
#define GRID_BAR(k) do { } while (0)
#endif
#define LOCAL_SEAM() do { asm volatile("s_waitcnt vmcnt(0)" ::: "memory"); __syncthreads(); __builtin_amdgcn_fence(__ATOMIC_ACQUIRE, "agent"); asm volatile("s_waitcnt vmcnt(0)" ::: "memory"); __syncthreads(); } while (0)

    if (IN(0)) {
        const int lane_ = lane_id(), tid_ = F.wave * 64 + lane_; (void)tid_;
        LAS float* scr = (LAS float*)(F.lds + F.wave * 16384);
        constexpr int I_IN = 16 * 80, I_SQ = 16 * 32, I_KV = 16 * 64, I_G = 16 * 16, I_D = 8 * 32;
        constexpr int NITEMS = I_IN + 3 * I_SQ + I_KV + NEXP * (2 * I_G + I_D);
        for (int it = gw; it < NITEMS; it += NGW) {
            int r = it;
            if (r < I_IN) { const int kb = r / 80, nb = r % 80; transpose_item(args.in[3], ZP, kb * 64, nb * 32, Win_t + (size_t)(nb * 32) * DM, DM, nullptr, scr, lane_); continue; } r -= I_IN;
            if (r < I_SQ) { const int kb = r / 32, nb = r % 32; transpose_item(args.in[13], DM, kb * 64, nb * 32, Wout_t + (size_t)(nb * 32) * DM, DM, nullptr, scr, lane_); continue; } r -= I_SQ;
            if (r < I_SQ) { const int kb = r / 32, nb = r % 32; transpose_item_fp8(args.in[16], DM, kb * 64, nb * 32, (unsigned char*)Wq_t + (size_t)(nb * 32) * DM, DM, F8_WSCALE, args.in[14], scr, lane_); continue; } r -= I_SQ;
            if (r < I_KV) { const int kb = r / 64, nb = r % 64; transpose_item(args.in[17], 2 * DM, kb * 64, nb * 32, Wkv_t + (size_t)(nb * 32) * DM, DM, nullptr, scr, lane_); continue; } r -= I_KV;
            if (r < I_SQ) { const int kb = r / 32, nb = r % 32; transpose_item_fp8(args.in[18], DM, kb * 64, nb * 32, (unsigned char*)Wo_t + (size_t)(nb * 32) * DM, DM, F8_WSCALE, nullptr, scr, lane_); continue; } r -= I_SQ;
            const int e = r / (2 * I_G + I_D); r -= e * (2 * I_G + I_D);
            if (r < 2 * I_G) { const int up = r >= I_G; if (up) r -= I_G; const int kb = r / 16, nb = r % 16, n0 = nb * 32;
                const float* W = (up ? args.in[25] : args.in[24]) + (size_t)e * DM * DEXP;
                transpose_item_fp8(W, DEXP, kb * 64, n0, (unsigned char*)Wgu_t + ((size_t)e * 1024 + (n0 >> 7) * 256 + 64 * ((n0 & 127) >> 5) + 32 * up) * DM, DM, F8_WSCALE, args.in[19], scr, lane_); continue; }
            r -= 2 * I_G;
            { const int kb = r / 32, nb = r % 32; transpose_item_fp8(args.in[26] + (size_t)e * DEXP * DM, DM, kb * 64, nb * 32, (unsigned char*)Wd_t + ((size_t)e * 1024 + nb * 32) * DEXP, DEXP, F8_WSCALE, nullptr, scr, lane_); }
        }
        for (int i = blockIdx.x * NTHR + tid_; i < 256 * DM; i += F.G * NTHR) { const int n = i >> 10, k = i & 1023; float v = 0.f;
            if (n < 4) v = args.in[20][k * 4 + n] * args.in[19][k]; else if (n < 36) v = args.in[22][k * 32 + (n - 4)] * args.in[19][k];
            Wr_t[i] = (bf16_t)(cvt_pk_bf16(v, 0.f) & 0xffffu); }
        for (int i = blockIdx.x * NTHR + tid_; i < 4 * 128 * 128; i += F.G * NTHR) { const int t = (i >> 7) & 127, s = i & 127; const float v = s <= t ? args.in[6][i] : 0.f; Wsgu[i] = (bf16_t)(cvt_pk_bf16(v, 0.f) & 0xffffu); }
        for (int m = gw; m < M; m += 2 * NGW) rms_rows2_to_bf16(x + (size_t)m * DM, x + (size_t)(m + NGW) * DM, args.in[2], XN + (size_t)m * DM, XN + (size_t)(m + NGW) * DM, lane_);
        for (int m = gw; m < MROWS / 2; m += NGW) rms_rows2_to_bf16(args.in[1] + (size_t)m * DM, args.in[1] + (size_t)(m + MROWS / 2) * DM, args.in[15], memn + (size_t)m * DM, memn + (size_t)(m + MROWS / 2) * DM, lane_);
        __syncthreads();
    }
    GRID_BAR(0);

    if (IN(1)) {
        { pg8::Gemm g{DM, DM, DM}; pg8::PlainSched S; S.to.init(M / 256, ZP / 256, F.G, (int)blockIdx.x); S.A = (const char*)XN; S.B = (const char*)Win_t; S.tA = (size_t)256 * DM * 2; S.tB = (size_t)256 * DM * 2;
          pg8::EpiZ E{Z, ctl + CW_KMX}; pg8::gemm_phase(F.lds, F.wave, g, S, E); }
    }
    GRID_BAR(1);

    if (IN(2)) {
        const int lane_ = lane_id(), tid_ = F.wave * 64 + lane_; (void)tid_;
        float lam;
        { const float a = args.in[8][lane_] * args.in[9][lane_], b = args.in[10][lane_] * args.in[11][lane_];
          lam = __expf(wave_sum(a)) - __expf(wave_sum(b)) + 0.2f; }
        const int nitems = 32 * 16, npass = 4;
        int nit, itA, itB, itC;
        if (F.G == 256) { const int b = F.vcu >> 5, r = F.vcu & 31; if (r < 16) { nit = 1; itA = ((b * 4 + 3) << 4) | r; itB = itA; itC = itA; }
            else { const int y = r - 16; nit = 3; itA = ((b * 4 + 2) << 4) | y; itB = ((b * 4 + 1) << 4) | (15 - y); itC = ((b * 4 + 0) << 4) | y; } }
        else { const int per = (nitems + F.G - 1) / F.G; itA = F.vcu * per; int e_ = itA + per; if (e_ > nitems) e_ = nitems; nit = e_ - itA; itB = itA + 1; itC = itA + 2; }
#define ITEM_OF(i) ((F.G == 256) ? ((i) == 0 ? itA : ((i) == 1 ? itB : itC)) : itA + (i))
        if (nit > 0) {
            int ii = 0, pass = 0; da::BlockRef cur = da::mkref(Z, AO, ctl + CW_KMX, ITEM_OF(0), 0); da::Seam S;
            da::prime(cur, (char*)lds_raw, S, F.wave);
            for (;;) {
                int ni = ii, np = pass + 1; if (np == npass) { np = 0; ni = ii + 1; }
                const bool last = ni >= nit * PROBE_DUP_ATTN;
                const da::BlockRef nxt = last ? cur : da::mkref(Z, AO, ctl + CW_KMX, ITEM_OF(ni % nit), np);
                da::block(cur, nxt, (char*)lds_raw, S, lam, args.in[12], F.wave);
                if (last) break;
                cur = nxt; ii = ni; pass = np;
            }
        }
#undef ITEM_OF
        __syncthreads();
        {
            const int lane = lane_, w = F.wave;
            const int nun = (M / 128) * 4;
            const int ch0 = (lane & 15) * 8, t = 16 * w + (lane & 15), nks = (w + 2) >> 1;
            u32x4 vr[4];
            LAS int* sq = (LAS int*)(F.lds + 2 * 34816);
            const bool puller = (w == 0 && lane == 0);
            if (puller) { sq[0] = (int)atomicAdd(ctl + CW_SGUQ, 1u); sq[1] = (int)atomicAdd(ctl + CW_SGUQ, 1u); }
            __syncthreads();
            int uidx = __builtin_amdgcn_readfirstlane(sq[0]), unext = __builtin_amdgcn_readfirstlane(sq[1]), kk = 0;
            if (uidx < nun) { const size_t R0 = (size_t)(uidx >> 2) * 128; const int g = uidx & 3;
#pragma unroll
                for (int ps = 0; ps < 4; ++ps) vr[ps] = *(const u32x4*)(Z + (R0 + 16 * w + 4 * ps + (lane >> 4)) * ZP + ZV + g * 128 + ch0); }
            int gcur = -1; float lg[8], lb[8]; bf16x8 wf[4]; float bias = 0.f; int buf = 0;
#pragma unroll
            for (int j = 0; j < 8; ++j) { lg[j] = 0.f; lb[j] = 0.f; }
#pragma unroll
            for (int ks = 0; ks < 4; ++ks) wf[ks] = (bf16x8){0, 0, 0, 0, 0, 0, 0, 0};
            for (; uidx < nun; uidx = unext, unext = __builtin_amdgcn_readfirstlane(sq[(kk + 1) & 3]), buf ^= 1) {
                int pulled_ = 0; if (puller) pulled_ = (int)atomicAdd(ctl + CW_SGUQ, 1u);
                const int c = uidx >> 2, g = uidx & 3; const size_t R0 = (size_t)c * 128;
                LAS bf16_t* vnT = (LAS bf16_t*)(F.lds + buf * 34816);
                if (g != gcur) { gcur = g;
#pragma unroll
                    for (int j = 0; j < 8; ++j) { lg[j] = args.in[4][g * 128 + ch0 + j]; lb[j] = args.in[5][g * 128 + ch0 + j]; }
#pragma unroll
                    for (int ks = 0; ks < 4; ++ks) if (ks < nks) wf[ks] = *(const bf16x8*)(Wsgu + ((size_t)g * 128 + t) * 128 + ks * 32 + 8 * (lane >> 4));
                    bias = args.in[7][g * 128 + t]; }
#pragma unroll
                for (int ps = 0; ps < 4; ++ps) { const int sr = 16 * w + 4 * ps + (lane >> 4); const u32x4 raw = vr[ps];
                    float v[8] = {bf_lo(raw.x), bf_hi(raw.x), bf_lo(raw.y), bf_hi(raw.y), bf_lo(raw.z), bf_hi(raw.z), bf_lo(raw.w), bf_hi(raw.w)};
                    float sm = 0.f;
#pragma unroll
                    for (int j = 0; j < 8; ++j) sm += v[j];
#pragma unroll
                    for (int o = 1; o < 16; o <<= 1) sm += __shfl_xor(sm, o);
                    const float mu = sm * (1.f / 128.f); float q = 0.f;
#pragma unroll
                    for (int j = 0; j < 8; ++j) { v[j] -= mu; q += v[j] * v[j]; }
#pragma unroll
                    for (int o = 1; o < 16; o <<= 1) q += __shfl_xor(q, o);
                    const float rstd = __builtin_amdgcn_rsqf(q * (1.f / 128.f) + LN_EPS);
#pragma unroll
                    for (int j = 0; j < 8; ++j) { const float y = v[j] * rstd * lg[j] + lb[j]; vnT[(ch0 + j) * 136 + sr] = (bf16_t)(cvt_pk_bf16(y, 0.f) & 0xffffu); } }
                u32x2 ur[8];
#pragma unroll
                for (int mi = 0; mi < 8; ++mi) ur[mi] = *(const u32x2*)(Z + (R0 + t) * ZP + ZU + g * 128 + 16 * mi + 4 * (lane >> 4));
                { const int un = unext; if (un < nun) { const size_t Rn = (size_t)(un >> 2) * 128; const int gn = un & 3;
#pragma unroll
                    for (int ps = 0; ps < 4; ++ps) vr[ps] = *(const u32x4*)(Z + (Rn + 16 * w + 4 * ps + (lane >> 4)) * ZP + ZV + gn * 128 + ch0); } }
                if (puller) sq[(kk + 2) & 3] = pulled_;
                ++kk;
                __syncthreads();
                f32x4 acc[8];
#pragma unroll
                for (int mi = 0; mi < 8; ++mi) acc[mi] = (f32x4){0.f, 0.f, 0.f, 0.f};
#pragma unroll
                for (int ks = 0; ks < 4; ++ks) if (ks < nks) {
#pragma unroll
                    for (int mi = 0; mi < 8; ++mi) { const bf16x8 afr = *(const LAS bf16x8*)(vnT + (16 * mi + (lane & 15)) * 136 + ks * 32 + 8 * (lane >> 4));
                        acc[mi] = __builtin_amdgcn_mfma_f32_16x16x32_bf16(afr, wf[ks], acc[mi], 0, 0, 0); } }
#pragma unroll
                for (int mi = 0; mi < 8; ++mi) { const int ch = 16 * mi + 4 * (lane >> 4); const u32x2 u2 = ur[mi];
                    const float o0 = bf_lo(u2.x) * (acc[mi][0] + bias), o1 = bf_hi(u2.x) * (acc[mi][1] + bias), o2 = bf_lo(u2.y) * (acc[mi][2] + bias), o3 = bf_hi(u2.y) * (acc[mi][3] + bias);
                    u32x2 wv; wv.x = cvt_pk_bf16(o0, o1); wv.y = cvt_pk_bf16(o2, o3);
                    *(u32x2*)(AO + (R0 + t) * DM + g * 128 + ch) = wv; }
            }
            __syncthreads();
        }
        {
            int e = -1;
            if (F.G == 256) { const int b = F.vcu >> 5, r = F.vcu & 31; if (r >= 16 && r < 24) e = b * 8 + (r - 16); }
            for (int e2 = (F.G == 256 ? e : F.vcu); e2 >= 0 && e2 < 64; e2 = (F.G == 256 ? 64 : e2 + F.G)) {
                pg8::Gemm g{DM, DM, DM}; pg8::OneUnitSched S;
                if (e2 < 32) { S.u0.pm = e2 >> 2; S.u0.pn = e2 & 3; S.u0.aux = 0; S.u0.rows = nullptr; S.u0.A = (const char*)(memn + (size_t)S.u0.pm * 256 * DM); S.u0.B = (const char*)(Wkv_t + (size_t)S.u0.pn * 256 * DM);
                    pg8::EpiF8 E{(unsigned char*)Km, DM, nullptr, F8_KSCALE}; pg8::gemm_phase(F.lds, F.wave, g, S, E); }
                else { const int e3 = e2 - 32; S.u0.pm = e3 >> 3; S.u0.pn = e3 & 7; S.u0.aux = 0; S.u0.rows = nullptr; S.u0.A = (const char*)(Wkv_t + (size_t)(1024 + S.u0.pm * 256) * DM); S.u0.B = (const char*)(memn + (size_t)S.u0.pn * 256 * DM);
                    pg8::EpiF8 E{(unsigned char*)Vt, MROWS, nullptr, F8_VSCALE}; pg8::gemm_phase(F.lds, F.wave, g, S, E); }
            }
        }
    }
    GRID_BAR(2);

    if (IN(3)) {
        pg8::Gemm g{DM, DM, DM}; pg8::PlainSched S; S.to.init(M / 256, 4, F.G, (int)blockIdx.x); S.A = (const char*)AO; S.B = (const char*)Wout_t; S.tA = (size_t)256 * DM * 2; S.tB = (size_t)256 * DM * 2;
        pg8::EpiResid<false> E{x, x1b, ssq1, (LAS float*)(F.lds + 131072 + 1024), x2f8, 1.f}; pg8::gemm_phase(F.lds, F.wave, g, S, E);
    }
    GRID_BAR(3);

    if (IN(4)) {
        pg8::Gemm g{DM / 2, DM / 2, DM / 2}; pg8::PlainSched S; S.to.init(M / 256, 4, F.G, (int)blockIdx.x); S.A = (const char*)x2f8; S.B = (const char*)Wq_t; S.tA = (size_t)256 * DM; S.tB = (size_t)256 * DM;
        pg8::EpiF8 E{(unsigned char*)Qm, DM, ssq1, F8_QSCALE * C2_MEM / (F8_XSCALE * F8_WSCALE)}; pg8::gemm_phase<pg8::EpiF8, pg8::PlainSched, false, true>(F.lds, F.wave, g, S, E);
    }
    if (MK_ONE_LAUNCH && IN(4) && IN(5)) LOCAL_SEAM();

    if (IN(5)) {
        pg8::Gemm g{DM / 2, DM / 2, 128}; pg8::MemAttnSched S; S.to.init(M / 256, 4, F.G, (int)blockIdx.x); S.A = (const char*)Qm; S.B = (const char*)Km; S.tA = (size_t)256 * DM; S.hA = 256; S.bB = (size_t)256 * DM; S.hB = 256;
        pg8::EpiSoftmax E{(unsigned char*)Sc, (LAS float*)(F.lds + LDS_MISC + 1024), 1.0f / (F8_QSCALE * F8_KSCALE)}; pg8::gemm_phase<pg8::EpiSoftmax, pg8::MemAttnSched, false, true>(F.lds, F.wave, g, S, E);
    }
    if (MK_ONE_LAUNCH && IN(5) && IN(6 + 1)) LOCAL_SEAM();

    if (IN(7)) {
        pg8::Gemm g{DM / 2, MROWS / 2, 128}; pg8::MemAttnSched S; S.to.init(M / 256, 4, F.G, (int)blockIdx.x); S.A = (const char*)Sc; S.B = (const char*)Vt; S.tA = (size_t)256 * DM; S.hA = 256; S.bB = 256; S.hB = (size_t)256 * MROWS;
        pg8::EpiF8 E{(unsigned char*)Om, DM, nullptr, F8_OSCALE / (F8_PSCALE * F8_VSCALE)}; pg8::gemm_phase<pg8::EpiF8, pg8::MemAttnSched, false, true>(F.lds, F.wave, g, S, E);
    }
    GRID_BAR(7);

    if (IN(8)) {
        pg8::Gemm g{DM / 2, DM / 2, DM / 2}; pg8::PlainSched S; S.to.init(M / 256, 4, F.G, (int)blockIdx.x); S.A = (const char*)Om; S.B = (const char*)Wo_t; S.tA = (size_t)256 * DM; S.tB = (size_t)256 * DM;
        pg8::EpiResid<true> E{x1b, x2b, ssq2, (LAS float*)(F.lds + 131072 + 1024), x2f8, 1.0f / (F8_OSCALE * F8_WSCALE)}; pg8::gemm_phase<pg8::EpiResid<true>, pg8::PlainSched, false, true>(F.lds, F.wave, g, S, E);
    }
    GRID_BAR(8);

    if (IN(9)) {
        pg8::Gemm g{DM, DM, DM}; pg8::PlainSched S; S.to.init(M / 256, 1, F.G, (int)blockIdx.x); S.A = (const char*)x2b; S.B = (const char*)Wr_t; S.tA = (size_t)256 * DM * 2; S.tB = 0;
        pg8::EpiRouter E{logit, ssq2, args.in[21], args.in[23], rstd2}; pg8::gemm_phase(F.lds, F.wave, g, S, E);
    }
    GRID_BAR(9);

    if (IN(10)) {
        const int lane_ = lane_id(), tid_ = F.wave * 64 + lane_; (void)tid_;
        LAS unsigned* lcnt = (LAS unsigned*)F.lds; LAS unsigned* lbase = lcnt + 32;
        for (int t0 = blockIdx.x * NTHR; t0 < M; t0 += F.G * NTHR) {
            if (tid_ < 32) lcnt[tid_] = 0u;
            __syncthreads();
            const int tok = t0 + tid_;
            const f32x4 lg = *(const f32x4*)(logit + (size_t)tok * 64);
            int gi = 0; float gm = lg[0];
#pragma unroll
            for (int j = 1; j < 4; ++j) if (lg[j] > gm) { gm = lg[j]; gi = j; }
            float gs = 0.f;
#pragma unroll
            for (int j = 0; j < 4; ++j) gs += __expf(lg[j] - gm);
            const float gate = 1.0f / gs;
            const f32x4 ea = *(const f32x4*)(logit + (size_t)tok * 64 + 4 + gi * 8), eb = *(const f32x4*)(logit + (size_t)tok * 64 + 8 + gi * 8);
            const float el[8] = {ea[0], ea[1], ea[2], ea[3], eb[0], eb[1], eb[2], eb[3]};
            int i0 = 0; float m0 = el[0];
#pragma unroll
            for (int j = 1; j < 8; ++j) if (el[j] > m0) { m0 = el[j]; i0 = j; }
            int i1 = -1; float m1 = -__builtin_inff();
#pragma unroll
            for (int j = 0; j < 8; ++j) if (j != i0 && el[j] > m1) { m1 = el[j]; i1 = j; }
            if (i1 < 0) i1 = (i0 == 0) ? 1 : 0;
            const float r = __expf(m1 - m0);
            const float w0 = gate / (1.0f + r), w1 = gate * r / (1.0f + r);
            const int e0 = gi * 8 + i0, e1 = gi * 8 + i1;
            const unsigned r0 = atomicAdd((unsigned*)&lcnt[e0], 1u), r1 = atomicAdd((unsigned*)&lcnt[e1], 1u);
            __syncthreads();
            if (tid_ < 32) lbase[tid_] = atomicAdd(ctl + CW_CNT + tid_, lcnt[tid_]);
            __syncthreads();
            tok_e[tok * 2] = e0; tok_e[tok * 2 + 1] = e1; tok_w[tok * 2] = w0; tok_w[tok * 2 + 1] = w1;
            tok_s[tok * 2] = (int)(lbase[e0] + r0); tok_s[tok * 2 + 1] = (int)(lbase[e1] + r1);
            __syncthreads();
        }
    }
    GRID_BAR(10);

    if (IN(11)) {
        const int lane_ = lane_id(), tid_ = F.wave * 64 + lane_; (void)tid_;
        LAS unsigned* lps = (LAS unsigned*)F.lds;
        if (tid_ == 0) { unsigned acc = 0; for (int e = 0; e < 32; ++e) { lps[e] = acc; const unsigned c = ld_u32_agent(ctl + CW_CNT + e); acc += (c + 255u) & ~255u; } lps[32] = acc; }
        __syncthreads();
        if (blockIdx.x == 0) {
            if (tid_ < 32) { const unsigned s = lps[tid_], e2 = lps[tid_ + 1], c = ld_u32_agent(ctl + CW_CNT + tid_);
                for (unsigned b = s >> 8; b < (e2 >> 8); ++b) ctl[CW_BLKE + b] = (unsigned)tid_;
                for (unsigned r = s + c; r < e2; ++r) { row_tok[r] = 0; rowrs[r] = 0.f; } }
            if (tid_ == 0) ctl[CW_NBLK] = lps[32] >> 8;
        }
        for (int a = blockIdx.x * NTHR + tid_; a < M * 2; a += F.G * NTHR) { const int e = tok_e[a]; const int pos = (int)lps[e] + tok_s[a]; row_tok[pos] = a >> 1; tok_s[a] = pos; rowrs[pos] = rstd2[a >> 1] * (1.0f / (F8_XSCALE * F8_WSCALE)); }
        __syncthreads();
    }
    GRID_BAR(11);

    if (IN(12)) {
        const int nblk = (int)__builtin_amdgcn_readfirstlane(ld_u32_agent(ctl + CW_NBLK));
        pg8::Gemm g{DM / 2, DM / 2, DM / 2}; pg8::MoeSched S{F.G, F.vcu, nblk, ctl + CW_BLKE, (const char*)x2f8, (const char*)Wgu_t, (size_t)0, (size_t)1024 * DM, (size_t)256 * DM, row_tok};
        pg8::EpiGateUp E{(unsigned char*)act, rowrs, row_tok}; pg8::gemm_phase<pg8::EpiGateUp, pg8::MoeSched, true, true>(F.lds, F.wave, g, S, E);
    }
    GRID_BAR(12);

    if (IN(13)) {
        const int nblk = (int)__builtin_amdgcn_readfirstlane(ld_u32_agent(ctl + CW_NBLK));
        pg8::Gemm g{DEXP / 2, DEXP / 2, DEXP / 2}; pg8::MoeSched S{F.G, F.vcu, nblk, ctl + CW_BLKE, (const char*)act, (const char*)Wd_t, (size_t)256 * DEXP, (size_t)1024 * DEXP, (size_t)256 * DEXP, row_tok};
        pg8::EpiF8 E{(unsigned char*)yb, DM, nullptr, F8_YSCALE / (F8_WSCALE * F8_ASCALE)}; pg8::gemm_phase<pg8::EpiF8, pg8::MoeSched, false, true>(F.lds, F.wave, g, S, E);
    }
    GRID_BAR(13);

    if (IN(14)) {
        const int lane_ = lane_id(), tid_ = F.wave * 64 + lane_; (void)tid_;
        const f32x4* gr = (const f32x4*)args.in[27] + lane_;
        f32x4 gg[4];
#pragma unroll
        for (int j = 0; j < 4; ++j) gg[j] = gr[64 * j];
        for (int m = gw; m < M; m += 2 * NGW) {
            const int ma = m, mb = m + NGW;
            const int pa0 = tok_s[ma * 2], pa1 = tok_s[ma * 2 + 1], pb0 = tok_s[mb * 2], pb1 = tok_s[mb * 2 + 1];
            const float wa0 = tok_w[ma * 2], wa1 = tok_w[ma * 2 + 1], wb0 = tok_w[mb * 2], wb1 = tok_w[mb * 2 + 1];
            const u32x2* xa = (const u32x2*)(x2b + (size_t)ma * DM) + lane_; const u32x2* xb = (const u32x2*)(x2b + (size_t)mb * DM) + lane_;
            const unsigned* ya0 = (const unsigned*)((const unsigned char*)yb + (size_t)pa0 * DM) + lane_; const unsigned* ya1 = (const unsigned*)((const unsigned char*)yb + (size_t)pa1 * DM) + lane_;
            const unsigned* yb0 = (const unsigned*)((const unsigned char*)yb + (size_t)pb0 * DM) + lane_; const unsigned* yb1 = (const unsigned*)((const unsigned char*)yb + (size_t)pb1 * DM) + lane_;
            u32x2 ca[4], cb[4]; unsigned a0[4], a1[4], b0[4], b1[4];
#pragma unroll
            for (int j = 0; j < 4; ++j) { ca[j] = xa[64 * j]; cb[j] = xb[64 * j]; a0[j] = ya0[64 * j]; a1[j] = ya1[64 * j]; b0[j] = yb0[64 * j]; b1[j] = yb1[64 * j]; }
            f32x4 va[4], vb[4]; float sa = 0.f, sb = 0.f;
            const float ka0 = wa0 * (1.0f / F8_YSCALE), ka1 = wa1 * (1.0f / F8_YSCALE), kb0 = wb0 * (1.0f / F8_YSCALE), kb1 = wb1 * (1.0f / F8_YSCALE);
#pragma unroll
            for (int j = 0; j < 4; ++j) {
                const f32x2 p0 = __builtin_amdgcn_cvt_pk_f32_fp8(a0[j], false), p1 = __builtin_amdgcn_cvt_pk_f32_fp8(a0[j], true), q0 = __builtin_amdgcn_cvt_pk_f32_fp8(a1[j], false), q1 = __builtin_amdgcn_cvt_pk_f32_fp8(a1[j], true);
                const f32x2 r0 = __builtin_amdgcn_cvt_pk_f32_fp8(b0[j], false), r1 = __builtin_amdgcn_cvt_pk_f32_fp8(b0[j], true), t0 = __builtin_amdgcn_cvt_pk_f32_fp8(b1[j], false), t1 = __builtin_amdgcn_cvt_pk_f32_fp8(b1[j], true);
                va[j].x = bf_lo(ca[j].x) + ka0 * p0.x + ka1 * q0.x; va[j].y = bf_hi(ca[j].x) + ka0 * p0.y + ka1 * q0.y; va[j].z = bf_lo(ca[j].y) + ka0 * p1.x + ka1 * q1.x; va[j].w = bf_hi(ca[j].y) + ka0 * p1.y + ka1 * q1.y;
                vb[j].x = bf_lo(cb[j].x) + kb0 * r0.x + kb1 * t0.x; vb[j].y = bf_hi(cb[j].x) + kb0 * r0.y + kb1 * t0.y; vb[j].z = bf_lo(cb[j].y) + kb0 * r1.x + kb1 * t1.x; vb[j].w = bf_hi(cb[j].y) + kb0 * r1.y + kb1 * t1.y;
                sa += (va[j].x * va[j].x + va[j].y * va[j].y) + (va[j].z * va[j].z + va[j].w * va[j].w); sb += (vb[j].x * vb[j].x + vb[j].y * vb[j].y) + (vb[j].z * vb[j].z + vb[j].w * vb[j].w); }
            const float ra = __builtin_amdgcn_rsqf(wave_sum(sa) * (1.f / DM) + RMS_EPS), rb = __builtin_amdgcn_rsqf(wave_sum(sb) * (1.f / DM) + RMS_EPS);
            f32x4* oa = (f32x4*)(out + (size_t)ma * DM) + lane_; f32x4* ob = (f32x4*)(out + (size_t)mb * DM) + lane_;
#pragma unroll
            for (int j = 0; j < 4; ++j) { oa[64 * j] = va[j] * ra * gg[j]; ob[64 * j] = vb[j] * rb * gg[j]; }
        }
    }
#undef IN
#undef GRID_BAR
}

extern "C" void kernel_launch(void* const* d_in, const int* in_sizes, int n_in, void* d_out, int out_size, void* d_ws, size_t ws_size, hipStream_t stream) {
    static int grid = 0;
    if (grid == 0) {
        if (n_in != 28 || in_sizes[0] != M * DM || out_size != M * DM || ws_size < WS_END) { fprintf(stderr, "kernel_launch: unexpected shapes (n_in %d in0 %d out %d ws %zu)\n", n_in, n_in > 0 ? in_sizes[0] : -1, out_size, ws_size); grid = -1; return; }
        int dev = 0, cus = 0, per_cu = 0;
        if (hipGetDevice(&dev) != hipSuccess || hipDeviceGetAttribute(&cus, hipDeviceAttributeMultiprocessorCount, dev) != hipSuccess) { grid = -1; return; }
        if (hipFuncSetAttribute((const void*)mega, hipFuncAttributeMaxDynamicSharedMemorySize, LDS_BYTES) != hipSuccess) { fprintf(stderr, "kernel_launch: hipFuncSetAttribute failed\n"); grid = -1; return; }
        if (hipOccupancyMaxActiveBlocksPerMultiprocessor(&per_cu, (const void*)mega, NTHR, LDS_BYTES) != hipSuccess || per_cu < 1) { fprintf(stderr, "kernel_launch: occupancy query says %d\n", per_cu); per_cu = 1; }
        (void)hipGetLastError();
        grid = cus;
    }
    if (grid < 0) return;
    (void)hipMemsetAsync((char*)d_ws + WS_CTL, 0, CTL_BYTES, stream);
    Args a{};
    for (int i = 0; i < 28; ++i) a.in[i] = (const float*)d_in[i];
    a.out = (float*)d_out; a.ws = (unsigned char*)d_ws;
#if MK_ONE_LAUNCH
    a.ph_lo = 0; a.ph_hi = N_PHASES;
    void* kargs[] = {&a};
    hipError_t e = hipLaunchCooperativeKernel((const void*)mega, dim3(grid), dim3(NTHR), kargs, LDS_BYTES, stream);
    if (e != hipSuccess) fprintf(stderr, "cooperative launch failed: %s (grid %d)\n", hipGetErrorString(e), grid);
#else
    for (int p = 0; p < N_PHASES; ++p) { a.ph_lo = p; a.ph_hi = p + 1; hipLaunchKernelGGL(mega, dim3(grid), dim3(NTHR), LDS_BYTES, stream, a); }
#endif
}
```

```cpp
#include <hip/hip_runtime.h>
#include <hip/hip_cooperative_groups.h>
#include <cstdio>
#include <cstdint>
namespace cg = cooperative_groups;

#ifndef PROBE_DUP
#define PROBE_DUP -1
#endif
#ifndef PROBE_DUP_ATTN
#define PROBE_DUP_ATTN 1
#endif
#ifndef MK_ONE_LAUNCH
#define MK_ONE_LAUNCH 1
#endif

#define LAS __attribute__((address_space(3)))
#define GAS __attribute__((address_space(1)))
typedef unsigned short bf16_t;
typedef short bf16x8 __attribute__((ext_vector_type(8)));
typedef short s16x4 __attribute__((ext_vector_type(4)));
typedef float f32x2 __attribute__((ext_vector_type(2)));
typedef float f32x4 __attribute__((ext_vector_type(4)));
typedef float f32x16 __attribute__((ext_vector_type(16)));
typedef unsigned u32x2 __attribute__((ext_vector_type(2)));
typedef unsigned u32x4 __attribute__((ext_vector_type(4)));
typedef int v8i32 __attribute__((ext_vector_type(8)));

constexpr int NB = 8, SEQ = 8192, DM = 1024, M = NB * SEQ;
constexpr int ZP = 2560;
constexpr int ZU = 0, ZV = 512, ZQ = 1024, ZK = 1536, ZVAL = 2048;
constexpr int MEML = 256, MROWS = NB * MEML;
constexpr int NEXP = 32, DEXP = 512;
constexpr int PROWS = 2 * M + NEXP * 256;
constexpr int MAXBLK = PROWS / 256;
constexpr float RMS_EPS = 1e-6f, LN_EPS = 1e-5f;
constexpr float LOG2E = 1.4426950408889634f;
constexpr float C2_DIFF = 0.125f * LOG2E;
constexpr float C2_MEM = 0.0625f * LOG2E;

constexpr size_t MiB = 1u << 20;
constexpr size_t WS_CTL = 0, CTL_BYTES = 1 * MiB;
constexpr size_t WS_WIN = 1 * MiB;
constexpr size_t WS_WOUT = 6 * MiB;
constexpr size_t WS_WQ = 8 * MiB;
constexpr size_t WS_WKV = 10 * MiB;
constexpr size_t WS_WO = 14 * MiB;
constexpr size_t WS_WR = 16 * MiB;
constexpr size_t WS_WSGU = 17 * MiB;
constexpr size_t WS_MEMN = 18 * MiB;
constexpr size_t WS_KM = 22 * MiB;
constexpr size_t WS_VT = 26 * MiB;
constexpr size_t WS_WGU = 30 * MiB;
constexpr size_t WS_WD = 94 * MiB;
constexpr size_t WS_RA = 128 * MiB;
constexpr size_t WS_RB = 448 * MiB;
constexpr size_t WS_RC = 592 * MiB;
constexpr size_t WS_SSQ1 = 720 * MiB;
constexpr size_t WS_SSQ2 = 724 * MiB;
constexpr size_t WS_LOGIT = 728 * MiB;
constexpr size_t WS_TOKE = 744 * MiB;
constexpr size_t WS_TOKW = 745 * MiB;
constexpr size_t WS_TOKS = 746 * MiB;
constexpr size_t WS_ROWTOK = 747 * MiB;
constexpr size_t WS_X2F8 = 752 * MiB;
constexpr size_t WS_END = 816 * MiB;
constexpr int CW_CNT = 64;
constexpr int CW_NBLK = 128;
constexpr int CW_PSTART = 192;
constexpr int CW_BLKE = 256;
constexpr int CW_KMX = 1024;
constexpr int CW_SGUQ = 1344;
constexpr int CW_ALIST = 8192;
constexpr int CW_BAR = 4096;
constexpr int LDS_MISC = 131072;
constexpr int LDS_TBUF = 140288, TBUF_W = 2304;

__device__ __forceinline__ unsigned cvt_pk_bf16(float lo, float hi) { unsigned r; asm volatile("v_cvt_pk_bf16_f32 %0, %1, %2" : "=v"(r) : "v"(lo), "v"(hi)); return r; }
__device__ __forceinline__ float bf_lo(unsigned w) { return __uint_as_float(w << 16); }
__device__ __forceinline__ float bf_hi(unsigned w) { return __uint_as_float(w & 0xffff0000u); }
constexpr float F8_WSCALE = 256.f, F8_ASCALE = 8.f, F8_XSCALE = 4.f, F8_OSCALE = 16.f, F8_YSCALE = 16.f, F8_QSCALE = 64.f, F8_KSCALE = 16.f, F8_PSCALE = 256.f, F8_VSCALE = 16.f;
__device__ __forceinline__ unsigned pk4_fp8(float a, float b, float c, float d) {
    a = fminf(fmaxf(a, -448.f), 448.f); b = fminf(fmaxf(b, -448.f), 448.f); c = fminf(fmaxf(c, -448.f), 448.f); d = fminf(fmaxf(d, -448.f), 448.f);
    int w = 0; w = __builtin_amdgcn_cvt_pk_fp8_f32(a, b, w, false); w = __builtin_amdgcn_cvt_pk_fp8_f32(c, d, w, true); return (unsigned)w; }
__device__ __forceinline__ float wave_sum(float v) {
#pragma unroll
    for (int o = 1; o < 64; o <<= 1) v += __shfl_xor(v, o);
    return v;
}
__device__ __forceinline__ float wave_max(float v) {
#pragma unroll
    for (int o = 1; o < 64; o <<= 1) v = fmaxf(v, __shfl_xor(v, o));
    return v;
}
__device__ __forceinline__ int lane_id() { int l; asm volatile("v_mbcnt_lo_u32_b32 %0, -1, 0\n\tv_mbcnt_hi_u32_b32 %0, -1, %0" : "=v"(l)); return l; }
__device__ __forceinline__ unsigned ld_u32_agent(const unsigned* p) { return __hip_atomic_load(p, __ATOMIC_RELAXED, __HIP_MEMORY_SCOPE_AGENT); }

namespace pg8 {
constexpr int BM = 256, BK = 64, HALF = 128, HTB = HALF * BK * 2, STAGE_BYTES = 8 * HTB, NXCD = 8, WGM = 8;
__host__ __device__ __forceinline__ int lds_byte(int r, int c) { const int st = (r >> 4) * 2 + (c >> 5), rr = r & 15, cc = c & 31, ob = rr * 64 + cc * 2; return st * 1024 + (ob ^ (((ob >> 9) & 1) << 5)); }
__host__ __device__ __forceinline__ void stage_rc(int b, int& R, int& C) { const int st = b / 1024, sb = b % 1024, swz = sb ^ (((sb >> 9) & 1) << 5); R = (st >> 1) * 16 + swz / 64; C = (st & 1) * 32 + (swz % 64) / 2; }
__host__ __device__ __forceinline__ int perm32(int rho) { const int n = rho >> 4, i = rho & 15; return 8 * (i >> 2) + 4 * n + (i & 3); }

struct Unit { const char* A; const char* B; int pm, pn, aux; const int* rows; };
struct Gemm { int lda, ldb, K; };

struct TileOrder {
    int nM, nN, nwg, G, c;
    __device__ void init(int nM_, int nN_, int G_, int c_) { nM = nM_; nN = nN_; nwg = nM * nN; G = G_; c = c_; }
    __device__ bool get(int i, int& pm, int& pn) const {
        const long L = (long)i * G + c; if (L >= nwg) return false;
        int wgid = (int)L; { const int q = nwg / NXCD, r = nwg % NXCD, xcd = wgid % NXCD, off = wgid / NXCD; wgid = (xcd < r ? xcd * (q + 1) : r * (q + 1) + (xcd - r) * q) + off; }
        const int nig = WGM * nN, gid = wgid / nig, fm = gid * WGM, gsz = (nM - fm) < WGM ? (nM - fm) : WGM;
        pm = fm + ((wgid % nig) % gsz); pn = (wgid % nig) / gsz; return true;
    }
};

typedef float f32x2g __attribute__((ext_vector_type(2)));
__device__ __forceinline__ f32x2g gelu_pk(f32x2g v) {
    const f32x2g av = __builtin_elementwise_abs(v), d = av * 0.2316418882f + 1.0f;
    f32x2g t; t.x = __builtin_amdgcn_rcpf(d.x); t.y = __builtin_amdgcn_rcpf(d.y);
    f32x2g q = t * 0.5307027145f + (-0.7265760135f); q = q * t + 0.7107068705f; q = q * t + (-0.142248368f); q = q * t + 0.127414796f; q = q * t;
    const f32x2g s = (v * v) * (-0.72134752044f);
    f32x2g e; e.x = __builtin_amdgcn_exp2f(s.x); e.y = __builtin_amdgcn_exp2f(s.y);
    const f32x2g m = v * (q * e), r = v - m;
    f32x2g o; o.x = v.x < 0.f ? m.x : r.x; o.y = v.y < 0.f ? m.y : r.y; return o;
}

__device__ __forceinline__ const char* uniform_ptr(const char* p) { const unsigned long long v = (unsigned long long)p; const unsigned lo = __builtin_amdgcn_readfirstlane((unsigned)v), hi = __builtin_amdgcn_readfirstlane((unsigned)(v >> 32)); return (const char*)(((unsigned long long)hi << 32) | lo); }
template <class Epi, class Sched, bool GATHER = false, bool FP8 = false>
__device__ __forceinline__ void gemm_phase(LAS unsigned char* lds, int wid, const Gemm g, const Sched& S, const Epi& E) {
    const int lane = lane_id(), tid = wid * 64 + lane, wr = wid >> 2, wc = wid & 3, fr = lane & 15, fq = lane >> 4;
    const int nt = g.K / BK;
    unsigned voffB[2]; unsigned vA0[2], vA1[2]; int RA[2], CA[2];
#pragma unroll
    for (int i = 0; i < 2; ++i) { int R, C; stage_rc(tid * 16 + i * 8192, R, C); const int pr = Epi::PERM ? perm32(R & 31) : (R & 31);
        RA[i] = R; CA[i] = C; voffB[i] = (unsigned)((64 * (R >> 5) + pr) * g.ldb + C) * 2u;
        vA0[i] = (unsigned)(R * g.lda + C) * 2u; vA1[i] = vA0[i]; }
    const size_t kstep = (size_t)(BK * 2);
    const size_t hstepA = GATHER ? (size_t)0 : (size_t)HALF * g.lda * 2, hstepB = (size_t)32 * g.ldb * 2;
    LAS u32x4* park = (LAS u32x4*)(lds + 131072 + 1024) + tid;
#define PG8_GOFF(U, d0, d1) do { _Pragma("unroll") for (int _i = 0; _i < 2; ++_i) { \
        d0[_i] = ((unsigned)(U).rows[RA[_i]] * (unsigned)g.lda + (unsigned)CA[_i]) * 2u; d1[_i] = ((unsigned)(U).rows[HALF + RA[_i]] * (unsigned)g.lda + (unsigned)CA[_i]) * 2u; } } while (0)
    const unsigned ldsw = (unsigned)wid * 1024u;
    const int aoff = lds_byte(wr * 64 + fr, fq * 8), boff = lds_byte(wc * 32 + fr, fq * 8);
#define PG8_SA(b, h) (((b) * 2 + (h)) * HTB)
#define PG8_SB(b, h) ((4 + (b) * 2 + (h)) * HTB)
#define PG8_STAGE(bufoff, gbase, voff) do { _Pragma("unroll") for (int _i = 0; _i < 2; ++_i) \
        __builtin_amdgcn_global_load_lds((const unsigned*)((const char*)(gbase) + (voff)[_i]), (LAS unsigned*)(lds + (bufoff) + ldsw + _i * 8192), 16, 0, 0); } while (0)
#define PG8_LD8(dst_, addr_) do { const u32x4 lo_ = *(const LAS u32x4*)(addr_), hi_ = *(const LAS u32x4*)((addr_) + 1024); \
        dst_ = (v8i32){(int)lo_.x, (int)lo_.y, (int)lo_.z, (int)lo_.w, (int)hi_.x, (int)hi_.y, (int)hi_.z, (int)hi_.w}; } while (0)
#define PG8_LDA(dst, b, h) do { _Pragma("unroll") for (int m = 0; m < 4; ++m) PG8_LD8(dst[m], lds + PG8_SA(b, h) + aoff + m * 2048); } while (0)
#define PG8_LDB(dst, b, h) do { _Pragma("unroll") for (int n = 0; n < 2; ++n) PG8_LD8(dst[n], lds + PG8_SB(b, h) + boff + n * 2048); } while (0)
#define PG8_HALF(v_, k_) __builtin_bit_cast(bf16x8, __builtin_shufflevector(v_, v_, 4 * (k_) + 0, 4 * (k_) + 1, 4 * (k_) + 2, 4 * (k_) + 3))
#define PG8_MMA(ai, bj, At, Bt) do { __builtin_amdgcn_s_setprio(1); _Pragma("unroll") for (int m = 0; m < 4; ++m) _Pragma("unroll") for (int n = 0; n < 2; ++n) { \
        if constexpr (FP8) asm volatile("v_mfma_scale_f32_16x16x128_f8f6f4 %0, %1, %2, %0, %3, %3 op_sel_hi:[0,0,0]" : "+v"(acc[ai][bj][m][n]) : "v"(Bt[n]), "v"(At[m]), "v"(one8_));   \
        else { acc[ai][bj][m][n] = __builtin_amdgcn_mfma_f32_16x16x32_bf16(PG8_HALF(Bt[n], 0), PG8_HALF(At[m], 0), acc[ai][bj][m][n], 0, 0, 0); \
               acc[ai][bj][m][n] = __builtin_amdgcn_mfma_f32_16x16x32_bf16(PG8_HALF(Bt[n], 1), PG8_HALF(At[m], 1), acc[ai][bj][m][n], 0, 0, 0); } } \
        __builtin_amdgcn_s_setprio(0); } while (0)
#define PG8_WAIT_V(n) asm volatile("s_waitcnt vmcnt(" #n ")" ::: "memory")
#define PG8_WAIT_L(n) asm volatile("s_waitcnt lgkmcnt(" #n ")" ::: "memory")
#define PG8_BAR __builtin_amdgcn_s_barrier()
#define PG8_SCHED __builtin_amdgcn_sched_barrier(0)
    Unit cur, nxt; int ui = 0;
    if (!S.next(0, cur)) return;
    f32x4 acc[2][2][4][2];
#pragma unroll
    for (int a = 0; a < 2; ++a)
#pragma unroll
        for (int b = 0; b < 2; ++b)
#pragma unroll
            for (int m = 0; m < 4; ++m)
#pragma unroll
                for (int n = 0; n < 2; ++n) acc[a][b][m][n] = (f32x4){0.f, 0.f, 0.f, 0.f};
    v8i32 At[4], B0[2], B1[2];
    const int one8_ = 0x7f7f7f7f;
    const char* cA = uniform_ptr(cur.A); const char* cB = uniform_ptr(cur.B);
    if constexpr (GATHER) { PG8_GOFF(cur, vA0, vA1); }
    PG8_STAGE(PG8_SB(0, 0), cB, voffB); PG8_STAGE(PG8_SB(0, 1), cB + hstepB, voffB); PG8_STAGE(PG8_SA(0, 0), cA, vA0); PG8_STAGE(PG8_SA(0, 1), cA + hstepA, vA1);
    if (wr == 1) PG8_BAR;
    PG8_WAIT_V(2); PG8_BAR;
    PG8_STAGE(PG8_SB(1, 0), cB + kstep, voffB); PG8_STAGE(PG8_SA(1, 0), cA + kstep, vA0); PG8_STAGE(PG8_SB(1, 1), cB + hstepB + kstep, voffB);
    PG8_WAIT_V(6); PG8_BAR;
    for (;;) {
        const bool has_next = S.next(ui + 1, nxt);
        const char* nA = has_next ? uniform_ptr(nxt.A) : cA; const char* nB = has_next ? uniform_ptr(nxt.B) : cB;
        if constexpr (GATHER) { unsigned n0[2] = {vA0[0], vA0[1]}, n1[2] = {vA1[0], vA1[1]}; if (has_next) { PG8_GOFF(nxt, n0, n1); } *park = (u32x4){n0[0], n0[1], n1[0], n1[1]}; }
#pragma nounroll
        for (int t = 0; t < nt; t += 2) {
            const bool last = (t == nt - 2);
            const char* a1 = cA + (size_t)(t + 1) * kstep;
            const char* a2 = uniform_ptr(last ? nA : cA + (size_t)(t + 2) * kstep); const char* b2 = uniform_ptr(last ? nB : cB + (size_t)(t + 2) * kstep);
            const char* a3 = a2 + kstep; const char* b3 = b2 + kstep;
            unsigned w0[2] = {vA0[0], vA0[1]}, w1[2] = {vA1[0], vA1[1]};
            if constexpr (GATHER) { if (last) { const u32x4 pk = *park; w0[0] = pk.x; w0[1] = pk.y; w1[0] = pk.z; w1[1] = pk.w; } }
            PG8_LDB(B0, 0, 0); PG8_LDB(B1, 0, 1); PG8_SCHED; PG8_LDA(At, 0, 0); PG8_STAGE(PG8_SA(1, 1), a1 + hstepA, vA1);
            PG8_WAIT_V(8); PG8_WAIT_L(0); PG8_BAR; PG8_MMA(0, 0, At, B0); PG8_MMA(0, 1, At, B1); PG8_BAR; PG8_SCHED;
            PG8_LDA(At, 0, 1); PG8_STAGE(PG8_SB(0, 0), b2, voffB); PG8_STAGE(PG8_SB(0, 1), b2 + hstepB, voffB); PG8_STAGE(PG8_SA(0, 0), a2, w0);
            PG8_WAIT_V(8); PG8_WAIT_L(0); PG8_BAR; PG8_MMA(1, 0, At, B0); PG8_MMA(1, 1, At, B1); PG8_BAR; PG8_SCHED;
            PG8_LDB(B0, 1, 0); PG8_LDB(B1, 1, 1); PG8_SCHED; PG8_LDA(At, 1, 0); PG8_STAGE(PG8_SA(0, 1), a2 + hstepA, w1);
            PG8_WAIT_V(8); PG8_WAIT_L(0); PG8_BAR; PG8_MMA(0, 0, At, B0); PG8_MMA(0, 1, At, B1); PG8_BAR; PG8_SCHED;
            PG8_LDA(At, 1, 1); PG8_STAGE(PG8_SB(1, 0), b3, voffB); PG8_STAGE(PG8_SB(1, 1), b3 + hstepB, voffB); PG8_STAGE(PG8_SA(1, 0), a3, w0);
            PG8_WAIT_V(8); PG8_WAIT_L(0); PG8_BAR; PG8_MMA(1, 0, At, B0); PG8_MMA(1, 1, At, B1); PG8_BAR; PG8_SCHED;
        }
        if (wr == 0) PG8_BAR;
        if constexpr (FP8) asm volatile("s_nop 15\n\ts_nop 7" ::: "memory");
        asm volatile("" ::: "memory");
        { const int l2_ = lane_id(); E(acc, cur, wr, wc, l2_ & 15, l2_ >> 4, lds + LDS_TBUF + wid * TBUF_W); }
        if (!has_next) break;
#pragma unroll
        for (int a = 0; a < 2; ++a)
#pragma unroll
            for (int b = 0; b < 2; ++b)
#pragma unroll
                for (int m = 0; m < 4; ++m)
#pragma unroll
                    for (int n = 0; n < 2; ++n) acc[a][b][m][n] = (f32x4){0.f, 0.f, 0.f, 0.f};
        cur = nxt; cA = nA; cB = nB; ++ui;
        if constexpr (GATHER) { const u32x4 pk = *park; vA0[0] = pk.x; vA0[1] = pk.y; vA1[0] = pk.z; vA1[1] = pk.w; }
        if (wr == 1) PG8_BAR;
    }
    PG8_WAIT_V(0);
    PG8_BAR;
#undef PG8_GOFF
#undef PG8_SA
#undef PG8_SB
#undef PG8_STAGE
#undef PG8_LD8
#undef PG8_HALF
#undef PG8_LDA
#undef PG8_LDB
#undef PG8_MMA
#undef PG8_WAIT_V
#undef PG8_WAIT_L
#undef PG8_BAR
#undef PG8_SCHED
}

struct PlainSched {
    TileOrder to; const char* A; const char* B; size_t tA, tB;
    __device__ __forceinline__ bool next(int i, Unit& u) const { int pm, pn; if (!to.get(i, pm, pn)) return false; u.pm = pm; u.pn = pn; u.aux = 0; u.rows = nullptr; u.A = A + (size_t)pm * tA; u.B = B + (size_t)pn * tB; return true; }
};
struct OneUnitSched {
    Unit u0;
    __device__ __forceinline__ bool next(int i, Unit& u) const { if (i != 0) return false; u = u0; return true; }
};
struct MemAttnSched {
    TileOrder to; const char* A; const char* B; size_t tA, hA, bB, hB;
    __device__ __forceinline__ bool next(int i, Unit& u) const { int pm, pn; if (!to.get(i, pm, pn)) return false; u.pm = pm; u.pn = pn; u.aux = 0; u.rows = nullptr;
        u.A = A + (size_t)pm * tA + (size_t)pn * hA; const int b = pm >> 5; u.B = B + (size_t)b * bB + (size_t)pn * hB; return true; }
};
struct MoeSched {
    int G, c, nblk; const unsigned* blk_e; const char* A; const char* B; size_t tA, eB, tB; const int* row_tok;
    __device__ __forceinline__ bool next(int i, Unit& u) const { const int L = i * G + c; if (L >= nblk * 4) return false; const int rb = L >> 2, pn = L & 3;
        const int e = (int)__builtin_amdgcn_readfirstlane(ld_u32_agent(blk_e + rb)); u.pm = rb; u.pn = pn; u.aux = e; u.rows = row_tok + (size_t)rb * 256;
        u.A = A + (size_t)rb * tA; u.B = B + (size_t)e * eB + (size_t)pn * tB; return true; }
};

#define EPI_ARGS f32x4 (&acc)[2][2][4][2], const Unit& u, int wr, int wc, int fr, int fq, LAS unsigned char* tb
__device__ __forceinline__ void st128(bf16_t* rowbase, size_t ldc, const u32x4 w0, const u32x4 w1, int fr, int fq, LAS unsigned char* tb) {
    *(LAS u32x4*)(tb + fr * 144 + fq * 16) = w0; *(LAS u32x4*)(tb + fr * 144 + 64 + fq * 16) = w1;
    const int L = fq * 16 + fr, r = L >> 3, c = L & 7;
    const u32x4 a = *(const LAS u32x4*)(tb + r * 144 + c * 16), b = *(const LAS u32x4*)(tb + (8 + r) * 144 + c * 16);
    *(u32x4*)(rowbase + (size_t)r * ldc + c * 8) = a; *(u32x4*)(rowbase + (size_t)(8 + r) * ldc + c * 8) = b;
}
__device__ __forceinline__ u32x4 pk8(const f32x4 v0, const f32x4 v1) { u32x4 w; w.x = cvt_pk_bf16(v0[0], v0[1]); w.y = cvt_pk_bf16(v0[2], v0[3]); w.z = cvt_pk_bf16(v1[0], v1[1]); w.w = cvt_pk_bf16(v1[2], v1[3]); return w; }
struct EpiZ {
    static constexpr bool PERM = true;
    bf16_t* O; unsigned* kmx;
    __device__ __forceinline__ void operator()(EPI_ARGS) const {
        const int mode = u.pn < 4 ? 1 : (u.pn < 6 ? 2 : 0);
        if (u.pn == 6 || u.pn == 7) {
#pragma unroll
            for (int bj = 0; bj < 2; ++bj) { float mx = 0.f;
#pragma unroll
                for (int ai = 0; ai < 2; ++ai)
#pragma unroll
                    for (int m = 0; m < 4; ++m) { const f32x4 a = acc[ai][bj][m][0], b = acc[ai][bj][m][1];
                        float q = (a[0] * a[0] + a[1] * a[1]) + (a[2] * a[2] + a[3] * a[3]) + (b[0] * b[0] + b[1] * b[1]) + (b[2] * b[2] + b[3] * b[3]);
                        q += __shfl_xor(q, 16); q += __shfl_xor(q, 32); mx = fmaxf(mx, q); }
#pragma unroll
                for (int o_ = 1; o_ < 16; o_ <<= 1) mx = fmaxf(mx, __shfl_xor(mx, o_));
                if (fr == 0 && fq == 0) { const int b_ = u.pm >> 5, h_ = (u.pn - 6) * 2 + (wc >> 1); atomicMax(kmx + (((b_ * 4 + h_) * 2 + (wc & 1)) * 2 + bj), __float_as_uint(mx)); } }
        }
#pragma unroll
        for (int ai = 0; ai < 2; ++ai)
#pragma unroll
            for (int m = 0; m < 4; ++m) { u32x4 w[2];
#pragma unroll
                for (int bj = 0; bj < 2; ++bj) { f32x4 v0 = acc[ai][bj][m][0], v1 = acc[ai][bj][m][1];
                    if (mode == 1) { f32x2g a = gelu_pk((f32x2g){v0[0], v0[1]}), b = gelu_pk((f32x2g){v0[2], v0[3]}), c = gelu_pk((f32x2g){v1[0], v1[1]}), d = gelu_pk((f32x2g){v1[2], v1[3]});
                        v0 = (f32x4){a.x, a.y, b.x, b.y}; v1 = (f32x4){c.x, c.y, d.x, d.y}; }
                    else if (mode == 2) { v0 = v0 * C2_DIFF; v1 = v1 * C2_DIFF; }
                    w[bj] = pk8(v0, v1); }
                st128(O + (size_t)(u.pm * BM + ai * HALF + wr * 64 + m * 16) * ZP + u.pn * BM + wc * 64, ZP, w[0], w[1], fr, fq, tb); }
    }
};
struct EpiBf16 {
    static constexpr bool PERM = true;
    bf16_t* O; int ldc; const float* ssq; float cscale;
    __device__ __forceinline__ void operator()(EPI_ARGS) const {
        float sc[2][4];
#pragma unroll
        for (int ai = 0; ai < 2; ++ai)
#pragma unroll
            for (int m = 0; m < 4; ++m) sc[ai][m] = cscale;
        if (ssq) {
#pragma unroll
            for (int ai = 0; ai < 2; ++ai)
#pragma unroll
                for (int m = 0; m < 4; ++m) { const f32x4 s4 = *(const f32x4*)(ssq + (size_t)(u.pm * BM + ai * HALF + wr * 64 + m * 16 + fr) * 4);
                    sc[ai][m] = cscale * __builtin_amdgcn_rsqf(((s4[0] + s4[1]) + (s4[2] + s4[3])) * (1.0f / DM) + RMS_EPS); }
        }
#pragma unroll
        for (int ai = 0; ai < 2; ++ai)
#pragma unroll
            for (int m = 0; m < 4; ++m) { const int rowg = u.pm * BM + ai * HALF + wr * 64 + m * 16; const float c = sc[ai][m];
                st128(O + (size_t)rowg * ldc + u.pn * BM + wc * 64, (size_t)ldc, pk8(acc[ai][0][m][0] * c, acc[ai][0][m][1] * c), pk8(acc[ai][1][m][0] * c, acc[ai][1][m][1] * c), fr, fq, tb); }
    }
};
struct EpiF8 {
    static constexpr bool PERM = true;
    unsigned char* O; int ldc; const float* ssq; float cscale;
    __device__ __forceinline__ void operator()(EPI_ARGS) const {
        const int L = fq * 16 + fr;
        float sc[2][4];
#pragma unroll
        for (int ai = 0; ai < 2; ++ai)
#pragma unroll
            for (int m = 0; m < 4; ++m) sc[ai][m] = cscale;
        if (ssq) {
#pragma unroll
            for (int ai = 0; ai < 2; ++ai)
#pragma unroll
                for (int m = 0; m < 4; ++m) { const f32x4 s4 = *(const f32x4*)(ssq + (size_t)(u.pm * BM + ai * HALF + wr * 64 + m * 16 + fr) * 4);
                    sc[ai][m] = cscale * __builtin_amdgcn_rsqf(((s4[0] + s4[1]) + (s4[2] + s4[3])) * (1.0f / DM) + RMS_EPS); }
        }
#pragma unroll
        for (int ai = 0; ai < 2; ++ai)
#pragma unroll
            for (int m = 0; m < 4; ++m) { const int rowg = u.pm * BM + ai * HALF + wr * 64 + m * 16; const float c = sc[ai][m];
#pragma unroll
                for (int bj = 0; bj < 2; ++bj) { const f32x4 a = acc[ai][bj][m][0] * c, b = acc[ai][bj][m][1] * c; u32x2 f; f.x = pk4_fp8(a[0], a[1], a[2], a[3]); f.y = pk4_fp8(b[0], b[1], b[2], b[3]);
                    *(LAS u32x2*)(tb + fr * 144 + bj * 32 + fq * 8) = f; }
                const u32x4 v8 = *(const LAS u32x4*)(tb + (L >> 2) * 144 + (L & 3) * 16);
                *(u32x4*)(O + (size_t)(rowg + (L >> 2)) * ldc + u.pn * BM + wc * 64 + (L & 3) * 16) = v8; }
    }
};
struct EpiSoftmax {
    static constexpr bool PERM = true;
    unsigned char* O; LAS float* xch; float sscale;
    __device__ __forceinline__ void operator()(EPI_ARGS) const {
        LAS float* xm = xch; LAS float* xs = xch + 1024;
#pragma unroll
        for (int ai = 0; ai < 2; ++ai)
#pragma unroll
            for (int bj = 0; bj < 2; ++bj)
#pragma unroll
                for (int m = 0; m < 4; ++m)
#pragma unroll
                    for (int n = 0; n < 2; ++n) acc[ai][bj][m][n] = acc[ai][bj][m][n] * sscale;
#pragma unroll
        for (int ai = 0; ai < 2; ++ai)
#pragma unroll
            for (int m = 0; m < 4; ++m) { float v = -__builtin_inff();
#pragma unroll
                for (int bj = 0; bj < 2; ++bj)
#pragma unroll
                    for (int n = 0; n < 2; ++n) { const f32x4 a = acc[ai][bj][m][n]; v = fmaxf(v, fmaxf(fmaxf(a[0], a[1]), fmaxf(a[2], a[3]))); }
                v = fmaxf(v, __shfl_xor(v, 16)); v = fmaxf(v, __shfl_xor(v, 32));
                if (fq == 0) xm[(ai * HALF + wr * 64 + m * 16 + fr) * 4 + wc] = v; }
        asm volatile("s_waitcnt lgkmcnt(0)" ::: "memory"); __builtin_amdgcn_s_barrier(); asm volatile("" ::: "memory");
#pragma unroll
        for (int ai = 0; ai < 2; ++ai)
#pragma unroll
            for (int m = 0; m < 4; ++m) { const f32x4 t = *(const LAS f32x4*)(xm + (ai * HALF + wr * 64 + m * 16 + fr) * 4); const float mx = fmaxf(fmaxf(t[0], t[1]), fmaxf(t[2], t[3])); float sm = 0.f;
#pragma unroll
                for (int bj = 0; bj < 2; ++bj)
#pragma unroll
                    for (int n = 0; n < 2; ++n) { f32x4 a = acc[ai][bj][m][n];
#pragma unroll
                        for (int j = 0; j < 4; ++j) { a[j] = __builtin_amdgcn_exp2f(a[j] - mx); sm += a[j]; }
                        acc[ai][bj][m][n] = a; }
                sm += __shfl_xor(sm, 16); sm += __shfl_xor(sm, 32);
                if (fq == 0) xs[(ai * HALF + wr * 64 + m * 16 + fr) * 4 + wc] = sm; }
        asm volatile("s_waitcnt lgkmcnt(0)" ::: "memory"); __builtin_amdgcn_s_barrier(); asm volatile("" ::: "memory");
#pragma unroll
        for (int ai = 0; ai < 2; ++ai)
#pragma unroll
            for (int m = 0; m < 4; ++m) { const f32x4 t = *(const LAS f32x4*)(xs + (ai * HALF + wr * 64 + m * 16 + fr) * 4); const float inv = F8_PSCALE * __builtin_amdgcn_rcpf((t[0] + t[1]) + (t[2] + t[3]));
                const int rowg = u.pm * BM + ai * HALF + wr * 64 + m * 16, L = fq * 16 + fr;
#pragma unroll
                for (int bj = 0; bj < 2; ++bj) { const f32x4 a = acc[ai][bj][m][0] * inv, b = acc[ai][bj][m][1] * inv; u32x2 f; f.x = pk4_fp8(a[0], a[1], a[2], a[3]); f.y = pk4_fp8(b[0], b[1], b[2], b[3]);
                    *(LAS u32x2*)(tb + fr * 144 + bj * 32 + fq * 8) = f; }
                const u32x4 v8 = *(const LAS u32x4*)(tb + (L >> 2) * 144 + (L & 3) * 16);
                *(u32x4*)(O + (size_t)(rowg + (L >> 2)) * DM + u.pn * BM + wc * 64 + (L & 3) * 16) = v8; }
    }
};
template <bool BF>
struct EpiResid {
    static constexpr bool PERM = true;
    const void* base; bf16_t* ob; float* ssq; LAS float* xs; unsigned char* o8; float as;
    __device__ __forceinline__ void operator()(EPI_ARGS) const {
        const int col0 = u.pn * BM + wc * 64 + 8 * fq;
        if constexpr (BF) {
            u32x4 br[2][4][2];
#pragma unroll
            for (int ai = 0; ai < 2; ++ai)
#pragma unroll
                for (int m = 0; m < 4; ++m)
#pragma unroll
                    for (int bj = 0; bj < 2; ++bj) br[ai][m][bj] = *(const u32x4*)((const bf16_t*)base + (size_t)(u.pm * BM + ai * HALF + wr * 64 + m * 16 + fr) * DM + col0 + bj * 32);
#pragma unroll
            for (int ai = 0; ai < 2; ++ai)
#pragma unroll
                for (int m = 0; m < 4; ++m) asm volatile("" : "+v"(br[ai][m][0]), "+v"(br[ai][m][1]));
#pragma unroll
            for (int ai = 0; ai < 2; ++ai)
#pragma unroll
                for (int m = 0; m < 4; ++m) { const int rowg = u.pm * BM + ai * HALF + wr * 64 + m * 16, row = rowg + fr; float s = 0.f; u32x4 w[2]; u32x2 f8[2];
#pragma unroll
                    for (int bj = 0; bj < 2; ++bj) { const u32x4 r = br[ai][m][bj];
                        const f32x4 o0 = (f32x4){bf_lo(r.x), bf_hi(r.x), bf_lo(r.y), bf_hi(r.y)} + acc[ai][bj][m][0] * as, o1 = (f32x4){bf_lo(r.z), bf_hi(r.z), bf_lo(r.w), bf_hi(r.w)} + acc[ai][bj][m][1] * as;
                        s += (o0[0] * o0[0] + o0[1] * o0[1]) + (o0[2] * o0[2] + o0[3] * o0[3]) + (o1[0] * o1[0] + o1[1] * o1[1]) + (o1[2] * o1[2] + o1[3] * o1[3]);
                        w[bj] = pk8(o0, o1);
                        f8[bj].x = pk4_fp8(o0[0] * F8_XSCALE, o0[1] * F8_XSCALE, o0[2] * F8_XSCALE, o0[3] * F8_XSCALE); f8[bj].y = pk4_fp8(o1[0] * F8_XSCALE, o1[1] * F8_XSCALE, o1[2] * F8_XSCALE, o1[3] * F8_XSCALE); }
                    st128(ob + (size_t)rowg * DM + u.pn * BM + wc * 64, (size_t)DM, w[0], w[1], fr, fq, tb);
                    if (o8) {
                        *(LAS u32x2*)(tb + fr * 144 + fq * 8) = f8[0]; *(LAS u32x2*)(tb + fr * 144 + 32 + fq * 8) = f8[1];
                        const int L = fq * 16 + fr; const u32x4 v8 = *(const LAS u32x4*)(tb + (L >> 2) * 144 + (L & 3) * 16);
                        *(u32x4*)(o8 + (size_t)(rowg + (L >> 2)) * DM + u.pn * BM + wc * 64 + (L & 3) * 16) = v8; }
                    s += __shfl_xor(s, 16); s += __shfl_xor(s, 32);
                    if (fq == 0) xs[(ai * HALF + wr * 64 + m * 16 + fr) * 4 + wc] = s; }
        } else {
#pragma unroll
            for (int ai = 0; ai < 2; ++ai) {
                f32x4 br[4][2][2];
#pragma unroll
                for (int m = 0; m < 4; ++m)
#pragma unroll
                    for (int bj = 0; bj < 2; ++bj) { const float* p = (const float*)base + (size_t)(u.pm * BM + ai * HALF + wr * 64 + m * 16 + fr) * DM + col0 + bj * 32; br[m][bj][0] = *(const f32x4*)p; br[m][bj][1] = *(const f32x4*)(p + 4); }
#pragma unroll
                for (int m = 0; m < 4; ++m) asm volatile("" : "+v"(br[m][0][0]), "+v"(br[m][0][1]), "+v"(br[m][1][0]), "+v"(br[m][1][1]));
#pragma unroll
                for (int m = 0; m < 4; ++m) { const int rowg = u.pm * BM + ai * HALF + wr * 64 + m * 16; float s = 0.f; u32x4 w[2]; u32x2 f8[2];
#pragma unroll
                    for (int bj = 0; bj < 2; ++bj) { const f32x4 o0 = br[m][bj][0] + acc[ai][bj][m][0] * as, o1 = br[m][bj][1] + acc[ai][bj][m][1] * as;
                        s += (o0[0] * o0[0] + o0[1] * o0[1]) + (o0[2] * o0[2] + o0[3] * o0[3]) + (o1[0] * o1[0] + o1[1] * o1[1]) + (o1[2] * o1[2] + o1[3] * o1[3]);
                        w[bj] = pk8(o0, o1);
                        f8[bj].x = pk4_fp8(o0[0] * F8_XSCALE, o0[1] * F8_XSCALE, o0[2] * F8_XSCALE, o0[3] * F8_XSCALE); f8[bj].y = pk4_fp8(o1[0] * F8_XSCALE, o1[1] * F8_XSCALE, o1[2] * F8_XSCALE, o1[3] * F8_XSCALE); }
                    st128(ob + (size_t)rowg * DM + u.pn * BM + wc * 64, (size_t)DM, w[0], w[1], fr, fq, tb);
                    if (o8) {
                        *(LAS u32x2*)(tb + fr * 144 + fq * 8) = f8[0]; *(LAS u32x2*)(tb + fr * 144 + 32 + fq * 8) = f8[1];
                        const int L = fq * 16 + fr; const u32x4 v8 = *(const LAS u32x4*)(tb + (L >> 2) * 144 + (L & 3) * 16);
                        *(u32x4*)(o8 + (size_t)(rowg + (L >> 2)) * DM + u.pn * BM + wc * 64 + (L & 3) * 16) = v8; }
                    s += __shfl_xor(s, 16); s += __shfl_xor(s, 32);
                    if (fq == 0) xs[(ai * HALF + wr * 64 + m * 16 + fr) * 4 + wc] = s; }
            }
        }
        asm volatile("s_waitcnt lgkmcnt(0)" ::: "memory"); __builtin_amdgcn_s_barrier(); asm volatile("" ::: "memory");
        { const int t_ = (wr * 4 + wc) * 64 + fq * 16 + fr;
          if (t_ < 256) { const f32x4 p = *(const LAS f32x4*)(xs + t_ * 4); ssq[(size_t)(u.pm * BM + t_) * 4 + u.pn] = (p[0] + p[1]) + (p[2] + p[3]); } }
    }
};
struct EpiRouter {
    static constexpr bool PERM = false;
    float* L; const float* ssq; const float* bg; const float* be; float* rstd_out;
    __device__ __forceinline__ void operator()(EPI_ARGS) const {
        if (wc != 0) return;
        const int row0 = u.pm * BM + wr * 64 + fr;
        float rsv[2][4];
#pragma unroll
        for (int ai = 0; ai < 2; ++ai)
#pragma unroll
            for (int m = 0; m < 4; ++m) { const f32x4 s4 = *(const f32x4*)(ssq + (size_t)(row0 + ai * HALF + m * 16) * 4);
                rsv[ai][m] = __builtin_amdgcn_rsqf(((s4[0] + s4[1]) + (s4[2] + s4[3])) * (1.0f / DM) + RMS_EPS); }
#pragma unroll
        for (int ai = 0; ai < 2; ++ai)
#pragma unroll
            for (int m = 0; m < 4; ++m) { const int row = row0 + ai * HALF + m * 16; const float rs = rsv[ai][m];
                if (fq == 0) rstd_out[row] = rs;
#pragma unroll
                for (int bj = 0; bj < 2; ++bj)
#pragma unroll
                    for (int n = 0; n < 2; ++n) { const int c0 = bj * 32 + n * 16 + 4 * fq; f32x4 o = acc[ai][bj][m][n] * rs;
#pragma unroll
                        for (int j = 0; j < 4; ++j) { const int c = c0 + j; const float b = c < 4 ? bg[c] : (c < 36 ? be[c - 4] : 0.f); o[j] += b; }
                        *(f32x4*)(L + (size_t)row * 64 + c0) = o; } }
    }
};
struct EpiGateUp {
    static constexpr bool PERM = true;
    unsigned char* act; const float* rstd; const int* row_tok;
    __device__ __forceinline__ void operator()(EPI_ARGS) const {
        const int row0 = u.pm * BM + wr * 64 + fr, col0 = u.pn * 128 + wc * 32 + 8 * fq;
        float rsv[2][4];
#pragma unroll
        for (int ai = 0; ai < 2; ++ai)
#pragma unroll
            for (int m = 0; m < 4; ++m) rsv[ai][m] = rstd[row0 + ai * HALF + m * 16];
#pragma unroll
        for (int ai = 0; ai < 2; ++ai)
#pragma unroll
            for (int m = 0; m < 4; ++m) { const int row = row0 + ai * HALF + m * 16; const float rs = rsv[ai][m];
                float r[8];
#pragma unroll
                for (int n = 0; n < 2; ++n)
#pragma unroll
                    for (int j = 0; j < 4; ++j) { const float gg = acc[ai][0][m][n][j] * rs, uu = acc[ai][1][m][n][j] * rs;
                        r[n * 4 + j] = gg * __builtin_amdgcn_rcpf(1.0f + __builtin_amdgcn_exp2f(-gg * LOG2E)) * uu; }
                u32x2 w; w.x = pk4_fp8(r[0] * F8_ASCALE, r[1] * F8_ASCALE, r[2] * F8_ASCALE, r[3] * F8_ASCALE); w.y = pk4_fp8(r[4] * F8_ASCALE, r[5] * F8_ASCALE, r[6] * F8_ASCALE, r[7] * F8_ASCALE);
                *(u32x2*)(act + (size_t)row * DEXP + col0) = w; }
    }
};
}

namespace da {
constexpr int NW = 8, QBLK = 32, KVBLK = 64, QB = NW * QBLK, DV = 128;
constexpr int SHM_V = KVBLK * DV * 2, SHM_K = KVBLK * 64 * 2;
constexpr int LDS_V = 0, LDS_K = 2 * SHM_V, LDS_WS = LDS_K + 2 * SHM_K, LDS_CX = LDS_WS + NW * 64 * 4, LDS_STASH = LDS_CX + 256, LDS_BYTES = LDS_STASH + NW * 8192;
constexpr float SKIP_MARGIN = 40.f;
constexpr float THR = 8.f;
#define SBAR() __builtin_amdgcn_sched_barrier(0)
__device__ __forceinline__ int kswz(int row, int chunk) { return row * 128 + ((chunk ^ ((row >> 1) & 7)) << 4); }
__device__ __forceinline__ int v_st(int k, int c) { const int kk = (k & ~0xC) | ((k & 4) << 1) | ((k & 8) >> 1); return ((kk >> 3) * 4 + (c >> 5)) * 512 + ((kk & 7) * 32 + (c & 31)) * 2; }
__device__ __forceinline__ int v_rd_base(int lane) { return ((lane & 3) << 3) | (((lane >> 2) & 3) << 6) | (((lane >> 4) & 1) << 5) | (((lane >> 5) & 1) << 8); }
constexpr int v_rd_off(int d0, int ks, int half) { return d0 * 512 + ks * 4096 + half * 2048; }
__device__ __forceinline__ int crow(int r, int hi) { return (r & 3) + 8 * (r >> 2) + 4 * hi; }
__device__ __forceinline__ bf16x8 load8(const bf16_t* p) { return *reinterpret_cast<const bf16x8*>(p); }

__device__ __forceinline__ void mask_tile(f32x16& p0, f32x16& p1, int dq) {
    const float NEG = -__builtin_inff();
#pragma unroll
    for (int r = 0; r < 16; ++r) { const int c = (r & 3) + 8 * (r >> 2); if (dq - c < 0) p0[r] = NEG; if (dq - c - 32 < 0) p1[r] = NEG; }
}
__device__ __forceinline__ void partialSM(f32x16& p0, f32x16& p1, float& m_reg, float& alpha, float l_reg) {
    float pmax = p0[0];
#pragma unroll
    for (int r = 1; r < 16; ++r) pmax = fmaxf(pmax, p0[r]);
#pragma unroll
    for (int r = 0; r < 16; ++r) pmax = fmaxf(pmax, p1[r]);
    { auto rr = __builtin_amdgcn_permlane32_swap(__float_as_uint(pmax), __float_as_uint(pmax), false, false); pmax = fmaxf(__uint_as_float(rr[0]), __uint_as_float(rr[1])); }
    const bool need = (pmax > THR) || (l_reg == 0.f && pmax > -__builtin_inff());
    if (__builtin_expect(__all(!need), 1)) { alpha = 1.f; }
    else { const float d = need ? pmax : 0.f; alpha = (l_reg == 0.f) ? 1.f : __builtin_amdgcn_exp2f(-d); m_reg += d;
#pragma unroll
        for (int r = 0; r < 16; ++r) p0[r] = p0[r] - d;
#pragma unroll
        for (int r = 0; r < 16; ++r) p1[r] = p1[r] - d; }
#pragma unroll
    for (int r = 0; r < 16; ++r) p0[r] = __builtin_amdgcn_exp2f(p0[r]);
}
__device__ __forceinline__ void finishSM(f32x16& p0, f32x16& p1, float alpha, float& l_reg, bf16x8& pa0, bf16x8& pa1, bf16x8& pa2, bf16x8& pa3) {
#pragma unroll
    for (int r = 0; r < 16; ++r) p1[r] = __builtin_amdgcn_exp2f(p1[r]);
    float ps = 0;
#pragma unroll
    for (int r = 0; r < 16; ++r) ps += p0[r];
#pragma unroll
    for (int r = 0; r < 16; ++r) ps += p1[r];
    { auto rr = __builtin_amdgcn_permlane32_swap(__float_as_uint(ps), __float_as_uint(ps), false, false); ps = __uint_as_float(rr[0]) + __uint_as_float(rr[1]); }
    l_reg = l_reg * alpha + ps;
#define PK4(P, B_, OUT) do { unsigned a0 = cvt_pk_bf16(P[B_+0], P[B_+1]), a1 = cvt_pk_bf16(P[B_+2], P[B_+3]);                          \
        unsigned b0 = cvt_pk_bf16(P[B_+4], P[B_+5]), b1 = cvt_pk_bf16(P[B_+6], P[B_+7]);                                             \
        auto r0 = __builtin_amdgcn_permlane32_swap(a0, b0, false, false); auto r1 = __builtin_amdgcn_permlane32_swap(a1, b1, false, false); \
        u32x4 w = {r0[0], r1[0], r0[1], r1[1]}; OUT = *reinterpret_cast<bf16x8*>(&w); } while (0)
    PK4(p0, 0, pa0); PK4(p0, 8, pa1); PK4(p1, 0, pa2); PK4(p1, 8, pa3);
#undef PK4
}
template <int KB>
__device__ __forceinline__ void qkt(f32x16& p0, f32x16& p1, const char* K_lds, int r32, int hi, const bf16x8* qr, float ab, float slope2) {
    const float s32 = 32.f * slope2;
#pragma unroll
    for (int r = 0; r < 16; ++r) { p0[r] = fmaf(slope2, (float)((r & 3) + 8 * (r >> 2)), ab); p1[r] = p0[r] + s32; }
#pragma unroll
    for (int d0 = 0; d0 < 4; ++d0) { const char* a = K_lds + KB * SHM_K + kswz(r32, d0 * 2 + hi);
        bf16x8 b0 = *reinterpret_cast<const bf16x8*>(a);
        bf16x8 b1 = *reinterpret_cast<const bf16x8*>(a + 32 * 128);
        p0 = __builtin_amdgcn_mfma_f32_32x32x16_bf16(b0, qr[d0], p0, 0, 0, 0);
        p1 = __builtin_amdgcn_mfma_f32_32x32x16_bf16(b1, qr[d0], p1, 0, 0, 0); }
}
template <int VB>
__device__ __forceinline__ void pv_tile(f32x16* o, int vb0, bf16x8 pa0, bf16x8 pa1, bf16x8 pa2, bf16x8 pa3) {
#define TRRD(dst, off) asm volatile("ds_read_b64_tr_b16 %0, %1 offset:%2" : "=&v"(dst) : "v"(vb0), "i"(off) : "memory")
#define PV_D0(d0) do { s16x4 l0, l1, l2, l3, h0, h1, h2, h3; constexpr int b_ = VB * SHM_V + v_rd_off(d0, 0, 0); \
        TRRD(l0, b_); TRRD(h0, b_ + 2048); TRRD(l1, b_ + 4096); TRRD(h1, b_ + 6144); TRRD(l2, b_ + 8192); TRRD(h2, b_ + 10240); TRRD(l3, b_ + 12288); TRRD(h3, b_ + 14336); \
        asm volatile("s_waitcnt lgkmcnt(0)" ::: "memory"); SBAR();   \
        o[d0] = __builtin_amdgcn_mfma_f32_32x32x16_bf16(pa0, (bf16x8){l0[0], l0[1], l0[2], l0[3], h0[0], h0[1], h0[2], h0[3]}, o[d0], 0, 0, 0);   \
        o[d0] = __builtin_amdgcn_mfma_f32_32x32x16_bf16(pa1, (bf16x8){l1[0], l1[1], l1[2], l1[3], h1[0], h1[1], h1[2], h1[3]}, o[d0], 0, 0, 0);   \
        o[d0] = __builtin_amdgcn_mfma_f32_32x32x16_bf16(pa2, (bf16x8){l2[0], l2[1], l2[2], l2[3], h2[0], h2[1], h2[2], h2[3]}, o[d0], 0, 0, 0);   \
        o[d0] = __builtin_amdgcn_mfma_f32_32x32x16_bf16(pa3, (bf16x8){l3[0], l3[1], l3[2], l3[3], h3[0], h3[1], h3[2], h3[3]}, o[d0], 0, 0, 0); } while (0)
    PV_D0(0); PV_D0(1); PV_D0(2); PV_D0(3);
#undef PV_D0
#undef TRRD
}

struct BlockRef { const bf16_t* Q; const bf16_t* K; const bf16_t* V; bf16_t* O; int P0; int mode; float slope2; float kmax; };
struct Seam { bf16x8 qr[4]; bf16x8 st_v0, st_v1, st_k0; };
__device__ __forceinline__ BlockRef mkref(const bf16_t* Z, bf16_t* AO, const float* kmt  , int b, int combo, int mp) { BlockRef r; const int h = combo >> 5, qb = combo & 31;
    const bf16_t* zb = Z + (size_t)b * SEQ * ZP; r.Q = zb + (size_t)(qb * 256) * ZP + ZQ + h * 128 + mp * 64; r.K = zb + ZK + h * 128 + mp * 64; r.V = zb + ZVAL + h * 128;
    r.O = AO + ((size_t)b * SEQ + qb * 256) * DM + 512 + h * 128; r.P0 = qb * 256; r.mode = mp; r.slope2 = exp2f(-2.0f * (float)(h + 1)) * LOG2E;
    r.kmax = kmt[h * 2 + mp]; return r; }
#define ROWV(p, k0, rr) ((p) + (size_t)((k0) + (rr)) * ZP + sc)
#define ROWK(p, k0) ((p) + (size_t)((k0) + skr) * ZP + skc * 8)
#define VMW() asm volatile("s_waitcnt vmcnt(0)" ::: "memory")
#define VMWN(n) asm volatile("s_waitcnt vmcnt(%0)" :: "i"(n) : "memory")
#define SLOAD_H(Kp, Vp, k0) do { S.st_v0 = load8(ROWV(Vp, k0, sr)); S.st_v1 = load8(ROWV(Vp, k0, 32 + sr)); S.st_k0 = load8(ROWK(Kp, k0)); } while (0)
#define SWRITE_HK(bf) do { *(bf16x8*)(K_lds + (bf) * SHM_K + kws) = S.st_k0; } while (0)
#define SWRITE_HV(bf) do { *(bf16x8*)(V_lds + (bf) * SHM_V + vst0) = S.st_v0; *(bf16x8*)(V_lds + (bf) * SHM_V + vst1) = S.st_v1; } while (0)
#define SWRITE_H(bf) do { SWRITE_HV(bf); SWRITE_HK(bf); } while (0)
__device__ __forceinline__ void prime(const BlockRef& cur, char* lds, Seam& S, int wid) {
    const int lane = lane_id(), tid = wid * 64 + lane, r32 = lane & 31, hi = lane >> 5;
    const int sr = tid >> 4, sc = (tid & 15) * 8, skr = tid >> 3, skc = tid & 7, kws = kswz(skr, skc); char* K_lds = lds + LDS_K;
#pragma unroll
    for (int d0 = 0; d0 < 4; ++d0) S.qr[d0] = load8(cur.Q + (size_t)(wid * QBLK + r32) * ZP + d0 * 16 + hi * 8);
    SLOAD_H(cur.K, cur.V, cur.P0 + QB - KVBLK); VMW(); SWRITE_HK(0);
    __syncthreads();
}
__device__ __forceinline__ void block(const BlockRef& cur, const BlockRef& nxt, char* lds, Seam& S, float lam, const float* __restrict__ subln, int wid) {
    const int lane = lane_id(), tid = wid * 64 + lane, r32 = lane & 31, hi = lane >> 5;
    const int NT0 = (cur.P0 + QB) / KVBLK;
    int NT = NT0;
    const int qlo = cur.P0 + wid * QBLK, qm = qlo + r32 - 4 * hi;
    const float slope2 = cur.slope2;
    char* V_lds = lds + LDS_V; char* K_lds = lds + LDS_K;
    float* ws = (float*)(lds + LDS_WS) + wid * 64; float* li_l = ws, * al_l = ws + 32;
    float m_reg = 0.f, l_reg = 0; f32x16 o[4] = {};
    const int sr = tid >> 4, sc = (tid & 15) * 8, vst0 = v_st(sr, sc), vst1 = v_st(32 + sr, sc), skr = tid >> 3, skc = tid & 7, kws = kswz(skr, skc);
    const int vb0 = (int)(uintptr_t)V_lds + v_rd_base(lane);
    const bf16_t* Kh = cur.K; const bf16_t* Vh = cur.V;
#define RESC(a) do { if (__any((a) < 1.f)) { if (hi == 0) al_l[r32] = (a); asm volatile("s_waitcnt lgkmcnt(0)" ::: "memory");              \
                     for (int d_ = 0; d_ < 4; ++d_) for (int r = 0; r < 16; ++r) o[d_][r] *= al_l[crow(r, hi)]; } } while (0)
#define KBASE(t) ((NT0 - 1 - (t)) * KVBLK)
#define AB(t) (slope2 * (float)(KBASE(t) - qm) - m_reg)
#define MASKT(P0_, P1_, t) do { const int kb_ = KBASE(t); if (kb_ + KVBLK - 1 > qlo) mask_tile(P0_, P1_, qm - kb_); } while (0)
    constexpr int NQL = 4;
#define SEAM_K0() do { VMWN(NQL); SWRITE_HK(0); SBAR(); } while (0)
    f32x16 pA0, pA1, pB0, pB1; float alA, alB; bf16x8 pa0, pa1, pa2, pa3;
    float cbase;
    { float q2 = 0.f;
#pragma unroll
      for (int d0 = 0; d0 < 4; ++d0)
#pragma unroll
          for (int j = 0; j < 8; ++j) { const float v = __uint_as_float(((unsigned)(unsigned short)S.qr[d0][j]) << 16); q2 = fmaf(v, v, q2); }
      { auto rr = __builtin_amdgcn_permlane32_swap(__float_as_uint(q2), __float_as_uint(q2), false, false); q2 = __uint_as_float(rr[0]) + __uint_as_float(rr[1]); }
      cbase = sqrtf(q2) * cur.kmax * 1.0001f - slope2 * (float)(qlo + r32); }
    SWRITE_HV(0); SBAR();
    if (NT > 1) { SLOAD_H(Kh, Vh, KBASE(1)); }
    SBAR(); qkt<0>(pA0, pA1, K_lds, r32, hi, S.qr, AB(0), slope2);
    MASKT(pA0, pA1, 0); partialSM(pA0, pA1, m_reg, alA, l_reg);
    if (NT > 1) { VMW(); SWRITE_H(1); }
    __syncthreads();
#define HALF_STEP(PX0, PX1, alX, PY0, PY1, alY, t, KB, VB, SB) do {                                                      \
        SBAR(); qkt<KB>(PX0, PX1, K_lds, r32, hi, S.qr, AB(t), slope2);                                                   \
        finishSM(PY0, PY1, alY, l_reg, pa0, pa1, pa2, pa3); SBAR();                                                       \
        if ((t) + 1 < NT) { SLOAD_H(Kh, Vh, KBASE((t) + 1)); SBAR(); }                                                    \
        pv_tile<VB>(o, vb0, pa0, pa1, pa2, pa3); MASKT(PX0, PX1, (t)); partialSM(PX0, PX1, m_reg, alX, l_reg);                   \
        __syncthreads();                                                                                                  \
        if ((t) + 1 < NT) { VMW(); SWRITE_H(SB); }                                                                        \
        RESC(alX); __syncthreads(); } while (0)
    for (int t = 1; t + 1 < NT; t += 2) {
        HALF_STEP(pB0, pB1, alB, pA0, pA1, alA, t, 1, 0, 0);
        HALF_STEP(pA0, pA1, alA, pB0, pB1, alB, t + 1, 0, 1, 1);
        if (t == 3 && NT0 > 6) {
            float c = cbase - m_reg;
#pragma unroll
            for (int o_ = 1; o_ < 64; o_ <<= 1) c = fmaxf(c, __shfl_xor(c, o_));
            float* cx = (float*)(lds + LDS_CX);
            if (lane == 0) cx[wid] = c;
            __syncthreads();
            float C = cx[0];
#pragma unroll
            for (int w_ = 1; w_ < NW; ++w_) C = fmaxf(C, cx[w_]);
            const float X = (-SKIP_MARGIN - C) / slope2 - 63.f;
            const float need_f = (float)(NT0 - 1) - X * (1.0f / 64.0f);
            if (need_f < (float)NT0) { int n = (int)ceilf(need_f); n = n < 6 ? 6 : n; n = (n + 1) & ~1; NT = n < NT0 ? n : NT0; }
        }
    }
    SBAR(); qkt<1>(pB0, pB1, K_lds, r32, hi, S.qr, AB(NT - 1), slope2); SBAR();
    SLOAD_H(nxt.K, nxt.V, nxt.P0 + QB - KVBLK); SBAR();
#pragma unroll
    for (int d0 = 0; d0 < 4; ++d0) S.qr[d0] = load8(nxt.Q + (size_t)(wid * QBLK + r32) * ZP + d0 * 16 + hi * 8);
    SBAR();
    finishSM(pA0, pA1, alA, l_reg, pa0, pa1, pa2, pa3); SBAR();
    pv_tile<0>(o, vb0, pa0, pa1, pa2, pa3);
    MASKT(pB0, pB1, NT - 1); partialSM(pB0, pB1, m_reg, alB, l_reg); __syncthreads(); RESC(alB);
    finishSM(pB0, pB1, alB, l_reg, pa0, pa1, pa2, pa3); SBAR(); pv_tile<1>(o, vb0, pa0, pa1, pa2, pa3);
    SBAR(); SEAM_K0();
    if (hi == 0) li_l[r32] = l_reg; asm volatile("s_waitcnt lgkmcnt(0)" ::: "memory");
    float rli[16];
#pragma unroll
    for (int r = 0; r < 16; ++r) rli[r] = __builtin_amdgcn_rcpf(li_l[crow(r, hi)]);
    unsigned* stash = (unsigned*)(lds + LDS_STASH) + wid * 2048 + lane;
    if (cur.mode == 0) {
#pragma unroll
        for (int r = 0; r < 16; ++r) { stash[(r * 2 + 0) * 64] = cvt_pk_bf16(o[0][r] * rli[r], o[1][r] * rli[r]); stash[(r * 2 + 1) * 64] = cvt_pk_bf16(o[2][r] * rli[r], o[3][r] * rli[r]); }
    } else {
        float ssq[16];
#pragma unroll
        for (int r = 0; r < 16; ++r) { const unsigned w0 = stash[(r * 2 + 0) * 64], w1 = stash[(r * 2 + 1) * 64];
            o[0][r] = bf_lo(w0) - lam * (o[0][r] * rli[r]); o[1][r] = bf_hi(w0) - lam * (o[1][r] * rli[r]);
            o[2][r] = bf_lo(w1) - lam * (o[2][r] * rli[r]); o[3][r] = bf_hi(w1) - lam * (o[3][r] * rli[r]);
            ssq[r] = (o[0][r] * o[0][r] + o[1][r] * o[1][r]) + (o[2][r] * o[2][r] + o[3][r] * o[3][r]); }
#pragma unroll
        for (int r = 0; r < 16; ++r) {
#pragma unroll
            for (int off = 1; off < 32; off <<= 1) ssq[r] += __shfl_xor(ssq[r], off);
            ssq[r] = __builtin_amdgcn_rsqf(ssq[r] * (1.0f / DV) + RMS_EPS); }
        float g4[4];
#pragma unroll
        for (int d0 = 0; d0 < 4; ++d0) g4[d0] = subln[d0 * 32 + r32] * 0.8f;
        bf16_t* Ow = cur.O + (size_t)(wid * QBLK) * DM;
#pragma unroll
        for (int r = 0; r < 16; ++r) { const int orow = crow(r, hi);
#pragma unroll
            for (int d0 = 0; d0 < 4; ++d0) { const float v = o[d0][r] * ssq[r] * g4[d0]; const float vn = __shfl_xor(v, 1);
                if ((r32 & 1) == 0) *(unsigned*)(Ow + (size_t)orow * DM + d0 * 32 + r32) = cvt_pk_bf16(v, vn); } }
    }
    __syncthreads();
#undef RESC
#undef KBASE
#undef AB
#undef MASKT
#undef SEAM_K0
#undef HALF_STEP
}
#undef ROWV
#undef ROWK
#undef VMW
#undef VMWN
#undef SLOAD_H
#undef SWRITE_HK
#undef SWRITE_HV
#undef SWRITE_H
#undef SBAR
}


#define XB_TMO      128
#define XB_XCNT(j)  (256  + 64 * (j))
#define XB_XSUB(j)  (1280 + 64 * (j))
#define XB_XGEN(j)  (2304 + 64 * (j))
#define XB_TOP      3328
#define XB_TOPGEN   3392
#define XCD_BAR_WORDS 3456
#define XB_SPIN_CAP (1u << 22)
__device__ __forceinline__ unsigned xb_ld(unsigned* p)              { return __hip_atomic_load(p, __ATOMIC_RELAXED, __HIP_MEMORY_SCOPE_AGENT); }
__device__ __forceinline__ unsigned xb_add(unsigned* p, unsigned v) { return __hip_atomic_fetch_add(p, v, __ATOMIC_RELAXED, __HIP_MEMORY_SCOPE_AGENT); }
__device__ __forceinline__ unsigned xb_xcc_id() { return (unsigned)__builtin_amdgcn_s_getreg((3 << 11) | 20) & 0xFu; }
#define XB_SPIN(cond, bar) do { unsigned _sp = 0; while (cond) { __builtin_amdgcn_s_sleep(1); \
    if ((++_sp & 255u) == 0u) { if (xb_ld(&(bar)[XB_TMO])) break; if (_sp > XB_SPIN_CAP) { atomicAdd(&(bar)[XB_TMO], 1u); break; } } } } while (0)
struct XcdBarrier { unsigned* bar; unsigned x; volatile LAS unsigned* st; };
__device__ __forceinline__ XcdBarrier xcd_barrier_post(unsigned* bar, volatile LAS unsigned* st, bool t0) {
    XcdBarrier b; b.bar = bar; b.x = xb_xcc_id(); b.st = st;
    if (t0) (void)xb_add(&bar[XB_XCNT(b.x)], 1u);
    return b;
}
__device__ __forceinline__ void xcd_barrier_complete(unsigned* bar, unsigned x, unsigned& nloc, unsigned& nx) {
    const unsigned G = gridDim.x;
    unsigned sum, cnt, mine, sp = 0u;
    for (;;) {
        sum = 0u; cnt = 0u; mine = 0u;
#pragma unroll
        for (unsigned j = 0; j < 16; ++j) { const unsigned c = xb_ld(&bar[XB_XCNT(j)]); sum += c; cnt += (c > 0u) ? 1u : 0u; mine = (j == x) ? c : mine; }
        if (sum == G) break;
        __builtin_amdgcn_s_sleep(1);
        if ((++sp & 255u) == 0u) { if (xb_ld(&bar[XB_TMO])) break; if (sp > XB_SPIN_CAP) { atomicAdd(&bar[XB_TMO], 1u); break; } }
    }
    nloc = mine > 0u ? mine : 1u; nx = cnt > 0u ? cnt : 1u;
}
__device__ __forceinline__ void xcd_barrier(const XcdBarrier& b, bool t0) {
    asm volatile("s_waitcnt vmcnt(0)" ::: "memory");
    __syncthreads();
    if (t0) {
        unsigned* bar = b.bar;
        __builtin_amdgcn_s_waitcnt(0);
        unsigned nloc = b.st[0], nx = b.st[1];
        if (nloc == 0u) { xcd_barrier_complete(bar, b.x, nloc, nx); b.st[0] = nloc; b.st[1] = nx; }
        const unsigned old = xb_add(&bar[XB_XSUB(b.x)], 1u);
        const unsigned gen = old / nloc;
        if (old + 1u == (gen + 1u) * nloc) {
            __builtin_amdgcn_fence(__ATOMIC_RELEASE, "agent");
            asm volatile("s_waitcnt vmcnt(0)" ::: "memory");
            const unsigned og = xb_add(&bar[XB_TOP], 1u);
            const unsigned tg = og / nx;
            if (og + 1u == (tg + 1u) * nx) xb_add(&bar[XB_TOPGEN], 1u);
            else XB_SPIN(xb_ld(&bar[XB_TOPGEN]) == tg, bar);
            __builtin_amdgcn_fence(__ATOMIC_ACQUIRE, "agent");
            xb_add(&bar[XB_XGEN(b.x)], 1u);
            asm volatile("s_waitcnt vmcnt(0)" ::: "memory");
        } else {
            XB_SPIN(xb_ld(&bar[XB_XGEN(b.x)]) == gen, bar);
            __builtin_amdgcn_fence(__ATOMIC_ACQUIRE, "agent");
            asm volatile("s_waitcnt vmcnt(0)" ::: "memory");
        }
    }
    __syncthreads();
}
constexpr int NWAVES = 8, NTHR = 512;
constexpr int LDS_BYTES = 163840;
struct Args {
    const float* in[28]; float* out; unsigned char* ws; int ph_lo, ph_hi;
};
constexpr int N_PHASES = 15;

struct Frame {
    LAS unsigned char* lds; int wave, vcu, G;
};

__device__ __forceinline__ void transpose_item(const float* W, int ldw, int k0, int n0, bf16_t* dst, int ldt, const float* kscale, LAS float* scr, int lane) {
    f32x4 v[8]; const int kr = lane >> 3, n4 = (lane & 7) * 4;
#pragma unroll
    for (int i = 0; i < 8; ++i) v[i] = *(const f32x4*)(W + (size_t)(k0 + i * 8 + kr) * ldw + n0 + n4);
#pragma unroll
    for (int i = 0; i < 8; ++i) { const int kk = i * 8 + kr; f32x4 x = v[i]; if (kscale) x = x * kscale[k0 + kk];
        scr[kk * 33 + n4 + 0] = x[0]; scr[kk * 33 + n4 + 1] = x[1]; scr[kk * 33 + n4 + 2] = x[2]; scr[kk * 33 + n4 + 3] = x[3]; }
    asm volatile("s_waitcnt lgkmcnt(0)" ::: "memory");
    const int c = lane & 7;
#pragma unroll
    for (int j = 0; j < 4; ++j) { const int n = (lane >> 3) + 8 * j; const LAS float* s = scr + (8 * c) * 33 + n;
        u32x4 o; o.x = cvt_pk_bf16(s[0 * 33], s[1 * 33]); o.y = cvt_pk_bf16(s[2 * 33], s[3 * 33]); o.z = cvt_pk_bf16(s[4 * 33], s[5 * 33]); o.w = cvt_pk_bf16(s[6 * 33], s[7 * 33]);
        *(u32x4*)(dst + (size_t)n * ldt + k0 + 8 * c) = o; }
    asm volatile("s_waitcnt lgkmcnt(0)" ::: "memory");
}
__device__ __forceinline__ void transpose_item_fp8(const float* W, int ldw, int k0, int n0, unsigned char* dst, int ldt, float scale, const float* kscale, LAS float* scr, int lane) {
    f32x4 v[8]; const int kr = lane >> 3, n4 = (lane & 7) * 4;
#pragma unroll
    for (int i = 0; i < 8; ++i) v[i] = *(const f32x4*)(W + (size_t)(k0 + i * 8 + kr) * ldw + n0 + n4);
#pragma unroll
    for (int i = 0; i < 8; ++i) { const int kk = i * 8 + kr; const f32x4 x = v[i] * (kscale ? scale * kscale[k0 + kk] : scale);
        scr[kk * 33 + n4 + 0] = x[0]; scr[kk * 33 + n4 + 1] = x[1]; scr[kk * 33 + n4 + 2] = x[2]; scr[kk * 33 + n4 + 3] = x[3]; }
    asm volatile("s_waitcnt lgkmcnt(0)" ::: "memory");
    const int n = lane >> 1, kh = (lane & 1) * 32; const LAS float* s = scr + kh * 33 + n;
    u32x4 o0, o1;
    o0.x = pk4_fp8(s[0 * 33], s[1 * 33], s[2 * 33], s[3 * 33]); o0.y = pk4_fp8(s[4 * 33], s[5 * 33], s[6 * 33], s[7 * 33]); o0.z = pk4_fp8(s[8 * 33], s[9 * 33], s[10 * 33], s[11 * 33]); o0.w = pk4_fp8(s[12 * 33], s[13 * 33], s[14 * 33], s[15 * 33]);
    o1.x = pk4_fp8(s[16 * 33], s[17 * 33], s[18 * 33], s[19 * 33]); o1.y = pk4_fp8(s[20 * 33], s[21 * 33], s[22 * 33], s[23 * 33]); o1.z = pk4_fp8(s[24 * 33], s[25 * 33], s[26 * 33], s[27 * 33]); o1.w = pk4_fp8(s[28 * 33], s[29 * 33], s[30 * 33], s[31 * 33]);
    *(u32x4*)(dst + (size_t)n * ldt + k0 + kh) = o0; *(u32x4*)(dst + (size_t)n * ldt + k0 + kh + 16) = o1;
    asm volatile("s_waitcnt lgkmcnt(0)" ::: "memory");
}
__device__ __forceinline__ void rms_rows2_to_bf16(const float* xa, const float* xb, const float* g, bf16_t* oa, bf16_t* ob, int lane) {
    const f32x4* ra = (const f32x4*)xa + lane; const f32x4* rb = (const f32x4*)xb + lane; const f32x4* gr = (const f32x4*)g + lane;
    f32x4 va[4], vb[4]; float sa = 0.f, sb = 0.f;
#pragma unroll
    for (int j = 0; j < 4; ++j) { va[j] = ra[64 * j]; vb[j] = rb[64 * j]; }
#pragma unroll
    for (int j = 0; j < 4; ++j) { sa += (va[j].x * va[j].x + va[j].y * va[j].y) + (va[j].z * va[j].z + va[j].w * va[j].w); sb += (vb[j].x * vb[j].x + vb[j].y * vb[j].y) + (vb[j].z * vb[j].z + vb[j].w * vb[j].w); }
    const float rsa = __builtin_amdgcn_rsqf(wave_sum(sa) * (1.f / DM) + RMS_EPS), rsb = __builtin_amdgcn_rsqf(wave_sum(sb) * (1.f / DM) + RMS_EPS);
    u32x2* pa = (u32x2*)oa + lane; u32x2* pb = (u32x2*)ob + lane;
#pragma unroll
    for (int j = 0; j < 4; ++j) { const f32x4 gg = gr[64 * j]; u32x2 w;
        w.x = cvt_pk_bf16(va[j].x * rsa * gg.x, va[j].y * rsa * gg.y); w.y = cvt_pk_bf16(va[j].z * rsa * gg.z, va[j].w * rsa * gg.w); pa[64 * j] = w;
        w.x = cvt_pk_bf16(vb[j].x * rsb * gg.x, vb[j].y * rsb * gg.y); w.y = cvt_pk_bf16(vb[j].z * rsb * gg.z, vb[j].w * rsb * gg.w); pb[64 * j] = w; }
}

__global__ void __launch_bounds__(NTHR, 2) mega(Args args) {
    extern __shared__ __attribute__((aligned(16))) unsigned char lds_raw[];
    Frame F; F.lds = (LAS unsigned char*)lds_raw; F.wave = __builtin_amdgcn_readfirstlane(threadIdx.x >> 6);
    F.G = gridDim.x; { const int bx = blockIdx.x; F.vcu = (F.G % 8 == 0) ? (bx % 8) * (F.G / 8) + bx / 8 : bx; }
    unsigned char* ws = args.ws;
    unsigned* ctl = (unsigned*)(ws + WS_CTL);
    const float* x = args.in[0]; float* out = args.out;
    bf16_t* Win_t = (bf16_t*)(ws + WS_WIN); bf16_t* Wout_t = (bf16_t*)(ws + WS_WOUT); bf16_t* Wq_t = (bf16_t*)(ws + WS_WQ); bf16_t* Wkv_t = (bf16_t*)(ws + WS_WKV);
    bf16_t* Wo_t = (bf16_t*)(ws + WS_WO); bf16_t* Wr_t = (bf16_t*)(ws + WS_WR); bf16_t* Wsgu = (bf16_t*)(ws + WS_WSGU); bf16_t* memn = (bf16_t*)(ws + WS_MEMN);
    bf16_t* Km = (bf16_t*)(ws + WS_KM); bf16_t* Vt = (bf16_t*)(ws + WS_VT); bf16_t* Wgu_t = (bf16_t*)(ws + WS_WGU); bf16_t* Wd_t = (bf16_t*)(ws + WS_WD);
    bf16_t* Z = (bf16_t*)(ws + WS_RA); bf16_t* Qm = (bf16_t*)(ws + WS_RA); bf16_t* Sc = (bf16_t*)(ws + WS_RA + 128 * MiB); bf16_t* xg = (bf16_t*)(ws + WS_RA); bf16_t* yb = (bf16_t*)(ws + WS_RA);
    bf16_t* XN = (bf16_t*)(ws + WS_RB); bf16_t* AO = (bf16_t*)(ws + WS_RB); bf16_t* Om = (bf16_t*)(ws + WS_RB); bf16_t* act = (bf16_t*)(ws + WS_RB);
    bf16_t* x1b = (bf16_t*)(ws + WS_RC); bf16_t* x2b = (bf16_t*)(ws + WS_RC); unsigned char* x2f8 = ws + WS_X2F8;
    float* ssq1 = (float*)(ws + WS_SSQ1); float* ssq2 = (float*)(ws + WS_SSQ2); float* rstd2 = (float*)(ws + WS_SSQ1);     float* logit = (float*)(ws + WS_LOGIT);
    int* tok_e = (int*)(ws + WS_TOKE); float* tok_w = (float*)(ws + WS_TOKW); int* tok_s = (int*)(ws + WS_TOKS); int* row_tok = (int*)(ws + WS_ROWTOK); float* rowrs = (float*)(ws + WS_ROWTOK + 1 * MiB);
    const int gw = F.vcu * NWAVES + F.wave, NGW = F.G * NWAVES;
    const int lo = args.ph_lo, hi = args.ph_hi;
#define IN(k) (lo <= (k) && (k) < hi)
#if MK_ONE_LAUNCH
    volatile LAS unsigned* misc = (volatile LAS unsigned*)(F.lds + LDS_MISC);
    if (threadIdx.x < 64) misc[threadIdx.x] = 0u;
    __syncthreads();
    XcdBarrier xbar = xcd_barrier_post(ctl + CW_BAR, misc + 8, threadIdx.x == 0);
#define GRID_BAR(k) do { if (IN(k) && IN((k) + 1)) { if ((k) == 0) cg::this_grid().sync(); else xcd_barrier(xbar, F.wave == 0 && lane_id() == 0); } } while (0)
#else
#define GRID_BAR(k) do { } while (0)
#endif
#define LOCAL_SEAM() do { asm volatile("s_waitcnt vmcnt(0)" ::: "memory"); __syncthreads(); __builtin_amdgcn_fence(__ATOMIC_ACQUIRE, "agent"); asm volatile("s_waitcnt vmcnt(0)" ::: "memory"); __syncthreads(); } while (0)

    if (IN(0)) {
        const int lane_ = lane_id(), tid_ = F.wave * 64 + lane_; (void)tid_;
        LAS float* scr = (LAS float*)(F.lds + F.wave * 16384);
        constexpr int I_IN = 16 * 80, I_SQ = 16 * 32, I_KV = 16 * 64, I_G = 16 * 16, I_D = 8 * 32;
        constexpr int NITEMS = I_IN + 3 * I_SQ + I_KV + NEXP * (2 * I_G + I_D);
        for (int it = gw; it < NITEMS; it += NGW) {
            int r = it;
            if (r < I_IN) { const int kb = r / 80, nb = r % 80; transpose_item(args.in[3], ZP, kb * 64, nb * 32, Win_t + (size_t)(nb * 32) * DM, DM, nullptr, scr, lane_); continue; } r -= I_IN;
            if (r < I_SQ) { const int kb = r / 32, nb = r % 32; transpose_item(args.in[13], DM, kb * 64, nb * 32, Wout_t + (size_t)(nb * 32) * DM, DM, nullptr, scr, lane_); continue; } r -= I_SQ;
            if (r < I_SQ) { const int kb = r / 32, nb = r % 32; transpose_item_fp8(args.in[16], DM, kb * 64, nb * 32, (unsigned char*)Wq_t + (size_t)(nb * 32) * DM, DM, F8_WSCALE, args.in[14], scr, lane_); continue; } r -= I_SQ;
            if (r < I_KV) { const int kb = r / 64, nb = r % 64; transpose_item(args.in[17], 2 * DM, kb * 64, nb * 32, Wkv_t + (size_t)(nb * 32) * DM, DM, nullptr, scr, lane_); continue; } r -= I_KV;
            if (r < I_SQ) { const int kb = r / 32, nb = r % 32; transpose_item_fp8(args.in[18], DM, kb * 64, nb * 32, (unsigned char*)Wo_t + (size_t)(nb * 32) * DM, DM, F8_WSCALE, nullptr, scr, lane_); continue; } r -= I_SQ;
            const int e = r / (2 * I_G + I_D); r -= e * (2 * I_G + I_D);
            if (r < 2 * I_G) { const int up = r >= I_G; if (up) r -= I_G; const int kb = r / 16, nb = r % 16, n0 = nb * 32;
                const float* W = (up ? args.in[25] : args.in[24]) + (size_t)e * DM * DEXP;
                transpose_item_fp8(W, DEXP, kb * 64, n0, (unsigned char*)Wgu_t + ((size_t)e * 1024 + (n0 >> 7) * 256 + 64 * ((n0 & 127) >> 5) + 32 * up) * DM, DM, F8_WSCALE, args.in[19], scr, lane_); continue; }
            r -= 2 * I_G;
            { const int kb = r / 32, nb = r % 32; transpose_item_fp8(args.in[26] + (size_t)e * DEXP * DM, DM, kb * 64, nb * 32, (unsigned char*)Wd_t + ((size_t)e * 1024 + nb * 32) * DEXP, DEXP, F8_WSCALE, nullptr, scr, lane_); }
        }
        for (int i = blockIdx.x * NTHR + tid_; i < 256 * DM; i += F.G * NTHR) { const int n = i >> 10, k = i & 1023; float v = 0.f;
            if (n < 4) v = args.in[20][k * 4 + n] * args.in[19][k]; else if (n < 36) v = args.in[22][k * 32 + (n - 4)] * args.in[19][k];
            Wr_t[i] = (bf16_t)(cvt_pk_bf16(v, 0.f) & 0xffffu); }
        for (int i = blockIdx.x * NTHR + tid_; i < 4 * 128 * 128; i += F.G * NTHR) { const int t = (i >> 7) & 127, s = i & 127; const float v = s <= t ? args.in[6][i] : 0.f; Wsgu[i] = (bf16_t)(cvt_pk_bf16(v, 0.f) & 0xffffu); }
        if (blockIdx.x == 0) {
            LAS int* srt = (LAS int*)(F.lds + 12288); LAS int* cst = srt + 128;
            if (tid_ < 128) { const int caps[4] = {7, 15, 46, 128};
                const int h = tid_ >> 5, qb = tid_ & 31; int st = 4 * (qb + 1); { const int cp = h == 0 ? caps[0] : (h == 1 ? caps[1] : (h == 2 ? caps[2] : caps[3])); st = st < cp ? st : cp; } const int mine = 2 * (15 * st + 200); int rank = 0;
                for (int j = 0; j < 128; ++j) { const int hj = j >> 5, qj = j & 31; int sj = 4 * (qj + 1); { const int cp = hj == 0 ? caps[0] : (hj == 1 ? caps[1] : (hj == 2 ? caps[2] : caps[3])); sj = sj < cp ? sj : cp; } const int cj = 2 * (15 * sj + 200);
                    rank += (cj > mine || (cj == mine && j < tid_)) ? 1 : 0; }
                srt[rank] = tid_; cst[rank] = mine; }
            __syncthreads();
            if (F.wave == 0) { int load = lane_ < 32 ? 0 : 0x00ffffff, cnt = 0;
                for (int i = 0; i < 128; ++i) { int key = load * 64 + lane_;
#pragma unroll
                    for (int o_ = 1; o_ < 64; o_ <<= 1) { const int ok = __shfl_xor(key, o_); key = ok < key ? ok : key; }
                    if ((key & 63) == lane_ && cnt < 24) { ctl[CW_ALIST + lane_ * 24 + cnt] = (unsigned)srt[i]; ++cnt; load += cst[i]; } }
                if (lane_ < 32) ctl[CW_ALIST + 768 + lane_] = (unsigned)cnt; }
        }
        for (int m = gw; m < M; m += 2 * NGW) rms_rows2_to_bf16(x + (size_t)m * DM, x + (size_t)(m + NGW) * DM, args.in[2], XN + (size_t)m * DM, XN + (size_t)(m + NGW) * DM, lane_);
        for (int m = gw; m < MROWS / 2; m += NGW) rms_rows2_to_bf16(args.in[1] + (size_t)m * DM, args.in[1] + (size_t)(m + MROWS / 2) * DM, args.in[15], memn + (size_t)m * DM, memn + (size_t)(m + MROWS / 2) * DM, lane_);
        __syncthreads();
    }
    GRID_BAR(0);

    if (IN(1)) {
        { pg8::Gemm g{DM, DM, DM}; pg8::PlainSched S; S.to.init(M / 256, ZP / 256, F.G, (int)blockIdx.x); S.A = (const char*)XN; S.B = (const char*)Win_t; S.tA = (size_t)256 * DM * 2; S.tB = (size_t)256 * DM * 2;
          pg8::EpiZ E{Z, ctl + CW_KMX}; pg8::gemm_phase(F.lds, F.wave, g, S, E); }
    }
    GRID_BAR(1);

    if (IN(2)) {
        const int lane_ = lane_id(), tid_ = F.wave * 64 + lane_; (void)tid_;
        float lam;
        { const float a = args.in[8][lane_] * args.in[9][lane_], b = args.in[10][lane_] * args.in[11][lane_];
          lam = __expf(wave_sum(a)) - __expf(wave_sum(b)) + 0.2f; }
        {
            LAS float* kmt = (LAS float*)(F.lds + da::LDS_CX + 64);
            const int b = (F.G == 256) ? (F.vcu >> 5) : 0, r = F.vcu & 31;
            if (tid_ < 8) { const unsigned* kp = ctl + CW_KMX + ((b * 4 + (tid_ >> 1)) * 2 + (tid_ & 1)) * 2; kmt[tid_] = 1.01f * sqrtf(__uint_as_float(ld_u32_agent(kp)) + __uint_as_float(ld_u32_agent(kp + 1))); }
            __syncthreads();
            const int nit = (F.G == 256) ? (int)__builtin_amdgcn_readfirstlane(ld_u32_agent(ctl + CW_ALIST + 768 + r)) : 0;
#define COMBO_OF(i) ((int)__builtin_amdgcn_readfirstlane(ld_u32_agent(ctl + CW_ALIST + r * 24 + (i))))
            if (nit > 0) {
                int ii = 0, pass = 0, combo = COMBO_OF(0); da::BlockRef cur = da::mkref(Z, AO, (const float*)kmt, b, combo, 0); da::Seam S;
                da::prime(cur, (char*)lds_raw, S, F.wave);
                for (;;) {
                    int ni = ii, np = pass + 1; if (np == 2) { np = 0; ni = ii + 1; }
                    const bool last = ni >= nit * PROBE_DUP_ATTN;
                    int ncombo = combo; if (!last && np == 0) ncombo = COMBO_OF(ni % nit);
                    const da::BlockRef nxt = last ? cur : da::mkref(Z, AO, (const float*)kmt, b, ncombo, np);
                    da::block(cur, nxt, (char*)lds_raw, S, lam, args.in[12], F.wave);
                    if (last) break;
                    cur = nxt; ii = ni; pass = np; combo = ncombo;
                }
            }
#undef COMBO_OF
        }
        __syncthreads();
        {
            const int lane = lane_, w = F.wave;
            const int nun = (M / 128) * 4;
            const int ch0 = (lane & 15) * 8, t = 16 * w + (lane & 15), nks = (w + 2) >> 1;
            u32x4 vr[4];
            LAS int* sq = (LAS int*)(F.lds + 2 * 34816);
            const bool puller = (w == 0 && lane == 0);
            if (puller) { sq[0] = (int)atomicAdd(ctl + CW_SGUQ, 1u); sq[1] = (int)atomicAdd(ctl + CW_SGUQ, 1u); }
            __syncthreads();
            int uidx = __builtin_amdgcn_readfirstlane(sq[0]), unext = __builtin_amdgcn_readfirstlane(sq[1]), kk = 0;
            if (uidx < nun) { const size_t R0 = (size_t)(uidx >> 2) * 128; const int g = uidx & 3;
#pragma unroll
                for (int ps = 0; ps < 4; ++ps) vr[ps] = *(const u32x4*)(Z + (R0 + 16 * w + 4 * ps + (lane >> 4)) * ZP + ZV + g * 128 + ch0); }
            int gcur = -1; float lg[8], lb[8]; bf16x8 wf[4]; float bias = 0.f; int buf = 0;
#pragma unroll
            for (int j = 0; j < 8; ++j) { lg[j] = 0.f; lb[j] = 0.f; }
#pragma unroll
            for (int ks = 0; ks < 4; ++ks) wf[ks] = (bf16x8){0, 0, 0, 0, 0, 0, 0, 0};
            for (; uidx < nun; uidx = unext, unext = __builtin_amdgcn_readfirstlane(sq[(kk + 1) & 3]), buf ^= 1) {
                int pulled_ = 0; if (puller) pulled_ = (int)atomicAdd(ctl + CW_SGUQ, 1u);
                const int c = uidx >> 2, g = uidx & 3; const size_t R0 = (size_t)c * 128;
                LAS bf16_t* vnT = (LAS bf16_t*)(F.lds + buf * 34816);
                if (g != gcur) { gcur = g;
#pragma unroll
                    for (int j = 0; j < 8; ++j) { lg[j] = args.in[4][g * 128 + ch0 + j]; lb[j] = args.in[5][g * 128 + ch0 + j]; }
#pragma unroll
                    for (int ks = 0; ks < 4; ++ks) if (ks < nks) wf[ks] = *(const bf16x8*)(Wsgu + ((size_t)g * 128 + t) * 128 + ks * 32 + 8 * (lane >> 4));
                    bias = args.in[7][g * 128 + t]; }
#pragma unroll
                for (int ps = 0; ps < 4; ++ps) { const int sr = 16 * w + 4 * ps + (lane >> 4); const u32x4 raw = vr[ps];
                    float v[8] = {bf_lo(raw.x), bf_hi(raw.x), bf_lo(raw.y), bf_hi(raw.y), bf_lo(raw.z), bf_hi(raw.z), bf_lo(raw.w), bf_hi(raw.w)};
                    float sm = 0.f;
#pragma unroll
                    for (int j = 0; j < 8; ++j) sm += v[j];
#pragma unroll
                    for (int o = 1; o < 16; o <<= 1) sm += __shfl_xor(sm, o);
                    const float mu = sm * (1.f / 128.f); float q = 0.f;
#pragma unroll
                    for (int j = 0; j < 8; ++j) { v[j] -= mu; q += v[j] * v[j]; }
#pragma unroll
                    for (int o = 1; o < 16; o <<= 1) q += __shfl_xor(q, o);
                    const float rstd = __builtin_amdgcn_rsqf(q * (1.f / 128.f) + LN_EPS);
#pragma unroll
                    for (int j = 0; j < 8; ++j) { const float y = v[j] * rstd * lg[j] + lb[j]; vnT[(ch0 + j) * 136 + sr] = (bf16_t)(cvt_pk_bf16(y, 0.f) & 0xffffu); } }
                u32x2 ur[8];
#pragma unroll
                for (int mi = 0; mi < 8; ++mi) ur[mi] = *(const u32x2*)(Z + (R0 + t) * ZP + ZU + g * 128 + 16 * mi + 4 * (lane >> 4));
                { const int un = unext; if (un < nun) { const size_t Rn = (size_t)(un >> 2) * 128; const int gn = un & 3;
#pragma unroll
                    for (int ps = 0; ps < 4; ++ps) vr[ps] = *(const u32x4*)(Z + (Rn + 16 * w + 4 * ps + (lane >> 4)) * ZP + ZV + gn * 128 + ch0); } }
                if (puller) sq[(kk + 2) & 3] = pulled_;
                ++kk;
                __syncthreads();
                f32x4 acc[8];
#pragma unroll
                for (int mi = 0; mi < 8; ++mi) acc[mi] = (f32x4){0.f, 0.f, 0.f, 0.f};
#pragma unroll
                for (int ks = 0; ks < 4; ++ks) if (ks < nks) {
#pragma unroll
                    for (int mi = 0; mi < 8; ++mi) { const bf16x8 afr = *(const LAS bf16x8*)(vnT + (16 * mi + (lane & 15)) * 136 + ks * 32 + 8 * (lane >> 4));
                        acc[mi] = __builtin_amdgcn_mfma_f32_16x16x32_bf16(afr, wf[ks], acc[mi], 0, 0, 0); } }
#pragma unroll
                for (int mi = 0; mi < 8; ++mi) { const int ch = 16 * mi + 4 * (lane >> 4); const u32x2 u2 = ur[mi];
                    const float o0 = bf_lo(u2.x) * (acc[mi][0] + bias), o1 = bf_hi(u2.x) * (acc[mi][1] + bias), o2 = bf_lo(u2.y) * (acc[mi][2] + bias), o3 = bf_hi(u2.y) * (acc[mi][3] + bias);
                    u32x2 wv; wv.x = cvt_pk_bf16(o0, o1); wv.y = cvt_pk_bf16(o2, o3);
                    *(u32x2*)(AO + (R0 + t) * DM + g * 128 + ch) = wv; }
            }
            __syncthreads();
        }
        {
            int e = -1;
            if (F.G == 256) { const int b = F.vcu >> 5, r = F.vcu & 31; if (r >= 16 && r < 24) e = b * 8 + (r - 16); }
            for (int e2 = (F.G == 256 ? e : F.vcu); e2 >= 0 && e2 < 64; e2 = (F.G == 256 ? 64 : e2 + F.G)) {
                pg8::Gemm g{DM, DM, DM}; pg8::OneUnitSched S;
                if (e2 < 32) { S.u0.pm = e2 >> 2; S.u0.pn = e2 & 3; S.u0.aux = 0; S.u0.rows = nullptr; S.u0.A = (const char*)(memn + (size_t)S.u0.pm * 256 * DM); S.u0.B = (const char*)(Wkv_t + (size_t)S.u0.pn * 256 * DM);
                    pg8::EpiF8 E{(unsigned char*)Km, DM, nullptr, F8_KSCALE}; pg8::gemm_phase(F.lds, F.wave, g, S, E); }
                else { const int e3 = e2 - 32; S.u0.pm = e3 >> 3; S.u0.pn = e3 & 7; S.u0.aux = 0; S.u0.rows = nullptr; S.u0.A = (const char*)(Wkv_t + (size_t)(1024 + S.u0.pm * 256) * DM); S.u0.B = (const char*)(memn + (size_t)S.u0.pn * 256 * DM);
                    pg8::EpiF8 E{(unsigned char*)Vt, MROWS, nullptr, F8_VSCALE}; pg8::gemm_phase(F.lds, F.wave, g, S, E); }
            }
        }
    }
    GRID_BAR(2);

    if (IN(3)) {
        pg8::Gemm g{DM, DM, DM}; pg8::PlainSched S; S.to.init(M / 256, 4, F.G, (int)blockIdx.x); S.A = (const char*)AO; S.B = (const char*)Wout_t; S.tA = (size_t)256 * DM * 2; S.tB = (size_t)256 * DM * 2;
        pg8::EpiResid<false> E{x, x1b, ssq1, (LAS float*)(F.lds + 131072 + 1024), x2f8, 1.f}; pg8::gemm_phase(F.lds, F.wave, g, S, E);
    }
    GRID_BAR(3);

    if (IN(4)) {
        pg8::Gemm g{DM / 2, DM / 2, DM / 2}; pg8::PlainSched S; S.to.init(M / 256, 4, F.G, (int)blockIdx.x); S.A = (const char*)x2f8; S.B = (const char*)Wq_t; S.tA = (size_t)256 * DM; S.tB = (size_t)256 * DM;
        pg8::EpiF8 E{(unsigned char*)Qm, DM, ssq1, F8_QSCALE * C2_MEM / (F8_XSCALE * F8_WSCALE)}; pg8::gemm_phase<pg8::EpiF8, pg8::PlainSched, false, true>(F.lds, F.wave, g, S, E);
    }
    if (MK_ONE_LAUNCH && IN(4) && IN(5)) LOCAL_SEAM();

    if (IN(5)) {
        pg8::Gemm g{DM / 2, DM / 2, 128}; pg8::MemAttnSched S; S.to.init(M / 256, 4, F.G, (int)blockIdx.x); S.A = (const char*)Qm; S.B = (const char*)Km; S.tA = (size_t)256 * DM; S.hA = 256; S.bB = (size_t)256 * DM; S.hB = 256;
        pg8::EpiSoftmax E{(unsigned char*)Sc, (LAS float*)(F.lds + LDS_MISC + 1024), 1.0f / (F8_QSCALE * F8_KSCALE)}; pg8::gemm_phase<pg8::EpiSoftmax, pg8::MemAttnSched, false, true>(F.lds, F.wave, g, S, E);
    }
    if (MK_ONE_LAUNCH && IN(5) && IN(6 + 1)) LOCAL_SEAM();

    if (IN(7)) {
        pg8::Gemm g{DM / 2, MROWS / 2, 128}; pg8::MemAttnSched S; S.to.init(M / 256, 4, F.G, (int)blockIdx.x); S.A = (const char*)Sc; S.B = (const char*)Vt; S.tA = (size_t)256 * DM; S.hA = 256; S.bB = 256; S.hB = (size_t)256 * MROWS;
        pg8::EpiF8 E{(unsigned char*)Om, DM, nullptr, F8_OSCALE / (F8_PSCALE * F8_VSCALE)}; pg8::gemm_phase<pg8::EpiF8, pg8::MemAttnSched, false, true>(F.lds, F.wave, g, S, E);
    }
    GRID_BAR(7);

    if (IN(8)) {
        pg8::Gemm g{DM / 2, DM / 2, DM / 2}; pg8::PlainSched S; S.to.init(M / 256, 4, F.G, (int)blockIdx.x); S.A = (const char*)Om; S.B = (const char*)Wo_t; S.tA = (size_t)256 * DM; S.tB = (size_t)256 * DM;
        pg8::EpiResid<true> E{x1b, x2b, ssq2, (LAS float*)(F.lds + 131072 + 1024), x2f8, 1.0f / (F8_OSCALE * F8_WSCALE)}; pg8::gemm_phase<pg8::EpiResid<true>, pg8::PlainSched, false, true>(F.lds, F.wave, g, S, E);
    }
    GRID_BAR(8);

    if (IN(9)) {
        pg8::Gemm g{DM, DM, DM}; pg8::PlainSched S; S.to.init(M / 256, 1, F.G, (int)blockIdx.x); S.A = (const char*)x2b; S.B = (const char*)Wr_t; S.tA = (size_t)256 * DM * 2; S.tB = 0;
        pg8::EpiRouter E{logit, ssq2, args.in[21], args.in[23], rstd2}; pg8::gemm_phase(F.lds, F.wave, g, S, E);
    }
    GRID_BAR(9);

    if (IN(10)) {
        const int lane_ = lane_id(), tid_ = F.wave * 64 + lane_; (void)tid_;
        LAS unsigned* lcnt = (LAS unsigned*)F.lds; LAS unsigned* lbase = lcnt + 32;
        for (int t0 = blockIdx.x * NTHR; t0 < M; t0 += F.G * NTHR) {
            if (tid_ < 32) lcnt[tid_] = 0u;
            __syncthreads();
            const int tok = t0 + tid_;
            const f32x4 lg = *(const f32x4*)(logit + (size_t)tok * 64);
            int gi = 0; float gm = lg[0];
#pragma unroll
            for (int j = 1; j < 4; ++j) if (lg[j] > gm) { gm = lg[j]; gi = j; }
            float gs = 0.f;
#pragma unroll
            for (int j = 0; j < 4; ++j) gs += __expf(lg[j] - gm);
            const float gate = 1.0f / gs;
            const f32x4 ea = *(const f32x4*)(logit + (size_t)tok * 64 + 4 + gi * 8), eb = *(const f32x4*)(logit + (size_t)tok * 64 + 8 + gi * 8);
            const float el[8] = {ea[0], ea[1], ea[2], ea[3], eb[0], eb[1], eb[2], eb[3]};
            int i0 = 0; float m0 = el[0];
#pragma unroll
            for (int j = 1; j < 8; ++j) if (el[j] > m0) { m0 = el[j]; i0 = j; }
            int i1 = -1; float m1 = -__builtin_inff();
#pragma unroll
            for (int j = 0; j < 8; ++j) if (j != i0 && el[j] > m1) { m1 = el[j]; i1 = j; }
            if (i1 < 0) i1 = (i0 == 0) ? 1 : 0;
            const float r = __expf(m1 - m0);
            const float w0 = gate / (1.0f + r), w1 = gate * r / (1.0f + r);
            const int e0 = gi * 8 + i0, e1 = gi * 8 + i1;
            const unsigned r0 = atomicAdd((unsigned*)&lcnt[e0], 1u), r1 = atomicAdd((unsigned*)&lcnt[e1], 1u);
            __syncthreads();
            if (tid_ < 32) lbase[tid_] = atomicAdd(ctl + CW_CNT + tid_, lcnt[tid_]);
            __syncthreads();
            tok_e[tok * 2] = e0; tok_e[tok * 2 + 1] = e1; tok_w[tok * 2] = w0; tok_w[tok * 2 + 1] = w1;
            tok_s[tok * 2] = (int)(lbase[e0] + r0); tok_s[tok * 2 + 1] = (int)(lbase[e1] + r1);
            __syncthreads();
        }
    }
    GRID_BAR(10);

    if (IN(11)) {
        const int lane_ = lane_id(), tid_ = F.wave * 64 + lane_; (void)tid_;
        LAS unsigned* lps = (LAS unsigned*)F.lds;
        if (tid_ == 0) { unsigned acc = 0; for (int e = 0; e < 32; ++e) { lps[e] = acc; const unsigned c = ld_u32_agent(ctl + CW_CNT + e); acc += (c + 255u) & ~255u; } lps[32] = acc; }
        __syncthreads();
        if (blockIdx.x == 0) {
            if (tid_ < 32) { const unsigned s = lps[tid_], e2 = lps[tid_ + 1], c = ld_u32_agent(ctl + CW_CNT + tid_);
                for (unsigned b = s >> 8; b < (e2 >> 8); ++b) ctl[CW_BLKE + b] = (unsigned)tid_;
                for (unsigned r = s + c; r < e2; ++r) { row_tok[r] = 0; rowrs[r] = 0.f; } }
            if (tid_ == 0) ctl[CW_NBLK] = lps[32] >> 8;
        }
        for (int a = blockIdx.x * NTHR + tid_; a < M * 2; a += F.G * NTHR) { const int e = tok_e[a]; const int pos = (int)lps[e] + tok_s[a]; row_tok[pos] = a >> 1; tok_s[a] = pos; rowrs[pos] = rstd2[a >> 1] * (1.0f / (F8_XSCALE * F8_WSCALE)); }
        __syncthreads();
    }
    GRID_BAR(11);

    if (IN(12)) {
        const int nblk = (int)__builtin_amdgcn_readfirstlane(ld_u32_agent(ctl + CW_NBLK));
        pg8::Gemm g{DM / 2, DM / 2, DM / 2}; pg8::MoeSched S{F.G, F.vcu, nblk, ctl + CW_BLKE, (const char*)x2f8, (const char*)Wgu_t, (size_t)0, (size_t)1024 * DM, (size_t)256 * DM, row_tok};
        pg8::EpiGateUp E{(unsigned char*)act, rowrs, row_tok}; pg8::gemm_phase<pg8::EpiGateUp, pg8::MoeSched, true, true>(F.lds, F.wave, g, S, E);
    }
    GRID_BAR(12);

    if (IN(13)) {
        const int nblk = (int)__builtin_amdgcn_readfirstlane(ld_u32_agent(ctl + CW_NBLK));
        pg8::Gemm g{DEXP / 2, DEXP / 2, DEXP / 2}; pg8::MoeSched S{F.G, F.vcu, nblk, ctl + CW_BLKE, (const char*)act, (const char*)Wd_t, (size_t)256 * DEXP, (size_t)1024 * DEXP, (size_t)256 * DEXP, row_tok};
        pg8::EpiF8 E{(unsigned char*)yb, DM, nullptr, F8_YSCALE / (F8_WSCALE * F8_ASCALE)}; pg8::gemm_phase<pg8::EpiF8, pg8::MoeSched, false, true>(F.lds, F.wave, g, S, E);
    }
    GRID_BAR(13);

    if (IN(14)) {
        const int lane_ = lane_id(), tid_ = F.wave * 64 + lane_; (void)tid_;
        const f32x4* gr = (const f32x4*)args.in[27] + lane_;
        f32x4 gg[4];
#pragma unroll
        for (int j = 0; j < 4; ++j) gg[j] = gr[64 * j];
        for (int m = gw; m < M; m += 2 * NGW) {
            const int ma = m, mb = m + NGW;
            const int pa0 = tok_s[ma * 2], pa1 = tok_s[ma * 2 + 1], pb0 = tok_s[mb * 2], pb1 = tok_s[mb * 2 + 1];
            const float wa0 = tok_w[ma * 2], wa1 = tok_w[ma * 2 + 1], wb0 = tok_w[mb * 2], wb1 = tok_w[mb * 2 + 1];
            const u32x2* xa = (const u32x2*)(x2b + (size_t)ma * DM) + lane_; const u32x2* xb = (const u32x2*)(x2b + (size_t)mb * DM) + lane_;
            const unsigned* ya0 = (const unsigned*)((const unsigned char*)yb + (size_t)pa0 * DM) + lane_; const unsigned* ya1 = (const unsigned*)((const unsigned char*)yb + (size_t)pa1 * DM) + lane_;
            const unsigned* yb0 = (const unsigned*)((const unsigned char*)yb + (size_t)pb0 * DM) + lane_; const unsigned* yb1 = (const unsigned*)((const unsigned char*)yb + (size_t)pb1 * DM) + lane_;
            u32x2 ca[4], cb[4]; unsigned a0[4], a1[4], b0[4], b1[4];
#pragma unroll
            for (int j = 0; j < 4; ++j) { ca[j] = xa[64 * j]; cb[j] = xb[64 * j]; a0[j] = ya0[64 * j]; a1[j] = ya1[64 * j]; b0[j] = yb0[64 * j]; b1[j] = yb1[64 * j]; }
            f32x4 va[4], vb[4]; float sa = 0.f, sb = 0.f;
            const float ka0 = wa0 * (1.0f / F8_YSCALE), ka1 = wa1 * (1.0f / F8_YSCALE), kb0 = wb0 * (1.0f / F8_YSCALE), kb1 = wb1 * (1.0f / F8_YSCALE);
#pragma unroll
            for (int j = 0; j < 4; ++j) {
                const f32x2 p0 = __builtin_amdgcn_cvt_pk_f32_fp8(a0[j], false), p1 = __builtin_amdgcn_cvt_pk_f32_fp8(a0[j], true), q0 = __builtin_amdgcn_cvt_pk_f32_fp8(a1[j], false), q1 = __builtin_amdgcn_cvt_pk_f32_fp8(a1[j], true);
                const f32x2 r0 = __builtin_amdgcn_cvt_pk_f32_fp8(b0[j], false), r1 = __builtin_amdgcn_cvt_pk_f32_fp8(b0[j], true), t0 = __builtin_amdgcn_cvt_pk_f32_fp8(b1[j], false), t1 = __builtin_amdgcn_cvt_pk_f32_fp8(b1[j], true);
                va[j].x = bf_lo(ca[j].x) + ka0 * p0.x + ka1 * q0.x; va[j].y = bf_hi(ca[j].x) + ka0 * p0.y + ka1 * q0.y; va[j].z = bf_lo(ca[j].y) + ka0 * p1.x + ka1 * q1.x; va[j].w = bf_hi(ca[j].y) + ka0 * p1.y + ka1 * q1.y;
                vb[j].x = bf_lo(cb[j].x) + kb0 * r0.x + kb1 * t0.x; vb[j].y = bf_hi(cb[j].x) + kb0 * r0.y + kb1 * t0.y; vb[j].z = bf_lo(cb[j].y) + kb0 * r1.x + kb1 * t1.x; vb[j].w = bf_hi(cb[j].y) + kb0 * r1.y + kb1 * t1.y;
                sa += (va[j].x * va[j].x + va[j].y * va[j].y) + (va[j].z * va[j].z + va[j].w * va[j].w); sb += (vb[j].x * vb[j].x + vb[j].y * vb[j].y) + (vb[j].z * vb[j].z + vb[j].w * vb[j].w); }
            const float ra = __builtin_amdgcn_rsqf(wave_sum(sa) * (1.f / DM) + RMS_EPS), rb = __builtin_amdgcn_rsqf(wave_sum(sb) * (1.f / DM) + RMS_EPS);
            f32x4* oa = (f32x4*)(out + (size_t)ma * DM) + lane_; f32x4* ob = (f32x4*)(out + (size_t)mb * DM) + lane_;
#pragma unroll
            for (int j = 0; j < 4; ++j) { oa[64 * j] = va[j] * ra * gg[j]; ob[64 * j] = vb[j] * rb * gg[j]; }
        }
    }
#undef IN
#undef GRID_BAR
}

extern "C" void kernel_launch(void* const* d_in, const int* in_sizes, int n_in, void* d_out, int out_size, void* d_ws, size_t ws_size, hipStream_t stream) {
    static int grid = 0;
    if (grid == 0) {
        if (n_in != 28 || in_sizes[0] != M * DM || out_size != M * DM || ws_size < WS_END) { fprintf(stderr, "kernel_launch: unexpected shapes (n_in %d in0 %d out %d ws %zu)\n", n_in, n_in > 0 ? in_sizes[0] : -1, out_size, ws_size); grid = -1; return; }
        int dev = 0, cus = 0, per_cu = 0;
        if (hipGetDevice(&dev) != hipSuccess || hipDeviceGetAttribute(&cus, hipDeviceAttributeMultiprocessorCount, dev) != hipSuccess) { grid = -1; return; }
        if (hipFuncSetAttribute((const void*)mega, hipFuncAttributeMaxDynamicSharedMemorySize, LDS_BYTES) != hipSuccess) { fprintf(stderr, "kernel_launch: hipFuncSetAttribute failed\n"); grid = -1; return; }
        if (hipOccupancyMaxActiveBlocksPerMultiprocessor(&per_cu, (const void*)mega, NTHR, LDS_BYTES) != hipSuccess || per_cu < 1) { fprintf(stderr, "kernel_launch: occupancy query says %d\n", per_cu); per_cu = 1; }
        (void)hipGetLastError();
        grid = cus;
    }
    if (grid < 0) return;
    (void)hipMemsetAsync((char*)d_ws + WS_CTL, 0, CTL_BYTES, stream);
    Args a{};
    for (int i = 0; i < 28; ++i) a.in[i] = (const float*)d_in[i];
    a.out = (float*)d_out; a.ws = (unsigned char*)d_ws;
#if MK_ONE_LAUNCH
    a.ph_lo = 0; a.ph_hi = N_PHASES;
    void* kargs[] = {&a};
    hipError_t e = hipLaunchCooperativeKernel((const void*)mega, dim3(grid), dim3(NTHR), kargs, LDS_BYTES, stream);
    if (e != hipSuccess) fprintf(stderr, "cooperative launch failed: %s (grid %d)\n", hipGetErrorString(e), grid);
#else
    for (int p = 0; p < N_PHASES; ++p) { a.ph_lo = p; a.ph_hi = p + 1; hipLaunchKernelGGL(mega, dim3(grid), dim3(NTHR), LDS_BYTES, stream, a); }
#endif
}
```

```cpp
#include <hip/hip_runtime.h>
#include <hip/hip_cooperative_groups.h>
#include <cstdio>
#include <cstdint>
namespace cg = cooperative_groups;

#ifndef PROBE_DUP
#define PROBE_DUP -1
#endif
#ifndef PROBE_DUP_ATTN
#define PROBE_DUP_ATTN 1
#endif
#ifndef MK_ONE_LAUNCH
#define MK_ONE_LAUNCH 1
#endif

#define LAS __attribute__((address_space(3)))
#define GAS __attribute__((address_space(1)))
typedef unsigned short bf16_t;
typedef short bf16x8 __attribute__((ext_vector_type(8)));
typedef short s16x4 __attribute__((ext_vector_type(4)));
typedef float f32x2 __attribute__((ext_vector_type(2)));
typedef float f32x4 __attribute__((ext_vector_type(4)));
typedef float f32x16 __attribute__((ext_vector_type(16)));
typedef unsigned u32x2 __attribute__((ext_vector_type(2)));
typedef unsigned u32x4 __attribute__((ext_vector_type(4)));
typedef int v8i32 __attribute__((ext_vector_type(8)));

constexpr int NB = 8, SEQ = 8192, DM = 1024, M = NB * SEQ;
constexpr int ZP = 2560;
constexpr int ZU = 0, ZV = 512, ZQ = 1024, ZK = 1536, ZVAL = 2048;
constexpr int MEML = 256, MROWS = NB * MEML;
constexpr int NEXP = 32, DEXP = 512;
constexpr int PROWS = 2 * M + NEXP * 256;
constexpr int MAXBLK = PROWS / 256;
constexpr float RMS_EPS = 1e-6f, LN_EPS = 1e-5f;
constexpr float LOG2E = 1.4426950408889634f;
constexpr float C2_DIFF = 0.125f * LOG2E;
constexpr float C2_MEM = 0.0625f * LOG2E;

constexpr size_t MiB = 1u << 20;
constexpr size_t WS_CTL = 0, CTL_BYTES = 1 * MiB;
constexpr size_t WS_WIN = 1 * MiB;
constexpr size_t WS_WOUT = 6 * MiB;
constexpr size_t WS_WQ = 8 * MiB;
constexpr size_t WS_WKV = 10 * MiB;
constexpr size_t WS_WO = 14 * MiB;
constexpr size_t WS_WR = 16 * MiB;
constexpr size_t WS_WSGU = 17 * MiB;
constexpr size_t WS_MEMN = 18 * MiB;
constexpr size_t WS_KM = 22 * MiB;
constexpr size_t WS_VT = 26 * MiB;
constexpr size_t WS_WGU = 30 * MiB;
constexpr size_t WS_WD = 94 * MiB;
constexpr size_t WS_RA = 128 * MiB;
constexpr size_t WS_RB = 448 * MiB;
constexpr size_t WS_RC = 592 * MiB;
constexpr size_t WS_SSQ1 = 720 * MiB;
constexpr size_t WS_SSQ2 = 724 * MiB;
constexpr size_t WS_LOGIT = 728 * MiB;
constexpr size_t WS_TOKE = 744 * MiB;
constexpr size_t WS_TOKW = 745 * MiB;
constexpr size_t WS_TOKS = 746 * MiB;
constexpr size_t WS_ROWTOK = 747 * MiB;
constexpr size_t WS_X2F8 = 752 * MiB;
constexpr size_t WS_END = 816 * MiB;
constexpr int CW_CNT = 64;
constexpr int CW_NBLK = 128;
constexpr int CW_PSTART = 192;
constexpr int CW_BLKE = 256;
constexpr int CW_KMX = 1024;
constexpr int CW_SGUQ = 1344;
constexpr int CW_ALIST = 8192;
constexpr int CW_BAR = 4096;
constexpr int LDS_MISC = 131072;
constexpr int LDS_TBUF = 140288, TBUF_W = 2304;

__device__ __forceinline__ unsigned cvt_pk_bf16(float lo, float hi) { unsigned r; asm volatile("v_cvt_pk_bf16_f32 %0, %1, %2" : "=v"(r) : "v"(lo), "v"(hi)); return r; }
__device__ __forceinline__ float bf_lo(unsigned w) { return __uint_as_float(w << 16); }
__device__ __forceinline__ float bf_hi(unsigned w) { return __uint_as_float(w & 0xffff0000u); }
constexpr float F8_WSCALE = 256.f, F8_ASCALE = 8.f, F8_XSCALE = 4.f, F8_OSCALE = 16.f, F8_YSCALE = 16.f, F8_QSCALE = 64.f, F8_KSCALE = 16.f, F8_PSCALE = 256.f, F8_VSCALE = 16.f;
__device__ __forceinline__ unsigned pk4_fp8(float a, float b, float c, float d) {
    a = fminf(fmaxf(a, -448.f), 448.f); b = fminf(fmaxf(b, -448.f), 448.f); c = fminf(fmaxf(c, -448.f), 448.f); d = fminf(fmaxf(d, -448.f), 448.f);
    int w = 0; w = __builtin_amdgcn_cvt_pk_fp8_f32(a, b, w, false); w = __builtin_amdgcn_cvt_pk_fp8_f32(c, d, w, true); return (unsigned)w; }
__device__ __forceinline__ float wave_sum(float v) {
#pragma unroll
    for (int o = 1; o < 64; o <<= 1) v += __shfl_xor(v, o);
    return v;
}
__device__ __forceinline__ float wave_max(float v) {
#pragma unroll
    for (int o = 1; o < 64; o <<= 1) v = fmaxf(v, __shfl_xor(v, o));
    return v;
}
__device__ __forceinline__ int lane_id() { int l; asm volatile("v_mbcnt_lo_u32_b32 %0, -1, 0\n\tv_mbcnt_hi_u32_b32 %0, -1, %0" : "=v"(l)); return l; }
__device__ __forceinline__ unsigned ld_u32_agent(const unsigned* p) { return __hip_atomic_load(p, __ATOMIC_RELAXED, __HIP_MEMORY_SCOPE_AGENT); }

namespace pg8 {
constexpr int BM = 256, BK = 64, HALF = 128, HTB = HALF * BK * 2, STAGE_BYTES = 8 * HTB, NXCD = 8, WGM = 8;
__host__ __device__ __forceinline__ int lds_byte(int r, int c) { const int st = (r >> 4) * 2 + (c >> 5), rr = r & 15, cc = c & 31, ob = rr * 64 + cc * 2; return st * 1024 + (ob ^ (((ob >> 9) & 1) << 5)); }
__host__ __device__ __forceinline__ void stage_rc(int b, int& R, int& C) { const int st = b / 1024, sb = b % 1024, swz = sb ^ (((sb >> 9) & 1) << 5); R = (st >> 1) * 16 + swz / 64; C = (st & 1) * 32 + (swz % 64) / 2; }
__host__ __device__ __forceinline__ int perm32(int rho) { const int n = rho >> 4, i = rho & 15; return 8 * (i >> 2) + 4 * n + (i & 3); }

struct Unit { const char* A; const char* B; int pm, pn, aux; const int* rows; };
struct Gemm { int lda, ldb, K; };

struct TileOrder {
    int nM, nN, nwg, G, c;
    __device__ __forceinline__ void init(int nM_, int nN_, int G_, int c_) { nM = nM_; nN = nN_; nwg = nM * nN; G = G_; c = c_; }
    __device__ __forceinline__ bool get(int i, int& pm, int& pn) const {
        const long L = (long)i * G + c; if (L >= nwg) return false;
        int wgid = (int)L; { const int q = nwg / NXCD, r = nwg % NXCD, xcd = wgid % NXCD, off = wgid / NXCD; wgid = (xcd < r ? xcd * (q + 1) : r * (q + 1) + (xcd - r) * q) + off; }
        const int nig = WGM * nN, gid = wgid / nig, fm = gid * WGM, gsz = (nM - fm) < WGM ? (nM - fm) : WGM;
        pm = fm + ((wgid % nig) % gsz); pn = (wgid % nig) / gsz; return true;
    }
};

typedef float f32x2g __attribute__((ext_vector_type(2)));
__device__ __forceinline__ f32x2g gelu_pk(f32x2g v) {
    const f32x2g av = __builtin_elementwise_abs(v), d = av * 0.2316418882f + 1.0f;
    f32x2g t; t.x = __builtin_amdgcn_rcpf(d.x); t.y = __builtin_amdgcn_rcpf(d.y);
    f32x2g q = t * 0.5307027145f + (-0.7265760135f); q = q * t + 0.7107068705f; q = q * t + (-0.142248368f); q = q * t + 0.127414796f; q = q * t;
    const f32x2g s = (v * v) * (-0.72134752044f);
    f32x2g e; e.x = __builtin_amdgcn_exp2f(s.x); e.y = __builtin_amdgcn_exp2f(s.y);
    const f32x2g m = v * (q * e), r = v - m;
    f32x2g o; o.x = v.x < 0.f ? m.x : r.x; o.y = v.y < 0.f ? m.y : r.y; return o;
}

__device__ __forceinline__ const char* uniform_ptr(const char* p) { const unsigned long long v = (unsigned long long)p; const unsigned lo = __builtin_amdgcn_readfirstlane((unsigned)v), hi = __builtin_amdgcn_readfirstlane((unsigned)(v >> 32)); return (const char*)(((unsigned long long)hi << 32) | lo); }
template <class Epi, class Sched, bool GATHER = false, bool FP8 = false>
__device__ __forceinline__ void gemm_phase(LAS unsigned char* lds, int wid, const Gemm g, const Sched& S, const Epi& E) {
    const int lane = lane_id(), tid = wid * 64 + lane, wr = wid >> 2, wc = wid & 3, fr = lane & 15, fq = lane >> 4;
    const int nt = g.K / BK;
    unsigned voffB[2]; unsigned vA0[2], vA1[2]; int RA[2], CA[2];
#pragma unroll
    for (int i = 0; i < 2; ++i) { int R, C; stage_rc(tid * 16 + i * 8192, R, C); const int pr = Epi::PERM ? perm32(R & 31) : (R & 31);
        RA[i] = R; CA[i] = C; voffB[i] = (unsigned)((64 * (R >> 5) + pr) * g.ldb + C) * 2u;
        vA0[i] = (unsigned)(R * g.lda + C) * 2u; vA1[i] = vA0[i]; }
    const size_t kstep = (size_t)(BK * 2);
    const size_t hstepA = GATHER ? (size_t)0 : (size_t)HALF * g.lda * 2, hstepB = (size_t)32 * g.ldb * 2;
    LAS u32x4* park = (LAS u32x4*)(lds + 131072 + 1024) + tid;
#define PG8_GOFF(U, d0, d1) do { _Pragma("unroll") for (int _i = 0; _i < 2; ++_i) { \
        d0[_i] = ((unsigned)(U).rows[RA[_i]] * (unsigned)g.lda + (unsigned)CA[_i]) * 2u; d1[_i] = ((unsigned)(U).rows[HALF + RA[_i]] * (unsigned)g.lda + (unsigned)CA[_i]) * 2u; } } while (0)
    const unsigned ldsw = (unsigned)wid * 1024u;
    const int aoff = lds_byte(wr * 64 + fr, fq * 8), boff = lds_byte(wc * 32 + fr, fq * 8);
#define PG8_SA(b, h) (((b) * 2 + (h)) * HTB)
#define PG8_SB(b, h) ((4 + (b) * 2 + (h)) * HTB)
#define PG8_STAGE(bufoff, gbase, voff) do { _Pragma("unroll") for (int _i = 0; _i < 2; ++_i) \
        __builtin_amdgcn_global_load_lds((const unsigned*)((const char*)(gbase) + (voff)[_i]), (LAS unsigned*)(lds + (bufoff) + ldsw + _i * 8192), 16, 0, 0); } while (0)
#define PG8_LD8(dst_, addr_) do { const u32x4 lo_ = *(const LAS u32x4*)(addr_), hi_ = *(const LAS u32x4*)((addr_) + 1024); \
        dst_ = (v8i32){(int)lo_.x, (int)lo_.y, (int)lo_.z, (int)lo_.w, (int)hi_.x, (int)hi_.y, (int)hi_.z, (int)hi_.w}; } while (0)
#define PG8_LDA(dst, b, h) do { _Pragma("unroll") for (int m = 0; m < 4; ++m) PG8_LD8(dst[m], lds + PG8_SA(b, h) + aoff + m * 2048); } while (0)
#define PG8_LDB(dst, b, h) do { _Pragma("unroll") for (int n = 0; n < 2; ++n) PG8_LD8(dst[n], lds + PG8_SB(b, h) + boff + n * 2048); } while (0)
#define PG8_HALF(v_, k_) __builtin_bit_cast(bf16x8, __builtin_shufflevector(v_, v_, 4 * (k_) + 0, 4 * (k_) + 1, 4 * (k_) + 2, 4 * (k_) + 3))
#define PG8_MMA(ai, bj, At, Bt) do { __builtin_amdgcn_s_setprio(1); _Pragma("unroll") for (int m = 0; m < 4; ++m) _Pragma("unroll") for (int n = 0; n < 2; ++n) { \
        if constexpr (FP8) asm volatile("v_mfma_scale_f32_16x16x128_f8f6f4 %0, %1, %2, %0, %3, %3 op_sel_hi:[0,0,0]" : "+v"(acc[ai][bj][m][n]) : "v"(Bt[n]), "v"(At[m]), "v"(one8_));   \
        else { acc[ai][bj][m][n] = __builtin_amdgcn_mfma_f32_16x16x32_bf16(PG8_HALF(Bt[n], 0), PG8_HALF(At[m], 0), acc[ai][bj][m][n], 0, 0, 0); \
               acc[ai][bj][m][n] = __builtin_amdgcn_mfma_f32_16x16x32_bf16(PG8_HALF(Bt[n], 1), PG8_HALF(At[m], 1), acc[ai][bj][m][n], 0, 0, 0); } } \
        __builtin_amdgcn_s_setprio(0); } while (0)
#define PG8_WAIT_V(n) asm volatile("s_waitcnt vmcnt(" #n ")" ::: "memory")
#define PG8_WAIT_L(n) asm volatile("s_waitcnt lgkmcnt(" #n ")" ::: "memory")
#define PG8_BAR __builtin_amdgcn_s_barrier()
#define PG8_SCHED __builtin_amdgcn_sched_barrier(0)
    Unit cur, nxt; int ui = 0;
    if (!S.next(0, cur)) return;
    f32x4 acc[2][2][4][2];
#pragma unroll
    for (int a = 0; a < 2; ++a)
#pragma unroll
        for (int b = 0; b < 2; ++b)
#pragma unroll
            for (int m = 0; m < 4; ++m)
#pragma unroll
                for (int n = 0; n < 2; ++n) acc[a][b][m][n] = (f32x4){0.f, 0.f, 0.f, 0.f};
    v8i32 At[4], B0[2], B1[2];
    const int one8_ = 0x7f7f7f7f;
    const char* cA = uniform_ptr(cur.A); const char* cB = uniform_ptr(cur.B);
    if constexpr (GATHER) { PG8_GOFF(cur, vA0, vA1); }
    PG8_STAGE(PG8_SB(0, 0), cB, voffB); PG8_STAGE(PG8_SB(0, 1), cB + hstepB, voffB); PG8_STAGE(PG8_SA(0, 0), cA, vA0); PG8_STAGE(PG8_SA(0, 1), cA + hstepA, vA1);
    if (wr == 1) PG8_BAR;
    PG8_WAIT_V(2); PG8_BAR;
    PG8_STAGE(PG8_SB(1, 0), cB + kstep, voffB); PG8_STAGE(PG8_SA(1, 0), cA + kstep, vA0); PG8_STAGE(PG8_SB(1, 1), cB + hstepB + kstep, voffB);
    PG8_WAIT_V(6); PG8_BAR;
    for (;;) {
        const bool has_next = S.next(ui + 1, nxt);
        const char* nA = has_next ? uniform_ptr(nxt.A) : cA; const char* nB = has_next ? uniform_ptr(nxt.B) : cB;
        if constexpr (GATHER) { unsigned n0[2] = {vA0[0], vA0[1]}, n1[2] = {vA1[0], vA1[1]}; if (has_next) { PG8_GOFF(nxt, n0, n1); } *park = (u32x4){n0[0], n0[1], n1[0], n1[1]}; }
#pragma nounroll
        for (int t = 0; t < nt; t += 2) {
            const bool last = (t == nt - 2);
            const char* a1 = cA + (size_t)(t + 1) * kstep;
            const char* a2 = uniform_ptr(last ? nA : cA + (size_t)(t + 2) * kstep); const char* b2 = uniform_ptr(last ? nB : cB + (size_t)(t + 2) * kstep);
            const char* a3 = a2 + kstep; const char* b3 = b2 + kstep;
            unsigned w0[2] = {vA0[0], vA0[1]}, w1[2] = {vA1[0], vA1[1]};
            if constexpr (GATHER) { if (last) { const u32x4 pk = *park; w0[0] = pk.x; w0[1] = pk.y; w1[0] = pk.z; w1[1] = pk.w; } }
            PG8_LDB(B0, 0, 0); PG8_LDB(B1, 0, 1); PG8_SCHED; PG8_LDA(At, 0, 0); PG8_STAGE(PG8_SA(1, 1), a1 + hstepA, vA1);
            PG8_WAIT_V(8); PG8_WAIT_L(0); PG8_BAR; PG8_MMA(0, 0, At, B0); PG8_MMA(0, 1, At, B1); PG8_BAR; PG8_SCHED;
            PG8_LDA(At, 0, 1); PG8_STAGE(PG8_SB(0, 0), b2, voffB); PG8_STAGE(PG8_SB(0, 1), b2 + hstepB, voffB); PG8_STAGE(PG8_SA(0, 0), a2, w0);
            PG8_WAIT_V(8); PG8_WAIT_L(0); PG8_BAR; PG8_MMA(1, 0, At, B0); PG8_MMA(1, 1, At, B1); PG8_BAR; PG8_SCHED;
            PG8_LDB(B0, 1, 0); PG8_LDB(B1, 1, 1); PG8_SCHED; PG8_LDA(At, 1, 0); PG8_STAGE(PG8_SA(0, 1), a2 + hstepA, w1);
            PG8_WAIT_V(8); PG8_WAIT_L(0); PG8_BAR; PG8_MMA(0, 0, At, B0); PG8_MMA(0, 1, At, B1); PG8_BAR; PG8_SCHED;
            PG8_LDA(At, 1, 1); PG8_STAGE(PG8_SB(1, 0), b3, voffB); PG8_STAGE(PG8_SB(1, 1), b3 + hstepB, voffB); PG8_STAGE(PG8_SA(1, 0), a3, w0);
            PG8_WAIT_V(8); PG8_WAIT_L(0); PG8_BAR; PG8_MMA(1, 0, At, B0); PG8_MMA(1, 1, At, B1); PG8_BAR; PG8_SCHED;
        }
        if (wr == 0) PG8_BAR;
        if constexpr (FP8) asm volatile("s_nop 15\n\ts_nop 7" ::: "memory");
        asm volatile("" ::: "memory");
        { const int l2_ = lane_id(); E(acc, cur, wr, wc, l2_ & 15, l2_ >> 4, lds + LDS_TBUF + wid * TBUF_W); }
        if (!has_next) break;
#pragma unroll
        for (int a = 0; a < 2; ++a)
#pragma unroll
            for (int b = 0; b < 2; ++b)
#pragma unroll
                for (int m = 0; m < 4; ++m)
#pragma unroll
                    for (int n = 0; n < 2; ++n) acc[a][b][m][n] = (f32x4){0.f, 0.f, 0.f, 0.f};
        cur = nxt; cA = nA; cB = nB; ++ui;
        if constexpr (GATHER) { const u32x4 pk = *park; vA0[0] = pk.x; vA0[1] = pk.y; vA1[0] = pk.z; vA1[1] = pk.w; }
        if (wr == 1) PG8_BAR;
    }
    PG8_WAIT_V(0);
    PG8_BAR;
#undef PG8_GOFF
#undef PG8_SA
#undef PG8_SB
#undef PG8_STAGE
#undef PG8_LD8
#undef PG8_HALF
#undef PG8_LDA
#undef PG8_LDB
#undef PG8_MMA
#undef PG8_WAIT_V
#undef PG8_WAIT_L
#undef PG8_BAR
#undef PG8_SCHED
}

struct PlainSched {
    TileOrder to; const char* A; const char* B; size_t tA, tB;
    __device__ __forceinline__ bool next(int i, Unit& u) const { int pm, pn; if (!to.get(i, pm, pn)) return false; u.pm = pm; u.pn = pn; u.aux = 0; u.rows = nullptr; u.A = A + (size_t)pm * tA; u.B = B + (size_t)pn * tB; return true; }
};
struct OneUnitSched {
    Unit u0;
    __device__ __forceinline__ bool next(int i, Unit& u) const { if (i != 0) return false; u = u0; return true; }
};
struct MemAttnSched {
    TileOrder to; const char* A; const char* B; size_t tA, hA, bB, hB;
    __device__ __forceinline__ bool next(int i, Unit& u) const { int pm, pn; if (!to.get(i, pm, pn)) return false; u.pm = pm; u.pn = pn; u.aux = 0; u.rows = nullptr;
        u.A = A + (size_t)pm * tA + (size_t)pn * hA; const int b = pm >> 5; u.B = B + (size_t)b * bB + (size_t)pn * hB; return true; }
};
struct MoeSched {
    int G, c, nblk; const unsigned* blk_e; const char* A; const char* B; size_t tA, eB, tB; const int* row_tok;
    __device__ __forceinline__ bool next(int i, Unit& u) const { const int L = i * G + c; if (L >= nblk * 4) return false; const int rb = L >> 2, pn = L & 3;
        const int e = (int)__builtin_amdgcn_readfirstlane(ld_u32_agent(blk_e + rb)); u.pm = rb; u.pn = pn; u.aux = e; u.rows = row_tok + (size_t)rb * 256;
        u.A = A + (size_t)rb * tA; u.B = B + (size_t)e * eB + (size_t)pn * tB; return true; }
};

#define EPI_ARGS f32x4 (&acc)[2][2][4][2], const Unit& u, int wr, int wc, int fr, int fq, LAS unsigned char* tb
__device__ __forceinline__ void st128(bf16_t* rowbase, size_t ldc, const u32x4 w0, const u32x4 w1, int fr, int fq, LAS unsigned char* tb) {
    *(LAS u32x4*)(tb + fr * 144 + fq * 16) = w0; *(LAS u32x4*)(tb + fr * 144 + 64 + fq * 16) = w1;
    const int L = fq * 16 + fr, r = L >> 3, c = L & 7;
    const u32x4 a = *(const LAS u32x4*)(tb + r * 144 + c * 16), b = *(const LAS u32x4*)(tb + (8 + r) * 144 + c * 16);
    *(u32x4*)(rowbase + (size_t)r * ldc + c * 8) = a; *(u32x4*)(rowbase + (size_t)(8 + r) * ldc + c * 8) = b;
}
__device__ __forceinline__ u32x4 pk8(const f32x4 v0, const f32x4 v1) { u32x4 w; w.x = cvt_pk_bf16(v0[0], v0[1]); w.y = cvt_pk_bf16(v0[2], v0[3]); w.z = cvt_pk_bf16(v1[0], v1[1]); w.w = cvt_pk_bf16(v1[2], v1[3]); return w; }
struct EpiZ {
    static constexpr bool PERM = true;
    bf16_t* O; unsigned* kmx;
    __device__ __forceinline__ void operator()(EPI_ARGS) const {
        const int mode = u.pn < 4 ? 1 : (u.pn < 6 ? 2 : 0);
        if (u.pn == 6 || u.pn == 7) {
#pragma unroll
            for (int bj = 0; bj < 2; ++bj) { float mx = 0.f;
#pragma unroll
                for (int ai = 0; ai < 2; ++ai)
#pragma unroll
                    for (int m = 0; m < 4; ++m) { const f32x4 a = acc[ai][bj][m][0], b = acc[ai][bj][m][1];
                        float q = (a[0] * a[0] + a[1] * a[1]) + (a[2] * a[2] + a[3] * a[3]) + (b[0] * b[0] + b[1] * b[1]) + (b[2] * b[2] + b[3] * b[3]);
                        q += __shfl_xor(q, 16); q += __shfl_xor(q, 32); mx = fmaxf(mx, q); }
#pragma unroll
                for (int o_ = 1; o_ < 16; o_ <<= 1) mx = fmaxf(mx, __shfl_xor(mx, o_));
                if (fr == 0 && fq == 0) { const int b_ = u.pm >> 5, h_ = (u.pn - 6) * 2 + (wc >> 1); atomicMax(kmx + (((b_ * 4 + h_) * 2 + (wc & 1)) * 2 + bj), __float_as_uint(mx)); } }
        }
#pragma unroll
        for (int ai = 0; ai < 2; ++ai)
#pragma unroll
            for (int m = 0; m < 4; ++m) { u32x4 w[2];
#pragma unroll
                for (int bj = 0; bj < 2; ++bj) { f32x4 v0 = acc[ai][bj][m][0], v1 = acc[ai][bj][m][1];
                    if (mode == 1) { f32x2g a = gelu_pk((f32x2g){v0[0], v0[1]}), b = gelu_pk((f32x2g){v0[2], v0[3]}), c = gelu_pk((f32x2g){v1[0], v1[1]}), d = gelu_pk((f32x2g){v1[2], v1[3]});
                        v0 = (f32x4){a.x, a.y, b.x, b.y}; v1 = (f32x4){c.x, c.y, d.x, d.y}; }
                    else if (mode == 2) { v0 = v0 * C2_DIFF; v1 = v1 * C2_DIFF; }
                    w[bj] = pk8(v0, v1); }
                st128(O + (size_t)(u.pm * BM + ai * HALF + wr * 64 + m * 16) * ZP + u.pn * BM + wc * 64, ZP, w[0], w[1], fr, fq, tb); }
    }
};
struct EpiBf16 {
    static constexpr bool PERM = true;
    bf16_t* O; int ldc; const float* ssq; float cscale;
    __device__ __forceinline__ void operator()(EPI_ARGS) const {
        float sc[2][4];
#pragma unroll
        for (int ai = 0; ai < 2; ++ai)
#pragma unroll
            for (int m = 0; m < 4; ++m) sc[ai][m] = cscale;
        if (ssq) {
#pragma unroll
            for (int ai = 0; ai < 2; ++ai)
#pragma unroll
                for (int m = 0; m < 4; ++m) { const f32x4 s4 = *(const f32x4*)(ssq + (size_t)(u.pm * BM + ai * HALF + wr * 64 + m * 16 + fr) * 4);
                    sc[ai][m] = cscale * __builtin_amdgcn_rsqf(((s4[0] + s4[1]) + (s4[2] + s4[3])) * (1.0f / DM) + RMS_EPS); }
        }
#pragma unroll
        for (int ai = 0; ai < 2; ++ai)
#pragma unroll
            for (int m = 0; m < 4; ++m) { const int rowg = u.pm * BM + ai * HALF + wr * 64 + m * 16; const float c = sc[ai][m];
                st128(O + (size_t)rowg * ldc + u.pn * BM + wc * 64, (size_t)ldc, pk8(acc[ai][0][m][0] * c, acc[ai][0][m][1] * c), pk8(acc[ai][1][m][0] * c, acc[ai][1][m][1] * c), fr, fq, tb); }
    }
};
struct EpiF8 {
    static constexpr bool PERM = true;
    unsigned char* O; int ldc; const float* ssq; float cscale;
    __device__ __forceinline__ void operator()(EPI_ARGS) const {
        const int L = fq * 16 + fr;
        float sc[2][4];
#pragma unroll
        for (int ai = 0; ai < 2; ++ai)
#pragma unroll
            for (int m = 0; m < 4; ++m) sc[ai][m] = cscale;
        if (ssq) {
#pragma unroll
            for (int ai = 0; ai < 2; ++ai)
#pragma unroll
                for (int m = 0; m < 4; ++m) { const f32x4 s4 = *(const f32x4*)(ssq + (size_t)(u.pm * BM + ai * HALF + wr * 64 + m * 16 + fr) * 4);
                    sc[ai][m] = cscale * __builtin_amdgcn_rsqf(((s4[0] + s4[1]) + (s4[2] + s4[3])) * (1.0f / DM) + RMS_EPS); }
        }
#pragma unroll
        for (int ai = 0; ai < 2; ++ai)
#pragma unroll
            for (int m = 0; m < 4; ++m) { const int rowg = u.pm * BM + ai * HALF + wr * 64 + m * 16; const float c = sc[ai][m];
#pragma unroll
                for (int bj = 0; bj < 2; ++bj) { const f32x4 a = acc[ai][bj][m][0] * c, b = acc[ai][bj][m][1] * c; u32x2 f; f.x = pk4_fp8(a[0], a[1], a[2], a[3]); f.y = pk4_fp8(b[0], b[1], b[2], b[3]);
                    *(LAS u32x2*)(tb + fr * 144 + bj * 32 + fq * 8) = f; }
                const u32x4 v8 = *(const LAS u32x4*)(tb + (L >> 2) * 144 + (L & 3) * 16);
                *(u32x4*)(O + (size_t)(rowg + (L >> 2)) * ldc + u.pn * BM + wc * 64 + (L & 3) * 16) = v8; }
    }
};
struct EpiSoftmax {
    static constexpr bool PERM = true;
    unsigned char* O; LAS float* xch; float sscale;
    __device__ __forceinline__ void operator()(EPI_ARGS) const {
        LAS float* xm = xch; LAS float* xs = xch + 1024;
#pragma unroll
        for (int ai = 0; ai < 2; ++ai)
#pragma unroll
            for (int bj = 0; bj < 2; ++bj)
#pragma unroll
                for (int m = 0; m < 4; ++m)
#pragma unroll
                    for (int n = 0; n < 2; ++n) acc[ai][bj][m][n] = acc[ai][bj][m][n] * sscale;
#pragma unroll
        for (int ai = 0; ai < 2; ++ai)
#pragma unroll
            for (int m = 0; m < 4; ++m) { float v = -__builtin_inff();
#pragma unroll
                for (int bj = 0; bj < 2; ++bj)
#pragma unroll
                    for (int n = 0; n < 2; ++n) { const f32x4 a = acc[ai][bj][m][n]; v = fmaxf(v, fmaxf(fmaxf(a[0], a[1]), fmaxf(a[2], a[3]))); }
                v = fmaxf(v, __shfl_xor(v, 16)); v = fmaxf(v, __shfl_xor(v, 32));
                if (fq == 0) xm[(ai * HALF + wr * 64 + m * 16 + fr) * 4 + wc] = v; }
        asm volatile("s_waitcnt lgkmcnt(0)" ::: "memory"); __builtin_amdgcn_s_barrier(); asm volatile("" ::: "memory");
#pragma unroll
        for (int ai = 0; ai < 2; ++ai)
#pragma unroll
            for (int m = 0; m < 4; ++m) { const f32x4 t = *(const LAS f32x4*)(xm + (ai * HALF + wr * 64 + m * 16 + fr) * 4); const float mx = fmaxf(fmaxf(t[0], t[1]), fmaxf(t[2], t[3])); float sm = 0.f;
#pragma unroll
                for (int bj = 0; bj < 2; ++bj)
#pragma unroll
                    for (int n = 0; n < 2; ++n) { f32x4 a = acc[ai][bj][m][n];
#pragma unroll
                        for (int j = 0; j < 4; ++j) { a[j] = __builtin_amdgcn_exp2f(a[j] - mx); sm += a[j]; }
                        acc[ai][bj][m][n] = a; }
                sm += __shfl_xor(sm, 16); sm += __shfl_xor(sm, 32);
                if (fq == 0) xs[(ai * HALF + wr * 64 + m * 16 + fr) * 4 + wc] = sm; }
        asm volatile("s_waitcnt lgkmcnt(0)" ::: "memory"); __builtin_amdgcn_s_barrier(); asm volatile("" ::: "memory");
#pragma unroll
        for (int ai = 0; ai < 2; ++ai)
#pragma unroll
            for (int m = 0; m < 4; ++m) { const f32x4 t = *(const LAS f32x4*)(xs + (ai * HALF + wr * 64 + m * 16 + fr) * 4); const float inv = F8_PSCALE * __builtin_amdgcn_rcpf((t[0] + t[1]) + (t[2] + t[3]));
                const int rowg = u.pm * BM + ai * HALF + wr * 64 + m * 16, L = fq * 16 + fr;
#pragma unroll
                for (int bj = 0; bj < 2; ++bj) { const f32x4 a = acc[ai][bj][m][0] * inv, b = acc[ai][bj][m][1] * inv; u32x2 f; f.x = pk4_fp8(a[0], a[1], a[2], a[3]); f.y = pk4_fp8(b[0], b[1], b[2], b[3]);
                    *(LAS u32x2*)(tb + fr * 144 + bj * 32 + fq * 8) = f; }
                const u32x4 v8 = *(const LAS u32x4*)(tb + (L >> 2) * 144 + (L & 3) * 16);
                *(u32x4*)(O + (size_t)(rowg + (L >> 2)) * DM + u.pn * BM + wc * 64 + (L & 3) * 16) = v8; }
    }
};
template <bool BF>
struct EpiResid {
    static constexpr bool PERM = true;
    const void* base; bf16_t* ob; float* ssq; LAS float* xs; unsigned char* o8; float as;
    __device__ __forceinline__ void operator()(EPI_ARGS) const {
        const int col0 = u.pn * BM + wc * 64 + 8 * fq;
        if constexpr (BF) {
            u32x4 br[2][4][2];
#pragma unroll
            for (int ai = 0; ai < 2; ++ai)
#pragma unroll
                for (int m = 0; m < 4; ++m)
#pragma unroll
                    for (int bj = 0; bj < 2; ++bj) br[ai][m][bj] = *(const u32x4*)((const bf16_t*)base + (size_t)(u.pm * BM + ai * HALF + wr * 64 + m * 16 + fr) * DM + col0 + bj * 32);
#pragma unroll
            for (int ai = 0; ai < 2; ++ai)
#pragma unroll
                for (int m = 0; m < 4; ++m) asm volatile("" : "+v"(br[ai][m][0]), "+v"(br[ai][m][1]));
#pragma unroll
            for (int ai = 0; ai < 2; ++ai)
#pragma unroll
                for (int m = 0; m < 4; ++m) { const int rowg = u.pm * BM + ai * HALF + wr * 64 + m * 16, row = rowg + fr; float s = 0.f; u32x4 w[2]; u32x2 f8[2];
#pragma unroll
                    for (int bj = 0; bj < 2; ++bj) { const u32x4 r = br[ai][m][bj];
                        const f32x4 o0 = (f32x4){bf_lo(r.x), bf_hi(r.x), bf_lo(r.y), bf_hi(r.y)} + acc[ai][bj][m][0] * as, o1 = (f32x4){bf_lo(r.z), bf_hi(r.z), bf_lo(r.w), bf_hi(r.w)} + acc[ai][bj][m][1] * as;
                        s += (o0[0] * o0[0] + o0[1] * o0[1]) + (o0[2] * o0[2] + o0[3] * o0[3]) + (o1[0] * o1[0] + o1[1] * o1[1]) + (o1[2] * o1[2] + o1[3] * o1[3]);
                        w[bj] = pk8(o0, o1);
                        f8[bj].x = pk4_fp8(o0[0] * F8_XSCALE, o0[1] * F8_XSCALE, o0[2] * F8_XSCALE, o0[3] * F8_XSCALE); f8[bj].y = pk4_fp8(o1[0] * F8_XSCALE, o1[1] * F8_XSCALE, o1[2] * F8_XSCALE, o1[3] * F8_XSCALE); }
                    st128(ob + (size_t)rowg * DM + u.pn * BM + wc * 64, (size_t)DM, w[0], w[1], fr, fq, tb);
                    if (o8) {
                        *(LAS u32x2*)(tb + fr * 144 + fq * 8) = f8[0]; *(LAS u32x2*)(tb + fr * 144 + 32 + fq * 8) = f8[1];
                        const int L = fq * 16 + fr; const u32x4 v8 = *(const LAS u32x4*)(tb + (L >> 2) * 144 + (L & 3) * 16);
                        *(u32x4*)(o8 + (size_t)(rowg + (L >> 2)) * DM + u.pn * BM + wc * 64 + (L & 3) * 16) = v8; }
                    s += __shfl_xor(s, 16); s += __shfl_xor(s, 32);
                    if (fq == 0) xs[(ai * HALF + wr * 64 + m * 16 + fr) * 4 + wc] = s; }
        } else {
#pragma unroll
            for (int ai = 0; ai < 2; ++ai) {
                f32x4 br[4][2][2];
#pragma unroll
                for (int m = 0; m < 4; ++m)
#pragma unroll
                    for (int bj = 0; bj < 2; ++bj) { const float* p = (const float*)base + (size_t)(u.pm * BM + ai * HALF + wr * 64 + m * 16 + fr) * DM + col0 + bj * 32; br[m][bj][0] = *(const f32x4*)p; br[m][bj][1] = *(const f32x4*)(p + 4); }
#pragma unroll
                for (int m = 0; m < 4; ++m) asm volatile("" : "+v"(br[m][0][0]), "+v"(br[m][0][1]), "+v"(br[m][1][0]), "+v"(br[m][1][1]));
#pragma unroll
                for (int m = 0; m < 4; ++m) { const int rowg = u.pm * BM + ai * HALF + wr * 64 + m * 16; float s = 0.f; u32x4 w[2]; u32x2 f8[2];
#pragma unroll
                    for (int bj = 0; bj < 2; ++bj) { const f32x4 o0 = br[m][bj][0] + acc[ai][bj][m][0] * as, o1 = br[m][bj][1] + acc[ai][bj][m][1] * as;
                        s += (o0[0] * o0[0] + o0[1] * o0[1]) + (o0[2] * o0[2] + o0[3] * o0[3]) + (o1[0] * o1[0] + o1[1] * o1[1]) + (o1[2] * o1[2] + o1[3] * o1[3]);
                        w[bj] = pk8(o0, o1);
                        f8[bj].x = pk4_fp8(o0[0] * F8_XSCALE, o0[1] * F8_XSCALE, o0[2] * F8_XSCALE, o0[3] * F8_XSCALE); f8[bj].y = pk4_fp8(o1[0] * F8_XSCALE, o1[1] * F8_XSCALE, o1[2] * F8_XSCALE, o1[3] * F8_XSCALE); }
                    st128(ob + (size_t)rowg * DM + u.pn * BM + wc * 64, (size_t)DM, w[0], w[1], fr, fq, tb);
                    if (o8) {
                        *(LAS u32x2*)(tb + fr * 144 + fq * 8) = f8[0]; *(LAS u32x2*)(tb + fr * 144 + 32 + fq * 8) = f8[1];
                        const int L = fq * 16 + fr; const u32x4 v8 = *(const LAS u32x4*)(tb + (L >> 2) * 144 + (L & 3) * 16);
                        *(u32x4*)(o8 + (size_t)(rowg + (L >> 2)) * DM + u.pn * BM + wc * 64 + (L & 3) * 16) = v8; }
                    s += __shfl_xor(s, 16); s += __shfl_xor(s, 32);
                    if (fq == 0) xs[(ai * HALF + wr * 64 + m * 16 + fr) * 4 + wc] = s; }
            }
        }
        asm volatile("s_waitcnt lgkmcnt(0)" ::: "memory"); __builtin_amdgcn_s_barrier(); asm volatile("" ::: "memory");
        { const int t_ = (wr * 4 + wc) * 64 + fq * 16 + fr;
          if (t_ < 256) { const f32x4 p = *(const LAS f32x4*)(xs + t_ * 4); ssq[(size_t)(u.pm * BM + t_) * 4 + u.pn] = (p[0] + p[1]) + (p[2] + p[3]); } }
    }
};
struct EpiRouter {
    static constexpr bool PERM = false;
    float* L; const float* ssq; const float* bg; const float* be; float* rstd_out;
    __device__ __forceinline__ void operator()(EPI_ARGS) const {
        if (wc != 0) return;
        const int row0 = u.pm * BM + wr * 64 + fr;
        float rsv[2][4];
#pragma unroll
        for (int ai = 0; ai < 2; ++ai)
#pragma unroll
            for (int m = 0; m < 4; ++m) { const f32x4 s4 = *(const f32x4*)(ssq + (size_t)(row0 + ai * HALF + m * 16) * 4);
                rsv[ai][m] = __builtin_amdgcn_rsqf(((s4[0] + s4[1]) + (s4[2] + s4[3])) * (1.0f / DM) + RMS_EPS); }
#pragma unroll
        for (int ai = 0; ai < 2; ++ai)
#pragma unroll
            for (int m = 0; m < 4; ++m) { const int row = row0 + ai * HALF + m * 16; const float rs = rsv[ai][m];
                if (fq == 0) rstd_out[row] = rs;
#pragma unroll
                for (int bj = 0; bj < 2; ++bj)
#pragma unroll
                    for (int n = 0; n < 2; ++n) { const int c0 = bj * 32 + n * 16 + 4 * fq; f32x4 o = acc[ai][bj][m][n] * rs;
#pragma unroll
                        for (int j = 0; j < 4; ++j) { const int c = c0 + j; const float b = c < 4 ? bg[c] : (c < 36 ? be[c - 4] : 0.f); o[j] += b; }
                        *(f32x4*)(L + (size_t)row * 64 + c0) = o; } }
    }
};
struct EpiGateUp {
    static constexpr bool PERM = true;
    unsigned char* act; const float* rstd; const int* row_tok;
    __device__ __forceinline__ void operator()(EPI_ARGS) const {
        const int row0 = u.pm * BM + wr * 64 + fr, col0 = u.pn * 128 + wc * 32 + 8 * fq;
        float rsv[2][4];
#pragma unroll
        for (int ai = 0; ai < 2; ++ai)
#pragma unroll
            for (int m = 0; m < 4; ++m) rsv[ai][m] = rstd[row0 + ai * HALF + m * 16];
#pragma unroll
        for (int ai = 0; ai < 2; ++ai)
#pragma unroll
            for (int m = 0; m < 4; ++m) { const int row = row0 + ai * HALF + m * 16; const float rs = rsv[ai][m];
                float r[8];
#pragma unroll
                for (int n = 0; n < 2; ++n)
#pragma unroll
                    for (int j = 0; j < 4; ++j) { const float gg = acc[ai][0][m][n][j] * rs, uu = acc[ai][1][m][n][j] * rs;
                        r[n * 4 + j] = gg * __builtin_amdgcn_rcpf(1.0f + __builtin_amdgcn_exp2f(-gg * LOG2E)) * uu; }
                u32x2 w; w.x = pk4_fp8(r[0] * F8_ASCALE, r[1] * F8_ASCALE, r[2] * F8_ASCALE, r[3] * F8_ASCALE); w.y = pk4_fp8(r[4] * F8_ASCALE, r[5] * F8_ASCALE, r[6] * F8_ASCALE, r[7] * F8_ASCALE);
                *(u32x2*)(act + (size_t)row * DEXP + col0) = w; }
    }
};
}

namespace da {
constexpr int NW = 8, QBLK = 32, KVBLK = 64, QB = NW * QBLK, DV = 128;
constexpr int SHM_V = KVBLK * DV * 2, SHM_K = KVBLK * 64 * 2;
constexpr int LDS_V = 0, LDS_K = 2 * SHM_V, LDS_WS = LDS_K + 2 * SHM_K, LDS_CX = LDS_WS + NW * 64 * 4, LDS_STASH = LDS_CX + 256, LDS_BYTES = LDS_STASH + NW * 8192;
constexpr float SKIP_MARGIN = 40.f;
constexpr float THR = 8.f;
#define SBAR() __builtin_amdgcn_sched_barrier(0)
__device__ __forceinline__ int kswz(int row, int chunk) { return row * 128 + ((chunk ^ ((row >> 1) & 7)) << 4); }
__device__ __forceinline__ int v_st(int k, int c) { const int kk = (k & ~0xC) | ((k & 4) << 1) | ((k & 8) >> 1); return ((kk >> 3) * 4 + (c >> 5)) * 512 + ((kk & 7) * 32 + (c & 31)) * 2; }
__device__ __forceinline__ int v_rd_base(int lane) { return ((lane & 3) << 3) | (((lane >> 2) & 3) << 6) | (((lane >> 4) & 1) << 5) | (((lane >> 5) & 1) << 8); }
constexpr int v_rd_off(int d0, int ks, int half) { return d0 * 512 + ks * 4096 + half * 2048; }
__device__ __forceinline__ int crow(int r, int hi) { return (r & 3) + 8 * (r >> 2) + 4 * hi; }
__device__ __forceinline__ bf16x8 load8(const bf16_t* p) { return *reinterpret_cast<const bf16x8*>(p); }

__device__ __forceinline__ void mask_tile(f32x16& p0, f32x16& p1, int dq) {
    const float NEG = -__builtin_inff();
#pragma unroll
    for (int r = 0; r < 16; ++r) { const int c = (r & 3) + 8 * (r >> 2); if (dq - c < 0) p0[r] = NEG; if (dq - c - 32 < 0) p1[r] = NEG; }
}
__device__ __forceinline__ void partialSM(f32x16& p0, f32x16& p1, float& m_reg, float& alpha, float l_reg) {
    float pmax = p0[0];
#pragma unroll
    for (int r = 1; r < 16; ++r) pmax = fmaxf(pmax, p0[r]);
#pragma unroll
    for (int r = 0; r < 16; ++r) pmax = fmaxf(pmax, p1[r]);
    { auto rr = __builtin_amdgcn_permlane32_swap(__float_as_uint(pmax), __float_as_uint(pmax), false, false); pmax = fmaxf(__uint_as_float(rr[0]), __uint_as_float(rr[1])); }
    const bool need = (pmax > THR) || (l_reg == 0.f && pmax > -__builtin_inff());
    if (__builtin_expect(__all(!need), 1)) { alpha = 1.f; }
    else { const float d = need ? pmax : 0.f; alpha = (l_reg == 0.f) ? 1.f : __builtin_amdgcn_exp2f(-d); m_reg += d;
#pragma unroll
        for (int r = 0; r < 16; ++r) p0[r] = p0[r] - d;
#pragma unroll
        for (int r = 0; r < 16; ++r) p1[r] = p1[r] - d; }
#pragma unroll
    for (int r = 0; r < 16; ++r) p0[r] = __builtin_amdgcn_exp2f(p0[r]);
}
__device__ __forceinline__ void finishSM(f32x16& p0, f32x16& p1, float alpha, float& l_reg, bf16x8& pa0, bf16x8& pa1, bf16x8& pa2, bf16x8& pa3) {
#pragma unroll
    for (int r = 0; r < 16; ++r) p1[r] = __builtin_amdgcn_exp2f(p1[r]);
    float ps = 0;
#pragma unroll
    for (int r = 0; r < 16; ++r) ps += p0[r];
#pragma unroll
    for (int r = 0; r < 16; ++r) ps += p1[r];
    { auto rr = __builtin_amdgcn_permlane32_swap(__float_as_uint(ps), __float_as_uint(ps), false, false); ps = __uint_as_float(rr[0]) + __uint_as_float(rr[1]); }
    l_reg = l_reg * alpha + ps;
#define PK4(P, B_, OUT) do { unsigned a0 = cvt_pk_bf16(P[B_+0], P[B_+1]), a1 = cvt_pk_bf16(P[B_+2], P[B_+3]);                          \
        unsigned b0 = cvt_pk_bf16(P[B_+4], P[B_+5]), b1 = cvt_pk_bf16(P[B_+6], P[B_+7]);                                             \
        auto r0 = __builtin_amdgcn_permlane32_swap(a0, b0, false, false); auto r1 = __builtin_amdgcn_permlane32_swap(a1, b1, false, false); \
        u32x4 w = {r0[0], r1[0], r0[1], r1[1]}; OUT = *reinterpret_cast<bf16x8*>(&w); } while (0)
    PK4(p0, 0, pa0); PK4(p0, 8, pa1); PK4(p1, 0, pa2); PK4(p1, 8, pa3);
#undef PK4
}
template <int KB>
__device__ __forceinline__ void qkt(f32x16& p0, f32x16& p1, const char* K_lds, int r32, int hi, const bf16x8* qr, float ab, float slope2) {
    const float s32 = 32.f * slope2;
#pragma unroll
    for (int r = 0; r < 16; ++r) { p0[r] = fmaf(slope2, (float)((r & 3) + 8 * (r >> 2)), ab); p1[r] = p0[r] + s32; }
#pragma unroll
    for (int d0 = 0; d0 < 4; ++d0) { const char* a = K_lds + KB * SHM_K + kswz(r32, d0 * 2 + hi);
        bf16x8 b0 = *reinterpret_cast<const bf16x8*>(a);
        bf16x8 b1 = *reinterpret_cast<const bf16x8*>(a + 32 * 128);
        p0 = __builtin_amdgcn_mfma_f32_32x32x16_bf16(b0, qr[d0], p0, 0, 0, 0);
        p1 = __builtin_amdgcn_mfma_f32_32x32x16_bf16(b1, qr[d0], p1, 0, 0, 0); }
}
template <int VB>
__device__ __forceinline__ void pv_tile(f32x16* o, int vb0, bf16x8 pa0, bf16x8 pa1, bf16x8 pa2, bf16x8 pa3) {
#define TRRD(dst, off) asm volatile("ds_read_b64_tr_b16 %0, %1 offset:%2" : "=&v"(dst) : "v"(vb0), "i"(off) : "memory")
#define PV_D0(d0) do { s16x4 l0, l1, l2, l3, h0, h1, h2, h3; constexpr int b_ = VB * SHM_V + v_rd_off(d0, 0, 0); \
        TRRD(l0, b_); TRRD(h0, b_ + 2048); TRRD(l1, b_ + 4096); TRRD(h1, b_ + 6144); TRRD(l2, b_ + 8192); TRRD(h2, b_ + 10240); TRRD(l3, b_ + 12288); TRRD(h3, b_ + 14336); \
        asm volatile("s_waitcnt lgkmcnt(0)" ::: "memory"); SBAR();   \
        o[d0] = __builtin_amdgcn_mfma_f32_32x32x16_bf16(pa0, (bf16x8){l0[0], l0[1], l0[2], l0[3], h0[0], h0[1], h0[2], h0[3]}, o[d0], 0, 0, 0);   \
        o[d0] = __builtin_amdgcn_mfma_f32_32x32x16_bf16(pa1, (bf16x8){l1[0], l1[1], l1[2], l1[3], h1[0], h1[1], h1[2], h1[3]}, o[d0], 0, 0, 0);   \
        o[d0] = __builtin_amdgcn_mfma_f32_32x32x16_bf16(pa2, (bf16x8){l2[0], l2[1], l2[2], l2[3], h2[0], h2[1], h2[2], h2[3]}, o[d0], 0, 0, 0);   \
        o[d0] = __builtin_amdgcn_mfma_f32_32x32x16_bf16(pa3, (bf16x8){l3[0], l3[1], l3[2], l3[3], h3[0], h3[1], h3[2], h3[3]}, o[d0], 0, 0, 0); } while (0)
    PV_D0(0); PV_D0(1); PV_D0(2); PV_D0(3);
#undef PV_D0
#undef TRRD
}

struct BlockRef { const bf16_t* Q; const bf16_t* K; const bf16_t* V; bf16_t* O; int P0; int mode; float slope2; float kmax; };
struct Seam { bf16x8 qr[4]; bf16x8 st_v0, st_v1, st_k0; };
__device__ __forceinline__ BlockRef mkref(const bf16_t* Z, bf16_t* AO, const float* kmt  , int b, int combo, int mp) { BlockRef r; const int h = combo >> 5, qb = combo & 31;
    const bf16_t* zb = Z + (size_t)b * SEQ * ZP; r.Q = zb + (size_t)(qb * 256) * ZP + ZQ + h * 128 + mp * 64; r.K = zb + ZK + h * 128 + mp * 64; r.V = zb + ZVAL + h * 128;
    r.O = AO + ((size_t)b * SEQ + qb * 256) * DM + 512 + h * 128; r.P0 = qb * 256; r.mode = mp; r.slope2 = exp2f(-2.0f * (float)(h + 1)) * LOG2E;
    r.kmax = kmt[h * 2 + mp]; return r; }
#define ROWV(p, k0, rr) ((p) + (size_t)((k0) + (rr)) * ZP + sc)
#define ROWK(p, k0) ((p) + (size_t)((k0) + skr) * ZP + skc * 8)
#define VMW() asm volatile("s_waitcnt vmcnt(0)" ::: "memory")
#define VMWN(n) asm volatile("s_waitcnt vmcnt(%0)" :: "i"(n) : "memory")
#define SLOAD_H(Kp, Vp, k0) do { S.st_v0 = load8(ROWV(Vp, k0, sr)); S.st_v1 = load8(ROWV(Vp, k0, 32 + sr)); S.st_k0 = load8(ROWK(Kp, k0)); } while (0)
#define SWRITE_HK(bf) do { *(bf16x8*)(K_lds + (bf) * SHM_K + kws) = S.st_k0; } while (0)
#define SWRITE_HV(bf) do { *(bf16x8*)(V_lds + (bf) * SHM_V + vst0) = S.st_v0; *(bf16x8*)(V_lds + (bf) * SHM_V + vst1) = S.st_v1; } while (0)
#define SWRITE_H(bf) do { SWRITE_HV(bf); SWRITE_HK(bf); } while (0)
__device__ __forceinline__ void prime(const BlockRef& cur, char* lds, Seam& S, int wid) {
    const int lane = lane_id(), tid = wid * 64 + lane, r32 = lane & 31, hi = lane >> 5;
    const int sr = tid >> 4, sc = (tid & 15) * 8, skr = tid >> 3, skc = tid & 7, kws = kswz(skr, skc); char* K_lds = lds + LDS_K;
#pragma unroll
    for (int d0 = 0; d0 < 4; ++d0) S.qr[d0] = load8(cur.Q + (size_t)(wid * QBLK + r32) * ZP + d0 * 16 + hi * 8);
    SLOAD_H(cur.K, cur.V, cur.P0 + QB - KVBLK); VMW(); SWRITE_HK(0);
    __syncthreads();
}
__device__ __forceinline__ void block(const BlockRef& cur, const BlockRef& nxt, char* lds, Seam& S, float lam, const float* __restrict__ subln, int wid) {
    const int lane = lane_id(), tid = wid * 64 + lane, r32 = lane & 31, hi = lane >> 5;
    const int NT0 = (cur.P0 + QB) / KVBLK;
    int NT = NT0;
    const int qlo = cur.P0 + wid * QBLK, qm = qlo + r32 - 4 * hi;
    const float slope2 = cur.slope2;
    char* V_lds = lds + LDS_V; char* K_lds = lds + LDS_K;
    float* ws = (float*)(lds + LDS_WS) + wid * 64; float* li_l = ws, * al_l = ws + 32;
    float m_reg = 0.f, l_reg = 0; f32x16 o[4] = {};
    const int sr = tid >> 4, sc = (tid & 15) * 8, vst0 = v_st(sr, sc), vst1 = v_st(32 + sr, sc), skr = tid >> 3, skc = tid & 7, kws = kswz(skr, skc);
    const int vb0 = (int)(uintptr_t)V_lds + v_rd_base(lane);
    const bf16_t* Kh = cur.K; const bf16_t* Vh = cur.V;
#define RESC(a) do { if (__any((a) < 1.f)) { if (hi == 0) al_l[r32] = (a); asm volatile("s_waitcnt lgkmcnt(0)" ::: "memory");              \
                     for (int d_ = 0; d_ < 4; ++d_) for (int r = 0; r < 16; ++r) o[d_][r] *= al_l[crow(r, hi)]; } } while (0)
#define KBASE(t) ((NT0 - 1 - (t)) * KVBLK)
#define AB(t) (slope2 * (float)(KBASE(t) - qm) - m_reg)
#define MASKT(P0_, P1_, t) do { const int kb_ = KBASE(t); if (kb_ + KVBLK - 1 > qlo) mask_tile(P0_, P1_, qm - kb_); } while (0)
    constexpr int NQL = 4;
#define SEAM_K0() do { VMWN(NQL); SWRITE_HK(0); SBAR(); } while (0)
    f32x16 pA0, pA1, pB0, pB1; float alA, alB; bf16x8 pa0, pa1, pa2, pa3;
    float cbase;
    { float q2 = 0.f;
#pragma unroll
      for (int d0 = 0; d0 < 4; ++d0)
#pragma unroll
          for (int j = 0; j < 8; ++j) { const float v = __uint_as_float(((unsigned)(unsigned short)S.qr[d0][j]) << 16); q2 = fmaf(v, v, q2); }
      { auto rr = __builtin_amdgcn_permlane32_swap(__float_as_uint(q2), __float_as_uint(q2), false, false); q2 = __uint_as_float(rr[0]) + __uint_as_float(rr[1]); }
      cbase = sqrtf(q2) * cur.kmax * 1.0001f - slope2 * (float)(qlo + r32); }
    SWRITE_HV(0); SBAR();
    if (NT > 1) { SLOAD_H(Kh, Vh, KBASE(1)); }
    SBAR(); qkt<0>(pA0, pA1, K_lds, r32, hi, S.qr, AB(0), slope2);
    MASKT(pA0, pA1, 0); partialSM(pA0, pA1, m_reg, alA, l_reg);
    if (NT > 1) { VMW(); SWRITE_H(1); }
    __syncthreads();
#define HALF_STEP(PX0, PX1, alX, PY0, PY1, alY, t, KB, VB, SB) do {                                                      \
        SBAR(); qkt<KB>(PX0, PX1, K_lds, r32, hi, S.qr, AB(t), slope2);                                                   \
        finishSM(PY0, PY1, alY, l_reg, pa0, pa1, pa2, pa3); SBAR();                                                       \
        if ((t) + 1 < NT) { SLOAD_H(Kh, Vh, KBASE((t) + 1)); SBAR(); }                                                    \
        pv_tile<VB>(o, vb0, pa0, pa1, pa2, pa3); MASKT(PX0, PX1, (t)); partialSM(PX0, PX1, m_reg, alX, l_reg);                   \
        __syncthreads();                                                                                                  \
        if ((t) + 1 < NT) { VMW(); SWRITE_H(SB); }                                                                        \
        RESC(alX); __syncthreads(); } while (0)
    for (int t = 1; t + 1 < NT; t += 2) {
        HALF_STEP(pB0, pB1, alB, pA0, pA1, alA, t, 1, 0, 0);
        HALF_STEP(pA0, pA1, alA, pB0, pB1, alB, t + 1, 0, 1, 1);
        if (t == 3 && NT0 > 6) {
            float c = cbase - m_reg;
#pragma unroll
            for (int o_ = 1; o_ < 64; o_ <<= 1) c = fmaxf(c, __shfl_xor(c, o_));
            float* cx = (float*)(lds + LDS_CX);
            if (lane == 0) cx[wid] = c;
            __syncthreads();
            float C = cx[0];
#pragma unroll
            for (int w_ = 1; w_ < NW; ++w_) C = fmaxf(C, cx[w_]);
            const float X = (-SKIP_MARGIN - C) / slope2 - 63.f;
            const float need_f = (float)(NT0 - 1) - X * (1.0f / 64.0f);
            if (need_f < (float)NT0) { int n = (int)ceilf(need_f); n = n < 6 ? 6 : n; n = (n + 1) & ~1; NT = n < NT0 ? n : NT0; }
        }
    }
    SBAR(); qkt<1>(pB0, pB1, K_lds, r32, hi, S.qr, AB(NT - 1), slope2); SBAR();
    SLOAD_H(nxt.K, nxt.V, nxt.P0 + QB - KVBLK); SBAR();
#pragma unroll
    for (int d0 = 0; d0 < 4; ++d0) S.qr[d0] = load8(nxt.Q + (size_t)(wid * QBLK + r32) * ZP + d0 * 16 + hi * 8);
    SBAR();
    finishSM(pA0, pA1, alA, l_reg, pa0, pa1, pa2, pa3); SBAR();
    pv_tile<0>(o, vb0, pa0, pa1, pa2, pa3);
    MASKT(pB0, pB1, NT - 1); partialSM(pB0, pB1, m_reg, alB, l_reg); __syncthreads(); RESC(alB);
    finishSM(pB0, pB1, alB, l_reg, pa0, pa1, pa2, pa3); SBAR(); pv_tile<1>(o, vb0, pa0, pa1, pa2, pa3);
    SBAR(); SEAM_K0();
    if (hi == 0) li_l[r32] = l_reg; asm volatile("s_waitcnt lgkmcnt(0)" ::: "memory");
    float rli[16];
#pragma unroll
    for (int r = 0; r < 16; ++r) rli[r] = __builtin_amdgcn_rcpf(li_l[crow(r, hi)]);
    unsigned* stash = (unsigned*)(lds + LDS_STASH) + wid * 2048 + lane;
    if (cur.mode == 0) {
#pragma unroll
        for (int r = 0; r < 16; ++r) { stash[(r * 2 + 0) * 64] = cvt_pk_bf16(o[0][r] * rli[r], o[1][r] * rli[r]); stash[(r * 2 + 1) * 64] = cvt_pk_bf16(o[2][r] * rli[r], o[3][r] * rli[r]); }
    } else {
        float ssq[16];
#pragma unroll
        for (int r = 0; r < 16; ++r) { const unsigned w0 = stash[(r * 2 + 0) * 64], w1 = stash[(r * 2 + 1) * 64];
            o[0][r] = bf_lo(w0) - lam * (o[0][r] * rli[r]); o[1][r] = bf_hi(w0) - lam * (o[1][r] * rli[r]);
            o[2][r] = bf_lo(w1) - lam * (o[2][r] * rli[r]); o[3][r] = bf_hi(w1) - lam * (o[3][r] * rli[r]);
            ssq[r] = (o[0][r] * o[0][r] + o[1][r] * o[1][r]) + (o[2][r] * o[2][r] + o[3][r] * o[3][r]); }
#pragma unroll
        for (int r = 0; r < 16; ++r) {
#pragma unroll
            for (int off = 1; off < 32; off <<= 1) ssq[r] += __shfl_xor(ssq[r], off);
            ssq[r] = __builtin_amdgcn_rsqf(ssq[r] * (1.0f / DV) + RMS_EPS); }
        float g4[4];
#pragma unroll
        for (int d0 = 0; d0 < 4; ++d0) g4[d0] = subln[d0 * 32 + r32] * 0.8f;
        bf16_t* Ow = cur.O + (size_t)(wid * QBLK) * DM;
#pragma unroll
        for (int r = 0; r < 16; ++r) { const int orow = crow(r, hi);
#pragma unroll
            for (int d0 = 0; d0 < 4; ++d0) { const float v = o[d0][r] * ssq[r] * g4[d0]; const float vn = __shfl_xor(v, 1);
                if ((r32 & 1) == 0) *(unsigned*)(Ow + (size_t)orow * DM + d0 * 32 + r32) = cvt_pk_bf16(v, vn); } }
    }
    __syncthreads();
#undef RESC
#undef KBASE
#undef AB
#undef MASKT
#undef SEAM_K0
#undef HALF_STEP
}
#undef ROWV
#undef ROWK
#undef VMW
#undef VMWN
#undef SLOAD_H
#undef SWRITE_HK
#undef SWRITE_HV
#undef SWRITE_H
#undef SBAR
}

struct AttnPlan { unsigned char list[32][24]; unsigned char cnt[32]; };
constexpr int attn_cost(int combo) { const int h = combo >> 5, qb = combo & 31; const int cap = h == 0 ? 7 : (h == 1 ? 15 : (h == 2 ? 46 : 128)); int st = 4 * (qb + 1); st = st < cap ? st : cap; return 2 * (15 * st + 200); }
constexpr AttnPlan make_attn_plan() {
    AttnPlan p{}; int load[32] = {}; bool used[128] = {};
    for (int i = 0; i < 128; ++i) { int best = -1; for (int j = 0; j < 128; ++j) if (!used[j] && (best < 0 || attn_cost(j) > attn_cost(best))) best = j;
        used[best] = true; int bin = 0; for (int b = 1; b < 32; ++b) if (load[b] < load[bin]) bin = b;
        if (p.cnt[bin] < 24) { p.list[bin][p.cnt[bin]] = (unsigned char)best; p.cnt[bin] = (unsigned char)(p.cnt[bin] + 1); } load[bin] += attn_cost(best); }
    return p;
}
__device__ const AttnPlan kAttnPlan = make_attn_plan();

#define XB_TMO      128
#define XB_XCNT(j)  (256  + 64 * (j))
#define XB_XSUB(j)  (1280 + 64 * (j))
#define XB_XGEN(j)  (2304 + 64 * (j))
#define XB_TOP      3328
#define XB_TOPGEN   3392
#define XCD_BAR_WORDS 3456
#define XB_SPIN_CAP (1u << 22)
__device__ __forceinline__ unsigned xb_ld(unsigned* p)              { return __hip_atomic_load(p, __ATOMIC_RELAXED, __HIP_MEMORY_SCOPE_AGENT); }
__device__ __forceinline__ unsigned xb_add(unsigned* p, unsigned v) { return __hip_atomic_fetch_add(p, v, __ATOMIC_RELAXED, __HIP_MEMORY_SCOPE_AGENT); }
__device__ __forceinline__ unsigned xb_xcc_id() { return (unsigned)__builtin_amdgcn_s_getreg((3 << 11) | 20) & 0xFu; }
#define XB_SPIN(cond, bar) do { unsigned _sp = 0; while (cond) { __builtin_amdgcn_s_sleep(1); \
    if ((++_sp & 255u) == 0u) { if (xb_ld(&(bar)[XB_TMO])) break; if (_sp > XB_SPIN_CAP) { atomicAdd(&(bar)[XB_TMO], 1u); break; } } } } while (0)
struct XcdBarrier { unsigned* bar; unsigned x; volatile LAS unsigned* st; };
__device__ __forceinline__ XcdBarrier xcd_barrier_post(unsigned* bar, volatile LAS unsigned* st, bool t0) {
    XcdBarrier b; b.bar = bar; b.x = xb_xcc_id(); b.st = st;
    if (t0) (void)xb_add(&bar[XB_XCNT(b.x)], 1u);
    return b;
}
__device__ __forceinline__ void xcd_barrier_complete(unsigned* bar, unsigned x, unsigned& nloc, unsigned& nx) {
    const unsigned G = gridDim.x;
    unsigned sum, cnt, mine, sp = 0u;
    for (;;) {
        sum = 0u; cnt = 0u; mine = 0u;
#pragma unroll
        for (unsigned j = 0; j < 16; ++j) { const unsigned c = xb_ld(&bar[XB_XCNT(j)]); sum += c; cnt += (c > 0u) ? 1u : 0u; mine = (j == x) ? c : mine; }
        if (sum == G) break;
        __builtin_amdgcn_s_sleep(1);
        if ((++sp & 255u) == 0u) { if (xb_ld(&bar[XB_TMO])) break; if (sp > XB_SPIN_CAP) { atomicAdd(&bar[XB_TMO], 1u); break; } }
    }
    nloc = mine > 0u ? mine : 1u; nx = cnt > 0u ? cnt : 1u;
}
__device__ __forceinline__ void xcd_barrier(const XcdBarrier& b, bool t0) {
    asm volatile("s_waitcnt vmcnt(0)" ::: "memory");
    __syncthreads();
    if (t0) {
        unsigned* bar = b.bar;
        __builtin_amdgcn_s_waitcnt(0);
        unsigned nloc = b.st[0], nx = b.st[1];
        if (nloc == 0u) { xcd_barrier_complete(bar, b.x, nloc, nx); b.st[0] = nloc; b.st[1] = nx; }
        const unsigned old = xb_add(&bar[XB_XSUB(b.x)], 1u);
        const unsigned gen = old / nloc;
        if (old + 1u == (gen + 1u) * nloc) {
            __builtin_amdgcn_fence(__ATOMIC_RELEASE, "agent");
            asm volatile("s_waitcnt vmcnt(0)" ::: "memory");
            const unsigned og = xb_add(&bar[XB_TOP], 1u);
            const unsigned tg = og / nx;
            if (og + 1u == (tg + 1u) * nx) xb_add(&bar[XB_TOPGEN], 1u);
            else XB_SPIN(xb_ld(&bar[XB_TOPGEN]) == tg, bar);
            __builtin_amdgcn_fence(__ATOMIC_ACQUIRE, "agent");
            xb_add(&bar[XB_XGEN(b.x)], 1u);
            asm volatile("s_waitcnt vmcnt(0)" ::: "memory");
        } else {
            XB_SPIN(xb_ld(&bar[XB_XGEN(b.x)]) == gen, bar);
            __builtin_amdgcn_fence(__ATOMIC_ACQUIRE, "agent");
            asm volatile("s_waitcnt vmcnt(0)" ::: "memory");
        }
    }
    __syncthreads();
}
constexpr int NWAVES = 8, NTHR = 512;
constexpr int LDS_BYTES = 163840;
struct Args {
    const float* in[28]; float* out; unsigned char* ws; int ph_lo, ph_hi;
};
constexpr int N_PHASES = 15;

struct Frame {
    LAS unsigned char* lds; int wave, vcu, G;
};

__device__ __forceinline__ void transpose_item(const float* W, int ldw, int k0, int n0, bf16_t* dst, int ldt, const float* kscale, LAS float* scr, int lane) {
    f32x4 v[8]; const int kr = lane >> 3, n4 = (lane & 7) * 4;
#pragma unroll
    for (int i = 0; i < 8; ++i) v[i] = __builtin_nontemporal_load((const f32x4*)(W + (size_t)(k0 + i * 8 + kr) * ldw + n0 + n4));
#pragma unroll
    for (int i = 0; i < 8; ++i) { const int kk = i * 8 + kr; f32x4 x = v[i]; if (kscale) x = x * kscale[k0 + kk];
        scr[kk * 33 + n4 + 0] = x[0]; scr[kk * 33 + n4 + 1] = x[1]; scr[kk * 33 + n4 + 2] = x[2]; scr[kk * 33 + n4 + 3] = x[3]; }
    asm volatile("s_waitcnt lgkmcnt(0)" ::: "memory");
    const int c = lane & 7;
#pragma unroll
    for (int j = 0; j < 4; ++j) { const int n = (lane >> 3) + 8 * j; const LAS float* s = scr + (8 * c) * 33 + n;
        u32x4 o; o.x = cvt_pk_bf16(s[0 * 33], s[1 * 33]); o.y = cvt_pk_bf16(s[2 * 33], s[3 * 33]); o.z = cvt_pk_bf16(s[4 * 33], s[5 * 33]); o.w = cvt_pk_bf16(s[6 * 33], s[7 * 33]);
        *(u32x4*)(dst + (size_t)n * ldt + k0 + 8 * c) = o; }
    asm volatile("s_waitcnt lgkmcnt(0)" ::: "memory");
}
__device__ __forceinline__ void transpose_item_fp8(const float* W, int ldw, int k0, int n0, unsigned char* dst, int ldt, float scale, const float* kscale, LAS float* scr, int lane) {
    f32x4 v[8]; const int kr = lane >> 3, n4 = (lane & 7) * 4;
#pragma unroll
    for (int i = 0; i < 8; ++i) v[i] = __builtin_nontemporal_load((const f32x4*)(W + (size_t)(k0 + i * 8 + kr) * ldw + n0 + n4));
#pragma unroll
    for (int i = 0; i < 8; ++i) { const int kk = i * 8 + kr; const f32x4 x = v[i] * (kscale ? scale * kscale[k0 + kk] : scale);
        scr[kk * 33 + n4 + 0] = x[0]; scr[kk * 33 + n4 + 1] = x[1]; scr[kk * 33 + n4 + 2] = x[2]; scr[kk * 33 + n4 + 3] = x[3]; }
    asm volatile("s_waitcnt lgkmcnt(0)" ::: "memory");
    const int n = lane >> 1, kh = (lane & 1) * 32; const LAS float* s = scr + kh * 33 + n;
    u32x4 o0, o1;
    o0.x = pk4_fp8(s[0 * 33], s[1 * 33], s[2 * 33], s[3 * 33]); o0.y = pk4_fp8(s[4 * 33], s[5 * 33], s[6 * 33], s[7 * 33]); o0.z = pk4_fp8(s[8 * 33], s[9 * 33], s[10 * 33], s[11 * 33]); o0.w = pk4_fp8(s[12 * 33], s[13 * 33], s[14 * 33], s[15 * 33]);
    o1.x = pk4_fp8(s[16 * 33], s[17 * 33], s[18 * 33], s[19 * 33]); o1.y = pk4_fp8(s[20 * 33], s[21 * 33], s[22 * 33], s[23 * 33]); o1.z = pk4_fp8(s[24 * 33], s[25 * 33], s[26 * 33], s[27 * 33]); o1.w = pk4_fp8(s[28 * 33], s[29 * 33], s[30 * 33], s[31 * 33]);
    __builtin_nontemporal_store(o0, (u32x4*)(dst + (size_t)n * ldt + k0 + kh)); __builtin_nontemporal_store(o1, (u32x4*)(dst + (size_t)n * ldt + k0 + kh + 16));
    asm volatile("s_waitcnt lgkmcnt(0)" ::: "memory");
}
__device__ __forceinline__ void rms_rows2_to_bf16(const float* xa, const float* xb, const float* g, bf16_t* oa, bf16_t* ob, int lane) {
    const f32x4* ra = (const f32x4*)xa + lane; const f32x4* rb = (const f32x4*)xb + lane; const f32x4* gr = (const f32x4*)g + lane;
    f32x4 va[4], vb[4]; float sa = 0.f, sb = 0.f;
#pragma unroll
    for (int j = 0; j < 4; ++j) { va[j] = __builtin_nontemporal_load(ra + 64 * j); vb[j] = __builtin_nontemporal_load(rb + 64 * j); }
#pragma unroll
    for (int j = 0; j < 4; ++j) { sa += (va[j].x * va[j].x + va[j].y * va[j].y) + (va[j].z * va[j].z + va[j].w * va[j].w); sb += (vb[j].x * vb[j].x + vb[j].y * vb[j].y) + (vb[j].z * vb[j].z + vb[j].w * vb[j].w); }
    const float rsa = __builtin_amdgcn_rsqf(wave_sum(sa) * (1.f / DM) + RMS_EPS), rsb = __builtin_amdgcn_rsqf(wave_sum(sb) * (1.f / DM) + RMS_EPS);
    u32x2* pa = (u32x2*)oa + lane; u32x2* pb = (u32x2*)ob + lane;
#pragma unroll
    for (int j = 0; j < 4; ++j) { const f32x4 gg = gr[64 * j]; u32x2 w;
        w.x = cvt_pk_bf16(va[j].x * rsa * gg.x, va[j].y * rsa * gg.y); w.y = cvt_pk_bf16(va[j].z * rsa * gg.z, va[j].w * rsa * gg.w); pa[64 * j] = w;
        w.x = cvt_pk_bf16(vb[j].x * rsb * gg.x, vb[j].y * rsb * gg.y); w.y = cvt_pk_bf16(vb[j].z * rsb * gg.z, vb[j].w * rsb * gg.w); pb[64 * j] = w; }
}

__global__ void __launch_bounds__(NTHR, 2) mega(Args args) {
    extern __shared__ __attribute__((aligned(16))) unsigned char lds_raw[];
    Frame F; F.lds = (LAS unsigned char*)lds_raw; F.wave = __builtin_amdgcn_readfirstlane(threadIdx.x >> 6);
    F.G = gridDim.x; { const int bx = blockIdx.x; F.vcu = (F.G % 8 == 0) ? (bx % 8) * (F.G / 8) + bx / 8 : bx; }
    unsigned char* ws = args.ws;
    unsigned* ctl = (unsigned*)(ws + WS_CTL);
    const float* x = args.in[0]; float* out = args.out;
    bf16_t* Win_t = (bf16_t*)(ws + WS_WIN); bf16_t* Wout_t = (bf16_t*)(ws + WS_WOUT); bf16_t* Wq_t = (bf16_t*)(ws + WS_WQ); bf16_t* Wkv_t = (bf16_t*)(ws + WS_WKV);
    bf16_t* Wo_t = (bf16_t*)(ws + WS_WO); bf16_t* Wr_t = (bf16_t*)(ws + WS_WR); bf16_t* Wsgu = (bf16_t*)(ws + WS_WSGU); bf16_t* memn = (bf16_t*)(ws + WS_MEMN);
    bf16_t* Km = (bf16_t*)(ws + WS_KM); bf16_t* Vt = (bf16_t*)(ws + WS_VT); bf16_t* Wgu_t = (bf16_t*)(ws + WS_WGU); bf16_t* Wd_t = (bf16_t*)(ws + WS_WD);
    bf16_t* Z = (bf16_t*)(ws + WS_RA); bf16_t* Qm = (bf16_t*)(ws + WS_RA); bf16_t* Sc = (bf16_t*)(ws + WS_RA + 128 * MiB); bf16_t* xg = (bf16_t*)(ws + WS_RA); bf16_t* yb = (bf16_t*)(ws + WS_RA);
    bf16_t* XN = (bf16_t*)(ws + WS_RB); bf16_t* AO = (bf16_t*)(ws + WS_RB); bf16_t* Om = (bf16_t*)(ws + WS_RB); bf16_t* act = (bf16_t*)(ws + WS_RB);
    bf16_t* x1b = (bf16_t*)(ws + WS_RC); bf16_t* x2b = (bf16_t*)(ws + WS_RC); unsigned char* x2f8 = ws + WS_X2F8;
    float* ssq1 = (float*)(ws + WS_SSQ1); float* ssq2 = (float*)(ws + WS_SSQ2); float* rstd2 = (float*)(ws + WS_SSQ1);     float* logit = (float*)(ws + WS_LOGIT);
    int* tok_e = (int*)(ws + WS_TOKE); float* tok_w = (float*)(ws + WS_TOKW); int* tok_s = (int*)(ws + WS_TOKS); int* row_tok = (int*)(ws + WS_ROWTOK); float* rowrs = (float*)(ws + WS_ROWTOK + 1 * MiB);
    const int gw = F.vcu * NWAVES + F.wave, NGW = F.G * NWAVES;
    const int lo = args.ph_lo, hi = args.ph_hi;
#define IN(k) (lo <= (k) && (k) < hi)
#if MK_ONE_LAUNCH
    volatile LAS unsigned* misc = (volatile LAS unsigned*)(F.lds + LDS_MISC);
    if (threadIdx.x < 64) misc[threadIdx.x] = 0u;
    __syncthreads();
    XcdBarrier xbar = xcd_barrier_post(ctl + CW_BAR, misc + 8, threadIdx.x == 0);
    if (args.ph_hi > 4096) cg::this_grid().sync();
#define GRID_BAR(k) do { if (IN(k) && IN((k) + 1)) xcd_barrier(xbar, F.wave == 0 && lane_id() == 0); } while (0)
#else
#define GRID_BAR(k) do { } while (0)
#endif
#define LOCAL_SEAM() do { asm volatile("s_waitcnt vmcnt(0)" ::: "memory"); __syncthreads(); __builtin_amdgcn_fence(__ATOMIC_ACQUIRE, "agent"); asm volatile("s_waitcnt vmcnt(0)" ::: "memory"); __syncthreads(); } while (0)

    if (IN(0)) {
        const int lane_ = lane_id(), tid_ = F.wave * 64 + lane_; (void)tid_;
        LAS float* scr = (LAS float*)(F.lds + F.wave * 16384);
        constexpr int I_IN = 16 * 80, I_SQ = 16 * 32, I_KV = 16 * 64, I_G = 16 * 16, I_D = 8 * 32;
        constexpr int NITEMS = I_IN + 3 * I_SQ + I_KV + NEXP * (2 * I_G + I_D);
        for (int it = gw; it < NITEMS; it += NGW) {
            int r = it;
            if (r < I_IN) { const int kb = r / 80, nb = r % 80; transpose_item(args.in[3], ZP, kb * 64, nb * 32, Win_t + (size_t)(nb * 32) * DM, DM, nullptr, scr, lane_); continue; } r -= I_IN;
            if (r < I_SQ) { const int kb = r / 32, nb = r % 32; transpose_item(args.in[13], DM, kb * 64, nb * 32, Wout_t + (size_t)(nb * 32) * DM, DM, nullptr, scr, lane_); continue; } r -= I_SQ;
            if (r < I_SQ) { const int kb = r / 32, nb = r % 32; transpose_item_fp8(args.in[16], DM, kb * 64, nb * 32, (unsigned char*)Wq_t + (size_t)(nb * 32) * DM, DM, F8_WSCALE, args.in[14], scr, lane_); continue; } r -= I_SQ;
            if (r < I_KV) { const int kb = r / 64, nb = r % 64; transpose_item(args.in[17], 2 * DM, kb * 64, nb * 32, Wkv_t + (size_t)(nb * 32) * DM, DM, nullptr, scr, lane_); continue; } r -= I_KV;
            if (r < I_SQ) { const int kb = r / 32, nb = r % 32; transpose_item_fp8(args.in[18], DM, kb * 64, nb * 32, (unsigned char*)Wo_t + (size_t)(nb * 32) * DM, DM, F8_WSCALE, nullptr, scr, lane_); continue; } r -= I_SQ;
            const int e = r / (2 * I_G + I_D); r -= e * (2 * I_G + I_D);
            if (r < 2 * I_G) { const int up = r >= I_G; if (up) r -= I_G; const int kb = r / 16, nb = r % 16, n0 = nb * 32;
                const float* W = (up ? args.in[25] : args.in[24]) + (size_t)e * DM * DEXP;
                transpose_item_fp8(W, DEXP, kb * 64, n0, (unsigned char*)Wgu_t + ((size_t)e * 1024 + (n0 >> 7) * 256 + 64 * ((n0 & 127) >> 5) + 32 * up) * DM, DM, F8_WSCALE, args.in[19], scr, lane_); continue; }
            r -= 2 * I_G;
            { const int kb = r / 32, nb = r % 32; transpose_item_fp8(args.in[26] + (size_t)e * DEXP * DM, DM, kb * 64, nb * 32, (unsigned char*)Wd_t + ((size_t)e * 1024 + nb * 32) * DEXP, DEXP, F8_WSCALE, nullptr, scr, lane_); }
        }
        for (int i = blockIdx.x * NTHR + tid_; i < 256 * DM; i += F.G * NTHR) { const int n = i >> 10, k = i & 1023; float v = 0.f;
            if (n < 4) v = args.in[20][k * 4 + n] * args.in[19][k]; else if (n < 36) v = args.in[22][k * 32 + (n - 4)] * args.in[19][k];
            Wr_t[i] = (bf16_t)(cvt_pk_bf16(v, 0.f) & 0xffffu); }
        for (int i = blockIdx.x * NTHR + tid_; i < 4 * 128 * 128; i += F.G * NTHR) { const int t = (i >> 7) & 127, s = i & 127; const float v = s <= t ? args.in[6][i] : 0.f; Wsgu[i] = (bf16_t)(cvt_pk_bf16(v, 0.f) & 0xffffu); }
        for (int m = gw; m < M; m += 2 * NGW) rms_rows2_to_bf16(x + (size_t)m * DM, x + (size_t)(m + NGW) * DM, args.in[2], XN + (size_t)m * DM, XN + (size_t)(m + NGW) * DM, lane_);
        for (int m = gw; m < MROWS / 2; m += NGW) rms_rows2_to_bf16(args.in[1] + (size_t)m * DM, args.in[1] + (size_t)(m + MROWS / 2) * DM, args.in[15], memn + (size_t)m * DM, memn + (size_t)(m + MROWS / 2) * DM, lane_);
        __syncthreads();
    }
    GRID_BAR(0);

    if (IN(1)) {
        { pg8::Gemm g{DM, DM, DM}; pg8::PlainSched S; S.to.init(M / 256, ZP / 256, F.G, (int)blockIdx.x); S.A = (const char*)XN; S.B = (const char*)Win_t; S.tA = (size_t)256 * DM * 2; S.tB = (size_t)256 * DM * 2;
          pg8::EpiZ E{Z, ctl + CW_KMX}; pg8::gemm_phase(F.lds, F.wave, g, S, E); }
    }
    GRID_BAR(1);

    if (IN(2)) {
        const int lane_ = lane_id(), tid_ = F.wave * 64 + lane_; (void)tid_;
        float lam;
        { const float a = args.in[8][lane_] * args.in[9][lane_], b = args.in[10][lane_] * args.in[11][lane_];
          lam = __expf(wave_sum(a)) - __expf(wave_sum(b)) + 0.2f; }
        {
            LAS float* kmt = (LAS float*)(F.lds + da::LDS_CX + 64);
            const int b = (F.G == 256) ? (F.vcu >> 5) : 0, r = F.vcu & 31;
            if (tid_ < 8) { const unsigned* kp = ctl + CW_KMX + ((b * 4 + (tid_ >> 1)) * 2 + (tid_ & 1)) * 2; kmt[tid_] = 1.01f * sqrtf(__uint_as_float(ld_u32_agent(kp)) + __uint_as_float(ld_u32_agent(kp + 1))); }
            __syncthreads();
            const int nit = (F.G == 256) ? (int)kAttnPlan.cnt[r] : 0;
#define COMBO_OF(i) ((int)__builtin_amdgcn_readfirstlane((int)kAttnPlan.list[r][(i)]))
            if (nit > 0) {
                int ii = 0, pass = 0, combo = COMBO_OF(0); da::BlockRef cur = da::mkref(Z, AO, (const float*)kmt, b, combo, 0); da::Seam S;
                da::prime(cur, (char*)lds_raw, S, F.wave);
                for (;;) {
                    int ni = ii, np = pass + 1; if (np == 2) { np = 0; ni = ii + 1; }
                    const bool last = ni >= nit * PROBE_DUP_ATTN;
                    int ncombo = combo; if (!last && np == 0) ncombo = COMBO_OF(ni % nit);
                    const da::BlockRef nxt = last ? cur : da::mkref(Z, AO, (const float*)kmt, b, ncombo, np);
                    da::block(cur, nxt, (char*)lds_raw, S, lam, args.in[12], F.wave);
                    if (last) break;
                    cur = nxt; ii = ni; pass = np; combo = ncombo;
                }
            }
#undef COMBO_OF
        }
        __syncthreads();
        {
            const int lane = lane_, w = F.wave;
            const int nun = (M / 128) * 4;
            const int ch0 = (lane & 15) * 8, t = 16 * w + (lane & 15), nks = (w + 2) >> 1;
            u32x4 vr[4];
            LAS int* sq = (LAS int*)(F.lds + 2 * 34816);
            const bool puller = (w == 0 && lane == 0);
            if (puller) { sq[0] = (int)atomicAdd(ctl + CW_SGUQ, 1u); sq[1] = (int)atomicAdd(ctl + CW_SGUQ, 1u); }
            __syncthreads();
            int uidx = __builtin_amdgcn_readfirstlane(sq[0]), unext = __builtin_amdgcn_readfirstlane(sq[1]), kk = 0;
            if (uidx < nun) { const size_t R0 = (size_t)(uidx >> 2) * 128; const int g = uidx & 3;
#pragma unroll
                for (int ps = 0; ps < 4; ++ps) vr[ps] = *(const u32x4*)(Z + (R0 + 16 * w + 4 * ps + (lane >> 4)) * ZP + ZV + g * 128 + ch0); }
            int gcur = -1; float lg[8], lb[8]; bf16x8 wf[4]; float bias = 0.f; int buf = 0;
#pragma unroll
            for (int j = 0; j < 8; ++j) { lg[j] = 0.f; lb[j] = 0.f; }
#pragma unroll
            for (int ks = 0; ks < 4; ++ks) wf[ks] = (bf16x8){0, 0, 0, 0, 0, 0, 0, 0};
            for (; uidx < nun; uidx = unext, unext = __builtin_amdgcn_readfirstlane(sq[(kk + 1) & 3]), buf ^= 1) {
                int pulled_ = 0; if (puller) pulled_ = (int)atomicAdd(ctl + CW_SGUQ, 1u);
                const int c = uidx >> 2, g = uidx & 3; const size_t R0 = (size_t)c * 128;
                LAS bf16_t* vnT = (LAS bf16_t*)(F.lds + buf * 34816);
                if (g != gcur) { gcur = g;
#pragma unroll
                    for (int j = 0; j < 8; ++j) { lg[j] = args.in[4][g * 128 + ch0 + j]; lb[j] = args.in[5][g * 128 + ch0 + j]; }
#pragma unroll
                    for (int ks = 0; ks < 4; ++ks) if (ks < nks) wf[ks] = *(const bf16x8*)(Wsgu + ((size_t)g * 128 + t) * 128 + ks * 32 + 8 * (lane >> 4));
                    bias = args.in[7][g * 128 + t]; }
#pragma unroll
                for (int ps = 0; ps < 4; ++ps) { const int sr = 16 * w + 4 * ps + (lane >> 4); const u32x4 raw = vr[ps];
                    float v[8] = {bf_lo(raw.x), bf_hi(raw.x), bf_lo(raw.y), bf_hi(raw.y), bf_lo(raw.z), bf_hi(raw.z), bf_lo(raw.w), bf_hi(raw.w)};
                    float sm = 0.f;
#pragma unroll
                    for (int j = 0; j < 8; ++j) sm += v[j];
#pragma unroll
                    for (int o = 1; o < 16; o <<= 1) sm += __shfl_xor(sm, o);
                    const float mu = sm * (1.f / 128.f); float q = 0.f;
#pragma unroll
                    for (int j = 0; j < 8; ++j) { v[j] -= mu; q += v[j] * v[j]; }
#pragma unroll
                    for (int o = 1; o < 16; o <<= 1) q += __shfl_xor(q, o);
                    const float rstd = __builtin_amdgcn_rsqf(q * (1.f / 128.f) + LN_EPS);
#pragma unroll
                    for (int j = 0; j < 8; ++j) { const float y = v[j] * rstd * lg[j] + lb[j]; vnT[(ch0 + j) * 136 + sr] = (bf16_t)(cvt_pk_bf16(y, 0.f) & 0xffffu); } }
                u32x2 ur[8];
#pragma unroll
                for (int mi = 0; mi < 8; ++mi) ur[mi] = *(const u32x2*)(Z + (R0 + t) * ZP + ZU + g * 128 + 16 * mi + 4 * (lane >> 4));
                { const int un = unext; if (un < nun) { const size_t Rn = (size_t)(un >> 2) * 128; const int gn = un & 3;
#pragma unroll
                    for (int ps = 0; ps < 4; ++ps) vr[ps] = *(const u32x4*)(Z + (Rn + 16 * w + 4 * ps + (lane >> 4)) * ZP + ZV + gn * 128 + ch0); } }
                if (puller) sq[(kk + 2) & 3] = pulled_;
                ++kk;
                __syncthreads();
                f32x4 acc[8];
#pragma unroll
                for (int mi = 0; mi < 8; ++mi) acc[mi] = (f32x4){0.f, 0.f, 0.f, 0.f};
#pragma unroll
                for (int ks = 0; ks < 4; ++ks) if (ks < nks) {
#pragma unroll
                    for (int mi = 0; mi < 8; ++mi) { const bf16x8 afr = *(const LAS bf16x8*)(vnT + (16 * mi + (lane & 15)) * 136 + ks * 32 + 8 * (lane >> 4));
                        acc[mi] = __builtin_amdgcn_mfma_f32_16x16x32_bf16(afr, wf[ks], acc[mi], 0, 0, 0); } }
#pragma unroll
                for (int mi = 0; mi < 8; ++mi) { const int ch = 16 * mi + 4 * (lane >> 4); const u32x2 u2 = ur[mi];
                    const float o0 = bf_lo(u2.x) * (acc[mi][0] + bias), o1 = bf_hi(u2.x) * (acc[mi][1] + bias), o2 = bf_lo(u2.y) * (acc[mi][2] + bias), o3 = bf_hi(u2.y) * (acc[mi][3] + bias);
                    u32x2 wv; wv.x = cvt_pk_bf16(o0, o1); wv.y = cvt_pk_bf16(o2, o3);
                    *(u32x2*)(AO + (R0 + t) * DM + g * 128 + ch) = wv; }
            }
            __syncthreads();
        }
        {
            int e = -1;
            if (F.G == 256) { const int b = F.vcu >> 5, r = F.vcu & 31; if (r >= 16 && r < 24) e = b * 8 + (r - 16); }
            for (int e2 = (F.G == 256 ? e : F.vcu); e2 >= 0 && e2 < 64; e2 = (F.G == 256 ? 64 : e2 + F.G)) {
                pg8::Gemm g{DM, DM, DM}; pg8::OneUnitSched S;
                if (e2 < 32) { S.u0.pm = e2 >> 2; S.u0.pn = e2 & 3; S.u0.aux = 0; S.u0.rows = nullptr; S.u0.A = (const char*)(memn + (size_t)S.u0.pm * 256 * DM); S.u0.B = (const char*)(Wkv_t + (size_t)S.u0.pn * 256 * DM);
                    pg8::EpiF8 E{(unsigned char*)Km, DM, nullptr, F8_KSCALE}; pg8::gemm_phase(F.lds, F.wave, g, S, E); }
                else { const int e3 = e2 - 32; S.u0.pm = e3 >> 3; S.u0.pn = e3 & 7; S.u0.aux = 0; S.u0.rows = nullptr; S.u0.A = (const char*)(Wkv_t + (size_t)(1024 + S.u0.pm * 256) * DM); S.u0.B = (const char*)(memn + (size_t)S.u0.pn * 256 * DM);
                    pg8::EpiF8 E{(unsigned char*)Vt, MROWS, nullptr, F8_VSCALE}; pg8::gemm_phase(F.lds, F.wave, g, S, E); }
            }
        }
    }
    GRID_BAR(2);

    if (IN(3)) {
        pg8::Gemm g{DM, DM, DM}; pg8::PlainSched S; S.to.init(M / 256, 4, F.G, (int)blockIdx.x); S.A = (const char*)AO; S.B = (const char*)Wout_t; S.tA = (size_t)256 * DM * 2; S.tB = (size_t)256 * DM * 2;
        pg8::EpiResid<false> E{x, x1b, ssq1, (LAS float*)(F.lds + 131072 + 1024), x2f8, 1.f}; pg8::gemm_phase(F.lds, F.wave, g, S, E);
    }
    GRID_BAR(3);

    if (IN(4)) {
        pg8::Gemm g{DM / 2, DM / 2, DM / 2}; pg8::PlainSched S; S.to.init(M / 256, 4, F.G, (int)blockIdx.x); S.A = (const char*)x2f8; S.B = (const char*)Wq_t; S.tA = (size_t)256 * DM; S.tB = (size_t)256 * DM;
        pg8::EpiF8 E{(unsigned char*)Qm, DM, ssq1, F8_QSCALE * C2_MEM / (F8_XSCALE * F8_WSCALE)}; pg8::gemm_phase<pg8::EpiF8, pg8::PlainSched, false, true>(F.lds, F.wave, g, S, E);
    }
    if (MK_ONE_LAUNCH && IN(4) && IN(5)) LOCAL_SEAM();

    if (IN(5)) {
        pg8::Gemm g{DM / 2, DM / 2, 128}; pg8::MemAttnSched S; S.to.init(M / 256, 4, F.G, (int)blockIdx.x); S.A = (const char*)Qm; S.B = (const char*)Km; S.tA = (size_t)256 * DM; S.hA = 256; S.bB = (size_t)256 * DM; S.hB = 256;
        pg8::EpiSoftmax E{(unsigned char*)Sc, (LAS float*)(F.lds + LDS_MISC + 1024), 1.0f / (F8_QSCALE * F8_KSCALE)}; pg8::gemm_phase<pg8::EpiSoftmax, pg8::MemAttnSched, false, true>(F.lds, F.wave, g, S, E);
    }
    if (MK_ONE_LAUNCH && IN(5) && IN(6 + 1)) LOCAL_SEAM();

    if (IN(7)) {
        pg8::Gemm g{DM / 2, MROWS / 2, 128}; pg8::MemAttnSched S; S.to.init(M / 256, 4, F.G, (int)blockIdx.x); S.A = (const char*)Sc; S.B = (const char*)Vt; S.tA = (size_t)256 * DM; S.hA = 256; S.bB = 256; S.hB = (size_t)256 * MROWS;
        pg8::EpiF8 E{(unsigned char*)Om, DM, nullptr, F8_OSCALE / (F8_PSCALE * F8_VSCALE)}; pg8::gemm_phase<pg8::EpiF8, pg8::MemAttnSched, false, true>(F.lds, F.wave, g, S, E);
    }
    GRID_BAR(7);

    if (IN(8)) {
        pg8::Gemm g{DM / 2, DM / 2, DM / 2}; pg8::PlainSched S; S.to.init(M / 256, 4, F.G, (int)blockIdx.x); S.A = (const char*)Om; S.B = (const char*)Wo_t; S.tA = (size_t)256 * DM; S.tB = (size_t)256 * DM;
        pg8::EpiResid<true> E{x1b, x2b, ssq2, (LAS float*)(F.lds + 131072 + 1024), x2f8, 1.0f / (F8_OSCALE * F8_WSCALE)}; pg8::gemm_phase<pg8::EpiResid<true>, pg8::PlainSched, false, true>(F.lds, F.wave, g, S, E);
    }
    GRID_BAR(8);

    if (IN(9)) {
        pg8::Gemm g{DM, DM, DM}; pg8::PlainSched S; S.to.init(M / 256, 1, F.G, (int)blockIdx.x); S.A = (const char*)x2b; S.B = (const char*)Wr_t; S.tA = (size_t)256 * DM * 2; S.tB = 0;
        pg8::EpiRouter E{logit, ssq2, args.in[21], args.in[23], rstd2}; pg8::gemm_phase(F.lds, F.wave, g, S, E);
    }
    if (MK_ONE_LAUNCH && IN(9) && IN(10)) LOCAL_SEAM();

    if (IN(10)) {
        const int lane_ = lane_id(), tid_ = F.wave * 64 + lane_; (void)tid_;
        LAS unsigned* lcnt = (LAS unsigned*)F.lds; LAS unsigned* lbase = lcnt + 32;
        pg8::TileOrder to10; to10.init(M / 256, 1, F.G, (int)blockIdx.x);
        int pm10 = 0, pn10 = 0;
        for (int i10 = 0; to10.get(i10, pm10, pn10); ++i10) {
            if (tid_ < 32) lcnt[tid_] = 0u;
            __syncthreads();
            const int tok = pm10 * 256 + (tid_ & 255); const bool act_ = tid_ < 256;
            const f32x4 lg = *(const f32x4*)(logit + (size_t)tok * 64);
            int gi = 0; float gm = lg[0];
#pragma unroll
            for (int j = 1; j < 4; ++j) if (lg[j] > gm) { gm = lg[j]; gi = j; }
            float gs = 0.f;
#pragma unroll
            for (int j = 0; j < 4; ++j) gs += __expf(lg[j] - gm);
            const float gate = 1.0f / gs;
            const f32x4 ea = *(const f32x4*)(logit + (size_t)tok * 64 + 4 + gi * 8), eb = *(const f32x4*)(logit + (size_t)tok * 64 + 8 + gi * 8);
            const float el[8] = {ea[0], ea[1], ea[2], ea[3], eb[0], eb[1], eb[2], eb[3]};
            int i0 = 0; float m0 = el[0];
#pragma unroll
            for (int j = 1; j < 8; ++j) if (el[j] > m0) { m0 = el[j]; i0 = j; }
            int i1 = -1; float m1 = -__builtin_inff();
#pragma unroll
            for (int j = 0; j < 8; ++j) if (j != i0 && el[j] > m1) { m1 = el[j]; i1 = j; }
            if (i1 < 0) i1 = (i0 == 0) ? 1 : 0;
            const float r = __expf(m1 - m0);
            const float w0 = gate / (1.0f + r), w1 = gate * r / (1.0f + r);
            const int e0 = gi * 8 + i0, e1 = gi * 8 + i1;
            unsigned r0 = 0u, r1 = 0u; if (act_) { r0 = atomicAdd((unsigned*)&lcnt[e0], 1u); r1 = atomicAdd((unsigned*)&lcnt[e1], 1u); }
            __syncthreads();
            if (tid_ < 32) lbase[tid_] = atomicAdd(ctl + CW_CNT + tid_, lcnt[tid_]);
            __syncthreads();
            if (act_) { tok_e[tok * 2] = e0; tok_e[tok * 2 + 1] = e1; tok_w[tok * 2] = w0; tok_w[tok * 2 + 1] = w1;
                tok_s[tok * 2] = (int)(lbase[e0] + r0); tok_s[tok * 2 + 1] = (int)(lbase[e1] + r1); }
            __syncthreads();
        }
    }
    GRID_BAR(10);

    if (IN(11)) {
        const int lane_ = lane_id(), tid_ = F.wave * 64 + lane_; (void)tid_;
        LAS unsigned* lps = (LAS unsigned*)F.lds;
        if (tid_ == 0) { unsigned acc = 0; for (int e = 0; e < 32; ++e) { lps[e] = acc; const unsigned c = ld_u32_agent(ctl + CW_CNT + e); acc += (c + 255u) & ~255u; } lps[32] = acc; }
        __syncthreads();
        if (blockIdx.x == 0) {
            if (tid_ < 32) { const unsigned s = lps[tid_], e2 = lps[tid_ + 1], c = ld_u32_agent(ctl + CW_CNT + tid_);
                for (unsigned b = s >> 8; b < (e2 >> 8); ++b) ctl[CW_BLKE + b] = (unsigned)tid_;
                for (unsigned r = s + c; r < e2; ++r) { row_tok[r] = 0; rowrs[r] = 0.f; } }
            if (tid_ == 0) ctl[CW_NBLK] = lps[32] >> 8;
        }
        for (int a = blockIdx.x * NTHR + tid_; a < M * 2; a += F.G * NTHR) { const int e = tok_e[a]; const int pos = (int)lps[e] + tok_s[a]; row_tok[pos] = a >> 1; tok_s[a] = pos; rowrs[pos] = rstd2[a >> 1] * (1.0f / (F8_XSCALE * F8_WSCALE)); }
        __syncthreads();
    }
    GRID_BAR(11);

    if (IN(12)) {
        const int nblk = (int)__builtin_amdgcn_readfirstlane(ld_u32_agent(ctl + CW_NBLK));
        pg8::Gemm g{DM / 2, DM / 2, DM / 2}; pg8::MoeSched S{F.G, F.vcu, nblk, ctl + CW_BLKE, (const char*)x2f8, (const char*)Wgu_t, (size_t)0, (size_t)1024 * DM, (size_t)256 * DM, row_tok};
        pg8::EpiGateUp E{(unsigned char*)act, rowrs, row_tok}; pg8::gemm_phase<pg8::EpiGateUp, pg8::MoeSched, true, true>(F.lds, F.wave, g, S, E);
    }
    GRID_BAR(12);

    if (IN(13)) {
        const int nblk = (int)__builtin_amdgcn_readfirstlane(ld_u32_agent(ctl + CW_NBLK));
        pg8::Gemm g{DEXP / 2, DEXP / 2, DEXP / 2}; pg8::MoeSched S{F.G, F.vcu, nblk, ctl + CW_BLKE, (const char*)act, (const char*)Wd_t, (size_t)256 * DEXP, (size_t)1024 * DEXP, (size_t)256 * DEXP, row_tok};
        pg8::EpiF8 E{(unsigned char*)yb, DM, nullptr, F8_YSCALE / (F8_WSCALE * F8_ASCALE)}; pg8::gemm_phase<pg8::EpiF8, pg8::MoeSched, false, true>(F.lds, F.wave, g, S, E);
    }
    GRID_BAR(13);

    if (IN(14)) {
        const int lane_ = lane_id(), tid_ = F.wave * 64 + lane_; (void)tid_;
        const f32x4* gr = (const f32x4*)args.in[27] + lane_;
        f32x4 gg[4];
#pragma unroll
        for (int j = 0; j < 4; ++j) gg[j] = gr[64 * j];
        for (int m = gw; m < M; m += 2 * NGW) {
            const int ma = m, mb = m + NGW;
            const int pa0 = tok_s[ma * 2], pa1 = tok_s[ma * 2 + 1], pb0 = tok_s[mb * 2], pb1 = tok_s[mb * 2 + 1];
            const float wa0 = tok_w[ma * 2], wa1 = tok_w[ma * 2 + 1], wb0 = tok_w[mb * 2], wb1 = tok_w[mb * 2 + 1];
            const u32x2* xa = (const u32x2*)(x2b + (size_t)ma * DM) + lane_; const u32x2* xb = (const u32x2*)(x2b + (size_t)mb * DM) + lane_;
            const unsigned* ya0 = (const unsigned*)((const unsigned char*)yb + (size_t)pa0 * DM) + lane_; const unsigned* ya1 = (const unsigned*)((const unsigned char*)yb + (size_t)pa1 * DM) + lane_;
            const unsigned* yb0 = (const unsigned*)((const unsigned char*)yb + (size_t)pb0 * DM) + lane_; const unsigned* yb1 = (const unsigned*)((const unsigned char*)yb + (size_t)pb1 * DM) + lane_;
            u32x2 ca[4], cb[4]; unsigned a0[4], a1[4], b0[4], b1[4];
#pragma unroll
            for (int j = 0; j < 4; ++j) { ca[j] = xa[64 * j]; cb[j] = xb[64 * j]; a0[j] = ya0[64 * j]; a1[j] = ya1[64 * j]; b0[j] = yb0[64 * j]; b1[j] = yb1[64 * j]; }
            f32x4 va[4], vb[4]; float sa = 0.f, sb = 0.f;
            const float ka0 = wa0 * (1.0f / F8_YSCALE), ka1 = wa1 * (1.0f / F8_YSCALE), kb0 = wb0 * (1.0f / F8_YSCALE), kb1 = wb1 * (1.0f / F8_YSCALE);
#pragma unroll
            for (int j = 0; j < 4; ++j) {
                const f32x2 p0 = __builtin_amdgcn_cvt_pk_f32_fp8(a0[j], false), p1 = __builtin_amdgcn_cvt_pk_f32_fp8(a0[j], true), q0 = __builtin_amdgcn_cvt_pk_f32_fp8(a1[j], false), q1 = __builtin_amdgcn_cvt_pk_f32_fp8(a1[j], true);
                const f32x2 r0 = __builtin_amdgcn_cvt_pk_f32_fp8(b0[j], false), r1 = __builtin_amdgcn_cvt_pk_f32_fp8(b0[j], true), t0 = __builtin_amdgcn_cvt_pk_f32_fp8(b1[j], false), t1 = __builtin_amdgcn_cvt_pk_f32_fp8(b1[j], true);
                va[j].x = bf_lo(ca[j].x) + ka0 * p0.x + ka1 * q0.x; va[j].y = bf_hi(ca[j].x) + ka0 * p0.y + ka1 * q0.y; va[j].z = bf_lo(ca[j].y) + ka0 * p1.x + ka1 * q1.x; va[j].w = bf_hi(ca[j].y) + ka0 * p1.y + ka1 * q1.y;
                vb[j].x = bf_lo(cb[j].x) + kb0 * r0.x + kb1 * t0.x; vb[j].y = bf_hi(cb[j].x) + kb0 * r0.y + kb1 * t0.y; vb[j].z = bf_lo(cb[j].y) + kb0 * r1.x + kb1 * t1.x; vb[j].w = bf_hi(cb[j].y) + kb0 * r1.y + kb1 * t1.y;
                sa += (va[j].x * va[j].x + va[j].y * va[j].y) + (va[j].z * va[j].z + va[j].w * va[j].w); sb += (vb[j].x * vb[j].x + vb[j].y * vb[j].y) + (vb[j].z * vb[j].z + vb[j].w * vb[j].w); }
            const float ra = __builtin_amdgcn_rsqf(wave_sum(sa) * (1.f / DM) + RMS_EPS), rb = __builtin_amdgcn_rsqf(wave_sum(sb) * (1.f / DM) + RMS_EPS);
            f32x4* oa = (f32x4*)(out + (size_t)ma * DM) + lane_; f32x4* ob = (f32x4*)(out + (size_t)mb * DM) + lane_;
#pragma unroll
            for (int j = 0; j < 4; ++j) { oa[64 * j] = va[j] * ra * gg[j]; ob[64 * j] = vb[j] * rb * gg[j]; }
        }
    }
#undef IN
#undef GRID_BAR
}

extern "C" void kernel_launch(void* const* d_in, const int* in_sizes, int n_in, void* d_out, int out_size, void* d_ws, size_t ws_size, hipStream_t stream) {
    static int grid = 0;
    if (grid == 0) {
        if (n_in != 28 || in_sizes[0] != M * DM || out_size != M * DM || ws_size < WS_END) { fprintf(stderr, "kernel_launch: unexpected shapes (n_in %d in0 %d out %d ws %zu)\n", n_in, n_in > 0 ? in_sizes[0] : -1, out_size, ws_size); grid = -1; return; }
        int dev = 0, cus = 0, per_cu = 0;
        if (hipGetDevice(&dev) != hipSuccess || hipDeviceGetAttribute(&cus, hipDeviceAttributeMultiprocessorCount, dev) != hipSuccess) { grid = -1; return; }
        if (hipFuncSetAttribute((const void*)mega, hipFuncAttributeMaxDynamicSharedMemorySize, LDS_BYTES) != hipSuccess) { fprintf(stderr, "kernel_launch: hipFuncSetAttribute failed\n"); grid = -1; return; }
        if (hipOccupancyMaxActiveBlocksPerMultiprocessor(&per_cu, (const void*)mega, NTHR, LDS_BYTES) != hipSuccess || per_cu < 1) { fprintf(stderr, "kernel_launch: occupancy query says %d\n", per_cu); per_cu = 1; }
        (void)hipGetLastError();
        grid = cus;
    }
    if (grid < 0) return;
    (void)hipMemsetAsync((char*)d_ws + WS_CTL, 0, CTL_BYTES, stream);
    Args a{};
    for (int i = 0; i < 28; ++i) a.in[i] = (const float*)d_in[i];
    a.out = (float*)d_out; a.ws = (unsigned char*)d_ws;
#if MK_ONE_LAUNCH
    a.ph_lo = 0; a.ph_hi = N_PHASES;
    void* kargs[] = {&a};
    hipError_t e = hipLaunchCooperativeKernel((const void*)mega, dim3(grid), dim3(NTHR), kargs, LDS_BYTES, stream);
    if (e != hipSuccess) fprintf(stderr, "cooperative launch failed: %s (grid %d)\n", hipGetErrorString(e), grid);
#else
    for (int p = 0; p < N_PHASES; ++p) { a.ph_lo = p; a.ph_hi = p + 1; hipLaunchKernelGGL(mega, dim3(grid), dim3(NTHR), LDS_BYTES, stream, a); }
#endif
}
```

```cpp
#include <hip/hip_runtime.h>
#include <hip/hip_cooperative_groups.h>
#include <cstdio>
#include <cstdint>
namespace cg = cooperative_groups;

#ifndef PROBE_DUP
#define PROBE_DUP -1
#endif
#ifndef PROBE_DUP_ATTN
#define PROBE_DUP_ATTN 1
#endif
#ifndef MK_ONE_LAUNCH
#define MK_ONE_LAUNCH 1
#endif

#define LAS __attribute__((address_space(3)))
#define GAS __attribute__((address_space(1)))
typedef unsigned short bf16_t;
typedef short bf16x8 __attribute__((ext_vector_type(8)));
typedef short s16x4 __attribute__((ext_vector_type(4)));
typedef float f32x2 __attribute__((ext_vector_type(2)));
typedef float f32x4 __attribute__((ext_vector_type(4)));
typedef float f32x16 __attribute__((ext_vector_type(16)));
typedef unsigned u32x2 __attribute__((ext_vector_type(2)));
typedef unsigned u32x4 __attribute__((ext_vector_type(4)));
typedef int v8i32 __attribute__((ext_vector_type(8)));

constexpr int NB = 8, SEQ = 8192, DM = 1024, M = NB * SEQ;
constexpr int ZP = 2560;
constexpr int ZU = 0, ZV = 512, ZQ = 1024, ZK = 1536, ZVAL = 2048;
constexpr int MEML = 256, MROWS = NB * MEML;
constexpr int NEXP = 32, DEXP = 512;
constexpr int PROWS = 2 * M + NEXP * 256;
constexpr int MAXBLK = PROWS / 256;
constexpr float RMS_EPS = 1e-6f, LN_EPS = 1e-5f;
constexpr float LOG2E = 1.4426950408889634f;
constexpr float C2_DIFF = 0.125f * LOG2E;
constexpr float C2_MEM = 0.0625f * LOG2E;

constexpr size_t MiB = 1u << 20;
constexpr size_t WS_CTL = 0, CTL_BYTES = 1 * MiB;
constexpr size_t WS_WIN = 1 * MiB;
constexpr size_t WS_WOUT = 6 * MiB;
constexpr size_t WS_WQ = 8 * MiB;
constexpr size_t WS_WKV = 10 * MiB;
constexpr size_t WS_WO = 14 * MiB;
constexpr size_t WS_WR = 16 * MiB;
constexpr size_t WS_WSGU = 17 * MiB;
constexpr size_t WS_MEMN = 18 * MiB;
constexpr size_t WS_KM = 22 * MiB;
constexpr size_t WS_VT = 26 * MiB;
constexpr size_t WS_WGU = 30 * MiB;
constexpr size_t WS_WD = 94 * MiB;
constexpr size_t WS_RA = 128 * MiB;
constexpr size_t WS_RB = 448 * MiB;
constexpr size_t WS_RC = 592 * MiB;
constexpr size_t WS_SSQ1 = 720 * MiB;
constexpr size_t WS_SSQ2 = 724 * MiB;
constexpr size_t WS_LOGIT = 728 * MiB;
constexpr size_t WS_TOKE = 744 * MiB;
constexpr size_t WS_TOKW = 745 * MiB;
constexpr size_t WS_TOKS = 746 * MiB;
constexpr size_t WS_ROWTOK = 747 * MiB;
constexpr size_t WS_X2F8 = 752 * MiB;
constexpr size_t WS_END = 816 * MiB;
constexpr int CW_CNT = 64;
constexpr int CW_NBLK = 128;
constexpr int CW_PSTART = 192;
constexpr int CW_BLKE = 256;
constexpr int CW_KMX = 1024;
constexpr int CW_SGUQ = 1344;
constexpr int CW_ALIST = 8192;
constexpr int CW_BAR = 4096;
constexpr int LDS_MISC = 131072;
constexpr int LDS_TBUF = 140288, TBUF_W = 2304;

__device__ __forceinline__ unsigned cvt_pk_bf16(float lo, float hi) { unsigned r; asm volatile("v_cvt_pk_bf16_f32 %0, %1, %2" : "=v"(r) : "v"(lo), "v"(hi)); return r; }
__device__ __forceinline__ float bf_lo(unsigned w) { return __uint_as_float(w << 16); }
__device__ __forceinline__ float bf_hi(unsigned w) { return __uint_as_float(w & 0xffff0000u); }
constexpr float F8_WSCALE = 256.f, F8_ASCALE = 8.f, F8_XSCALE = 4.f, F8_OSCALE = 16.f, F8_YSCALE = 16.f, F8_QSCALE = 64.f, F8_KSCALE = 16.f, F8_PSCALE = 256.f, F8_VSCALE = 16.f;
__device__ __forceinline__ unsigned pk4_fp8(float a, float b, float c, float d) {
    a = fminf(fmaxf(a, -448.f), 448.f); b = fminf(fmaxf(b, -448.f), 448.f); c = fminf(fmaxf(c, -448.f), 448.f); d = fminf(fmaxf(d, -448.f), 448.f);
    int w = 0; w = __builtin_amdgcn_cvt_pk_fp8_f32(a, b, w, false); w = __builtin_amdgcn_cvt_pk_fp8_f32(c, d, w, true); return (unsigned)w; }
__device__ __forceinline__ float wave_sum(float v) {
#pragma unroll
    for (int o = 1; o < 64; o <<= 1) v += __shfl_xor(v, o);
    return v;
}
__device__ __forceinline__ float wave_max(float v) {
#pragma unroll
    for (int o = 1; o < 64; o <<= 1) v = fmaxf(v, __shfl_xor(v, o));
    return v;
}
__device__ __forceinline__ int lane_id() { int l; asm volatile("v_mbcnt_lo_u32_b32 %0, -1, 0\n\tv_mbcnt_hi_u32_b32 %0, -1, %0" : "=v"(l)); return l; }
__device__ __forceinline__ unsigned ld_u32_agent(const unsigned* p) { return __hip_atomic_load(p, __ATOMIC_RELAXED, __HIP_MEMORY_SCOPE_AGENT); }

namespace pg8 {
constexpr int BM = 256, BK = 64, HALF = 128, HTB = HALF * BK * 2, STAGE_BYTES = 8 * HTB, NXCD = 8, WGM = 8;
__host__ __device__ __forceinline__ int lds_byte(int r, int c) { const int st = (r >> 4) * 2 + (c >> 5), rr = r & 15, cc = c & 31, ob = rr * 64 + cc * 2; return st * 1024 + (ob ^ (((ob >> 9) & 1) << 5)); }
__host__ __device__ __forceinline__ void stage_rc(int b, int& R, int& C) { const int st = b / 1024, sb = b % 1024, swz = sb ^ (((sb >> 9) & 1) << 5); R = (st >> 1) * 16 + swz / 64; C = (st & 1) * 32 + (swz % 64) / 2; }
__host__ __device__ __forceinline__ int perm32(int rho) { const int n = rho >> 4, i = rho & 15; return 8 * (i >> 2) + 4 * n + (i & 3); }

struct Unit { const char* A; const char* B; int pm, pn, aux; const int* rows; };
struct Gemm { int lda, ldb, K; };

struct TileOrder {
    int nM, nN, nwg, G, c;
    __device__ __forceinline__ void init(int nM_, int nN_, int G_, int c_) { nM = nM_; nN = nN_; nwg = nM * nN; G = G_; c = c_; }
    __device__ __forceinline__ bool get(int i, int& pm, int& pn) const {
        const long L = (long)i * G + c; if (L >= nwg) return false;
        int wgid = (int)L; { const int q = nwg / NXCD, r = nwg % NXCD, xcd = wgid % NXCD, off = wgid / NXCD; wgid = (xcd < r ? xcd * (q + 1) : r * (q + 1) + (xcd - r) * q) + off; }
        const int nig = WGM * nN, gid = wgid / nig, fm = gid * WGM, gsz = (nM - fm) < WGM ? (nM - fm) : WGM;
        pm = fm + ((wgid % nig) % gsz); pn = (wgid % nig) / gsz; return true;
    }
};

typedef float f32x2g __attribute__((ext_vector_type(2)));
__device__ __forceinline__ f32x2g gelu_pk(f32x2g v) {
    const f32x2g av = __builtin_elementwise_abs(v), d = av * 0.2316418882f + 1.0f;
    f32x2g t; t.x = __builtin_amdgcn_rcpf(d.x); t.y = __builtin_amdgcn_rcpf(d.y);
    f32x2g q = t * 0.5307027145f + (-0.7265760135f); q = q * t + 0.7107068705f; q = q * t + (-0.142248368f); q = q * t + 0.127414796f; q = q * t;
    const f32x2g s = (v * v) * (-0.72134752044f);
    f32x2g e; e.x = __builtin_amdgcn_exp2f(s.x); e.y = __builtin_amdgcn_exp2f(s.y);
    const f32x2g m = v * (q * e), r = v - m;
    f32x2g o; o.x = v.x < 0.f ? m.x : r.x; o.y = v.y < 0.f ? m.y : r.y; return o;
}

__device__ __forceinline__ const char* uniform_ptr(const char* p) { const unsigned long long v = (unsigned long long)p; const unsigned lo = __builtin_amdgcn_readfirstlane((unsigned)v), hi = __builtin_amdgcn_readfirstlane((unsigned)(v >> 32)); return (const char*)(((unsigned long long)hi << 32) | lo); }
template <class Epi, class Sched, bool GATHER = false, bool FP8 = false>
__device__ __forceinline__ void gemm_phase(LAS unsigned char* lds, int wid, const Gemm g, const Sched& S, const Epi& E) {
    const int lane = lane_id(), tid = wid * 64 + lane, wr = wid >> 2, wc = wid & 3, fr = lane & 15, fq = lane >> 4;
    const int nt = g.K / BK;
    unsigned voffB[2]; unsigned vA0[2], vA1[2]; int RA[2], CA[2];
#pragma unroll
    for (int i = 0; i < 2; ++i) { int R, C; stage_rc(tid * 16 + i * 8192, R, C); const int pr = Epi::PERM ? perm32(R & 31) : (R & 31);
        RA[i] = R; CA[i] = C; voffB[i] = (unsigned)((64 * (R >> 5) + pr) * g.ldb + C) * 2u;
        vA0[i] = (unsigned)(R * g.lda + C) * 2u; vA1[i] = vA0[i]; }
    const size_t kstep = (size_t)(BK * 2);
    const size_t hstepA = GATHER ? (size_t)0 : (size_t)HALF * g.lda * 2, hstepB = (size_t)32 * g.ldb * 2;
    LAS u32x4* park = (LAS u32x4*)(lds + 131072 + 1024) + tid;
#define PG8_GOFF(U, d0, d1) do { _Pragma("unroll") for (int _i = 0; _i < 2; ++_i) { \
        d0[_i] = ((unsigned)(U).rows[RA[_i]] * (unsigned)g.lda + (unsigned)CA[_i]) * 2u; d1[_i] = ((unsigned)(U).rows[HALF + RA[_i]] * (unsigned)g.lda + (unsigned)CA[_i]) * 2u; } } while (0)
    const unsigned ldsw = (unsigned)wid * 1024u;
    const int aoff = lds_byte(wr * 64 + fr, fq * 8), boff = lds_byte(wc * 32 + fr, fq * 8);
#define PG8_SA(b, h) (((b) * 2 + (h)) * HTB)
#define PG8_SB(b, h) ((4 + (b) * 2 + (h)) * HTB)
#define PG8_STAGE(bufoff, gbase, voff) do { _Pragma("unroll") for (int _i = 0; _i < 2; ++_i) \
        __builtin_amdgcn_global_load_lds((const unsigned*)((const char*)(gbase) + (voff)[_i]), (LAS unsigned*)(lds + (bufoff) + ldsw + _i * 8192), 16, 0, 0); } while (0)
#define PG8_LD8(dst_, addr_) do { const u32x4 lo_ = *(const LAS u32x4*)(addr_), hi_ = *(const LAS u32x4*)((addr_) + 1024); \
        dst_ = (v8i32){(int)lo_.x, (int)lo_.y, (int)lo_.z, (int)lo_.w, (int)hi_.x, (int)hi_.y, (int)hi_.z, (int)hi_.w}; } while (0)
#define PG8_LDA(dst, b, h) do { _Pragma("unroll") for (int m = 0; m < 4; ++m) PG8_LD8(dst[m], lds + PG8_SA(b, h) + aoff + m * 2048); } while (0)
#define PG8_LDB(dst, b, h) do { _Pragma("unroll") for (int n = 0; n < 2; ++n) PG8_LD8(dst[n], lds + PG8_SB(b, h) + boff + n * 2048); } while (0)
#define PG8_HALF(v_, k_) __builtin_bit_cast(bf16x8, __builtin_shufflevector(v_, v_, 4 * (k_) + 0, 4 * (k_) + 1, 4 * (k_) + 2, 4 * (k_) + 3))
#define PG8_MMA(ai, bj, At, Bt) do { __builtin_amdgcn_s_setprio(1); _Pragma("unroll") for (int m = 0; m < 4; ++m) _Pragma("unroll") for (int n = 0; n < 2; ++n) { \
        if constexpr (FP8) asm volatile("v_mfma_scale_f32_16x16x128_f8f6f4 %0, %1, %2, %0, %3, %3 op_sel_hi:[0,0,0]" : "+v"(acc[ai][bj][m][n]) : "v"(Bt[n]), "v"(At[m]), "v"(one8_));   \
        else { acc[ai][bj][m][n] = __builtin_amdgcn_mfma_f32_16x16x32_bf16(PG8_HALF(Bt[n], 0), PG8_HALF(At[m], 0), acc[ai][bj][m][n], 0, 0, 0); \
               acc[ai][bj][m][n] = __builtin_amdgcn_mfma_f32_16x16x32_bf16(PG8_HALF(Bt[n], 1), PG8_HALF(At[m], 1), acc[ai][bj][m][n], 0, 0, 0); } } \
        __builtin_amdgcn_s_setprio(0); } while (0)
#define PG8_WAIT_V(n) asm volatile("s_waitcnt vmcnt(" #n ")" ::: "memory")
#define PG8_WAIT_L(n) asm volatile("s_waitcnt lgkmcnt(" #n ")" ::: "memory")
#define PG8_BAR __builtin_amdgcn_s_barrier()
#define PG8_SCHED __builtin_amdgcn_sched_barrier(0)
    Unit cur, nxt; int ui = 0;
    if (!S.next(0, cur)) return;
    f32x4 acc[2][2][4][2];
#pragma unroll
    for (int a = 0; a < 2; ++a)
#pragma unroll
        for (int b = 0; b < 2; ++b)
#pragma unroll
            for (int m = 0; m < 4; ++m)
#pragma unroll
                for (int n = 0; n < 2; ++n) acc[a][b][m][n] = (f32x4){0.f, 0.f, 0.f, 0.f};
    v8i32 At[4], B0[2], B1[2];
    const int one8_ = 0x7f7f7f7f;
    const char* cA = uniform_ptr(cur.A); const char* cB = uniform_ptr(cur.B);
    if constexpr (GATHER) { PG8_GOFF(cur, vA0, vA1); }
    PG8_STAGE(PG8_SB(0, 0), cB, voffB); PG8_STAGE(PG8_SB(0, 1), cB + hstepB, voffB); PG8_STAGE(PG8_SA(0, 0), cA, vA0); PG8_STAGE(PG8_SA(0, 1), cA + hstepA, vA1);
    if (wr == 1) PG8_BAR;
    PG8_WAIT_V(2); PG8_BAR;
    PG8_STAGE(PG8_SB(1, 0), cB + kstep, voffB); PG8_STAGE(PG8_SA(1, 0), cA + kstep, vA0); PG8_STAGE(PG8_SB(1, 1), cB + hstepB + kstep, voffB);
    PG8_WAIT_V(6); PG8_BAR;
    for (;;) {
        const bool has_next = S.next(ui + 1, nxt);
        const char* nA = has_next ? uniform_ptr(nxt.A) : cA; const char* nB = has_next ? uniform_ptr(nxt.B) : cB;
        if constexpr (GATHER) { unsigned n0[2] = {vA0[0], vA0[1]}, n1[2] = {vA1[0], vA1[1]}; if (has_next) { PG8_GOFF(nxt, n0, n1); } *park = (u32x4){n0[0], n0[1], n1[0], n1[1]}; }
#pragma nounroll
        for (int t = 0; t < nt; t += 2) {
            const bool last = (t == nt - 2);
            const char* a1 = cA + (size_t)(t + 1) * kstep;
            const char* a2 = uniform_ptr(last ? nA : cA + (size_t)(t + 2) * kstep); const char* b2 = uniform_ptr(last ? nB : cB + (size_t)(t + 2) * kstep);
            const char* a3 = a2 + kstep; const char* b3 = b2 + kstep;
            unsigned w0[2] = {vA0[0], vA0[1]}, w1[2] = {vA1[0], vA1[1]};
            if constexpr (GATHER) { if (last) { const u32x4 pk = *park; w0[0] = pk.x; w0[1] = pk.y; w1[0] = pk.z; w1[1] = pk.w; } }
            PG8_LDB(B0, 0, 0); PG8_LDB(B1, 0, 1); PG8_SCHED; PG8_LDA(At, 0, 0); PG8_STAGE(PG8_SA(1, 1), a1 + hstepA, vA1);
            PG8_WAIT_V(8); PG8_WAIT_L(0); PG8_BAR; PG8_MMA(0, 0, At, B0); PG8_MMA(0, 1, At, B1); PG8_BAR; PG8_SCHED;
            PG8_LDA(At, 0, 1); PG8_STAGE(PG8_SB(0, 0), b2, voffB); PG8_STAGE(PG8_SB(0, 1), b2 + hstepB, voffB); PG8_STAGE(PG8_SA(0, 0), a2, w0);
            PG8_WAIT_V(8); PG8_WAIT_L(0); PG8_BAR; PG8_MMA(1, 0, At, B0); PG8_MMA(1, 1, At, B1); PG8_BAR; PG8_SCHED;
            PG8_LDB(B0, 1, 0); PG8_LDB(B1, 1, 1); PG8_SCHED; PG8_LDA(At, 1, 0); PG8_STAGE(PG8_SA(0, 1), a2 + hstepA, w1);
            PG8_WAIT_V(8); PG8_WAIT_L(0); PG8_BAR; PG8_MMA(0, 0, At, B0); PG8_MMA(0, 1, At, B1); PG8_BAR; PG8_SCHED;
            PG8_LDA(At, 1, 1); PG8_STAGE(PG8_SB(1, 0), b3, voffB); PG8_STAGE(PG8_SB(1, 1), b3 + hstepB, voffB); PG8_STAGE(PG8_SA(1, 0), a3, w0);
            PG8_WAIT_V(8); PG8_WAIT_L(0); PG8_BAR; PG8_MMA(1, 0, At, B0); PG8_MMA(1, 1, At, B1); PG8_BAR; PG8_SCHED;
        }
        if (wr == 0) PG8_BAR;
        if constexpr (FP8) asm volatile("s_nop 15\n\ts_nop 7" ::: "memory");
        asm volatile("" ::: "memory");
        { const int l2_ = lane_id(); E(acc, cur, wr, wc, l2_ & 15, l2_ >> 4, lds + LDS_TBUF + wid * TBUF_W); }
        if (!has_next) break;
#pragma unroll
        for (int a = 0; a < 2; ++a)
#pragma unroll
            for (int b = 0; b < 2; ++b)
#pragma unroll
                for (int m = 0; m < 4; ++m)
#pragma unroll
                    for (int n = 0; n < 2; ++n) acc[a][b][m][n] = (f32x4){0.f, 0.f, 0.f, 0.f};
        cur = nxt; cA = nA; cB = nB; ++ui;
        if constexpr (GATHER) { const u32x4 pk = *park; vA0[0] = pk.x; vA0[1] = pk.y; vA1[0] = pk.z; vA1[1] = pk.w; }
        if (wr == 1) PG8_BAR;
    }
    PG8_WAIT_V(0);
    PG8_BAR;
#undef PG8_GOFF
#undef PG8_SA
#undef PG8_SB
#undef PG8_STAGE
#undef PG8_LD8
#undef PG8_HALF
#undef PG8_LDA
#undef PG8_LDB
#undef PG8_MMA
#undef PG8_WAIT_V
#undef PG8_WAIT_L
#undef PG8_BAR
#undef PG8_SCHED
}

struct PlainSched {
    TileOrder to; const char* A; const char* B; size_t tA, tB;
    __device__ __forceinline__ bool next(int i, Unit& u) const { int pm, pn; if (!to.get(i, pm, pn)) return false; u.pm = pm; u.pn = pn; u.aux = 0; u.rows = nullptr; u.A = A + (size_t)pm * tA; u.B = B + (size_t)pn * tB; return true; }
};
struct OneUnitSched {
    Unit u0;
    __device__ __forceinline__ bool next(int i, Unit& u) const { if (i != 0) return false; u = u0; return true; }
};
struct MemAttnSched {
    TileOrder to; const char* A; const char* B; size_t tA, hA, bB, hB;
    __device__ __forceinline__ bool next(int i, Unit& u) const { int pm, pn; if (!to.get(i, pm, pn)) return false; u.pm = pm; u.pn = pn; u.aux = 0; u.rows = nullptr;
        u.A = A + (size_t)pm * tA + (size_t)pn * hA; const int b = pm >> 5; u.B = B + (size_t)b * bB + (size_t)pn * hB; return true; }
};
struct MoeSched {
    int G, c, nblk; const unsigned* blk_e; const char* A; const char* B; size_t tA, eB, tB; const int* row_tok;
    __device__ __forceinline__ bool next(int i, Unit& u) const { const int L = i * G + c; if (L >= nblk * 4) return false; const int rb = L >> 2, pn = L & 3;
        const int e = (int)__builtin_amdgcn_readfirstlane(ld_u32_agent(blk_e + rb)); u.pm = rb; u.pn = pn; u.aux = e; u.rows = row_tok + (size_t)rb * 256;
        u.A = A + (size_t)rb * tA; u.B = B + (size_t)e * eB + (size_t)pn * tB; return true; }
};

#define EPI_ARGS f32x4 (&acc)[2][2][4][2], const Unit& u, int wr, int wc, int fr, int fq, LAS unsigned char* tb
__device__ __forceinline__ void st128(bf16_t* rowbase, size_t ldc, const u32x4 w0, const u32x4 w1, int fr, int fq, LAS unsigned char* tb) {
    *(LAS u32x4*)(tb + fr * 144 + fq * 16) = w0; *(LAS u32x4*)(tb + fr * 144 + 64 + fq * 16) = w1;
    const int L = fq * 16 + fr, r = L >> 3, c = L & 7;
    const u32x4 a = *(const LAS u32x4*)(tb + r * 144 + c * 16), b = *(const LAS u32x4*)(tb + (8 + r) * 144 + c * 16);
    *(u32x4*)(rowbase + (size_t)r * ldc + c * 8) = a; *(u32x4*)(rowbase + (size_t)(8 + r) * ldc + c * 8) = b;
}
__device__ __forceinline__ u32x4 pk8(const f32x4 v0, const f32x4 v1) { u32x4 w; w.x = cvt_pk_bf16(v0[0], v0[1]); w.y = cvt_pk_bf16(v0[2], v0[3]); w.z = cvt_pk_bf16(v1[0], v1[1]); w.w = cvt_pk_bf16(v1[2], v1[3]); return w; }
struct EpiZ {
    static constexpr bool PERM = true;
    bf16_t* O; unsigned* kmx;
    __device__ __forceinline__ void operator()(EPI_ARGS) const {
        const int mode = u.pn < 4 ? 1 : (u.pn < 6 ? 2 : 0);
        if (u.pn == 6 || u.pn == 7) {
#pragma unroll
            for (int bj = 0; bj < 2; ++bj) { float mx = 0.f;
#pragma unroll
                for (int ai = 0; ai < 2; ++ai)
#pragma unroll
                    for (int m = 0; m < 4; ++m) { const f32x4 a = acc[ai][bj][m][0], b = acc[ai][bj][m][1];
                        float q = (a[0] * a[0] + a[1] * a[1]) + (a[2] * a[2] + a[3] * a[3]) + (b[0] * b[0] + b[1] * b[1]) + (b[2] * b[2] + b[3] * b[3]);
                        q += __shfl_xor(q, 16); q += __shfl_xor(q, 32); mx = fmaxf(mx, q); }
#pragma unroll
                for (int o_ = 1; o_ < 16; o_ <<= 1) mx = fmaxf(mx, __shfl_xor(mx, o_));
                if (fr == 0 && fq == 0) { const int b_ = u.pm >> 5, h_ = (u.pn - 6) * 2 + (wc >> 1); atomicMax(kmx + (((b_ * 4 + h_) * 2 + (wc & 1)) * 2 + bj), __float_as_uint(mx)); } }
        }
#pragma unroll
        for (int ai = 0; ai < 2; ++ai)
#pragma unroll
            for (int m = 0; m < 4; ++m) { u32x4 w[2];
#pragma unroll
                for (int bj = 0; bj < 2; ++bj) { f32x4 v0 = acc[ai][bj][m][0], v1 = acc[ai][bj][m][1];
                    if (mode == 1) { f32x2g a = gelu_pk((f32x2g){v0[0], v0[1]}), b = gelu_pk((f32x2g){v0[2], v0[3]}), c = gelu_pk((f32x2g){v1[0], v1[1]}), d = gelu_pk((f32x2g){v1[2], v1[3]});
                        v0 = (f32x4){a.x, a.y, b.x, b.y}; v1 = (f32x4){c.x, c.y, d.x, d.y}; }
                    else if (mode == 2) { v0 = v0 * C2_DIFF; v1 = v1 * C2_DIFF; }
                    w[bj] = pk8(v0, v1); }
                st128(O + (size_t)(u.pm * BM + ai * HALF + wr * 64 + m * 16) * ZP + u.pn * BM + wc * 64, ZP, w[0], w[1], fr, fq, tb); }
    }
};
struct EpiBf16 {
    static constexpr bool PERM = true;
    bf16_t* O; int ldc; const float* ssq; float cscale;
    __device__ __forceinline__ void operator()(EPI_ARGS) const {
        float sc[2][4];
#pragma unroll
        for (int ai = 0; ai < 2; ++ai)
#pragma unroll
            for (int m = 0; m < 4; ++m) sc[ai][m] = cscale;
        if (ssq) {
#pragma unroll
            for (int ai = 0; ai < 2; ++ai)
#pragma unroll
                for (int m = 0; m < 4; ++m) { const f32x4 s4 = *(const f32x4*)(ssq + (size_t)(u.pm * BM + ai * HALF + wr * 64 + m * 16 + fr) * 4);
                    sc[ai][m] = cscale * __builtin_amdgcn_rsqf(((s4[0] + s4[1]) + (s4[2] + s4[3])) * (1.0f / DM) + RMS_EPS); }
        }
#pragma unroll
        for (int ai = 0; ai < 2; ++ai)
#pragma unroll
            for (int m = 0; m < 4; ++m) { const int rowg = u.pm * BM + ai * HALF + wr * 64 + m * 16; const float c = sc[ai][m];
                st128(O + (size_t)rowg * ldc + u.pn * BM + wc * 64, (size_t)ldc, pk8(acc[ai][0][m][0] * c, acc[ai][0][m][1] * c), pk8(acc[ai][1][m][0] * c, acc[ai][1][m][1] * c), fr, fq, tb); }
    }
};
struct EpiF8 {
    static constexpr bool PERM = true;
    unsigned char* O; int ldc; const float* ssq; float cscale;
    __device__ __forceinline__ void operator()(EPI_ARGS) const {
        const int L = fq * 16 + fr;
        float sc[2][4];
#pragma unroll
        for (int ai = 0; ai < 2; ++ai)
#pragma unroll
            for (int m = 0; m < 4; ++m) sc[ai][m] = cscale;
        if (ssq) {
#pragma unroll
            for (int ai = 0; ai < 2; ++ai)
#pragma unroll
                for (int m = 0; m < 4; ++m) { const f32x4 s4 = *(const f32x4*)(ssq + (size_t)(u.pm * BM + ai * HALF + wr * 64 + m * 16 + fr) * 4);
                    sc[ai][m] = cscale * __builtin_amdgcn_rsqf(((s4[0] + s4[1]) + (s4[2] + s4[3])) * (1.0f / DM) + RMS_EPS); }
        }
#pragma unroll
        for (int ai = 0; ai < 2; ++ai)
#pragma unroll
            for (int m = 0; m < 4; ++m) { const int rowg = u.pm * BM + ai * HALF + wr * 64 + m * 16; const float c = sc[ai][m];
#pragma unroll
                for (int bj = 0; bj < 2; ++bj) { const f32x4 a = acc[ai][bj][m][0] * c, b = acc[ai][bj][m][1] * c; u32x2 f; f.x = pk4_fp8(a[0], a[1], a[2], a[3]); f.y = pk4_fp8(b[0], b[1], b[2], b[3]);
                    *(LAS u32x2*)(tb + fr * 144 + bj * 32 + fq * 8) = f; }
                const u32x4 v8 = *(const LAS u32x4*)(tb + (L >> 2) * 144 + (L & 3) * 16);
                *(u32x4*)(O + (size_t)(rowg + (L >> 2)) * ldc + u.pn * BM + wc * 64 + (L & 3) * 16) = v8; }
    }
};
struct EpiSoftmax {
    static constexpr bool PERM = true;
    unsigned char* O; LAS float* xch; float sscale;
    __device__ __forceinline__ void operator()(EPI_ARGS) const {
        LAS float* xm = xch; LAS float* xs = xch + 1024;
#pragma unroll
        for (int ai = 0; ai < 2; ++ai)
#pragma unroll
            for (int bj = 0; bj < 2; ++bj)
#pragma unroll
                for (int m = 0; m < 4; ++m)
#pragma unroll
                    for (int n = 0; n < 2; ++n) acc[ai][bj][m][n] = acc[ai][bj][m][n] * sscale;
#pragma unroll
        for (int ai = 0; ai < 2; ++ai)
#pragma unroll
            for (int m = 0; m < 4; ++m) { float v = -__builtin_inff();
#pragma unroll
                for (int bj = 0; bj < 2; ++bj)
#pragma unroll
                    for (int n = 0; n < 2; ++n) { const f32x4 a = acc[ai][bj][m][n]; v = fmaxf(v, fmaxf(fmaxf(a[0], a[1]), fmaxf(a[2], a[3]))); }
                v = fmaxf(v, __shfl_xor(v, 16)); v = fmaxf(v, __shfl_xor(v, 32));
                if (fq == 0) xm[(ai * HALF + wr * 64 + m * 16 + fr) * 4 + wc] = v; }
        asm volatile("s_waitcnt lgkmcnt(0)" ::: "memory"); __builtin_amdgcn_s_barrier(); asm volatile("" ::: "memory");
#pragma unroll
        for (int ai = 0; ai < 2; ++ai)
#pragma unroll
            for (int m = 0; m < 4; ++m) { const f32x4 t = *(const LAS f32x4*)(xm + (ai * HALF + wr * 64 + m * 16 + fr) * 4); const float mx = fmaxf(fmaxf(t[0], t[1]), fmaxf(t[2], t[3])); float sm = 0.f;
#pragma unroll
                for (int bj = 0; bj < 2; ++bj)
#pragma unroll
                    for (int n = 0; n < 2; ++n) { f32x4 a = acc[ai][bj][m][n];
#pragma unroll
                        for (int j = 0; j < 4; ++j) { a[j] = __builtin_amdgcn_exp2f(a[j] - mx); sm += a[j]; }
                        acc[ai][bj][m][n] = a; }
                sm += __shfl_xor(sm, 16); sm += __shfl_xor(sm, 32);
                if (fq == 0) xs[(ai * HALF + wr * 64 + m * 16 + fr) * 4 + wc] = sm; }
        asm volatile("s_waitcnt lgkmcnt(0)" ::: "memory"); __builtin_amdgcn_s_barrier(); asm volatile("" ::: "memory");
#pragma unroll
        for (int ai = 0; ai < 2; ++ai)
#pragma unroll
            for (int m = 0; m < 4; ++m) { const f32x4 t = *(const LAS f32x4*)(xs + (ai * HALF + wr * 64 + m * 16 + fr) * 4); const float inv = F8_PSCALE * __builtin_amdgcn_rcpf((t[0] + t[1]) + (t[2] + t[3]));
                const int rowg = u.pm * BM + ai * HALF + wr * 64 + m * 16, L = fq * 16 + fr;
#pragma unroll
                for (int bj = 0; bj < 2; ++bj) { const f32x4 a = acc[ai][bj][m][0] * inv, b = acc[ai][bj][m][1] * inv; u32x2 f; f.x = pk4_fp8(a[0], a[1], a[2], a[3]); f.y = pk4_fp8(b[0], b[1], b[2], b[3]);
                    *(LAS u32x2*)(tb + fr * 144 + bj * 32 + fq * 8) = f; }
                const u32x4 v8 = *(const LAS u32x4*)(tb + (L >> 2) * 144 + (L & 3) * 16);
                *(u32x4*)(O + (size_t)(rowg + (L >> 2)) * DM + u.pn * BM + wc * 64 + (L & 3) * 16) = v8; }
    }
};
template <bool BF>
struct EpiResid {
    static constexpr bool PERM = true;
    const void* base; bf16_t* ob; float* ssq; LAS float* xs; unsigned char* o8; float as;
    __device__ __forceinline__ void operator()(EPI_ARGS) const {
        const int col0 = u.pn * BM + wc * 64 + 8 * fq;
        if constexpr (BF) {
            u32x4 br[2][4][2];
#pragma unroll
            for (int ai = 0; ai < 2; ++ai)
#pragma unroll
                for (int m = 0; m < 4; ++m)
#pragma unroll
                    for (int bj = 0; bj < 2; ++bj) br[ai][m][bj] = *(const u32x4*)((const bf16_t*)base + (size_t)(u.pm * BM + ai * HALF + wr * 64 + m * 16 + fr) * DM + col0 + bj * 32);
#pragma unroll
            for (int ai = 0; ai < 2; ++ai)
#pragma unroll
                for (int m = 0; m < 4; ++m) asm volatile("" : "+v"(br[ai][m][0]), "+v"(br[ai][m][1]));
#pragma unroll
            for (int ai = 0; ai < 2; ++ai)
#pragma unroll
                for (int m = 0; m < 4; ++m) { const int rowg = u.pm * BM + ai * HALF + wr * 64 + m * 16, row = rowg + fr; float s = 0.f; u32x4 w[2]; u32x2 f8[2];
#pragma unroll
                    for (int bj = 0; bj < 2; ++bj) { const u32x4 r = br[ai][m][bj];
                        const f32x4 o0 = (f32x4){bf_lo(r.x), bf_hi(r.x), bf_lo(r.y), bf_hi(r.y)} + acc[ai][bj][m][0] * as, o1 = (f32x4){bf_lo(r.z), bf_hi(r.z), bf_lo(r.w), bf_hi(r.w)} + acc[ai][bj][m][1] * as;
                        s += (o0[0] * o0[0] + o0[1] * o0[1]) + (o0[2] * o0[2] + o0[3] * o0[3]) + (o1[0] * o1[0] + o1[1] * o1[1]) + (o1[2] * o1[2] + o1[3] * o1[3]);
                        w[bj] = pk8(o0, o1);
                        f8[bj].x = pk4_fp8(o0[0] * F8_XSCALE, o0[1] * F8_XSCALE, o0[2] * F8_XSCALE, o0[3] * F8_XSCALE); f8[bj].y = pk4_fp8(o1[0] * F8_XSCALE, o1[1] * F8_XSCALE, o1[2] * F8_XSCALE, o1[3] * F8_XSCALE); }
                    st128(ob + (size_t)rowg * DM + u.pn * BM + wc * 64, (size_t)DM, w[0], w[1], fr, fq, tb);
                    if (o8) {
                        *(LAS u32x2*)(tb + fr * 144 + fq * 8) = f8[0]; *(LAS u32x2*)(tb + fr * 144 + 32 + fq * 8) = f8[1];
                        const int L = fq * 16 + fr; const u32x4 v8 = *(const LAS u32x4*)(tb + (L >> 2) * 144 + (L & 3) * 16);
                        *(u32x4*)(o8 + (size_t)(rowg + (L >> 2)) * DM + u.pn * BM + wc * 64 + (L & 3) * 16) = v8; }
                    s += __shfl_xor(s, 16); s += __shfl_xor(s, 32);
                    if (fq == 0) xs[(ai * HALF + wr * 64 + m * 16 + fr) * 4 + wc] = s; }
        } else {
#pragma unroll
            for (int ai = 0; ai < 2; ++ai) {
                f32x4 br[4][2][2];
#pragma unroll
                for (int m = 0; m < 4; ++m)
#pragma unroll
                    for (int bj = 0; bj < 2; ++bj) { const float* p = (const float*)base + (size_t)(u.pm * BM + ai * HALF + wr * 64 + m * 16 + fr) * DM + col0 + bj * 32; br[m][bj][0] = *(const f32x4*)p; br[m][bj][1] = *(const f32x4*)(p + 4); }
#pragma unroll
                for (int m = 0; m < 4; ++m) asm volatile("" : "+v"(br[m][0][0]), "+v"(br[m][0][1]), "+v"(br[m][1][0]), "+v"(br[m][1][1]));
#pragma unroll
                for (int m = 0; m < 4; ++m) { const int rowg = u.pm * BM + ai * HALF + wr * 64 + m * 16; float s = 0.f; u32x4 w[2]; u32x2 f8[2];
#pragma unroll
                    for (int bj = 0; bj < 2; ++bj) { const f32x4 o0 = br[m][bj][0] + acc[ai][bj][m][0] * as, o1 = br[m][bj][1] + acc[ai][bj][m][1] * as;
                        s += (o0[0] * o0[0] + o0[1] * o0[1]) + (o0[2] * o0[2] + o0[3] * o0[3]) + (o1[0] * o1[0] + o1[1] * o1[1]) + (o1[2] * o1[2] + o1[3] * o1[3]);
                        w[bj] = pk8(o0, o1);
                        f8[bj].x = pk4_fp8(o0[0] * F8_XSCALE, o0[1] * F8_XSCALE, o0[2] * F8_XSCALE, o0[3] * F8_XSCALE); f8[bj].y = pk4_fp8(o1[0] * F8_XSCALE, o1[1] * F8_XSCALE, o1[2] * F8_XSCALE, o1[3] * F8_XSCALE); }
                    st128(ob + (size_t)rowg * DM + u.pn * BM + wc * 64, (size_t)DM, w[0], w[1], fr, fq, tb);
                    if (o8) {
                        *(LAS u32x2*)(tb + fr * 144 + fq * 8) = f8[0]; *(LAS u32x2*)(tb + fr * 144 + 32 + fq * 8) = f8[1];
                        const int L = fq * 16 + fr; const u32x4 v8 = *(const LAS u32x4*)(tb + (L >> 2) * 144 + (L & 3) * 16);
                        *(u32x4*)(o8 + (size_t)(rowg + (L >> 2)) * DM + u.pn * BM + wc * 64 + (L & 3) * 16) = v8; }
                    s += __shfl_xor(s, 16); s += __shfl_xor(s, 32);
                    if (fq == 0) xs[(ai * HALF + wr * 64 + m * 16 + fr) * 4 + wc] = s; }
            }
        }
        asm volatile("s_waitcnt lgkmcnt(0)" ::: "memory"); __builtin_amdgcn_s_barrier(); asm volatile("" ::: "memory");
        { const int t_ = (wr * 4 + wc) * 64 + fq * 16 + fr;
          if (t_ < 256) { const f32x4 p = *(const LAS f32x4*)(xs + t_ * 4); ssq[(size_t)(u.pm * BM + t_) * 4 + u.pn] = (p[0] + p[1]) + (p[2] + p[3]); } }
    }
};
struct EpiRouter {
    static constexpr bool PERM = false;
    float* L; const float* ssq; const float* bg; const float* be; float* rstd_out;
    __device__ __forceinline__ void operator()(EPI_ARGS) const {
        if (wc != 0) return;
        const int row0 = u.pm * BM + wr * 64 + fr;
        float rsv[2][4];
#pragma unroll
        for (int ai = 0; ai < 2; ++ai)
#pragma unroll
            for (int m = 0; m < 4; ++m) { const f32x4 s4 = *(const f32x4*)(ssq + (size_t)(row0 + ai * HALF + m * 16) * 4);
                rsv[ai][m] = __builtin_amdgcn_rsqf(((s4[0] + s4[1]) + (s4[2] + s4[3])) * (1.0f / DM) + RMS_EPS); }
#pragma unroll
        for (int ai = 0; ai < 2; ++ai)
#pragma unroll
            for (int m = 0; m < 4; ++m) { const int row = row0 + ai * HALF + m * 16; const float rs = rsv[ai][m];
                if (fq == 0) rstd_out[row] = rs;
#pragma unroll
                for (int bj = 0; bj < 2; ++bj)
#pragma unroll
                    for (int n = 0; n < 2; ++n) { const int c0 = bj * 32 + n * 16 + 4 * fq; f32x4 o = acc[ai][bj][m][n] * rs;
#pragma unroll
                        for (int j = 0; j < 4; ++j) { const int c = c0 + j; const float b = c < 4 ? bg[c] : (c < 36 ? be[c - 4] : 0.f); o[j] += b; }
                        *(f32x4*)(L + (size_t)row * 64 + c0) = o; } }
    }
};
struct EpiGateUp {
    static constexpr bool PERM = true;
    unsigned char* act; const float* rstd; const int* row_tok;
    __device__ __forceinline__ void operator()(EPI_ARGS) const {
        const int row0 = u.pm * BM + wr * 64 + fr, col0 = u.pn * 128 + wc * 32 + 8 * fq;
        float rsv[2][4];
#pragma unroll
        for (int ai = 0; ai < 2; ++ai)
#pragma unroll
            for (int m = 0; m < 4; ++m) rsv[ai][m] = rstd[row0 + ai * HALF + m * 16];
#pragma unroll
        for (int ai = 0; ai < 2; ++ai)
#pragma unroll
            for (int m = 0; m < 4; ++m) { const int row = row0 + ai * HALF + m * 16; const float rs = rsv[ai][m];
                float r[8];
#pragma unroll
                for (int n = 0; n < 2; ++n)
#pragma unroll
                    for (int j = 0; j < 4; ++j) { const float gg = acc[ai][0][m][n][j] * rs, uu = acc[ai][1][m][n][j] * rs;
                        r[n * 4 + j] = gg * __builtin_amdgcn_rcpf(1.0f + __builtin_amdgcn_exp2f(-gg * LOG2E)) * uu; }
                u32x2 w; w.x = pk4_fp8(r[0] * F8_ASCALE, r[1] * F8_ASCALE, r[2] * F8_ASCALE, r[3] * F8_ASCALE); w.y = pk4_fp8(r[4] * F8_ASCALE, r[5] * F8_ASCALE, r[6] * F8_ASCALE, r[7] * F8_ASCALE);
                *(u32x2*)(act + (size_t)row * DEXP + col0) = w; }
    }
};
}

namespace da {
constexpr int NW = 8, QBLK = 32, KVBLK = 64, QB = NW * QBLK, DV = 128;
constexpr int SHM_V = KVBLK * DV * 2, SHM_K = KVBLK * 64 * 2;
constexpr int LDS_V = 0, LDS_K = 2 * SHM_V, LDS_WS = LDS_K + 2 * SHM_K, LDS_CX = LDS_WS + NW * 64 * 4, LDS_STASH = LDS_CX + 256, LDS_BYTES = LDS_STASH + NW * 8192;
constexpr float SKIP_MARGIN = 40.f;
constexpr float THR = 8.f;
#define SBAR() __builtin_amdgcn_sched_barrier(0)
__device__ __forceinline__ int kswz(int row, int chunk) { return row * 128 + ((chunk ^ ((row >> 1) & 7)) << 4); }
__device__ __forceinline__ int v_st(int k, int c) { const int kk = (k & ~0xC) | ((k & 4) << 1) | ((k & 8) >> 1); return ((kk >> 3) * 4 + (c >> 5)) * 512 + ((kk & 7) * 32 + (c & 31)) * 2; }
__device__ __forceinline__ int v_rd_base(int lane) { return ((lane & 3) << 3) | (((lane >> 2) & 3) << 6) | (((lane >> 4) & 1) << 5) | (((lane >> 5) & 1) << 8); }
constexpr int v_rd_off(int d0, int ks, int half) { return d0 * 512 + ks * 4096 + half * 2048; }
__device__ __forceinline__ int crow(int r, int hi) { return (r & 3) + 8 * (r >> 2) + 4 * hi; }
__device__ __forceinline__ bf16x8 load8(const bf16_t* p) { return *reinterpret_cast<const bf16x8*>(p); }

__device__ __forceinline__ void mask_tile(f32x16& p0, f32x16& p1, int dq) {
    const float NEG = -__builtin_inff();
#pragma unroll
    for (int r = 0; r < 16; ++r) { const int c = (r & 3) + 8 * (r >> 2); if (dq - c < 0) p0[r] = NEG; if (dq - c - 32 < 0) p1[r] = NEG; }
}
__device__ __forceinline__ void partialSM(f32x16& p0, f32x16& p1, float& m_reg, float& alpha, float l_reg) {
    float pmax = p0[0];
#pragma unroll
    for (int r = 1; r < 16; ++r) pmax = fmaxf(pmax, p0[r]);
#pragma unroll
    for (int r = 0; r < 16; ++r) pmax = fmaxf(pmax, p1[r]);
    { auto rr = __builtin_amdgcn_permlane32_swap(__float_as_uint(pmax), __float_as_uint(pmax), false, false); pmax = fmaxf(__uint_as_float(rr[0]), __uint_as_float(rr[1])); }
    const bool need = (pmax > THR) || (l_reg == 0.f && pmax > -__builtin_inff());
    if (__builtin_expect(__all(!need), 1)) { alpha = 1.f; }
    else { const float d = need ? pmax : 0.f; alpha = (l_reg == 0.f) ? 1.f : __builtin_amdgcn_exp2f(-d); m_reg += d;
#pragma unroll
        for (int r = 0; r < 16; ++r) p0[r] = p0[r] - d;
#pragma unroll
        for (int r = 0; r < 16; ++r) p1[r] = p1[r] - d; }
#pragma unroll
    for (int r = 0; r < 16; ++r) p0[r] = __builtin_amdgcn_exp2f(p0[r]);
}
__device__ __forceinline__ void finishSM(f32x16& p0, f32x16& p1, float alpha, float& l_reg, bf16x8& pa0, bf16x8& pa1, bf16x8& pa2, bf16x8& pa3) {
#pragma unroll
    for (int r = 0; r < 16; ++r) p1[r] = __builtin_amdgcn_exp2f(p1[r]);
    float ps = 0;
#pragma unroll
    for (int r = 0; r < 16; ++r) ps += p0[r];
#pragma unroll
    for (int r = 0; r < 16; ++r) ps += p1[r];
    { auto rr = __builtin_amdgcn_permlane32_swap(__float_as_uint(ps), __float_as_uint(ps), false, false); ps = __uint_as_float(rr[0]) + __uint_as_float(rr[1]); }
    l_reg = l_reg * alpha + ps;
#define PK4(P, B_, OUT) do { unsigned a0 = cvt_pk_bf16(P[B_+0], P[B_+1]), a1 = cvt_pk_bf16(P[B_+2], P[B_+3]);                          \
        unsigned b0 = cvt_pk_bf16(P[B_+4], P[B_+5]), b1 = cvt_pk_bf16(P[B_+6], P[B_+7]);                                             \
        auto r0 = __builtin_amdgcn_permlane32_swap(a0, b0, false, false); auto r1 = __builtin_amdgcn_permlane32_swap(a1, b1, false, false); \
        u32x4 w = {r0[0], r1[0], r0[1], r1[1]}; OUT = *reinterpret_cast<bf16x8*>(&w); } while (0)
    PK4(p0, 0, pa0); PK4(p0, 8, pa1); PK4(p1, 0, pa2); PK4(p1, 8, pa3);
#undef PK4
}
template <int KB>
__device__ __forceinline__ void qkt(f32x16& p0, f32x16& p1, const char* K_lds, int r32, int hi, const bf16x8* qr, float ab, float slope2) {
    const float s32 = 32.f * slope2;
#pragma unroll
    for (int r = 0; r < 16; ++r) { p0[r] = fmaf(slope2, (float)((r & 3) + 8 * (r >> 2)), ab); p1[r] = p0[r] + s32; }
#pragma unroll
    for (int d0 = 0; d0 < 4; ++d0) { const char* a = K_lds + KB * SHM_K + kswz(r32, d0 * 2 + hi);
        bf16x8 b0 = *reinterpret_cast<const bf16x8*>(a);
        bf16x8 b1 = *reinterpret_cast<const bf16x8*>(a + 32 * 128);
        p0 = __builtin_amdgcn_mfma_f32_32x32x16_bf16(b0, qr[d0], p0, 0, 0, 0);
        p1 = __builtin_amdgcn_mfma_f32_32x32x16_bf16(b1, qr[d0], p1, 0, 0, 0); }
}
template <int VB>
__device__ __forceinline__ void pv_tile(f32x16* o, int vb0, bf16x8 pa0, bf16x8 pa1, bf16x8 pa2, bf16x8 pa3) {
#define TRRD(dst, off) asm volatile("ds_read_b64_tr_b16 %0, %1 offset:%2" : "=&v"(dst) : "v"(vb0), "i"(off) : "memory")
#define PV_D0(d0) do { s16x4 l0, l1, l2, l3, h0, h1, h2, h3; constexpr int b_ = VB * SHM_V + v_rd_off(d0, 0, 0); \
        TRRD(l0, b_); TRRD(h0, b_ + 2048); TRRD(l1, b_ + 4096); TRRD(h1, b_ + 6144); TRRD(l2, b_ + 8192); TRRD(h2, b_ + 10240); TRRD(l3, b_ + 12288); TRRD(h3, b_ + 14336); \
        asm volatile("s_waitcnt lgkmcnt(0)" ::: "memory"); SBAR();   \
        o[d0] = __builtin_amdgcn_mfma_f32_32x32x16_bf16(pa0, (bf16x8){l0[0], l0[1], l0[2], l0[3], h0[0], h0[1], h0[2], h0[3]}, o[d0], 0, 0, 0);   \
        o[d0] = __builtin_amdgcn_mfma_f32_32x32x16_bf16(pa1, (bf16x8){l1[0], l1[1], l1[2], l1[3], h1[0], h1[1], h1[2], h1[3]}, o[d0], 0, 0, 0);   \
        o[d0] = __builtin_amdgcn_mfma_f32_32x32x16_bf16(pa2, (bf16x8){l2[0], l2[1], l2[2], l2[3], h2[0], h2[1], h2[2], h2[3]}, o[d0], 0, 0, 0);   \
        o[d0] = __builtin_amdgcn_mfma_f32_32x32x16_bf16(pa3, (bf16x8){l3[0], l3[1], l3[2], l3[3], h3[0], h3[1], h3[2], h3[3]}, o[d0], 0, 0, 0); } while (0)
    PV_D0(0); PV_D0(1); PV_D0(2); PV_D0(3);
#undef PV_D0
#undef TRRD
}

struct BlockRef { const bf16_t* Q; const bf16_t* K; const bf16_t* V; bf16_t* O; int P0; int mode; float slope2; float kmax; };
struct Seam { bf16x8 qr[4]; bf16x8 st_v0, st_v1, st_k0; };
__device__ __forceinline__ BlockRef mkref(const bf16_t* Z, bf16_t* AO, const float* kmt  , int b, int combo, int mp) { BlockRef r; const int h = combo >> 5, qb = combo & 31;
    const bf16_t* zb = Z + (size_t)b * SEQ * ZP; r.Q = zb + (size_t)(qb * 256) * ZP + ZQ + h * 128 + mp * 64; r.K = zb + ZK + h * 128 + mp * 64; r.V = zb + ZVAL + h * 128;
    r.O = AO + ((size_t)b * SEQ + qb * 256) * DM + 512 + h * 128; r.P0 = qb * 256; r.mode = mp; r.slope2 = exp2f(-2.0f * (float)(h + 1)) * LOG2E;
    r.kmax = kmt[h * 2 + mp]; return r; }
#define ROWV(p, k0, rr) ((p) + (size_t)((k0) + (rr)) * ZP + sc)
#define ROWK(p, k0) ((p) + (size_t)((k0) + skr) * ZP + skc * 8)
#define VMW() asm volatile("s_waitcnt vmcnt(0)" ::: "memory")
#define VMWN(n) asm volatile("s_waitcnt vmcnt(%0)" :: "i"(n) : "memory")
#define SLOAD_H(Kp, Vp, k0) do { S.st_v0 = load8(ROWV(Vp, k0, sr)); S.st_v1 = load8(ROWV(Vp, k0, 32 + sr)); S.st_k0 = load8(ROWK(Kp, k0)); } while (0)
#define SWRITE_HK(bf) do { *(bf16x8*)(K_lds + (bf) * SHM_K + kws) = S.st_k0; } while (0)
#define SWRITE_HV(bf) do { *(bf16x8*)(V_lds + (bf) * SHM_V + vst0) = S.st_v0; *(bf16x8*)(V_lds + (bf) * SHM_V + vst1) = S.st_v1; } while (0)
#define SWRITE_H(bf) do { SWRITE_HV(bf); SWRITE_HK(bf); } while (0)
__device__ __forceinline__ void prime(const BlockRef& cur, char* lds, Seam& S, int wid) {
    const int lane = lane_id(), tid = wid * 64 + lane, r32 = lane & 31, hi = lane >> 5;
    const int sr = tid >> 4, sc = (tid & 15) * 8, skr = tid >> 3, skc = tid & 7, kws = kswz(skr, skc); char* K_lds = lds + LDS_K;
#pragma unroll
    for (int d0 = 0; d0 < 4; ++d0) S.qr[d0] = load8(cur.Q + (size_t)(wid * QBLK + r32) * ZP + d0 * 16 + hi * 8);
    SLOAD_H(cur.K, cur.V, cur.P0 + QB - KVBLK); VMW(); SWRITE_HK(0);
    __syncthreads();
}
__device__ __forceinline__ void block(const BlockRef& cur, const BlockRef& nxt, char* lds, Seam& S, float lam, const float* __restrict__ subln, int wid) {
    const int lane = lane_id(), tid = wid * 64 + lane, r32 = lane & 31, hi = lane >> 5;
    const int NT0 = (cur.P0 + QB) / KVBLK;
    int NT = NT0;
    const int qlo = cur.P0 + wid * QBLK, qm = qlo + r32 - 4 * hi;
    const float slope2 = cur.slope2;
    char* V_lds = lds + LDS_V; char* K_lds = lds + LDS_K;
    float* ws = (float*)(lds + LDS_WS) + wid * 64; float* li_l = ws, * al_l = ws + 32;
    float m_reg = 0.f, l_reg = 0; f32x16 o[4] = {};
    const int sr = tid >> 4, sc = (tid & 15) * 8, vst0 = v_st(sr, sc), vst1 = v_st(32 + sr, sc), skr = tid >> 3, skc = tid & 7, kws = kswz(skr, skc);
    const int vb0 = (int)(uintptr_t)V_lds + v_rd_base(lane);
    const bf16_t* Kh = cur.K; const bf16_t* Vh = cur.V;
#define RESC(a) do { if (__any((a) < 1.f)) { if (hi == 0) al_l[r32] = (a); asm volatile("s_waitcnt lgkmcnt(0)" ::: "memory");              \
                     for (int d_ = 0; d_ < 4; ++d_) for (int r = 0; r < 16; ++r) o[d_][r] *= al_l[crow(r, hi)]; } } while (0)
#define KBASE(t) ((NT0 - 1 - (t)) * KVBLK)
#define AB(t) (slope2 * (float)(KBASE(t) - qm) - m_reg)
#define MASKT(P0_, P1_, t) do { const int kb_ = KBASE(t); if (kb_ + KVBLK - 1 > qlo) mask_tile(P0_, P1_, qm - kb_); } while (0)
    constexpr int NQL = 4;
#define SEAM_K0() do { VMWN(NQL); SWRITE_HK(0); SBAR(); } while (0)
    f32x16 pA0, pA1, pB0, pB1; float alA, alB; bf16x8 pa0, pa1, pa2, pa3;
    float cbase;
    { float q2 = 0.f;
#pragma unroll
      for (int d0 = 0; d0 < 4; ++d0)
#pragma unroll
          for (int j = 0; j < 8; ++j) { const float v = __uint_as_float(((unsigned)(unsigned short)S.qr[d0][j]) << 16); q2 = fmaf(v, v, q2); }
      { auto rr = __builtin_amdgcn_permlane32_swap(__float_as_uint(q2), __float_as_uint(q2), false, false); q2 = __uint_as_float(rr[0]) + __uint_as_float(rr[1]); }
      cbase = sqrtf(q2) * cur.kmax * 1.0001f - slope2 * (float)(qlo + r32); }
    SWRITE_HV(0); SBAR();
    if (NT > 1) { SLOAD_H(Kh, Vh, KBASE(1)); }
    SBAR(); qkt<0>(pA0, pA1, K_lds, r32, hi, S.qr, AB(0), slope2);
    MASKT(pA0, pA1, 0); partialSM(pA0, pA1, m_reg, alA, l_reg);
    if (NT > 1) { VMW(); SWRITE_H(1); }
    __syncthreads();
#define HALF_STEP(PX0, PX1, alX, PY0, PY1, alY, t, KB, VB, SB) do {                                                      \
        SBAR(); qkt<KB>(PX0, PX1, K_lds, r32, hi, S.qr, AB(t), slope2);                                                   \
        finishSM(PY0, PY1, alY, l_reg, pa0, pa1, pa2, pa3); SBAR();                                                       \
        if ((t) + 1 < NT) { SLOAD_H(Kh, Vh, KBASE((t) + 1)); SBAR(); }                                                    \
        pv_tile<VB>(o, vb0, pa0, pa1, pa2, pa3); MASKT(PX0, PX1, (t)); partialSM(PX0, PX1, m_reg, alX, l_reg);                   \
        __syncthreads();                                                                                                  \
        if ((t) + 1 < NT) { VMW(); SWRITE_H(SB); }                                                                        \
        RESC(alX); __syncthreads(); } while (0)
    for (int t = 1; t + 1 < NT; t += 2) {
        HALF_STEP(pB0, pB1, alB, pA0, pA1, alA, t, 1, 0, 0);
        HALF_STEP(pA0, pA1, alA, pB0, pB1, alB, t + 1, 0, 1, 1);
        if (t == 3 && NT0 > 6) {
            float c = cbase - m_reg;
#pragma unroll
            for (int o_ = 1; o_ < 64; o_ <<= 1) c = fmaxf(c, __shfl_xor(c, o_));
            float* cx = (float*)(lds + LDS_CX);
            if (lane == 0) cx[wid] = c;
            __syncthreads();
            float C = cx[0];
#pragma unroll
            for (int w_ = 1; w_ < NW; ++w_) C = fmaxf(C, cx[w_]);
            const float X = (-SKIP_MARGIN - C) / slope2 - 63.f;
            const float need_f = (float)(NT0 - 1) - X * (1.0f / 64.0f);
            if (need_f < (float)NT0) { int n = (int)ceilf(need_f); n = n < 6 ? 6 : n; n = (n + 1) & ~1; NT = n < NT0 ? n : NT0; }
        }
    }
    SBAR(); qkt<1>(pB0, pB1, K_lds, r32, hi, S.qr, AB(NT - 1), slope2); SBAR();
    SLOAD_H(nxt.K, nxt.V, nxt.P0 + QB - KVBLK); SBAR();
#pragma unroll
    for (int d0 = 0; d0 < 4; ++d0) S.qr[d0] = load8(nxt.Q + (size_t)(wid * QBLK + r32) * ZP + d0 * 16 + hi * 8);
    SBAR();
    finishSM(pA0, pA1, alA, l_reg, pa0, pa1, pa2, pa3); SBAR();
    pv_tile<0>(o, vb0, pa0, pa1, pa2, pa3);
    MASKT(pB0, pB1, NT - 1); partialSM(pB0, pB1, m_reg, alB, l_reg); __syncthreads(); RESC(alB);
    finishSM(pB0, pB1, alB, l_reg, pa0, pa1, pa2, pa3); SBAR(); pv_tile<1>(o, vb0, pa0, pa1, pa2, pa3);
    SBAR(); SEAM_K0();
    if (hi == 0) li_l[r32] = l_reg; asm volatile("s_waitcnt lgkmcnt(0)" ::: "memory");
    float rli[16];
#pragma unroll
    for (int r = 0; r < 16; ++r) rli[r] = __builtin_amdgcn_rcpf(li_l[crow(r, hi)]);
    unsigned* stash = (unsigned*)(lds + LDS_STASH) + wid * 2048 + lane;
    if (cur.mode == 0) {
#pragma unroll
        for (int r = 0; r < 16; ++r) { stash[(r * 2 + 0) * 64] = cvt_pk_bf16(o[0][r] * rli[r], o[1][r] * rli[r]); stash[(r * 2 + 1) * 64] = cvt_pk_bf16(o[2][r] * rli[r], o[3][r] * rli[r]); }
    } else {
        float ssq[16];
#pragma unroll
        for (int r = 0; r < 16; ++r) { const unsigned w0 = stash[(r * 2 + 0) * 64], w1 = stash[(r * 2 + 1) * 64];
            o[0][r] = bf_lo(w0) - lam * (o[0][r] * rli[r]); o[1][r] = bf_hi(w0) - lam * (o[1][r] * rli[r]);
            o[2][r] = bf_lo(w1) - lam * (o[2][r] * rli[r]); o[3][r] = bf_hi(w1) - lam * (o[3][r] * rli[r]);
            ssq[r] = (o[0][r] * o[0][r] + o[1][r] * o[1][r]) + (o[2][r] * o[2][r] + o[3][r] * o[3][r]); }
#pragma unroll
        for (int r = 0; r < 16; ++r) {
#pragma unroll
            for (int off = 1; off < 32; off <<= 1) ssq[r] += __shfl_xor(ssq[r], off);
            ssq[r] = __builtin_amdgcn_rsqf(ssq[r] * (1.0f / DV) + RMS_EPS); }
        float g4[4];
#pragma unroll
        for (int d0 = 0; d0 < 4; ++d0) g4[d0] = subln[d0 * 32 + r32] * 0.8f;
        bf16_t* Ow = cur.O + (size_t)(wid * QBLK) * DM;
#pragma unroll
        for (int r = 0; r < 16; ++r) { const int orow = crow(r, hi);
#pragma unroll
            for (int d0 = 0; d0 < 4; ++d0) { const float v = o[d0][r] * ssq[r] * g4[d0]; const float vn = __shfl_xor(v, 1);
                if ((r32 & 1) == 0) *(unsigned*)(Ow + (size_t)orow * DM + d0 * 32 + r32) = cvt_pk_bf16(v, vn); } }
    }
    __syncthreads();
#undef RESC
#undef KBASE
#undef AB
#undef MASKT
#undef SEAM_K0
#undef HALF_STEP
}
#undef ROWV
#undef ROWK
#undef VMW
#undef VMWN
#undef SLOAD_H
#undef SWRITE_HK
#undef SWRITE_HV
#undef SWRITE_H
#undef SBAR
}

struct AttnPlan { unsigned char list[32][24]; unsigned char cnt[32]; };
constexpr int attn_cost(int combo) { const int h = combo >> 5, qb = combo & 31; const int cap = h == 0 ? 7 : (h == 1 ? 15 : (h == 2 ? 46 : 128)); int st = 4 * (qb + 1); st = st < cap ? st : cap; return 2 * (15 * st + 200); }
constexpr AttnPlan make_attn_plan() {
    AttnPlan p{}; int load[32] = {}; bool used[128] = {};
    for (int i = 0; i < 128; ++i) { int best = -1; for (int j = 0; j < 128; ++j) if (!used[j] && (best < 0 || attn_cost(j) > attn_cost(best))) best = j;
        used[best] = true; int bin = 0; for (int b = 1; b < 32; ++b) if (load[b] < load[bin]) bin = b;
        if (p.cnt[bin] < 24) { p.list[bin][p.cnt[bin]] = (unsigned char)best; p.cnt[bin] = (unsigned char)(p.cnt[bin] + 1); } load[bin] += attn_cost(best); }
    return p;
}
__device__ const AttnPlan kAttnPlan = make_attn_plan();

#define XB_TMO      128
#define XB_XCNT(j)  (256  + 64 * (j))
#define XB_XSUB(j)  (1280 + 64 * (j))
#define XB_XGEN(j)  (2304 + 64 * (j))
#define XB_TOP      3328
#define XB_TOPGEN   3392
#define XCD_BAR_WORDS 3456
#define XB_SPIN_CAP (1u << 22)
__device__ __forceinline__ unsigned xb_ld(unsigned* p)              { return __hip_atomic_load(p, __ATOMIC_RELAXED, __HIP_MEMORY_SCOPE_AGENT); }
__device__ __forceinline__ unsigned xb_add(unsigned* p, unsigned v) { return __hip_atomic_fetch_add(p, v, __ATOMIC_RELAXED, __HIP_MEMORY_SCOPE_AGENT); }
__device__ __forceinline__ unsigned xb_xcc_id() { return (unsigned)__builtin_amdgcn_s_getreg((3 << 11) | 20) & 0xFu; }
#define XB_SPIN(cond, bar) do { unsigned _sp = 0; while (cond) { __builtin_amdgcn_s_sleep(1); \
    if ((++_sp & 255u) == 0u) { if (xb_ld(&(bar)[XB_TMO])) break; if (_sp > XB_SPIN_CAP) { atomicAdd(&(bar)[XB_TMO], 1u); break; } } } } while (0)
struct XcdBarrier { unsigned* bar; unsigned x; volatile LAS unsigned* st; };
__device__ __forceinline__ XcdBarrier xcd_barrier_post(unsigned* bar, volatile LAS unsigned* st, bool t0) {
    XcdBarrier b; b.bar = bar; b.x = xb_xcc_id(); b.st = st;
    if (t0) (void)xb_add(&bar[XB_XCNT(b.x)], 1u);
    return b;
}
__device__ __forceinline__ void xcd_barrier_complete(unsigned* bar, unsigned x, unsigned& nloc, unsigned& nx) {
    const unsigned G = gridDim.x;
    unsigned sum, cnt, mine, sp = 0u;
    for (;;) {
        sum = 0u; cnt = 0u; mine = 0u;
#pragma unroll
        for (unsigned j = 0; j < 16; ++j) { const unsigned c = xb_ld(&bar[XB_XCNT(j)]); sum += c; cnt += (c > 0u) ? 1u : 0u; mine = (j == x) ? c : mine; }
        if (sum == G) break;
        __builtin_amdgcn_s_sleep(1);
        if ((++sp & 255u) == 0u) { if (xb_ld(&bar[XB_TMO])) break; if (sp > XB_SPIN_CAP) { atomicAdd(&bar[XB_TMO], 1u); break; } }
    }
    nloc = mine > 0u ? mine : 1u; nx = cnt > 0u ? cnt : 1u;
}
__device__ __forceinline__ void xcd_barrier(const XcdBarrier& b, bool t0) {
    asm volatile("s_waitcnt vmcnt(0)" ::: "memory");
    __syncthreads();
    if (t0) {
        unsigned* bar = b.bar;
        __builtin_amdgcn_s_waitcnt(0);
        unsigned nloc = b.st[0], nx = b.st[1];
        if (nloc == 0u) { xcd_barrier_complete(bar, b.x, nloc, nx); b.st[0] = nloc; b.st[1] = nx; }
        const unsigned old = xb_add(&bar[XB_XSUB(b.x)], 1u);
        const unsigned gen = old / nloc;
        if (old + 1u == (gen + 1u) * nloc) {
            __builtin_amdgcn_fence(__ATOMIC_RELEASE, "agent");
            asm volatile("s_waitcnt vmcnt(0)" ::: "memory");
            const unsigned og = xb_add(&bar[XB_TOP], 1u);
            const unsigned tg = og / nx;
            if (og + 1u == (tg + 1u) * nx) xb_add(&bar[XB_TOPGEN], 1u);
            else XB_SPIN(xb_ld(&bar[XB_TOPGEN]) == tg, bar);
            __builtin_amdgcn_fence(__ATOMIC_ACQUIRE, "agent");
            xb_add(&bar[XB_XGEN(b.x)], 1u);
            asm volatile("s_waitcnt vmcnt(0)" ::: "memory");
        } else {
            XB_SPIN(xb_ld(&bar[XB_XGEN(b.x)]) == gen, bar);
            __builtin_amdgcn_fence(__ATOMIC_ACQUIRE, "agent");
            asm volatile("s_waitcnt vmcnt(0)" ::: "memory");
        }
    }
    __syncthreads();
}
constexpr int NWAVES = 8, NTHR = 512;
constexpr int LDS_BYTES = 163840;
struct Args {
    const float* in[28]; float* out; unsigned char* ws; int ph_lo, ph_hi;
};
constexpr int N_PHASES = 15;

struct Frame {
    LAS unsigned char* lds; int wave, vcu, G;
};

__device__ __forceinline__ void transpose_item(const float* W, int ldw, int k0, int n0, bf16_t* dst, int ldt, const float* kscale, LAS float* scr, int lane) {
    f32x4 v[8]; const int kr = lane >> 3, n4 = (lane & 7) * 4;
#pragma unroll
    for (int i = 0; i < 8; ++i) v[i] = __builtin_nontemporal_load((const f32x4*)(W + (size_t)(k0 + i * 8 + kr) * ldw + n0 + n4));
#pragma unroll
    for (int i = 0; i < 8; ++i) { const int kk = i * 8 + kr; f32x4 x = v[i]; if (kscale) x = x * kscale[k0 + kk];
        scr[kk * 33 + n4 + 0] = x[0]; scr[kk * 33 + n4 + 1] = x[1]; scr[kk * 33 + n4 + 2] = x[2]; scr[kk * 33 + n4 + 3] = x[3]; }
    asm volatile("s_waitcnt lgkmcnt(0)" ::: "memory");
    const int c = lane & 7;
#pragma unroll
    for (int j = 0; j < 4; ++j) { const int n = (lane >> 3) + 8 * j; const LAS float* s = scr + (8 * c) * 33 + n;
        u32x4 o; o.x = cvt_pk_bf16(s[0 * 33], s[1 * 33]); o.y = cvt_pk_bf16(s[2 * 33], s[3 * 33]); o.z = cvt_pk_bf16(s[4 * 33], s[5 * 33]); o.w = cvt_pk_bf16(s[6 * 33], s[7 * 33]);
        *(u32x4*)(dst + (size_t)n * ldt + k0 + 8 * c) = o; }
    asm volatile("s_waitcnt lgkmcnt(0)" ::: "memory");
}
__device__ __forceinline__ void transpose_item_fp8(const float* W, int ldw, int k0, int n0, unsigned char* dst, int ldt, float scale, const float* kscale, LAS float* scr, int lane) {
    f32x4 v[8]; const int kr = lane >> 3, n4 = (lane & 7) * 4;
#pragma unroll
    for (int i = 0; i < 8; ++i) v[i] = __builtin_nontemporal_load((const f32x4*)(W + (size_t)(k0 + i * 8 + kr) * ldw + n0 + n4));
#pragma unroll
    for (int i = 0; i < 8; ++i) { const int kk = i * 8 + kr; const f32x4 x = v[i] * (kscale ? scale * kscale[k0 + kk] : scale);
        scr[kk * 33 + n4 + 0] = x[0]; scr[kk * 33 + n4 + 1] = x[1]; scr[kk * 33 + n4 + 2] = x[2]; scr[kk * 33 + n4 + 3] = x[3]; }
    asm volatile("s_waitcnt lgkmcnt(0)" ::: "memory");
    const int n = lane >> 1, kh = (lane & 1) * 32; const LAS float* s = scr + kh * 33 + n;
    u32x4 o0, o1;
    o0.x = pk4_fp8(s[0 * 33], s[1 * 33], s[2 * 33], s[3 * 33]); o0.y = pk4_fp8(s[4 * 33], s[5 * 33], s[6 * 33], s[7 * 33]); o0.z = pk4_fp8(s[8 * 33], s[9 * 33], s[10 * 33], s[11 * 33]); o0.w = pk4_fp8(s[12 * 33], s[13 * 33], s[14 * 33], s[15 * 33]);
    o1.x = pk4_fp8(s[16 * 33], s[17 * 33], s[18 * 33], s[19 * 33]); o1.y = pk4_fp8(s[20 * 33], s[21 * 33], s[22 * 33], s[23 * 33]); o1.z = pk4_fp8(s[24 * 33], s[25 * 33], s[26 * 33], s[27 * 33]); o1.w = pk4_fp8(s[28 * 33], s[29 * 33], s[30 * 33], s[31 * 33]);
    __builtin_nontemporal_store(o0, (u32x4*)(dst + (size_t)n * ldt + k0 + kh)); __builtin_nontemporal_store(o1, (u32x4*)(dst + (size_t)n * ldt + k0 + kh + 16));
    asm volatile("s_waitcnt lgkmcnt(0)" ::: "memory");
}
__device__ __forceinline__ void rms_rows2_to_bf16(const float* xa, const float* xb, const float* g, bf16_t* oa, bf16_t* ob, int lane) {
    const f32x4* ra = (const f32x4*)xa + lane; const f32x4* rb = (const f32x4*)xb + lane; const f32x4* gr = (const f32x4*)g + lane;
    f32x4 va[4], vb[4]; float sa = 0.f, sb = 0.f;
#pragma unroll
    for (int j = 0; j < 4; ++j) { va[j] = __builtin_nontemporal_load(ra + 64 * j); vb[j] = __builtin_nontemporal_load(rb + 64 * j); }
#pragma unroll
    for (int j = 0; j < 4; ++j) { sa += (va[j].x * va[j].x + va[j].y * va[j].y) + (va[j].z * va[j].z + va[j].w * va[j].w); sb += (vb[j].x * vb[j].x + vb[j].y * vb[j].y) + (vb[j].z * vb[j].z + vb[j].w * vb[j].w); }
    const float rsa = __builtin_amdgcn_rsqf(wave_sum(sa) * (1.f / DM) + RMS_EPS), rsb = __builtin_amdgcn_rsqf(wave_sum(sb) * (1.f / DM) + RMS_EPS);
    u32x2* pa = (u32x2*)oa + lane; u32x2* pb = (u32x2*)ob + lane;
#pragma unroll
    for (int j = 0; j < 4; ++j) { const f32x4 gg = gr[64 * j]; u32x2 w;
        w.x = cvt_pk_bf16(va[j].x * rsa * gg.x, va[j].y * rsa * gg.y); w.y = cvt_pk_bf16(va[j].z * rsa * gg.z, va[j].w * rsa * gg.w); pa[64 * j] = w;
        w.x = cvt_pk_bf16(vb[j].x * rsb * gg.x, vb[j].y * rsb * gg.y); w.y = cvt_pk_bf16(vb[j].z * rsb * gg.z, vb[j].w * rsb * gg.w); pb[64 * j] = w; }
}

__global__ void __launch_bounds__(NTHR, 2) mega(Args args) {
    extern __shared__ __attribute__((aligned(16))) unsigned char lds_raw[];
    Frame F; F.lds = (LAS unsigned char*)lds_raw; F.wave = __builtin_amdgcn_readfirstlane(threadIdx.x >> 6);
    F.G = gridDim.x; { const int bx = blockIdx.x; F.vcu = (F.G % 8 == 0) ? (bx % 8) * (F.G / 8) + bx / 8 : bx; }
    unsigned char* ws = args.ws;
    unsigned* ctl = (unsigned*)(ws + WS_CTL);
    const float* x = args.in[0]; float* out = args.out;
    bf16_t* Win_t = (bf16_t*)(ws + WS_WIN); bf16_t* Wout_t = (bf16_t*)(ws + WS_WOUT); bf16_t* Wq_t = (bf16_t*)(ws + WS_WQ); bf16_t* Wkv_t = (bf16_t*)(ws + WS_WKV);
    bf16_t* Wo_t = (bf16_t*)(ws + WS_WO); bf16_t* Wr_t = (bf16_t*)(ws + WS_WR); bf16_t* Wsgu = (bf16_t*)(ws + WS_WSGU); bf16_t* memn = (bf16_t*)(ws + WS_MEMN);
    bf16_t* Km = (bf16_t*)(ws + WS_KM); bf16_t* Vt = (bf16_t*)(ws + WS_VT); bf16_t* Wgu_t = (bf16_t*)(ws + WS_WGU); bf16_t* Wd_t = (bf16_t*)(ws + WS_WD);
    bf16_t* Z = (bf16_t*)(ws + WS_RA); bf16_t* Qm = (bf16_t*)(ws + WS_RA); bf16_t* Sc = (bf16_t*)(ws + WS_RA + 128 * MiB); bf16_t* xg = (bf16_t*)(ws + WS_RA); bf16_t* yb = (bf16_t*)(ws + WS_RA);
    bf16_t* XN = (bf16_t*)(ws + WS_RB); bf16_t* AO = (bf16_t*)(ws + WS_RB); bf16_t* Om = (bf16_t*)(ws + WS_RB); bf16_t* act = (bf16_t*)(ws + WS_RB);
    bf16_t* x1b = (bf16_t*)(ws + WS_RC); bf16_t* x2b = (bf16_t*)(ws + WS_RC); unsigned char* x2f8 = ws + WS_X2F8;
    float* ssq1 = (float*)(ws + WS_SSQ1); float* ssq2 = (float*)(ws + WS_SSQ2); float* rstd2 = (float*)(ws + WS_SSQ1);     float* logit = (float*)(ws + WS_LOGIT);
    int* tok_e = (int*)(ws + WS_TOKE); float* tok_w = (float*)(ws + WS_TOKW); int* tok_s = (int*)(ws + WS_TOKS); int* row_tok = (int*)(ws + WS_ROWTOK); float* rowrs = (float*)(ws + WS_ROWTOK + 1 * MiB);
    const int gw = F.vcu * NWAVES + F.wave, NGW = F.G * NWAVES;
    const int lo = args.ph_lo, hi = args.ph_hi;
#define IN(k) (lo <= (k) && (k) < hi)
#if MK_ONE_LAUNCH
    volatile LAS unsigned* misc = (volatile LAS unsigned*)(F.lds + LDS_MISC);
    if (threadIdx.x < 64) misc[threadIdx.x] = 0u;
    __syncthreads();
    XcdBarrier xbar = xcd_barrier_post(ctl + CW_BAR, misc + 8, threadIdx.x == 0);
    if (args.ph_hi > 4096) cg::this_grid().sync();
#define GRID_BAR(k) do { if (IN(k) && IN((k) + 1)) xcd_barrier(xbar, F.wave == 0 && lane_id() == 0); } while (0)
#else
#define GRID_BAR(k) do { } while (0)
#endif
#define LOCAL_SEAM() do { asm volatile("s_waitcnt vmcnt(0)" ::: "memory"); __syncthreads(); __builtin_amdgcn_fence(__ATOMIC_ACQUIRE, "agent"); asm volatile("s_waitcnt vmcnt(0)" ::: "memory"); __syncthreads(); } while (0)

    if (IN(0)) {
        const int lane_ = lane_id(), tid_ = F.wave * 64 + lane_; (void)tid_;
        LAS float* scr = (LAS float*)(F.lds + F.wave * 16384);
        constexpr int I_IN = 16 * 80, I_SQ = 16 * 32, I_KV = 16 * 64, I_G = 16 * 16, I_D = 8 * 32;
        constexpr int NITEMS = I_IN + 3 * I_SQ + I_KV + NEXP * (2 * I_G + I_D);
        for (int it = gw; it < NITEMS; it += NGW) {
            int r = it;
            if (r < I_IN) { const int kb = r / 80, nb = r % 80; transpose_item(args.in[3], ZP, kb * 64, nb * 32, Win_t + (size_t)(nb * 32) * DM, DM, nullptr, scr, lane_); continue; } r -= I_IN;
            if (r < I_SQ) { const int kb = r / 32, nb = r % 32; transpose_item(args.in[13], DM, kb * 64, nb * 32, Wout_t + (size_t)(nb * 32) * DM, DM, nullptr, scr, lane_); continue; } r -= I_SQ;
            if (r < I_SQ) { const int kb = r / 32, nb = r % 32; transpose_item_fp8(args.in[16], DM, kb * 64, nb * 32, (unsigned char*)Wq_t + (size_t)(nb * 32) * DM, DM, F8_WSCALE, args.in[14], scr, lane_); continue; } r -= I_SQ;
            if (r < I_KV) { const int kb = r / 64, nb = r % 64; transpose_item(args.in[17], 2 * DM, kb * 64, nb * 32, Wkv_t + (size_t)(nb * 32) * DM, DM, nullptr, scr, lane_); continue; } r -= I_KV;
            if (r < I_SQ) { const int kb = r / 32, nb = r % 32; transpose_item_fp8(args.in[18], DM, kb * 64, nb * 32, (unsigned char*)Wo_t + (size_t)(nb * 32) * DM, DM, F8_WSCALE, nullptr, scr, lane_); continue; } r -= I_SQ;
            const int e = r / (2 * I_G + I_D); r -= e * (2 * I_G + I_D);
            if (r < 2 * I_G) { const int up = r >= I_G; if (up) r -= I_G; const int kb = r / 16, nb = r % 16, n0 = nb * 32;
                const float* W = (up ? args.in[25] : args.in[24]) + (size_t)e * DM * DEXP;
                transpose_item_fp8(W, DEXP, kb * 64, n0, (unsigned char*)Wgu_t + ((size_t)e * 1024 + (n0 >> 7) * 256 + 64 * ((n0 & 127) >> 5) + 32 * up) * DM, DM, F8_WSCALE, args.in[19], scr, lane_); continue; }
            r -= 2 * I_G;
            { const int kb = r / 32, nb = r % 32; transpose_item_fp8(args.in[26] + (size_t)e * DEXP * DM, DM, kb * 64, nb * 32, (unsigned char*)Wd_t + ((size_t)e * 1024 + nb * 32) * DEXP, DEXP, F8_WSCALE, nullptr, scr, lane_); }
        }
        for (int i = blockIdx.x * NTHR + tid_; i < 256 * DM; i += F.G * NTHR) { const int n = i >> 10, k = i & 1023; float v = 0.f;
            if (n < 4) v = args.in[20][k * 4 + n] * args.in[19][k]; else if (n < 36) v = args.in[22][k * 32 + (n - 4)] * args.in[19][k];
            Wr_t[i] = (bf16_t)(cvt_pk_bf16(v, 0.f) & 0xffffu); }
        for (int i = blockIdx.x * NTHR + tid_; i < 4 * 128 * 128; i += F.G * NTHR) { const int t = (i >> 7) & 127, s = i & 127; const float v = s <= t ? args.in[6][i] : 0.f; Wsgu[i] = (bf16_t)(cvt_pk_bf16(v, 0.f) & 0xffffu); }
        for (int m = gw; m < M; m += 2 * NGW) rms_rows2_to_bf16(x + (size_t)m * DM, x + (size_t)(m + NGW) * DM, args.in[2], XN + (size_t)m * DM, XN + (size_t)(m + NGW) * DM, lane_);
        for (int m = gw; m < MROWS / 2; m += NGW) rms_rows2_to_bf16(args.in[1] + (size_t)m * DM, args.in[1] + (size_t)(m + MROWS / 2) * DM, args.in[15], memn + (size_t)m * DM, memn + (size_t)(m + MROWS / 2) * DM, lane_);
        __syncthreads();
    }
    GRID_BAR(0);

    if (IN(1)) {
        { pg8::Gemm g{DM, DM, DM}; pg8::PlainSched S; S.to.init(M / 256, ZP / 256, F.G, (int)blockIdx.x); S.A = (const char*)XN; S.B = (const char*)Win_t; S.tA = (size_t)256 * DM * 2; S.tB = (size_t)256 * DM * 2;
          pg8::EpiZ E{Z, ctl + CW_KMX}; pg8::gemm_phase(F.lds, F.wave, g, S, E); }
    }
    GRID_BAR(1);

    if (IN(2)) {
        const int lane_ = lane_id(), tid_ = F.wave * 64 + lane_; (void)tid_;
        float lam;
        { const float a = args.in[8][lane_] * args.in[9][lane_], b = args.in[10][lane_] * args.in[11][lane_];
          lam = __expf(wave_sum(a)) - __expf(wave_sum(b)) + 0.2f; }
        {
            LAS float* kmt = (LAS float*)(F.lds + da::LDS_CX + 64);
            const int b = (F.G == 256) ? (F.vcu >> 5) : 0, r = F.vcu & 31;
            if (tid_ < 8) { const unsigned* kp = ctl + CW_KMX + ((b * 4 + (tid_ >> 1)) * 2 + (tid_ & 1)) * 2; kmt[tid_] = 1.01f * sqrtf(__uint_as_float(ld_u32_agent(kp)) + __uint_as_float(ld_u32_agent(kp + 1))); }
            __syncthreads();
            const int nit = (F.G == 256) ? (int)kAttnPlan.cnt[r] : 0;
#define COMBO_OF(i) ((int)__builtin_amdgcn_readfirstlane((int)kAttnPlan.list[r][(i)]))
            if (nit > 0) {
                int ii = 0, pass = 0, combo = COMBO_OF(0); da::BlockRef cur = da::mkref(Z, AO, (const float*)kmt, b, combo, 0); da::Seam S;
                da::prime(cur, (char*)lds_raw, S, F.wave);
                for (;;) {
                    int ni = ii, np = pass + 1; if (np == 2) { np = 0; ni = ii + 1; }
                    const bool last = ni >= nit * PROBE_DUP_ATTN;
                    int ncombo = combo; if (!last && np == 0) ncombo = COMBO_OF(ni % nit);
                    const da::BlockRef nxt = last ? cur : da::mkref(Z, AO, (const float*)kmt, b, ncombo, np);
                    da::block(cur, nxt, (char*)lds_raw, S, lam, args.in[12], F.wave);
                    if (last) break;
                    cur = nxt; ii = ni; pass = np; combo = ncombo;
                }
            }
#undef COMBO_OF
        }
        __syncthreads();
        {
            int e = -1;
            if (F.G == 256) { const int b = F.vcu >> 5, r = F.vcu & 31; if (r >= 16 && r < 24) e = b * 8 + (r - 16); }
            for (int e2 = (F.G == 256 ? e : F.vcu); e2 >= 0 && e2 < 64; e2 = (F.G == 256 ? 64 : e2 + F.G)) {
                pg8::Gemm g{DM, DM, DM}; pg8::OneUnitSched S;
                if (e2 < 32) { S.u0.pm = e2 >> 2; S.u0.pn = e2 & 3; S.u0.aux = 0; S.u0.rows = nullptr; S.u0.A = (const char*)(memn + (size_t)S.u0.pm * 256 * DM); S.u0.B = (const char*)(Wkv_t + (size_t)S.u0.pn * 256 * DM);
                    pg8::EpiF8 E{(unsigned char*)Km, DM, nullptr, F8_KSCALE}; pg8::gemm_phase(F.lds, F.wave, g, S, E); }
                else { const int e3 = e2 - 32; S.u0.pm = e3 >> 3; S.u0.pn = e3 & 7; S.u0.aux = 0; S.u0.rows = nullptr; S.u0.A = (const char*)(Wkv_t + (size_t)(1024 + S.u0.pm * 256) * DM); S.u0.B = (const char*)(memn + (size_t)S.u0.pn * 256 * DM);
                    pg8::EpiF8 E{(unsigned char*)Vt, MROWS, nullptr, F8_VSCALE}; pg8::gemm_phase(F.lds, F.wave, g, S, E); }
            }
        }
        __syncthreads();
        {
            const int lane = lane_, w = F.wave;
            const int nun = (M / 128) * 4;
            const int ch0 = (lane & 15) * 8, t = 16 * w + (lane & 15), nks = (w + 2) >> 1;
            u32x4 vr[4];
            LAS int* sq = (LAS int*)(F.lds + 2 * 34816);
            const bool puller = (w == 0 && lane == 0);
            if (puller) { sq[0] = (int)atomicAdd(ctl + CW_SGUQ, 1u); sq[1] = (int)atomicAdd(ctl + CW_SGUQ, 1u); }
            __syncthreads();
            int uidx = __builtin_amdgcn_readfirstlane(sq[0]), unext = __builtin_amdgcn_readfirstlane(sq[1]), kk = 0;
            if (uidx < nun) { const size_t R0 = (size_t)(uidx >> 2) * 128; const int g = uidx & 3;
#pragma unroll
                for (int ps = 0; ps < 4; ++ps) vr[ps] = *(const u32x4*)(Z + (R0 + 16 * w + 4 * ps + (lane >> 4)) * ZP + ZV + g * 128 + ch0); }
            int gcur = -1; float lg[8], lb[8]; bf16x8 wf[4]; float bias = 0.f; int buf = 0;
#pragma unroll
            for (int j = 0; j < 8; ++j) { lg[j] = 0.f; lb[j] = 0.f; }
#pragma unroll
            for (int ks = 0; ks < 4; ++ks) wf[ks] = (bf16x8){0, 0, 0, 0, 0, 0, 0, 0};
            for (; uidx < nun; uidx = unext, unext = __builtin_amdgcn_readfirstlane(sq[(kk + 1) & 3]), buf ^= 1) {
                int pulled_ = 0; if (puller) pulled_ = (int)atomicAdd(ctl + CW_SGUQ, 1u);
                const int c = uidx >> 2, g = uidx & 3; const size_t R0 = (size_t)c * 128;
                LAS bf16_t* vnT = (LAS bf16_t*)(F.lds + buf * 34816);
                if (g != gcur) { gcur = g;
#pragma unroll
                    for (int j = 0; j < 8; ++j) { lg[j] = args.in[4][g * 128 + ch0 + j]; lb[j] = args.in[5][g * 128 + ch0 + j]; }
#pragma unroll
                    for (int ks = 0; ks < 4; ++ks) if (ks < nks) wf[ks] = *(const bf16x8*)(Wsgu + ((size_t)g * 128 + t) * 128 + ks * 32 + 8 * (lane >> 4));
                    bias = args.in[7][g * 128 + t]; }
#pragma unroll
                for (int ps = 0; ps < 4; ++ps) { const int sr = 16 * w + 4 * ps + (lane >> 4); const u32x4 raw = vr[ps];
                    float v[8] = {bf_lo(raw.x), bf_hi(raw.x), bf_lo(raw.y), bf_hi(raw.y), bf_lo(raw.z), bf_hi(raw.z), bf_lo(raw.w), bf_hi(raw.w)};
                    float sm = 0.f;
#pragma unroll
                    for (int j = 0; j < 8; ++j) sm += v[j];
#pragma unroll
                    for (int o = 1; o < 16; o <<= 1) sm += __shfl_xor(sm, o);
                    const float mu = sm * (1.f / 128.f); float q = 0.f;
#pragma unroll
                    for (int j = 0; j < 8; ++j) { v[j] -= mu; q += v[j] * v[j]; }
#pragma unroll
                    for (int o = 1; o < 16; o <<= 1) q += __shfl_xor(q, o);
                    const float rstd = __builtin_amdgcn_rsqf(q * (1.f / 128.f) + LN_EPS);
#pragma unroll
                    for (int j = 0; j < 8; ++j) { const float y = v[j] * rstd * lg[j] + lb[j]; vnT[(ch0 + j) * 136 + sr] = (bf16_t)(cvt_pk_bf16(y, 0.f) & 0xffffu); } }
                u32x2 ur[8];
#pragma unroll
                for (int mi = 0; mi < 8; ++mi) ur[mi] = *(const u32x2*)(Z + (R0 + t) * ZP + ZU + g * 128 + 16 * mi + 4 * (lane >> 4));
                { const int un = unext; if (un < nun) { const size_t Rn = (size_t)(un >> 2) * 128; const int gn = un & 3;
#pragma unroll
                    for (int ps = 0; ps < 4; ++ps) vr[ps] = *(const u32x4*)(Z + (Rn + 16 * w + 4 * ps + (lane >> 4)) * ZP + ZV + gn * 128 + ch0); } }
                if (puller) sq[(kk + 2) & 3] = pulled_;
                ++kk;
                __syncthreads();
                f32x4 acc[8];
#pragma unroll
                for (int mi = 0; mi < 8; ++mi) acc[mi] = (f32x4){0.f, 0.f, 0.f, 0.f};
#pragma unroll
                for (int ks = 0; ks < 4; ++ks) if (ks < nks) {
#pragma unroll
                    for (int mi = 0; mi < 8; ++mi) { const bf16x8 afr = *(const LAS bf16x8*)(vnT + (16 * mi + (lane & 15)) * 136 + ks * 32 + 8 * (lane >> 4));
                        acc[mi] = __builtin_amdgcn_mfma_f32_16x16x32_bf16(afr, wf[ks], acc[mi], 0, 0, 0); } }
#pragma unroll
                for (int mi = 0; mi < 8; ++mi) { const int ch = 16 * mi + 4 * (lane >> 4); const u32x2 u2 = ur[mi];
                    const float o0 = bf_lo(u2.x) * (acc[mi][0] + bias), o1 = bf_hi(u2.x) * (acc[mi][1] + bias), o2 = bf_lo(u2.y) * (acc[mi][2] + bias), o3 = bf_hi(u2.y) * (acc[mi][3] + bias);
                    u32x2 wv; wv.x = cvt_pk_bf16(o0, o1); wv.y = cvt_pk_bf16(o2, o3);
                    *(u32x2*)(AO + (R0 + t) * DM + g * 128 + ch) = wv; }
            }
            __syncthreads();
        }
    }
    GRID_BAR(2);

    if (IN(3)) {
        pg8::Gemm g{DM, DM, DM}; pg8::PlainSched S; S.to.init(M / 256, 4, F.G, (int)blockIdx.x); S.A = (const char*)AO; S.B = (const char*)Wout_t; S.tA = (size_t)256 * DM * 2; S.tB = (size_t)256 * DM * 2;
        pg8::EpiResid<false> E{x, x1b, ssq1, (LAS float*)(F.lds + 131072 + 1024), x2f8, 1.f}; pg8::gemm_phase(F.lds, F.wave, g, S, E);
    }
    GRID_BAR(3);

    if (IN(4)) {
        pg8::Gemm g{DM / 2, DM / 2, DM / 2}; pg8::PlainSched S; S.to.init(M / 256, 4, F.G, (int)blockIdx.x); S.A = (const char*)x2f8; S.B = (const char*)Wq_t; S.tA = (size_t)256 * DM; S.tB = (size_t)256 * DM;
        pg8::EpiF8 E{(unsigned char*)Qm, DM, ssq1, F8_QSCALE * C2_MEM / (F8_XSCALE * F8_WSCALE)}; pg8::gemm_phase<pg8::EpiF8, pg8::PlainSched, false, true>(F.lds, F.wave, g, S, E);
    }
    if (MK_ONE_LAUNCH && IN(4) && IN(5)) LOCAL_SEAM();

    if (IN(5)) {
        pg8::Gemm g{DM / 2, DM / 2, 128}; pg8::MemAttnSched S; S.to.init(M / 256, 4, F.G, (int)blockIdx.x); S.A = (const char*)Qm; S.B = (const char*)Km; S.tA = (size_t)256 * DM; S.hA = 256; S.bB = (size_t)256 * DM; S.hB = 256;
        pg8::EpiSoftmax E{(unsigned char*)Sc, (LAS float*)(F.lds + LDS_MISC + 1024), 1.0f / (F8_QSCALE * F8_KSCALE)}; pg8::gemm_phase<pg8::EpiSoftmax, pg8::MemAttnSched, false, true>(F.lds, F.wave, g, S, E);
    }
    if (MK_ONE_LAUNCH && IN(5) && IN(6 + 1)) LOCAL_SEAM();

    if (IN(7)) {
        pg8::Gemm g{DM / 2, MROWS / 2, 128}; pg8::MemAttnSched S; S.to.init(M / 256, 4, F.G, (int)blockIdx.x); S.A = (const char*)Sc; S.B = (const char*)Vt; S.tA = (size_t)256 * DM; S.hA = 256; S.bB = 256; S.hB = (size_t)256 * MROWS;
        pg8::EpiF8 E{(unsigned char*)Om, DM, nullptr, F8_OSCALE / (F8_PSCALE * F8_VSCALE)}; pg8::gemm_phase<pg8::EpiF8, pg8::MemAttnSched, false, true>(F.lds, F.wave, g, S, E);
    }
    GRID_BAR(7);

    if (IN(8)) {
        pg8::Gemm g{DM / 2, DM / 2, DM / 2}; pg8::PlainSched S; S.to.init(M / 256, 4, F.G, (int)blockIdx.x); S.A = (const char*)Om; S.B = (const char*)Wo_t; S.tA = (size_t)256 * DM; S.tB = (size_t)256 * DM;
        pg8::EpiResid<true> E{x1b, x2b, ssq2, (LAS float*)(F.lds + 131072 + 1024), x2f8, 1.0f / (F8_OSCALE * F8_WSCALE)}; pg8::gemm_phase<pg8::EpiResid<true>, pg8::PlainSched, false, true>(F.lds, F.wave, g, S, E);
    }
    GRID_BAR(8);

    if (IN(9)) {
        pg8::Gemm g{DM, DM, DM}; pg8::PlainSched S; S.to.init(M / 256, 1, F.G, (int)blockIdx.x); S.A = (const char*)x2b; S.B = (const char*)Wr_t; S.tA = (size_t)256 * DM * 2; S.tB = 0;
        pg8::EpiRouter E{logit, ssq2, args.in[21], args.in[23], rstd2}; pg8::gemm_phase(F.lds, F.wave, g, S, E);
    }
    if (MK_ONE_LAUNCH && IN(9) && IN(10)) LOCAL_SEAM();

    if (IN(10)) {
        const int lane_ = lane_id(), tid_ = F.wave * 64 + lane_; (void)tid_;
        LAS unsigned* lcnt = (LAS unsigned*)F.lds; LAS unsigned* lbase = lcnt + 32;
        pg8::TileOrder to10; to10.init(M / 256, 1, F.G, (int)blockIdx.x);
        int pm10 = 0, pn10 = 0;
        for (int i10 = 0; to10.get(i10, pm10, pn10); ++i10) {
            if (tid_ < 32) lcnt[tid_] = 0u;
            __syncthreads();
            const int tok = pm10 * 256 + (tid_ & 255); const bool act_ = tid_ < 256;
            const f32x4 lg = *(const f32x4*)(logit + (size_t)tok * 64);
            int gi = 0; float gm = lg[0];
#pragma unroll
            for (int j = 1; j < 4; ++j) if (lg[j] > gm) { gm = lg[j]; gi = j; }
            float gs = 0.f;
#pragma unroll
            for (int j = 0; j < 4; ++j) gs += __expf(lg[j] - gm);
            const float gate = 1.0f / gs;
            const f32x4 ea = *(const f32x4*)(logit + (size_t)tok * 64 + 4 + gi * 8), eb = *(const f32x4*)(logit + (size_t)tok * 64 + 8 + gi * 8);
            const float el[8] = {ea[0], ea[1], ea[2], ea[3], eb[0], eb[1], eb[2], eb[3]};
            int i0 = 0; float m0 = el[0];
#pragma unroll
            for (int j = 1; j < 8; ++j) if (el[j] > m0) { m0 = el[j]; i0 = j; }
            int i1 = -1; float m1 = -__builtin_inff();
#pragma unroll
            for (int j = 0; j < 8; ++j) if (j != i0 && el[j] > m1) { m1 = el[j]; i1 = j; }
            if (i1 < 0) i1 = (i0 == 0) ? 1 : 0;
            const float r = __expf(m1 - m0);
            const float w0 = gate / (1.0f + r), w1 = gate * r / (1.0f + r);
            const int e0 = gi * 8 + i0, e1 = gi * 8 + i1;
            unsigned r0 = 0u, r1 = 0u; if (act_) { r0 = atomicAdd((unsigned*)&lcnt[e0], 1u); r1 = atomicAdd((unsigned*)&lcnt[e1], 1u); }
            __syncthreads();
            if (tid_ < 32) lbase[tid_] = atomicAdd(ctl + CW_CNT + tid_, lcnt[tid_]);
            __syncthreads();
            if (act_) { tok_e[tok * 2] = e0; tok_e[tok * 2 + 1] = e1; tok_w[tok * 2] = w0; tok_w[tok * 2 + 1] = w1;
                tok_s[tok * 2] = (int)(lbase[e0] + r0); tok_s[tok * 2 + 1] = (int)(lbase[e1] + r1); }
            __syncthreads();
        }
    }
    GRID_BAR(10);

    if (IN(11)) {
        const int lane_ = lane_id(), tid_ = F.wave * 64 + lane_; (void)tid_;
        LAS unsigned* lps = (LAS unsigned*)F.lds;
        if (tid_ == 0) { unsigned acc = 0; for (int e = 0; e < 32; ++e) { lps[e] = acc; const unsigned c = ld_u32_agent(ctl + CW_CNT + e); acc += (c + 255u) & ~255u; } lps[32] = acc; }
        __syncthreads();
        if (blockIdx.x == 0) {
            if (tid_ < 32) { const unsigned s = lps[tid_], e2 = lps[tid_ + 1], c = ld_u32_agent(ctl + CW_CNT + tid_);
                for (unsigned b = s >> 8; b < (e2 >> 8); ++b) ctl[CW_BLKE + b] = (unsigned)tid_;
                for (unsigned r = s + c; r < e2; ++r) { row_tok[r] = 0; rowrs[r] = 0.f; } }
            if (tid_ == 0) ctl[CW_NBLK] = lps[32] >> 8;
        }
        for (int a = blockIdx.x * NTHR + tid_; a < M * 2; a += F.G * NTHR) { const int e = tok_e[a]; const int pos = (int)lps[e] + tok_s[a]; row_tok[pos] = a >> 1; tok_s[a] = pos; rowrs[pos] = rstd2[a >> 1] * (1.0f / (F8_XSCALE * F8_WSCALE)); }
        __syncthreads();
    }
    GRID_BAR(11);

    if (IN(12)) {
        const int nblk = (int)__builtin_amdgcn_readfirstlane(ld_u32_agent(ctl + CW_NBLK));
        pg8::Gemm g{DM / 2, DM / 2, DM / 2}; pg8::MoeSched S{F.G, F.vcu, nblk, ctl + CW_BLKE, (const char*)x2f8, (const char*)Wgu_t, (size_t)0, (size_t)1024 * DM, (size_t)256 * DM, row_tok};
        pg8::EpiGateUp E{(unsigned char*)act, rowrs, row_tok}; pg8::gemm_phase<pg8::EpiGateUp, pg8::MoeSched, true, true>(F.lds, F.wave, g, S, E);
    }
    GRID_BAR(12);

    if (IN(13)) {
        const int nblk = (int)__builtin_amdgcn_readfirstlane(ld_u32_agent(ctl + CW_NBLK));
        pg8::Gemm g{DEXP / 2, DEXP / 2, DEXP / 2}; pg8::MoeSched S{F.G, F.vcu, nblk, ctl + CW_BLKE, (const char*)act, (const char*)Wd_t, (size_t)256 * DEXP, (size_t)1024 * DEXP, (size_t)256 * DEXP, row_tok};
        pg8::EpiF8 E{(unsigned char*)yb, DM, nullptr, F8_YSCALE / (F8_WSCALE * F8_ASCALE)}; pg8::gemm_phase<pg8::EpiF8, pg8::MoeSched, false, true>(F.lds, F.wave, g, S, E);
    }
    GRID_BAR(13);

    if (IN(14)) {
        const int lane_ = lane_id(), tid_ = F.wave * 64 + lane_; (void)tid_;
        const f32x4* gr = (const f32x4*)args.in[27] + lane_;
        f32x4 gg[4];
#pragma unroll
        for (int j = 0; j < 4; ++j) gg[j] = gr[64 * j];
        for (int m = gw; m < M; m += 2 * NGW) {
            const int ma = m, mb = m + NGW;
            const int pa0 = tok_s[ma * 2], pa1 = tok_s[ma * 2 + 1], pb0 = tok_s[mb * 2], pb1 = tok_s[mb * 2 + 1];
            const float wa0 = tok_w[ma * 2], wa1 = tok_w[ma * 2 + 1], wb0 = tok_w[mb * 2], wb1 = tok_w[mb * 2 + 1];
            const u32x2* xa = (const u32x2*)(x2b + (size_t)ma * DM) + lane_; const u32x2* xb = (const u32x2*)(x2b + (size_t)mb * DM) + lane_;
            const unsigned* ya0 = (const unsigned*)((const unsigned char*)yb + (size_t)pa0 * DM) + lane_; const unsigned* ya1 = (const unsigned*)((const unsigned char*)yb + (size_t)pa1 * DM) + lane_;
            const unsigned* yb0 = (const unsigned*)((const unsigned char*)yb + (size_t)pb0 * DM) + lane_; const unsigned* yb1 = (const unsigned*)((const unsigned char*)yb + (size_t)pb1 * DM) + lane_;
            u32x2 ca[4], cb[4]; unsigned a0[4], a1[4], b0[4], b1[4];
#pragma unroll
            for (int j = 0; j < 4; ++j) { ca[j] = xa[64 * j]; cb[j] = xb[64 * j]; a0[j] = ya0[64 * j]; a1[j] = ya1[64 * j]; b0[j] = yb0[64 * j]; b1[j] = yb1[64 * j]; }
            f32x4 va[4], vb[4]; float sa = 0.f, sb = 0.f;
            const float ka0 = wa0 * (1.0f / F8_YSCALE), ka1 = wa1 * (1.0f / F8_YSCALE), kb0 = wb0 * (1.0f / F8_YSCALE), kb1 = wb1 * (1.0f / F8_YSCALE);
#pragma unroll
            for (int j = 0; j < 4; ++j) {
                const f32x2 p0 = __builtin_amdgcn_cvt_pk_f32_fp8(a0[j], false), p1 = __builtin_amdgcn_cvt_pk_f32_fp8(a0[j], true), q0 = __builtin_amdgcn_cvt_pk_f32_fp8(a1[j], false), q1 = __builtin_amdgcn_cvt_pk_f32_fp8(a1[j], true);
                const f32x2 r0 = __builtin_amdgcn_cvt_pk_f32_fp8(b0[j], false), r1 = __builtin_amdgcn_cvt_pk_f32_fp8(b0[j], true), t0 = __builtin_amdgcn_cvt_pk_f32_fp8(b1[j], false), t1 = __builtin_amdgcn_cvt_pk_f32_fp8(b1[j], true);
                va[j].x = bf_lo(ca[j].x) + ka0 * p0.x + ka1 * q0.x; va[j].y = bf_hi(ca[j].x) + ka0 * p0.y + ka1 * q0.y; va[j].z = bf_lo(ca[j].y) + ka0 * p1.x + ka1 * q1.x; va[j].w = bf_hi(ca[j].y) + ka0 * p1.y + ka1 * q1.y;
                vb[j].x = bf_lo(cb[j].x) + kb0 * r0.x + kb1 * t0.x; vb[j].y = bf_hi(cb[j].x) + kb0 * r0.y + kb1 * t0.y; vb[j].z = bf_lo(cb[j].y) + kb0 * r1.x + kb1 * t1.x; vb[j].w = bf_hi(cb[j].y) + kb0 * r1.y + kb1 * t1.y;
                sa += (va[j].x * va[j].x + va[j].y * va[j].y) + (va[j].z * va[j].z + va[j].w * va[j].w); sb += (vb[j].x * vb[j].x + vb[j].y * vb[j].y) + (vb[j].z * vb[j].z + vb[j].w * vb[j].w); }
            const float ra = __builtin_amdgcn_rsqf(wave_sum(sa) * (1.f / DM) + RMS_EPS), rb = __builtin_amdgcn_rsqf(wave_sum(sb) * (1.f / DM) + RMS_EPS);
            f32x4* oa = (f32x4*)(out + (size_t)ma * DM) + lane_; f32x4* ob = (f32x4*)(out + (size_t)mb * DM) + lane_;
#pragma unroll
            for (int j = 0; j < 4; ++j) { oa[64 * j] = va[j] * ra * gg[j]; ob[64 * j] = vb[j] * rb * gg[j]; }
        }
    }
#undef IN
#undef GRID_BAR
}

extern "C" void kernel_launch(void* const* d_in, const int* in_sizes, int n_in, void* d_out, int out_size, void* d_ws, size_t ws_size, hipStream_t stream) {
    static int grid = 0;
    if (grid == 0) {
        if (n_in != 28 || in_sizes[0] != M * DM || out_size != M * DM || ws_size < WS_END) { fprintf(stderr, "kernel_launch: unexpected shapes (n_in %d in0 %d out %d ws %zu)\n", n_in, n_in > 0 ? in_sizes[0] : -1, out_size, ws_size); grid = -1; return; }
        int dev = 0, cus = 0, per_cu = 0;
        if (hipGetDevice(&dev) != hipSuccess || hipDeviceGetAttribute(&cus, hipDeviceAttributeMultiprocessorCount, dev) != hipSuccess) { grid = -1; return; }
        if (hipFuncSetAttribute((const void*)mega, hipFuncAttributeMaxDynamicSharedMemorySize, LDS_BYTES) != hipSuccess) { fprintf(stderr, "kernel_launch: hipFuncSetAttribute failed\n"); grid = -1; return; }
        if (hipOccupancyMaxActiveBlocksPerMultiprocessor(&per_cu, (const void*)mega, NTHR, LDS_BYTES) != hipSuccess || per_cu < 1) { fprintf(stderr, "kernel_launch: occupancy query says %d\n", per_cu); per_cu = 1; }
        (void)hipGetLastError();
        grid = cus;
    }
    if (grid < 0) return;
    (void)hipMemsetAsync((char*)d_ws + WS_CTL, 0, CTL_BYTES, stream);
    Args a{};
    for (int i = 0; i < 28; ++i) a.in[i] = (const float*)d_in[i];
    a.out = (float*)d_out; a.ws = (unsigned char*)d_ws;
#if MK_ONE_LAUNCH
    a.ph_lo = 0; a.ph_hi = N_PHASES;
    void* kargs[] = {&a};
    hipError_t e = hipLaunchCooperativeKernel((const void*)mega, dim3(grid), dim3(NTHR), kargs, LDS_BYTES, stream);
    if (e != hipSuccess) fprintf(stderr, "cooperative launch failed: %s (grid %d)\n", hipGetErrorString(e), grid);
#else
    for (int p = 0; p < N_PHASES; ++p) { a.ph_lo = p; a.ph_hi = p + 1; hipLaunchKernelGGL(mega, dim3(grid), dim3(NTHR), LDS_BYTES, stream, a); }
#endif
}
```

```cpp
#include <hip/hip_runtime.h>
#include <hip/hip_cooperative_groups.h>
#include <cstdio>
#include <cstdint>
namespace cg = cooperative_groups;

#ifndef PROBE_DUP
#define PROBE_DUP -1
#endif
#ifndef PROBE_DUP_ATTN
#define PROBE_DUP_ATTN 1
#endif
#ifndef MK_ONE_LAUNCH
#define MK_ONE_LAUNCH 1
#endif

#define LAS __attribute__((address_space(3)))
#define GAS __attribute__((address_space(1)))
typedef unsigned short bf16_t;
typedef short bf16x8 __attribute__((ext_vector_type(8)));
typedef short s16x4 __attribute__((ext_vector_type(4)));
typedef float f32x2 __attribute__((ext_vector_type(2)));
typedef float f32x4 __attribute__((ext_vector_type(4)));
typedef float f32x16 __attribute__((ext_vector_type(16)));
typedef unsigned u32x2 __attribute__((ext_vector_type(2)));
typedef unsigned u32x4 __attribute__((ext_vector_type(4)));
typedef int v8i32 __attribute__((ext_vector_type(8)));

constexpr int NB = 8, SEQ = 8192, DM = 1024, M = NB * SEQ;
constexpr int ZP = 2560;
constexpr int ZU = 0, ZV = 512, ZQ = 1024, ZK = 1536, ZVAL = 2048;
constexpr int MEML = 256, MROWS = NB * MEML;
constexpr int NEXP = 32, DEXP = 512;
constexpr int PROWS = 2 * M + NEXP * 256;
constexpr int MAXBLK = PROWS / 256;
constexpr float RMS_EPS = 1e-6f, LN_EPS = 1e-5f;
constexpr float LOG2E = 1.4426950408889634f;
constexpr float C2_DIFF = 0.125f * LOG2E;
constexpr float C2_MEM = 0.0625f * LOG2E;

constexpr size_t MiB = 1u << 20;
constexpr size_t WS_CTL = 0, CTL_BYTES = 1 * MiB;
constexpr size_t WS_WIN = 1 * MiB;
constexpr size_t WS_WOUT = 6 * MiB;
constexpr size_t WS_WQ = 8 * MiB;
constexpr size_t WS_WKV = 10 * MiB;
constexpr size_t WS_WO = 14 * MiB;
constexpr size_t WS_WR = 16 * MiB;
constexpr size_t WS_WSGU = 17 * MiB;
constexpr size_t WS_MEMN = 18 * MiB;
constexpr size_t WS_KM = 22 * MiB;
constexpr size_t WS_VT = 26 * MiB;
constexpr size_t WS_WGU = 30 * MiB;
constexpr size_t WS_WD = 94 * MiB;
constexpr size_t WS_RA = 128 * MiB;
constexpr size_t WS_RB = 448 * MiB;
constexpr size_t WS_RC = 592 * MiB;
constexpr size_t WS_SSQ1 = 720 * MiB;
constexpr size_t WS_SSQ2 = 724 * MiB;
constexpr size_t WS_LOGIT = 728 * MiB;
constexpr size_t WS_TOKE = 744 * MiB;
constexpr size_t WS_TOKW = 745 * MiB;
constexpr size_t WS_TOKS = 746 * MiB;
constexpr size_t WS_ROWTOK = 747 * MiB;
constexpr size_t WS_X2F8 = 752 * MiB;
constexpr size_t WS_SLOTTOK = 816 * MiB;
constexpr size_t SLOT_RS_OFF = 8 * MiB;
constexpr size_t WS_END = 832 * MiB;
constexpr int CW_CNT = 64;
constexpr int CW_NBLK = 128;
constexpr int CW_PSTART = 192;
constexpr int CW_BLKE = 256;
constexpr int CW_KMX = 1024;
constexpr int CW_SGUQ = 1344;
constexpr int CW_ALIST = 8192;
constexpr int CW_BAR = 4096;
constexpr int LDS_MISC = 131072;
constexpr int LDS_MOE = 158720;
constexpr int MAXBLK_MOE = 544;
constexpr int LDS_TBUF = 140288, TBUF_W = 2304;

__device__ __forceinline__ unsigned cvt_pk_bf16(float lo, float hi) { unsigned r; asm volatile("v_cvt_pk_bf16_f32 %0, %1, %2" : "=v"(r) : "v"(lo), "v"(hi)); return r; }
__device__ __forceinline__ float bf_lo(unsigned w) { return __uint_as_float(w << 16); }
__device__ __forceinline__ float bf_hi(unsigned w) { return __uint_as_float(w & 0xffff0000u); }
constexpr float F8_WSCALE = 256.f, F8_ASCALE = 8.f, F8_XSCALE = 4.f, F8_OSCALE = 16.f, F8_YSCALE = 16.f, F8_QSCALE = 64.f, F8_KSCALE = 16.f, F8_PSCALE = 256.f, F8_VSCALE = 16.f;
__device__ __forceinline__ unsigned pk4_fp8(float a, float b, float c, float d) {
    a = fminf(fmaxf(a, -448.f), 448.f); b = fminf(fmaxf(b, -448.f), 448.f); c = fminf(fmaxf(c, -448.f), 448.f); d = fminf(fmaxf(d, -448.f), 448.f);
    int w = 0; w = __builtin_amdgcn_cvt_pk_fp8_f32(a, b, w, false); w = __builtin_amdgcn_cvt_pk_fp8_f32(c, d, w, true); return (unsigned)w; }
__device__ __forceinline__ float wave_sum(float v) {
#pragma unroll
    for (int o = 1; o < 64; o <<= 1) v += __shfl_xor(v, o);
    return v;
}
__device__ __forceinline__ float wave_max(float v) {
#pragma unroll
    for (int o = 1; o < 64; o <<= 1) v = fmaxf(v, __shfl_xor(v, o));
    return v;
}
__device__ __forceinline__ int lane_id() { int l; asm volatile("v_mbcnt_lo_u32_b32 %0, -1, 0\n\tv_mbcnt_hi_u32_b32 %0, -1, %0" : "=v"(l)); return l; }
__device__ __forceinline__ unsigned ld_u32_agent(const unsigned* p) { return __hip_atomic_load(p, __ATOMIC_RELAXED, __HIP_MEMORY_SCOPE_AGENT); }

namespace pg8 {
constexpr unsigned GATHER_ROW_MASK = 65535u;
constexpr int BM = 256, BK = 64, HALF = 128, HTB = HALF * BK * 2, STAGE_BYTES = 8 * HTB, NXCD = 8, WGM = 8;
__host__ __device__ __forceinline__ int lds_byte(int r, int c) { const int st = (r >> 4) * 2 + (c >> 5), rr = r & 15, cc = c & 31, ob = rr * 64 + cc * 2; return st * 1024 + (ob ^ (((ob >> 9) & 1) << 5)); }
__host__ __device__ __forceinline__ void stage_rc(int b, int& R, int& C) { const int st = b / 1024, sb = b % 1024, swz = sb ^ (((sb >> 9) & 1) << 5); R = (st >> 1) * 16 + swz / 64; C = (st & 1) * 32 + (swz % 64) / 2; }
__host__ __device__ __forceinline__ int perm32(int rho) { const int n = rho >> 4, i = rho & 15; return 8 * (i >> 2) + 4 * n + (i & 3); }

struct Unit { const char* A; const char* B; int pm, pn, aux; const int* rows; };
struct Gemm { int lda, ldb, K; };

struct TileOrder {
    int nM, nN, nwg, G, c;
    __device__ __forceinline__ void init(int nM_, int nN_, int G_, int c_) { nM = nM_; nN = nN_; nwg = nM * nN; G = G_; c = c_; }
    __device__ __forceinline__ bool get(int i, int& pm, int& pn) const {
        const long L = (long)i * G + c; if (L >= nwg) return false;
        int wgid = (int)L; { const int q = nwg / NXCD, r = nwg % NXCD, xcd = wgid % NXCD, off = wgid / NXCD; wgid = (xcd < r ? xcd * (q + 1) : r * (q + 1) + (xcd - r) * q) + off; }
        const int nig = WGM * nN, gid = wgid / nig, fm = gid * WGM, gsz = (nM - fm) < WGM ? (nM - fm) : WGM;
        pm = fm + ((wgid % nig) % gsz); pn = (wgid % nig) / gsz; return true;
    }
};

typedef float f32x2g __attribute__((ext_vector_type(2)));
__device__ __forceinline__ f32x2g gelu_pk(f32x2g v) {
    const f32x2g av = __builtin_elementwise_abs(v), d = av * 0.2316418882f + 1.0f;
    f32x2g t; t.x = __builtin_amdgcn_rcpf(d.x); t.y = __builtin_amdgcn_rcpf(d.y);
    f32x2g q = t * 0.5307027145f + (-0.7265760135f); q = q * t + 0.7107068705f; q = q * t + (-0.142248368f); q = q * t + 0.127414796f; q = q * t;
    const f32x2g s = (v * v) * (-0.72134752044f);
    f32x2g e; e.x = __builtin_amdgcn_exp2f(s.x); e.y = __builtin_amdgcn_exp2f(s.y);
    const f32x2g m = v * (q * e), r = v - m;
    f32x2g o; o.x = v.x < 0.f ? m.x : r.x; o.y = v.y < 0.f ? m.y : r.y; return o;
}

__device__ __forceinline__ const char* uniform_ptr(const char* p) { const unsigned long long v = (unsigned long long)p; const unsigned lo = __builtin_amdgcn_readfirstlane((unsigned)v), hi = __builtin_amdgcn_readfirstlane((unsigned)(v >> 32)); return (const char*)(((unsigned long long)hi << 32) | lo); }
template <class Epi, class Sched, bool GATHER = false, bool FP8 = false>
__device__ __forceinline__ void gemm_phase(LAS unsigned char* lds, int wid, const Gemm g, const Sched& S, const Epi& E) {
    const int lane = lane_id(), tid = wid * 64 + lane, wr = wid >> 2, wc = wid & 3, fr = lane & 15, fq = lane >> 4;
    const int nt = g.K / BK;
    unsigned voffB[2]; unsigned vA0[2], vA1[2]; int RA[2], CA[2];
#pragma unroll
    for (int i = 0; i < 2; ++i) { int R, C; stage_rc(tid * 16 + i * 8192, R, C); const int pr = Epi::PERM ? perm32(R & 31) : (R & 31);
        RA[i] = R; CA[i] = C; voffB[i] = (unsigned)((64 * (R >> 5) + pr) * g.ldb + C) * 2u;
        vA0[i] = (unsigned)(R * g.lda + C) * 2u; vA1[i] = vA0[i]; }
    const size_t kstep = (size_t)(BK * 2);
    const size_t hstepA = GATHER ? (size_t)0 : (size_t)HALF * g.lda * 2, hstepB = (size_t)32 * g.ldb * 2;
    LAS u32x4* park = (LAS u32x4*)(lds + 131072 + 1024) + tid;
#define PG8_GOFF(U, d0, d1) do { _Pragma("unroll") for (int _i = 0; _i < 2; ++_i) { \
        d0[_i] = (((unsigned)(U).rows[RA[_i]] & GATHER_ROW_MASK) * (unsigned)g.lda + (unsigned)CA[_i]) * 2u; d1[_i] = (((unsigned)(U).rows[HALF + RA[_i]] & GATHER_ROW_MASK) * (unsigned)g.lda + (unsigned)CA[_i]) * 2u; } } while (0)
    const unsigned ldsw = (unsigned)wid * 1024u;
    const int aoff = lds_byte(wr * 64 + fr, fq * 8), boff = lds_byte(wc * 32 + fr, fq * 8);
#define PG8_SA(b, h) (((b) * 2 + (h)) * HTB)
#define PG8_SB(b, h) ((4 + (b) * 2 + (h)) * HTB)
#define PG8_STAGE(bufoff, gbase, voff) do { _Pragma("unroll") for (int _i = 0; _i < 2; ++_i) \
        __builtin_amdgcn_global_load_lds((const unsigned*)((const char*)(gbase) + (voff)[_i]), (LAS unsigned*)(lds + (bufoff) + ldsw + _i * 8192), 16, 0, 0); } while (0)
#define PG8_LD8(dst_, addr_) do { const u32x4 lo_ = *(const LAS u32x4*)(addr_), hi_ = *(const LAS u32x4*)((addr_) + 1024); \
        dst_ = (v8i32){(int)lo_.x, (int)lo_.y, (int)lo_.z, (int)lo_.w, (int)hi_.x, (int)hi_.y, (int)hi_.z, (int)hi_.w}; } while (0)
#define PG8_LDA(dst, b, h) do { _Pragma("unroll") for (int m = 0; m < 4; ++m) PG8_LD8(dst[m], lds + PG8_SA(b, h) + aoff + m * 2048); } while (0)
#define PG8_LDB(dst, b, h) do { _Pragma("unroll") for (int n = 0; n < 2; ++n) PG8_LD8(dst[n], lds + PG8_SB(b, h) + boff + n * 2048); } while (0)
#define PG8_HALF(v_, k_) __builtin_bit_cast(bf16x8, __builtin_shufflevector(v_, v_, 4 * (k_) + 0, 4 * (k_) + 1, 4 * (k_) + 2, 4 * (k_) + 3))
#define PG8_MMA(ai, bj, At, Bt) do { __builtin_amdgcn_s_setprio(1); _Pragma("unroll") for (int m = 0; m < 4; ++m) _Pragma("unroll") for (int n = 0; n < 2; ++n) { \
        if constexpr (FP8) asm volatile("v_mfma_scale_f32_16x16x128_f8f6f4 %0, %1, %2, %0, %3, %3 op_sel_hi:[0,0,0]" : "+v"(acc[ai][bj][m][n]) : "v"(Bt[n]), "v"(At[m]), "v"(one8_));   \
        else { acc[ai][bj][m][n] = __builtin_amdgcn_mfma_f32_16x16x32_bf16(PG8_HALF(Bt[n], 0), PG8_HALF(At[m], 0), acc[ai][bj][m][n], 0, 0, 0); \
               acc[ai][bj][m][n] = __builtin_amdgcn_mfma_f32_16x16x32_bf16(PG8_HALF(Bt[n], 1), PG8_HALF(At[m], 1), acc[ai][bj][m][n], 0, 0, 0); } } \
        __builtin_amdgcn_s_setprio(0); } while (0)
#define PG8_WAIT_V(n) asm volatile("s_waitcnt vmcnt(" #n ")" ::: "memory")
#define PG8_WAIT_L(n) asm volatile("s_waitcnt lgkmcnt(" #n ")" ::: "memory")
#define PG8_BAR __builtin_amdgcn_s_barrier()
#define PG8_SCHED __builtin_amdgcn_sched_barrier(0)
    Unit cur, nxt; int ui = 0;
    if (!S.next(0, cur)) return;
    f32x4 acc[2][2][4][2];
#pragma unroll
    for (int a = 0; a < 2; ++a)
#pragma unroll
        for (int b = 0; b < 2; ++b)
#pragma unroll
            for (int m = 0; m < 4; ++m)
#pragma unroll
                for (int n = 0; n < 2; ++n) acc[a][b][m][n] = (f32x4){0.f, 0.f, 0.f, 0.f};
    v8i32 At[4], B0[2], B1[2];
    const int one8_ = 0x7f7f7f7f;
    const char* cA = uniform_ptr(cur.A); const char* cB = uniform_ptr(cur.B);
    if constexpr (GATHER) { PG8_GOFF(cur, vA0, vA1); }
    PG8_STAGE(PG8_SB(0, 0), cB, voffB); PG8_STAGE(PG8_SB(0, 1), cB + hstepB, voffB); PG8_STAGE(PG8_SA(0, 0), cA, vA0); PG8_STAGE(PG8_SA(0, 1), cA + hstepA, vA1);
    if (wr == 1) PG8_BAR;
    PG8_WAIT_V(2); PG8_BAR;
    PG8_STAGE(PG8_SB(1, 0), cB + kstep, voffB); PG8_STAGE(PG8_SA(1, 0), cA + kstep, vA0); PG8_STAGE(PG8_SB(1, 1), cB + hstepB + kstep, voffB);
    PG8_WAIT_V(6); PG8_BAR;
    for (;;) {
        const bool has_next = S.next(ui + 1, nxt);
        const char* nA = has_next ? uniform_ptr(nxt.A) : cA; const char* nB = has_next ? uniform_ptr(nxt.B) : cB;
        if constexpr (GATHER) { unsigned n0[2] = {vA0[0], vA0[1]}, n1[2] = {vA1[0], vA1[1]}; if (has_next) { PG8_GOFF(nxt, n0, n1); } *park = (u32x4){n0[0], n0[1], n1[0], n1[1]}; }
#pragma nounroll
        for (int t = 0; t < nt; t += 2) {
            const bool last = (t == nt - 2);
            const char* a1 = cA + (size_t)(t + 1) * kstep;
            const char* a2 = uniform_ptr(last ? nA : cA + (size_t)(t + 2) * kstep); const char* b2 = uniform_ptr(last ? nB : cB + (size_t)(t + 2) * kstep);
            const char* a3 = a2 + kstep; const char* b3 = b2 + kstep;
            unsigned w0[2] = {vA0[0], vA0[1]}, w1[2] = {vA1[0], vA1[1]};
            if constexpr (GATHER) { if (last) { const u32x4 pk = *park; w0[0] = pk.x; w0[1] = pk.y; w1[0] = pk.z; w1[1] = pk.w; } }
            PG8_LDB(B0, 0, 0); PG8_LDB(B1, 0, 1); PG8_SCHED; PG8_LDA(At, 0, 0); PG8_STAGE(PG8_SA(1, 1), a1 + hstepA, vA1);
            PG8_WAIT_V(8); PG8_WAIT_L(0); PG8_BAR; PG8_MMA(0, 0, At, B0); PG8_MMA(0, 1, At, B1); PG8_BAR; PG8_SCHED;
            PG8_LDA(At, 0, 1); PG8_STAGE(PG8_SB(0, 0), b2, voffB); PG8_STAGE(PG8_SB(0, 1), b2 + hstepB, voffB); PG8_STAGE(PG8_SA(0, 0), a2, w0);
            PG8_WAIT_V(8); PG8_WAIT_L(0); PG8_BAR; PG8_MMA(1, 0, At, B0); PG8_MMA(1, 1, At, B1); PG8_BAR; PG8_SCHED;
            PG8_LDB(B0, 1, 0); PG8_LDB(B1, 1, 1); PG8_SCHED; PG8_LDA(At, 1, 0); PG8_STAGE(PG8_SA(0, 1), a2 + hstepA, w1);
            PG8_WAIT_V(8); PG8_WAIT_L(0); PG8_BAR; PG8_MMA(0, 0, At, B0); PG8_MMA(0, 1, At, B1); PG8_BAR; PG8_SCHED;
            PG8_LDA(At, 1, 1); PG8_STAGE(PG8_SB(1, 0), b3, voffB); PG8_STAGE(PG8_SB(1, 1), b3 + hstepB, voffB); PG8_STAGE(PG8_SA(1, 0), a3, w0);
            PG8_WAIT_V(8); PG8_WAIT_L(0); PG8_BAR; PG8_MMA(1, 0, At, B0); PG8_MMA(1, 1, At, B1); PG8_BAR; PG8_SCHED;
        }
        if (wr == 0) PG8_BAR;
        if constexpr (FP8) asm volatile("s_nop 15\n\ts_nop 7" ::: "memory");
        asm volatile("" ::: "memory");
        { const int l2_ = lane_id(); E(acc, cur, wr, wc, l2_ & 15, l2_ >> 4, lds + LDS_TBUF + wid * TBUF_W); }
        if (!has_next) break;
#pragma unroll
        for (int a = 0; a < 2; ++a)
#pragma unroll
            for (int b = 0; b < 2; ++b)
#pragma unroll
                for (int m = 0; m < 4; ++m)
#pragma unroll
                    for (int n = 0; n < 2; ++n) acc[a][b][m][n] = (f32x4){0.f, 0.f, 0.f, 0.f};
        cur = nxt; cA = nA; cB = nB; ++ui;
        if constexpr (GATHER) { const u32x4 pk = *park; vA0[0] = pk.x; vA0[1] = pk.y; vA1[0] = pk.z; vA1[1] = pk.w; }
        if (wr == 1) PG8_BAR;
    }
    PG8_WAIT_V(0);
    PG8_BAR;
#undef PG8_GOFF
#undef PG8_SA
#undef PG8_SB
#undef PG8_STAGE
#undef PG8_LD8
#undef PG8_HALF
#undef PG8_LDA
#undef PG8_LDB
#undef PG8_MMA
#undef PG8_WAIT_V
#undef PG8_WAIT_L
#undef PG8_BAR
#undef PG8_SCHED
}

struct PlainSched {
    TileOrder to; const char* A; const char* B; size_t tA, tB;
    __device__ __forceinline__ bool next(int i, Unit& u) const { int pm, pn; if (!to.get(i, pm, pn)) return false; u.pm = pm; u.pn = pn; u.aux = 0; u.rows = nullptr; u.A = A + (size_t)pm * tA; u.B = B + (size_t)pn * tB; return true; }
};
struct OneUnitSched {
    Unit u0;
    __device__ __forceinline__ bool next(int i, Unit& u) const { if (i != 0) return false; u = u0; return true; }
};
struct MemAttnSched {
    TileOrder to; const char* A; const char* B; size_t tA, hA, bB, hB;
    __device__ __forceinline__ bool next(int i, Unit& u) const { int pm, pn; if (!to.get(i, pm, pn)) return false; u.pm = pm; u.pn = pn; u.aux = 0; u.rows = nullptr;
        u.A = A + (size_t)pm * tA + (size_t)pn * hA; const int b = pm >> 5; u.B = B + (size_t)b * bB + (size_t)pn * hB; return true; }
};
struct MoeSched {
    int G, c; const LAS unsigned* lps; const char* A; const char* B; size_t tA, eB, tB; const int* slots;
    __device__ __forceinline__ bool next(int i, Unit& u) const { const int L = i * G + c; const int nblk = (int)__builtin_amdgcn_readfirstlane(lps[32] >> 8); if (L >= nblk * 4) return false; const int rb = L >> 2, pn = L & 3;
        const int e = (int)__builtin_amdgcn_readfirstlane(lps[64 + rb]); const int s0 = (int)__builtin_amdgcn_readfirstlane(lps[e]); u.pm = rb; u.pn = pn; u.aux = e; u.rows = slots + (size_t)e * 65536 + (rb * 256 - s0);
        u.A = A + (size_t)rb * tA; u.B = B + (size_t)e * eB + (size_t)pn * tB; return true; }
};

#define EPI_ARGS f32x4 (&acc)[2][2][4][2], const Unit& u, int wr, int wc, int fr, int fq, LAS unsigned char* tb
__device__ __forceinline__ void st128(bf16_t* rowbase, size_t ldc, const u32x4 w0, const u32x4 w1, int fr, int fq, LAS unsigned char* tb) {
    *(LAS u32x4*)(tb + fr * 144 + fq * 16) = w0; *(LAS u32x4*)(tb + fr * 144 + 64 + fq * 16) = w1;
    const int L = fq * 16 + fr, r = L >> 3, c = L & 7;
    const u32x4 a = *(const LAS u32x4*)(tb + r * 144 + c * 16), b = *(const LAS u32x4*)(tb + (8 + r) * 144 + c * 16);
    *(u32x4*)(rowbase + (size_t)r * ldc + c * 8) = a; *(u32x4*)(rowbase + (size_t)(8 + r) * ldc + c * 8) = b;
}
__device__ __forceinline__ u32x4 pk8(const f32x4 v0, const f32x4 v1) { u32x4 w; w.x = cvt_pk_bf16(v0[0], v0[1]); w.y = cvt_pk_bf16(v0[2], v0[3]); w.z = cvt_pk_bf16(v1[0], v1[1]); w.w = cvt_pk_bf16(v1[2], v1[3]); return w; }
struct EpiZ {
    static constexpr bool PERM = true;
    bf16_t* O; unsigned* kmx;
    __device__ __forceinline__ void operator()(EPI_ARGS) const {
        const int mode = u.pn < 4 ? 1 : (u.pn < 6 ? 2 : 0);
        if (u.pn == 6 || u.pn == 7) {
#pragma unroll
            for (int bj = 0; bj < 2; ++bj) { float mx = 0.f;
#pragma unroll
                for (int ai = 0; ai < 2; ++ai)
#pragma unroll
                    for (int m = 0; m < 4; ++m) { const f32x4 a = acc[ai][bj][m][0], b = acc[ai][bj][m][1];
                        float q = (a[0] * a[0] + a[1] * a[1]) + (a[2] * a[2] + a[3] * a[3]) + (b[0] * b[0] + b[1] * b[1]) + (b[2] * b[2] + b[3] * b[3]);
                        q += __shfl_xor(q, 16); q += __shfl_xor(q, 32); mx = fmaxf(mx, q); }
#pragma unroll
                for (int o_ = 1; o_ < 16; o_ <<= 1) mx = fmaxf(mx, __shfl_xor(mx, o_));
                if (fr == 0 && fq == 0) { const int b_ = u.pm >> 5, h_ = (u.pn - 6) * 2 + (wc >> 1); atomicMax(kmx + (((b_ * 4 + h_) * 2 + (wc & 1)) * 2 + bj), __float_as_uint(mx)); } }
        }
#pragma unroll
        for (int ai = 0; ai < 2; ++ai)
#pragma unroll
            for (int m = 0; m < 4; ++m) { u32x4 w[2];
#pragma unroll
                for (int bj = 0; bj < 2; ++bj) { f32x4 v0 = acc[ai][bj][m][0], v1 = acc[ai][bj][m][1];
                    if (mode == 1) { f32x2g a = gelu_pk((f32x2g){v0[0], v0[1]}), b = gelu_pk((f32x2g){v0[2], v0[3]}), c = gelu_pk((f32x2g){v1[0], v1[1]}), d = gelu_pk((f32x2g){v1[2], v1[3]});
                        v0 = (f32x4){a.x, a.y, b.x, b.y}; v1 = (f32x4){c.x, c.y, d.x, d.y}; }
                    else if (mode == 2) { v0 = v0 * C2_DIFF; v1 = v1 * C2_DIFF; }
                    w[bj] = pk8(v0, v1); }
                st128(O + (size_t)(u.pm * BM + ai * HALF + wr * 64 + m * 16) * ZP + u.pn * BM + wc * 64, ZP, w[0], w[1], fr, fq, tb); }
    }
};
struct EpiBf16 {
    static constexpr bool PERM = true;
    bf16_t* O; int ldc; const float* ssq; float cscale;
    __device__ __forceinline__ void operator()(EPI_ARGS) const {
        float sc[2][4];
#pragma unroll
        for (int ai = 0; ai < 2; ++ai)
#pragma unroll
            for (int m = 0; m < 4; ++m) sc[ai][m] = cscale;
        if (ssq) {
#pragma unroll
            for (int ai = 0; ai < 2; ++ai)
#pragma unroll
                for (int m = 0; m < 4; ++m) { const f32x4 s4 = *(const f32x4*)(ssq + (size_t)(u.pm * BM + ai * HALF + wr * 64 + m * 16 + fr) * 4);
                    sc[ai][m] = cscale * __builtin_amdgcn_rsqf(((s4[0] + s4[1]) + (s4[2] + s4[3])) * (1.0f / DM) + RMS_EPS); }
        }
#pragma unroll
        for (int ai = 0; ai < 2; ++ai)
#pragma unroll
            for (int m = 0; m < 4; ++m) { const int rowg = u.pm * BM + ai * HALF + wr * 64 + m * 16; const float c = sc[ai][m];
                st128(O + (size_t)rowg * ldc + u.pn * BM + wc * 64, (size_t)ldc, pk8(acc[ai][0][m][0] * c, acc[ai][0][m][1] * c), pk8(acc[ai][1][m][0] * c, acc[ai][1][m][1] * c), fr, fq, tb); }
    }
};
struct EpiF8 {
    static constexpr bool PERM = true;
    unsigned char* O; int ldc; const float* ssq; float cscale;
    __device__ __forceinline__ void operator()(EPI_ARGS) const {
        const int L = fq * 16 + fr;
        float sc[2][4];
#pragma unroll
        for (int ai = 0; ai < 2; ++ai)
#pragma unroll
            for (int m = 0; m < 4; ++m) sc[ai][m] = cscale;
        if (ssq) {
#pragma unroll
            for (int ai = 0; ai < 2; ++ai)
#pragma unroll
                for (int m = 0; m < 4; ++m) { const f32x4 s4 = *(const f32x4*)(ssq + (size_t)(u.pm * BM + ai * HALF + wr * 64 + m * 16 + fr) * 4);
                    sc[ai][m] = cscale * __builtin_amdgcn_rsqf(((s4[0] + s4[1]) + (s4[2] + s4[3])) * (1.0f / DM) + RMS_EPS); }
        }
#pragma unroll
        for (int ai = 0; ai < 2; ++ai)
#pragma unroll
            for (int m = 0; m < 4; ++m) { const int rowg = u.pm * BM + ai * HALF + wr * 64 + m * 16; const float c = sc[ai][m];
#pragma unroll
                for (int bj = 0; bj < 2; ++bj) { const f32x4 a = acc[ai][bj][m][0] * c, b = acc[ai][bj][m][1] * c; u32x2 f; f.x = pk4_fp8(a[0], a[1], a[2], a[3]); f.y = pk4_fp8(b[0], b[1], b[2], b[3]);
                    *(LAS u32x2*)(tb + fr * 144 + bj * 32 + fq * 8) = f; }
                const u32x4 v8 = *(const LAS u32x4*)(tb + (L >> 2) * 144 + (L & 3) * 16);
                *(u32x4*)(O + (size_t)(rowg + (L >> 2)) * ldc + u.pn * BM + wc * 64 + (L & 3) * 16) = v8; }
    }
};
struct EpiSoftmax {
    static constexpr bool PERM = true;
    unsigned char* O; LAS float* xch; float sscale;
    __device__ __forceinline__ void operator()(EPI_ARGS) const {
        LAS float* xm = xch; LAS float* xs = xch + 1024;
#pragma unroll
        for (int ai = 0; ai < 2; ++ai)
#pragma unroll
            for (int bj = 0; bj < 2; ++bj)
#pragma unroll
                for (int m = 0; m < 4; ++m)
#pragma unroll
                    for (int n = 0; n < 2; ++n) acc[ai][bj][m][n] = acc[ai][bj][m][n] * sscale;
#pragma unroll
        for (int ai = 0; ai < 2; ++ai)
#pragma unroll
            for (int m = 0; m < 4; ++m) { float v = -__builtin_inff();
#pragma unroll
                for (int bj = 0; bj < 2; ++bj)
#pragma unroll
                    for (int n = 0; n < 2; ++n) { const f32x4 a = acc[ai][bj][m][n]; v = fmaxf(v, fmaxf(fmaxf(a[0], a[1]), fmaxf(a[2], a[3]))); }
                v = fmaxf(v, __shfl_xor(v, 16)); v = fmaxf(v, __shfl_xor(v, 32));
                if (fq == 0) xm[(ai * HALF + wr * 64 + m * 16 + fr) * 4 + wc] = v; }
        asm volatile("s_waitcnt lgkmcnt(0)" ::: "memory"); __builtin_amdgcn_s_barrier(); asm volatile("" ::: "memory");
#pragma unroll
        for (int ai = 0; ai < 2; ++ai)
#pragma unroll
            for (int m = 0; m < 4; ++m) { const f32x4 t = *(const LAS f32x4*)(xm + (ai * HALF + wr * 64 + m * 16 + fr) * 4); const float mx = fmaxf(fmaxf(t[0], t[1]), fmaxf(t[2], t[3])); float sm = 0.f;
#pragma unroll
                for (int bj = 0; bj < 2; ++bj)
#pragma unroll
                    for (int n = 0; n < 2; ++n) { f32x4 a = acc[ai][bj][m][n];
#pragma unroll
                        for (int j = 0; j < 4; ++j) { a[j] = __builtin_amdgcn_exp2f(a[j] - mx); sm += a[j]; }
                        acc[ai][bj][m][n] = a; }
                sm += __shfl_xor(sm, 16); sm += __shfl_xor(sm, 32);
                if (fq == 0) xs[(ai * HALF + wr * 64 + m * 16 + fr) * 4 + wc] = sm; }
        asm volatile("s_waitcnt lgkmcnt(0)" ::: "memory"); __builtin_amdgcn_s_barrier(); asm volatile("" ::: "memory");
#pragma unroll
        for (int ai = 0; ai < 2; ++ai)
#pragma unroll
            for (int m = 0; m < 4; ++m) { const f32x4 t = *(const LAS f32x4*)(xs + (ai * HALF + wr * 64 + m * 16 + fr) * 4); const float inv = F8_PSCALE * __builtin_amdgcn_rcpf((t[0] + t[1]) + (t[2] + t[3]));
                const int rowg = u.pm * BM + ai * HALF + wr * 64 + m * 16, L = fq * 16 + fr;
#pragma unroll
                for (int bj = 0; bj < 2; ++bj) { const f32x4 a = acc[ai][bj][m][0] * inv, b = acc[ai][bj][m][1] * inv; u32x2 f; f.x = pk4_fp8(a[0], a[1], a[2], a[3]); f.y = pk4_fp8(b[0], b[1], b[2], b[3]);
                    *(LAS u32x2*)(tb + fr * 144 + bj * 32 + fq * 8) = f; }
                const u32x4 v8 = *(const LAS u32x4*)(tb + (L >> 2) * 144 + (L & 3) * 16);
                *(u32x4*)(O + (size_t)(rowg + (L >> 2)) * DM + u.pn * BM + wc * 64 + (L & 3) * 16) = v8; }
    }
};
template <bool BF>
struct EpiResid {
    static constexpr bool PERM = true;
    const void* base; bf16_t* ob; float* ssq; LAS float* xs; unsigned char* o8; float as;
    __device__ __forceinline__ void operator()(EPI_ARGS) const {
        const int col0 = u.pn * BM + wc * 64 + 8 * fq;
        if constexpr (BF) {
            u32x4 br[2][4][2];
#pragma unroll
            for (int ai = 0; ai < 2; ++ai)
#pragma unroll
                for (int m = 0; m < 4; ++m)
#pragma unroll
                    for (int bj = 0; bj < 2; ++bj) br[ai][m][bj] = *(const u32x4*)((const bf16_t*)base + (size_t)(u.pm * BM + ai * HALF + wr * 64 + m * 16 + fr) * DM + col0 + bj * 32);
#pragma unroll
            for (int ai = 0; ai < 2; ++ai)
#pragma unroll
                for (int m = 0; m < 4; ++m) asm volatile("" : "+v"(br[ai][m][0]), "+v"(br[ai][m][1]));
#pragma unroll
            for (int ai = 0; ai < 2; ++ai)
#pragma unroll
                for (int m = 0; m < 4; ++m) { const int rowg = u.pm * BM + ai * HALF + wr * 64 + m * 16, row = rowg + fr; float s = 0.f; u32x4 w[2]; u32x2 f8[2];
#pragma unroll
                    for (int bj = 0; bj < 2; ++bj) { const u32x4 r = br[ai][m][bj];
                        const f32x4 o0 = (f32x4){bf_lo(r.x), bf_hi(r.x), bf_lo(r.y), bf_hi(r.y)} + acc[ai][bj][m][0] * as, o1 = (f32x4){bf_lo(r.z), bf_hi(r.z), bf_lo(r.w), bf_hi(r.w)} + acc[ai][bj][m][1] * as;
                        s += (o0[0] * o0[0] + o0[1] * o0[1]) + (o0[2] * o0[2] + o0[3] * o0[3]) + (o1[0] * o1[0] + o1[1] * o1[1]) + (o1[2] * o1[2] + o1[3] * o1[3]);
                        w[bj] = pk8(o0, o1);
                        f8[bj].x = pk4_fp8(o0[0] * F8_XSCALE, o0[1] * F8_XSCALE, o0[2] * F8_XSCALE, o0[3] * F8_XSCALE); f8[bj].y = pk4_fp8(o1[0] * F8_XSCALE, o1[1] * F8_XSCALE, o1[2] * F8_XSCALE, o1[3] * F8_XSCALE); }
                    st128(ob + (size_t)rowg * DM + u.pn * BM + wc * 64, (size_t)DM, w[0], w[1], fr, fq, tb);
                    if (o8) {
                        *(LAS u32x2*)(tb + fr * 144 + fq * 8) = f8[0]; *(LAS u32x2*)(tb + fr * 144 + 32 + fq * 8) = f8[1];
                        const int L = fq * 16 + fr; const u32x4 v8 = *(const LAS u32x4*)(tb + (L >> 2) * 144 + (L & 3) * 16);
                        *(u32x4*)(o8 + (size_t)(rowg + (L >> 2)) * DM + u.pn * BM + wc * 64 + (L & 3) * 16) = v8; }
                    s += __shfl_xor(s, 16); s += __shfl_xor(s, 32);
                    if (fq == 0) xs[(ai * HALF + wr * 64 + m * 16 + fr) * 4 + wc] = s; }
        } else {
#pragma unroll
            for (int ai = 0; ai < 2; ++ai) {
                f32x4 br[4][2][2];
#pragma unroll
                for (int m = 0; m < 4; ++m)
#pragma unroll
                    for (int bj = 0; bj < 2; ++bj) { const float* p = (const float*)base + (size_t)(u.pm * BM + ai * HALF + wr * 64 + m * 16 + fr) * DM + col0 + bj * 32; br[m][bj][0] = *(const f32x4*)p; br[m][bj][1] = *(const f32x4*)(p + 4); }
#pragma unroll
                for (int m = 0; m < 4; ++m) asm volatile("" : "+v"(br[m][0][0]), "+v"(br[m][0][1]), "+v"(br[m][1][0]), "+v"(br[m][1][1]));
#pragma unroll
                for (int m = 0; m < 4; ++m) { const int rowg = u.pm * BM + ai * HALF + wr * 64 + m * 16; float s = 0.f; u32x4 w[2]; u32x2 f8[2];
#pragma unroll
                    for (int bj = 0; bj < 2; ++bj) { const f32x4 o0 = br[m][bj][0] + acc[ai][bj][m][0] * as, o1 = br[m][bj][1] + acc[ai][bj][m][1] * as;
                        s += (o0[0] * o0[0] + o0[1] * o0[1]) + (o0[2] * o0[2] + o0[3] * o0[3]) + (o1[0] * o1[0] + o1[1] * o1[1]) + (o1[2] * o1[2] + o1[3] * o1[3]);
                        w[bj] = pk8(o0, o1);
                        f8[bj].x = pk4_fp8(o0[0] * F8_XSCALE, o0[1] * F8_XSCALE, o0[2] * F8_XSCALE, o0[3] * F8_XSCALE); f8[bj].y = pk4_fp8(o1[0] * F8_XSCALE, o1[1] * F8_XSCALE, o1[2] * F8_XSCALE, o1[3] * F8_XSCALE); }
                    st128(ob + (size_t)rowg * DM + u.pn * BM + wc * 64, (size_t)DM, w[0], w[1], fr, fq, tb);
                    if (o8) {
                        *(LAS u32x2*)(tb + fr * 144 + fq * 8) = f8[0]; *(LAS u32x2*)(tb + fr * 144 + 32 + fq * 8) = f8[1];
                        const int L = fq * 16 + fr; const u32x4 v8 = *(const LAS u32x4*)(tb + (L >> 2) * 144 + (L & 3) * 16);
                        *(u32x4*)(o8 + (size_t)(rowg + (L >> 2)) * DM + u.pn * BM + wc * 64 + (L & 3) * 16) = v8; }
                    s += __shfl_xor(s, 16); s += __shfl_xor(s, 32);
                    if (fq == 0) xs[(ai * HALF + wr * 64 + m * 16 + fr) * 4 + wc] = s; }
            }
        }
        asm volatile("s_waitcnt lgkmcnt(0)" ::: "memory"); __builtin_amdgcn_s_barrier(); asm volatile("" ::: "memory");
        { const int t_ = (wr * 4 + wc) * 64 + fq * 16 + fr;
          if (t_ < 256) { const f32x4 p = *(const LAS f32x4*)(xs + t_ * 4); ssq[(size_t)(u.pm * BM + t_) * 4 + u.pn] = (p[0] + p[1]) + (p[2] + p[3]); } }
    }
};
struct EpiRouter {
    static constexpr bool PERM = false;
    float* L; const float* ssq; const float* bg; const float* be; float* rstd_out;
    __device__ __forceinline__ void operator()(EPI_ARGS) const {
        if (wc != 0) return;
        const int row0 = u.pm * BM + wr * 64 + fr;
        float rsv[2][4];
#pragma unroll
        for (int ai = 0; ai < 2; ++ai)
#pragma unroll
            for (int m = 0; m < 4; ++m) { const f32x4 s4 = *(const f32x4*)(ssq + (size_t)(row0 + ai * HALF + m * 16) * 4);
                rsv[ai][m] = __builtin_amdgcn_rsqf(((s4[0] + s4[1]) + (s4[2] + s4[3])) * (1.0f / DM) + RMS_EPS); }
#pragma unroll
        for (int ai = 0; ai < 2; ++ai)
#pragma unroll
            for (int m = 0; m < 4; ++m) { const int row = row0 + ai * HALF + m * 16; const float rs = rsv[ai][m];
                if (fq == 0) rstd_out[row] = rs;
#pragma unroll
                for (int bj = 0; bj < 2; ++bj)
#pragma unroll
                    for (int n = 0; n < 2; ++n) { const int c0 = bj * 32 + n * 16 + 4 * fq; f32x4 o = acc[ai][bj][m][n] * rs;
#pragma unroll
                        for (int j = 0; j < 4; ++j) { const int c = c0 + j; const float b = c < 4 ? bg[c] : (c < 36 ? be[c - 4] : 0.f); o[j] += b; }
                        *(f32x4*)(L + (size_t)row * 64 + c0) = o; } }
    }
};
struct EpiGateUp {
    static constexpr bool PERM = true;
    unsigned char* act;
    __device__ __forceinline__ void operator()(EPI_ARGS) const {
        const int row0 = u.pm * BM + wr * 64 + fr, col0 = u.pn * 128 + wc * 32 + 8 * fq;
        const float* rstd = (const float*)((const char*)u.rows + SLOT_RS_OFF) + wr * 64 + fr;
        float rsv[2][4];
#pragma unroll
        for (int ai = 0; ai < 2; ++ai)
#pragma unroll
            for (int m = 0; m < 4; ++m) rsv[ai][m] = rstd[ai * HALF + m * 16];
#pragma unroll
        for (int ai = 0; ai < 2; ++ai)
#pragma unroll
            for (int m = 0; m < 4; ++m) { const int row = row0 + ai * HALF + m * 16; const float rs = rsv[ai][m];
                float r[8];
#pragma unroll
                for (int n = 0; n < 2; ++n)
#pragma unroll
                    for (int j = 0; j < 4; ++j) { const float gg = acc[ai][0][m][n][j] * rs, uu = acc[ai][1][m][n][j] * rs;
                        r[n * 4 + j] = gg * __builtin_amdgcn_rcpf(1.0f + __builtin_amdgcn_exp2f(-gg * LOG2E)) * uu; }
                u32x2 w; w.x = pk4_fp8(r[0] * F8_ASCALE, r[1] * F8_ASCALE, r[2] * F8_ASCALE, r[3] * F8_ASCALE); w.y = pk4_fp8(r[4] * F8_ASCALE, r[5] * F8_ASCALE, r[6] * F8_ASCALE, r[7] * F8_ASCALE);
                *(u32x2*)(act + (size_t)row * DEXP + col0) = w; }
    }
};
}

namespace da {
constexpr int NW = 8, QBLK = 32, KVBLK = 64, QB = NW * QBLK, DV = 128;
constexpr int SHM_V = KVBLK * DV * 2, SHM_K = KVBLK * 64 * 2;
constexpr int LDS_V = 0, LDS_K = 2 * SHM_V, LDS_WS = LDS_K + 2 * SHM_K, LDS_CX = LDS_WS + NW * 64 * 4, LDS_STASH = LDS_CX + 256, LDS_BYTES = LDS_STASH + NW * 8192;
constexpr float SKIP_MARGIN = 40.f;
constexpr float THR = 8.f;
#define SBAR() __builtin_amdgcn_sched_barrier(0)
__device__ __forceinline__ int kswz(int row, int chunk) { return row * 128 + ((chunk ^ ((row >> 1) & 7)) << 4); }
__device__ __forceinline__ int v_st(int k, int c) { const int kk = (k & ~0xC) | ((k & 4) << 1) | ((k & 8) >> 1); return ((kk >> 3) * 4 + (c >> 5)) * 512 + ((kk & 7) * 32 + (c & 31)) * 2; }
__device__ __forceinline__ int v_rd_base(int lane) { return ((lane & 3) << 3) | (((lane >> 2) & 3) << 6) | (((lane >> 4) & 1) << 5) | (((lane >> 5) & 1) << 8); }
constexpr int v_rd_off(int d0, int ks, int half) { return d0 * 512 + ks * 4096 + half * 2048; }
__device__ __forceinline__ int crow(int r, int hi) { return (r & 3) + 8 * (r >> 2) + 4 * hi; }
__device__ __forceinline__ bf16x8 load8(const bf16_t* p) { return *reinterpret_cast<const bf16x8*>(p); }

__device__ __forceinline__ void mask_tile(f32x16& p0, f32x16& p1, int dq) {
    const float NEG = -__builtin_inff();
#pragma unroll
    for (int r = 0; r < 16; ++r) { const int c = (r & 3) + 8 * (r >> 2); if (dq - c < 0) p0[r] = NEG; if (dq - c - 32 < 0) p1[r] = NEG; }
}
__device__ __forceinline__ void partialSM(f32x16& p0, f32x16& p1, float& m_reg, float& alpha, float l_reg) {
    float pmax = p0[0];
#pragma unroll
    for (int r = 1; r < 16; ++r) pmax = fmaxf(pmax, p0[r]);
#pragma unroll
    for (int r = 0; r < 16; ++r) pmax = fmaxf(pmax, p1[r]);
    { auto rr = __builtin_amdgcn_permlane32_swap(__float_as_uint(pmax), __float_as_uint(pmax), false, false); pmax = fmaxf(__uint_as_float(rr[0]), __uint_as_float(rr[1])); }
    const bool need = (pmax > THR) || (l_reg == 0.f && pmax > -__builtin_inff());
    if (__builtin_expect(__all(!need), 1)) { alpha = 1.f; }
    else { const float d = need ? pmax : 0.f; alpha = (l_reg == 0.f) ? 1.f : __builtin_amdgcn_exp2f(-d); m_reg += d;
#pragma unroll
        for (int r = 0; r < 16; ++r) p0[r] = p0[r] - d;
#pragma unroll
        for (int r = 0; r < 16; ++r) p1[r] = p1[r] - d; }
#pragma unroll
    for (int r = 0; r < 16; ++r) p0[r] = __builtin_amdgcn_exp2f(p0[r]);
}
__device__ __forceinline__ void finishSM(f32x16& p0, f32x16& p1, float alpha, float& l_reg, bf16x8& pa0, bf16x8& pa1, bf16x8& pa2, bf16x8& pa3) {
#pragma unroll
    for (int r = 0; r < 16; ++r) p1[r] = __builtin_amdgcn_exp2f(p1[r]);
    float ps = 0;
#pragma unroll
    for (int r = 0; r < 16; ++r) ps += p0[r];
#pragma unroll
    for (int r = 0; r < 16; ++r) ps += p1[r];
    { auto rr = __builtin_amdgcn_permlane32_swap(__float_as_uint(ps), __float_as_uint(ps), false, false); ps = __uint_as_float(rr[0]) + __uint_as_float(rr[1]); }
    l_reg = l_reg * alpha + ps;
#define PK4(P, B_, OUT) do { unsigned a0 = cvt_pk_bf16(P[B_+0], P[B_+1]), a1 = cvt_pk_bf16(P[B_+2], P[B_+3]);                          \
        unsigned b0 = cvt_pk_bf16(P[B_+4], P[B_+5]), b1 = cvt_pk_bf16(P[B_+6], P[B_+7]);                                             \
        auto r0 = __builtin_amdgcn_permlane32_swap(a0, b0, false, false); auto r1 = __builtin_amdgcn_permlane32_swap(a1, b1, false, false); \
        u32x4 w = {r0[0], r1[0], r0[1], r1[1]}; OUT = *reinterpret_cast<bf16x8*>(&w); } while (0)
    PK4(p0, 0, pa0); PK4(p0, 8, pa1); PK4(p1, 0, pa2); PK4(p1, 8, pa3);
#undef PK4
}
template <int KB>
__device__ __forceinline__ void qkt(f32x16& p0, f32x16& p1, const char* K_lds, int r32, int hi, const bf16x8* qr, float ab, float slope2) {
    const float s32 = 32.f * slope2;
#pragma unroll
    for (int r = 0; r < 16; ++r) { p0[r] = fmaf(slope2, (float)((r & 3) + 8 * (r >> 2)), ab); p1[r] = p0[r] + s32; }
#pragma unroll
    for (int d0 = 0; d0 < 4; ++d0) { const char* a = K_lds + KB * SHM_K + kswz(r32, d0 * 2 + hi);
        bf16x8 b0 = *reinterpret_cast<const bf16x8*>(a);
        bf16x8 b1 = *reinterpret_cast<const bf16x8*>(a + 32 * 128);
        p0 = __builtin_amdgcn_mfma_f32_32x32x16_bf16(b0, qr[d0], p0, 0, 0, 0);
        p1 = __builtin_amdgcn_mfma_f32_32x32x16_bf16(b1, qr[d0], p1, 0, 0, 0); }
}
template <int VB>
__device__ __forceinline__ void pv_tile(f32x16* o, int vb0, bf16x8 pa0, bf16x8 pa1, bf16x8 pa2, bf16x8 pa3) {
#define TRRD(dst, off) asm volatile("ds_read_b64_tr_b16 %0, %1 offset:%2" : "=&v"(dst) : "v"(vb0), "i"(off) : "memory")
#define PV_D0(d0) do { s16x4 l0, l1, l2, l3, h0, h1, h2, h3; constexpr int b_ = VB * SHM_V + v_rd_off(d0, 0, 0); \
        TRRD(l0, b_); TRRD(h0, b_ + 2048); TRRD(l1, b_ + 4096); TRRD(h1, b_ + 6144); TRRD(l2, b_ + 8192); TRRD(h2, b_ + 10240); TRRD(l3, b_ + 12288); TRRD(h3, b_ + 14336); \
        asm volatile("s_waitcnt lgkmcnt(0)" ::: "memory"); SBAR();   \
        o[d0] = __builtin_amdgcn_mfma_f32_32x32x16_bf16(pa0, (bf16x8){l0[0], l0[1], l0[2], l0[3], h0[0], h0[1], h0[2], h0[3]}, o[d0], 0, 0, 0);   \
        o[d0] = __builtin_amdgcn_mfma_f32_32x32x16_bf16(pa1, (bf16x8){l1[0], l1[1], l1[2], l1[3], h1[0], h1[1], h1[2], h1[3]}, o[d0], 0, 0, 0);   \
        o[d0] = __builtin_amdgcn_mfma_f32_32x32x16_bf16(pa2, (bf16x8){l2[0], l2[1], l2[2], l2[3], h2[0], h2[1], h2[2], h2[3]}, o[d0], 0, 0, 0);   \
        o[d0] = __builtin_amdgcn_mfma_f32_32x32x16_bf16(pa3, (bf16x8){l3[0], l3[1], l3[2], l3[3], h3[0], h3[1], h3[2], h3[3]}, o[d0], 0, 0, 0); } while (0)
    PV_D0(0); PV_D0(1); PV_D0(2); PV_D0(3);
#undef PV_D0
#undef TRRD
}

struct BlockRef { const bf16_t* Q; const bf16_t* K; const bf16_t* V; bf16_t* O; int P0; int mode; float slope2; float kmax; };
struct Seam { bf16x8 qr[4]; bf16x8 st_v0, st_v1, st_k0; };
__device__ __forceinline__ BlockRef mkref(const bf16_t* Z, bf16_t* AO, const float* kmt  , int b, int combo, int mp) { BlockRef r; const int h = combo >> 5, qb = combo & 31;
    const bf16_t* zb = Z + (size_t)b * SEQ * ZP; r.Q = zb + (size_t)(qb * 256) * ZP + ZQ + h * 128 + mp * 64; r.K = zb + ZK + h * 128 + mp * 64; r.V = zb + ZVAL + h * 128;
    r.O = AO + ((size_t)b * SEQ + qb * 256) * DM + 512 + h * 128; r.P0 = qb * 256; r.mode = mp; r.slope2 = exp2f(-2.0f * (float)(h + 1)) * LOG2E;
    r.kmax = kmt[h * 2 + mp]; return r; }
#define ROWV(p, k0, rr) ((p) + (size_t)((k0) + (rr)) * ZP + sc)
#define ROWK(p, k0) ((p) + (size_t)((k0) + skr) * ZP + skc * 8)
#define VMW() asm volatile("s_waitcnt vmcnt(0)" ::: "memory")
#define VMWN(n) asm volatile("s_waitcnt vmcnt(%0)" :: "i"(n) : "memory")
#define SLOAD_H(Kp, Vp, k0) do { S.st_v0 = load8(ROWV(Vp, k0, sr)); S.st_v1 = load8(ROWV(Vp, k0, 32 + sr)); S.st_k0 = load8(ROWK(Kp, k0)); } while (0)
#define SWRITE_HK(bf) do { *(bf16x8*)(K_lds + (bf) * SHM_K + kws) = S.st_k0; } while (0)
#define SWRITE_HV(bf) do { *(bf16x8*)(V_lds + (bf) * SHM_V + vst0) = S.st_v0; *(bf16x8*)(V_lds + (bf) * SHM_V + vst1) = S.st_v1; } while (0)
#define SWRITE_H(bf) do { SWRITE_HV(bf); SWRITE_HK(bf); } while (0)
__device__ __forceinline__ void prime(const BlockRef& cur, char* lds, Seam& S, int wid) {
    const int lane = lane_id(), tid = wid * 64 + lane, r32 = lane & 31, hi = lane >> 5;
    const int sr = tid >> 4, sc = (tid & 15) * 8, skr = tid >> 3, skc = tid & 7, kws = kswz(skr, skc); char* K_lds = lds + LDS_K;
#pragma unroll
    for (int d0 = 0; d0 < 4; ++d0) S.qr[d0] = load8(cur.Q + (size_t)(wid * QBLK + r32) * ZP + d0 * 16 + hi * 8);
    SLOAD_H(cur.K, cur.V, cur.P0 + QB - KVBLK); VMW(); SWRITE_HK(0);
    __syncthreads();
}
__device__ __forceinline__ void block(const BlockRef& cur, const BlockRef& nxt, char* lds, Seam& S, float lam, const float* __restrict__ subln, int wid) {
    const int lane = lane_id(), tid = wid * 64 + lane, r32 = lane & 31, hi = lane >> 5;
    const int NT0 = (cur.P0 + QB) / KVBLK;
    int NT = NT0;
    const int qlo = cur.P0 + wid * QBLK, qm = qlo + r32 - 4 * hi;
    const float slope2 = cur.slope2;
    char* V_lds = lds + LDS_V; char* K_lds = lds + LDS_K;
    float* ws = (float*)(lds + LDS_WS) + wid * 64; float* li_l = ws, * al_l = ws + 32;
    float m_reg = 0.f, l_reg = 0; f32x16 o[4] = {};
    const int sr = tid >> 4, sc = (tid & 15) * 8, vst0 = v_st(sr, sc), vst1 = v_st(32 + sr, sc), skr = tid >> 3, skc = tid & 7, kws = kswz(skr, skc);
    const int vb0 = (int)(uintptr_t)V_lds + v_rd_base(lane);
    const bf16_t* Kh = cur.K; const bf16_t* Vh = cur.V;
#define RESC(a) do { if (__any((a) < 1.f)) { if (hi == 0) al_l[r32] = (a); asm volatile("s_waitcnt lgkmcnt(0)" ::: "memory");              \
                     for (int d_ = 0; d_ < 4; ++d_) for (int r = 0; r < 16; ++r) o[d_][r] *= al_l[crow(r, hi)]; } } while (0)
#define KBASE(t) ((NT0 - 1 - (t)) * KVBLK)
#define AB(t) (slope2 * (float)(KBASE(t) - qm) - m_reg)
#define MASKT(P0_, P1_, t) do { const int kb_ = KBASE(t); if (kb_ + KVBLK - 1 > qlo) mask_tile(P0_, P1_, qm - kb_); } while (0)
    constexpr int NQL = 4;
#define SEAM_K0() do { VMWN(NQL); SWRITE_HK(0); SBAR(); } while (0)
    f32x16 pA0, pA1, pB0, pB1; float alA, alB; bf16x8 pa0, pa1, pa2, pa3;
    float cbase;
    { float q2 = 0.f;
#pragma unroll
      for (int d0 = 0; d0 < 4; ++d0)
#pragma unroll
          for (int j = 0; j < 8; ++j) { const float v = __uint_as_float(((unsigned)(unsigned short)S.qr[d0][j]) << 16); q2 = fmaf(v, v, q2); }
      { auto rr = __builtin_amdgcn_permlane32_swap(__float_as_uint(q2), __float_as_uint(q2), false, false); q2 = __uint_as_float(rr[0]) + __uint_as_float(rr[1]); }
      cbase = sqrtf(q2) * cur.kmax * 1.0001f - slope2 * (float)(qlo + r32); }
    SWRITE_HV(0); SBAR();
    if (NT > 1) { SLOAD_H(Kh, Vh, KBASE(1)); }
    SBAR(); qkt<0>(pA0, pA1, K_lds, r32, hi, S.qr, AB(0), slope2);
    MASKT(pA0, pA1, 0); partialSM(pA0, pA1, m_reg, alA, l_reg);
    if (NT > 1) { VMW(); SWRITE_H(1); }
    __syncthreads();
#define HALF_STEP(PX0, PX1, alX, PY0, PY1, alY, t, KB, VB, SB) do {                                                      \
        SBAR(); qkt<KB>(PX0, PX1, K_lds, r32, hi, S.qr, AB(t), slope2);                                                   \
        finishSM(PY0, PY1, alY, l_reg, pa0, pa1, pa2, pa3); SBAR();                                                       \
        if ((t) + 1 < NT) { SLOAD_H(Kh, Vh, KBASE((t) + 1)); SBAR(); }                                                    \
        pv_tile<VB>(o, vb0, pa0, pa1, pa2, pa3); MASKT(PX0, PX1, (t)); partialSM(PX0, PX1, m_reg, alX, l_reg);                   \
        __syncthreads();                                                                                                  \
        if ((t) + 1 < NT) { VMW(); SWRITE_H(SB); }                                                                        \
        RESC(alX); __syncthreads(); } while (0)
    for (int t = 1; t + 1 < NT; t += 2) {
        HALF_STEP(pB0, pB1, alB, pA0, pA1, alA, t, 1, 0, 0);
        HALF_STEP(pA0, pA1, alA, pB0, pB1, alB, t + 1, 0, 1, 1);
        if (t == 3 && NT0 > 6) {
            float c = cbase - m_reg;
#pragma unroll
            for (int o_ = 1; o_ < 64; o_ <<= 1) c = fmaxf(c, __shfl_xor(c, o_));
            float* cx = (float*)(lds + LDS_CX);
            if (lane == 0) cx[wid] = c;
            __syncthreads();
            float C = cx[0];
#pragma unroll
            for (int w_ = 1; w_ < NW; ++w_) C = fmaxf(C, cx[w_]);
            const float X = (-SKIP_MARGIN - C) / slope2 - 63.f;
            const float need_f = (float)(NT0 - 1) - X * (1.0f / 64.0f);
            if (need_f < (float)NT0) { int n = (int)ceilf(need_f); n = n < 6 ? 6 : n; n = (n + 1) & ~1; NT = n < NT0 ? n : NT0; }
        }
    }
    SBAR(); qkt<1>(pB0, pB1, K_lds, r32, hi, S.qr, AB(NT - 1), slope2); SBAR();
    SLOAD_H(nxt.K, nxt.V, nxt.P0 + QB - KVBLK); SBAR();
#pragma unroll
    for (int d0 = 0; d0 < 4; ++d0) S.qr[d0] = load8(nxt.Q + (size_t)(wid * QBLK + r32) * ZP + d0 * 16 + hi * 8);
    SBAR();
    finishSM(pA0, pA1, alA, l_reg, pa0, pa1, pa2, pa3); SBAR();
    pv_tile<0>(o, vb0, pa0, pa1, pa2, pa3);
    MASKT(pB0, pB1, NT - 1); partialSM(pB0, pB1, m_reg, alB, l_reg); __syncthreads(); RESC(alB);
    finishSM(pB0, pB1, alB, l_reg, pa0, pa1, pa2, pa3); SBAR(); pv_tile<1>(o, vb0, pa0, pa1, pa2, pa3);
    SBAR(); SEAM_K0();
    if (hi == 0) li_l[r32] = l_reg; asm volatile("s_waitcnt lgkmcnt(0)" ::: "memory");
    float rli[16];
#pragma unroll
    for (int r = 0; r < 16; ++r) rli[r] = __builtin_amdgcn_rcpf(li_l[crow(r, hi)]);
    unsigned* stash = (unsigned*)(lds + LDS_STASH) + wid * 2048 + lane;
    if (cur.mode == 0) {
#pragma unroll
        for (int r = 0; r < 16; ++r) { stash[(r * 2 + 0) * 64] = cvt_pk_bf16(o[0][r] * rli[r], o[1][r] * rli[r]); stash[(r * 2 + 1) * 64] = cvt_pk_bf16(o[2][r] * rli[r], o[3][r] * rli[r]); }
    } else {
        float ssq[16];
#pragma unroll
        for (int r = 0; r < 16; ++r) { const unsigned w0 = stash[(r * 2 + 0) * 64], w1 = stash[(r * 2 + 1) * 64];
            o[0][r] = bf_lo(w0) - lam * (o[0][r] * rli[r]); o[1][r] = bf_hi(w0) - lam * (o[1][r] * rli[r]);
            o[2][r] = bf_lo(w1) - lam * (o[2][r] * rli[r]); o[3][r] = bf_hi(w1) - lam * (o[3][r] * rli[r]);
            ssq[r] = (o[0][r] * o[0][r] + o[1][r] * o[1][r]) + (o[2][r] * o[2][r] + o[3][r] * o[3][r]); }
#pragma unroll
        for (int r = 0; r < 16; ++r) {
#pragma unroll
            for (int off = 1; off < 32; off <<= 1) ssq[r] += __shfl_xor(ssq[r], off);
            ssq[r] = __builtin_amdgcn_rsqf(ssq[r] * (1.0f / DV) + RMS_EPS); }
        float g4[4];
#pragma unroll
        for (int d0 = 0; d0 < 4; ++d0) g4[d0] = subln[d0 * 32 + r32] * 0.8f;
        bf16_t* Ow = cur.O + (size_t)(wid * QBLK) * DM;
#pragma unroll
        for (int r = 0; r < 16; ++r) { const int orow = crow(r, hi);
#pragma unroll
            for (int d0 = 0; d0 < 4; ++d0) { const float v = o[d0][r] * ssq[r] * g4[d0]; const float vn = __shfl_xor(v, 1);
                if ((r32 & 1) == 0) *(unsigned*)(Ow + (size_t)orow * DM + d0 * 32 + r32) = cvt_pk_bf16(v, vn); } }
    }
    __syncthreads();
#undef RESC
#undef KBASE
#undef AB
#undef MASKT
#undef SEAM_K0
#undef HALF_STEP
}
#undef ROWV
#undef ROWK
#undef VMW
#undef VMWN
#undef SLOAD_H
#undef SWRITE_HK
#undef SWRITE_HV
#undef SWRITE_H
#undef SBAR
}

struct AttnPlan { unsigned char list[32][24]; unsigned char cnt[32]; };
constexpr int attn_cost(int combo) { const int h = combo >> 5, qb = combo & 31; const int cap = h == 0 ? 7 : (h == 1 ? 15 : (h == 2 ? 46 : 128)); int st = 4 * (qb + 1); st = st < cap ? st : cap; return 2 * (15 * st + 200); }
constexpr AttnPlan make_attn_plan() {
    AttnPlan p{}; int load[32] = {}; bool used[128] = {};
    for (int i = 0; i < 128; ++i) { int best = -1; for (int j = 0; j < 128; ++j) if (!used[j] && (best < 0 || attn_cost(j) > attn_cost(best))) best = j;
        used[best] = true; int bin = 0; for (int b = 1; b < 32; ++b) if (load[b] < load[bin]) bin = b;
        if (p.cnt[bin] < 24) { p.list[bin][p.cnt[bin]] = (unsigned char)best; p.cnt[bin] = (unsigned char)(p.cnt[bin] + 1); } load[bin] += attn_cost(best); }
    return p;
}
__device__ const AttnPlan kAttnPlan = make_attn_plan();

#define XB_TMO      128
#define XB_XCNT(j)  (256  + 64 * (j))
#define XB_XSUB(j)  (1280 + 64 * (j))
#define XB_XGEN(j)  (2304 + 64 * (j))
#define XB_TOP      3328
#define XB_TOPGEN   3392
#define XCD_BAR_WORDS 3456
#define XB_SPIN_CAP (1u << 22)
__device__ __forceinline__ unsigned xb_ld(unsigned* p)              { return __hip_atomic_load(p, __ATOMIC_RELAXED, __HIP_MEMORY_SCOPE_AGENT); }
__device__ __forceinline__ unsigned xb_add(unsigned* p, unsigned v) { return __hip_atomic_fetch_add(p, v, __ATOMIC_RELAXED, __HIP_MEMORY_SCOPE_AGENT); }
__device__ __forceinline__ unsigned xb_xcc_id() { return (unsigned)__builtin_amdgcn_s_getreg((3 << 11) | 20) & 0xFu; }
#define XB_SPIN(cond, bar) do { unsigned _sp = 0; while (cond) { __builtin_amdgcn_s_sleep(1); \
    if ((++_sp & 255u) == 0u) { if (xb_ld(&(bar)[XB_TMO])) break; if (_sp > XB_SPIN_CAP) { atomicAdd(&(bar)[XB_TMO], 1u); break; } } } } while (0)
struct XcdBarrier { unsigned* bar; unsigned x; volatile LAS unsigned* st; };
__device__ __forceinline__ XcdBarrier xcd_barrier_post(unsigned* bar, volatile LAS unsigned* st, bool t0) {
    XcdBarrier b; b.bar = bar; b.x = xb_xcc_id(); b.st = st;
    if (t0) (void)xb_add(&bar[XB_XCNT(b.x)], 1u);
    return b;
}
__device__ __forceinline__ void xcd_barrier_complete(unsigned* bar, unsigned x, unsigned& nloc, unsigned& nx) {
    const unsigned G = gridDim.x;
    unsigned sum, cnt, mine, sp = 0u;
    for (;;) {
        sum = 0u; cnt = 0u; mine = 0u;
#pragma unroll
        for (unsigned j = 0; j < 16; ++j) { const unsigned c = xb_ld(&bar[XB_XCNT(j)]); sum += c; cnt += (c > 0u) ? 1u : 0u; mine = (j == x) ? c : mine; }
        if (sum == G) break;
        __builtin_amdgcn_s_sleep(1);
        if ((++sp & 255u) == 0u) { if (xb_ld(&bar[XB_TMO])) break; if (sp > XB_SPIN_CAP) { atomicAdd(&bar[XB_TMO], 1u); break; } }
    }
    nloc = mine > 0u ? mine : 1u; nx = cnt > 0u ? cnt : 1u;
}
__device__ __forceinline__ void xcd_barrier(const XcdBarrier& b, bool t0) {
    asm volatile("s_waitcnt vmcnt(0)" ::: "memory");
    __syncthreads();
    if (t0) {
        unsigned* bar = b.bar;
        __builtin_amdgcn_s_waitcnt(0);
        unsigned nloc = b.st[0], nx = b.st[1];
        if (nloc == 0u) { xcd_barrier_complete(bar, b.x, nloc, nx); b.st[0] = nloc; b.st[1] = nx; }
        const unsigned old = xb_add(&bar[XB_XSUB(b.x)], 1u);
        const unsigned gen = old / nloc;
        if (old + 1u == (gen + 1u) * nloc) {
            __builtin_amdgcn_fence(__ATOMIC_RELEASE, "agent");
            asm volatile("s_waitcnt vmcnt(0)" ::: "memory");
            const unsigned og = xb_add(&bar[XB_TOP], 1u);
            const unsigned tg = og / nx;
            if (og + 1u == (tg + 1u) * nx) xb_add(&bar[XB_TOPGEN], 1u);
            else XB_SPIN(xb_ld(&bar[XB_TOPGEN]) == tg, bar);
            __builtin_amdgcn_fence(__ATOMIC_ACQUIRE, "agent");
            xb_add(&bar[XB_XGEN(b.x)], 1u);
            asm volatile("s_waitcnt vmcnt(0)" ::: "memory");
        } else {
            XB_SPIN(xb_ld(&bar[XB_XGEN(b.x)]) == gen, bar);
            __builtin_amdgcn_fence(__ATOMIC_ACQUIRE, "agent");
            asm volatile("s_waitcnt vmcnt(0)" ::: "memory");
        }
    }
    __syncthreads();
}
constexpr int NWAVES = 8, NTHR = 512;
constexpr int LDS_BYTES = 163840;
struct Args {
    const float* in[28]; float* out; unsigned char* ws; int ph_lo, ph_hi;
};
constexpr int N_PHASES = 15;

struct Frame {
    LAS unsigned char* lds; int wave, vcu, G;
};

__device__ __forceinline__ void transpose_item(const float* W, int ldw, int k0, int n0, bf16_t* dst, int ldt, const float* kscale, LAS float* scr, int lane) {
    f32x4 v[8]; const int kr = lane >> 3, n4 = (lane & 7) * 4;
#pragma unroll
    for (int i = 0; i < 8; ++i) v[i] = __builtin_nontemporal_load((const f32x4*)(W + (size_t)(k0 + i * 8 + kr) * ldw + n0 + n4));
#pragma unroll
    for (int i = 0; i < 8; ++i) { const int kk = i * 8 + kr; f32x4 x = v[i]; if (kscale) x = x * kscale[k0 + kk];
        scr[kk * 33 + n4 + 0] = x[0]; scr[kk * 33 + n4 + 1] = x[1]; scr[kk * 33 + n4 + 2] = x[2]; scr[kk * 33 + n4 + 3] = x[3]; }
    asm volatile("s_waitcnt lgkmcnt(0)" ::: "memory");
    const int c = lane & 7;
#pragma unroll
    for (int j = 0; j < 4; ++j) { const int n = (lane >> 3) + 8 * j; const LAS float* s = scr + (8 * c) * 33 + n;
        u32x4 o; o.x = cvt_pk_bf16(s[0 * 33], s[1 * 33]); o.y = cvt_pk_bf16(s[2 * 33], s[3 * 33]); o.z = cvt_pk_bf16(s[4 * 33], s[5 * 33]); o.w = cvt_pk_bf16(s[6 * 33], s[7 * 33]);
        *(u32x4*)(dst + (size_t)n * ldt + k0 + 8 * c) = o; }
    asm volatile("s_waitcnt lgkmcnt(0)" ::: "memory");
}
__device__ __forceinline__ void transpose_item_fp8(const float* W, int ldw, int k0, int n0, unsigned char* dst, int ldt, float scale, const float* kscale, LAS float* scr, int lane) {
    f32x4 v[8]; const int kr = lane >> 3, n4 = (lane & 7) * 4;
#pragma unroll
    for (int i = 0; i < 8; ++i) v[i] = __builtin_nontemporal_load((const f32x4*)(W + (size_t)(k0 + i * 8 + kr) * ldw + n0 + n4));
#pragma unroll
    for (int i = 0; i < 8; ++i) { const int kk = i * 8 + kr; const f32x4 x = v[i] * (kscale ? scale * kscale[k0 + kk] : scale);
        scr[kk * 33 + n4 + 0] = x[0]; scr[kk * 33 + n4 + 1] = x[1]; scr[kk * 33 + n4 + 2] = x[2]; scr[kk * 33 + n4 + 3] = x[3]; }
    asm volatile("s_waitcnt lgkmcnt(0)" ::: "memory");
    const int n = lane >> 1, kh = (lane & 1) * 32; const LAS float* s = scr + kh * 33 + n;
    u32x4 o0, o1;
    o0.x = pk4_fp8(s[0 * 33], s[1 * 33], s[2 * 33], s[3 * 33]); o0.y = pk4_fp8(s[4 * 33], s[5 * 33], s[6 * 33], s[7 * 33]); o0.z = pk4_fp8(s[8 * 33], s[9 * 33], s[10 * 33], s[11 * 33]); o0.w = pk4_fp8(s[12 * 33], s[13 * 33], s[14 * 33], s[15 * 33]);
    o1.x = pk4_fp8(s[16 * 33], s[17 * 33], s[18 * 33], s[19 * 33]); o1.y = pk4_fp8(s[20 * 33], s[21 * 33], s[22 * 33], s[23 * 33]); o1.z = pk4_fp8(s[24 * 33], s[25 * 33], s[26 * 33], s[27 * 33]); o1.w = pk4_fp8(s[28 * 33], s[29 * 33], s[30 * 33], s[31 * 33]);
    __builtin_nontemporal_store(o0, (u32x4*)(dst + (size_t)n * ldt + k0 + kh)); __builtin_nontemporal_store(o1, (u32x4*)(dst + (size_t)n * ldt + k0 + kh + 16));
    asm volatile("s_waitcnt lgkmcnt(0)" ::: "memory");
}
__device__ __forceinline__ void rms_rows2_to_bf16(const float* xa, const float* xb, const float* g, bf16_t* oa, bf16_t* ob, int lane) {
    const f32x4* ra = (const f32x4*)xa + lane; const f32x4* rb = (const f32x4*)xb + lane; const f32x4* gr = (const f32x4*)g + lane;
    f32x4 va[4], vb[4]; float sa = 0.f, sb = 0.f;
#pragma unroll
    for (int j = 0; j < 4; ++j) { va[j] = __builtin_nontemporal_load(ra + 64 * j); vb[j] = __builtin_nontemporal_load(rb + 64 * j); }
#pragma unroll
    for (int j = 0; j < 4; ++j) { sa += (va[j].x * va[j].x + va[j].y * va[j].y) + (va[j].z * va[j].z + va[j].w * va[j].w); sb += (vb[j].x * vb[j].x + vb[j].y * vb[j].y) + (vb[j].z * vb[j].z + vb[j].w * vb[j].w); }
    const float rsa = __builtin_amdgcn_rsqf(wave_sum(sa) * (1.f / DM) + RMS_EPS), rsb = __builtin_amdgcn_rsqf(wave_sum(sb) * (1.f / DM) + RMS_EPS);
    u32x2* pa = (u32x2*)oa + lane; u32x2* pb = (u32x2*)ob + lane;
#pragma unroll
    for (int j = 0; j < 4; ++j) { const f32x4 gg = gr[64 * j]; u32x2 w;
        w.x = cvt_pk_bf16(va[j].x * rsa * gg.x, va[j].y * rsa * gg.y); w.y = cvt_pk_bf16(va[j].z * rsa * gg.z, va[j].w * rsa * gg.w); pa[64 * j] = w;
        w.x = cvt_pk_bf16(vb[j].x * rsb * gg.x, vb[j].y * rsb * gg.y); w.y = cvt_pk_bf16(vb[j].z * rsb * gg.z, vb[j].w * rsb * gg.w); pb[64 * j] = w; }
}

__global__ void __launch_bounds__(NTHR, 2) mega(Args args) {
    extern __shared__ __attribute__((aligned(16))) unsigned char lds_raw[];
    Frame F; F.lds = (LAS unsigned char*)lds_raw; F.wave = __builtin_amdgcn_readfirstlane(threadIdx.x >> 6);
    F.G = gridDim.x; { const int bx = blockIdx.x; F.vcu = (F.G % 8 == 0) ? (bx % 8) * (F.G / 8) + bx / 8 : bx; }
    unsigned char* ws = args.ws;
    unsigned* ctl = (unsigned*)(ws + WS_CTL);
    const float* x = args.in[0]; float* out = args.out;
    bf16_t* Win_t = (bf16_t*)(ws + WS_WIN); bf16_t* Wout_t = (bf16_t*)(ws + WS_WOUT); bf16_t* Wq_t = (bf16_t*)(ws + WS_WQ); bf16_t* Wkv_t = (bf16_t*)(ws + WS_WKV);
    bf16_t* Wo_t = (bf16_t*)(ws + WS_WO); bf16_t* Wr_t = (bf16_t*)(ws + WS_WR); bf16_t* Wsgu = (bf16_t*)(ws + WS_WSGU); bf16_t* memn = (bf16_t*)(ws + WS_MEMN);
    bf16_t* Km = (bf16_t*)(ws + WS_KM); bf16_t* Vt = (bf16_t*)(ws + WS_VT); bf16_t* Wgu_t = (bf16_t*)(ws + WS_WGU); bf16_t* Wd_t = (bf16_t*)(ws + WS_WD);
    bf16_t* Z = (bf16_t*)(ws + WS_RA); bf16_t* Qm = (bf16_t*)(ws + WS_RA); bf16_t* Sc = (bf16_t*)(ws + WS_RA + 128 * MiB); bf16_t* xg = (bf16_t*)(ws + WS_RA); bf16_t* yb = (bf16_t*)(ws + WS_RA);
    bf16_t* XN = (bf16_t*)(ws + WS_RB); bf16_t* AO = (bf16_t*)(ws + WS_RB); bf16_t* Om = (bf16_t*)(ws + WS_RB); bf16_t* act = (bf16_t*)(ws + WS_RB);
    bf16_t* x1b = (bf16_t*)(ws + WS_RC); bf16_t* x2b = (bf16_t*)(ws + WS_RC); unsigned char* x2f8 = ws + WS_X2F8;
    float* ssq1 = (float*)(ws + WS_SSQ1); float* ssq2 = (float*)(ws + WS_SSQ2); float* rstd2 = (float*)(ws + WS_SSQ1);     float* logit = (float*)(ws + WS_LOGIT);
    float* tok_w = (float*)(ws + WS_TOKW); int* tok_s = (int*)(ws + WS_TOKS); int* slot_tok = (int*)(ws + WS_SLOTTOK); float* slot_rs = (float*)(ws + WS_SLOTTOK + SLOT_RS_OFF);
    const int gw = F.vcu * NWAVES + F.wave, NGW = F.G * NWAVES;
    const int lo = args.ph_lo, hi = args.ph_hi;
#define IN(k) (lo <= (k) && (k) < hi)
#if MK_ONE_LAUNCH
    volatile LAS unsigned* misc = (volatile LAS unsigned*)(F.lds + LDS_MISC);
    if (threadIdx.x < 64) misc[threadIdx.x] = 0u;
    __syncthreads();
    XcdBarrier xbar = xcd_barrier_post(ctl + CW_BAR, misc + 8, threadIdx.x == 0);
    if (args.ph_hi > 4096) cg::this_grid().sync();
#define GRID_BAR(k) do { if (IN(k) && IN((k) + 1)) xcd_barrier(xbar, F.wave == 0 && lane_id() == 0); } while (0)
#else
#define GRID_BAR(k) do { } while (0)
#endif
#define LOCAL_SEAM() do { asm volatile("s_waitcnt vmcnt(0)" ::: "memory"); __syncthreads(); __builtin_amdgcn_fence(__ATOMIC_ACQUIRE, "agent"); asm volatile("s_waitcnt vmcnt(0)" ::: "memory"); __syncthreads(); } while (0)

    if (IN(0)) {
        const int lane_ = lane_id(), tid_ = F.wave * 64 + lane_; (void)tid_;
        LAS float* scr = (LAS float*)(F.lds + F.wave * 16384);
        constexpr int I_IN = 16 * 80, I_SQ = 16 * 32, I_KV = 16 * 64, I_G = 16 * 16, I_D = 8 * 32;
        constexpr int NITEMS = I_IN + 3 * I_SQ + I_KV + NEXP * (2 * I_G + I_D);
        for (int it = gw; it < NITEMS; it += NGW) {
            int r = it;
            if (r < I_IN) { const int kb = r / 80, nb = r % 80; transpose_item(args.in[3], ZP, kb * 64, nb * 32, Win_t + (size_t)(nb * 32) * DM, DM, nullptr, scr, lane_); continue; } r -= I_IN;
            if (r < I_SQ) { const int kb = r / 32, nb = r % 32; transpose_item(args.in[13], DM, kb * 64, nb * 32, Wout_t + (size_t)(nb * 32) * DM, DM, nullptr, scr, lane_); continue; } r -= I_SQ;
            if (r < I_SQ) { const int kb = r / 32, nb = r % 32; transpose_item_fp8(args.in[16], DM, kb * 64, nb * 32, (unsigned char*)Wq_t + (size_t)(nb * 32) * DM, DM, F8_WSCALE, args.in[14], scr, lane_); continue; } r -= I_SQ;
            if (r < I_KV) { const int kb = r / 64, nb = r % 64; transpose_item(args.in[17], 2 * DM, kb * 64, nb * 32, Wkv_t + (size_t)(nb * 32) * DM, DM, nullptr, scr, lane_); continue; } r -= I_KV;
            if (r < I_SQ) { const int kb = r / 32, nb = r % 32; transpose_item_fp8(args.in[18], DM, kb * 64, nb * 32, (unsigned char*)Wo_t + (size_t)(nb * 32) * DM, DM, F8_WSCALE, nullptr, scr, lane_); continue; } r -= I_SQ;
            const int e = r / (2 * I_G + I_D); r -= e * (2 * I_G + I_D);
            if (r < 2 * I_G) { const int up = r >= I_G; if (up) r -= I_G; const int kb = r / 16, nb = r % 16, n0 = nb * 32;
                const float* W = (up ? args.in[25] : args.in[24]) + (size_t)e * DM * DEXP;
                transpose_item_fp8(W, DEXP, kb * 64, n0, (unsigned char*)Wgu_t + ((size_t)e * 1024 + (n0 >> 7) * 256 + 64 * ((n0 & 127) >> 5) + 32 * up) * DM, DM, F8_WSCALE, args.in[19], scr, lane_); continue; }
            r -= 2 * I_G;
            { const int kb = r / 32, nb = r % 32; transpose_item_fp8(args.in[26] + (size_t)e * DEXP * DM, DM, kb * 64, nb * 32, (unsigned char*)Wd_t + ((size_t)e * 1024 + nb * 32) * DEXP, DEXP, F8_WSCALE, nullptr, scr, lane_); }
        }
        for (int i = blockIdx.x * NTHR + tid_; i < 256 * DM; i += F.G * NTHR) { const int n = i >> 10, k = i & 1023; float v = 0.f;
            if (n < 4) v = args.in[20][k * 4 + n] * args.in[19][k]; else if (n < 36) v = args.in[22][k * 32 + (n - 4)] * args.in[19][k];
            Wr_t[i] = (bf16_t)(cvt_pk_bf16(v, 0.f) & 0xffffu); }
        for (int i = blockIdx.x * NTHR + tid_; i < 4 * 128 * 128; i += F.G * NTHR) { const int t = (i >> 7) & 127, s = i & 127; const float v = s <= t ? args.in[6][i] : 0.f; Wsgu[i] = (bf16_t)(cvt_pk_bf16(v, 0.f) & 0xffffu); }
        for (int m = gw; m < M; m += 2 * NGW) rms_rows2_to_bf16(x + (size_t)m * DM, x + (size_t)(m + NGW) * DM, args.in[2], XN + (size_t)m * DM, XN + (size_t)(m + NGW) * DM, lane_);
        for (int m = gw; m < MROWS / 2; m += NGW) rms_rows2_to_bf16(args.in[1] + (size_t)m * DM, args.in[1] + (size_t)(m + MROWS / 2) * DM, args.in[15], memn + (size_t)m * DM, memn + (size_t)(m + MROWS / 2) * DM, lane_);
        __syncthreads();
    }
    GRID_BAR(0);

    if (IN(1)) {
        { pg8::Gemm g{DM, DM, DM}; pg8::PlainSched S; S.to.init(M / 256, ZP / 256, F.G, (int)blockIdx.x); S.A = (const char*)XN; S.B = (const char*)Win_t; S.tA = (size_t)256 * DM * 2; S.tB = (size_t)256 * DM * 2;
          pg8::EpiZ E{Z, ctl + CW_KMX}; pg8::gemm_phase(F.lds, F.wave, g, S, E); }
    }
    GRID_BAR(1);

    if (IN(2)) {
        const int lane_ = lane_id(), tid_ = F.wave * 64 + lane_; (void)tid_;
        float lam;
        { const float a = args.in[8][lane_] * args.in[9][lane_], b = args.in[10][lane_] * args.in[11][lane_];
          lam = __expf(wave_sum(a)) - __expf(wave_sum(b)) + 0.2f; }
        {
            LAS float* kmt = (LAS float*)(F.lds + da::LDS_CX + 64);
            const int b = (F.G == 256) ? (F.vcu >> 5) : 0, r = F.vcu & 31;
            if (tid_ < 8) { const unsigned* kp = ctl + CW_KMX + ((b * 4 + (tid_ >> 1)) * 2 + (tid_ & 1)) * 2; kmt[tid_] = 1.01f * sqrtf(__uint_as_float(ld_u32_agent(kp)) + __uint_as_float(ld_u32_agent(kp + 1))); }
            __syncthreads();
            const int nit = (F.G == 256) ? (int)kAttnPlan.cnt[r] : 0;
#define COMBO_OF(i) ((int)__builtin_amdgcn_readfirstlane((int)kAttnPlan.list[r][(i)]))
            if (nit > 0) {
                int ii = 0, pass = 0, combo = COMBO_OF(0); da::BlockRef cur = da::mkref(Z, AO, (const float*)kmt, b, combo, 0); da::Seam S;
                da::prime(cur, (char*)lds_raw, S, F.wave);
                for (;;) {
                    int ni = ii, np = pass + 1; if (np == 2) { np = 0; ni = ii + 1; }
                    const bool last = ni >= nit * PROBE_DUP_ATTN;
                    int ncombo = combo; if (!last && np == 0) ncombo = COMBO_OF(ni % nit);
                    const da::BlockRef nxt = last ? cur : da::mkref(Z, AO, (const float*)kmt, b, ncombo, np);
                    da::block(cur, nxt, (char*)lds_raw, S, lam, args.in[12], F.wave);
                    if (last) break;
                    cur = nxt; ii = ni; pass = np; combo = ncombo;
                }
            }
#undef COMBO_OF
        }
        __syncthreads();
        {
            int e = -1;
            if (F.G == 256) { const int b = F.vcu >> 5, r = F.vcu & 31; if (r >= 16 && r < 24) e = b * 8 + (r - 16); }
            for (int e2 = (F.G == 256 ? e : F.vcu); e2 >= 0 && e2 < 64; e2 = (F.G == 256 ? 64 : e2 + F.G)) {
                pg8::Gemm g{DM, DM, DM}; pg8::OneUnitSched S;
                if (e2 < 32) { S.u0.pm = e2 >> 2; S.u0.pn = e2 & 3; S.u0.aux = 0; S.u0.rows = nullptr; S.u0.A = (const char*)(memn + (size_t)S.u0.pm * 256 * DM); S.u0.B = (const char*)(Wkv_t + (size_t)S.u0.pn * 256 * DM);
                    pg8::EpiF8 E{(unsigned char*)Km, DM, nullptr, F8_KSCALE}; pg8::gemm_phase(F.lds, F.wave, g, S, E); }
                else { const int e3 = e2 - 32; S.u0.pm = e3 >> 3; S.u0.pn = e3 & 7; S.u0.aux = 0; S.u0.rows = nullptr; S.u0.A = (const char*)(Wkv_t + (size_t)(1024 + S.u0.pm * 256) * DM); S.u0.B = (const char*)(memn + (size_t)S.u0.pn * 256 * DM);
                    pg8::EpiF8 E{(unsigned char*)Vt, MROWS, nullptr, F8_VSCALE}; pg8::gemm_phase(F.lds, F.wave, g, S, E); }
            }
        }
        __syncthreads();
        {
            const int lane = lane_, w = F.wave;
            const int nun = (M / 128) * 4;
            const int ch0 = (lane & 15) * 8, t = 16 * w + (lane & 15), nks = (w + 2) >> 1;
            u32x4 vr[4];
            LAS int* sq = (LAS int*)(F.lds + 2 * 34816);
            const bool puller = (w == 0 && lane == 0);
            if (puller) { sq[0] = (int)atomicAdd(ctl + CW_SGUQ, 1u); sq[1] = (int)atomicAdd(ctl + CW_SGUQ, 1u); }
            __syncthreads();
            int uidx = __builtin_amdgcn_readfirstlane(sq[0]), unext = __builtin_amdgcn_readfirstlane(sq[1]), kk = 0;
            if (uidx < nun) { const size_t R0 = (size_t)(uidx >> 2) * 128; const int g = uidx & 3;
#pragma unroll
                for (int ps = 0; ps < 4; ++ps) vr[ps] = *(const u32x4*)(Z + (R0 + 16 * w + 4 * ps + (lane >> 4)) * ZP + ZV + g * 128 + ch0); }
            int gcur = -1; float lg[8], lb[8]; bf16x8 wf[4]; float bias = 0.f; int buf = 0;
#pragma unroll
            for (int j = 0; j < 8; ++j) { lg[j] = 0.f; lb[j] = 0.f; }
#pragma unroll
            for (int ks = 0; ks < 4; ++ks) wf[ks] = (bf16x8){0, 0, 0, 0, 0, 0, 0, 0};
            for (; uidx < nun; uidx = unext, unext = __builtin_amdgcn_readfirstlane(sq[(kk + 1) & 3]), buf ^= 1) {
                int pulled_ = 0; if (puller) pulled_ = (int)atomicAdd(ctl + CW_SGUQ, 1u);
                const int c = uidx >> 2, g = uidx & 3; const size_t R0 = (size_t)c * 128;
                LAS bf16_t* vnT = (LAS bf16_t*)(F.lds + buf * 34816);
                if (g != gcur) { gcur = g;
#pragma unroll
                    for (int j = 0; j < 8; ++j) { lg[j] = args.in[4][g * 128 + ch0 + j]; lb[j] = args.in[5][g * 128 + ch0 + j]; }
#pragma unroll
                    for (int ks = 0; ks < 4; ++ks) if (ks < nks) wf[ks] = *(const bf16x8*)(Wsgu + ((size_t)g * 128 + t) * 128 + ks * 32 + 8 * (lane >> 4));
                    bias = args.in[7][g * 128 + t]; }
#pragma unroll
                for (int ps = 0; ps < 4; ++ps) { const int sr = 16 * w + 4 * ps + (lane >> 4); const u32x4 raw = vr[ps];
                    float v[8] = {bf_lo(raw.x), bf_hi(raw.x), bf_lo(raw.y), bf_hi(raw.y), bf_lo(raw.z), bf_hi(raw.z), bf_lo(raw.w), bf_hi(raw.w)};
                    float sm = 0.f;
#pragma unroll
                    for (int j = 0; j < 8; ++j) sm += v[j];
#pragma unroll
                    for (int o = 1; o < 16; o <<= 1) sm += __shfl_xor(sm, o);
                    const float mu = sm * (1.f / 128.f); float q = 0.f;
#pragma unroll
                    for (int j = 0; j < 8; ++j) { v[j] -= mu; q += v[j] * v[j]; }
#pragma unroll
                    for (int o = 1; o < 16; o <<= 1) q += __shfl_xor(q, o);
                    const float rstd = __builtin_amdgcn_rsqf(q * (1.f / 128.f) + LN_EPS);
#pragma unroll
                    for (int j = 0; j < 8; ++j) { const float y = v[j] * rstd * lg[j] + lb[j]; vnT[(ch0 + j) * 136 + sr] = (bf16_t)(cvt_pk_bf16(y, 0.f) & 0xffffu); } }
                u32x2 ur[8];
#pragma unroll
                for (int mi = 0; mi < 8; ++mi) ur[mi] = *(const u32x2*)(Z + (R0 + t) * ZP + ZU + g * 128 + 16 * mi + 4 * (lane >> 4));
                { const int un = unext; if (un < nun) { const size_t Rn = (size_t)(un >> 2) * 128; const int gn = un & 3;
#pragma unroll
                    for (int ps = 0; ps < 4; ++ps) vr[ps] = *(const u32x4*)(Z + (Rn + 16 * w + 4 * ps + (lane >> 4)) * ZP + ZV + gn * 128 + ch0); } }
                if (puller) sq[(kk + 2) & 3] = pulled_;
                ++kk;
                __syncthreads();
                f32x4 acc[8];
#pragma unroll
                for (int mi = 0; mi < 8; ++mi) acc[mi] = (f32x4){0.f, 0.f, 0.f, 0.f};
#pragma unroll
                for (int ks = 0; ks < 4; ++ks) if (ks < nks) {
#pragma unroll
                    for (int mi = 0; mi < 8; ++mi) { const bf16x8 afr = *(const LAS bf16x8*)(vnT + (16 * mi + (lane & 15)) * 136 + ks * 32 + 8 * (lane >> 4));
                        acc[mi] = __builtin_amdgcn_mfma_f32_16x16x32_bf16(afr, wf[ks], acc[mi], 0, 0, 0); } }
#pragma unroll
                for (int mi = 0; mi < 8; ++mi) { const int ch = 16 * mi + 4 * (lane >> 4); const u32x2 u2 = ur[mi];
                    const float o0 = bf_lo(u2.x) * (acc[mi][0] + bias), o1 = bf_hi(u2.x) * (acc[mi][1] + bias), o2 = bf_lo(u2.y) * (acc[mi][2] + bias), o3 = bf_hi(u2.y) * (acc[mi][3] + bias);
                    u32x2 wv; wv.x = cvt_pk_bf16(o0, o1); wv.y = cvt_pk_bf16(o2, o3);
                    *(u32x2*)(AO + (R0 + t) * DM + g * 128 + ch) = wv; }
            }
            __syncthreads();
        }
    }
    GRID_BAR(2);

    if (IN(3)) {
        pg8::Gemm g{DM, DM, DM}; pg8::PlainSched S; S.to.init(M / 256, 4, F.G, (int)blockIdx.x); S.A = (const char*)AO; S.B = (const char*)Wout_t; S.tA = (size_t)256 * DM * 2; S.tB = (size_t)256 * DM * 2;
        pg8::EpiResid<false> E{x, x1b, ssq1, (LAS float*)(F.lds + 131072 + 1024), x2f8, 1.f}; pg8::gemm_phase(F.lds, F.wave, g, S, E);
    }
    GRID_BAR(3);

    if (IN(4)) {
        pg8::Gemm g{DM / 2, DM / 2, DM / 2}; pg8::PlainSched S; S.to.init(M / 256, 4, F.G, (int)blockIdx.x); S.A = (const char*)x2f8; S.B = (const char*)Wq_t; S.tA = (size_t)256 * DM; S.tB = (size_t)256 * DM;
        pg8::EpiF8 E{(unsigned char*)Qm, DM, ssq1, F8_QSCALE * C2_MEM / (F8_XSCALE * F8_WSCALE)}; pg8::gemm_phase<pg8::EpiF8, pg8::PlainSched, false, true>(F.lds, F.wave, g, S, E);
    }
    if (MK_ONE_LAUNCH && IN(4) && IN(5)) LOCAL_SEAM();

    if (IN(5)) {
        pg8::Gemm g{DM / 2, DM / 2, 128}; pg8::MemAttnSched S; S.to.init(M / 256, 4, F.G, (int)blockIdx.x); S.A = (const char*)Qm; S.B = (const char*)Km; S.tA = (size_t)256 * DM; S.hA = 256; S.bB = (size_t)256 * DM; S.hB = 256;
        pg8::EpiSoftmax E{(unsigned char*)Sc, (LAS float*)(F.lds + LDS_MISC + 1024), 1.0f / (F8_QSCALE * F8_KSCALE)}; pg8::gemm_phase<pg8::EpiSoftmax, pg8::MemAttnSched, false, true>(F.lds, F.wave, g, S, E);
    }
    if (MK_ONE_LAUNCH && IN(5) && IN(6 + 1)) LOCAL_SEAM();

    if (IN(7)) {
        pg8::Gemm g{DM / 2, MROWS / 2, 128}; pg8::MemAttnSched S; S.to.init(M / 256, 4, F.G, (int)blockIdx.x); S.A = (const char*)Sc; S.B = (const char*)Vt; S.tA = (size_t)256 * DM; S.hA = 256; S.bB = 256; S.hB = (size_t)256 * MROWS;
        pg8::EpiF8 E{(unsigned char*)Om, DM, nullptr, F8_OSCALE / (F8_PSCALE * F8_VSCALE)}; pg8::gemm_phase<pg8::EpiF8, pg8::MemAttnSched, false, true>(F.lds, F.wave, g, S, E);
    }
    GRID_BAR(7);

    if (IN(8)) {
        pg8::Gemm g{DM / 2, DM / 2, DM / 2}; pg8::PlainSched S; S.to.init(M / 256, 4, F.G, (int)blockIdx.x); S.A = (const char*)Om; S.B = (const char*)Wo_t; S.tA = (size_t)256 * DM; S.tB = (size_t)256 * DM;
        pg8::EpiResid<true> E{x1b, x2b, ssq2, (LAS float*)(F.lds + 131072 + 1024), x2f8, 1.0f / (F8_OSCALE * F8_WSCALE)}; pg8::gemm_phase<pg8::EpiResid<true>, pg8::PlainSched, false, true>(F.lds, F.wave, g, S, E);
    }
    GRID_BAR(8);

    if (IN(9)) {
        pg8::Gemm g{DM, DM, DM}; pg8::PlainSched S; S.to.init(M / 256, 1, F.G, (int)blockIdx.x); S.A = (const char*)x2b; S.B = (const char*)Wr_t; S.tA = (size_t)256 * DM * 2; S.tB = 0;
        pg8::EpiRouter E{logit, ssq2, args.in[21], args.in[23], rstd2}; pg8::gemm_phase(F.lds, F.wave, g, S, E);
    }
    if (MK_ONE_LAUNCH && IN(9) && IN(10)) LOCAL_SEAM();

    if (IN(10)) {
        const int lane_ = lane_id(), tid_ = F.wave * 64 + lane_; (void)tid_;
        LAS unsigned* lcnt = (LAS unsigned*)F.lds; LAS unsigned* lbase = lcnt + 32;
        pg8::TileOrder to10; to10.init(M / 256, 1, F.G, (int)blockIdx.x);
        int pm10 = 0, pn10 = 0;
        for (int i10 = 0; to10.get(i10, pm10, pn10); ++i10) {
            if (tid_ < 32) lcnt[tid_] = 0u;
            __syncthreads();
            const int tok = pm10 * 256 + (tid_ & 255); const bool act_ = tid_ < 256;
            const f32x4 lg = *(const f32x4*)(logit + (size_t)tok * 64);
            int gi = 0; float gm = lg[0];
#pragma unroll
            for (int j = 1; j < 4; ++j) if (lg[j] > gm) { gm = lg[j]; gi = j; }
            float gs = 0.f;
#pragma unroll
            for (int j = 0; j < 4; ++j) gs += __expf(lg[j] - gm);
            const float gate = 1.0f / gs;
            const f32x4 ea = *(const f32x4*)(logit + (size_t)tok * 64 + 4 + gi * 8), eb = *(const f32x4*)(logit + (size_t)tok * 64 + 8 + gi * 8);
            const float el[8] = {ea[0], ea[1], ea[2], ea[3], eb[0], eb[1], eb[2], eb[3]};
            int i0 = 0; float m0 = el[0];
#pragma unroll
            for (int j = 1; j < 8; ++j) if (el[j] > m0) { m0 = el[j]; i0 = j; }
            int i1 = -1; float m1 = -__builtin_inff();
#pragma unroll
            for (int j = 0; j < 8; ++j) if (j != i0 && el[j] > m1) { m1 = el[j]; i1 = j; }
            if (i1 < 0) i1 = (i0 == 0) ? 1 : 0;
            const float r = __expf(m1 - m0);
            const float w0 = gate / (1.0f + r), w1 = gate * r / (1.0f + r);
            const int e0 = gi * 8 + i0, e1 = gi * 8 + i1;
            unsigned r0 = 0u, r1 = 0u; if (act_) { r0 = atomicAdd((unsigned*)&lcnt[e0], 1u); r1 = atomicAdd((unsigned*)&lcnt[e1], 1u); }
            __syncthreads();
            if (tid_ < 32) lbase[tid_] = atomicAdd(ctl + CW_CNT + tid_, lcnt[tid_]);
            __syncthreads();
            if (act_) { const unsigned s0 = lbase[e0] + r0, s1 = lbase[e1] + r1; const float rsx = rstd2[tok] * (1.0f / (F8_XSCALE * F8_WSCALE));
                tok_w[tok * 2] = w0; tok_w[tok * 2 + 1] = w1; tok_s[tok * 2] = (int)(((unsigned)e0 << 16) | s0); tok_s[tok * 2 + 1] = (int)(((unsigned)e1 << 16) | s1);
                slot_tok[(size_t)e0 * 65536 + s0] = tok; slot_tok[(size_t)e1 * 65536 + s1] = tok; slot_rs[(size_t)e0 * 65536 + s0] = rsx; slot_rs[(size_t)e1 * 65536 + s1] = rsx; }
            __syncthreads();
        }
    }
    GRID_BAR(10);

    LAS unsigned* lps = (LAS unsigned*)(F.lds + LDS_MOE);
    if (IN(12) || IN(13) || IN(14)) {
        const int lane_ = lane_id(), tid_ = F.wave * 64 + lane_;
        if (F.wave == 0) {
            const unsigned c = lane_ < 32 ? ld_u32_agent(ctl + CW_CNT + lane_) : 0u; unsigned sc = (c + 255u) & ~255u;
#pragma unroll
            for (int d = 1; d < 32; d <<= 1) { const unsigned t = (unsigned)__shfl_up((int)sc, d); if (lane_ >= d) sc += t; }
            if (lane_ < 32) lps[lane_ + 1] = sc;
            if (lane_ == 0) lps[0] = 0u;
        }
        __syncthreads();
        for (int b = tid_; b < MAXBLK_MOE; b += NTHR) { int e = 0;
#pragma unroll 1
            for (int j = 1; j < 32; ++j) e += ((lps[j] >> 8) <= (unsigned)b) ? 1 : 0;
            lps[64 + b] = (unsigned)e; }
        __syncthreads();
    }

    if (IN(12)) {
        pg8::Gemm g{DM / 2, DM / 2, DM / 2}; pg8::MoeSched S{F.G, F.vcu, lps, (const char*)x2f8, (const char*)Wgu_t, (size_t)0, (size_t)1024 * DM, (size_t)256 * DM, slot_tok};
        pg8::EpiGateUp E{(unsigned char*)act}; pg8::gemm_phase<pg8::EpiGateUp, pg8::MoeSched, true, true>(F.lds, F.wave, g, S, E);
    }
    GRID_BAR(12);

    if (IN(13)) {
        pg8::Gemm g{DEXP / 2, DEXP / 2, DEXP / 2}; pg8::MoeSched S{F.G, F.vcu, lps, (const char*)act, (const char*)Wd_t, (size_t)256 * DEXP, (size_t)1024 * DEXP, (size_t)256 * DEXP, slot_tok};
        pg8::EpiF8 E{(unsigned char*)yb, DM, nullptr, F8_YSCALE / (F8_WSCALE * F8_ASCALE)}; pg8::gemm_phase<pg8::EpiF8, pg8::MoeSched, false, true>(F.lds, F.wave, g, S, E);
    }
    GRID_BAR(13);

    if (IN(14)) {
        const int lane_ = lane_id(), tid_ = F.wave * 64 + lane_; (void)tid_;
        const f32x4* gr = (const f32x4*)args.in[27] + lane_;
        f32x4 gg[4];
#pragma unroll
        for (int j = 0; j < 4; ++j) gg[j] = gr[64 * j];
        for (int m = gw; m < M; m += 2 * NGW) {
            const int ma = m, mb = m + NGW;
            const unsigned sa0 = (unsigned)tok_s[ma * 2], sa1 = (unsigned)tok_s[ma * 2 + 1], sb0 = (unsigned)tok_s[mb * 2], sb1 = (unsigned)tok_s[mb * 2 + 1];
            const int pa0 = (int)(lps[sa0 >> 16] + (sa0 & 65535u)), pa1 = (int)(lps[sa1 >> 16] + (sa1 & 65535u)), pb0 = (int)(lps[sb0 >> 16] + (sb0 & 65535u)), pb1 = (int)(lps[sb1 >> 16] + (sb1 & 65535u));
            const float wa0 = tok_w[ma * 2], wa1 = tok_w[ma * 2 + 1], wb0 = tok_w[mb * 2], wb1 = tok_w[mb * 2 + 1];
            const u32x2* xa = (const u32x2*)(x2b + (size_t)ma * DM) + lane_; const u32x2* xb = (const u32x2*)(x2b + (size_t)mb * DM) + lane_;
            const unsigned* ya0 = (const unsigned*)((const unsigned char*)yb + (size_t)pa0 * DM) + lane_; const unsigned* ya1 = (const unsigned*)((const unsigned char*)yb + (size_t)pa1 * DM) + lane_;
            const unsigned* yb0 = (const unsigned*)((const unsigned char*)yb + (size_t)pb0 * DM) + lane_; const unsigned* yb1 = (const unsigned*)((const unsigned char*)yb + (size_t)pb1 * DM) + lane_;
            u32x2 ca[4], cb[4]; unsigned a0[4], a1[4], b0[4], b1[4];
#pragma unroll
            for (int j = 0; j < 4; ++j) { ca[j] = xa[64 * j]; cb[j] = xb[64 * j]; a0[j] = ya0[64 * j]; a1[j] = ya1[64 * j]; b0[j] = yb0[64 * j]; b1[j] = yb1[64 * j]; }
            f32x4 va[4], vb[4]; float sa = 0.f, sb = 0.f;
            const float ka0 = wa0 * (1.0f / F8_YSCALE), ka1 = wa1 * (1.0f / F8_YSCALE), kb0 = wb0 * (1.0f / F8_YSCALE), kb1 = wb1 * (1.0f / F8_YSCALE);
#pragma unroll
            for (int j = 0; j < 4; ++j) {
                const f32x2 p0 = __builtin_amdgcn_cvt_pk_f32_fp8(a0[j], false), p1 = __builtin_amdgcn_cvt_pk_f32_fp8(a0[j], true), q0 = __builtin_amdgcn_cvt_pk_f32_fp8(a1[j], false), q1 = __builtin_amdgcn_cvt_pk_f32_fp8(a1[j], true);
                const f32x2 r0 = __builtin_amdgcn_cvt_pk_f32_fp8(b0[j], false), r1 = __builtin_amdgcn_cvt_pk_f32_fp8(b0[j], true), t0 = __builtin_amdgcn_cvt_pk_f32_fp8(b1[j], false), t1 = __builtin_amdgcn_cvt_pk_f32_fp8(b1[j], true);
                va[j].x = bf_lo(ca[j].x) + ka0 * p0.x + ka1 * q0.x; va[j].y = bf_hi(ca[j].x) + ka0 * p0.y + ka1 * q0.y; va[j].z = bf_lo(ca[j].y) + ka0 * p1.x + ka1 * q1.x; va[j].w = bf_hi(ca[j].y) + ka0 * p1.y + ka1 * q1.y;
                vb[j].x = bf_lo(cb[j].x) + kb0 * r0.x + kb1 * t0.x; vb[j].y = bf_hi(cb[j].x) + kb0 * r0.y + kb1 * t0.y; vb[j].z = bf_lo(cb[j].y) + kb0 * r1.x + kb1 * t1.x; vb[j].w = bf_hi(cb[j].y) + kb0 * r1.y + kb1 * t1.y;
                sa += (va[j].x * va[j].x + va[j].y * va[j].y) + (va[j].z * va[j].z + va[j].w * va[j].w); sb += (vb[j].x * vb[j].x + vb[j].y * vb[j].y) + (vb[j].z * vb[j].z + vb[j].w * vb[j].w); }
            const float ra = __builtin_amdgcn_rsqf(wave_sum(sa) * (1.f / DM) + RMS_EPS), rb = __builtin_amdgcn_rsqf(wave_sum(sb) * (1.f / DM) + RMS_EPS);
            f32x4* oa = (f32x4*)(out + (size_t)ma * DM) + lane_; f32x4* ob = (f32x4*)(out + (size_t)mb * DM) + lane_;
#pragma unroll
            for (int j = 0; j < 4; ++j) { oa[64 * j] = va[j] * ra * gg[j]; ob[64 * j] = vb[j] * rb * gg[j]; }
        }
    }
#undef IN
#undef GRID_BAR
}

extern "C" void kernel_launch(void* const* d_in, const int* in_sizes, int n_in, void* d_out, int out_size, void* d_ws, size_t ws_size, hipStream_t stream) {
    static int grid = 0;
    if (grid == 0) {
        if (n_in != 28 || in_sizes[0] != M * DM || out_size != M * DM || ws_size < WS_END) { fprintf(stderr, "kernel_launch: unexpected shapes (n_in %d in0 %d out %d ws %zu)\n", n_in, n_in > 0 ? in_sizes[0] : -1, out_size, ws_size); grid = -1; return; }
        int dev = 0, cus = 0, per_cu = 0;
        if (hipGetDevice(&dev) != hipSuccess || hipDeviceGetAttribute(&cus, hipDeviceAttributeMultiprocessorCount, dev) != hipSuccess) { grid = -1; return; }
        if (hipFuncSetAttribute((const void*)mega, hipFuncAttributeMaxDynamicSharedMemorySize, LDS_BYTES) != hipSuccess) { fprintf(stderr, "kernel_launch: hipFuncSetAttribute failed\n"); grid = -1; return; }
        if (hipOccupancyMaxActiveBlocksPerMultiprocessor(&per_cu, (const void*)mega, NTHR, LDS_BYTES) != hipSuccess || per_cu < 1) { fprintf(stderr, "kernel_launch: occupancy query says %d\n", per_cu); per_cu = 1; }
        (void)hipGetLastError();
        grid = cus;
    }
    if (grid < 0) return;
    (void)hipMemsetAsync((char*)d_ws + WS_CTL, 0, CTL_BYTES, stream);
    Args a{};
    for (int i = 0; i < 28; ++i) a.in[i] = (const float*)d_in[i];
    a.out = (float*)d_out; a.ws = (unsigned char*)d_ws;
#if MK_ONE_LAUNCH
    a.ph_lo = 0; a.ph_hi = N_PHASES;
    void* kargs[] = {&a};
    hipError_t e = hipLaunchCooperativeKernel((const void*)mega, dim3(grid), dim3(NTHR), kargs, LDS_BYTES, stream);
    if (e != hipSuccess) fprintf(stderr, "cooperative launch failed: %s (grid %d)\n", hipGetErrorString(e), grid);
#else
    for (int p = 0; p < N_PHASES; ++p) { a.ph_lo = p; a.ph_hi = p + 1; hipLaunchKernelGGL(mega, dim3(grid), dim3(NTHR), LDS_BYTES, stream, a); }
#endif
}
```

```cpp
#include <hip/hip_runtime.h>
#include <hip/hip_cooperative_groups.h>
#include <cstdio>
#include <cstdint>
namespace cg = cooperative_groups;

#ifndef PROBE_DUP
#define PROBE_DUP -1
#endif
#ifndef PROBE_DUP_ATTN
#define PROBE_DUP_ATTN 1
#endif
#ifndef MK_ONE_LAUNCH
#define MK_ONE_LAUNCH 1
#endif

#define LAS __attribute__((address_space(3)))
#define GAS __attribute__((address_space(1)))
typedef unsigned short bf16_t;
typedef short bf16x8 __attribute__((ext_vector_type(8)));
typedef short s16x4 __attribute__((ext_vector_type(4)));
typedef float f32x2 __attribute__((ext_vector_type(2)));
typedef float f32x4 __attribute__((ext_vector_type(4)));
typedef float f32x16 __attribute__((ext_vector_type(16)));
typedef unsigned u32x2 __attribute__((ext_vector_type(2)));
typedef unsigned u32x4 __attribute__((ext_vector_type(4)));
typedef int v8i32 __attribute__((ext_vector_type(8)));

constexpr int NB = 8, SEQ = 8192, DM = 1024, M = NB * SEQ;
constexpr int ZP = 2560;
constexpr int ZU = 0, ZV = 512, ZQ = 1024, ZK = 1536, ZVAL = 2048;
constexpr int MEML = 256, MROWS = NB * MEML;
constexpr int NEXP = 32, DEXP = 512;
constexpr int PROWS = 2 * M + NEXP * 256;
constexpr int MAXBLK = PROWS / 256;
constexpr float RMS_EPS = 1e-6f, LN_EPS = 1e-5f;
constexpr float LOG2E = 1.4426950408889634f;
constexpr float C2_DIFF = 0.125f * LOG2E;
constexpr float C2_MEM = 0.0625f * LOG2E;

constexpr size_t MiB = 1u << 20;
constexpr size_t WS_CTL = 0, CTL_BYTES = 1 * MiB;
constexpr size_t WS_WIN = 1 * MiB;
constexpr size_t WS_WOUT = 6 * MiB;
constexpr size_t WS_WQ = 8 * MiB;
constexpr size_t WS_WKV = 10 * MiB;
constexpr size_t WS_WO = 14 * MiB;
constexpr size_t WS_WR = 16 * MiB;
constexpr size_t WS_WSGU = 17 * MiB;
constexpr size_t WS_MEMN = 18 * MiB;
constexpr size_t WS_KM = 22 * MiB;
constexpr size_t WS_VT = 26 * MiB;
constexpr size_t WS_WGU = 30 * MiB;
constexpr size_t WS_WD = 94 * MiB;
constexpr size_t WS_RA = 128 * MiB;
constexpr size_t WS_RB = 448 * MiB;
constexpr size_t WS_RC = 592 * MiB;
constexpr size_t WS_SSQ1 = 720 * MiB;
constexpr size_t WS_SSQ2 = 724 * MiB;
constexpr size_t WS_LOGIT = 728 * MiB;
constexpr size_t WS_TOKE = 744 * MiB;
constexpr size_t WS_TOKW = 745 * MiB;
constexpr size_t WS_TOKS = 746 * MiB;
constexpr size_t WS_ROWTOK = 747 * MiB;
constexpr size_t WS_X2F8 = 752 * MiB;
constexpr size_t WS_SLOTTOK = 816 * MiB;
constexpr size_t SLOT_RS_OFF = 8 * MiB;
constexpr size_t WS_END = 832 * MiB;
constexpr int CW_CNT = 64;
constexpr int CW_NBLK = 128;
constexpr int CW_PSTART = 192;
constexpr int CW_BLKE = 256;
constexpr int CW_KMX = 1024;
constexpr int CW_SGUQ = 1344;
constexpr int CW_ALIST = 8192;
constexpr int CW_BAR = 4096;
constexpr int LDS_MISC = 131072;
constexpr int LDS_MOE = 158720;
constexpr int MAXBLK_MOE = 544;
constexpr int LDS_TBUF = 140288, TBUF_W = 2304;

__device__ __forceinline__ unsigned cvt_pk_bf16(float lo, float hi) { unsigned r; asm volatile("v_cvt_pk_bf16_f32 %0, %1, %2" : "=v"(r) : "v"(lo), "v"(hi)); return r; }
__device__ __forceinline__ float bf_lo(unsigned w) { return __uint_as_float(w << 16); }
__device__ __forceinline__ float bf_hi(unsigned w) { return __uint_as_float(w & 0xffff0000u); }
constexpr float F8_WSCALE = 256.f, F8_ASCALE = 8.f, F8_XSCALE = 4.f, F8_OSCALE = 16.f, F8_YSCALE = 16.f, F8_QSCALE = 64.f, F8_KSCALE = 16.f, F8_PSCALE = 256.f, F8_VSCALE = 16.f;
__device__ __forceinline__ unsigned pk4_fp8(float a, float b, float c, float d) {
    a = fminf(fmaxf(a, -448.f), 448.f); b = fminf(fmaxf(b, -448.f), 448.f); c = fminf(fmaxf(c, -448.f), 448.f); d = fminf(fmaxf(d, -448.f), 448.f);
    int w = 0; w = __builtin_amdgcn_cvt_pk_fp8_f32(a, b, w, false); w = __builtin_amdgcn_cvt_pk_fp8_f32(c, d, w, true); return (unsigned)w; }
__device__ __forceinline__ float wave_sum(float v) {
#pragma unroll
    for (int o = 1; o < 64; o <<= 1) v += __shfl_xor(v, o);
    return v;
}
__device__ __forceinline__ float wave_max(float v) {
#pragma unroll
    for (int o = 1; o < 64; o <<= 1) v = fmaxf(v, __shfl_xor(v, o));
    return v;
}
__device__ __forceinline__ int lane_id() { int l; asm volatile("v_mbcnt_lo_u32_b32 %0, -1, 0\n\tv_mbcnt_hi_u32_b32 %0, -1, %0" : "=v"(l)); return l; }
__device__ __forceinline__ unsigned ld_u32_agent(const unsigned* p) { return __hip_atomic_load(p, __ATOMIC_RELAXED, __HIP_MEMORY_SCOPE_AGENT); }

namespace pg8 {
constexpr unsigned GATHER_ROW_MASK = 65535u;
constexpr int BM = 256, BK = 64, HALF = 128, HTB = HALF * BK * 2, STAGE_BYTES = 8 * HTB, NXCD = 8, WGM = 8;
__host__ __device__ __forceinline__ int lds_byte(int r, int c) { const int st = (r >> 4) * 2 + (c >> 5), rr = r & 15, cc = c & 31, ob = rr * 64 + cc * 2; return st * 1024 + (ob ^ (((ob >> 9) & 1) << 5)); }
__host__ __device__ __forceinline__ void stage_rc(int b, int& R, int& C) { const int st = b / 1024, sb = b % 1024, swz = sb ^ (((sb >> 9) & 1) << 5); R = (st >> 1) * 16 + swz / 64; C = (st & 1) * 32 + (swz % 64) / 2; }
__host__ __device__ __forceinline__ int perm32(int rho) { const int n = rho >> 4, i = rho & 15; return 8 * (i >> 2) + 4 * n + (i & 3); }

struct Unit { const char* A; const char* B; int pm, pn, aux; const int* rows; };
struct Gemm { int lda, ldb, K; };

struct TileOrder {
    int nM, nN, nwg, G, c;
    __device__ __forceinline__ void init(int nM_, int nN_, int G_, int c_) { nM = nM_; nN = nN_; nwg = nM * nN; G = G_; c = c_; }
    __device__ __forceinline__ bool get(int i, int& pm, int& pn) const {
        const long L = (long)i * G + c; if (L >= nwg) return false;
        int wgid = (int)L; { const int q = nwg / NXCD, r = nwg % NXCD, xcd = wgid % NXCD, off = wgid / NXCD; wgid = (xcd < r ? xcd * (q + 1) : r * (q + 1) + (xcd - r) * q) + off; }
        const int nig = WGM * nN, gid = wgid / nig, fm = gid * WGM, gsz = (nM - fm) < WGM ? (nM - fm) : WGM;
        pm = fm + ((wgid % nig) % gsz); pn = (wgid % nig) / gsz; return true;
    }
};

typedef float f32x2g __attribute__((ext_vector_type(2)));
__device__ __forceinline__ f32x2g gelu_pk(f32x2g v) {
    const f32x2g av = __builtin_elementwise_abs(v), d = av * 0.2316418882f + 1.0f;
    f32x2g t; t.x = __builtin_amdgcn_rcpf(d.x); t.y = __builtin_amdgcn_rcpf(d.y);
    f32x2g q = t * 0.5307027145f + (-0.7265760135f); q = q * t + 0.7107068705f; q = q * t + (-0.142248368f); q = q * t + 0.127414796f; q = q * t;
    const f32x2g s = (v * v) * (-0.72134752044f);
    f32x2g e; e.x = __builtin_amdgcn_exp2f(s.x); e.y = __builtin_amdgcn_exp2f(s.y);
    const f32x2g m = v * (q * e), r = v - m;
    f32x2g o; o.x = v.x < 0.f ? m.x : r.x; o.y = v.y < 0.f ? m.y : r.y; return o;
}

__device__ __forceinline__ const char* uniform_ptr(const char* p) { const unsigned long long v = (unsigned long long)p; const unsigned lo = __builtin_amdgcn_readfirstlane((unsigned)v), hi = __builtin_amdgcn_readfirstlane((unsigned)(v >> 32)); return (const char*)(((unsigned long long)hi << 32) | lo); }
template <class Epi, class Sched, bool GATHER = false, bool FP8 = false>
__device__ __forceinline__ void gemm_phase(LAS unsigned char* lds, int wid, const Gemm g, const Sched& S, const Epi& E) {
    const int lane = lane_id(), tid = wid * 64 + lane, wr = wid >> 2, wc = wid & 3, fr = lane & 15, fq = lane >> 4;
    const int nt = g.K / BK;
    unsigned voffB[2]; unsigned vA0[2], vA1[2]; int RA[2], CA[2];
#pragma unroll
    for (int i = 0; i < 2; ++i) { int R, C; stage_rc(tid * 16 + i * 8192, R, C); const int pr = Epi::PERM ? perm32(R & 31) : (R & 31);
        RA[i] = R; CA[i] = C; voffB[i] = (unsigned)((64 * (R >> 5) + pr) * g.ldb + C) * 2u;
        vA0[i] = (unsigned)(R * g.lda + C) * 2u; vA1[i] = vA0[i]; }
    const size_t kstep = (size_t)(BK * 2);
    const size_t hstepA = GATHER ? (size_t)0 : (size_t)HALF * g.lda * 2, hstepB = (size_t)32 * g.ldb * 2;
    LAS u32x4* park = (LAS u32x4*)(lds + 131072 + 1024) + tid;
#define PG8_GOFF(U, d0, d1) do { _Pragma("unroll") for (int _i = 0; _i < 2; ++_i) { \
        d0[_i] = (((unsigned)(U).rows[RA[_i]] & GATHER_ROW_MASK) * (unsigned)g.lda + (unsigned)CA[_i]) * 2u; d1[_i] = (((unsigned)(U).rows[HALF + RA[_i]] & GATHER_ROW_MASK) * (unsigned)g.lda + (unsigned)CA[_i]) * 2u; } } while (0)
    const unsigned ldsw = (unsigned)wid * 1024u;
    const int aoff = lds_byte(wr * 64 + fr, fq * 8), boff = lds_byte(wc * 32 + fr, fq * 8);
#define PG8_SA(b, h) (((b) * 2 + (h)) * HTB)
#define PG8_SB(b, h) ((4 + (b) * 2 + (h)) * HTB)
#define PG8_STAGE(bufoff, gbase, voff) do { _Pragma("unroll") for (int _i = 0; _i < 2; ++_i) \
        __builtin_amdgcn_global_load_lds((const unsigned*)((const char*)(gbase) + (voff)[_i]), (LAS unsigned*)(lds + (bufoff) + ldsw + _i * 8192), 16, 0, 0); } while (0)
#define PG8_LD8(dst_, addr_) do { const u32x4 lo_ = *(const LAS u32x4*)(addr_), hi_ = *(const LAS u32x4*)((addr_) + 1024); \
        dst_ = (v8i32){(int)lo_.x, (int)lo_.y, (int)lo_.z, (int)lo_.w, (int)hi_.x, (int)hi_.y, (int)hi_.z, (int)hi_.w}; } while (0)
#define PG8_LDA(dst, b, h) do { _Pragma("unroll") for (int m = 0; m < 4; ++m) PG8_LD8(dst[m], lds + PG8_SA(b, h) + aoff + m * 2048); } while (0)
#define PG8_LDB(dst, b, h) do { _Pragma("unroll") for (int n = 0; n < 2; ++n) PG8_LD8(dst[n], lds + PG8_SB(b, h) + boff + n * 2048); } while (0)
#define PG8_HALF(v_, k_) __builtin_bit_cast(bf16x8, __builtin_shufflevector(v_, v_, 4 * (k_) + 0, 4 * (k_) + 1, 4 * (k_) + 2, 4 * (k_) + 3))
#define PG8_MMA(ai, bj, At, Bt) do { __builtin_amdgcn_s_setprio(1); _Pragma("unroll") for (int m = 0; m < 4; ++m) _Pragma("unroll") for (int n = 0; n < 2; ++n) { \
        if constexpr (FP8) asm volatile("v_mfma_scale_f32_16x16x128_f8f6f4 %0, %1, %2, %0, %3, %3 op_sel_hi:[0,0,0]" : "+v"(acc[ai][bj][m][n]) : "v"(Bt[n]), "v"(At[m]), "v"(one8_));   \
        else { acc[ai][bj][m][n] = __builtin_amdgcn_mfma_f32_16x16x32_bf16(PG8_HALF(Bt[n], 0), PG8_HALF(At[m], 0), acc[ai][bj][m][n], 0, 0, 0); \
               acc[ai][bj][m][n] = __builtin_amdgcn_mfma_f32_16x16x32_bf16(PG8_HALF(Bt[n], 1), PG8_HALF(At[m], 1), acc[ai][bj][m][n], 0, 0, 0); } } \
        __builtin_amdgcn_s_setprio(0); } while (0)
#define PG8_WAIT_V(n) asm volatile("s_waitcnt vmcnt(" #n ")" ::: "memory")
#define PG8_WAIT_L(n) asm volatile("s_waitcnt lgkmcnt(" #n ")" ::: "memory")
#define PG8_BAR __builtin_amdgcn_s_barrier()
#define PG8_SCHED __builtin_amdgcn_sched_barrier(0)
    Unit cur, nxt; int ui = 0;
    if (!S.next(0, cur)) return;
    f32x4 acc[2][2][4][2];
#pragma unroll
    for (int a = 0; a < 2; ++a)
#pragma unroll
        for (int b = 0; b < 2; ++b)
#pragma unroll
            for (int m = 0; m < 4; ++m)
#pragma unroll
                for (int n = 0; n < 2; ++n) acc[a][b][m][n] = (f32x4){0.f, 0.f, 0.f, 0.f};
    v8i32 At[4], B0[2], B1[2];
    const int one8_ = 0x7f7f7f7f;
    const char* cA = uniform_ptr(cur.A); const char* cB = uniform_ptr(cur.B);
    if constexpr (GATHER) { PG8_GOFF(cur, vA0, vA1); }
    PG8_STAGE(PG8_SB(0, 0), cB, voffB); PG8_STAGE(PG8_SB(0, 1), cB + hstepB, voffB); PG8_STAGE(PG8_SA(0, 0), cA, vA0); PG8_STAGE(PG8_SA(0, 1), cA + hstepA, vA1);
    if (wr == 1) PG8_BAR;
    PG8_WAIT_V(2); PG8_BAR;
    PG8_STAGE(PG8_SB(1, 0), cB + kstep, voffB); PG8_STAGE(PG8_SA(1, 0), cA + kstep, vA0); PG8_STAGE(PG8_SB(1, 1), cB + hstepB + kstep, voffB);
    PG8_WAIT_V(6); PG8_BAR;
    for (;;) {
        const bool has_next = S.next(ui + 1, nxt);
        const char* nA = has_next ? uniform_ptr(nxt.A) : cA; const char* nB = has_next ? uniform_ptr(nxt.B) : cB;
        if constexpr (GATHER) { unsigned n0[2] = {vA0[0], vA0[1]}, n1[2] = {vA1[0], vA1[1]}; if (has_next) { PG8_GOFF(nxt, n0, n1); } *park = (u32x4){n0[0], n0[1], n1[0], n1[1]}; }
#pragma nounroll
        for (int t = 0; t < nt; t += 2) {
            const bool last = (t == nt - 2);
            const char* a1 = cA + (size_t)(t + 1) * kstep;
            const char* a2 = uniform_ptr(last ? nA : cA + (size_t)(t + 2) * kstep); const char* b2 = uniform_ptr(last ? nB : cB + (size_t)(t + 2) * kstep);
            const char* a3 = a2 + kstep; const char* b3 = b2 + kstep;
            unsigned w0[2] = {vA0[0], vA0[1]}, w1[2] = {vA1[0], vA1[1]};
            if constexpr (GATHER) { if (last) { const u32x4 pk = *park; w0[0] = pk.x; w0[1] = pk.y; w1[0] = pk.z; w1[1] = pk.w; } }
            PG8_LDB(B0, 0, 0); PG8_LDB(B1, 0, 1); PG8_SCHED; PG8_LDA(At, 0, 0); PG8_STAGE(PG8_SA(1, 1), a1 + hstepA, vA1);
            PG8_WAIT_V(8); PG8_WAIT_L(0); PG8_BAR; PG8_MMA(0, 0, At, B0); PG8_MMA(0, 1, At, B1); PG8_BAR; PG8_SCHED;
            PG8_LDA(At, 0, 1); PG8_STAGE(PG8_SB(0, 0), b2, voffB); PG8_STAGE(PG8_SB(0, 1), b2 + hstepB, voffB); PG8_STAGE(PG8_SA(0, 0), a2, w0);
            PG8_WAIT_V(8); PG8_WAIT_L(0); PG8_BAR; PG8_MMA(1, 0, At, B0); PG8_MMA(1, 1, At, B1); PG8_BAR; PG8_SCHED;
            PG8_LDB(B0, 1, 0); PG8_LDB(B1, 1, 1); PG8_SCHED; PG8_LDA(At, 1, 0); PG8_STAGE(PG8_SA(0, 1), a2 + hstepA, w1);
            PG8_WAIT_V(8); PG8_WAIT_L(0); PG8_BAR; PG8_MMA(0, 0, At, B0); PG8_MMA(0, 1, At, B1); PG8_BAR; PG8_SCHED;
            PG8_LDA(At, 1, 1); PG8_STAGE(PG8_SB(1, 0), b3, voffB); PG8_STAGE(PG8_SB(1, 1), b3 + hstepB, voffB); PG8_STAGE(PG8_SA(1, 0), a3, w0);
            PG8_WAIT_V(8); PG8_WAIT_L(0); PG8_BAR; PG8_MMA(1, 0, At, B0); PG8_MMA(1, 1, At, B1); PG8_BAR; PG8_SCHED;
        }
        if (wr == 0) PG8_BAR;
        if constexpr (FP8) asm volatile("s_nop 15\n\ts_nop 7" ::: "memory");
        asm volatile("" ::: "memory");
        { const int l2_ = lane_id(); E(acc, cur, wr, wc, l2_ & 15, l2_ >> 4, lds + LDS_TBUF + wid * TBUF_W); }
        if (!has_next) break;
#pragma unroll
        for (int a = 0; a < 2; ++a)
#pragma unroll
            for (int b = 0; b < 2; ++b)
#pragma unroll
                for (int m = 0; m < 4; ++m)
#pragma unroll
                    for (int n = 0; n < 2; ++n) acc[a][b][m][n] = (f32x4){0.f, 0.f, 0.f, 0.f};
        cur = nxt; cA = nA; cB = nB; ++ui;
        if constexpr (GATHER) { const u32x4 pk = *park; vA0[0] = pk.x; vA0[1] = pk.y; vA1[0] = pk.z; vA1[1] = pk.w; }
        if (wr == 1) PG8_BAR;
    }
    PG8_WAIT_V(0);
    PG8_BAR;
#undef PG8_GOFF
#undef PG8_SA
#undef PG8_SB
#undef PG8_STAGE
#undef PG8_LD8
#undef PG8_HALF
#undef PG8_LDA
#undef PG8_LDB
#undef PG8_MMA
#undef PG8_WAIT_V
#undef PG8_WAIT_L
#undef PG8_BAR
#undef PG8_SCHED
}

struct PlainSched {
    TileOrder to; const char* A; const char* B; size_t tA, tB;
    __device__ __forceinline__ bool next(int i, Unit& u) const { int pm, pn; if (!to.get(i, pm, pn)) return false; u.pm = pm; u.pn = pn; u.aux = 0; u.rows = nullptr; u.A = A + (size_t)pm * tA; u.B = B + (size_t)pn * tB; return true; }
};
struct OneUnitSched {
    Unit u0;
    __device__ __forceinline__ bool next(int i, Unit& u) const { if (i != 0) return false; u = u0; return true; }
};
struct MemAttnSched {
    TileOrder to; const char* A; const char* B; size_t tA, hA, bB, hB;
    __device__ __forceinline__ bool next(int i, Unit& u) const { int pm, pn; if (!to.get(i, pm, pn)) return false; u.pm = pm; u.pn = pn; u.aux = 0; u.rows = nullptr;
        u.A = A + (size_t)pm * tA + (size_t)pn * hA; const int b = pm >> 5; u.B = B + (size_t)b * bB + (size_t)pn * hB; return true; }
};
struct MoeSched {
    int G, c; const LAS unsigned* lps; const char* A; const char* B; size_t tA, eB, tB; const int* slots;
    __device__ __forceinline__ bool next(int i, Unit& u) const { const int L = i * G + c; const int nblk = (int)__builtin_amdgcn_readfirstlane(lps[32] >> 8); if (L >= nblk * 4) return false; const int rb = L >> 2, pn = L & 3;
        const int e = (int)__builtin_amdgcn_readfirstlane(lps[64 + rb]); const int s0 = (int)__builtin_amdgcn_readfirstlane(lps[e]); u.pm = rb; u.pn = pn; u.aux = e; u.rows = slots + (size_t)e * 65536 + (rb * 256 - s0);
        u.A = A + (size_t)rb * tA; u.B = B + (size_t)e * eB + (size_t)pn * tB; return true; }
};

#define EPI_ARGS f32x4 (&acc)[2][2][4][2], const Unit& u, int wr, int wc, int fr, int fq, LAS unsigned char* tb
__device__ __forceinline__ void st128(bf16_t* rowbase, size_t ldc, const u32x4 w0, const u32x4 w1, int fr, int fq, LAS unsigned char* tb) {
    *(LAS u32x4*)(tb + fr * 144 + fq * 16) = w0; *(LAS u32x4*)(tb + fr * 144 + 64 + fq * 16) = w1;
    const int L = fq * 16 + fr, r = L >> 3, c = L & 7;
    const u32x4 a = *(const LAS u32x4*)(tb + r * 144 + c * 16), b = *(const LAS u32x4*)(tb + (8 + r) * 144 + c * 16);
    *(u32x4*)(rowbase + (size_t)r * ldc + c * 8) = a; *(u32x4*)(rowbase + (size_t)(8 + r) * ldc + c * 8) = b;
}
__device__ __forceinline__ u32x4 pk8(const f32x4 v0, const f32x4 v1) { u32x4 w; w.x = cvt_pk_bf16(v0[0], v0[1]); w.y = cvt_pk_bf16(v0[2], v0[3]); w.z = cvt_pk_bf16(v1[0], v1[1]); w.w = cvt_pk_bf16(v1[2], v1[3]); return w; }
struct EpiZ {
    static constexpr bool PERM = true;
    bf16_t* O; unsigned* kmx;
    __device__ __forceinline__ void operator()(EPI_ARGS) const {
        const int mode = u.pn < 4 ? 1 : (u.pn < 6 ? 2 : 0);
        if (u.pn == 6 || u.pn == 7) {
#pragma unroll
            for (int bj = 0; bj < 2; ++bj) { float mx = 0.f;
#pragma unroll
                for (int ai = 0; ai < 2; ++ai)
#pragma unroll
                    for (int m = 0; m < 4; ++m) { const f32x4 a = acc[ai][bj][m][0], b = acc[ai][bj][m][1];
                        float q = (a[0] * a[0] + a[1] * a[1]) + (a[2] * a[2] + a[3] * a[3]) + (b[0] * b[0] + b[1] * b[1]) + (b[2] * b[2] + b[3] * b[3]);
                        q += __shfl_xor(q, 16); q += __shfl_xor(q, 32); mx = fmaxf(mx, q); }
#pragma unroll
                for (int o_ = 1; o_ < 16; o_ <<= 1) mx = fmaxf(mx, __shfl_xor(mx, o_));
                if (fr == 0 && fq == 0) { const int b_ = u.pm >> 5, h_ = (u.pn - 6) * 2 + (wc >> 1); atomicMax(kmx + (((b_ * 4 + h_) * 2 + (wc & 1)) * 2 + bj), __float_as_uint(mx)); } }
        }
#pragma unroll
        for (int ai = 0; ai < 2; ++ai)
#pragma unroll
            for (int m = 0; m < 4; ++m) { u32x4 w[2];
#pragma unroll
                for (int bj = 0; bj < 2; ++bj) { f32x4 v0 = acc[ai][bj][m][0], v1 = acc[ai][bj][m][1];
                    if (mode == 1) { f32x2g a = gelu_pk((f32x2g){v0[0], v0[1]}), b = gelu_pk((f32x2g){v0[2], v0[3]}), c = gelu_pk((f32x2g){v1[0], v1[1]}), d = gelu_pk((f32x2g){v1[2], v1[3]});
                        v0 = (f32x4){a.x, a.y, b.x, b.y}; v1 = (f32x4){c.x, c.y, d.x, d.y}; }
                    else if (mode == 2) { v0 = v0 * C2_DIFF; v1 = v1 * C2_DIFF; }
                    w[bj] = pk8(v0, v1); }
                st128(O + (size_t)(u.pm * BM + ai * HALF + wr * 64 + m * 16) * ZP + u.pn * BM + wc * 64, ZP, w[0], w[1], fr, fq, tb); }
    }
};
struct EpiBf16 {
    static constexpr bool PERM = true;
    bf16_t* O; int ldc; const float* ssq; float cscale;
    __device__ __forceinline__ void operator()(EPI_ARGS) const {
        float sc[2][4];
#pragma unroll
        for (int ai = 0; ai < 2; ++ai)
#pragma unroll
            for (int m = 0; m < 4; ++m) sc[ai][m] = cscale;
        if (ssq) {
#pragma unroll
            for (int ai = 0; ai < 2; ++ai)
#pragma unroll
                for (int m = 0; m < 4; ++m) { const f32x4 s4 = *(const f32x4*)(ssq + (size_t)(u.pm * BM + ai * HALF + wr * 64 + m * 16 + fr) * 4);
                    sc[ai][m] = cscale * __builtin_amdgcn_rsqf(((s4[0] + s4[1]) + (s4[2] + s4[3])) * (1.0f / DM) + RMS_EPS); }
        }
#pragma unroll
        for (int ai = 0; ai < 2; ++ai)
#pragma unroll
            for (int m = 0; m < 4; ++m) { const int rowg = u.pm * BM + ai * HALF + wr * 64 + m * 16; const float c = sc[ai][m];
                st128(O + (size_t)rowg * ldc + u.pn * BM + wc * 64, (size_t)ldc, pk8(acc[ai][0][m][0] * c, acc[ai][0][m][1] * c), pk8(acc[ai][1][m][0] * c, acc[ai][1][m][1] * c), fr, fq, tb); }
    }
};
struct EpiF8 {
    static constexpr bool PERM = true;
    unsigned char* O; int ldc; const float* ssq; float cscale;
    __device__ __forceinline__ void operator()(EPI_ARGS) const {
        const int L = fq * 16 + fr;
        float sc[2][4];
#pragma unroll
        for (int ai = 0; ai < 2; ++ai)
#pragma unroll
            for (int m = 0; m < 4; ++m) sc[ai][m] = cscale;
        if (ssq) {
#pragma unroll
            for (int ai = 0; ai < 2; ++ai)
#pragma unroll
                for (int m = 0; m < 4; ++m) { const f32x4 s4 = *(const f32x4*)(ssq + (size_t)(u.pm * BM + ai * HALF + wr * 64 + m * 16 + fr) * 4);
                    sc[ai][m] = cscale * __builtin_amdgcn_rsqf(((s4[0] + s4[1]) + (s4[2] + s4[3])) * (1.0f / DM) + RMS_EPS); }
        }
#pragma unroll
        for (int ai = 0; ai < 2; ++ai)
#pragma unroll
            for (int m = 0; m < 4; ++m) { const int rowg = u.pm * BM + ai * HALF + wr * 64 + m * 16; const float c = sc[ai][m];
#pragma unroll
                for (int bj = 0; bj < 2; ++bj) { const f32x4 a = acc[ai][bj][m][0] * c, b = acc[ai][bj][m][1] * c; u32x2 f; f.x = pk4_fp8(a[0], a[1], a[2], a[3]); f.y = pk4_fp8(b[0], b[1], b[2], b[3]);
                    *(LAS u32x2*)(tb + fr * 144 + bj * 32 + fq * 8) = f; }
                const u32x4 v8 = *(const LAS u32x4*)(tb + (L >> 2) * 144 + (L & 3) * 16);
                *(u32x4*)(O + (size_t)(rowg + (L >> 2)) * ldc + u.pn * BM + wc * 64 + (L & 3) * 16) = v8; }
    }
};
struct EpiSoftmax {
    static constexpr bool PERM = true;
    unsigned char* O; LAS float* xch; float sscale;
    __device__ __forceinline__ void operator()(EPI_ARGS) const {
        LAS float* xm = xch; LAS float* xs = xch + 1024;
#pragma unroll
        for (int ai = 0; ai < 2; ++ai)
#pragma unroll
            for (int bj = 0; bj < 2; ++bj)
#pragma unroll
                for (int m = 0; m < 4; ++m)
#pragma unroll
                    for (int n = 0; n < 2; ++n) acc[ai][bj][m][n] = acc[ai][bj][m][n] * sscale;
#pragma unroll
        for (int ai = 0; ai < 2; ++ai)
#pragma unroll
            for (int m = 0; m < 4; ++m) { float v = -__builtin_inff();
#pragma unroll
                for (int bj = 0; bj < 2; ++bj)
#pragma unroll
                    for (int n = 0; n < 2; ++n) { const f32x4 a = acc[ai][bj][m][n]; v = fmaxf(v, fmaxf(fmaxf(a[0], a[1]), fmaxf(a[2], a[3]))); }
                v = fmaxf(v, __shfl_xor(v, 16)); v = fmaxf(v, __shfl_xor(v, 32));
                if (fq == 0) xm[(ai * HALF + wr * 64 + m * 16 + fr) * 4 + wc] = v; }
        asm volatile("s_waitcnt lgkmcnt(0)" ::: "memory"); __builtin_amdgcn_s_barrier(); asm volatile("" ::: "memory");
#pragma unroll
        for (int ai = 0; ai < 2; ++ai)
#pragma unroll
            for (int m = 0; m < 4; ++m) { const f32x4 t = *(const LAS f32x4*)(xm + (ai * HALF + wr * 64 + m * 16 + fr) * 4); const float mx = fmaxf(fmaxf(t[0], t[1]), fmaxf(t[2], t[3])); float sm = 0.f;
#pragma unroll
                for (int bj = 0; bj < 2; ++bj)
#pragma unroll
                    for (int n = 0; n < 2; ++n) { f32x4 a = acc[ai][bj][m][n];
#pragma unroll
                        for (int j = 0; j < 4; ++j) { a[j] = __builtin_amdgcn_exp2f(a[j] - mx); sm += a[j]; }
                        acc[ai][bj][m][n] = a; }
                sm += __shfl_xor(sm, 16); sm += __shfl_xor(sm, 32);
                if (fq == 0) xs[(ai * HALF + wr * 64 + m * 16 + fr) * 4 + wc] = sm; }
        asm volatile("s_waitcnt lgkmcnt(0)" ::: "memory"); __builtin_amdgcn_s_barrier(); asm volatile("" ::: "memory");
#pragma unroll
        for (int ai = 0; ai < 2; ++ai)
#pragma unroll
            for (int m = 0; m < 4; ++m) { const f32x4 t = *(const LAS f32x4*)(xs + (ai * HALF + wr * 64 + m * 16 + fr) * 4); const float inv = F8_PSCALE * __builtin_amdgcn_rcpf((t[0] + t[1]) + (t[2] + t[3]));
                const int rowg = u.pm * BM + ai * HALF + wr * 64 + m * 16, L = fq * 16 + fr;
#pragma unroll
                for (int bj = 0; bj < 2; ++bj) { const f32x4 a = acc[ai][bj][m][0] * inv, b = acc[ai][bj][m][1] * inv; u32x2 f; f.x = pk4_fp8(a[0], a[1], a[2], a[3]); f.y = pk4_fp8(b[0], b[1], b[2], b[3]);
                    *(LAS u32x2*)(tb + fr * 144 + bj * 32 + fq * 8) = f; }
                const u32x4 v8 = *(const LAS u32x4*)(tb + (L >> 2) * 144 + (L & 3) * 16);
                *(u32x4*)(O + (size_t)(rowg + (L >> 2)) * DM + u.pn * BM + wc * 64 + (L & 3) * 16) = v8; }
    }
};
template <bool BF>
struct EpiResid {
    static constexpr bool PERM = true;
    const void* base; bf16_t* ob; float* ssq; LAS float* xs; unsigned char* o8; float as;
    __device__ __forceinline__ void operator()(EPI_ARGS) const {
        const int col0 = u.pn * BM + wc * 64 + 8 * fq;
        if constexpr (BF) {
            u32x4 br[2][4][2];
#pragma unroll
            for (int ai = 0; ai < 2; ++ai)
#pragma unroll
                for (int m = 0; m < 4; ++m)
#pragma unroll
                    for (int bj = 0; bj < 2; ++bj) br[ai][m][bj] = *(const u32x4*)((const bf16_t*)base + (size_t)(u.pm * BM + ai * HALF + wr * 64 + m * 16 + fr) * DM + col0 + bj * 32);
#pragma unroll
            for (int ai = 0; ai < 2; ++ai)
#pragma unroll
                for (int m = 0; m < 4; ++m) asm volatile("" : "+v"(br[ai][m][0]), "+v"(br[ai][m][1]));
#pragma unroll
            for (int ai = 0; ai < 2; ++ai)
#pragma unroll
                for (int m = 0; m < 4; ++m) { const int rowg = u.pm * BM + ai * HALF + wr * 64 + m * 16, row = rowg + fr; float s = 0.f; u32x4 w[2]; u32x2 f8[2];
#pragma unroll
                    for (int bj = 0; bj < 2; ++bj) { const u32x4 r = br[ai][m][bj];
                        const f32x4 o0 = (f32x4){bf_lo(r.x), bf_hi(r.x), bf_lo(r.y), bf_hi(r.y)} + acc[ai][bj][m][0] * as, o1 = (f32x4){bf_lo(r.z), bf_hi(r.z), bf_lo(r.w), bf_hi(r.w)} + acc[ai][bj][m][1] * as;
                        s += (o0[0] * o0[0] + o0[1] * o0[1]) + (o0[2] * o0[2] + o0[3] * o0[3]) + (o1[0] * o1[0] + o1[1] * o1[1]) + (o1[2] * o1[2] + o1[3] * o1[3]);
                        w[bj] = pk8(o0, o1);
                        f8[bj].x = pk4_fp8(o0[0] * F8_XSCALE, o0[1] * F8_XSCALE, o0[2] * F8_XSCALE, o0[3] * F8_XSCALE); f8[bj].y = pk4_fp8(o1[0] * F8_XSCALE, o1[1] * F8_XSCALE, o1[2] * F8_XSCALE, o1[3] * F8_XSCALE); }
                    st128(ob + (size_t)rowg * DM + u.pn * BM + wc * 64, (size_t)DM, w[0], w[1], fr, fq, tb);
                    if (o8) {
                        *(LAS u32x2*)(tb + fr * 144 + fq * 8) = f8[0]; *(LAS u32x2*)(tb + fr * 144 + 32 + fq * 8) = f8[1];
                        const int L = fq * 16 + fr; const u32x4 v8 = *(const LAS u32x4*)(tb + (L >> 2) * 144 + (L & 3) * 16);
                        *(u32x4*)(o8 + (size_t)(rowg + (L >> 2)) * DM + u.pn * BM + wc * 64 + (L & 3) * 16) = v8; }
                    s += __shfl_xor(s, 16); s += __shfl_xor(s, 32);
                    if (fq == 0) xs[(ai * HALF + wr * 64 + m * 16 + fr) * 4 + wc] = s; }
        } else {
#pragma unroll
            for (int ai = 0; ai < 2; ++ai) {
                f32x4 br[4][2][2];
#pragma unroll
                for (int m = 0; m < 4; ++m)
#pragma unroll
                    for (int bj = 0; bj < 2; ++bj) { const float* p = (const float*)base + (size_t)(u.pm * BM + ai * HALF + wr * 64 + m * 16 + fr) * DM + col0 + bj * 32; br[m][bj][0] = *(const f32x4*)p; br[m][bj][1] = *(const f32x4*)(p + 4); }
#pragma unroll
                for (int m = 0; m < 4; ++m) asm volatile("" : "+v"(br[m][0][0]), "+v"(br[m][0][1]), "+v"(br[m][1][0]), "+v"(br[m][1][1]));
#pragma unroll
                for (int m = 0; m < 4; ++m) { const int rowg = u.pm * BM + ai * HALF + wr * 64 + m * 16; float s = 0.f; u32x4 w[2]; u32x2 f8[2];
#pragma unroll
                    for (int bj = 0; bj < 2; ++bj) { const f32x4 o0 = br[m][bj][0] + acc[ai][bj][m][0] * as, o1 = br[m][bj][1] + acc[ai][bj][m][1] * as;
                        s += (o0[0] * o0[0] + o0[1] * o0[1]) + (o0[2] * o0[2] + o0[3] * o0[3]) + (o1[0] * o1[0] + o1[1] * o1[1]) + (o1[2] * o1[2] + o1[3] * o1[3]);
                        w[bj] = pk8(o0, o1);
                        f8[bj].x = pk4_fp8(o0[0] * F8_XSCALE, o0[1] * F8_XSCALE, o0[2] * F8_XSCALE, o0[3] * F8_XSCALE); f8[bj].y = pk4_fp8(o1[0] * F8_XSCALE, o1[1] * F8_XSCALE, o1[2] * F8_XSCALE, o1[3] * F8_XSCALE); }
                    st128(ob + (size_t)rowg * DM + u.pn * BM + wc * 64, (size_t)DM, w[0], w[1], fr, fq, tb);
                    if (o8) {
                        *(LAS u32x2*)(tb + fr * 144 + fq * 8) = f8[0]; *(LAS u32x2*)(tb + fr * 144 + 32 + fq * 8) = f8[1];
                        const int L = fq * 16 + fr; const u32x4 v8 = *(const LAS u32x4*)(tb + (L >> 2) * 144 + (L & 3) * 16);
                        *(u32x4*)(o8 + (size_t)(rowg + (L >> 2)) * DM + u.pn * BM + wc * 64 + (L & 3) * 16) = v8; }
                    s += __shfl_xor(s, 16); s += __shfl_xor(s, 32);
                    if (fq == 0) xs[(ai * HALF + wr * 64 + m * 16 + fr) * 4 + wc] = s; }
            }
        }
        asm volatile("s_waitcnt lgkmcnt(0)" ::: "memory"); __builtin_amdgcn_s_barrier(); asm volatile("" ::: "memory");
        { const int t_ = (wr * 4 + wc) * 64 + fq * 16 + fr;
          if (t_ < 256) { const f32x4 p = *(const LAS f32x4*)(xs + t_ * 4); ssq[(size_t)(u.pm * BM + t_) * 4 + u.pn] = (p[0] + p[1]) + (p[2] + p[3]); } }
    }
};
struct EpiRouter {
    static constexpr bool PERM = false;
    float* L; const float* ssq; const float* bg; const float* be; float* rstd_out;
    __device__ __forceinline__ void operator()(EPI_ARGS) const {
        if (wc != 0) return;
        const int row0 = u.pm * BM + wr * 64 + fr;
        float rsv[2][4];
#pragma unroll
        for (int ai = 0; ai < 2; ++ai)
#pragma unroll
            for (int m = 0; m < 4; ++m) { const f32x4 s4 = *(const f32x4*)(ssq + (size_t)(row0 + ai * HALF + m * 16) * 4);
                rsv[ai][m] = __builtin_amdgcn_rsqf(((s4[0] + s4[1]) + (s4[2] + s4[3])) * (1.0f / DM) + RMS_EPS); }
#pragma unroll
        for (int ai = 0; ai < 2; ++ai)
#pragma unroll
            for (int m = 0; m < 4; ++m) { const int row = row0 + ai * HALF + m * 16; const float rs = rsv[ai][m];
                if (fq == 0) rstd_out[row] = rs;
#pragma unroll
                for (int bj = 0; bj < 2; ++bj)
#pragma unroll
                    for (int n = 0; n < 2; ++n) { const int c0 = bj * 32 + n * 16 + 4 * fq; f32x4 o = acc[ai][bj][m][n] * rs;
#pragma unroll
                        for (int j = 0; j < 4; ++j) { const int c = c0 + j; const float b = c < 4 ? bg[c] : (c < 36 ? be[c - 4] : 0.f); o[j] += b; }
                        *(f32x4*)(L + (size_t)row * 64 + c0) = o; } }
    }
};
struct EpiGateUp {
    static constexpr bool PERM = true;
    unsigned char* act;
    __device__ __forceinline__ void operator()(EPI_ARGS) const {
        const int row0 = u.pm * BM + wr * 64 + fr, col0 = u.pn * 128 + wc * 32 + 8 * fq;
        const float* rstd = (const float*)((const char*)u.rows + SLOT_RS_OFF) + wr * 64 + fr;
        float rsv[2][4];
#pragma unroll
        for (int ai = 0; ai < 2; ++ai)
#pragma unroll
            for (int m = 0; m < 4; ++m) rsv[ai][m] = rstd[ai * HALF + m * 16];
#pragma unroll
        for (int ai = 0; ai < 2; ++ai)
#pragma unroll
            for (int m = 0; m < 4; ++m) { const int row = row0 + ai * HALF + m * 16; const float rs = rsv[ai][m];
                float r[8];
#pragma unroll
                for (int n = 0; n < 2; ++n)
#pragma unroll
                    for (int j = 0; j < 4; ++j) { const float gg = acc[ai][0][m][n][j] * rs, uu = acc[ai][1][m][n][j] * rs;
                        r[n * 4 + j] = gg * __builtin_amdgcn_rcpf(1.0f + __builtin_amdgcn_exp2f(-gg * LOG2E)) * uu; }
                u32x2 w; w.x = pk4_fp8(r[0] * F8_ASCALE, r[1] * F8_ASCALE, r[2] * F8_ASCALE, r[3] * F8_ASCALE); w.y = pk4_fp8(r[4] * F8_ASCALE, r[5] * F8_ASCALE, r[6] * F8_ASCALE, r[7] * F8_ASCALE);
                *(u32x2*)(act + (size_t)row * DEXP + col0) = w; }
    }
};
}

namespace da {
constexpr int NW = 8, QBLK = 32, KVBLK = 64, QB = NW * QBLK, DV = 128;
constexpr int SHM_V = KVBLK * DV * 2, SHM_K = KVBLK * 64 * 2;
constexpr int LDS_V = 0, LDS_K = 2 * SHM_V, LDS_WS = LDS_K + 2 * SHM_K, LDS_CX = LDS_WS + NW * 64 * 4, LDS_STASH = LDS_CX + 256, LDS_BYTES = LDS_STASH + NW * 8192;
constexpr float SKIP_MARGIN = 40.f;
constexpr float THR = 8.f;
#define SBAR() __builtin_amdgcn_sched_barrier(0)
__device__ __forceinline__ int kswz(int row, int chunk) { return row * 128 + ((chunk ^ ((row >> 1) & 7)) << 4); }
__device__ __forceinline__ int v_st(int k, int c) { const int kk = (k & ~0xC) | ((k & 4) << 1) | ((k & 8) >> 1); return ((kk >> 3) * 4 + (c >> 5)) * 512 + ((kk & 7) * 32 + (c & 31)) * 2; }
__device__ __forceinline__ int v_rd_base(int lane) { return ((lane & 3) << 3) | (((lane >> 2) & 3) << 6) | (((lane >> 4) & 1) << 5) | (((lane >> 5) & 1) << 8); }
constexpr int v_rd_off(int d0, int ks, int half) { return d0 * 512 + ks * 4096 + half * 2048; }
__device__ __forceinline__ int crow(int r, int hi) { return (r & 3) + 8 * (r >> 2) + 4 * hi; }
__device__ __forceinline__ bf16x8 load8(const bf16_t* p) { return *reinterpret_cast<const bf16x8*>(p); }

__device__ __forceinline__ void mask_tile(f32x16& p0, f32x16& p1, int dq) {
    const float NEG = -__builtin_inff();
#pragma unroll
    for (int r = 0; r < 16; ++r) { const int c = (r & 3) + 8 * (r >> 2); if (dq - c < 0) p0[r] = NEG; if (dq - c - 32 < 0) p1[r] = NEG; }
}
__device__ __forceinline__ void partialSM(f32x16& p0, f32x16& p1, float& m_reg, float& alpha, float l_reg) {
    float pmax = p0[0];
#pragma unroll
    for (int r = 1; r < 16; ++r) pmax = fmaxf(pmax, p0[r]);
#pragma unroll
    for (int r = 0; r < 16; ++r) pmax = fmaxf(pmax, p1[r]);
    { auto rr = __builtin_amdgcn_permlane32_swap(__float_as_uint(pmax), __float_as_uint(pmax), false, false); pmax = fmaxf(__uint_as_float(rr[0]), __uint_as_float(rr[1])); }
    const bool need = (pmax > THR) || (l_reg == 0.f && pmax > -__builtin_inff());
    if (__builtin_expect(__all(!need), 1)) { alpha = 1.f; }
    else { const float d = need ? pmax : 0.f; alpha = (l_reg == 0.f) ? 1.f : __builtin_amdgcn_exp2f(-d); m_reg += d;
#pragma unroll
        for (int r = 0; r < 16; ++r) p0[r] = p0[r] - d;
#pragma unroll
        for (int r = 0; r < 16; ++r) p1[r] = p1[r] - d; }
#pragma unroll
    for (int r = 0; r < 16; ++r) p0[r] = __builtin_amdgcn_exp2f(p0[r]);
}
__device__ __forceinline__ void finishSM(f32x16& p0, f32x16& p1, float alpha, float& l_reg, bf16x8& pa0, bf16x8& pa1, bf16x8& pa2, bf16x8& pa3) {
#pragma unroll
    for (int r = 0; r < 16; ++r) p1[r] = __builtin_amdgcn_exp2f(p1[r]);
    float ps = 0;
#pragma unroll
    for (int r = 0; r < 16; ++r) ps += p0[r];
#pragma unroll
    for (int r = 0; r < 16; ++r) ps += p1[r];
    { auto rr = __builtin_amdgcn_permlane32_swap(__float_as_uint(ps), __float_as_uint(ps), false, false); ps = __uint_as_float(rr[0]) + __uint_as_float(rr[1]); }
    l_reg = l_reg * alpha + ps;
#define PK4(P, B_, OUT) do { unsigned a0 = cvt_pk_bf16(P[B_+0], P[B_+1]), a1 = cvt_pk_bf16(P[B_+2], P[B_+3]);                          \
        unsigned b0 = cvt_pk_bf16(P[B_+4], P[B_+5]), b1 = cvt_pk_bf16(P[B_+6], P[B_+7]);                                             \
        auto r0 = __builtin_amdgcn_permlane32_swap(a0, b0, false, false); auto r1 = __builtin_amdgcn_permlane32_swap(a1, b1, false, false); \
        u32x4 w = {r0[0], r1[0], r0[1], r1[1]}; OUT = *reinterpret_cast<bf16x8*>(&w); } while (0)
    PK4(p0, 0, pa0); PK4(p0, 8, pa1); PK4(p1, 0, pa2); PK4(p1, 8, pa3);
#undef PK4
}
template <int KB>
__device__ __forceinline__ void qkt(f32x16& p0, f32x16& p1, const char* K_lds, int r32, int hi, const bf16x8* qr, float ab, float slope2) {
    const float s32 = 32.f * slope2;
#pragma unroll
    for (int r = 0; r < 16; ++r) { p0[r] = fmaf(slope2, (float)((r & 3) + 8 * (r >> 2)), ab); p1[r] = p0[r] + s32; }
#pragma unroll
    for (int d0 = 0; d0 < 4; ++d0) { const char* a = K_lds + KB * SHM_K + kswz(r32, d0 * 2 + hi);
        bf16x8 b0 = *reinterpret_cast<const bf16x8*>(a);
        bf16x8 b1 = *reinterpret_cast<const bf16x8*>(a + 32 * 128);
        p0 = __builtin_amdgcn_mfma_f32_32x32x16_bf16(b0, qr[d0], p0, 0, 0, 0);
        p1 = __builtin_amdgcn_mfma_f32_32x32x16_bf16(b1, qr[d0], p1, 0, 0, 0); }
}
template <int VB>
__device__ __forceinline__ void pv_tile(f32x16* o, int vb0, bf16x8 pa0, bf16x8 pa1, bf16x8 pa2, bf16x8 pa3) {
#define TRRD(dst, off) asm volatile("ds_read_b64_tr_b16 %0, %1 offset:%2" : "=&v"(dst) : "v"(vb0), "i"(off) : "memory")
#define PV_D0(d0) do { s16x4 l0, l1, l2, l3, h0, h1, h2, h3; constexpr int b_ = VB * SHM_V + v_rd_off(d0, 0, 0); \
        TRRD(l0, b_); TRRD(h0, b_ + 2048); TRRD(l1, b_ + 4096); TRRD(h1, b_ + 6144); TRRD(l2, b_ + 8192); TRRD(h2, b_ + 10240); TRRD(l3, b_ + 12288); TRRD(h3, b_ + 14336); \
        asm volatile("s_waitcnt lgkmcnt(0)" ::: "memory"); SBAR();   \
        o[d0] = __builtin_amdgcn_mfma_f32_32x32x16_bf16(pa0, (bf16x8){l0[0], l0[1], l0[2], l0[3], h0[0], h0[1], h0[2], h0[3]}, o[d0], 0, 0, 0);   \
        o[d0] = __builtin_amdgcn_mfma_f32_32x32x16_bf16(pa1, (bf16x8){l1[0], l1[1], l1[2], l1[3], h1[0], h1[1], h1[2], h1[3]}, o[d0], 0, 0, 0);   \
        o[d0] = __builtin_amdgcn_mfma_f32_32x32x16_bf16(pa2, (bf16x8){l2[0], l2[1], l2[2], l2[3], h2[0], h2[1], h2[2], h2[3]}, o[d0], 0, 0, 0);   \
        o[d0] = __builtin_amdgcn_mfma_f32_32x32x16_bf16(pa3, (bf16x8){l3[0], l3[1], l3[2], l3[3], h3[0], h3[1], h3[2], h3[3]}, o[d0], 0, 0, 0); } while (0)
    PV_D0(0); PV_D0(1); PV_D0(2); PV_D0(3);
#undef PV_D0
#undef TRRD
}

template <int KB>
__device__ __forceinline__ void mcluster(f32x16& p0, f32x16& p1, f32x16* o, int ka0_, int ka1_, int ka2_, int ka3_, int vb0, const bf16x8* qr, float ab, float slope2, bf16x8 pa0, bf16x8 pa1, bf16x8 pa2, bf16x8 pa3) {
    constexpr int VB = KB ^ 1;
#define KRD(dst, addr, off) asm volatile("ds_read_b128 %0, %1 offset:%2" : "=&v"(dst) : "v"(addr), "i"(off) : "memory")
#define TRRD(dst, off) asm volatile("ds_read_b64_tr_b16 %0, %1 offset:%2" : "=&v"(dst) : "v"(vb0), "i"(off) : "memory")
#define TRSET(S_, d0) do { constexpr int b_ = VB * SHM_V + v_rd_off(d0, 0, 0); TRRD(S_##0, b_); TRRD(S_##1, b_ + 2048); TRRD(S_##2, b_ + 4096); TRRD(S_##3, b_ + 6144); \
        TRRD(S_##4, b_ + 8192); TRRD(S_##5, b_ + 10240); TRRD(S_##6, b_ + 12288); TRRD(S_##7, b_ + 14336); } while (0)
#define TRWAIT(S_, n) asm volatile("s_waitcnt lgkmcnt(" #n ")" : "+v"(S_##0), "+v"(S_##1), "+v"(S_##2), "+v"(S_##3), "+v"(S_##4), "+v"(S_##5), "+v"(S_##6), "+v"(S_##7) :: "memory")
#define CAT8(l_, h_) ((bf16x8){l_[0], l_[1], l_[2], l_[3], h_[0], h_[1], h_[2], h_[3]})
#define PVMMA(S_, d0) do { o[d0] = __builtin_amdgcn_mfma_f32_32x32x16_bf16(pa0, CAT8(S_##0, S_##1), o[d0], 0, 0, 0); o[d0] = __builtin_amdgcn_mfma_f32_32x32x16_bf16(pa1, CAT8(S_##2, S_##3), o[d0], 0, 0, 0); \
        o[d0] = __builtin_amdgcn_mfma_f32_32x32x16_bf16(pa2, CAT8(S_##4, S_##5), o[d0], 0, 0, 0); o[d0] = __builtin_amdgcn_mfma_f32_32x32x16_bf16(pa3, CAT8(S_##6, S_##7), o[d0], 0, 0, 0); } while (0)
    bf16x8 ka0, ka1, ka2, ka3, kb0, kb1, kb2, kb3;
    KRD(ka0, ka0_, KB * SHM_K); KRD(kb0, ka0_, KB * SHM_K + 4096); KRD(ka1, ka1_, KB * SHM_K); KRD(kb1, ka1_, KB * SHM_K + 4096);
    KRD(ka2, ka2_, KB * SHM_K); KRD(kb2, ka2_, KB * SHM_K + 4096); KRD(ka3, ka3_, KB * SHM_K); KRD(kb3, ka3_, KB * SHM_K + 4096);
    s16x4 A0, A1, A2, A3, A4, A5, A6, A7, B0, B1, B2, B3, B4, B5, B6, B7;
    TRSET(A, 0);
    const float s32 = 32.f * slope2;
#pragma unroll
    for (int r = 0; r < 16; ++r) { p0[r] = fmaf(slope2, (float)((r & 3) + 8 * (r >> 2)), ab); p1[r] = p0[r] + s32; }
    asm volatile("s_waitcnt lgkmcnt(8)" : "+v"(ka0), "+v"(ka1), "+v"(ka2), "+v"(ka3), "+v"(kb0), "+v"(kb1), "+v"(kb2), "+v"(kb3) :: "memory");
    SBAR();
    p0 = __builtin_amdgcn_mfma_f32_32x32x16_bf16(ka0, qr[0], p0, 0, 0, 0); p1 = __builtin_amdgcn_mfma_f32_32x32x16_bf16(kb0, qr[0], p1, 0, 0, 0);
    p0 = __builtin_amdgcn_mfma_f32_32x32x16_bf16(ka1, qr[1], p0, 0, 0, 0); p1 = __builtin_amdgcn_mfma_f32_32x32x16_bf16(kb1, qr[1], p1, 0, 0, 0);
    p0 = __builtin_amdgcn_mfma_f32_32x32x16_bf16(ka2, qr[2], p0, 0, 0, 0); p1 = __builtin_amdgcn_mfma_f32_32x32x16_bf16(kb2, qr[2], p1, 0, 0, 0);
    p0 = __builtin_amdgcn_mfma_f32_32x32x16_bf16(ka3, qr[3], p0, 0, 0, 0); p1 = __builtin_amdgcn_mfma_f32_32x32x16_bf16(kb3, qr[3], p1, 0, 0, 0);
    SBAR();
    TRSET(B, 1); TRWAIT(A, 8); SBAR(); PVMMA(A, 0); SBAR();
    TRSET(A, 2); TRWAIT(B, 8); SBAR(); PVMMA(B, 1); SBAR();
    TRSET(B, 3); TRWAIT(A, 8); SBAR(); PVMMA(A, 2); SBAR();
    TRWAIT(B, 0); SBAR(); PVMMA(B, 3); SBAR();
#undef KRD
#undef TRRD
#undef TRSET
#undef TRWAIT
#undef CAT8
#undef PVMMA
}

struct BlockRef { const bf16_t* Q; const bf16_t* K; const bf16_t* V; bf16_t* O; int P0; int mode; float slope2; float kmax; };
struct Seam { bf16x8 qr[4]; bf16x8 st_v0, st_v1, st_k0; };
__device__ __forceinline__ BlockRef mkref(const bf16_t* Z, bf16_t* AO, const float* kmt  , int b, int combo, int mp) { BlockRef r; const int h = combo >> 5, qb = combo & 31;
    const bf16_t* zb = Z + (size_t)b * SEQ * ZP; r.Q = zb + (size_t)(qb * 256) * ZP + ZQ + h * 128 + mp * 64; r.K = zb + ZK + h * 128 + mp * 64; r.V = zb + ZVAL + h * 128;
    r.O = AO + ((size_t)b * SEQ + qb * 256) * DM + 512 + h * 128; r.P0 = qb * 256; r.mode = mp; r.slope2 = exp2f(-2.0f * (float)(h + 1)) * LOG2E;
    r.kmax = kmt[h * 2 + mp]; return r; }
#define ROWV(p, k0, rr) ((p) + (size_t)((k0) + (rr)) * ZP + sc)
#define ROWK(p, k0) ((p) + (size_t)((k0) + skr) * ZP + skc * 8)
#define VMW() asm volatile("s_waitcnt vmcnt(0)" ::: "memory")
#define VMWN(n) asm volatile("s_waitcnt vmcnt(%0)" :: "i"(n) : "memory")
#define SLOAD_K(Kp, k0) do { S.st_k0 = load8(ROWK(Kp, k0)); } while (0)
#define SLOAD_V(Vp, k0) do { S.st_v0 = load8(ROWV(Vp, k0, sr)); S.st_v1 = load8(ROWV(Vp, k0, 32 + sr)); } while (0)
#define SWRITE_HK(bf) do { *(bf16x8*)(K_lds + (bf) * SHM_K + kws) = S.st_k0; } while (0)
#define SWRITE_HV(bf) do { *(bf16x8*)(V_lds + (bf) * SHM_V + vst0) = S.st_v0; *(bf16x8*)(V_lds + (bf) * SHM_V + vst1) = S.st_v1; } while (0)
__device__ __forceinline__ void prime(const BlockRef& cur, char* lds, Seam& S, int wid) {
    const int lane = lane_id(), tid = wid * 64 + lane, r32 = lane & 31, hi = lane >> 5;
    const int sr = tid >> 4, sc = (tid & 15) * 8, skr = tid >> 3, skc = tid & 7, kws = kswz(skr, skc); char* K_lds = lds + LDS_K;
#pragma unroll
    for (int d0 = 0; d0 < 4; ++d0) S.qr[d0] = load8(cur.Q + (size_t)(wid * QBLK + r32) * ZP + d0 * 16 + hi * 8);
    const int kb0 = cur.P0 + QB - KVBLK;
    SLOAD_K(cur.K, kb0); VMW(); SWRITE_HK(0);
    SLOAD_K(cur.K, kb0 - KVBLK); SLOAD_V(cur.V, kb0);
    __syncthreads();
}
__device__ __forceinline__ void block(const BlockRef& cur, const BlockRef& nxt, char* lds, Seam& S, float lam, const float* __restrict__ subln, int wid) {
    const int lane = lane_id(), tid = wid * 64 + lane, r32 = lane & 31, hi = lane >> 5;
    const int NT0 = (cur.P0 + QB) / KVBLK;
    int NT = NT0;
    const int qlo = cur.P0 + wid * QBLK, qm = qlo + r32 - 4 * hi;
    const float slope2 = cur.slope2;
    const bool grpB = wid >= 4;
    char* V_lds = lds + LDS_V; char* K_lds = lds + LDS_K;
    float* ws = (float*)(lds + LDS_WS) + wid * 64; float* li_l = ws, * al_l = ws + 32;
    float m_reg = 0.f, l_reg = 0; f32x16 o[4] = {};
    const int sr = tid >> 4, sc = (tid & 15) * 8, vst0 = v_st(sr, sc), vst1 = v_st(32 + sr, sc), skr = tid >> 3, skc = tid & 7, kws = kswz(skr, skc);
    const int vb0 = (int)(uintptr_t)V_lds + v_rd_base(lane);
    const int kad0 = (int)(uintptr_t)K_lds + kswz(r32, 0 + hi), kad1 = (int)(uintptr_t)K_lds + kswz(r32, 2 + hi), kad2 = (int)(uintptr_t)K_lds + kswz(r32, 4 + hi), kad3 = (int)(uintptr_t)K_lds + kswz(r32, 6 + hi);
    const bf16_t* Kh = cur.K; const bf16_t* Vh = cur.V;
#define RESC(a) do { if (__any((a) < 1.f)) { if (hi == 0) al_l[r32] = (a); asm volatile("s_waitcnt lgkmcnt(0)" ::: "memory");              \
                     for (int d_ = 0; d_ < 4; ++d_) for (int r = 0; r < 16; ++r) o[d_][r] *= al_l[crow(r, hi)]; } } while (0)
#define KBASE(t) ((NT0 - 1 - (t)) * KVBLK)
#define AB(t) (slope2 * (float)(KBASE(t) - qm) - m_reg)
#define MASKT(P0_, P1_, t) do { const int kb_ = KBASE(t); if (kb_ + KVBLK - 1 > qlo) mask_tile(P0_, P1_, qm - kb_); } while (0)
    f32x16 pX0, pX1; float al; bf16x8 pa0, pa1, pa2, pa3;
    float cbase;
    { float q2 = 0.f;
#pragma unroll
      for (int d0 = 0; d0 < 4; ++d0)
#pragma unroll
          for (int j = 0; j < 8; ++j) { const float v = __uint_as_float(((unsigned)(unsigned short)S.qr[d0][j]) << 16); q2 = fmaf(v, v, q2); }
      { auto rr = __builtin_amdgcn_permlane32_swap(__float_as_uint(q2), __float_as_uint(q2), false, false); q2 = __uint_as_float(rr[0]) + __uint_as_float(rr[1]); }
      cbase = sqrtf(q2) * cur.kmax * 1.0001f - slope2 * (float)(qlo + r32); }
#define SOFTMAX(t) do { MASKT(pX0, pX1, (t)); partialSM(pX0, pX1, m_reg, al, l_reg); RESC(al); finishSM(pX0, pX1, al, l_reg, pa0, pa1, pa2, pa3); SBAR(); } while (0)
#define MATRIX(t, KB) do {                                                                                                   \
        __syncthreads();                                                                                                      \
        VMW(); if ((t) + 1 < NT) SWRITE_HK((KB) ^ 1); SWRITE_HV(KB);                                                           \
        if ((t) + 2 < NT) SLOAD_K(Kh, KBASE((t) + 2)); if ((t) + 1 < NT) SLOAD_V(Vh, KBASE((t) + 1));                            \
        SBAR(); mcluster<KB>(pX0, pX1, o, kad0, kad1, kad2, kad3, vb0, S.qr, AB(t), slope2, pa0, pa1, pa2, pa3); SBAR();            \
        __syncthreads(); } while (0)
    if (grpB) __builtin_amdgcn_s_barrier();
    VMW(); SWRITE_HK(1); SWRITE_HV(0);
    SLOAD_K(Kh, KBASE(2)); SLOAD_V(Vh, KBASE(1));
    SBAR(); qkt<0>(pX0, pX1, K_lds, r32, hi, S.qr, AB(0), slope2); SBAR();
    __syncthreads();
    SOFTMAX(0);
    for (int t = 1; t + 1 < NT; t += 2) {
        MATRIX(t, 1); SOFTMAX(t);
        const bool cut_here = (t == 3 && NT0 > 6);
        if (cut_here) {
            float c = cbase - m_reg;
#pragma unroll
            for (int o_ = 1; o_ < 64; o_ <<= 1) c = fmaxf(c, __shfl_xor(c, o_));
            if (lane == 0) ((float*)(lds + LDS_CX))[wid] = c;
        }
        MATRIX(t + 1, 0);
        if (cut_here) {
            const float* cx = (const float*)(lds + LDS_CX);
            float C = cx[0];
#pragma unroll
            for (int w_ = 1; w_ < NW; ++w_) C = fmaxf(C, cx[w_]);
            const float X = (-SKIP_MARGIN - C) / slope2 - 63.f;
            const float need_f = (float)(NT0 - 1) - X * (1.0f / 64.0f);
            if (need_f < (float)NT0) { int n = (int)ceilf(need_f); n = n < 6 ? 6 : n; n = (n + 1) & ~1; NT = n < NT0 ? n : NT0; }
        }
        SOFTMAX(t + 1);
    }
    __syncthreads();
    VMW(); SWRITE_HV(1);
    SLOAD_K(nxt.K, nxt.P0 + QB - KVBLK);
    SBAR(); mcluster<1>(pX0, pX1, o, kad0, kad1, kad2, kad3, vb0, S.qr, AB(NT - 1), slope2, pa0, pa1, pa2, pa3); SBAR();
    __syncthreads();
#pragma unroll
    for (int d0 = 0; d0 < 4; ++d0) S.qr[d0] = load8(nxt.Q + (size_t)(wid * QBLK + r32) * ZP + d0 * 16 + hi * 8);
    SBAR();
    SOFTMAX(NT - 1);
    if (!grpB) __builtin_amdgcn_s_barrier();
    pv_tile<1>(o, vb0, pa0, pa1, pa2, pa3); SBAR();
    VMW(); SWRITE_HK(0);
    { const int kbn = nxt.P0 + QB - KVBLK; SLOAD_K(nxt.K, kbn - KVBLK); SLOAD_V(nxt.V, kbn); }
    SBAR();
    if (hi == 0) li_l[r32] = l_reg; asm volatile("s_waitcnt lgkmcnt(0)" ::: "memory");
    float rli[16];
#pragma unroll
    for (int r = 0; r < 16; ++r) rli[r] = __builtin_amdgcn_rcpf(li_l[crow(r, hi)]);
    unsigned* stash = (unsigned*)(lds + LDS_STASH) + wid * 2048 + lane;
    if (cur.mode == 0) {
#pragma unroll
        for (int r = 0; r < 16; ++r) { stash[(r * 2 + 0) * 64] = cvt_pk_bf16(o[0][r] * rli[r], o[1][r] * rli[r]); stash[(r * 2 + 1) * 64] = cvt_pk_bf16(o[2][r] * rli[r], o[3][r] * rli[r]); }
    } else {
        float ssq[16];
#pragma unroll
        for (int r = 0; r < 16; ++r) { const unsigned w0 = stash[(r * 2 + 0) * 64], w1 = stash[(r * 2 + 1) * 64];
            o[0][r] = bf_lo(w0) - lam * (o[0][r] * rli[r]); o[1][r] = bf_hi(w0) - lam * (o[1][r] * rli[r]);
            o[2][r] = bf_lo(w1) - lam * (o[2][r] * rli[r]); o[3][r] = bf_hi(w1) - lam * (o[3][r] * rli[r]);
            ssq[r] = (o[0][r] * o[0][r] + o[1][r] * o[1][r]) + (o[2][r] * o[2][r] + o[3][r] * o[3][r]); }
#pragma unroll
        for (int r = 0; r < 16; ++r) {
#pragma unroll
            for (int off = 1; off < 32; off <<= 1) ssq[r] += __shfl_xor(ssq[r], off);
            ssq[r] = __builtin_amdgcn_rsqf(ssq[r] * (1.0f / DV) + RMS_EPS); }
        float g4[4];
#pragma unroll
        for (int d0 = 0; d0 < 4; ++d0) g4[d0] = subln[d0 * 32 + r32] * 0.8f;
        bf16_t* Ow = cur.O + (size_t)(wid * QBLK) * DM;
#pragma unroll
        for (int r = 0; r < 16; ++r) { const int orow = crow(r, hi);
#pragma unroll
            for (int d0 = 0; d0 < 4; ++d0) { const float v = o[d0][r] * ssq[r] * g4[d0]; const float vn = __shfl_xor(v, 1);
                if ((r32 & 1) == 0) *(unsigned*)(Ow + (size_t)orow * DM + d0 * 32 + r32) = cvt_pk_bf16(v, vn); } }
    }
    __syncthreads();
#undef RESC
#undef KBASE
#undef AB
#undef MASKT
#undef SOFTMAX
#undef MATRIX
}
#undef ROWV
#undef ROWK
#undef VMW
#undef VMWN
#undef SLOAD_K
#undef SLOAD_V
#undef SWRITE_HK
#undef SWRITE_HV
#undef SBAR
}

struct AttnPlan { unsigned char list[32][24]; unsigned char cnt[32]; };
constexpr int attn_cost(int combo) { const int h = combo >> 5, qb = combo & 31; const int cap = h == 0 ? 7 : (h == 1 ? 15 : (h == 2 ? 46 : 128)); int st = 4 * (qb + 1); st = st < cap ? st : cap; return 2 * (15 * st + 200); }
constexpr AttnPlan make_attn_plan() {
    AttnPlan p{}; int load[32] = {}; bool used[128] = {};
    for (int i = 0; i < 128; ++i) { int best = -1; for (int j = 0; j < 128; ++j) if (!used[j] && (best < 0 || attn_cost(j) > attn_cost(best))) best = j;
        used[best] = true; int bin = 0; for (int b = 1; b < 32; ++b) if (load[b] < load[bin]) bin = b;
        if (p.cnt[bin] < 24) { p.list[bin][p.cnt[bin]] = (unsigned char)best; p.cnt[bin] = (unsigned char)(p.cnt[bin] + 1); } load[bin] += attn_cost(best); }
    return p;
}
__device__ const AttnPlan kAttnPlan = make_attn_plan();

#define XB_TMO      128
#define XB_XCNT(j)  (256  + 64 * (j))
#define XB_XSUB(j)  (1280 + 64 * (j))
#define XB_XGEN(j)  (2304 + 64 * (j))
#define XB_TOP      3328
#define XB_TOPGEN   3392
#define XCD_BAR_WORDS 3456
#define XB_SPIN_CAP (1u << 22)
__device__ __forceinline__ unsigned xb_ld(unsigned* p)              { return __hip_atomic_load(p, __ATOMIC_RELAXED, __HIP_MEMORY_SCOPE_AGENT); }
__device__ __forceinline__ unsigned xb_add(unsigned* p, unsigned v) { return __hip_atomic_fetch_add(p, v, __ATOMIC_RELAXED, __HIP_MEMORY_SCOPE_AGENT); }
__device__ __forceinline__ unsigned xb_xcc_id() { return (unsigned)__builtin_amdgcn_s_getreg((3 << 11) | 20) & 0xFu; }
#define XB_SPIN(cond, bar) do { unsigned _sp = 0; while (cond) { __builtin_amdgcn_s_sleep(1); \
    if ((++_sp & 255u) == 0u) { if (xb_ld(&(bar)[XB_TMO])) break; if (_sp > XB_SPIN_CAP) { atomicAdd(&(bar)[XB_TMO], 1u); break; } } } } while (0)
struct XcdBarrier { unsigned* bar; unsigned x; volatile LAS unsigned* st; };
__device__ __forceinline__ XcdBarrier xcd_barrier_post(unsigned* bar, volatile LAS unsigned* st, bool t0) {
    XcdBarrier b; b.bar = bar; b.x = xb_xcc_id(); b.st = st;
    if (t0) (void)xb_add(&bar[XB_XCNT(b.x)], 1u);
    return b;
}
__device__ __forceinline__ void xcd_barrier_complete(unsigned* bar, unsigned x, unsigned& nloc, unsigned& nx) {
    const unsigned G = gridDim.x;
    unsigned sum, cnt, mine, sp = 0u;
    for (;;) {
        sum = 0u; cnt = 0u; mine = 0u;
#pragma unroll
        for (unsigned j = 0; j < 16; ++j) { const unsigned c = xb_ld(&bar[XB_XCNT(j)]); sum += c; cnt += (c > 0u) ? 1u : 0u; mine = (j == x) ? c : mine; }
        if (sum == G) break;
        __builtin_amdgcn_s_sleep(1);
        if ((++sp & 255u) == 0u) { if (xb_ld(&bar[XB_TMO])) break; if (sp > XB_SPIN_CAP) { atomicAdd(&bar[XB_TMO], 1u); break; } }
    }
    nloc = mine > 0u ? mine : 1u; nx = cnt > 0u ? cnt : 1u;
}
__device__ __forceinline__ void xcd_barrier(const XcdBarrier& b, bool t0) {
    asm volatile("s_waitcnt vmcnt(0)" ::: "memory");
    __syncthreads();
    if (t0) {
        unsigned* bar = b.bar;
        __builtin_amdgcn_s_waitcnt(0);
        unsigned nloc = b.st[0], nx = b.st[1];
        if (nloc == 0u) { xcd_barrier_complete(bar, b.x, nloc, nx); b.st[0] = nloc; b.st[1] = nx; }
        const unsigned old = xb_add(&bar[XB_XSUB(b.x)], 1u);
        const unsigned gen = old / nloc;
        if (old + 1u == (gen + 1u) * nloc) {
            __builtin_amdgcn_fence(__ATOMIC_RELEASE, "agent");
            asm volatile("s_waitcnt vmcnt(0)" ::: "memory");
            const unsigned og = xb_add(&bar[XB_TOP], 1u);
            const unsigned tg = og / nx;
            if (og + 1u == (tg + 1u) * nx) xb_add(&bar[XB_TOPGEN], 1u);
            else XB_SPIN(xb_ld(&bar[XB_TOPGEN]) == tg, bar);
            __builtin_amdgcn_fence(__ATOMIC_ACQUIRE, "agent");
            xb_add(&bar[XB_XGEN(b.x)], 1u);
            asm volatile("s_waitcnt vmcnt(0)" ::: "memory");
        } else {
            XB_SPIN(xb_ld(&bar[XB_XGEN(b.x)]) == gen, bar);
            __builtin_amdgcn_fence(__ATOMIC_ACQUIRE, "agent");
            asm volatile("s_waitcnt vmcnt(0)" ::: "memory");
        }
    }
    __syncthreads();
}
constexpr int NWAVES = 8, NTHR = 512;
constexpr int LDS_BYTES = 163840;
struct Args {
    const float* in[28]; float* out; unsigned char* ws; int ph_lo, ph_hi;
};
constexpr int N_PHASES = 15;

struct Frame {
    LAS unsigned char* lds; int wave, vcu, G;
};

__device__ __forceinline__ void transpose_item(const float* W, int ldw, int k0, int n0, bf16_t* dst, int ldt, const float* kscale, LAS float* scr, int lane) {
    f32x4 v[8]; const int kr = lane >> 3, n4 = (lane & 7) * 4;
#pragma unroll
    for (int i = 0; i < 8; ++i) v[i] = __builtin_nontemporal_load((const f32x4*)(W + (size_t)(k0 + i * 8 + kr) * ldw + n0 + n4));
#pragma unroll
    for (int i = 0; i < 8; ++i) { const int kk = i * 8 + kr; f32x4 x = v[i]; if (kscale) x = x * kscale[k0 + kk];
        scr[kk * 33 + n4 + 0] = x[0]; scr[kk * 33 + n4 + 1] = x[1]; scr[kk * 33 + n4 + 2] = x[2]; scr[kk * 33 + n4 + 3] = x[3]; }
    asm volatile("s_waitcnt lgkmcnt(0)" ::: "memory");
    const int c = lane & 7;
#pragma unroll
    for (int j = 0; j < 4; ++j) { const int n = (lane >> 3) + 8 * j; const LAS float* s = scr + (8 * c) * 33 + n;
        u32x4 o; o.x = cvt_pk_bf16(s[0 * 33], s[1 * 33]); o.y = cvt_pk_bf16(s[2 * 33], s[3 * 33]); o.z = cvt_pk_bf16(s[4 * 33], s[5 * 33]); o.w = cvt_pk_bf16(s[6 * 33], s[7 * 33]);
        *(u32x4*)(dst + (size_t)n * ldt + k0 + 8 * c) = o; }
    asm volatile("s_waitcnt lgkmcnt(0)" ::: "memory");
}
__device__ __forceinline__ void transpose_item_fp8(const float* W, int ldw, int k0, int n0, unsigned char* dst, int ldt, float scale, const float* kscale, LAS float* scr, int lane) {
    f32x4 v[8]; const int kr = lane >> 3, n4 = (lane & 7) * 4;
#pragma unroll
    for (int i = 0; i < 8; ++i) v[i] = __builtin_nontemporal_load((const f32x4*)(W + (size_t)(k0 + i * 8 + kr) * ldw + n0 + n4));
#pragma unroll
    for (int i = 0; i < 8; ++i) { const int kk = i * 8 + kr; const f32x4 x = v[i] * (kscale ? scale * kscale[k0 + kk] : scale);
        scr[kk * 33 + n4 + 0] = x[0]; scr[kk * 33 + n4 + 1] = x[1]; scr[kk * 33 + n4 + 2] = x[2]; scr[kk * 33 + n4 + 3] = x[3]; }
    asm volatile("s_waitcnt lgkmcnt(0)" ::: "memory");
    const int n = lane >> 1, kh = (lane & 1) * 32; const LAS float* s = scr + kh * 33 + n;
    u32x4 o0, o1;
    o0.x = pk4_fp8(s[0 * 33], s[1 * 33], s[2 * 33], s[3 * 33]); o0.y = pk4_fp8(s[4 * 33], s[5 * 33], s[6 * 33], s[7 * 33]); o0.z = pk4_fp8(s[8 * 33], s[9 * 33], s[10 * 33], s[11 * 33]); o0.w = pk4_fp8(s[12 * 33], s[13 * 33], s[14 * 33], s[15 * 33]);
    o1.x = pk4_fp8(s[16 * 33], s[17 * 33], s[18 * 33], s[19 * 33]); o1.y = pk4_fp8(s[20 * 33], s[21 * 33], s[22 * 33], s[23 * 33]); o1.z = pk4_fp8(s[24 * 33], s[25 * 33], s[26 * 33], s[27 * 33]); o1.w = pk4_fp8(s[28 * 33], s[29 * 33], s[30 * 33], s[31 * 33]);
    __builtin_nontemporal_store(o0, (u32x4*)(dst + (size_t)n * ldt + k0 + kh)); __builtin_nontemporal_store(o1, (u32x4*)(dst + (size_t)n * ldt + k0 + kh + 16));
    asm volatile("s_waitcnt lgkmcnt(0)" ::: "memory");
}
__device__ __forceinline__ void rms_rows2_to_bf16(const float* xa, const float* xb, const float* g, bf16_t* oa, bf16_t* ob, int lane) {
    const f32x4* ra = (const f32x4*)xa + lane; const f32x4* rb = (const f32x4*)xb + lane; const f32x4* gr = (const f32x4*)g + lane;
    f32x4 va[4], vb[4]; float sa = 0.f, sb = 0.f;
#pragma unroll
    for (int j = 0; j < 4; ++j) { va[j] = __builtin_nontemporal_load(ra + 64 * j); vb[j] = __builtin_nontemporal_load(rb + 64 * j); }
#pragma unroll
    for (int j = 0; j < 4; ++j) { sa += (va[j].x * va[j].x + va[j].y * va[j].y) + (va[j].z * va[j].z + va[j].w * va[j].w); sb += (vb[j].x * vb[j].x + vb[j].y * vb[j].y) + (vb[j].z * vb[j].z + vb[j].w * vb[j].w); }
    const float rsa = __builtin_amdgcn_rsqf(wave_sum(sa) * (1.f / DM) + RMS_EPS), rsb = __builtin_amdgcn_rsqf(wave_sum(sb) * (1.f / DM) + RMS_EPS);
    u32x2* pa = (u32x2*)oa + lane; u32x2* pb = (u32x2*)ob + lane;
#pragma unroll
    for (int j = 0; j < 4; ++j) { const f32x4 gg = gr[64 * j]; u32x2 w;
        w.x = cvt_pk_bf16(va[j].x * rsa * gg.x, va[j].y * rsa * gg.y); w.y = cvt_pk_bf16(va[j].z * rsa * gg.z, va[j].w * rsa * gg.w); pa[64 * j] = w;
        w.x = cvt_pk_bf16(vb[j].x * rsb * gg.x, vb[j].y * rsb * gg.y); w.y = cvt_pk_bf16(vb[j].z * rsb * gg.z, vb[j].w * rsb * gg.w); pb[64 * j] = w; }
}

__global__ void __launch_bounds__(NTHR, 2) mega(Args args) {
    extern __shared__ __attribute__((aligned(16))) unsigned char lds_raw[];
    Frame F; F.lds = (LAS unsigned char*)lds_raw; F.wave = __builtin_amdgcn_readfirstlane(threadIdx.x >> 6);
    F.G = gridDim.x; { const int bx = blockIdx.x; F.vcu = (F.G % 8 == 0) ? (bx % 8) * (F.G / 8) + bx / 8 : bx; }
    unsigned char* ws = args.ws;
    unsigned* ctl = (unsigned*)(ws + WS_CTL);
    const float* x = args.in[0]; float* out = args.out;
    bf16_t* Win_t = (bf16_t*)(ws + WS_WIN); bf16_t* Wout_t = (bf16_t*)(ws + WS_WOUT); bf16_t* Wq_t = (bf16_t*)(ws + WS_WQ); bf16_t* Wkv_t = (bf16_t*)(ws + WS_WKV);
    bf16_t* Wo_t = (bf16_t*)(ws + WS_WO); bf16_t* Wr_t = (bf16_t*)(ws + WS_WR); bf16_t* Wsgu = (bf16_t*)(ws + WS_WSGU); bf16_t* memn = (bf16_t*)(ws + WS_MEMN);
    bf16_t* Km = (bf16_t*)(ws + WS_KM); bf16_t* Vt = (bf16_t*)(ws + WS_VT); bf16_t* Wgu_t = (bf16_t*)(ws + WS_WGU); bf16_t* Wd_t = (bf16_t*)(ws + WS_WD);
    bf16_t* Z = (bf16_t*)(ws + WS_RA); bf16_t* Qm = (bf16_t*)(ws + WS_RA); bf16_t* Sc = (bf16_t*)(ws + WS_RA + 128 * MiB); bf16_t* xg = (bf16_t*)(ws + WS_RA); bf16_t* yb = (bf16_t*)(ws + WS_RA);
    bf16_t* XN = (bf16_t*)(ws + WS_RB); bf16_t* AO = (bf16_t*)(ws + WS_RB); bf16_t* Om = (bf16_t*)(ws + WS_RB); bf16_t* act = (bf16_t*)(ws + WS_RB);
    bf16_t* x1b = (bf16_t*)(ws + WS_RC); bf16_t* x2b = (bf16_t*)(ws + WS_RC); unsigned char* x2f8 = ws + WS_X2F8;
    float* ssq1 = (float*)(ws + WS_SSQ1); float* ssq2 = (float*)(ws + WS_SSQ2); float* rstd2 = (float*)(ws + WS_SSQ1);     float* logit = (float*)(ws + WS_LOGIT);
    float* tok_w = (float*)(ws + WS_TOKW); int* tok_s = (int*)(ws + WS_TOKS); int* slot_tok = (int*)(ws + WS_SLOTTOK); float* slot_rs = (float*)(ws + WS_SLOTTOK + SLOT_RS_OFF);
    const int gw = F.vcu * NWAVES + F.wave, NGW = F.G * NWAVES;
    const int lo = args.ph_lo, hi = args.ph_hi;
#define IN(k) (lo <= (k) && (k) < hi)
#if MK_ONE_LAUNCH
    volatile LAS unsigned* misc = (volatile LAS unsigned*)(F.lds + LDS_MISC);
    if (threadIdx.x < 64) misc[threadIdx.x] = 0u;
    __syncthreads();
    XcdBarrier xbar = xcd_barrier_post(ctl + CW_BAR, misc + 8, threadIdx.x == 0);
    if (args.ph_hi > 4096) cg::this_grid().sync();
#define GRID_BAR(k) do { if (IN(k) && IN((k) + 1)) xcd_barrier(xbar, F.wave == 0 && lane_id() == 0); } while (0)
#else
#define GRID_BAR(k) do { } while (0)
#endif
#define LOCAL_SEAM() do { asm volatile("s_waitcnt vmcnt(0)" ::: "memory"); __syncthreads(); __builtin_amdgcn_fence(__ATOMIC_ACQUIRE, "agent"); asm volatile("s_waitcnt vmcnt(0)" ::: "memory"); __syncthreads(); } while (0)

    if (IN(0)) {
        const int lane_ = lane_id(), tid_ = F.wave * 64 + lane_; (void)tid_;
        LAS float* scr = (LAS float*)(F.lds + F.wave * 16384);
        constexpr int I_IN = 16 * 80, I_SQ = 16 * 32, I_KV = 16 * 64, I_G = 16 * 16, I_D = 8 * 32;
        constexpr int NITEMS = I_IN + 3 * I_SQ + I_KV + NEXP * (2 * I_G + I_D);
        for (int it = gw; it < NITEMS; it += NGW) {
            int r = it;
            if (r < I_IN) { const int kb = r / 80, nb = r % 80; transpose_item(args.in[3], ZP, kb * 64, nb * 32, Win_t + (size_t)(nb * 32) * DM, DM, nullptr, scr, lane_); continue; } r -= I_IN;
            if (r < I_SQ) { const int kb = r / 32, nb = r % 32; transpose_item(args.in[13], DM, kb * 64, nb * 32, Wout_t + (size_t)(nb * 32) * DM, DM, nullptr, scr, lane_); continue; } r -= I_SQ;
            if (r < I_SQ) { const int kb = r / 32, nb = r % 32; transpose_item_fp8(args.in[16], DM, kb * 64, nb * 32, (unsigned char*)Wq_t + (size_t)(nb * 32) * DM, DM, F8_WSCALE, args.in[14], scr, lane_); continue; } r -= I_SQ;
            if (r < I_KV) { const int kb = r / 64, nb = r % 64; transpose_item(args.in[17], 2 * DM, kb * 64, nb * 32, Wkv_t + (size_t)(nb * 32) * DM, DM, nullptr, scr, lane_); continue; } r -= I_KV;
            if (r < I_SQ) { const int kb = r / 32, nb = r % 32; transpose_item_fp8(args.in[18], DM, kb * 64, nb * 32, (unsigned char*)Wo_t + (size_t)(nb * 32) * DM, DM, F8_WSCALE, nullptr, scr, lane_); continue; } r -= I_SQ;
            const int e = r / (2 * I_G + I_D); r -= e * (2 * I_G + I_D);
            if (r < 2 * I_G) { const int up = r >= I_G; if (up) r -= I_G; const int kb = r / 16, nb = r % 16, n0 = nb * 32;
                const float* W = (up ? args.in[25] : args.in[24]) + (size_t)e * DM * DEXP;
                transpose_item_fp8(W, DEXP, kb * 64, n0, (unsigned char*)Wgu_t + ((size_t)e * 1024 + (n0 >> 7) * 256 + 64 * ((n0 & 127) >> 5) + 32 * up) * DM, DM, F8_WSCALE, args.in[19], scr, lane_); continue; }
            r -= 2 * I_G;
            { const int kb = r / 32, nb = r % 32; transpose_item_fp8(args.in[26] + (size_t)e * DEXP * DM, DM, kb * 64, nb * 32, (unsigned char*)Wd_t + ((size_t)e * 1024 + nb * 32) * DEXP, DEXP, F8_WSCALE, nullptr, scr, lane_); }
        }
        for (int i = blockIdx.x * NTHR + tid_; i < 256 * DM; i += F.G * NTHR) { const int n = i >> 10, k = i & 1023; float v = 0.f;
            if (n < 4) v = args.in[20][k * 4 + n] * args.in[19][k]; else if (n < 36) v = args.in[22][k * 32 + (n - 4)] * args.in[19][k];
            Wr_t[i] = (bf16_t)(cvt_pk_bf16(v, 0.f) & 0xffffu); }
        for (int i = blockIdx.x * NTHR + tid_; i < 4 * 128 * 128; i += F.G * NTHR) { const int t = (i >> 7) & 127, s = i & 127; const float v = s <= t ? args.in[6][i] : 0.f; Wsgu[i] = (bf16_t)(cvt_pk_bf16(v, 0.f) & 0xffffu); }
        for (int m = gw; m < M; m += 2 * NGW) rms_rows2_to_bf16(x + (size_t)m * DM, x + (size_t)(m + NGW) * DM, args.in[2], XN + (size_t)m * DM, XN + (size_t)(m + NGW) * DM, lane_);
        for (int m = gw; m < MROWS / 2; m += NGW) rms_rows2_to_bf16(args.in[1] + (size_t)m * DM, args.in[1] + (size_t)(m + MROWS / 2) * DM, args.in[15], memn + (size_t)m * DM, memn + (size_t)(m + MROWS / 2) * DM, lane_);
        __syncthreads();
    }
    GRID_BAR(0);

    if (IN(1)) {
        { pg8::Gemm g{DM, DM, DM}; pg8::PlainSched S; S.to.init(M / 256, ZP / 256, F.G, (int)blockIdx.x); S.A = (const char*)XN; S.B = (const char*)Win_t; S.tA = (size_t)256 * DM * 2; S.tB = (size_t)256 * DM * 2;
          pg8::EpiZ E{Z, ctl + CW_KMX}; pg8::gemm_phase(F.lds, F.wave, g, S, E); }
    }
    GRID_BAR(1);

    if (IN(2)) {
        const int lane_ = lane_id(), tid_ = F.wave * 64 + lane_; (void)tid_;
        float lam;
        { const float a = args.in[8][lane_] * args.in[9][lane_], b = args.in[10][lane_] * args.in[11][lane_];
          lam = __expf(wave_sum(a)) - __expf(wave_sum(b)) + 0.2f; }
        {
            LAS float* kmt = (LAS float*)(F.lds + da::LDS_CX + 64);
            const int b = (F.G == 256) ? (F.vcu >> 5) : 0, r = F.vcu & 31;
            if (tid_ < 8) { const unsigned* kp = ctl + CW_KMX + ((b * 4 + (tid_ >> 1)) * 2 + (tid_ & 1)) * 2; kmt[tid_] = 1.01f * sqrtf(__uint_as_float(ld_u32_agent(kp)) + __uint_as_float(ld_u32_agent(kp + 1))); }
            __syncthreads();
            const int nit = (F.G == 256) ? (int)kAttnPlan.cnt[r] : 0;
#define COMBO_OF(i) ((int)__builtin_amdgcn_readfirstlane((int)kAttnPlan.list[r][(i)]))
            if (nit > 0) {
                int ii = 0, pass = 0, combo = COMBO_OF(0); da::BlockRef cur = da::mkref(Z, AO, (const float*)kmt, b, combo, 0); da::Seam S;
                da::prime(cur, (char*)lds_raw, S, F.wave);
                for (;;) {
                    int ni = ii, np = pass + 1; if (np == 2) { np = 0; ni = ii + 1; }
                    const bool last = ni >= nit * PROBE_DUP_ATTN;
                    int ncombo = combo; if (!last && np == 0) ncombo = COMBO_OF(ni % nit);
                    const da::BlockRef nxt = last ? cur : da::mkref(Z, AO, (const float*)kmt, b, ncombo, np);
                    da::block(cur, nxt, (char*)lds_raw, S, lam, args.in[12], F.wave);
                    if (last) break;
                    cur = nxt; ii = ni; pass = np; combo = ncombo;
                }
            }
#undef COMBO_OF
        }
        __syncthreads();
        {
            int e = -1;
            if (F.G == 256) { const int b = F.vcu >> 5, r = F.vcu & 31; if (r >= 16 && r < 24) e = b * 8 + (r - 16); }
            for (int e2 = (F.G == 256 ? e : F.vcu); e2 >= 0 && e2 < 64; e2 = (F.G == 256 ? 64 : e2 + F.G)) {
                pg8::Gemm g{DM, DM, DM}; pg8::OneUnitSched S;
                if (e2 < 32) { S.u0.pm = e2 >> 2; S.u0.pn = e2 & 3; S.u0.aux = 0; S.u0.rows = nullptr; S.u0.A = (const char*)(memn + (size_t)S.u0.pm * 256 * DM); S.u0.B = (const char*)(Wkv_t + (size_t)S.u0.pn * 256 * DM);
                    pg8::EpiF8 E{(unsigned char*)Km, DM, nullptr, F8_KSCALE}; pg8::gemm_phase(F.lds, F.wave, g, S, E); }
                else { const int e3 = e2 - 32; S.u0.pm = e3 >> 3; S.u0.pn = e3 & 7; S.u0.aux = 0; S.u0.rows = nullptr; S.u0.A = (const char*)(Wkv_t + (size_t)(1024 + S.u0.pm * 256) * DM); S.u0.B = (const char*)(memn + (size_t)S.u0.pn * 256 * DM);
                    pg8::EpiF8 E{(unsigned char*)Vt, MROWS, nullptr, F8_VSCALE}; pg8::gemm_phase(F.lds, F.wave, g, S, E); }
            }
        }
        __syncthreads();
        {
            const int lane = lane_, w = F.wave;
            const int nun = (M / 128) * 4;
            const int ch0 = (lane & 15) * 8, t = 16 * w + (lane & 15), nks = (w + 2) >> 1;
            u32x4 vr[4];
            LAS int* sq = (LAS int*)(F.lds + 2 * 34816);
            const bool puller = (w == 0 && lane == 0);
            if (puller) { sq[0] = (int)atomicAdd(ctl + CW_SGUQ, 1u); sq[1] = (int)atomicAdd(ctl + CW_SGUQ, 1u); }
            __syncthreads();
            int uidx = __builtin_amdgcn_readfirstlane(sq[0]), unext = __builtin_amdgcn_readfirstlane(sq[1]), kk = 0;
            if (uidx < nun) { const size_t R0 = (size_t)(uidx >> 2) * 128; const int g = uidx & 3;
#pragma unroll
                for (int ps = 0; ps < 4; ++ps) vr[ps] = *(const u32x4*)(Z + (R0 + 16 * w + 4 * ps + (lane >> 4)) * ZP + ZV + g * 128 + ch0); }
            int gcur = -1; float lg[8], lb[8]; bf16x8 wf[4]; float bias = 0.f; int buf = 0;
#pragma unroll
            for (int j = 0; j < 8; ++j) { lg[j] = 0.f; lb[j] = 0.f; }
#pragma unroll
            for (int ks = 0; ks < 4; ++ks) wf[ks] = (bf16x8){0, 0, 0, 0, 0, 0, 0, 0};
            for (; uidx < nun; uidx = unext, unext = __builtin_amdgcn_readfirstlane(sq[(kk + 1) & 3]), buf ^= 1) {
                int pulled_ = 0; if (puller) pulled_ = (int)atomicAdd(ctl + CW_SGUQ, 1u);
                const int c = uidx >> 2, g = uidx & 3; const size_t R0 = (size_t)c * 128;
                LAS bf16_t* vnT = (LAS bf16_t*)(F.lds + buf * 34816);
                if (g != gcur) { gcur = g;
#pragma unroll
                    for (int j = 0; j < 8; ++j) { lg[j] = args.in[4][g * 128 + ch0 + j]; lb[j] = args.in[5][g * 128 + ch0 + j]; }
#pragma unroll
                    for (int ks = 0; ks < 4; ++ks) if (ks < nks) wf[ks] = *(const bf16x8*)(Wsgu + ((size_t)g * 128 + t) * 128 + ks * 32 + 8 * (lane >> 4));
                    bias = args.in[7][g * 128 + t]; }
#pragma unroll
                for (int ps = 0; ps < 4; ++ps) { const int sr = 16 * w + 4 * ps + (lane >> 4); const u32x4 raw = vr[ps];
                    float v[8] = {bf_lo(raw.x), bf_hi(raw.x), bf_lo(raw.y), bf_hi(raw.y), bf_lo(raw.z), bf_hi(raw.z), bf_lo(raw.w), bf_hi(raw.w)};
                    float sm = 0.f;
#pragma unroll
                    for (int j = 0; j < 8; ++j) sm += v[j];
#pragma unroll
                    for (int o = 1; o < 16; o <<= 1) sm += __shfl_xor(sm, o);
                    const float mu = sm * (1.f / 128.f); float q = 0.f;
#pragma unroll
                    for (int j = 0; j < 8; ++j) { v[j] -= mu; q += v[j] * v[j]; }
#pragma unroll
                    for (int o = 1; o < 16; o <<= 1) q += __shfl_xor(q, o);
                    const float rstd = __builtin_amdgcn_rsqf(q * (1.f / 128.f) + LN_EPS);
#pragma unroll
                    for (int j = 0; j < 8; ++j) { const float y = v[j] * rstd * lg[j] + lb[j]; vnT[(ch0 + j) * 136 + sr] = (bf16_t)(cvt_pk_bf16(y, 0.f) & 0xffffu); } }
                u32x2 ur[8];
#pragma unroll
                for (int mi = 0; mi < 8; ++mi) ur[mi] = *(const u32x2*)(Z + (R0 + t) * ZP + ZU + g * 128 + 16 * mi + 4 * (lane >> 4));
                { const int un = unext; if (un < nun) { const size_t Rn = (size_t)(un >> 2) * 128; const int gn = un & 3;
#pragma unroll
                    for (int ps = 0; ps < 4; ++ps) vr[ps] = *(const u32x4*)(Z + (Rn + 16 * w + 4 * ps + (lane >> 4)) * ZP + ZV + gn * 128 + ch0); } }
                if (puller) sq[(kk + 2) & 3] = pulled_;
                ++kk;
                __syncthreads();
                f32x4 acc[8];
#pragma unroll
                for (int mi = 0; mi < 8; ++mi) acc[mi] = (f32x4){0.f, 0.f, 0.f, 0.f};
#pragma unroll
                for (int ks = 0; ks < 4; ++ks) if (ks < nks) {
#pragma unroll
                    for (int mi = 0; mi < 8; ++mi) { const bf16x8 afr = *(const LAS bf16x8*)(vnT + (16 * mi + (lane & 15)) * 136 + ks * 32 + 8 * (lane >> 4));
                        acc[mi] = __builtin_amdgcn_mfma_f32_16x16x32_bf16(afr, wf[ks], acc[mi], 0, 0, 0); } }
#pragma unroll
                for (int mi = 0; mi < 8; ++mi) { const int ch = 16 * mi + 4 * (lane >> 4); const u32x2 u2 = ur[mi];
                    const float o0 = bf_lo(u2.x) * (acc[mi][0] + bias), o1 = bf_hi(u2.x) * (acc[mi][1] + bias), o2 = bf_lo(u2.y) * (acc[mi][2] + bias), o3 = bf_hi(u2.y) * (acc[mi][3] + bias);
                    u32x2 wv; wv.x = cvt_pk_bf16(o0, o1); wv.y = cvt_pk_bf16(o2, o3);
                    *(u32x2*)(AO + (R0 + t) * DM + g * 128 + ch) = wv; }
            }
            __syncthreads();
        }
    }
    GRID_BAR(2);

    if (IN(3)) {
        pg8::Gemm g{DM, DM, DM}; pg8::PlainSched S; S.to.init(M / 256, 4, F.G, (int)blockIdx.x); S.A = (const char*)AO; S.B = (const char*)Wout_t; S.tA = (size_t)256 * DM * 2; S.tB = (size_t)256 * DM * 2;
        pg8::EpiResid<false> E{x, x1b, ssq1, (LAS float*)(F.lds + 131072 + 1024), x2f8, 1.f}; pg8::gemm_phase(F.lds, F.wave, g, S, E);
    }
    GRID_BAR(3);

    if (IN(4)) {
        pg8::Gemm g{DM / 2, DM / 2, DM / 2}; pg8::PlainSched S; S.to.init(M / 256, 4, F.G, (int)blockIdx.x); S.A = (const char*)x2f8; S.B = (const char*)Wq_t; S.tA = (size_t)256 * DM; S.tB = (size_t)256 * DM;
        pg8::EpiF8 E{(unsigned char*)Qm, DM, ssq1, F8_QSCALE * C2_MEM / (F8_XSCALE * F8_WSCALE)}; pg8::gemm_phase<pg8::EpiF8, pg8::PlainSched, false, true>(F.lds, F.wave, g, S, E);
    }
    if (MK_ONE_LAUNCH && IN(4) && IN(5)) LOCAL_SEAM();

    if (IN(5)) {
        pg8::Gemm g{DM / 2, DM / 2, 128}; pg8::MemAttnSched S; S.to.init(M / 256, 4, F.G, (int)blockIdx.x); S.A = (const char*)Qm; S.B = (const char*)Km; S.tA = (size_t)256 * DM; S.hA = 256; S.bB = (size_t)256 * DM; S.hB = 256;
        pg8::EpiSoftmax E{(unsigned char*)Sc, (LAS float*)(F.lds + LDS_MISC + 1024), 1.0f / (F8_QSCALE * F8_KSCALE)}; pg8::gemm_phase<pg8::EpiSoftmax, pg8::MemAttnSched, false, true>(F.lds, F.wave, g, S, E);
    }
    if (MK_ONE_LAUNCH && IN(5) && IN(6 + 1)) LOCAL_SEAM();

    if (IN(7)) {
        pg8::Gemm g{DM / 2, MROWS / 2, 128}; pg8::MemAttnSched S; S.to.init(M / 256, 4, F.G, (int)blockIdx.x); S.A = (const char*)Sc; S.B = (const char*)Vt; S.tA = (size_t)256 * DM; S.hA = 256; S.bB = 256; S.hB = (size_t)256 * MROWS;
        pg8::EpiF8 E{(unsigned char*)Om, DM, nullptr, F8_OSCALE / (F8_PSCALE * F8_VSCALE)}; pg8::gemm_phase<pg8::EpiF8, pg8::MemAttnSched, false, true>(F.lds, F.wave, g, S, E);
    }
    GRID_BAR(7);

    if (IN(8)) {
        pg8::Gemm g{DM / 2, DM / 2, DM / 2}; pg8::PlainSched S; S.to.init(M / 256, 4, F.G, (int)blockIdx.x); S.A = (const char*)Om; S.B = (const char*)Wo_t; S.tA = (size_t)256 * DM; S.tB = (size_t)256 * DM;
        pg8::EpiResid<true> E{x1b, x2b, ssq2, (LAS float*)(F.lds + 131072 + 1024), x2f8, 1.0f / (F8_OSCALE * F8_WSCALE)}; pg8::gemm_phase<pg8::EpiResid<true>, pg8::PlainSched, false, true>(F.lds, F.wave, g, S, E);
    }
    GRID_BAR(8);

    if (IN(9)) {
        pg8::Gemm g{DM, DM, DM}; pg8::PlainSched S; S.to.init(M / 256, 1, F.G, (int)blockIdx.x); S.A = (const char*)x2b; S.B = (const char*)Wr_t; S.tA = (size_t)256 * DM * 2; S.tB = 0;
        pg8::EpiRouter E{logit, ssq2, args.in[21], args.in[23], rstd2}; pg8::gemm_phase(F.lds, F.wave, g, S, E);
    }
    if (MK_ONE_LAUNCH && IN(9) && IN(10)) LOCAL_SEAM();

    if (IN(10)) {
        const int lane_ = lane_id(), tid_ = F.wave * 64 + lane_; (void)tid_;
        LAS unsigned* lcnt = (LAS unsigned*)F.lds; LAS unsigned* lbase = lcnt + 32;
        pg8::TileOrder to10; to10.init(M / 256, 1, F.G, (int)blockIdx.x);
        int pm10 = 0, pn10 = 0;
        for (int i10 = 0; to10.get(i10, pm10, pn10); ++i10) {
            if (tid_ < 32) lcnt[tid_] = 0u;
            __syncthreads();
            const int tok = pm10 * 256 + (tid_ & 255); const bool act_ = tid_ < 256;
            const f32x4 lg = *(const f32x4*)(logit + (size_t)tok * 64);
            int gi = 0; float gm = lg[0];
#pragma unroll
            for (int j = 1; j < 4; ++j) if (lg[j] > gm) { gm = lg[j]; gi = j; }
            float gs = 0.f;
#pragma unroll
            for (int j = 0; j < 4; ++j) gs += __expf(lg[j] - gm);
            const float gate = 1.0f / gs;
            const f32x4 ea = *(const f32x4*)(logit + (size_t)tok * 64 + 4 + gi * 8), eb = *(const f32x4*)(logit + (size_t)tok * 64 + 8 + gi * 8);
            const float el[8] = {ea[0], ea[1], ea[2], ea[3], eb[0], eb[1], eb[2], eb[3]};
            int i0 = 0; float m0 = el[0];
#pragma unroll
            for (int j = 1; j < 8; ++j) if (el[j] > m0) { m0 = el[j]; i0 = j; }
            int i1 = -1; float m1 = -__builtin_inff();
#pragma unroll
            for (int j = 0; j < 8; ++j) if (j != i0 && el[j] > m1) { m1 = el[j]; i1 = j; }
            if (i1 < 0) i1 = (i0 == 0) ? 1 : 0;
            const float r = __expf(m1 - m0);
            const float w0 = gate / (1.0f + r), w1 = gate * r / (1.0f + r);
            const int e0 = gi * 8 + i0, e1 = gi * 8 + i1;
            unsigned r0 = 0u, r1 = 0u; if (act_) { r0 = atomicAdd((unsigned*)&lcnt[e0], 1u); r1 = atomicAdd((unsigned*)&lcnt[e1], 1u); }
            __syncthreads();
            if (tid_ < 32) lbase[tid_] = atomicAdd(ctl + CW_CNT + tid_, lcnt[tid_]);
            __syncthreads();
            if (act_) { const unsigned s0 = lbase[e0] + r0, s1 = lbase[e1] + r1; const float rsx = rstd2[tok] * (1.0f / (F8_XSCALE * F8_WSCALE));
                tok_w[tok * 2] = w0; tok_w[tok * 2 + 1] = w1; tok_s[tok * 2] = (int)(((unsigned)e0 << 16) | s0); tok_s[tok * 2 + 1] = (int)(((unsigned)e1 << 16) | s1);
                slot_tok[(size_t)e0 * 65536 + s0] = tok; slot_tok[(size_t)e1 * 65536 + s1] = tok; slot_rs[(size_t)e0 * 65536 + s0] = rsx; slot_rs[(size_t)e1 * 65536 + s1] = rsx; }
            __syncthreads();
        }
    }
    GRID_BAR(10);

    LAS unsigned* lps = (LAS unsigned*)(F.lds + LDS_MOE);
    if (IN(12) || IN(13) || IN(14)) {
        const int lane_ = lane_id(), tid_ = F.wave * 64 + lane_;
        if (F.wave == 0) {
            const unsigned c = lane_ < 32 ? ld_u32_agent(ctl + CW_CNT + lane_) : 0u; unsigned sc = (c + 255u) & ~255u;
#pragma unroll
            for (int d = 1; d < 32; d <<= 1) { const unsigned t = (unsigned)__shfl_up((int)sc, d); if (lane_ >= d) sc += t; }
            if (lane_ < 32) lps[lane_ + 1] = sc;
            if (lane_ == 0) lps[0] = 0u;
        }
        __syncthreads();
        for (int b = tid_; b < MAXBLK_MOE; b += NTHR) { int e = 0;
#pragma unroll 1
            for (int j = 1; j < 32; ++j) e += ((lps[j] >> 8) <= (unsigned)b) ? 1 : 0;
            lps[64 + b] = (unsigned)e; }
        __syncthreads();
    }

    if (IN(12)) {
        pg8::Gemm g{DM / 2, DM / 2, DM / 2}; pg8::MoeSched S{F.G, F.vcu, lps, (const char*)x2f8, (const char*)Wgu_t, (size_t)0, (size_t)1024 * DM, (size_t)256 * DM, slot_tok};
        pg8::EpiGateUp E{(unsigned char*)act}; pg8::gemm_phase<pg8::EpiGateUp, pg8::MoeSched, true, true>(F.lds, F.wave, g, S, E);
    }
    GRID_BAR(12);

    if (IN(13)) {
        pg8::Gemm g{DEXP / 2, DEXP / 2, DEXP / 2}; pg8::MoeSched S{F.G, F.vcu, lps, (const char*)act, (const char*)Wd_t, (size_t)256 * DEXP, (size_t)1024 * DEXP, (size_t)256 * DEXP, slot_tok};
        pg8::EpiF8 E{(unsigned char*)yb, DM, nullptr, F8_YSCALE / (F8_WSCALE * F8_ASCALE)}; pg8::gemm_phase<pg8::EpiF8, pg8::MoeSched, false, true>(F.lds, F.wave, g, S, E);
    }
    GRID_BAR(13);

    if (IN(14)) {
        const int lane_ = lane_id(), tid_ = F.wave * 64 + lane_; (void)tid_;
        const f32x4* gr = (const f32x4*)args.in[27] + lane_;
        f32x4 gg[4];
#pragma unroll
        for (int j = 0; j < 4; ++j) gg[j] = gr[64 * j];
        for (int m = gw; m < M; m += 2 * NGW) {
            const int ma = m, mb = m + NGW;
            const unsigned sa0 = (unsigned)tok_s[ma * 2], sa1 = (unsigned)tok_s[ma * 2 + 1], sb0 = (unsigned)tok_s[mb * 2], sb1 = (unsigned)tok_s[mb * 2 + 1];
            const int pa0 = (int)(lps[sa0 >> 16] + (sa0 & 65535u)), pa1 = (int)(lps[sa1 >> 16] + (sa1 & 65535u)), pb0 = (int)(lps[sb0 >> 16] + (sb0 & 65535u)), pb1 = (int)(lps[sb1 >> 16] + (sb1 & 65535u));
            const float wa0 = tok_w[ma * 2], wa1 = tok_w[ma * 2 + 1], wb0 = tok_w[mb * 2], wb1 = tok_w[mb * 2 + 1];
            const u32x2* xa = (const u32x2*)(x2b + (size_t)ma * DM) + lane_; const u32x2* xb = (const u32x2*)(x2b + (size_t)mb * DM) + lane_;
            const unsigned* ya0 = (const unsigned*)((const unsigned char*)yb + (size_t)pa0 * DM) + lane_; const unsigned* ya1 = (const unsigned*)((const unsigned char*)yb + (size_t)pa1 * DM) + lane_;
            const unsigned* yb0 = (const unsigned*)((const unsigned char*)yb + (size_t)pb0 * DM) + lane_; const unsigned* yb1 = (const unsigned*)((const unsigned char*)yb + (size_t)pb1 * DM) + lane_;
            u32x2 ca[4], cb[4]; unsigned a0[4], a1[4], b0[4], b1[4];
#pragma unroll
            for (int j = 0; j < 4; ++j) { ca[j] = xa[64 * j]; cb[j] = xb[64 * j]; a0[j] = ya0[64 * j]; a1[j] = ya1[64 * j]; b0[j] = yb0[64 * j]; b1[j] = yb1[64 * j]; }
            f32x4 va[4], vb[4]; float sa = 0.f, sb = 0.f;
            const float ka0 = wa0 * (1.0f / F8_YSCALE), ka1 = wa1 * (1.0f / F8_YSCALE), kb0 = wb0 * (1.0f / F8_YSCALE), kb1 = wb1 * (1.0f / F8_YSCALE);
#pragma unroll
            for (int j = 0; j < 4; ++j) {
                const f32x2 p0 = __builtin_amdgcn_cvt_pk_f32_fp8(a0[j], false), p1 = __builtin_amdgcn_cvt_pk_f32_fp8(a0[j], true), q0 = __builtin_amdgcn_cvt_pk_f32_fp8(a1[j], false), q1 = __builtin_amdgcn_cvt_pk_f32_fp8(a1[j], true);
                const f32x2 r0 = __builtin_amdgcn_cvt_pk_f32_fp8(b0[j], false), r1 = __builtin_amdgcn_cvt_pk_f32_fp8(b0[j], true), t0 = __builtin_amdgcn_cvt_pk_f32_fp8(b1[j], false), t1 = __builtin_amdgcn_cvt_pk_f32_fp8(b1[j], true);
                va[j].x = bf_lo(ca[j].x) + ka0 * p0.x + ka1 * q0.x; va[j].y = bf_hi(ca[j].x) + ka0 * p0.y + ka1 * q0.y; va[j].z = bf_lo(ca[j].y) + ka0 * p1.x + ka1 * q1.x; va[j].w = bf_hi(ca[j].y) + ka0 * p1.y + ka1 * q1.y;
                vb[j].x = bf_lo(cb[j].x) + kb0 * r0.x + kb1 * t0.x; vb[j].y = bf_hi(cb[j].x) + kb0 * r0.y + kb1 * t0.y; vb[j].z = bf_lo(cb[j].y) + kb0 * r1.x + kb1 * t1.x; vb[j].w = bf_hi(cb[j].y) + kb0 * r1.y + kb1 * t1.y;
                sa += (va[j].x * va[j].x + va[j].y * va[j].y) + (va[j].z * va[j].z + va[j].w * va[j].w); sb += (vb[j].x * vb[j].x + vb[j].y * vb[j].y) + (vb[j].z * vb[j].z + vb[j].w * vb[j].w); }
            const float ra = __builtin_amdgcn_rsqf(wave_sum(sa) * (1.f / DM) + RMS_EPS), rb = __builtin_amdgcn_rsqf(wave_sum(sb) * (1.f / DM) + RMS_EPS);
            f32x4* oa = (f32x4*)(out + (size_t)ma * DM) + lane_; f32x4* ob = (f32x4*)(out + (size_t)mb * DM) + lane_;
#pragma unroll
            for (int j = 0; j < 4; ++j) { oa[64 * j] = va[j] * ra * gg[j]; ob[64 * j] = vb[j] * rb * gg[j]; }
        }
    }
#undef IN
#undef GRID_BAR
}

extern "C" void kernel_launch(void* const* d_in, const int* in_sizes, int n_in, void* d_out, int out_size, void* d_ws, size_t ws_size, hipStream_t stream) {
    static int grid = 0;
    if (grid == 0) {
        if (n_in != 28 || in_sizes[0] != M * DM || out_size != M * DM || ws_size < WS_END) { fprintf(stderr, "kernel_launch: unexpected shapes (n_in %d in0 %d out %d ws %zu)\n", n_in, n_in > 0 ? in_sizes[0] : -1, out_size, ws_size); grid = -1; return; }
        int dev = 0, cus = 0, per_cu = 0;
        if (hipGetDevice(&dev) != hipSuccess || hipDeviceGetAttribute(&cus, hipDeviceAttributeMultiprocessorCount, dev) != hipSuccess) { grid = -1; return; }
        if (hipFuncSetAttribute((const void*)mega, hipFuncAttributeMaxDynamicSharedMemorySize, LDS_BYTES) != hipSuccess) { fprintf(stderr, "kernel_launch: hipFuncSetAttribute failed\n"); grid = -1; return; }
        if (hipOccupancyMaxActiveBlocksPerMultiprocessor(&per_cu, (const void*)mega, NTHR, LDS_BYTES) != hipSuccess || per_cu < 1) { fprintf(stderr, "kernel_launch: occupancy query says %d\n", per_cu); per_cu = 1; }
        (void)hipGetLastError();
        grid = cus;
    }
    if (grid < 0) return;
    (void)hipMemsetAsync((char*)d_ws + WS_CTL, 0, CTL_BYTES, stream);
    Args a{};
    for (int i = 0; i < 28; ++i) a.in[i] = (const float*)d_in[i];
    a.out = (float*)d_out; a.ws = (unsigned char*)d_ws;
#if MK_ONE_LAUNCH
    a.ph_lo = 0; a.ph_hi = N_PHASES;
    void* kargs[] = {&a};
    hipError_t e = hipLaunchCooperativeKernel((const void*)mega, dim3(grid), dim3(NTHR), kargs, LDS_BYTES, stream);
    if (e != hipSuccess) fprintf(stderr, "cooperative launch failed: %s (grid %d)\n", hipGetErrorString(e), grid);
#else
    for (int p = 0; p < N_PHASES; ++p) { a.ph_lo = p; a.ph_hi = p + 1; hipLaunchKernelGGL(mega, dim3(grid), dim3(NTHR), LDS_BYTES, stream, a); }
#endif
}
```

```cpp
#include <hip/hip_runtime.h>
#include <hip/hip_cooperative_groups.h>
#include <cstdio>
#include <cstdint>
namespace cg = cooperative_groups;

#ifndef PROBE_DUP
#define PROBE_DUP -1
#endif
#ifndef PROBE_DUP_ATTN
#define PROBE_DUP_ATTN 1
#endif
#ifndef MK_ONE_LAUNCH
#define MK_ONE_LAUNCH 1
#endif

#define LAS __attribute__((address_space(3)))
#define GAS __attribute__((address_space(1)))
typedef unsigned short bf16_t;
typedef short bf16x8 __attribute__((ext_vector_type(8)));
typedef short s16x4 __attribute__((ext_vector_type(4)));
typedef float f32x2 __attribute__((ext_vector_type(2)));
typedef float f32x4 __attribute__((ext_vector_type(4)));
typedef float f32x16 __attribute__((ext_vector_type(16)));
typedef unsigned u32x2 __attribute__((ext_vector_type(2)));
typedef unsigned u32x4 __attribute__((ext_vector_type(4)));
typedef int v8i32 __attribute__((ext_vector_type(8)));

constexpr int NB = 8, SEQ = 8192, DM = 1024, M = NB * SEQ;
constexpr int ZP = 2560;
constexpr int ZU = 0, ZV = 512, ZQ = 1024, ZK = 1536, ZVAL = 2048;
constexpr int MEML = 256, MROWS = NB * MEML;
constexpr int NEXP = 32, DEXP = 512;
constexpr int PROWS = 2 * M + NEXP * 256;
constexpr int MAXBLK = PROWS / 256;
constexpr float RMS_EPS = 1e-6f, LN_EPS = 1e-5f;
constexpr float LOG2E = 1.4426950408889634f;
constexpr float C2_DIFF = 0.125f * LOG2E;
constexpr float C2_MEM = 0.0625f * LOG2E;

constexpr size_t MiB = 1u << 20;
constexpr size_t WS_CTL = 0, CTL_BYTES = 1 * MiB;
constexpr size_t WS_WIN = 1 * MiB;
constexpr size_t WS_WOUT = 6 * MiB;
constexpr size_t WS_WQ = 8 * MiB;
constexpr size_t WS_WKV = 10 * MiB;
constexpr size_t WS_WO = 14 * MiB;
constexpr size_t WS_WR = 16 * MiB;
constexpr size_t WS_WSGU = 17 * MiB;
constexpr size_t WS_MEMN = 18 * MiB;
constexpr size_t WS_KM = 22 * MiB;
constexpr size_t WS_VT = 26 * MiB;
constexpr size_t WS_WGU = 30 * MiB;
constexpr size_t WS_WD = 94 * MiB;
constexpr size_t WS_RA = 128 * MiB;
constexpr size_t WS_RB = 448 * MiB;
constexpr size_t WS_RC = 592 * MiB;
constexpr size_t WS_SSQ1 = 720 * MiB;
constexpr size_t WS_SSQ2 = 724 * MiB;
constexpr size_t WS_LOGIT = 728 * MiB;
constexpr size_t WS_TOKE = 744 * MiB;
constexpr size_t WS_TOKW = 745 * MiB;
constexpr size_t WS_TOKS = 746 * MiB;
constexpr size_t WS_ROWTOK = 747 * MiB;
constexpr size_t WS_X2F8 = 752 * MiB;
constexpr size_t WS_SLOTTOK = 816 * MiB;
constexpr size_t SLOT_RS_OFF = 8 * MiB;
constexpr size_t WS_END = 832 * MiB;
constexpr int CW_CNT = 64;
constexpr int CW_NBLK = 128;
constexpr int CW_PSTART = 192;
constexpr int CW_BLKE = 256;
constexpr int CW_KMX = 1024;
constexpr int CW_SGUQ = 1344;
constexpr int CW_ALIST = 8192;
constexpr int CW_BAR = 4096;
constexpr int LDS_MISC = 131072;
constexpr int LDS_MOE = 158720;
constexpr int MAXBLK_MOE = 544;
constexpr int LDS_TBUF = 140288, TBUF_W = 2304;

__device__ __forceinline__ unsigned cvt_pk_bf16(float lo, float hi) { unsigned r; asm volatile("v_cvt_pk_bf16_f32 %0, %1, %2" : "=v"(r) : "v"(lo), "v"(hi)); return r; }
__device__ __forceinline__ float bf_lo(unsigned w) { return __uint_as_float(w << 16); }
__device__ __forceinline__ float bf_hi(unsigned w) { return __uint_as_float(w & 0xffff0000u); }
constexpr float F8_WSCALE = 256.f, F8_ASCALE = 8.f, F8_XSCALE = 4.f, F8_OSCALE = 16.f, F8_YSCALE = 16.f, F8_QSCALE = 64.f, F8_KSCALE = 16.f, F8_PSCALE = 256.f, F8_VSCALE = 16.f;
__device__ __forceinline__ unsigned pk4_fp8(float a, float b, float c, float d) {
    a = fminf(fmaxf(a, -448.f), 448.f); b = fminf(fmaxf(b, -448.f), 448.f); c = fminf(fmaxf(c, -448.f), 448.f); d = fminf(fmaxf(d, -448.f), 448.f);
    int w = 0; w = __builtin_amdgcn_cvt_pk_fp8_f32(a, b, w, false); w = __builtin_amdgcn_cvt_pk_fp8_f32(c, d, w, true); return (unsigned)w; }
__device__ __forceinline__ float wave_sum(float v) {
#pragma unroll
    for (int o = 1; o < 64; o <<= 1) v += __shfl_xor(v, o);
    return v;
}
__device__ __forceinline__ float wave_max(float v) {
#pragma unroll
    for (int o = 1; o < 64; o <<= 1) v = fmaxf(v, __shfl_xor(v, o));
    return v;
}
__device__ __forceinline__ int lane_id() { int l; asm volatile("v_mbcnt_lo_u32_b32 %0, -1, 0\n\tv_mbcnt_hi_u32_b32 %0, -1, %0" : "=v"(l)); return l; }
__device__ __forceinline__ unsigned ld_u32_agent(const unsigned* p) { return __hip_atomic_load(p, __ATOMIC_RELAXED, __HIP_MEMORY_SCOPE_AGENT); }

namespace pg8 {
constexpr unsigned GATHER_ROW_MASK = 65535u;
constexpr int BM = 256, BK = 64, HALF = 128, HTB = HALF * BK * 2, STAGE_BYTES = 8 * HTB, NXCD = 8, WGM = 8;
__host__ __device__ __forceinline__ int lds_byte(int r, int c) { const int st = (r >> 4) * 2 + (c >> 5), rr = r & 15, cc = c & 31, ob = rr * 64 + cc * 2; return st * 1024 + (ob ^ (((ob >> 9) & 1) << 5)); }
__host__ __device__ __forceinline__ void stage_rc(int b, int& R, int& C) { const int st = b / 1024, sb = b % 1024, swz = sb ^ (((sb >> 9) & 1) << 5); R = (st >> 1) * 16 + swz / 64; C = (st & 1) * 32 + (swz % 64) / 2; }
__host__ __device__ __forceinline__ int perm32(int rho) { const int n = rho >> 4, i = rho & 15; return 8 * (i >> 2) + 4 * n + (i & 3); }

struct Unit { const char* A; const char* B; int pm, pn, aux; const int* rows; };
struct Gemm { int lda, ldb, K; };

struct TileOrder {
    int nM, nN, nwg, G, c;
    __device__ __forceinline__ void init(int nM_, int nN_, int G_, int c_) { nM = nM_; nN = nN_; nwg = nM * nN; G = G_; c = c_; }
    __device__ __forceinline__ bool get(int i, int& pm, int& pn) const {
        const long L = (long)i * G + c; if (L >= nwg) return false;
        int wgid = (int)L; { const int q = nwg / NXCD, r = nwg % NXCD, xcd = wgid % NXCD, off = wgid / NXCD; wgid = (xcd < r ? xcd * (q + 1) : r * (q + 1) + (xcd - r) * q) + off; }
        const int nig = WGM * nN, gid = wgid / nig, fm = gid * WGM, gsz = (nM - fm) < WGM ? (nM - fm) : WGM;
        pm = fm + ((wgid % nig) % gsz); pn = (wgid % nig) / gsz; return true;
    }
};

typedef float f32x2g __attribute__((ext_vector_type(2)));
__device__ __forceinline__ f32x2g gelu_pk(f32x2g v) {
    const f32x2g av = __builtin_elementwise_abs(v), d = av * 0.2316418882f + 1.0f;
    f32x2g t; t.x = __builtin_amdgcn_rcpf(d.x); t.y = __builtin_amdgcn_rcpf(d.y);
    f32x2g q = t * 0.5307027145f + (-0.7265760135f); q = q * t + 0.7107068705f; q = q * t + (-0.142248368f); q = q * t + 0.127414796f; q = q * t;
    const f32x2g s = (v * v) * (-0.72134752044f);
    f32x2g e; e.x = __builtin_amdgcn_exp2f(s.x); e.y = __builtin_amdgcn_exp2f(s.y);
    const f32x2g m = v * (q * e), r = v - m;
    f32x2g o; o.x = v.x < 0.f ? m.x : r.x; o.y = v.y < 0.f ? m.y : r.y; return o;
}

__device__ __forceinline__ const char* uniform_ptr(const char* p) { const unsigned long long v = (unsigned long long)p; const unsigned lo = __builtin_amdgcn_readfirstlane((unsigned)v), hi = __builtin_amdgcn_readfirstlane((unsigned)(v >> 32)); return (const char*)(((unsigned long long)hi << 32) | lo); }
template <class Epi, class Sched, bool GATHER = false, bool FP8 = false>
__device__ __forceinline__ void gemm_phase(LAS unsigned char* lds, int wid, const Gemm g, const Sched& S, const Epi& E) {
    const int lane = lane_id(), tid = wid * 64 + lane, wr = wid >> 2, wc = wid & 3, fr = lane & 15, fq = lane >> 4;
    const int nt = g.K / BK;
    unsigned voffB[2]; unsigned vA0[2], vA1[2]; int RA[2], CA[2];
#pragma unroll
    for (int i = 0; i < 2; ++i) { int R, C; stage_rc(tid * 16 + i * 8192, R, C); const int pr = Epi::PERM ? perm32(R & 31) : (R & 31);
        RA[i] = R; CA[i] = C; voffB[i] = (unsigned)((64 * (R >> 5) + pr) * g.ldb + C) * 2u;
        vA0[i] = (unsigned)(R * g.lda + C) * 2u; vA1[i] = vA0[i]; }
    const size_t kstep = (size_t)(BK * 2);
    const size_t hstepA = GATHER ? (size_t)0 : (size_t)HALF * g.lda * 2, hstepB = (size_t)32 * g.ldb * 2;
    LAS u32x4* park = (LAS u32x4*)(lds + 131072 + 1024) + tid;
#define PG8_GOFF(U, d0, d1) do { _Pragma("unroll") for (int _i = 0; _i < 2; ++_i) { \
        d0[_i] = (((unsigned)(U).rows[RA[_i]] & GATHER_ROW_MASK) * (unsigned)g.lda + (unsigned)CA[_i]) * 2u; d1[_i] = (((unsigned)(U).rows[HALF + RA[_i]] & GATHER_ROW_MASK) * (unsigned)g.lda + (unsigned)CA[_i]) * 2u; } } while (0)
    const unsigned ldsw = (unsigned)wid * 1024u;
    const int aoff = lds_byte(wr * 64 + fr, fq * 8), boff = lds_byte(wc * 32 + fr, fq * 8);
#define PG8_SA(b, h) (((b) * 2 + (h)) * HTB)
#define PG8_SB(b, h) ((4 + (b) * 2 + (h)) * HTB)
#define PG8_STAGE(bufoff, gbase, voff) do { _Pragma("unroll") for (int _i = 0; _i < 2; ++_i) \
        __builtin_amdgcn_global_load_lds((const unsigned*)((const char*)(gbase) + (voff)[_i]), (LAS unsigned*)(lds + (bufoff) + ldsw + _i * 8192), 16, 0, 0); } while (0)
#define PG8_LD8(dst_, addr_) do { const u32x4 lo_ = *(const LAS u32x4*)(addr_), hi_ = *(const LAS u32x4*)((addr_) + 1024); \
        dst_ = (v8i32){(int)lo_.x, (int)lo_.y, (int)lo_.z, (int)lo_.w, (int)hi_.x, (int)hi_.y, (int)hi_.z, (int)hi_.w}; } while (0)
#define PG8_LDA(dst, b, h) do { _Pragma("unroll") for (int m = 0; m < 4; ++m) PG8_LD8(dst[m], lds + PG8_SA(b, h) + aoff + m * 2048); } while (0)
#define PG8_LDB(dst, b, h) do { _Pragma("unroll") for (int n = 0; n < 2; ++n) PG8_LD8(dst[n], lds + PG8_SB(b, h) + boff + n * 2048); } while (0)
#define PG8_HALF(v_, k_) __builtin_bit_cast(bf16x8, __builtin_shufflevector(v_, v_, 4 * (k_) + 0, 4 * (k_) + 1, 4 * (k_) + 2, 4 * (k_) + 3))
#define PG8_MMA(ai, bj, At, Bt) do { __builtin_amdgcn_s_setprio(1); _Pragma("unroll") for (int m = 0; m < 4; ++m) _Pragma("unroll") for (int n = 0; n < 2; ++n) { \
        if constexpr (FP8) asm volatile("v_mfma_scale_f32_16x16x128_f8f6f4 %0, %1, %2, %0, %3, %3 op_sel_hi:[0,0,0]" : "+v"(acc[ai][bj][m][n]) : "v"(Bt[n]), "v"(At[m]), "v"(one8_));   \
        else { acc[ai][bj][m][n] = __builtin_amdgcn_mfma_f32_16x16x32_bf16(PG8_HALF(Bt[n], 0), PG8_HALF(At[m], 0), acc[ai][bj][m][n], 0, 0, 0); \
               acc[ai][bj][m][n] = __builtin_amdgcn_mfma_f32_16x16x32_bf16(PG8_HALF(Bt[n], 1), PG8_HALF(At[m], 1), acc[ai][bj][m][n], 0, 0, 0); } } \
        __builtin_amdgcn_s_setprio(0); } while (0)
#define PG8_WAIT_V(n) asm volatile("s_waitcnt vmcnt(" #n ")" ::: "memory")
#define PG8_WAIT_L(n) asm volatile("s_waitcnt lgkmcnt(" #n ")" ::: "memory")
#define PG8_BAR __builtin_amdgcn_s_barrier()
#define PG8_SCHED __builtin_amdgcn_sched_barrier(0)
    Unit cur, nxt; int ui = 0;
    if (!S.next(0, cur)) return;
    f32x4 acc[2][2][4][2];
#pragma unroll
    for (int a = 0; a < 2; ++a)
#pragma unroll
        for (int b = 0; b < 2; ++b)
#pragma unroll
            for (int m = 0; m < 4; ++m)
#pragma unroll
                for (int n = 0; n < 2; ++n) acc[a][b][m][n] = (f32x4){0.f, 0.f, 0.f, 0.f};
    v8i32 At[4], B0[2], B1[2];
    const int one8_ = 0x7f7f7f7f;
    const char* cA = uniform_ptr(cur.A); const char* cB = uniform_ptr(cur.B);
    if constexpr (GATHER) { PG8_GOFF(cur, vA0, vA1); }
    PG8_STAGE(PG8_SB(0, 0), cB, voffB); PG8_STAGE(PG8_SB(0, 1), cB + hstepB, voffB); PG8_STAGE(PG8_SA(0, 0), cA, vA0); PG8_STAGE(PG8_SA(0, 1), cA + hstepA, vA1);
    if (wr == 1) PG8_BAR;
    PG8_WAIT_V(2); PG8_BAR;
    PG8_STAGE(PG8_SB(1, 0), cB + kstep, voffB); PG8_STAGE(PG8_SA(1, 0), cA + kstep, vA0); PG8_STAGE(PG8_SB(1, 1), cB + hstepB + kstep, voffB);
    PG8_WAIT_V(6); PG8_BAR;
    for (;;) {
        const bool has_next = S.next(ui + 1, nxt);
        const char* nA = has_next ? uniform_ptr(nxt.A) : cA; const char* nB = has_next ? uniform_ptr(nxt.B) : cB;
        if constexpr (GATHER) { unsigned n0[2] = {vA0[0], vA0[1]}, n1[2] = {vA1[0], vA1[1]}; if (has_next) { PG8_GOFF(nxt, n0, n1); } *park = (u32x4){n0[0], n0[1], n1[0], n1[1]}; }
#pragma nounroll
        for (int t = 0; t < nt; t += 2) {
            const bool last = (t == nt - 2);
            const char* a1 = cA + (size_t)(t + 1) * kstep;
            const char* a2 = uniform_ptr(last ? nA : cA + (size_t)(t + 2) * kstep); const char* b2 = uniform_ptr(last ? nB : cB + (size_t)(t + 2) * kstep);
            const char* a3 = a2 + kstep; const char* b3 = b2 + kstep;
            unsigned w0[2] = {vA0[0], vA0[1]}, w1[2] = {vA1[0], vA1[1]};
            if constexpr (GATHER) { if (last) { const u32x4 pk = *park; w0[0] = pk.x; w0[1] = pk.y; w1[0] = pk.z; w1[1] = pk.w; } }
            PG8_LDB(B0, 0, 0); PG8_LDB(B1, 0, 1); PG8_SCHED; PG8_LDA(At, 0, 0); PG8_STAGE(PG8_SA(1, 1), a1 + hstepA, vA1);
            PG8_WAIT_V(8); PG8_WAIT_L(0); PG8_BAR; PG8_MMA(0, 0, At, B0); PG8_MMA(0, 1, At, B1); PG8_BAR; PG8_SCHED;
            PG8_LDA(At, 0, 1); PG8_STAGE(PG8_SB(0, 0), b2, voffB); PG8_STAGE(PG8_SB(0, 1), b2 + hstepB, voffB); PG8_STAGE(PG8_SA(0, 0), a2, w0);
            PG8_WAIT_V(8); PG8_WAIT_L(0); PG8_BAR; PG8_MMA(1, 0, At, B0); PG8_MMA(1, 1, At, B1); PG8_BAR; PG8_SCHED;
            PG8_LDB(B0, 1, 0); PG8_LDB(B1, 1, 1); PG8_SCHED; PG8_LDA(At, 1, 0); PG8_STAGE(PG8_SA(0, 1), a2 + hstepA, w1);
            PG8_WAIT_V(8); PG8_WAIT_L(0); PG8_BAR; PG8_MMA(0, 0, At, B0); PG8_MMA(0, 1, At, B1); PG8_BAR; PG8_SCHED;
            PG8_LDA(At, 1, 1); PG8_STAGE(PG8_SB(1, 0), b3, voffB); PG8_STAGE(PG8_SB(1, 1), b3 + hstepB, voffB); PG8_STAGE(PG8_SA(1, 0), a3, w0);
            PG8_WAIT_V(8); PG8_WAIT_L(0); PG8_BAR; PG8_MMA(1, 0, At, B0); PG8_MMA(1, 1, At, B1); PG8_BAR; PG8_SCHED;
        }
        if (wr == 0) PG8_BAR;
        if constexpr (FP8) asm volatile("s_nop 15\n\ts_nop 7" ::: "memory");
        asm volatile("" ::: "memory");
        { const int l2_ = lane_id(); E(acc, cur, wr, wc, l2_ & 15, l2_ >> 4, lds + LDS_TBUF + wid * TBUF_W); }
        if (!has_next) break;
#pragma unroll
        for (int a = 0; a < 2; ++a)
#pragma unroll
            for (int b = 0; b < 2; ++b)
#pragma unroll
                for (int m = 0; m < 4; ++m)
#pragma unroll
                    for (int n = 0; n < 2; ++n) acc[a][b][m][n] = (f32x4){0.f, 0.f, 0.f, 0.f};
        cur = nxt; cA = nA; cB = nB; ++ui;
        if constexpr (GATHER) { const u32x4 pk = *park; vA0[0] = pk.x; vA0[1] = pk.y; vA1[0] = pk.z; vA1[1] = pk.w; }
        if (wr == 1) PG8_BAR;
    }
    PG8_WAIT_V(0);
    PG8_BAR;
#undef PG8_GOFF
#undef PG8_SA
#undef PG8_SB
#undef PG8_STAGE
#undef PG8_LD8
#undef PG8_HALF
#undef PG8_LDA
#undef PG8_LDB
#undef PG8_MMA
#undef PG8_WAIT_V
#undef PG8_WAIT_L
#undef PG8_BAR
#undef PG8_SCHED
}

struct PlainSched {
    TileOrder to; const char* A; const char* B; size_t tA, tB;
    __device__ __forceinline__ bool next(int i, Unit& u) const { int pm, pn; if (!to.get(i, pm, pn)) return false; u.pm = pm; u.pn = pn; u.aux = 0; u.rows = nullptr; u.A = A + (size_t)pm * tA; u.B = B + (size_t)pn * tB; return true; }
};
struct OneUnitSched {
    Unit u0;
    __device__ __forceinline__ bool next(int i, Unit& u) const { if (i != 0) return false; u = u0; return true; }
};
struct MemAttnSched {
    TileOrder to; const char* A; const char* B; size_t tA, hA, bB, hB;
    __device__ __forceinline__ bool next(int i, Unit& u) const { int pm, pn; if (!to.get(i, pm, pn)) return false; u.pm = pm; u.pn = pn; u.aux = 0; u.rows = nullptr;
        u.A = A + (size_t)pm * tA + (size_t)pn * hA; const int b = pm >> 5; u.B = B + (size_t)b * bB + (size_t)pn * hB; return true; }
};
struct MoeSched {
    int G, c; const LAS unsigned* lps; const char* A; const char* B; size_t tA, eB, tB; const int* slots;
    __device__ __forceinline__ bool next(int i, Unit& u) const { const int L = i * G + c; const int nblk = (int)__builtin_amdgcn_readfirstlane(lps[32] >> 8); if (L >= nblk * 4) return false; const int rb = L >> 2, pn = L & 3;
        const int e = (int)__builtin_amdgcn_readfirstlane(lps[64 + rb]); const int s0 = (int)__builtin_amdgcn_readfirstlane(lps[e]); u.pm = rb; u.pn = pn; u.aux = e; u.rows = slots + (size_t)e * 65536 + (rb * 256 - s0);
        u.A = A + (size_t)rb * tA; u.B = B + (size_t)e * eB + (size_t)pn * tB; return true; }
};

#define EPI_ARGS f32x4 (&acc)[2][2][4][2], const Unit& u, int wr, int wc, int fr, int fq, LAS unsigned char* tb
__device__ __forceinline__ void st128(bf16_t* rowbase, size_t ldc, const u32x4 w0, const u32x4 w1, int fr, int fq, LAS unsigned char* tb) {
    *(LAS u32x4*)(tb + fr * 144 + fq * 16) = w0; *(LAS u32x4*)(tb + fr * 144 + 64 + fq * 16) = w1;
    const int L = fq * 16 + fr, r = L >> 3, c = L & 7;
    const u32x4 a = *(const LAS u32x4*)(tb + r * 144 + c * 16), b = *(const LAS u32x4*)(tb + (8 + r) * 144 + c * 16);
    *(u32x4*)(rowbase + (size_t)r * ldc + c * 8) = a; *(u32x4*)(rowbase + (size_t)(8 + r) * ldc + c * 8) = b;
}
__device__ __forceinline__ u32x4 pk8(const f32x4 v0, const f32x4 v1) { u32x4 w; w.x = cvt_pk_bf16(v0[0], v0[1]); w.y = cvt_pk_bf16(v0[2], v0[3]); w.z = cvt_pk_bf16(v1[0], v1[1]); w.w = cvt_pk_bf16(v1[2], v1[3]); return w; }
struct EpiZ {
    static constexpr bool PERM = true;
    bf16_t* O; unsigned* kmx;
    __device__ __forceinline__ void operator()(EPI_ARGS) const {
        const int mode = u.pn < 4 ? 1 : (u.pn < 6 ? 2 : 0);
        if (u.pn == 6 || u.pn == 7) {
#pragma unroll
            for (int bj = 0; bj < 2; ++bj) { float mx = 0.f;
#pragma unroll
                for (int ai = 0; ai < 2; ++ai)
#pragma unroll
                    for (int m = 0; m < 4; ++m) { const f32x4 a = acc[ai][bj][m][0], b = acc[ai][bj][m][1];
                        float q = (a[0] * a[0] + a[1] * a[1]) + (a[2] * a[2] + a[3] * a[3]) + (b[0] * b[0] + b[1] * b[1]) + (b[2] * b[2] + b[3] * b[3]);
                        q += __shfl_xor(q, 16); q += __shfl_xor(q, 32); mx = fmaxf(mx, q); }
#pragma unroll
                for (int o_ = 1; o_ < 16; o_ <<= 1) mx = fmaxf(mx, __shfl_xor(mx, o_));
                if (fr == 0 && fq == 0) { const int b_ = u.pm >> 5, h_ = (u.pn - 6) * 2 + (wc >> 1); atomicMax(kmx + (((b_ * 4 + h_) * 2 + (wc & 1)) * 2 + bj), __float_as_uint(mx)); } }
        }
#pragma unroll
        for (int ai = 0; ai < 2; ++ai)
#pragma unroll
            for (int m = 0; m < 4; ++m) { u32x4 w[2];
#pragma unroll
                for (int bj = 0; bj < 2; ++bj) { f32x4 v0 = acc[ai][bj][m][0], v1 = acc[ai][bj][m][1];
                    if (mode == 1) { f32x2g a = gelu_pk((f32x2g){v0[0], v0[1]}), b = gelu_pk((f32x2g){v0[2], v0[3]}), c = gelu_pk((f32x2g){v1[0], v1[1]}), d = gelu_pk((f32x2g){v1[2], v1[3]});
                        v0 = (f32x4){a.x, a.y, b.x, b.y}; v1 = (f32x4){c.x, c.y, d.x, d.y}; }
                    else if (mode == 2) { v0 = v0 * C2_DIFF; v1 = v1 * C2_DIFF; }
                    w[bj] = pk8(v0, v1); }
                st128(O + (size_t)(u.pm * BM + ai * HALF + wr * 64 + m * 16) * ZP + u.pn * BM + wc * 64, ZP, w[0], w[1], fr, fq, tb); }
    }
};
struct EpiBf16 {
    static constexpr bool PERM = true;
    bf16_t* O; int ldc; const float* ssq; float cscale;
    __device__ __forceinline__ void operator()(EPI_ARGS) const {
        float sc[2][4];
#pragma unroll
        for (int ai = 0; ai < 2; ++ai)
#pragma unroll
            for (int m = 0; m < 4; ++m) sc[ai][m] = cscale;
        if (ssq) {
#pragma unroll
            for (int ai = 0; ai < 2; ++ai)
#pragma unroll
                for (int m = 0; m < 4; ++m) { const f32x4 s4 = *(const f32x4*)(ssq + (size_t)(u.pm * BM + ai * HALF + wr * 64 + m * 16 + fr) * 4);
                    sc[ai][m] = cscale * __builtin_amdgcn_rsqf(((s4[0] + s4[1]) + (s4[2] + s4[3])) * (1.0f / DM) + RMS_EPS); }
        }
#pragma unroll
        for (int ai = 0; ai < 2; ++ai)
#pragma unroll
            for (int m = 0; m < 4; ++m) { const int rowg = u.pm * BM + ai * HALF + wr * 64 + m * 16; const float c = sc[ai][m];
                st128(O + (size_t)rowg * ldc + u.pn * BM + wc * 64, (size_t)ldc, pk8(acc[ai][0][m][0] * c, acc[ai][0][m][1] * c), pk8(acc[ai][1][m][0] * c, acc[ai][1][m][1] * c), fr, fq, tb); }
    }
};
struct EpiF8 {
    static constexpr bool PERM = true;
    unsigned char* O; int ldc; const float* ssq; float cscale;
    __device__ __forceinline__ void operator()(EPI_ARGS) const {
        const int L = fq * 16 + fr;
        float sc[2][4];
#pragma unroll
        for (int ai = 0; ai < 2; ++ai)
#pragma unroll
            for (int m = 0; m < 4; ++m) sc[ai][m] = cscale;
        if (ssq) {
#pragma unroll
            for (int ai = 0; ai < 2; ++ai)
#pragma unroll
                for (int m = 0; m < 4; ++m) { const f32x4 s4 = *(const f32x4*)(ssq + (size_t)(u.pm * BM + ai * HALF + wr * 64 + m * 16 + fr) * 4);
                    sc[ai][m] = cscale * __builtin_amdgcn_rsqf(((s4[0] + s4[1]) + (s4[2] + s4[3])) * (1.0f / DM) + RMS_EPS); }
        }
#pragma unroll
        for (int ai = 0; ai < 2; ++ai)
#pragma unroll
            for (int m = 0; m < 4; ++m) { const int rowg = u.pm * BM + ai * HALF + wr * 64 + m * 16; const float c = sc[ai][m];
#pragma unroll
                for (int bj = 0; bj < 2; ++bj) { const f32x4 a = acc[ai][bj][m][0] * c, b = acc[ai][bj][m][1] * c; u32x2 f; f.x = pk4_fp8(a[0], a[1], a[2], a[3]); f.y = pk4_fp8(b[0], b[1], b[2], b[3]);
                    *(LAS u32x2*)(tb + fr * 144 + bj * 32 + fq * 8) = f; }
                const u32x4 v8 = *(const LAS u32x4*)(tb + (L >> 2) * 144 + (L & 3) * 16);
                *(u32x4*)(O + (size_t)(rowg + (L >> 2)) * ldc + u.pn * BM + wc * 64 + (L & 3) * 16) = v8; }
    }
};
struct EpiSoftmax {
    static constexpr bool PERM = true;
    unsigned char* O; LAS float* xch; float sscale;
    __device__ __forceinline__ void operator()(EPI_ARGS) const {
        LAS float* xm = xch; LAS float* xs = xch + 1024;
#pragma unroll
        for (int ai = 0; ai < 2; ++ai)
#pragma unroll
            for (int bj = 0; bj < 2; ++bj)
#pragma unroll
                for (int m = 0; m < 4; ++m)
#pragma unroll
                    for (int n = 0; n < 2; ++n) acc[ai][bj][m][n] = acc[ai][bj][m][n] * sscale;
#pragma unroll
        for (int ai = 0; ai < 2; ++ai)
#pragma unroll
            for (int m = 0; m < 4; ++m) { float v = -__builtin_inff();
#pragma unroll
                for (int bj = 0; bj < 2; ++bj)
#pragma unroll
                    for (int n = 0; n < 2; ++n) { const f32x4 a = acc[ai][bj][m][n]; v = fmaxf(v, fmaxf(fmaxf(a[0], a[1]), fmaxf(a[2], a[3]))); }
                v = fmaxf(v, __shfl_xor(v, 16)); v = fmaxf(v, __shfl_xor(v, 32));
                if (fq == 0) xm[(ai * HALF + wr * 64 + m * 16 + fr) * 4 + wc] = v; }
        asm volatile("s_waitcnt lgkmcnt(0)" ::: "memory"); __builtin_amdgcn_s_barrier(); asm volatile("" ::: "memory");
#pragma unroll
        for (int ai = 0; ai < 2; ++ai)
#pragma unroll
            for (int m = 0; m < 4; ++m) { const f32x4 t = *(const LAS f32x4*)(xm + (ai * HALF + wr * 64 + m * 16 + fr) * 4); const float mx = fmaxf(fmaxf(t[0], t[1]), fmaxf(t[2], t[3])); float sm = 0.f;
#pragma unroll
                for (int bj = 0; bj < 2; ++bj)
#pragma unroll
                    for (int n = 0; n < 2; ++n) { f32x4 a = acc[ai][bj][m][n];
#pragma unroll
                        for (int j = 0; j < 4; ++j) { a[j] = __builtin_amdgcn_exp2f(a[j] - mx); sm += a[j]; }
                        acc[ai][bj][m][n] = a; }
                sm += __shfl_xor(sm, 16); sm += __shfl_xor(sm, 32);
                if (fq == 0) xs[(ai * HALF + wr * 64 + m * 16 + fr) * 4 + wc] = sm; }
        asm volatile("s_waitcnt lgkmcnt(0)" ::: "memory"); __builtin_amdgcn_s_barrier(); asm volatile("" ::: "memory");
#pragma unroll
        for (int ai = 0; ai < 2; ++ai)
#pragma unroll
            for (int m = 0; m < 4; ++m) { const f32x4 t = *(const LAS f32x4*)(xs + (ai * HALF + wr * 64 + m * 16 + fr) * 4); const float inv = F8_PSCALE * __builtin_amdgcn_rcpf((t[0] + t[1]) + (t[2] + t[3]));
                const int rowg = u.pm * BM + ai * HALF + wr * 64 + m * 16, L = fq * 16 + fr;
#pragma unroll
                for (int bj = 0; bj < 2; ++bj) { const f32x4 a = acc[ai][bj][m][0] * inv, b = acc[ai][bj][m][1] * inv; u32x2 f; f.x = pk4_fp8(a[0], a[1], a[2], a[3]); f.y = pk4_fp8(b[0], b[1], b[2], b[3]);
                    *(LAS u32x2*)(tb + fr * 144 + bj * 32 + fq * 8) = f; }
                const u32x4 v8 = *(const LAS u32x4*)(tb + (L >> 2) * 144 + (L & 3) * 16);
                *(u32x4*)(O + (size_t)(rowg + (L >> 2)) * DM + u.pn * BM + wc * 64 + (L & 3) * 16) = v8; }
    }
};
template <bool BF>
struct EpiResid {
    static constexpr bool PERM = true;
    const void* base; bf16_t* ob; float* ssq; LAS float* xs; unsigned char* o8; float as;
    __device__ __forceinline__ void operator()(EPI_ARGS) const {
        const int col0 = u.pn * BM + wc * 64 + 8 * fq;
        if constexpr (BF) {
            u32x4 br[2][4][2];
#pragma unroll
            for (int ai = 0; ai < 2; ++ai)
#pragma unroll
                for (int m = 0; m < 4; ++m)
#pragma unroll
                    for (int bj = 0; bj < 2; ++bj) br[ai][m][bj] = *(const u32x4*)((const bf16_t*)base + (size_t)(u.pm * BM + ai * HALF + wr * 64 + m * 16 + fr) * DM + col0 + bj * 32);
#pragma unroll
            for (int ai = 0; ai < 2; ++ai)
#pragma unroll
                for (int m = 0; m < 4; ++m) asm volatile("" : "+v"(br[ai][m][0]), "+v"(br[ai][m][1]));
#pragma unroll
            for (int ai = 0; ai < 2; ++ai)
#pragma unroll
                for (int m = 0; m < 4; ++m) { const int rowg = u.pm * BM + ai * HALF + wr * 64 + m * 16, row = rowg + fr; float s = 0.f; u32x4 w[2]; u32x2 f8[2];
#pragma unroll
                    for (int bj = 0; bj < 2; ++bj) { const u32x4 r = br[ai][m][bj];
                        const f32x4 o0 = (f32x4){bf_lo(r.x), bf_hi(r.x), bf_lo(r.y), bf_hi(r.y)} + acc[ai][bj][m][0] * as, o1 = (f32x4){bf_lo(r.z), bf_hi(r.z), bf_lo(r.w), bf_hi(r.w)} + acc[ai][bj][m][1] * as;
                        s += (o0[0] * o0[0] + o0[1] * o0[1]) + (o0[2] * o0[2] + o0[3] * o0[3]) + (o1[0] * o1[0] + o1[1] * o1[1]) + (o1[2] * o1[2] + o1[3] * o1[3]);
                        w[bj] = pk8(o0, o1);
                        f8[bj].x = pk4_fp8(o0[0] * F8_XSCALE, o0[1] * F8_XSCALE, o0[2] * F8_XSCALE, o0[3] * F8_XSCALE); f8[bj].y = pk4_fp8(o1[0] * F8_XSCALE, o1[1] * F8_XSCALE, o1[2] * F8_XSCALE, o1[3] * F8_XSCALE); }
                    st128(ob + (size_t)rowg * DM + u.pn * BM + wc * 64, (size_t)DM, w[0], w[1], fr, fq, tb);
                    if (o8) {
                        *(LAS u32x2*)(tb + fr * 144 + fq * 8) = f8[0]; *(LAS u32x2*)(tb + fr * 144 + 32 + fq * 8) = f8[1];
                        const int L = fq * 16 + fr; const u32x4 v8 = *(const LAS u32x4*)(tb + (L >> 2) * 144 + (L & 3) * 16);
                        *(u32x4*)(o8 + (size_t)(rowg + (L >> 2)) * DM + u.pn * BM + wc * 64 + (L & 3) * 16) = v8; }
                    s += __shfl_xor(s, 16); s += __shfl_xor(s, 32);
                    if (fq == 0) xs[(ai * HALF + wr * 64 + m * 16 + fr) * 4 + wc] = s; }
        } else {
#pragma unroll
            for (int ai = 0; ai < 2; ++ai) {
                f32x4 br[4][2][2];
#pragma unroll
                for (int m = 0; m < 4; ++m)
#pragma unroll
                    for (int bj = 0; bj < 2; ++bj) { const float* p = (const float*)base + (size_t)(u.pm * BM + ai * HALF + wr * 64 + m * 16 + fr) * DM + col0 + bj * 32; br[m][bj][0] = *(const f32x4*)p; br[m][bj][1] = *(const f32x4*)(p + 4); }
#pragma unroll
                for (int m = 0; m < 4; ++m) asm volatile("" : "+v"(br[m][0][0]), "+v"(br[m][0][1]), "+v"(br[m][1][0]), "+v"(br[m][1][1]));
#pragma unroll
                for (int m = 0; m < 4; ++m) { const int rowg = u.pm * BM + ai * HALF + wr * 64 + m * 16; float s = 0.f; u32x4 w[2]; u32x2 f8[2];
#pragma unroll
                    for (int bj = 0; bj < 2; ++bj) { const f32x4 o0 = br[m][bj][0] + acc[ai][bj][m][0] * as, o1 = br[m][bj][1] + acc[ai][bj][m][1] * as;
                        s += (o0[0] * o0[0] + o0[1] * o0[1]) + (o0[2] * o0[2] + o0[3] * o0[3]) + (o1[0] * o1[0] + o1[1] * o1[1]) + (o1[2] * o1[2] + o1[3] * o1[3]);
                        w[bj] = pk8(o0, o1);
                        f8[bj].x = pk4_fp8(o0[0] * F8_XSCALE, o0[1] * F8_XSCALE, o0[2] * F8_XSCALE, o0[3] * F8_XSCALE); f8[bj].y = pk4_fp8(o1[0] * F8_XSCALE, o1[1] * F8_XSCALE, o1[2] * F8_XSCALE, o1[3] * F8_XSCALE); }
                    st128(ob + (size_t)rowg * DM + u.pn * BM + wc * 64, (size_t)DM, w[0], w[1], fr, fq, tb);
                    if (o8) {
                        *(LAS u32x2*)(tb + fr * 144 + fq * 8) = f8[0]; *(LAS u32x2*)(tb + fr * 144 + 32 + fq * 8) = f8[1];
                        const int L = fq * 16 + fr; const u32x4 v8 = *(const LAS u32x4*)(tb + (L >> 2) * 144 + (L & 3) * 16);
                        *(u32x4*)(o8 + (size_t)(rowg + (L >> 2)) * DM + u.pn * BM + wc * 64 + (L & 3) * 16) = v8; }
                    s += __shfl_xor(s, 16); s += __shfl_xor(s, 32);
                    if (fq == 0) xs[(ai * HALF + wr * 64 + m * 16 + fr) * 4 + wc] = s; }
            }
        }
        asm volatile("s_waitcnt lgkmcnt(0)" ::: "memory"); __builtin_amdgcn_s_barrier(); asm volatile("" ::: "memory");
        { const int t_ = (wr * 4 + wc) * 64 + fq * 16 + fr;
          if (t_ < 256) { const f32x4 p = *(const LAS f32x4*)(xs + t_ * 4); ssq[(size_t)(u.pm * BM + t_) * 4 + u.pn] = (p[0] + p[1]) + (p[2] + p[3]); } }
    }
};
struct EpiRouter {
    static constexpr bool PERM = false;
    float* L; const float* ssq; const float* bg; const float* be; float* rstd_out;
    __device__ __forceinline__ void operator()(EPI_ARGS) const {
        if (wc != 0) return;
        const int row0 = u.pm * BM + wr * 64 + fr;
        float rsv[2][4];
#pragma unroll
        for (int ai = 0; ai < 2; ++ai)
#pragma unroll
            for (int m = 0; m < 4; ++m) { const f32x4 s4 = *(const f32x4*)(ssq + (size_t)(row0 + ai * HALF + m * 16) * 4);
                rsv[ai][m] = __builtin_amdgcn_rsqf(((s4[0] + s4[1]) + (s4[2] + s4[3])) * (1.0f / DM) + RMS_EPS); }
#pragma unroll
        for (int ai = 0; ai < 2; ++ai)
#pragma unroll
            for (int m = 0; m < 4; ++m) { const int row = row0 + ai * HALF + m * 16; const float rs = rsv[ai][m];
                if (fq == 0) rstd_out[row] = rs;
#pragma unroll
                for (int bj = 0; bj < 2; ++bj)
#pragma unroll
                    for (int n = 0; n < 2; ++n) { const int c0 = bj * 32 + n * 16 + 4 * fq; f32x4 o = acc[ai][bj][m][n] * rs;
#pragma unroll
                        for (int j = 0; j < 4; ++j) { const int c = c0 + j; const float b = c < 4 ? bg[c] : (c < 36 ? be[c - 4] : 0.f); o[j] += b; }
                        *(f32x4*)(L + (size_t)row * 64 + c0) = o; } }
    }
};
struct EpiGateUp {
    static constexpr bool PERM = true;
    unsigned char* act;
    __device__ __forceinline__ void operator()(EPI_ARGS) const {
        const int row0 = u.pm * BM + wr * 64 + fr, col0 = u.pn * 128 + wc * 32 + 8 * fq;
        const float* rstd = (const float*)((const char*)u.rows + SLOT_RS_OFF) + wr * 64 + fr;
        float rsv[2][4];
#pragma unroll
        for (int ai = 0; ai < 2; ++ai)
#pragma unroll
            for (int m = 0; m < 4; ++m) rsv[ai][m] = rstd[ai * HALF + m * 16];
#pragma unroll
        for (int ai = 0; ai < 2; ++ai)
#pragma unroll
            for (int m = 0; m < 4; ++m) { const int row = row0 + ai * HALF + m * 16; const float rs = rsv[ai][m];
                float r[8];
#pragma unroll
                for (int n = 0; n < 2; ++n)
#pragma unroll
                    for (int j = 0; j < 4; ++j) { const float gg = acc[ai][0][m][n][j] * rs, uu = acc[ai][1][m][n][j] * rs;
                        r[n * 4 + j] = gg * __builtin_amdgcn_rcpf(1.0f + __builtin_amdgcn_exp2f(-gg * LOG2E)) * uu; }
                u32x2 w; w.x = pk4_fp8(r[0] * F8_ASCALE, r[1] * F8_ASCALE, r[2] * F8_ASCALE, r[3] * F8_ASCALE); w.y = pk4_fp8(r[4] * F8_ASCALE, r[5] * F8_ASCALE, r[6] * F8_ASCALE, r[7] * F8_ASCALE);
                *(u32x2*)(act + (size_t)row * DEXP + col0) = w; }
    }
};
}

namespace da {
constexpr int NW = 8, QBLK = 32, KVBLK = 64, QB = NW * QBLK, DV = 128;
constexpr int SHM_V = KVBLK * DV * 2, SHM_K = KVBLK * 64 * 2;
constexpr int LDS_V = 0, LDS_K = 2 * SHM_V, LDS_WS = LDS_K + 2 * SHM_K, LDS_CX = LDS_WS + NW * 64 * 4, LDS_STASH = LDS_CX + 256, LDS_BYTES = LDS_STASH + NW * 8192;
constexpr float SKIP_MARGIN = 40.f;
constexpr float THR = 8.f;
#define SBAR() __builtin_amdgcn_sched_barrier(0)
__device__ __forceinline__ int kswz(int row, int chunk) { return row * 128 + ((chunk ^ ((row >> 1) & 7)) << 4); }
__device__ __forceinline__ int v_st(int k, int c) { const int kk = (k & ~0xC) | ((k & 4) << 1) | ((k & 8) >> 1); return ((kk >> 3) * 4 + (c >> 5)) * 512 + ((kk & 7) * 32 + (c & 31)) * 2; }
__device__ __forceinline__ int v_rd_base(int lane) { return ((lane & 3) << 3) | (((lane >> 2) & 3) << 6) | (((lane >> 4) & 1) << 5) | (((lane >> 5) & 1) << 8); }
constexpr int v_rd_off(int d0, int ks, int half) { return d0 * 512 + ks * 4096 + half * 2048; }
__device__ __forceinline__ int crow(int r, int hi) { return (r & 3) + 8 * (r >> 2) + 4 * hi; }
__device__ __forceinline__ bf16x8 load8(const bf16_t* p) { return *reinterpret_cast<const bf16x8*>(p); }

__device__ __forceinline__ void mask_tile(f32x16& p0, f32x16& p1, int dq) {
    const float NEG = -__builtin_inff();
#pragma unroll
    for (int r = 0; r < 16; ++r) { const int c = (r & 3) + 8 * (r >> 2); if (dq - c < 0) p0[r] = NEG; if (dq - c - 32 < 0) p1[r] = NEG; }
}
__device__ __forceinline__ void partialSM(f32x16& p0, f32x16& p1, float& m_reg, float& alpha, float l_reg) {
    float pmax = p0[0];
#pragma unroll
    for (int r = 1; r < 16; ++r) pmax = fmaxf(pmax, p0[r]);
#pragma unroll
    for (int r = 0; r < 16; ++r) pmax = fmaxf(pmax, p1[r]);
    { auto rr = __builtin_amdgcn_permlane32_swap(__float_as_uint(pmax), __float_as_uint(pmax), false, false); pmax = fmaxf(__uint_as_float(rr[0]), __uint_as_float(rr[1])); }
    const bool need = (pmax > THR) || (l_reg == 0.f && pmax > -__builtin_inff());
    if (__builtin_expect(__all(!need), 1)) { alpha = 1.f; }
    else { const float d = need ? pmax : 0.f; alpha = (l_reg == 0.f) ? 1.f : __builtin_amdgcn_exp2f(-d); m_reg += d;
#pragma unroll
        for (int r = 0; r < 16; ++r) p0[r] = p0[r] - d;
#pragma unroll
        for (int r = 0; r < 16; ++r) p1[r] = p1[r] - d; }
#pragma unroll
    for (int r = 0; r < 16; ++r) p0[r] = __builtin_amdgcn_exp2f(p0[r]);
}
__device__ __forceinline__ void finishSM(f32x16& p0, f32x16& p1, float alpha, float& l_reg, bf16x8& pa0, bf16x8& pa1, bf16x8& pa2, bf16x8& pa3) {
#pragma unroll
    for (int r = 0; r < 16; ++r) p1[r] = __builtin_amdgcn_exp2f(p1[r]);
    float ps = 0;
#pragma unroll
    for (int r = 0; r < 16; ++r) ps += p0[r];
#pragma unroll
    for (int r = 0; r < 16; ++r) ps += p1[r];
    { auto rr = __builtin_amdgcn_permlane32_swap(__float_as_uint(ps), __float_as_uint(ps), false, false); ps = __uint_as_float(rr[0]) + __uint_as_float(rr[1]); }
    l_reg = l_reg * alpha + ps;
#define PK4(P, B_, OUT) do { unsigned a0 = cvt_pk_bf16(P[B_+0], P[B_+1]), a1 = cvt_pk_bf16(P[B_+2], P[B_+3]);                          \
        unsigned b0 = cvt_pk_bf16(P[B_+4], P[B_+5]), b1 = cvt_pk_bf16(P[B_+6], P[B_+7]);                                             \
        auto r0 = __builtin_amdgcn_permlane32_swap(a0, b0, false, false); auto r1 = __builtin_amdgcn_permlane32_swap(a1, b1, false, false); \
        u32x4 w = {r0[0], r1[0], r0[1], r1[1]}; OUT = *reinterpret_cast<bf16x8*>(&w); } while (0)
    PK4(p0, 0, pa0); PK4(p0, 8, pa1); PK4(p1, 0, pa2); PK4(p1, 8, pa3);
#undef PK4
}
template <int KB>
__device__ __forceinline__ void qkt(f32x16& p0, f32x16& p1, const char* K_lds, int r32, int hi, const bf16x8* qr, float ab, float slope2) {
    const float s32 = 32.f * slope2;
#pragma unroll
    for (int r = 0; r < 16; ++r) { p0[r] = fmaf(slope2, (float)((r & 3) + 8 * (r >> 2)), ab); p1[r] = p0[r] + s32; }
#pragma unroll
    for (int d0 = 0; d0 < 4; ++d0) { const char* a = K_lds + KB * SHM_K + kswz(r32, d0 * 2 + hi);
        bf16x8 b0 = *reinterpret_cast<const bf16x8*>(a);
        bf16x8 b1 = *reinterpret_cast<const bf16x8*>(a + 32 * 128);
        p0 = __builtin_amdgcn_mfma_f32_32x32x16_bf16(b0, qr[d0], p0, 0, 0, 0);
        p1 = __builtin_amdgcn_mfma_f32_32x32x16_bf16(b1, qr[d0], p1, 0, 0, 0); }
}
template <int VB>
__device__ __forceinline__ void pv_tile(f32x16* o, int vb0, bf16x8 pa0, bf16x8 pa1, bf16x8 pa2, bf16x8 pa3) {
#define TRRD(dst, off) asm volatile("ds_read_b64_tr_b16 %0, %1 offset:%2" : "=&v"(dst) : "v"(vb0), "i"(off) : "memory")
#define PV_D0(d0) do { s16x4 l0, l1, l2, l3, h0, h1, h2, h3; constexpr int b_ = VB * SHM_V + v_rd_off(d0, 0, 0); \
        TRRD(l0, b_); TRRD(h0, b_ + 2048); TRRD(l1, b_ + 4096); TRRD(h1, b_ + 6144); TRRD(l2, b_ + 8192); TRRD(h2, b_ + 10240); TRRD(l3, b_ + 12288); TRRD(h3, b_ + 14336); \
        asm volatile("s_waitcnt lgkmcnt(0)" ::: "memory"); SBAR();   \
        o[d0] = __builtin_amdgcn_mfma_f32_32x32x16_bf16(pa0, (bf16x8){l0[0], l0[1], l0[2], l0[3], h0[0], h0[1], h0[2], h0[3]}, o[d0], 0, 0, 0);   \
        o[d0] = __builtin_amdgcn_mfma_f32_32x32x16_bf16(pa1, (bf16x8){l1[0], l1[1], l1[2], l1[3], h1[0], h1[1], h1[2], h1[3]}, o[d0], 0, 0, 0);   \
        o[d0] = __builtin_amdgcn_mfma_f32_32x32x16_bf16(pa2, (bf16x8){l2[0], l2[1], l2[2], l2[3], h2[0], h2[1], h2[2], h2[3]}, o[d0], 0, 0, 0);   \
        o[d0] = __builtin_amdgcn_mfma_f32_32x32x16_bf16(pa3, (bf16x8){l3[0], l3[1], l3[2], l3[3], h3[0], h3[1], h3[2], h3[3]}, o[d0], 0, 0, 0); } while (0)
    PV_D0(0); PV_D0(1); PV_D0(2); PV_D0(3);
#undef PV_D0
#undef TRRD
}

template <int KB>
__device__ __forceinline__ void mcluster(f32x16& p0, f32x16& p1, f32x16* o, int ka0_, int ka1_, int ka2_, int ka3_, int vb0, const bf16x8* qr, bf16x8 pa0, bf16x8 pa1, bf16x8 pa2, bf16x8 pa3) {
    constexpr int VB = KB ^ 1;
#define KRD(dst, addr, off) asm volatile("ds_read_b128 %0, %1 offset:%2" : "=&v"(dst) : "v"(addr), "i"(off) : "memory")
#define TRRD(dst, off) asm volatile("ds_read_b64_tr_b16 %0, %1 offset:%2" : "=&v"(dst) : "v"(vb0), "i"(off) : "memory")
#define TRSET(S_, d0) do { constexpr int b_ = VB * SHM_V + v_rd_off(d0, 0, 0); TRRD(S_##0, b_); TRRD(S_##1, b_ + 2048); TRRD(S_##2, b_ + 4096); TRRD(S_##3, b_ + 6144); \
        TRRD(S_##4, b_ + 8192); TRRD(S_##5, b_ + 10240); TRRD(S_##6, b_ + 12288); TRRD(S_##7, b_ + 14336); } while (0)
#define TRWAIT(S_, n) asm volatile("s_waitcnt lgkmcnt(" #n ")" : "+v"(S_##0), "+v"(S_##1), "+v"(S_##2), "+v"(S_##3), "+v"(S_##4), "+v"(S_##5), "+v"(S_##6), "+v"(S_##7) :: "memory")
#define CAT8(l_, h_) ((bf16x8){l_[0], l_[1], l_[2], l_[3], h_[0], h_[1], h_[2], h_[3]})
#define PVMMA(S_, d0) do { o[d0] = __builtin_amdgcn_mfma_f32_32x32x16_bf16(pa0, CAT8(S_##0, S_##1), o[d0], 0, 0, 0); o[d0] = __builtin_amdgcn_mfma_f32_32x32x16_bf16(pa1, CAT8(S_##2, S_##3), o[d0], 0, 0, 0); \
        o[d0] = __builtin_amdgcn_mfma_f32_32x32x16_bf16(pa2, CAT8(S_##4, S_##5), o[d0], 0, 0, 0); o[d0] = __builtin_amdgcn_mfma_f32_32x32x16_bf16(pa3, CAT8(S_##6, S_##7), o[d0], 0, 0, 0); } while (0)
    bf16x8 ka0, ka1, ka2, ka3, kb0, kb1, kb2, kb3;
    KRD(ka0, ka0_, KB * SHM_K); KRD(kb0, ka0_, KB * SHM_K + 4096); KRD(ka1, ka1_, KB * SHM_K); KRD(kb1, ka1_, KB * SHM_K + 4096);
    KRD(ka2, ka2_, KB * SHM_K); KRD(kb2, ka2_, KB * SHM_K + 4096); KRD(ka3, ka3_, KB * SHM_K); KRD(kb3, ka3_, KB * SHM_K + 4096);
    s16x4 A0, A1, A2, A3, A4, A5, A6, A7, B0, B1, B2, B3, B4, B5, B6, B7;
    TRSET(A, 0);
    asm volatile("s_waitcnt lgkmcnt(8)" : "+v"(ka0), "+v"(ka1), "+v"(ka2), "+v"(ka3), "+v"(kb0), "+v"(kb1), "+v"(kb2), "+v"(kb3) :: "memory");
    SBAR();
    p0 = __builtin_amdgcn_mfma_f32_32x32x16_bf16(ka0, qr[0], p0, 0, 0, 0); p1 = __builtin_amdgcn_mfma_f32_32x32x16_bf16(kb0, qr[0], p1, 0, 0, 0);
    p0 = __builtin_amdgcn_mfma_f32_32x32x16_bf16(ka1, qr[1], p0, 0, 0, 0); p1 = __builtin_amdgcn_mfma_f32_32x32x16_bf16(kb1, qr[1], p1, 0, 0, 0);
    p0 = __builtin_amdgcn_mfma_f32_32x32x16_bf16(ka2, qr[2], p0, 0, 0, 0); p1 = __builtin_amdgcn_mfma_f32_32x32x16_bf16(kb2, qr[2], p1, 0, 0, 0);
    p0 = __builtin_amdgcn_mfma_f32_32x32x16_bf16(ka3, qr[3], p0, 0, 0, 0); p1 = __builtin_amdgcn_mfma_f32_32x32x16_bf16(kb3, qr[3], p1, 0, 0, 0);
    SBAR();
    TRSET(B, 1); TRWAIT(A, 8); SBAR(); PVMMA(A, 0); SBAR();
    TRSET(A, 2); TRWAIT(B, 8); SBAR(); PVMMA(B, 1); SBAR();
    TRSET(B, 3); TRWAIT(A, 8); SBAR(); PVMMA(A, 2); SBAR();
    TRWAIT(B, 0); SBAR(); PVMMA(B, 3); SBAR();
#undef KRD
#undef TRRD
#undef TRSET
#undef TRWAIT
#undef CAT8
#undef PVMMA
}

struct BlockRef { const bf16_t* Q; const bf16_t* K; const bf16_t* V; bf16_t* O; int P0; int mode; float slope2; float kmax; };
struct Seam { bf16x8 qr[4]; bf16x8 st_v0, st_v1, st_k0; };
__device__ __forceinline__ BlockRef mkref(const bf16_t* Z, bf16_t* AO, const float* kmt  , int b, int combo, int mp) { BlockRef r; const int h = combo >> 5, qb = combo & 31;
    const bf16_t* zb = Z + (size_t)b * SEQ * ZP; r.Q = zb + (size_t)(qb * 256) * ZP + ZQ + h * 128 + mp * 64; r.K = zb + ZK + h * 128 + mp * 64; r.V = zb + ZVAL + h * 128;
    r.O = AO + ((size_t)b * SEQ + qb * 256) * DM + 512 + h * 128; r.P0 = qb * 256; r.mode = mp; r.slope2 = exp2f(-2.0f * (float)(h + 1)) * LOG2E;
    r.kmax = kmt[h * 2 + mp]; return r; }
#define ROWV(p, k0, rr) ((p) + (size_t)((k0) + (rr)) * ZP + sc)
#define ROWK(p, k0) ((p) + (size_t)((k0) + skr) * ZP + skc * 8)
#define VMW() asm volatile("s_waitcnt vmcnt(0)" ::: "memory")
#define VMWN(n) asm volatile("s_waitcnt vmcnt(%0)" :: "i"(n) : "memory")
#define SLOAD_K(Kp, k0) do { S.st_k0 = load8(ROWK(Kp, k0)); } while (0)
#define SLOAD_V(Vp, k0) do { S.st_v0 = load8(ROWV(Vp, k0, sr)); S.st_v1 = load8(ROWV(Vp, k0, 32 + sr)); } while (0)
#define SWRITE_HK(bf) do { *(bf16x8*)(K_lds + (bf) * SHM_K + kws) = S.st_k0; } while (0)
#define SWRITE_HV(bf) do { *(bf16x8*)(V_lds + (bf) * SHM_V + vst0) = S.st_v0; *(bf16x8*)(V_lds + (bf) * SHM_V + vst1) = S.st_v1; } while (0)
__device__ __forceinline__ void prime(const BlockRef& cur, char* lds, Seam& S, int wid) {
    const int lane = lane_id(), tid = wid * 64 + lane, r32 = lane & 31, hi = lane >> 5;
    const int sr = tid >> 4, sc = (tid & 15) * 8, skr = tid >> 3, skc = tid & 7, kws = kswz(skr, skc); char* K_lds = lds + LDS_K;
#pragma unroll
    for (int d0 = 0; d0 < 4; ++d0) S.qr[d0] = load8(cur.Q + (size_t)(wid * QBLK + r32) * ZP + d0 * 16 + hi * 8);
    const int kb0 = cur.P0 + QB - KVBLK;
    SLOAD_K(cur.K, kb0); VMW(); SWRITE_HK(0);
    SLOAD_K(cur.K, kb0 - KVBLK); SLOAD_V(cur.V, kb0);
    __syncthreads();
}
__device__ __forceinline__ void block(const BlockRef& cur, const BlockRef& nxt, char* lds, Seam& S, float lam, const float* __restrict__ subln, int wid) {
    const int lane = lane_id(), tid = wid * 64 + lane, r32 = lane & 31, hi = lane >> 5;
    const int NT0 = (cur.P0 + QB) / KVBLK;
    int NT = NT0;
    const int qlo = cur.P0 + wid * QBLK, qm = qlo + r32 - 4 * hi;
    const float slope2 = cur.slope2;
    const bool grpB = wid >= 4;
    char* V_lds = lds + LDS_V; char* K_lds = lds + LDS_K;
    float* ws = (float*)(lds + LDS_WS) + wid * 64; float* li_l = ws, * al_l = ws + 32;
    float m_reg = 0.f, l_reg = 0; f32x16 o[4] = {};
    const int sr = tid >> 4, sc = (tid & 15) * 8, vst0 = v_st(sr, sc), vst1 = v_st(32 + sr, sc), skr = tid >> 3, skc = tid & 7, kws = kswz(skr, skc);
    const int vb0 = (int)(uintptr_t)V_lds + v_rd_base(lane);
    const int kad0 = (int)(uintptr_t)K_lds + kswz(r32, 0 + hi), kad1 = (int)(uintptr_t)K_lds + kswz(r32, 2 + hi), kad2 = (int)(uintptr_t)K_lds + kswz(r32, 4 + hi), kad3 = (int)(uintptr_t)K_lds + kswz(r32, 6 + hi);
    const bf16_t* Kh = cur.K; const bf16_t* Vh = cur.V;
#define RESC(a) do { if (__any((a) < 1.f)) { if (hi == 0) al_l[r32] = (a); asm volatile("s_waitcnt lgkmcnt(0)" ::: "memory");              \
                     for (int d_ = 0; d_ < 4; ++d_) for (int r = 0; r < 16; ++r) o[d_][r] *= al_l[crow(r, hi)]; } } while (0)
#define KBASE(t) ((NT0 - 1 - (t)) * KVBLK)
#define AB(t) (slope2 * (float)(KBASE(t) - qm) - m_reg)
#define MASKT(P0_, P1_, t) do { const int kb_ = KBASE(t); if (kb_ + KVBLK - 1 > qlo) mask_tile(P0_, P1_, qm - kb_); } while (0)
    f32x16 pX0, pX1; float al; bf16x8 pa0, pa1, pa2, pa3;
    float cbase;
    { float q2 = 0.f;
#pragma unroll
      for (int d0 = 0; d0 < 4; ++d0)
#pragma unroll
          for (int j = 0; j < 8; ++j) { const float v = __uint_as_float(((unsigned)(unsigned short)S.qr[d0][j]) << 16); q2 = fmaf(v, v, q2); }
      { auto rr = __builtin_amdgcn_permlane32_swap(__float_as_uint(q2), __float_as_uint(q2), false, false); q2 = __uint_as_float(rr[0]) + __uint_as_float(rr[1]); }
      cbase = sqrtf(q2) * cur.kmax * 1.0001f - slope2 * (float)(qlo + r32); }
#define ACCINIT(t) do { const float ab_ = AB(t), s32_ = 32.f * slope2; _Pragma("unroll") for (int r = 0; r < 16; ++r) { pX0[r] = fmaf(slope2, (float)((r & 3) + 8 * (r >> 2)), ab_); pX1[r] = pX0[r] + s32_; } } while (0)
#define SOFTMAX(t, NEXT) do { MASKT(pX0, pX1, (t)); partialSM(pX0, pX1, m_reg, al, l_reg); RESC(al); finishSM(pX0, pX1, al, l_reg, pa0, pa1, pa2, pa3); if (NEXT) ACCINIT((t) + 1); SBAR(); } while (0)
#define MATRIX(t, KB) do {                                                                                                   \
        __syncthreads();                                                                                                      \
        SBAR(); mcluster<KB>(pX0, pX1, o, kad0, kad1, kad2, kad3, vb0, S.qr, pa0, pa1, pa2, pa3); SBAR();                         \
        VMW(); if ((t) + 1 < NT) SWRITE_HK((KB) ^ 1); SWRITE_HV(KB);                                                           \
        if ((t) + 2 < NT) SLOAD_K(Kh, KBASE((t) + 2)); if ((t) + 1 < NT) SLOAD_V(Vh, KBASE((t) + 1));                            \
        SBAR(); __syncthreads(); } while (0)
    if (grpB) __builtin_amdgcn_s_barrier();
    VMW(); SWRITE_HK(1); SWRITE_HV(0);
    SLOAD_K(Kh, KBASE(2)); SLOAD_V(Vh, KBASE(1));
    SBAR(); qkt<0>(pX0, pX1, K_lds, r32, hi, S.qr, AB(0), slope2); SBAR();
    __syncthreads();
    SOFTMAX(0, true);
    for (int t = 1; t + 1 < NT; t += 2) {
        MATRIX(t, 1); SOFTMAX(t, true);
        const bool cut_here = (t == 3 && NT0 > 6);
        if (cut_here) {
            float c = cbase - m_reg;
#pragma unroll
            for (int o_ = 1; o_ < 64; o_ <<= 1) c = fmaxf(c, __shfl_xor(c, o_));
            if (lane == 0) ((float*)(lds + LDS_CX))[wid] = c;
        }
        MATRIX(t + 1, 0);
        if (cut_here) {
            const float* cx = (const float*)(lds + LDS_CX);
            float C = cx[0];
#pragma unroll
            for (int w_ = 1; w_ < NW; ++w_) C = fmaxf(C, cx[w_]);
            const float X = (-SKIP_MARGIN - C) / slope2 - 63.f;
            const float need_f = (float)(NT0 - 1) - X * (1.0f / 64.0f);
            if (need_f < (float)NT0) { int n = (int)ceilf(need_f); n = n < 6 ? 6 : n; n = (n + 1) & ~1; NT = n < NT0 ? n : NT0; }
        }
        SOFTMAX(t + 1, true);
    }
    __syncthreads();
    SBAR(); mcluster<1>(pX0, pX1, o, kad0, kad1, kad2, kad3, vb0, S.qr, pa0, pa1, pa2, pa3); SBAR();
    VMW(); SWRITE_HV(1);
    SLOAD_K(nxt.K, nxt.P0 + QB - KVBLK);
    SBAR(); __syncthreads();
#pragma unroll
    for (int d0 = 0; d0 < 4; ++d0) S.qr[d0] = load8(nxt.Q + (size_t)(wid * QBLK + r32) * ZP + d0 * 16 + hi * 8);
    SBAR();
    SOFTMAX(NT - 1, false);
    if (!grpB) __builtin_amdgcn_s_barrier();
    pv_tile<1>(o, vb0, pa0, pa1, pa2, pa3); SBAR();
    VMW(); SWRITE_HK(0);
    { const int kbn = nxt.P0 + QB - KVBLK; SLOAD_K(nxt.K, kbn - KVBLK); SLOAD_V(nxt.V, kbn); }
    SBAR();
    if (hi == 0) li_l[r32] = l_reg; asm volatile("s_waitcnt lgkmcnt(0)" ::: "memory");
    float rli[16];
#pragma unroll
    for (int r = 0; r < 16; ++r) rli[r] = __builtin_amdgcn_rcpf(li_l[crow(r, hi)]);
    unsigned* stash = (unsigned*)(lds + LDS_STASH) + wid * 2048 + lane;
    if (cur.mode == 0) {
#pragma unroll
        for (int r = 0; r < 16; ++r) { stash[(r * 2 + 0) * 64] = cvt_pk_bf16(o[0][r] * rli[r], o[1][r] * rli[r]); stash[(r * 2 + 1) * 64] = cvt_pk_bf16(o[2][r] * rli[r], o[3][r] * rli[r]); }
    } else {
        float ssq[16];
#pragma unroll
        for (int r = 0; r < 16; ++r) { const unsigned w0 = stash[(r * 2 + 0) * 64], w1 = stash[(r * 2 + 1) * 64];
            o[0][r] = bf_lo(w0) - lam * (o[0][r] * rli[r]); o[1][r] = bf_hi(w0) - lam * (o[1][r] * rli[r]);
            o[2][r] = bf_lo(w1) - lam * (o[2][r] * rli[r]); o[3][r] = bf_hi(w1) - lam * (o[3][r] * rli[r]);
            ssq[r] = (o[0][r] * o[0][r] + o[1][r] * o[1][r]) + (o[2][r] * o[2][r] + o[3][r] * o[3][r]); }
#pragma unroll
        for (int r = 0; r < 16; ++r) {
#pragma unroll
            for (int off = 1; off < 32; off <<= 1) ssq[r] += __shfl_xor(ssq[r], off);
            ssq[r] = __builtin_amdgcn_rsqf(ssq[r] * (1.0f / DV) + RMS_EPS); }
        float g4[4];
#pragma unroll
        for (int d0 = 0; d0 < 4; ++d0) g4[d0] = subln[d0 * 32 + r32] * 0.8f;
        bf16_t* Ow = cur.O + (size_t)(wid * QBLK) * DM;
#pragma unroll
        for (int r = 0; r < 16; ++r) { const int orow = crow(r, hi);
#pragma unroll
            for (int d0 = 0; d0 < 4; ++d0) { const float v = o[d0][r] * ssq[r] * g4[d0]; const float vn = __shfl_xor(v, 1);
                if ((r32 & 1) == 0) *(unsigned*)(Ow + (size_t)orow * DM + d0 * 32 + r32) = cvt_pk_bf16(v, vn); } }
    }
    __syncthreads();
#undef RESC
#undef KBASE
#undef AB
#undef MASKT
#undef SOFTMAX
#undef MATRIX
}
#undef ROWV
#undef ROWK
#undef VMW
#undef VMWN
#undef SLOAD_K
#undef SLOAD_V
#undef SWRITE_HK
#undef SWRITE_HV
#undef SBAR
}

struct AttnPlan { unsigned char list[32][24]; unsigned char cnt[32]; };
constexpr int attn_cost(int combo) { const int h = combo >> 5, qb = combo & 31; const int cap = h == 0 ? 7 : (h == 1 ? 15 : (h == 2 ? 46 : 128)); int st = 4 * (qb + 1); st = st < cap ? st : cap; return 2 * (15 * st + 200); }
constexpr AttnPlan make_attn_plan() {
    AttnPlan p{}; int load[32] = {}; bool used[128] = {};
    for (int i = 0; i < 128; ++i) { int best = -1; for (int j = 0; j < 128; ++j) if (!used[j] && (best < 0 || attn_cost(j) > attn_cost(best))) best = j;
        used[best] = true; int bin = 0; for (int b = 1; b < 32; ++b) if (load[b] < load[bin]) bin = b;
        if (p.cnt[bin] < 24) { p.list[bin][p.cnt[bin]] = (unsigned char)best; p.cnt[bin] = (unsigned char)(p.cnt[bin] + 1); } load[bin] += attn_cost(best); }
    return p;
}
__device__ const AttnPlan kAttnPlan = make_attn_plan();

#define XB_TMO      128
#define XB_XCNT(j)  (256  + 64 * (j))
#define XB_XSUB(j)  (1280 + 64 * (j))
#define XB_XGEN(j)  (2304 + 64 * (j))
#define XB_TOP      3328
#define XB_TOPGEN   3392
#define XCD_BAR_WORDS 3456
#define XB_SPIN_CAP (1u << 22)
__device__ __forceinline__ unsigned xb_ld(unsigned* p)              { return __hip_atomic_load(p, __ATOMIC_RELAXED, __HIP_MEMORY_SCOPE_AGENT); }
__device__ __forceinline__ unsigned xb_add(unsigned* p, unsigned v) { return __hip_atomic_fetch_add(p, v, __ATOMIC_RELAXED, __HIP_MEMORY_SCOPE_AGENT); }
__device__ __forceinline__ unsigned xb_xcc_id() { return (unsigned)__builtin_amdgcn_s_getreg((3 << 11) | 20) & 0xFu; }
#define XB_SPIN(cond, bar) do { unsigned _sp = 0; while (cond) { __builtin_amdgcn_s_sleep(1); \
    if ((++_sp & 255u) == 0u) { if (xb_ld(&(bar)[XB_TMO])) break; if (_sp > XB_SPIN_CAP) { atomicAdd(&(bar)[XB_TMO], 1u); break; } } } } while (0)
struct XcdBarrier { unsigned* bar; unsigned x; volatile LAS unsigned* st; };
__device__ __forceinline__ XcdBarrier xcd_barrier_post(unsigned* bar, volatile LAS unsigned* st, bool t0) {
    XcdBarrier b; b.bar = bar; b.x = xb_xcc_id(); b.st = st;
    if (t0) (void)xb_add(&bar[XB_XCNT(b.x)], 1u);
    return b;
}
__device__ __forceinline__ void xcd_barrier_complete(unsigned* bar, unsigned x, unsigned& nloc, unsigned& nx) {
    const unsigned G = gridDim.x;
    unsigned sum, cnt, mine, sp = 0u;
    for (;;) {
        sum = 0u; cnt = 0u; mine = 0u;
#pragma unroll
        for (unsigned j = 0; j < 16; ++j) { const unsigned c = xb_ld(&bar[XB_XCNT(j)]); sum += c; cnt += (c > 0u) ? 1u : 0u; mine = (j == x) ? c : mine; }
        if (sum == G) break;
        __builtin_amdgcn_s_sleep(1);
        if ((++sp & 255u) == 0u) { if (xb_ld(&bar[XB_TMO])) break; if (sp > XB_SPIN_CAP) { atomicAdd(&bar[XB_TMO], 1u); break; } }
    }
    nloc = mine > 0u ? mine : 1u; nx = cnt > 0u ? cnt : 1u;
}
__device__ __forceinline__ void xcd_barrier(const XcdBarrier& b, bool t0) {
    asm volatile("s_waitcnt vmcnt(0)" ::: "memory");
    __syncthreads();
    if (t0) {
        unsigned* bar = b.bar;
        __builtin_amdgcn_s_waitcnt(0);
        unsigned nloc = b.st[0], nx = b.st[1];
        if (nloc == 0u) { xcd_barrier_complete(bar, b.x, nloc, nx); b.st[0] = nloc; b.st[1] = nx; }
        const unsigned old = xb_add(&bar[XB_XSUB(b.x)], 1u);
        const unsigned gen = old / nloc;
        if (old + 1u == (gen + 1u) * nloc) {
            __builtin_amdgcn_fence(__ATOMIC_RELEASE, "agent");
            asm volatile("s_waitcnt vmcnt(0)" ::: "memory");
            const unsigned og = xb_add(&bar[XB_TOP], 1u);
            const unsigned tg = og / nx;
            if (og + 1u == (tg + 1u) * nx) xb_add(&bar[XB_TOPGEN], 1u);
            else XB_SPIN(xb_ld(&bar[XB_TOPGEN]) == tg, bar);
            __builtin_amdgcn_fence(__ATOMIC_ACQUIRE, "agent");
            xb_add(&bar[XB_XGEN(b.x)], 1u);
            asm volatile("s_waitcnt vmcnt(0)" ::: "memory");
        } else {
            XB_SPIN(xb_ld(&bar[XB_XGEN(b.x)]) == gen, bar);
            __builtin_amdgcn_fence(__ATOMIC_ACQUIRE, "agent");
            asm volatile("s_waitcnt vmcnt(0)" ::: "memory");
        }
    }
    __syncthreads();
}
constexpr int NWAVES = 8, NTHR = 512;
constexpr int LDS_BYTES = 163840;
struct Args {
    const float* in[28]; float* out; unsigned char* ws; int ph_lo, ph_hi;
};
constexpr int N_PHASES = 15;

struct Frame {
    LAS unsigned char* lds; int wave, vcu, G;
};

__device__ __forceinline__ void transpose_item(const float* W, int ldw, int k0, int n0, bf16_t* dst, int ldt, const float* kscale, LAS float* scr, int lane) {
    f32x4 v[8]; const int kr = lane >> 3, n4 = (lane & 7) * 4;
#pragma unroll
    for (int i = 0; i < 8; ++i) v[i] = __builtin_nontemporal_load((const f32x4*)(W + (size_t)(k0 + i * 8 + kr) * ldw + n0 + n4));
#pragma unroll
    for (int i = 0; i < 8; ++i) { const int kk = i * 8 + kr; f32x4 x = v[i]; if (kscale) x = x * kscale[k0 + kk];
        scr[kk * 33 + n4 + 0] = x[0]; scr[kk * 33 + n4 + 1] = x[1]; scr[kk * 33 + n4 + 2] = x[2]; scr[kk * 33 + n4 + 3] = x[3]; }
    asm volatile("s_waitcnt lgkmcnt(0)" ::: "memory");
    const int c = lane & 7;
#pragma unroll
    for (int j = 0; j < 4; ++j) { const int n = (lane >> 3) + 8 * j; const LAS float* s = scr + (8 * c) * 33 + n;
        u32x4 o; o.x = cvt_pk_bf16(s[0 * 33], s[1 * 33]); o.y = cvt_pk_bf16(s[2 * 33], s[3 * 33]); o.z = cvt_pk_bf16(s[4 * 33], s[5 * 33]); o.w = cvt_pk_bf16(s[6 * 33], s[7 * 33]);
        *(u32x4*)(dst + (size_t)n * ldt + k0 + 8 * c) = o; }
    asm volatile("s_waitcnt lgkmcnt(0)" ::: "memory");
}
__device__ __forceinline__ void transpose_item_fp8(const float* W, int ldw, int k0, int n0, unsigned char* dst, int ldt, float scale, const float* kscale, LAS float* scr, int lane) {
    f32x4 v[8]; const int kr = lane >> 3, n4 = (lane & 7) * 4;
#pragma unroll
    for (int i = 0; i < 8; ++i) v[i] = __builtin_nontemporal_load((const f32x4*)(W + (size_t)(k0 + i * 8 + kr) * ldw + n0 + n4));
#pragma unroll
    for (int i = 0; i < 8; ++i) { const int kk = i * 8 + kr; const f32x4 x = v[i] * (kscale ? scale * kscale[k0 + kk] : scale);
        scr[kk * 33 + n4 + 0] = x[0]; scr[kk * 33 + n4 + 1] = x[1]; scr[kk * 33 + n4 + 2] = x[2]; scr[kk * 33 + n4 + 3] = x[3]; }
    asm volatile("s_waitcnt lgkmcnt(0)" ::: "memory");
    const int n = lane >> 1, kh = (lane & 1) * 32; const LAS float* s = scr + kh * 33 + n;
    u32x4 o0, o1;
    o0.x = pk4_fp8(s[0 * 33], s[1 * 33], s[2 * 33], s[3 * 33]); o0.y = pk4_fp8(s[4 * 33], s[5 * 33], s[6 * 33], s[7 * 33]); o0.z = pk4_fp8(s[8 * 33], s[9 * 33], s[10 * 33], s[11 * 33]); o0.w = pk4_fp8(s[12 * 33], s[13 * 33], s[14 * 33], s[15 * 33]);
    o1.x = pk4_fp8(s[16 * 33], s[17 * 33], s[18 * 33], s[19 * 33]); o1.y = pk4_fp8(s[20 * 33], s[21 * 33], s[22 * 33], s[23 * 33]); o1.z = pk4_fp8(s[24 * 33], s[25 * 33], s[26 * 33], s[27 * 33]); o1.w = pk4_fp8(s[28 * 33], s[29 * 33], s[30 * 33], s[31 * 33]);
    __builtin_nontemporal_store(o0, (u32x4*)(dst + (size_t)n * ldt + k0 + kh)); __builtin_nontemporal_store(o1, (u32x4*)(dst + (size_t)n * ldt + k0 + kh + 16));
    asm volatile("s_waitcnt lgkmcnt(0)" ::: "memory");
}
__device__ __forceinline__ void rms_rows2_to_bf16(const float* xa, const float* xb, const float* g, bf16_t* oa, bf16_t* ob, int lane) {
    const f32x4* ra = (const f32x4*)xa + lane; const f32x4* rb = (const f32x4*)xb + lane; const f32x4* gr = (const f32x4*)g + lane;
    f32x4 va[4], vb[4]; float sa = 0.f, sb = 0.f;
#pragma unroll
    for (int j = 0; j < 4; ++j) { va[j] = __builtin_nontemporal_load(ra + 64 * j); vb[j] = __builtin_nontemporal_load(rb + 64 * j); }
#pragma unroll
    for (int j = 0; j < 4; ++j) { sa += (va[j].x * va[j].x + va[j].y * va[j].y) + (va[j].z * va[j].z + va[j].w * va[j].w); sb += (vb[j].x * vb[j].x + vb[j].y * vb[j].y) + (vb[j].z * vb[j].z + vb[j].w * vb[j].w); }
    const float rsa = __builtin_amdgcn_rsqf(wave_sum(sa) * (1.f / DM) + RMS_EPS), rsb = __builtin_amdgcn_rsqf(wave_sum(sb) * (1.f / DM) + RMS_EPS);
    u32x2* pa = (u32x2*)oa + lane; u32x2* pb = (u32x2*)ob + lane;
#pragma unroll
    for (int j = 0; j < 4; ++j) { const f32x4 gg = gr[64 * j]; u32x2 w;
        w.x = cvt_pk_bf16(va[j].x * rsa * gg.x, va[j].y * rsa * gg.y); w.y = cvt_pk_bf16(va[j].z * rsa * gg.z, va[j].w * rsa * gg.w); pa[64 * j] = w;
        w.x = cvt_pk_bf16(vb[j].x * rsb * gg.x, vb[j].y * rsb * gg.y); w.y = cvt_pk_bf16(vb[j].z * rsb * gg.z, vb[j].w * rsb * gg.w); pb[64 * j] = w; }
}

__global__ void __launch_bounds__(NTHR, 2) mega(Args args) {
    extern __shared__ __attribute__((aligned(16))) unsigned char lds_raw[];
    Frame F; F.lds = (LAS unsigned char*)lds_raw; F.wave = __builtin_amdgcn_readfirstlane(threadIdx.x >> 6);
    F.G = gridDim.x; { const int bx = blockIdx.x; F.vcu = (F.G % 8 == 0) ? (bx % 8) * (F.G / 8) + bx / 8 : bx; }
    unsigned char* ws = args.ws;
    unsigned* ctl = (unsigned*)(ws + WS_CTL);
    const float* x = args.in[0]; float* out = args.out;
    bf16_t* Win_t = (bf16_t*)(ws + WS_WIN); bf16_t* Wout_t = (bf16_t*)(ws + WS_WOUT); bf16_t* Wq_t = (bf16_t*)(ws + WS_WQ); bf16_t* Wkv_t = (bf16_t*)(ws + WS_WKV);
    bf16_t* Wo_t = (bf16_t*)(ws + WS_WO); bf16_t* Wr_t = (bf16_t*)(ws + WS_WR); bf16_t* Wsgu = (bf16_t*)(ws + WS_WSGU); bf16_t* memn = (bf16_t*)(ws + WS_MEMN);
    bf16_t* Km = (bf16_t*)(ws + WS_KM); bf16_t* Vt = (bf16_t*)(ws + WS_VT); bf16_t* Wgu_t = (bf16_t*)(ws + WS_WGU); bf16_t* Wd_t = (bf16_t*)(ws + WS_WD);
    bf16_t* Z = (bf16_t*)(ws + WS_RA); bf16_t* Qm = (bf16_t*)(ws + WS_RA); bf16_t* Sc = (bf16_t*)(ws + WS_RA + 128 * MiB); bf16_t* xg = (bf16_t*)(ws + WS_RA); bf16_t* yb = (bf16_t*)(ws + WS_RA);
    bf16_t* XN = (bf16_t*)(ws + WS_RB); bf16_t* AO = (bf16_t*)(ws + WS_RB); bf16_t* Om = (bf16_t*)(ws + WS_RB); bf16_t* act = (bf16_t*)(ws + WS_RB);
    bf16_t* x1b = (bf16_t*)(ws + WS_RC); bf16_t* x2b = (bf16_t*)(ws + WS_RC); unsigned char* x2f8 = ws + WS_X2F8;
    float* ssq1 = (float*)(ws + WS_SSQ1); float* ssq2 = (float*)(ws + WS_SSQ2); float* rstd2 = (float*)(ws + WS_SSQ1);     float* logit = (float*)(ws + WS_LOGIT);
    float* tok_w = (float*)(ws + WS_TOKW); int* tok_s = (int*)(ws + WS_TOKS); int* slot_tok = (int*)(ws + WS_SLOTTOK); float* slot_rs = (float*)(ws + WS_SLOTTOK + SLOT_RS_OFF);
    const int gw = F.vcu * NWAVES + F.wave, NGW = F.G * NWAVES;
    const int lo = args.ph_lo, hi = args.ph_hi;
#define IN(k) (lo <= (k) && (k) < hi)
#if MK_ONE_LAUNCH
    volatile LAS unsigned* misc = (volatile LAS unsigned*)(F.lds + LDS_MISC);
    if (threadIdx.x < 64) misc[threadIdx.x] = 0u;
    __syncthreads();
    XcdBarrier xbar = xcd_barrier_post(ctl + CW_BAR, misc + 8, threadIdx.x == 0);
    if (args.ph_hi > 4096) cg::this_grid().sync();
#define GRID_BAR(k) do { if (IN(k) && IN((k) + 1)) xcd_barrier(xbar, F.wave == 0 && lane_id() == 0); } while (0)
#else
#define GRID_BAR(k) do { } while (0)
#endif
#define LOCAL_SEAM() do { asm volatile("s_waitcnt vmcnt(0)" ::: "memory"); __syncthreads(); __builtin_amdgcn_fence(__ATOMIC_ACQUIRE, "agent"); asm volatile("s_waitcnt vmcnt(0)" ::: "memory"); __syncthreads(); } while (0)

    if (IN(0)) {
        const int lane_ = lane_id(), tid_ = F.wave * 64 + lane_; (void)tid_;
        LAS float* scr = (LAS float*)(F.lds + F.wave * 16384);
        constexpr int I_IN = 16 * 80, I_SQ = 16 * 32, I_KV = 16 * 64, I_G = 16 * 16, I_D = 8 * 32;
        constexpr int NITEMS = I_IN + 3 * I_SQ + I_KV + NEXP * (2 * I_G + I_D);
        for (int it = gw; it < NITEMS; it += NGW) {
            int r = it;
            if (r < I_IN) { const int kb = r / 80, nb = r % 80; transpose_item(args.in[3], ZP, kb * 64, nb * 32, Win_t + (size_t)(nb * 32) * DM, DM, nullptr, scr, lane_); continue; } r -= I_IN;
            if (r < I_SQ) { const int kb = r / 32, nb = r % 32; transpose_item(args.in[13], DM, kb * 64, nb * 32, Wout_t + (size_t)(nb * 32) * DM, DM, nullptr, scr, lane_); continue; } r -= I_SQ;
            if (r < I_SQ) { const int kb = r / 32, nb = r % 32; transpose_item_fp8(args.in[16], DM, kb * 64, nb * 32, (unsigned char*)Wq_t + (size_t)(nb * 32) * DM, DM, F8_WSCALE, args.in[14], scr, lane_); continue; } r -= I_SQ;
            if (r < I_KV) { const int kb = r / 64, nb = r % 64; transpose_item(args.in[17], 2 * DM, kb * 64, nb * 32, Wkv_t + (size_t)(nb * 32) * DM, DM, nullptr, scr, lane_); continue; } r -= I_KV;
            if (r < I_SQ) { const int kb = r / 32, nb = r % 32; transpose_item_fp8(args.in[18], DM, kb * 64, nb * 32, (unsigned char*)Wo_t + (size_t)(nb * 32) * DM, DM, F8_WSCALE, nullptr, scr, lane_); continue; } r -= I_SQ;
            const int e = r / (2 * I_G + I_D); r -= e * (2 * I_G + I_D);
            if (r < 2 * I_G) { const int up = r >= I_G; if (up) r -= I_G; const int kb = r / 16, nb = r % 16, n0 = nb * 32;
                const float* W = (up ? args.in[25] : args.in[24]) + (size_t)e * DM * DEXP;
                transpose_item_fp8(W, DEXP, kb * 64, n0, (unsigned char*)Wgu_t + ((size_t)e * 1024 + (n0 >> 7) * 256 + 64 * ((n0 & 127) >> 5) + 32 * up) * DM, DM, F8_WSCALE, args.in[19], scr, lane_); continue; }
            r -= 2 * I_G;
            { const int kb = r / 32, nb = r % 32; transpose_item_fp8(args.in[26] + (size_t)e * DEXP * DM, DM, kb * 64, nb * 32, (unsigned char*)Wd_t + ((size_t)e * 1024 + nb * 32) * DEXP, DEXP, F8_WSCALE, nullptr, scr, lane_); }
        }
        for (int i = blockIdx.x * NTHR + tid_; i < 256 * DM; i += F.G * NTHR) { const int n = i >> 10, k = i & 1023; float v = 0.f;
            if (n < 4) v = args.in[20][k * 4 + n] * args.in[19][k]; else if (n < 36) v = args.in[22][k * 32 + (n - 4)] * args.in[19][k];
            Wr_t[i] = (bf16_t)(cvt_pk_bf16(v, 0.f) & 0xffffu); }
        for (int i = blockIdx.x * NTHR + tid_; i < 4 * 128 * 128; i += F.G * NTHR) { const int t = (i >> 7) & 127, s = i & 127; const float v = s <= t ? args.in[6][i] : 0.f; Wsgu[i] = (bf16_t)(cvt_pk_bf16(v, 0.f) & 0xffffu); }
        for (int m = gw; m < M; m += 2 * NGW) rms_rows2_to_bf16(x + (size_t)m * DM, x + (size_t)(m + NGW) * DM, args.in[2], XN + (size_t)m * DM, XN + (size_t)(m + NGW) * DM, lane_);
        for (int m = gw; m < MROWS / 2; m += NGW) rms_rows2_to_bf16(args.in[1] + (size_t)m * DM, args.in[1] + (size_t)(m + MROWS / 2) * DM, args.in[15], memn + (size_t)m * DM, memn + (size_t)(m + MROWS / 2) * DM, lane_);
        __syncthreads();
    }
    GRID_BAR(0);

    if (IN(1)) {
        { pg8::Gemm g{DM, DM, DM}; pg8::PlainSched S; S.to.init(M / 256, ZP / 256, F.G, (int)blockIdx.x); S.A = (const char*)XN; S.B = (const char*)Win_t; S.tA = (size_t)256 * DM * 2; S.tB = (size_t)256 * DM * 2;
          pg8::EpiZ E{Z, ctl + CW_KMX}; pg8::gemm_phase(F.lds, F.wave, g, S, E); }
    }
    GRID_BAR(1);

    if (IN(2)) {
        const int lane_ = lane_id(), tid_ = F.wave * 64 + lane_; (void)tid_;
        float lam;
        { const float a = args.in[8][lane_] * args.in[9][lane_], b = args.in[10][lane_] * args.in[11][lane_];
          lam = __expf(wave_sum(a)) - __expf(wave_sum(b)) + 0.2f; }
        {
            LAS float* kmt = (LAS float*)(F.lds + da::LDS_CX + 64);
            const int b = (F.G == 256) ? (F.vcu >> 5) : 0, r = F.vcu & 31;
            if (tid_ < 8) { const unsigned* kp = ctl + CW_KMX + ((b * 4 + (tid_ >> 1)) * 2 + (tid_ & 1)) * 2; kmt[tid_] = 1.01f * sqrtf(__uint_as_float(ld_u32_agent(kp)) + __uint_as_float(ld_u32_agent(kp + 1))); }
            __syncthreads();
            const int nit = (F.G == 256) ? (int)kAttnPlan.cnt[r] : 0;
#define COMBO_OF(i) ((int)__builtin_amdgcn_readfirstlane((int)kAttnPlan.list[r][(i)]))
            if (nit > 0) {
                int ii = 0, pass = 0, combo = COMBO_OF(0); da::BlockRef cur = da::mkref(Z, AO, (const float*)kmt, b, combo, 0); da::Seam S;
                da::prime(cur, (char*)lds_raw, S, F.wave);
                for (;;) {
                    int ni = ii, np = pass + 1; if (np == 2) { np = 0; ni = ii + 1; }
                    const bool last = ni >= nit * PROBE_DUP_ATTN;
                    int ncombo = combo; if (!last && np == 0) ncombo = COMBO_OF(ni % nit);
                    const da::BlockRef nxt = last ? cur : da::mkref(Z, AO, (const float*)kmt, b, ncombo, np);
                    da::block(cur, nxt, (char*)lds_raw, S, lam, args.in[12], F.wave);
                    if (last) break;
                    cur = nxt; ii = ni; pass = np; combo = ncombo;
                }
            }
#undef COMBO_OF
        }
        __syncthreads();
        {
            int e = -1;
            if (F.G == 256) { const int b = F.vcu >> 5, r = F.vcu & 31; if (r >= 16 && r < 24) e = b * 8 + (r - 16); }
            for (int e2 = (F.G == 256 ? e : F.vcu); e2 >= 0 && e2 < 64; e2 = (F.G == 256 ? 64 : e2 + F.G)) {
                pg8::Gemm g{DM, DM, DM}; pg8::OneUnitSched S;
                if (e2 < 32) { S.u0.pm = e2 >> 2; S.u0.pn = e2 & 3; S.u0.aux = 0; S.u0.rows = nullptr; S.u0.A = (const char*)(memn + (size_t)S.u0.pm * 256 * DM); S.u0.B = (const char*)(Wkv_t + (size_t)S.u0.pn * 256 * DM);
                    pg8::EpiF8 E{(unsigned char*)Km, DM, nullptr, F8_KSCALE}; pg8::gemm_phase(F.lds, F.wave, g, S, E); }
                else { const int e3 = e2 - 32; S.u0.pm = e3 >> 3; S.u0.pn = e3 & 7; S.u0.aux = 0; S.u0.rows = nullptr; S.u0.A = (const char*)(Wkv_t + (size_t)(1024 + S.u0.pm * 256) * DM); S.u0.B = (const char*)(memn + (size_t)S.u0.pn * 256 * DM);
                    pg8::EpiF8 E{(unsigned char*)Vt, MROWS, nullptr, F8_VSCALE}; pg8::gemm_phase(F.lds, F.wave, g, S, E); }
            }
        }
        __syncthreads();
        {
            const int lane = lane_, w = F.wave;
            const int nun = (M / 128) * 4;
            const int ch0 = (lane & 15) * 8, t = 16 * w + (lane & 15), nks = (w + 2) >> 1;
            u32x4 vr[4];
            LAS int* sq = (LAS int*)(F.lds + 2 * 34816);
            const bool puller = (w == 0 && lane == 0);
            if (puller) { sq[0] = (int)atomicAdd(ctl + CW_SGUQ, 1u); sq[1] = (int)atomicAdd(ctl + CW_SGUQ, 1u); }
            __syncthreads();
            int uidx = __builtin_amdgcn_readfirstlane(sq[0]), unext = __builtin_amdgcn_readfirstlane(sq[1]), kk = 0;
            if (uidx < nun) { const size_t R0 = (size_t)(uidx >> 2) * 128; const int g = uidx & 3;
#pragma unroll
                for (int ps = 0; ps < 4; ++ps) vr[ps] = *(const u32x4*)(Z + (R0 + 16 * w + 4 * ps + (lane >> 4)) * ZP + ZV + g * 128 + ch0); }
            int gcur = -1; float lg[8], lb[8]; bf16x8 wf[4]; float bias = 0.f; int buf = 0;
#pragma unroll
            for (int j = 0; j < 8; ++j) { lg[j] = 0.f; lb[j] = 0.f; }
#pragma unroll
            for (int ks = 0; ks < 4; ++ks) wf[ks] = (bf16x8){0, 0, 0, 0, 0, 0, 0, 0};
            for (; uidx < nun; uidx = unext, unext = __builtin_amdgcn_readfirstlane(sq[(kk + 1) & 3]), buf ^= 1) {
                int pulled_ = 0; if (puller) pulled_ = (int)atomicAdd(ctl + CW_SGUQ, 1u);
                const int c = uidx >> 2, g = uidx & 3; const size_t R0 = (size_t)c * 128;
                LAS bf16_t* vnT = (LAS bf16_t*)(F.lds + buf * 34816);
                if (g != gcur) { gcur = g;
#pragma unroll
                    for (int j = 0; j < 8; ++j) { lg[j] = args.in[4][g * 128 + ch0 + j]; lb[j] = args.in[5][g * 128 + ch0 + j]; }
#pragma unroll
                    for (int ks = 0; ks < 4; ++ks) if (ks < nks) wf[ks] = *(const bf16x8*)(Wsgu + ((size_t)g * 128 + t) * 128 + ks * 32 + 8 * (lane >> 4));
                    bias = args.in[7][g * 128 + t]; }
#pragma unroll
                for (int ps = 0; ps < 4; ++ps) { const int sr = 16 * w + 4 * ps + (lane >> 4); const u32x4 raw = vr[ps];
                    float v[8] = {bf_lo(raw.x), bf_hi(raw.x), bf_lo(raw.y), bf_hi(raw.y), bf_lo(raw.z), bf_hi(raw.z), bf_lo(raw.w), bf_hi(raw.w)};
                    float sm = 0.f;
#pragma unroll
                    for (int j = 0; j < 8; ++j) sm += v[j];
#pragma unroll
                    for (int o = 1; o < 16; o <<= 1) sm += __shfl_xor(sm, o);
                    const float mu = sm * (1.f / 128.f); float q = 0.f;
#pragma unroll
                    for (int j = 0; j < 8; ++j) { v[j] -= mu; q += v[j] * v[j]; }
#pragma unroll
                    for (int o = 1; o < 16; o <<= 1) q += __shfl_xor(q, o);
                    const float rstd = __builtin_amdgcn_rsqf(q * (1.f / 128.f) + LN_EPS);
#pragma unroll
                    for (int j = 0; j < 8; ++j) { const float y = v[j] * rstd * lg[j] + lb[j]; vnT[(ch0 + j) * 136 + sr] = (bf16_t)(cvt_pk_bf16(y, 0.f) & 0xffffu); } }
                u32x2 ur[8];
#pragma unroll
                for (int mi = 0; mi < 8; ++mi) ur[mi] = *(const u32x2*)(Z + (R0 + t) * ZP + ZU + g * 128 + 16 * mi + 4 * (lane >> 4));
                { const int un = unext; if (un < nun) { const size_t Rn = (size_t)(un >> 2) * 128; const int gn = un & 3;
#pragma unroll
                    for (int ps = 0; ps < 4; ++ps) vr[ps] = *(const u32x4*)(Z + (Rn + 16 * w + 4 * ps + (lane >> 4)) * ZP + ZV + gn * 128 + ch0); } }
                if (puller) sq[(kk + 2) & 3] = pulled_;
                ++kk;
                __syncthreads();
                f32x4 acc[8];
#pragma unroll
                for (int mi = 0; mi < 8; ++mi) acc[mi] = (f32x4){0.f, 0.f, 0.f, 0.f};
#pragma unroll
                for (int ks = 0; ks < 4; ++ks) if (ks < nks) {
#pragma unroll
                    for (int mi = 0; mi < 8; ++mi) { const bf16x8 afr = *(const LAS bf16x8*)(vnT + (16 * mi + (lane & 15)) * 136 + ks * 32 + 8 * (lane >> 4));
                        acc[mi] = __builtin_amdgcn_mfma_f32_16x16x32_bf16(afr, wf[ks], acc[mi], 0, 0, 0); } }
#pragma unroll
                for (int mi = 0; mi < 8; ++mi) { const int ch = 16 * mi + 4 * (lane >> 4); const u32x2 u2 = ur[mi];
                    const float o0 = bf_lo(u2.x) * (acc[mi][0] + bias), o1 = bf_hi(u2.x) * (acc[mi][1] + bias), o2 = bf_lo(u2.y) * (acc[mi][2] + bias), o3 = bf_hi(u2.y) * (acc[mi][3] + bias);
                    u32x2 wv; wv.x = cvt_pk_bf16(o0, o1); wv.y = cvt_pk_bf16(o2, o3);
                    *(u32x2*)(AO + (R0 + t) * DM + g * 128 + ch) = wv; }
            }
            __syncthreads();
        }
    }
    GRID_BAR(2);

    if (IN(3)) {
        pg8::Gemm g{DM, DM, DM}; pg8::PlainSched S; S.to.init(M / 256, 4, F.G, (int)blockIdx.x); S.A = (const char*)AO; S.B = (const char*)Wout_t; S.tA = (size_t)256 * DM * 2; S.tB = (size_t)256 * DM * 2;
        pg8::EpiResid<false> E{x, x1b, ssq1, (LAS float*)(F.lds + 131072 + 1024), x2f8, 1.f}; pg8::gemm_phase(F.lds, F.wave, g, S, E);
    }
    GRID_BAR(3);

    if (IN(4)) {
        pg8::Gemm g{DM / 2, DM / 2, DM / 2}; pg8::PlainSched S; S.to.init(M / 256, 4, F.G, (int)blockIdx.x); S.A = (const char*)x2f8; S.B = (const char*)Wq_t; S.tA = (size_t)256 * DM; S.tB = (size_t)256 * DM;
        pg8::EpiF8 E{(unsigned char*)Qm, DM, ssq1, F8_QSCALE * C2_MEM / (F8_XSCALE * F8_WSCALE)}; pg8::gemm_phase<pg8::EpiF8, pg8::PlainSched, false, true>(F.lds, F.wave, g, S, E);
    }
    if (MK_ONE_LAUNCH && IN(4) && IN(5)) LOCAL_SEAM();

    if (IN(5)) {
        pg8::Gemm g{DM / 2, DM / 2, 128}; pg8::MemAttnSched S; S.to.init(M / 256, 4, F.G, (int)blockIdx.x); S.A = (const char*)Qm; S.B = (const char*)Km; S.tA = (size_t)256 * DM; S.hA = 256; S.bB = (size_t)256 * DM; S.hB = 256;
        pg8::EpiSoftmax E{(unsigned char*)Sc, (LAS float*)(F.lds + LDS_MISC + 1024), 1.0f / (F8_QSCALE * F8_KSCALE)}; pg8::gemm_phase<pg8::EpiSoftmax, pg8::MemAttnSched, false, true>(F.lds, F.wave, g, S, E);
    }
    if (MK_ONE_LAUNCH && IN(5) && IN(6 + 1)) LOCAL_SEAM();

    if (IN(7)) {
        pg8::Gemm g{DM / 2, MROWS / 2, 128}; pg8::MemAttnSched S; S.to.init(M / 256, 4, F.G, (int)blockIdx.x); S.A = (const char*)Sc; S.B = (const char*)Vt; S.tA = (size_t)256 * DM; S.hA = 256; S.bB = 256; S.hB = (size_t)256 * MROWS;
        pg8::EpiF8 E{(unsigned char*)Om, DM, nullptr, F8_OSCALE / (F8_PSCALE * F8_VSCALE)}; pg8::gemm_phase<pg8::EpiF8, pg8::MemAttnSched, false, true>(F.lds, F.wave, g, S, E);
    }
    GRID_BAR(7);

    if (IN(8)) {
        pg8::Gemm g{DM / 2, DM / 2, DM / 2}; pg8::PlainSched S; S.to.init(M / 256, 4, F.G, (int)blockIdx.x); S.A = (const char*)Om; S.B = (const char*)Wo_t; S.tA = (size_t)256 * DM; S.tB = (size_t)256 * DM;
        pg8::EpiResid<true> E{x1b, x2b, ssq2, (LAS float*)(F.lds + 131072 + 1024), x2f8, 1.0f / (F8_OSCALE * F8_WSCALE)}; pg8::gemm_phase<pg8::EpiResid<true>, pg8::PlainSched, false, true>(F.lds, F.wave, g, S, E);
    }
    GRID_BAR(8);

    if (IN(9)) {
        pg8::Gemm g{DM, DM, DM}; pg8::PlainSched S; S.to.init(M / 256, 1, F.G, (int)blockIdx.x); S.A = (const char*)x2b; S.B = (const char*)Wr_t; S.tA = (size_t)256 * DM * 2; S.tB = 0;
        pg8::EpiRouter E{logit, ssq2, args.in[21], args.in[23], rstd2}; pg8::gemm_phase(F.lds, F.wave, g, S, E);
    }
    if (MK_ONE_LAUNCH && IN(9) && IN(10)) LOCAL_SEAM();

    if (IN(10)) {
        const int lane_ = lane_id(), tid_ = F.wave * 64 + lane_; (void)tid_;
        LAS unsigned* lcnt = (LAS unsigned*)F.lds; LAS unsigned* lbase = lcnt + 32;
        pg8::TileOrder to10; to10.init(M / 256, 1, F.G, (int)blockIdx.x);
        int pm10 = 0, pn10 = 0;
        for (int i10 = 0; to10.get(i10, pm10, pn10); ++i10) {
            if (tid_ < 32) lcnt[tid_] = 0u;
            __syncthreads();
            const int tok = pm10 * 256 + (tid_ & 255); const bool act_ = tid_ < 256;
            const f32x4 lg = *(const f32x4*)(logit + (size_t)tok * 64);
            int gi = 0; float gm = lg[0];
#pragma unroll
            for (int j = 1; j < 4; ++j) if (lg[j] > gm) { gm = lg[j]; gi = j; }
            float gs = 0.f;
#pragma unroll
            for (int j = 0; j < 4; ++j) gs += __expf(lg[j] - gm);
            const float gate = 1.0f / gs;
            const f32x4 ea = *(const f32x4*)(logit + (size_t)tok * 64 + 4 + gi * 8), eb = *(const f32x4*)(logit + (size_t)tok * 64 + 8 + gi * 8);
            const float el[8] = {ea[0], ea[1], ea[2], ea[3], eb[0], eb[1], eb[2], eb[3]};
            int i0 = 0; float m0 = el[0];
#pragma unroll
            for (int j = 1; j < 8; ++j) if (el[j] > m0) { m0 = el[j]; i0 = j; }
            int i1 = -1; float m1 = -__builtin_inff();
#pragma unroll
            for (int j = 0; j < 8; ++j) if (j != i0 && el[j] > m1) { m1 = el[j]; i1 = j; }
            if (i1 < 0) i1 = (i0 == 0) ? 1 : 0;
            const float r = __expf(m1 - m0);
            const float w0 = gate / (1.0f + r), w1 = gate * r / (1.0f + r);
            const int e0 = gi * 8 + i0, e1 = gi * 8 + i1;
            unsigned r0 = 0u, r1 = 0u; if (act_) { r0 = atomicAdd((unsigned*)&lcnt[e0], 1u); r1 = atomicAdd((unsigned*)&lcnt[e1], 1u); }
            __syncthreads();
            if (tid_ < 32) lbase[tid_] = atomicAdd(ctl + CW_CNT + tid_, lcnt[tid_]);
            __syncthreads();
            if (act_) { const unsigned s0 = lbase[e0] + r0, s1 = lbase[e1] + r1; const float rsx = rstd2[tok] * (1.0f / (F8_XSCALE * F8_WSCALE));
                tok_w[tok * 2] = w0; tok_w[tok * 2 + 1] = w1; tok_s[tok * 2] = (int)(((unsigned)e0 << 16) | s0); tok_s[tok * 2 + 1] = (int)(((unsigned)e1 << 16) | s1);
                slot_tok[(size_t)e0 * 65536 + s0] = tok; slot_tok[(size_t)e1 * 65536 + s1] = tok; slot_rs[(size_t)e0 * 65536 + s0] = rsx; slot_rs[(size_t)e1 * 65536 + s1] = rsx; }
            __syncthreads();
        }
    }
    GRID_BAR(10);

    LAS unsigned* lps = (LAS unsigned*)(F.lds + LDS_MOE);
    if (IN(12) || IN(13) || IN(14)) {
        const int lane_ = lane_id(), tid_ = F.wave * 64 + lane_;
        if (F.wave == 0) {
            const unsigned c = lane_ < 32 ? ld_u32_agent(ctl + CW_CNT + lane_) : 0u; unsigned sc = (c + 255u) & ~255u;
#pragma unroll
            for (int d = 1; d < 32; d <<= 1) { const unsigned t = (unsigned)__shfl_up((int)sc, d); if (lane_ >= d) sc += t; }
            if (lane_ < 32) lps[lane_ + 1] = sc;
            if (lane_ == 0) lps[0] = 0u;
        }
        __syncthreads();
        for (int b = tid_; b < MAXBLK_MOE; b += NTHR) { int e = 0;
#pragma unroll 1
            for (int j = 1; j < 32; ++j) e += ((lps[j] >> 8) <= (unsigned)b) ? 1 : 0;
            lps[64 + b] = (unsigned)e; }
        __syncthreads();
    }

    if (IN(12)) {
        pg8::Gemm g{DM / 2, DM / 2, DM / 2}; pg8::MoeSched S{F.G, F.vcu, lps, (const char*)x2f8, (const char*)Wgu_t, (size_t)0, (size_t)1024 * DM, (size_t)256 * DM, slot_tok};
        pg8::EpiGateUp E{(unsigned char*)act}; pg8::gemm_phase<pg8::EpiGateUp, pg8::MoeSched, true, true>(F.lds, F.wave, g, S, E);
    }
    GRID_BAR(12);

    if (IN(13)) {
        pg8::Gemm g{DEXP / 2, DEXP / 2, DEXP / 2}; pg8::MoeSched S{F.G, F.vcu, lps, (const char*)act, (const char*)Wd_t, (size_t)256 * DEXP, (size_t)1024 * DEXP, (size_t)256 * DEXP, slot_tok};
        pg8::EpiF8 E{(unsigned char*)yb, DM, nullptr, F8_YSCALE / (F8_WSCALE * F8_ASCALE)}; pg8::gemm_phase<pg8::EpiF8, pg8::MoeSched, false, true>(F.lds, F.wave, g, S, E);
    }
    GRID_BAR(13);

    if (IN(14)) {
        const int lane_ = lane_id(), tid_ = F.wave * 64 + lane_; (void)tid_;
        const f32x4* gr = (const f32x4*)args.in[27] + lane_;
        f32x4 gg[4];
#pragma unroll
        for (int j = 0; j < 4; ++j) gg[j] = gr[64 * j];
        for (int m = gw; m < M; m += 2 * NGW) {
            const int ma = m, mb = m + NGW;
            const unsigned sa0 = (unsigned)tok_s[ma * 2], sa1 = (unsigned)tok_s[ma * 2 + 1], sb0 = (unsigned)tok_s[mb * 2], sb1 = (unsigned)tok_s[mb * 2 + 1];
            const int pa0 = (int)(lps[sa0 >> 16] + (sa0 & 65535u)), pa1 = (int)(lps[sa1 >> 16] + (sa1 & 65535u)), pb0 = (int)(lps[sb0 >> 16] + (sb0 & 65535u)), pb1 = (int)(lps[sb1 >> 16] + (sb1 & 65535u));
            const float wa0 = tok_w[ma * 2], wa1 = tok_w[ma * 2 + 1], wb0 = tok_w[mb * 2], wb1 = tok_w[mb * 2 + 1];
            const u32x2* xa = (const u32x2*)(x2b + (size_t)ma * DM) + lane_; const u32x2* xb = (const u32x2*)(x2b + (size_t)mb * DM) + lane_;
            const unsigned* ya0 = (const unsigned*)((const unsigned char*)yb + (size_t)pa0 * DM) + lane_; const unsigned* ya1 = (const unsigned*)((const unsigned char*)yb + (size_t)pa1 * DM) + lane_;
            const unsigned* yb0 = (const unsigned*)((const unsigned char*)yb + (size_t)pb0 * DM) + lane_; const unsigned* yb1 = (const unsigned*)((const unsigned char*)yb + (size_t)pb1 * DM) + lane_;
            u32x2 ca[4], cb[4]; unsigned a0[4], a1[4], b0[4], b1[4];
#pragma unroll
            for (int j = 0; j < 4; ++j) { ca[j] = xa[64 * j]; cb[j] = xb[64 * j]; a0[j] = ya0[64 * j]; a1[j] = ya1[64 * j]; b0[j] = yb0[64 * j]; b1[j] = yb1[64 * j]; }
            f32x4 va[4], vb[4]; float sa = 0.f, sb = 0.f;
            const float ka0 = wa0 * (1.0f / F8_YSCALE), ka1 = wa1 * (1.0f / F8_YSCALE), kb0 = wb0 * (1.0f / F8_YSCALE), kb1 = wb1 * (1.0f / F8_YSCALE);
#pragma unroll
            for (int j = 0; j < 4; ++j) {
                const f32x2 p0 = __builtin_amdgcn_cvt_pk_f32_fp8(a0[j], false), p1 = __builtin_amdgcn_cvt_pk_f32_fp8(a0[j], true), q0 = __builtin_amdgcn_cvt_pk_f32_fp8(a1[j], false), q1 = __builtin_amdgcn_cvt_pk_f32_fp8(a1[j], true);
                const f32x2 r0 = __builtin_amdgcn_cvt_pk_f32_fp8(b0[j], false), r1 = __builtin_amdgcn_cvt_pk_f32_fp8(b0[j], true), t0 = __builtin_amdgcn_cvt_pk_f32_fp8(b1[j], false), t1 = __builtin_amdgcn_cvt_pk_f32_fp8(b1[j], true);
                va[j].x = bf_lo(ca[j].x) + ka0 * p0.x + ka1 * q0.x; va[j].y = bf_hi(ca[j].x) + ka0 * p0.y + ka1 * q0.y; va[j].z = bf_lo(ca[j].y) + ka0 * p1.x + ka1 * q1.x; va[j].w = bf_hi(ca[j].y) + ka0 * p1.y + ka1 * q1.y;
                vb[j].x = bf_lo(cb[j].x) + kb0 * r0.x + kb1 * t0.x; vb[j].y = bf_hi(cb[j].x) + kb0 * r0.y + kb1 * t0.y; vb[j].z = bf_lo(cb[j].y) + kb0 * r1.x + kb1 * t1.x; vb[j].w = bf_hi(cb[j].y) + kb0 * r1.y + kb1 * t1.y;
                sa += (va[j].x * va[j].x + va[j].y * va[j].y) + (va[j].z * va[j].z + va[j].w * va[j].w); sb += (vb[j].x * vb[j].x + vb[j].y * vb[j].y) + (vb[j].z * vb[j].z + vb[j].w * vb[j].w); }
            const float ra = __builtin_amdgcn_rsqf(wave_sum(sa) * (1.f / DM) + RMS_EPS), rb = __builtin_amdgcn_rsqf(wave_sum(sb) * (1.f / DM) + RMS_EPS);
            f32x4* oa = (f32x4*)(out + (size_t)ma * DM) + lane_; f32x4* ob = (f32x4*)(out + (size_t)mb * DM) + lane_;
#pragma unroll
            for (int j = 0; j < 4; ++j) { oa[64 * j] = va[j] * ra * gg[j]; ob[64 * j] = vb[j] * rb * gg[j]; }
        }
    }
#undef IN
#undef GRID_BAR
}

extern "C" void kernel_launch(void* const* d_in, const int* in_sizes, int n_in, void* d_out, int out_size, void* d_ws, size_t ws_size, hipStream_t stream) {
    static int grid = 0;
    if (grid == 0) {
        if (n_in != 28 || in_sizes[0] != M * DM || out_size != M * DM || ws_size < WS_END) { fprintf(stderr, "kernel_launch: unexpected shapes (n_in %d in0 %d out %d ws %zu)\n", n_in, n_in > 0 ? in_sizes[0] : -1, out_size, ws_size); grid = -1; return; }
        int dev = 0, cus = 0, per_cu = 0;
        if (hipGetDevice(&dev) != hipSuccess || hipDeviceGetAttribute(&cus, hipDeviceAttributeMultiprocessorCount, dev) != hipSuccess) { grid = -1; return; }
        if (hipFuncSetAttribute((const void*)mega, hipFuncAttributeMaxDynamicSharedMemorySize, LDS_BYTES) != hipSuccess) { fprintf(stderr, "kernel_launch: hipFuncSetAttribute failed\n"); grid = -1; return; }
        if (hipOccupancyMaxActiveBlocksPerMultiprocessor(&per_cu, (const void*)mega, NTHR, LDS_BYTES) != hipSuccess || per_cu < 1) { fprintf(stderr, "kernel_launch: occupancy query says %d\n", per_cu); per_cu = 1; }
        (void)hipGetLastError();
        grid = cus;
    }
    if (grid < 0) return;
    (void)hipMemsetAsync((char*)d_ws + WS_CTL, 0, CTL_BYTES, stream);
    Args a{};
    for (int i = 0; i < 28; ++i) a.in[i] = (const float*)d_in[i];
    a.out = (float*)d_out; a.ws = (unsigned char*)d_ws;
#if MK_ONE_LAUNCH
    a.ph_lo = 0; a.ph_hi = N_PHASES;
    void* kargs[] = {&a};
    hipError_t e = hipLaunchCooperativeKernel((const void*)mega, dim3(grid), dim3(NTHR), kargs, LDS_BYTES, stream);
    if (e != hipSuccess) fprintf(stderr, "cooperative launch failed: %s (grid %d)\n", hipGetErrorString(e), grid);
#else
    for (int p = 0; p < N_PHASES; ++p) { a.ph_lo = p; a.ph_hi = p + 1; hipLaunchKernelGGL(mega, dim3(grid), dim3(NTHR), LDS_BYTES, stream, a); }
#endif
}
```
